# Optimizing an MI355X kernel written in HIP

```python
import jax, jax.numpy as jnp
from jax import lax
import numpy as np

D_MODEL = 4096
BATCH = 4
SEQ = 4096
DEPTH = 2

CHUNK = 64
N_META = 16
Q_BLOCK = 128
RMS_EPS = 1e-6

LRU_WIDTH = D_MODEL // 2
LRU_BLOCKS = 16
LRU_BLOCK_DIM = LRU_WIDTH // LRU_BLOCKS
CONV_WIDTH = 4
LRU_C = 8.0
FOX_HEADS = 16
FOX_HEAD_DIM = (D_MODEL // 2) // FOX_HEADS
FOX_WIDTH = FOX_HEADS * FOX_HEAD_DIM
AB_IN = 2 * LRU_WIDTH + 3 * FOX_WIDTH + FOX_HEADS
AB_MIX = LRU_WIDTH + FOX_WIDTH

RET_HEADS = 16
RET_QK_DIM = D_MODEL // RET_HEADS
RET_V_DIM = 2 * D_MODEL // RET_HEADS
RET_QK_WIDTH = RET_HEADS * RET_QK_DIM
RET_V_WIDTH = RET_HEADS * RET_V_DIM
RET_IN = 2 * RET_QK_WIDTH + 2 * RET_V_WIDTH
ROPE_BASE = 10000.0

D_FF = -(-8 * D_MODEL // (3 * 256)) * 256

N_EVEN = (DEPTH + 1) // 2
N_ODD = DEPTH // 2

kernel_name = "hybrid_rglru_fox_retention_trunk"


def rms_norm(x, g):
    xf = x.astype(jnp.float32)
    y = xf * lax.rsqrt(jnp.mean(xf * xf, axis=-1, keepdims=True) + RMS_EPS)
    return (y * g.astype(jnp.float32)).astype(x.dtype)


def swiglu(x, w_gate, w_up, w_down):
    return (jax.nn.silu(x @ w_gate) * (x @ w_up)) @ w_down


def causal_depthwise_conv(x, w, b):
    L = x.shape[1]
    K = w.shape[0]
    xp = jnp.pad(x, ((0, 0), (K - 1, 0), (0, 0)))
    y = b
    for j in range(K):
        y = y + xp[:, j:j + L] * w[j]
    return y


def rg_lru(x, w_a, b_a, w_x, b_x, lam):
    Bsz, L, C = x.shape
    xb = x.reshape(Bsz, L, LRU_BLOCKS, LRU_BLOCK_DIM)
    r = jax.nn.sigmoid(jnp.einsum('blnc,ncd->blnd', xb, w_a).reshape(Bsz, L, C) + b_a)
    i = jax.nn.sigmoid(jnp.einsum('blnc,ncd->blnd', xb, w_x).reshape(Bsz, L, C) + b_x)
    log_a = -LRU_C * jax.nn.softplus(-lam.astype(jnp.float32)) * r.astype(jnp.float32)
    a = jnp.exp(log_a)
    gated_x = jnp.sqrt(-jnp.expm1(2.0 * log_a)) * (i * x).astype(jnp.float32)

    def combine(p, q):
        a1, b1 = p
        a2, b2 = q
        return a1 * a2, a2 * b1 + b2

    _, h = lax.associative_scan(combine, (a, gated_x), axis=1)
    return h.astype(x.dtype)


def forgetting_attention(q, k, v, f_logit):
    Bsz, L, H, Dh = q.shape
    log_f = jax.nn.log_sigmoid(f_logit.astype(jnp.float32))
    cum = jnp.cumsum(log_f, axis=1).transpose(0, 2, 1)
    n_blocks = -(-L // Q_BLOCK)
    pad = n_blocks * Q_BLOCK - L
    qp = jnp.pad(q, ((0, 0), (0, pad), (0, 0), (0, 0)))
    cq = jnp.pad(cum, ((0, 0), (0, 0), (0, pad)))
    scale = Dh ** -0.5
    key_pos = jnp.arange(L)

    def block(i):
        start = i * Q_BLOCK
        qb = lax.dynamic_slice_in_dim(qp, start, Q_BLOCK, axis=1)
        cb = lax.dynamic_slice_in_dim(cq, start, Q_BLOCK, axis=2)
        s = jnp.einsum('bqhd,bkhd->bhqk', qb, k).astype(jnp.float32) * scale
        s = s + cb[..., None] - cum[:, :, None, :]
        qpos = start + jnp.arange(Q_BLOCK)
        s = jnp.where(key_pos[None, :] <= qpos[:, None], s, -jnp.inf)
        p = jax.nn.softmax(s, axis=-1).astype(v.dtype)
        return jnp.einsum('bhqk,bkhd->bqhd', p, v)

    out = lax.map(block, jnp.arange(n_blocks))
    out = out.transpose(1, 0, 2, 3, 4).reshape(Bsz, n_blocks * Q_BLOCK, H, Dh)
    return out[:, :L]


def lru_fox_mixer(h, w_in, b_f, conv_w, conv_b, w_a, b_a, w_x, b_x, lam, q_norm, k_norm, w_out):
    Bsz, L, _ = h.shape
    z = h @ w_in
    cuts = [LRU_WIDTH, 2 * LRU_WIDTH, 2 * LRU_WIDTH + FOX_WIDTH,
            2 * LRU_WIDTH + 2 * FOX_WIDTH, 2 * LRU_WIDTH + 3 * FOX_WIDTH]
    x_lru, gate, q, k, v, f = jnp.split(z, cuts, axis=-1)
    x_lru = causal_depthwise_conv(x_lru, conv_w, conv_b)
    y_lru = rg_lru(x_lru, w_a, b_a, w_x, b_x, lam) * jax.nn.gelu(gate)
    q = rms_norm(q.reshape(Bsz, L, FOX_HEADS, FOX_HEAD_DIM), q_norm)
    k = rms_norm(k.reshape(Bsz, L, FOX_HEADS, FOX_HEAD_DIM), k_norm)
    v = v.reshape(Bsz, L, FOX_HEADS, FOX_HEAD_DIM)
    y_fox = forgetting_attention(q, k, v, f + b_f).reshape(Bsz, L, FOX_WIDTH)
    return jnp.concatenate([y_lru, y_fox.astype(y_lru.dtype)], axis=-1) @ w_out


def rotary(x, pos):
    half = x.shape[-1] // 2
    inv = ROPE_BASE ** (-jnp.arange(half, dtype=jnp.float32) / half)
    ang = pos[:, None].astype(jnp.float32) * inv[None, :]
    cos = jnp.cos(ang)[None, :, None, :]
    sin = jnp.sin(ang)[None, :, None, :]
    xf = x.astype(jnp.float32)
    x1, x2 = xf[..., :half], xf[..., half:]
    return jnp.concatenate([x1 * cos - x2 * sin, x1 * sin + x2 * cos], axis=-1).astype(x.dtype)


def retention_mixer(h, w_in, ret_norm, w_out):
    Bsz, L, _ = h.shape
    z = h @ w_in
    q, k, v, g = jnp.split(z, [RET_QK_WIDTH, 2 * RET_QK_WIDTH, 2 * RET_QK_WIDTH + RET_V_WIDTH], axis=-1)
    pos = jnp.arange(L)
    q = rotary(q.reshape(Bsz, L, RET_HEADS, RET_QK_DIM), pos)
    k = rotary(k.reshape(Bsz, L, RET_HEADS, RET_QK_DIM), pos) * (RET_QK_DIM ** -0.5)
    v = v.reshape(Bsz, L, RET_HEADS, RET_V_DIM)
    lead = (-N_META) % CHUNK
    padw = ((0, 0), (lead, 0), (0, 0), (0, 0))
    Lp = L + lead
    n_chunks = Lp // CHUNK

    def to_chunks(t):
        return jnp.pad(t, padw).reshape(Bsz, n_chunks, CHUNK, RET_HEADS, -1).transpose(1, 0, 3, 2, 4)

    qc, kc, vc = to_chunks(q), to_chunks(k), to_chunks(v)
    log_gamma = jnp.log(1.0 - 2.0 ** (-5.0 - jnp.arange(RET_HEADS, dtype=jnp.float32)))
    idx = jnp.arange(CHUNK, dtype=jnp.float32)
    intra_decay = jnp.exp(log_gamma[:, None, None] * jnp.abs(idx[:, None] - idx[None, :]))
    q_decay = jnp.exp(log_gamma[:, None] * (idx + 1.0))[..., None]
    k_decay = jnp.exp(log_gamma[:, None] * (CHUNK - 1.0 - idx))[..., None]
    chunk_decay = jnp.exp(log_gamma * CHUNK)[:, None, None]

    def step(S, inp):
        qb, kb, vb = inp
        s = jnp.einsum('bhcd,bhmd->bhcm', qb, kb) * intra_decay
        o = jnp.einsum('bhcm,bhme->bhce', s, vb) + jnp.einsum('bhcd,bhde->bhce', qb * q_decay, S)
        S = S * chunk_decay + jnp.einsum('bhmd,bhme->bhde', kb * k_decay, vb)
        return S, o

    S0 = jnp.zeros((Bsz, RET_HEADS, RET_QK_DIM, RET_V_DIM), jnp.float32)
    _, o = lax.scan(step, S0, (qc, kc, vc))
    o = o.transpose(1, 0, 3, 2, 4).reshape(Bsz, Lp, RET_HEADS, RET_V_DIM)[:, lead:]
    o = rms_norm(o, ret_norm.reshape(RET_HEADS, RET_V_DIM)).reshape(Bsz, L, RET_V_WIDTH).astype(h.dtype)
    return (jax.nn.silu(g) * o) @ w_out


def setup_inputs(seed: int = 0) -> dict:
    key = jax.random.key(seed)
    ks = jax.random.split(key, 24)
    f32 = jnp.float32

    def nrm(k, shape, fan_in):
        return jax.random.normal(k, shape, f32) * (fan_in ** -0.5)

    def gain(k, shape):
        return 1.0 + 0.01 * jax.random.normal(k, shape, f32)

    def small(k, shape):
        return 0.01 * jax.random.normal(k, shape, f32)

    a0 = jax.random.uniform(ks[11], (N_EVEN, LRU_WIDTH), f32, 0.9, 0.999)
    p = a0 ** (1.0 / LRU_C)
    lam = jnp.log(p) - jnp.log1p(-p)
    return {
        "x": jax.random.normal(ks[0], (BATCH, SEQ, D_MODEL), f32),
        "meta_tokens": jax.random.normal(ks[1], (N_META, D_MODEL), f32),
        "ab_norm": gain(ks[2], (N_EVEN, D_MODEL)),
        "ab_w_in": nrm(ks[3], (N_EVEN, D_MODEL, AB_IN), D_MODEL),
        "ab_b_f": 2.0 + 0.1 * jax.random.normal(ks[4], (N_EVEN, FOX_HEADS), f32),
        "ab_conv_w": nrm(ks[5], (N_EVEN, CONV_WIDTH, LRU_WIDTH), CONV_WIDTH),
        "ab_conv_b": small(ks[6], (N_EVEN, LRU_WIDTH)),
        "ab_w_a": nrm(ks[7], (N_EVEN, LRU_BLOCKS, LRU_BLOCK_DIM, LRU_BLOCK_DIM), LRU_BLOCK_DIM),
        "ab_b_a": small(ks[8], (N_EVEN, LRU_WIDTH)),
        "ab_w_x": nrm(ks[9], (N_EVEN, LRU_BLOCKS, LRU_BLOCK_DIM, LRU_BLOCK_DIM), LRU_BLOCK_DIM),
        "ab_b_x": small(ks[10], (N_EVEN, LRU_WIDTH)),
        "ab_lambda": lam,
        "ab_q_norm": gain(ks[12], (N_EVEN, FOX_HEAD_DIM)),
        "ab_k_norm": gain(ks[13], (N_EVEN, FOX_HEAD_DIM)),
        "ab_w_out": nrm(ks[14], (N_EVEN, AB_MIX, D_MODEL), AB_MIX),
        "c_norm": gain(ks[15], (N_ODD, D_MODEL)),
        "c_w_in": nrm(ks[16], (N_ODD, D_MODEL, RET_IN), D_MODEL),
        "c_ret_norm": gain(ks[17], (N_ODD, RET_V_WIDTH)),
        "c_w_out": nrm(ks[18], (N_ODD, RET_V_WIDTH, D_MODEL), RET_V_WIDTH),
        "ffn_norm": gain(ks[19], (DEPTH, D_MODEL)),
        "ffn_w_gate": nrm(ks[20], (DEPTH, D_MODEL, D_FF), D_MODEL),
        "ffn_w_up": nrm(ks[21], (DEPTH, D_MODEL, D_FF), D_MODEL),
        "ffn_w_down": nrm(ks[22], (DEPTH, D_FF, D_MODEL), D_FF),
    }


def reference(x, meta_tokens, ab_norm, ab_w_in, ab_b_f, ab_conv_w, ab_conv_b, ab_w_a, ab_b_a,
              ab_w_x, ab_b_x, ab_lambda, ab_q_norm, ab_k_norm, ab_w_out, c_norm, c_w_in,
              c_ret_norm, c_w_out, ffn_norm, ffn_w_gate, ffn_w_up, ffn_w_down):
    Bsz = x.shape[0]
    meta = jnp.broadcast_to(meta_tokens[None].astype(x.dtype), (Bsz, N_META, D_MODEL))
    h = jnp.concatenate([meta, x], axis=1)
    for layer in range(DEPTH):
        j = layer // 2
        if layer % 2 == 0:
            h = h + lru_fox_mixer(rms_norm(h, ab_norm[j]), ab_w_in[j], ab_b_f[j], ab_conv_w[j],
                                  ab_conv_b[j], ab_w_a[j], ab_b_a[j], ab_w_x[j], ab_b_x[j],
                                  ab_lambda[j], ab_q_norm[j], ab_k_norm[j], ab_w_out[j])
        else:
            h = h + retention_mixer(rms_norm(h, c_norm[j]), c_w_in[j], c_ret_norm[j], c_w_out[j])
        h = h + swiglu(rms_norm(h, ffn_norm[layer]), ffn_w_gate[layer], ffn_w_up[layer], ffn_w_down[layer])
    return h[:, N_META:]
```

```cpp
#include <hip/hip_runtime.h>
#include <cstdio>
#include <cstdint>
#ifndef MK_PER_PHASE
#define MK_PER_PHASE 1
#endif
constexpr int DM = 4096, NB = 4, SEQ = 4096, NMETA = 16, LSEQ = NMETA + SEQ;
constexpr int MTOK = NB * SEQ;
constexpr int MMETA = MTOK;
constexpr int MP = 65 * 256;
constexpr int LRU_W = 2048, FOX_H = 16, FOX_D = 128, AB_IN = 10256, AB_Z = 10240;
constexpr int RET_H = 16, RET_QK = 256, RET_V = 512, RET_IN = 24576, RET_VW = 8192;
constexpr int DFF = 11008;
constexpr float RMS_EPS = 1e-6f;
namespace pg8 {
#define PG8_LAS __attribute__((address_space(3)))
typedef unsigned short bf16_t;
typedef short bf16x8 __attribute__((ext_vector_type(8)));
typedef float f32x4 __attribute__((ext_vector_type(4)));
typedef unsigned u32x4 __attribute__((ext_vector_type(4)));
constexpr int BM = 256, BK = 64, HALF = 128, HTB = HALF * BK * 2  , STAGE_BYTES = 8 * HTB, NXCD = 8, WGM = 8;

__host__ __device__ __forceinline__ int lds_byte(int r, int c) { const int st = (r >> 4) * 2 + (c >> 5), rr = r & 15, cc = c & 31, ob = rr * 64 + cc * 2; return st * 1024 + (ob ^ (((ob >> 9) & 1) << 5)); }
__host__ __device__ __forceinline__ void stage_rc(int b, int& R, int& C) { const int st = b / 1024, sb = b % 1024, swz = sb ^ (((sb >> 9) & 1) << 5); R = (st >> 1) * 16 + swz / 64; C = (st & 1) * 32 + (swz % 64) / 2; }
__host__ __device__ __forceinline__ int perm32(int rho) { const int n = rho >> 4, i = rho & 15; return 8 * (i >> 2) + 4 * n + (i & 3); }

struct Unit { int pm, pn; };
struct Gemm { const bf16_t* A; const bf16_t* Bt; int M, N, K; };

struct StaticOrder {
    int nM, nN, nwg, G, c;
    __host__ __device__ void init(int M, int N, int G_, int c_) { nM = M / BM; nN = N / BM; nwg = nM * nN; G = G_; c = c_; }
    __host__ __device__ bool next(int i, Unit& u) const {
        const long L = (long)i * G + c; if (L >= nwg) return false;
        int wgid = (int)L; { const int q = nwg / NXCD, r = nwg % NXCD, xcd = wgid % NXCD, off = wgid / NXCD; wgid = (xcd < r ? xcd * (q + 1) : r * (q + 1) + (xcd - r) * q) + off; }
        const int nig = WGM * nN, gid = wgid / nig, fm = gid * WGM, gsz = (nM - fm) < WGM ? (nM - fm) : WGM;
        u.pm = fm + ((wgid % nig) % gsz); u.pn = (wgid % nig) / gsz; return true;
    }
    __device__ __forceinline__ void a_ready(const Unit&) const {}
    __device__ __forceinline__ void done(const Unit&) const {}
};

__device__ __forceinline__ unsigned cvt_pk_bf16(float lo, float hi) { unsigned r; asm volatile("v_cvt_pk_bf16_f32 %0, %1, %2" : "=v"(r) : "v"(lo), "v"(hi)); return r; }
__device__ __forceinline__ u32x4 pack8(const f32x4 a, const f32x4 b) { u32x4 w; w.x = cvt_pk_bf16(a[0], a[1]); w.y = cvt_pk_bf16(a[2], a[3]); w.z = cvt_pk_bf16(b[0], b[1]); w.w = cvt_pk_bf16(b[2], b[3]); return w; }
__device__ __forceinline__ float row_rstd(const float* ssq, int r) { return 1.0f / sqrtf(ssq[r] * (1.0f / 4096.0f) + RMS_EPS); }

struct EpiIn0 {
    static constexpr bool PERM = true, AFTER_DRAIN = false;
    bf16_t* Z; float* F; const float* ssq;
    __device__ __forceinline__ void operator()(const f32x4 (&acc)[2][2][4][2], const Unit& u, int wr, int wc, int fr, int fq) const {
        const int row0 = u.pm * BM + wr * 64 + fr;
        if (u.pn < 40) {
            const int col0 = u.pn * BM + wc * 32 + 8 * fq;
#pragma unroll
            for (int ai = 0; ai < 2; ++ai)
#pragma unroll
                for (int m = 0; m < 4; ++m) { const int r = row0 + ai * HALF + m * 16; const float rs = row_rstd(ssq, r); bf16_t* rowp = Z + (size_t)r * AB_Z + col0;
#pragma unroll
                    for (int bj = 0; bj < 2; ++bj) *(u32x4*)(rowp + bj * HALF) = pack8(acc[ai][bj][m][0] * rs, acc[ai][bj][m][1] * rs); }
        } else if (wc == 0 && fq < 2) {
#pragma unroll
            for (int ai = 0; ai < 2; ++ai)
#pragma unroll
                for (int m = 0; m < 4; ++m) { const int r = row0 + ai * HALF + m * 16; const float rs = row_rstd(ssq, r); float* fp = F + (size_t)r * 16 + 8 * fq;
                    *(f32x4*)(fp) = acc[ai][0][m][0] * rs; *(f32x4*)(fp + 4) = acc[ai][0][m][1] * rs; }
        }
    }
};
struct EpiRes {
    static constexpr bool PERM = true, AFTER_DRAIN = false;
    float* Htok; float* Hmeta; bf16_t* XB; float* ssq_out;
    __device__ __forceinline__ void operator()(const f32x4 (&acc)[2][2][4][2], const Unit& u, int wr, int wc, int fr, int fq) const {
        const int row0 = u.pm * BM + wr * 64 + fr, col0 = u.pn * BM + wc * 32 + 8 * fq;
        float* H = u.pm < MTOK / BM ? Htok : Hmeta - (size_t)MTOK * DM;
#pragma unroll
        for (int ai = 0; ai < 2; ++ai)
#pragma unroll
            for (int m = 0; m < 4; ++m) { const int r = row0 + ai * HALF + m * 16; float* hp = H + (size_t)r * DM + col0; bf16_t* xp = XB + (size_t)r * DM + col0; float s = 0.f;
#pragma unroll
                for (int bj = 0; bj < 2; ++bj) { const f32x4 v0 = *(const f32x4*)(hp + bj * HALF) + acc[ai][bj][m][0], v1 = *(const f32x4*)(hp + bj * HALF + 4) + acc[ai][bj][m][1];
                    *(f32x4*)(hp + bj * HALF) = v0; *(f32x4*)(hp + bj * HALF + 4) = v1; *(u32x4*)(xp + bj * HALF) = pack8(v0, v1);
                    s += (v0[0] * v0[0] + v0[1] * v0[1]) + (v0[2] * v0[2] + v0[3] * v0[3]) + (v1[0] * v1[0] + v1[1] * v1[1]) + (v1[2] * v1[2] + v1[3] * v1[3]); }
                s += __shfl_xor(s, 16); s += __shfl_xor(s, 32);
                if (fq == 0) atomicAdd(ssq_out + r, s);
                asm volatile("" ::: "memory"); }
    }
};
struct EpiFinal {
    static constexpr bool PERM = true, AFTER_DRAIN = false;
    float* OUT;
    __device__ __forceinline__ void operator()(const f32x4 (&acc)[2][2][4][2], const Unit& u, int wr, int wc, int fr, int fq) const {
        const int row0 = u.pm * BM + wr * 64 + fr, col0 = u.pn * BM + wc * 32 + 8 * fq;
#pragma unroll
        for (int ai = 0; ai < 2; ++ai)
#pragma unroll
            for (int m = 0; m < 4; ++m) { const int r = row0 + ai * HALF + m * 16; float* op = OUT + (size_t)r * DM + col0; const float* hp = op;
#pragma unroll
                for (int bj = 0; bj < 2; ++bj) { const f32x4 v0 = *(const f32x4*)(hp + bj * HALF) + acc[ai][bj][m][0], v1 = *(const f32x4*)(hp + bj * HALF + 4) + acc[ai][bj][m][1];
                    *(f32x4*)(op + bj * HALF) = v0; *(f32x4*)(op + bj * HALF + 4) = v1; }
                asm volatile("" ::: "memory"); }
    }
};
struct EpiGU {
    static constexpr bool PERM = true, AFTER_DRAIN = false;
    bf16_t* HID; const float* ssq;
    __device__ __forceinline__ void operator()(const f32x4 (&acc)[2][2][4][2], const Unit& u, int wr, int wc, int fr, int fq) const {
        const int row0 = u.pm * BM + wr * 64 + fr, col0 = u.pn * HALF + wc * 32 + 8 * fq;
#pragma unroll
        for (int ai = 0; ai < 2; ++ai)
#pragma unroll
            for (int m = 0; m < 4; ++m) { const int r = row0 + ai * HALF + m * 16; const float rs = row_rstd(ssq, r); f32x4 o[2];
#pragma unroll
                for (int n = 0; n < 2; ++n)
#pragma unroll
                    for (int j = 0; j < 4; ++j) { const float g = acc[ai][0][m][n][j] * rs, uu = acc[ai][1][m][n][j] * rs;
                        o[n][j] = g * uu * __builtin_amdgcn_rcpf(1.0f + __expf(-g)); }
                *(u32x4*)(HID + (size_t)r * DFF + col0) = pack8(o[0], o[1]); }
    }
};
struct EpiIn1 {
    static constexpr bool PERM = true, AFTER_DRAIN = false;
    bf16_t* Z; const float* ssq;
    __device__ __forceinline__ void operator()(const f32x4 (&acc)[2][2][4][2], const Unit& u, int wr, int wc, int fr, int fq) const {
        const int row0 = u.pm * BM + wr * 64 + fr, col0 = u.pn * BM + wc * 32 + 8 * fq;
        if (u.pn < 32) {
            const float sc = u.pn < 16 ? 1.0f : 0.0625f;
            float inv[2][4];
#pragma unroll
            for (int n = 0; n < 2; ++n)
#pragma unroll
                for (int j = 0; j < 4; ++j) inv[n][j] = exp2f(-(float)(wc * 32 + 8 * fq + 4 * n + j) * (13.287712379549449f / 128.0f));
#pragma unroll
            for (int ai = 0; ai < 2; ++ai)
#pragma unroll
                for (int m = 0; m < 4; ++m) { const int r = row0 + ai * HALF + m * 16; const float rs = row_rstd(ssq, r) * sc;
                    const float t = (float)(r < MTOK ? NMETA + (r & (SEQ - 1)) : ((r - MTOK) & 15));
                    f32x4 o1[2], o2[2];
#pragma unroll
                    for (int n = 0; n < 2; ++n)
#pragma unroll
                        for (int j = 0; j < 4; ++j) { const float x1 = acc[ai][0][m][n][j] * rs, x2 = acc[ai][1][m][n][j] * rs;
                            const float ang = t * inv[n][j]; float rev = ang * 0.15915494309189535f; rev = rev - floorf(rev);
                            const float c = __builtin_amdgcn_cosf(rev), s = __builtin_amdgcn_sinf(rev);
                            o1[n][j] = x1 * c - x2 * s; o2[n][j] = x1 * s + x2 * c; }
                    bf16_t* rowp = Z + (size_t)r * RET_IN + col0;
                    *(u32x4*)(rowp) = pack8(o1[0], o1[1]); *(u32x4*)(rowp + HALF) = pack8(o2[0], o2[1]); }
        } else {
#pragma unroll
            for (int ai = 0; ai < 2; ++ai)
#pragma unroll
                for (int m = 0; m < 4; ++m) { const int r = row0 + ai * HALF + m * 16; const float rs = row_rstd(ssq, r); bf16_t* rowp = Z + (size_t)r * RET_IN + col0;
#pragma unroll
                    for (int bj = 0; bj < 2; ++bj) *(u32x4*)(rowp + bj * HALF) = pack8(acc[ai][bj][m][0] * rs, acc[ai][bj][m][1] * rs); }
        }
    }
};

template <class Epi, class Sched, bool ALIGN_EPI = false, bool SP2 = false>
__device__ __forceinline__ void gemm_phase(PG8_LAS unsigned char* lds, const Gemm g, const Sched& S, const Epi& E) {
    const int tid = threadIdx.x, wid = __builtin_amdgcn_readfirstlane(tid >> 6), lane = tid & 63, wr = wid >> 2, wc = wid & 3, fr = lane & 15, fq = lane >> 4;
    const int K = g.K, nt = K / BK;
    unsigned voffA[2], voffB[2];
#pragma unroll
    for (int i = 0; i < 2; ++i) { int R, C; stage_rc(tid * 16 + i * 8192, R, C); const int Rb = Epi::PERM ? ((R & ~31) + perm32(R & 31)) : R;
        voffA[i] = (unsigned)(R * K + C) * 2u; voffB[i] = (unsigned)(Rb * K + C) * 2u; }
    const size_t kstep = (size_t)(BK * 2);
    const size_t hstep = (size_t)HALF * K * 2;
    const size_t tstep = 2 * hstep;
    const unsigned ldsw = (unsigned)wid * 1024u;
    const int aoff = lds_byte(wr * 64 + fr, fq * 8), boff = lds_byte(wc * 32 + fr, fq * 8);
#define PG8_SA(b, h) (((b) * 2 + (h)) * HTB)
#define PG8_SB(b, h) ((4 + (b) * 2 + (h)) * HTB)
#define PG8_STAGE(bufoff, gbase, voff) do { _Pragma("unroll") for (int _i = 0; _i < 2; ++_i) \
        __builtin_amdgcn_global_load_lds((const unsigned*)((const char*)(gbase) + (voff)[_i]), (PG8_LAS unsigned*)(lds + (bufoff) + ldsw + _i * 8192), 16, 0, 0); } while (0)
#define PG8_LDA(dst, b, h) do { _Pragma("unroll") for (int m = 0; m < 4; ++m) _Pragma("unroll") for (int k = 0; k < 2; ++k) dst[m][k] = *(const PG8_LAS bf16x8*)(lds + PG8_SA(b, h) + aoff + m * 2048 + k * 1024); } while (0)
#define PG8_LDB(dst, b, h) do { _Pragma("unroll") for (int n = 0; n < 2; ++n) _Pragma("unroll") for (int k = 0; k < 2; ++k) dst[n][k] = *(const PG8_LAS bf16x8*)(lds + PG8_SB(b, h) + boff + n * 2048 + k * 1024); } while (0)
#define PG8_MMA(ai, bj, At, Bt) do { __builtin_amdgcn_s_setprio(1); _Pragma("unroll") for (int m = 0; m < 4; ++m) _Pragma("unroll") for (int n = 0; n < 2; ++n) _Pragma("unroll") for (int k = 0; k < 2; ++k) \
        acc[ai][bj][m][n] = __builtin_amdgcn_mfma_f32_16x16x32_bf16(Bt[n][k], At[m][k], acc[ai][bj][m][n], 0, 0, 0); __builtin_amdgcn_s_setprio(0); } while (0)
#define PG8_WAIT_V(n) asm volatile("s_waitcnt vmcnt(" #n ")" ::: "memory")
#define PG8_WAIT_L(n) asm volatile("s_waitcnt lgkmcnt(" #n ")" ::: "memory")
#define PG8_BAR __builtin_amdgcn_s_barrier()
#define PG8_SCHED __builtin_amdgcn_sched_barrier(0)
    Unit cur, nxt; int ui = 0;
    if (!S.next(0, cur)) return;
    f32x4 acc[2][2][4][2];
#pragma unroll
    for (int a = 0; a < 2; ++a)
#pragma unroll
        for (int b = 0; b < 2; ++b)
#pragma unroll
            for (int m = 0; m < 4; ++m)
#pragma unroll
                for (int n = 0; n < 2; ++n) acc[a][b][m][n] = (f32x4){0.f, 0.f, 0.f, 0.f};
    bf16x8 At[4][2], B0[2][2], B1[2][2];
    const char* cA = (const char*)g.A + (size_t)cur.pm * tstep; const char* cB = (const char*)g.Bt + (size_t)cur.pn * tstep;
    S.a_ready(cur);
    if constexpr (SP2) {
        PG8_STAGE(PG8_SB(0, 0), cB, voffB); PG8_STAGE(PG8_SB(0, 1), cB + hstep, voffB); PG8_STAGE(PG8_SA(0, 0), cA, voffA); PG8_STAGE(PG8_SA(0, 1), cA + hstep, voffA);
        if (wr == 1) PG8_BAR;
        PG8_WAIT_V(2); PG8_BAR;
        PG8_STAGE(PG8_SB(1, 0), cB + kstep, voffB); PG8_STAGE(PG8_SA(1, 0), cA + kstep, voffA); PG8_STAGE(PG8_SB(1, 1), cB + hstep + kstep, voffB);
        PG8_WAIT_V(6); PG8_BAR;
    } else {
        PG8_STAGE(PG8_SB(0, 0), cB, voffB); PG8_STAGE(PG8_SA(0, 0), cA, voffA); PG8_STAGE(PG8_SB(0, 1), cB + hstep, voffB); PG8_STAGE(PG8_SA(0, 1), cA + hstep, voffA);
        if (wr == 1) PG8_BAR;
        PG8_WAIT_V(4); PG8_BAR;
        PG8_STAGE(PG8_SB(1, 0), cB + kstep, voffB); PG8_STAGE(PG8_SA(1, 0), cA + kstep, voffA); PG8_STAGE(PG8_SB(1, 1), cB + hstep + kstep, voffB);
        PG8_WAIT_V(6); PG8_BAR;
    }
    for (;;) {
        const bool has_next = S.next(ui + 1, nxt);
        const char* nA = has_next ? (const char*)g.A + (size_t)nxt.pm * tstep : cA; const char* nB = has_next ? (const char*)g.Bt + (size_t)nxt.pn * tstep : cB;
        for (int t = 0; t < nt; t += 2) {
            const bool last = (t == nt - 2);
            const char* a1 = cA + (size_t)(t + 1) * kstep;
            const char* a2 = last ? nA : cA + (size_t)(t + 2) * kstep; const char* b2 = last ? nB : cB + (size_t)(t + 2) * kstep;
            const char* a3 = a2 + kstep; const char* b3 = b2 + kstep;
            if (last && has_next) S.a_ready(nxt);
            if constexpr (SP2) {
            PG8_LDB(B0, 0, 0); PG8_LDB(B1, 0, 1); PG8_SCHED; PG8_LDA(At, 0, 0); PG8_STAGE(PG8_SA(1, 1), a1 + hstep, voffA);
            PG8_WAIT_V(8); PG8_WAIT_L(0); PG8_BAR; PG8_MMA(0, 0, At, B0); PG8_MMA(0, 1, At, B1); PG8_BAR; PG8_SCHED;
            PG8_LDA(At, 0, 1); PG8_STAGE(PG8_SB(0, 0), b2, voffB); PG8_STAGE(PG8_SB(0, 1), b2 + hstep, voffB); PG8_STAGE(PG8_SA(0, 0), a2, voffA);
            PG8_WAIT_V(8); PG8_WAIT_L(0); PG8_BAR; PG8_MMA(1, 0, At, B0); PG8_MMA(1, 1, At, B1); PG8_BAR; PG8_SCHED;
            PG8_LDB(B0, 1, 0); PG8_LDB(B1, 1, 1); PG8_SCHED; PG8_LDA(At, 1, 0); PG8_STAGE(PG8_SA(0, 1), a2 + hstep, voffA);
            PG8_WAIT_V(8); PG8_WAIT_L(0); PG8_BAR; PG8_MMA(0, 0, At, B0); PG8_MMA(0, 1, At, B1); PG8_BAR; PG8_SCHED;
            PG8_LDA(At, 1, 1); PG8_STAGE(PG8_SB(1, 0), b3, voffB); PG8_STAGE(PG8_SB(1, 1), b3 + hstep, voffB); PG8_STAGE(PG8_SA(1, 0), a3, voffA);
            PG8_WAIT_V(8); PG8_WAIT_L(0); PG8_BAR; PG8_MMA(1, 0, At, B0); PG8_MMA(1, 1, At, B1); PG8_BAR; PG8_SCHED;
            } else {
            PG8_LDB(B0, 0, 0); PG8_SCHED; PG8_LDA(At, 0, 0); PG8_STAGE(PG8_SA(1, 1), a1 + hstep, voffA);
            PG8_WAIT_L(8); PG8_BAR; PG8_WAIT_L(0); PG8_MMA(0, 0, At, B0); PG8_BAR; PG8_SCHED;
            PG8_LDB(B1, 0, 1); PG8_STAGE(PG8_SB(0, 0), b2, voffB);
            PG8_BAR; PG8_WAIT_L(0); PG8_MMA(0, 1, At, B1); PG8_BAR;
            PG8_LDA(At, 0, 1); PG8_STAGE(PG8_SA(0, 0), a2, voffA);
            PG8_BAR; PG8_WAIT_L(0); PG8_MMA(1, 0, At, B0); PG8_BAR; PG8_SCHED;
            PG8_STAGE(PG8_SB(0, 1), b2 + hstep, voffB);
            PG8_WAIT_V(6); PG8_BAR; PG8_MMA(1, 1, At, B1); PG8_BAR;
            PG8_LDB(B0, 1, 0); PG8_SCHED; PG8_LDA(At, 1, 0); PG8_STAGE(PG8_SA(0, 1), a2 + hstep, voffA);
            PG8_WAIT_L(8); PG8_BAR; PG8_WAIT_L(0); PG8_MMA(0, 0, At, B0); PG8_BAR; PG8_SCHED;
            PG8_LDB(B1, 1, 1); PG8_STAGE(PG8_SB(1, 0), b3, voffB);
            PG8_BAR; PG8_WAIT_L(0); PG8_MMA(0, 1, At, B1); PG8_BAR;
            PG8_LDA(At, 1, 1); PG8_STAGE(PG8_SA(1, 0), a3, voffA);
            PG8_BAR; PG8_WAIT_L(0); PG8_MMA(1, 0, At, B0); PG8_BAR; PG8_SCHED;
            PG8_STAGE(PG8_SB(1, 1), b3 + hstep, voffB);
            PG8_WAIT_V(6); PG8_BAR; PG8_MMA(1, 1, At, B1); PG8_BAR;
            }
        }
        if constexpr (ALIGN_EPI) { if (wr == 0) PG8_BAR; }
        if constexpr (!Epi::AFTER_DRAIN) { E(acc, cur, wr, wc, fr, fq); S.done(cur); }
        if (!has_next) break;
#pragma unroll
        for (int a = 0; a < 2; ++a)
#pragma unroll
            for (int b = 0; b < 2; ++b)
#pragma unroll
                for (int m = 0; m < 4; ++m)
#pragma unroll
                    for (int n = 0; n < 2; ++n) acc[a][b][m][n] = (f32x4){0.f, 0.f, 0.f, 0.f};
        cur = nxt; cA = nA; cB = nB; ++ui;
        if constexpr (ALIGN_EPI) { if (wr == 1) PG8_BAR; }
    }
    PG8_WAIT_V(0);
    if constexpr (!ALIGN_EPI) { if (wr == 0) PG8_BAR; }
    PG8_BAR;
    if constexpr (Epi::AFTER_DRAIN) { E.fused(acc, cur, wr, wc, fr, fq, lds, wid, lane); S.done(cur); }
#undef PG8_SA
#undef PG8_SB
#undef PG8_STAGE
#undef PG8_LDA
#undef PG8_LDB
#undef PG8_MMA
#undef PG8_WAIT_V
#undef PG8_WAIT_L
#undef PG8_BAR
#undef PG8_SCHED
}
}

constexpr size_t MiB = 1u << 20;
constexpr size_t WS_CTL = 0, CTL_ZERO_BYTES = 2 * MiB;
constexpr size_t WS_SSQ1 = 64 * 1024, WS_SSQ2 = 192 * 1024, WS_SSQ3 = 320 * 1024, WS_SSQO = 512 * 1024;
constexpr size_t WS_SSQ0 = 2 * MiB;
constexpr size_t WS_FBUF = 2 * MiB + 512 * 1024;
constexpr size_t WS_HMETA = 4 * MiB;
constexpr size_t WS_WIN0 = 8 * MiB, WS_WOUT0 = 90 * MiB, WS_WGU0 = 122 * MiB, WS_WD0 = 294 * MiB, WS_WIN1 = 380 * MiB, WS_WOUT1 = 572 * MiB, WS_WGU1 = 636 * MiB, WS_WD1 = 808 * MiB;
constexpr size_t WS_WAT = 894 * MiB, WS_WXT = WS_WAT + 512 * 1024;
constexpr size_t WS_XB = 896 * MiB, WS_Z = 1026 * MiB, WS_END = 1806 * MiB;
constexpr size_t WS_Y0 = WS_Z + 400 * MiB;
constexpr size_t WS_Y1 = 8 * MiB;
static_assert(WS_SSQO + (size_t)MP * 16 * 4 <= CTL_ZERO_BYTES && WS_FBUF + (size_t)MP * 16 * 4 <= WS_HMETA && WS_HMETA + (size_t)256 * DM * 4 <= WS_WIN0, "ctl map");
static_assert(WS_WIN0 + (size_t)41 * 256 * DM * 2 <= WS_WOUT0 && WS_WGU0 + (size_t)2 * DFF * DM * 2 <= WS_WD0 && WS_WD0 + (size_t)DM * DFF * 2 <= WS_WIN1 && WS_WIN1 + (size_t)RET_IN * DM * 2 <= WS_WOUT1, "weight map");
static_assert(WS_WOUT1 + (size_t)DM * RET_VW * 2 <= WS_WGU1 && WS_WGU1 + (size_t)2 * DFF * DM * 2 <= WS_WD1 && WS_WD1 + (size_t)DM * DFF * 2 <= WS_WAT, "weight map 2");
static_assert(WS_XB + (size_t)MP * DM * 2 <= WS_Z && WS_Z + (size_t)MP * RET_IN * 2 <= WS_END && WS_Z + (size_t)MP * AB_Z * 2 <= WS_Y0 && WS_Z + (size_t)MP * DFF * 2 <= WS_Y0 && WS_Y0 + (size_t)MP * DM * 2 <= WS_END && WS_Y1 + (size_t)MP * RET_VW * 2 <= WS_WD0, "activation map");
constexpr int CW_TMO = 0, CW_Q2 = 64, CW_BAR = 4096;
constexpr int RING_BYTES = 131072;
constexpr int LDS_BYTES = 147456;
constexpr int MISC_OFF = LDS_BYTES - 256;
constexpr int NWAVES = 8, NTHREADS = 512;
constexpr int NPHASES = 12;

#define GAS __attribute__((address_space(1)))
#define LAS __attribute__((address_space(3)))
typedef unsigned short bf16;
typedef unsigned v4u __attribute__((ext_vector_type(4)));
typedef unsigned v2u __attribute__((ext_vector_type(2)));
typedef float f32x4 __attribute__((ext_vector_type(4)));
typedef short bf16x8 __attribute__((ext_vector_type(8)));
typedef short bf16x4 __attribute__((ext_vector_type(4)));
typedef GAS unsigned gu32;
#define RLX_AGENT __ATOMIC_RELAXED, __HIP_MEMORY_SCOPE_AGENT
#define LDS_WAIT() asm volatile("s_waitcnt lgkmcnt(0)" ::: "memory")
#define VM_WAIT() asm volatile("s_waitcnt vmcnt(0)" ::: "memory")
__device__ __forceinline__ unsigned f2bf(float f) { unsigned u = __builtin_bit_cast(unsigned, f); return (u + 0x7fffu + ((u >> 16) & 1u)) >> 16; }
__device__ __forceinline__ unsigned pk2(float lo, float hi) { return pg8::cvt_pk_bf16(lo, hi); }
__device__ __forceinline__ float bflo(unsigned w) { return __builtin_bit_cast(float, w << 16); }
__device__ __forceinline__ float bfhi(unsigned w) { return __builtin_bit_cast(float, w & 0xffff0000u); }
__device__ __forceinline__ float bf2f(unsigned short h) { return __builtin_bit_cast(float, (unsigned)h << 16); }
__device__ __forceinline__ void unpack8(const v4u w, float (&f)[8]) { f[0] = bflo(w.x); f[1] = bfhi(w.x); f[2] = bflo(w.y); f[3] = bfhi(w.y); f[4] = bflo(w.z); f[5] = bfhi(w.z); f[6] = bflo(w.w); f[7] = bfhi(w.w); }
__device__ __forceinline__ v4u pack8f(const float (&f)[8]) { v4u w; w.x = pk2(f[0], f[1]); w.y = pk2(f[2], f[3]); w.z = pk2(f[4], f[5]); w.w = pk2(f[6], f[7]); return w; }
__device__ __forceinline__ int row_of(int b, int t) { return t < NMETA ? MMETA + NMETA * b + t : b * SEQ + (t - NMETA); }
__device__ __forceinline__ f32x4 mfma16(bf16x8 a, bf16x8 b, f32x4 c) { return __builtin_amdgcn_mfma_f32_16x16x32_bf16(a, b, c, 0, 0, 0); }

#define XB_TMO      128
#define XB_XCNT(j)  (256  + 64 * (j))
#define XB_XSUB(j)  (1280 + 64 * (j))
#define XB_XGEN(j)  (2304 + 64 * (j))
#define XB_TOP      3328
#define XB_TOPGEN   3392
#define XCD_BAR_WORDS 3456
#define XB_SPIN_CAP (1u << 22)

__device__ __forceinline__ unsigned xb_ld(unsigned* p)              { return __hip_atomic_load(p, __ATOMIC_RELAXED, __HIP_MEMORY_SCOPE_AGENT); }
__device__ __forceinline__ unsigned xb_add(unsigned* p, unsigned v) { return __hip_atomic_fetch_add(p, v, __ATOMIC_RELAXED, __HIP_MEMORY_SCOPE_AGENT); }
__device__ __forceinline__ unsigned xb_xcc_id() { return (unsigned)__builtin_amdgcn_s_getreg((3 << 11) | 20) & 0xFu; }
#define XB_SPIN(cond, bar) do { unsigned _sp = 0; while (cond) { __builtin_amdgcn_s_sleep(1); \
    if ((++_sp & 255u) == 0u) { if (xb_ld(&(bar)[XB_TMO])) break; if (_sp > XB_SPIN_CAP) { atomicAdd(&(bar)[XB_TMO], 1u); break; } } } } while (0)

struct XcdBarrier {
    unsigned* bar; unsigned x;
    volatile LAS unsigned* st;
};
__device__ __forceinline__ XcdBarrier xcd_barrier_post(unsigned* bar, volatile LAS unsigned* st) {
    XcdBarrier b; b.bar = bar; b.x = xb_xcc_id(); b.st = st;
    if (threadIdx.x == 0) (void)xb_add(&bar[XB_XCNT(b.x)], 1u);
    return b;
}
__device__ __forceinline__ void xcd_barrier_complete(unsigned* bar, unsigned x, unsigned& nloc, unsigned& nx) {
    const unsigned G = gridDim.x * gridDim.y * gridDim.z;
    unsigned sum, cnt, mine, sp = 0u;
    for (;;) {
        sum = 0u; cnt = 0u; mine = 0u;
#pragma unroll
        for (unsigned j = 0; j < 16; ++j) { const unsigned c = xb_ld(&bar[XB_XCNT(j)]); sum += c; cnt += (c > 0u) ? 1u : 0u; mine = (j == x) ? c : mine; }
        if (sum == G) break;
        __builtin_amdgcn_s_sleep(1);
        if ((++sp & 255u) == 0u) { if (xb_ld(&bar[XB_TMO])) break; if (sp > XB_SPIN_CAP) { atomicAdd(&bar[XB_TMO], 1u); break; } }
    }
    nloc = mine > 0u ? mine : 1u; nx = cnt > 0u ? cnt : 1u;
}
__device__ __forceinline__ void xcd_barrier(const XcdBarrier& b) {
    asm volatile("s_waitcnt vmcnt(0)" ::: "memory");
    __syncthreads();
    if (threadIdx.x == 0) {
        unsigned* bar = b.bar;
        __builtin_amdgcn_s_waitcnt(0);
        unsigned nloc = b.st[0], nx = b.st[1];
        if (nloc == 0u) { xcd_barrier_complete(bar, b.x, nloc, nx); b.st[0] = nloc; b.st[1] = nx; }
        const unsigned old = xb_add(&bar[XB_XSUB(b.x)], 1u);
        const unsigned gen = old / nloc;
        if (old + 1u == (gen + 1u) * nloc) {
            __builtin_amdgcn_fence(__ATOMIC_RELEASE, "agent");
            asm volatile("s_waitcnt vmcnt(0)" ::: "memory");
            const unsigned og = xb_add(&bar[XB_TOP], 1u);
            const unsigned tg = og / nx;
            if (og + 1u == (tg + 1u) * nx) xb_add(&bar[XB_TOPGEN], 1u);
            else XB_SPIN(xb_ld(&bar[XB_TOPGEN]) == tg, bar);
            __builtin_amdgcn_fence(__ATOMIC_ACQUIRE, "agent");
            xb_add(&bar[XB_XGEN(b.x)], 1u);
            asm volatile("s_waitcnt vmcnt(0)" ::: "memory");
        } else {
            XB_SPIN(xb_ld(&bar[XB_XGEN(b.x)]) == gen, bar);
            __builtin_amdgcn_fence(__ATOMIC_ACQUIRE, "agent");
            asm volatile("s_waitcnt vmcnt(0)" ::: "memory");
        }
    }
    __syncthreads();
}

struct Args { const float* in[23]; float* out; unsigned char* ws; int ph_lo, ph_hi; };
__device__ __forceinline__ float* h_row(float* out, unsigned char* ws, int r) { return r < MTOK ? out + (size_t)r * DM : (float*)(ws + WS_HMETA) + (size_t)(r - MTOK) * DM; }
struct Frame {
    LAS unsigned char* lds;
    volatile LAS unsigned* MISC;
    unsigned char* ws;
    int tid, lane, wave, G;
};
__device__ __forceinline__ float wave_sum(float v) {
#pragma unroll
    for (int o = 1; o < 64; o <<= 1) v += __shfl_xor(v, o);
    return v;
}

template <int MODE>
__device__ __forceinline__ void p0_transpose_item(const float* W, int K, int N, const float* gain, bf16* WT, LAS float* scr, int item, int lane) {
    const int nblk = (N + 31) / 32, kb = item / nblk, nb = item - kb * nblk, k0 = 64 * kb, n0 = 32 * nb;
    const int nn = n0 + (lane & 31); const bool ok = nn < N;
#pragma unroll 8
    for (int i = 0; i < 32; ++i) { const int kk = 2 * i + (lane >> 5); float v = ok ? W[(size_t)(k0 + kk) * N + nn] : 0.f; if (gain) v *= gain[k0 + kk]; scr[kk * 33 + (lane & 31)] = v; }
    LDS_WAIT(); asm volatile("" ::: "memory");
    const int c = lane & 7;
#pragma unroll
    for (int j = 0; j < 4; ++j) { const int n = (lane >> 3) + 8 * j; const LAS float* s = scr + (8 * c) * 33 + n;
        v4u o; o.x = pk2(s[0 * 33], s[1 * 33]); o.y = pk2(s[2 * 33], s[3 * 33]); o.z = pk2(s[4 * 33], s[5 * 33]); o.w = pk2(s[6 * 33], s[7 * 33]);
        const int ng = n0 + n; const int drow = MODE == 0 ? ng : (MODE == 1 ? 256 * (ng >> 7) + (ng & 127) : 256 * (ng >> 7) + 128 + (ng & 127));
        *(GAS v4u*)(WT + (size_t)drow * K + k0 + 8 * c) = o; }
    LDS_WAIT(); asm volatile("" ::: "memory");
}
__device__ __forceinline__ void p0_row(Frame& F, const float* x, const float* meta, float* out, int r) {
    float* hrow = h_row(out, F.ws, r); bf16* xrow = (bf16*)(F.ws + WS_XB) + (size_t)r * DM;
    const float* src = r < MTOK ? x + (size_t)r * DM : meta + (size_t)((r - MTOK) & 15) * DM;
    const bool pad = r >= MTOK + NB * NMETA;
    float s = 0.f;
#pragma unroll 4
    for (int j = 0; j < 16; ++j) { const int e = (F.lane + 64 * j) * 4;
        f32x4 v = pad ? (f32x4){0.f, 0.f, 0.f, 0.f} : *(const GAS f32x4*)(src + e);
        s += (v.x * v.x + v.y * v.y) + (v.z * v.z + v.w * v.w);
        *(GAS f32x4*)(hrow + e) = v; v2u w; w.x = pk2(v.x, v.y); w.y = pk2(v.z, v.w); *(GAS v2u*)(xrow + e) = w; }
    s = wave_sum(s);
    if (F.lane == 0) ((float*)(F.ws + WS_SSQ0))[r] = s;
}
__device__ __forceinline__ void p0_prologue(Frame& F, const Args& A) {
    LAS float* scr = (LAS float*)(F.lds + F.wave * 16384);
    const int gw = blockIdx.x * NWAVES + F.wave, NGW = F.G * NWAVES;
    unsigned char* ws = F.ws;
    constexpr int I_IN0 = 64 * 321, I_SQ = 64 * 128, I_G = 64 * 344, I_D = 172 * 128, I_IN1 = 64 * 768, I_O1 = 128 * 128, I_BD = 16 * 8;
    constexpr int NITEMS = I_IN0 + I_SQ + 2 * (2 * I_G + I_D) + I_IN1 + I_O1 + 2 * I_BD;
    for (int it = gw; it < NITEMS; it += NGW) {
        int r = it;
        if (r < I_IN0) { p0_transpose_item<0>(A.in[3], DM, AB_IN, A.in[2], (bf16*)(ws + WS_WIN0), scr, r, F.lane); continue; } r -= I_IN0;
        if (r < I_SQ) { p0_transpose_item<0>(A.in[14], DM, DM, nullptr, (bf16*)(ws + WS_WOUT0), scr, r, F.lane); continue; } r -= I_SQ;
        if (r < I_G) { p0_transpose_item<1>(A.in[20], DM, DFF, A.in[19], (bf16*)(ws + WS_WGU0), scr, r, F.lane); continue; } r -= I_G;
        if (r < I_G) { p0_transpose_item<2>(A.in[21], DM, DFF, A.in[19], (bf16*)(ws + WS_WGU0), scr, r, F.lane); continue; } r -= I_G;
        if (r < I_D) { p0_transpose_item<0>(A.in[22], DFF, DM, nullptr, (bf16*)(ws + WS_WD0), scr, r, F.lane); continue; } r -= I_D;
        if (r < I_IN1) { p0_transpose_item<0>(A.in[16], DM, RET_IN, A.in[15], (bf16*)(ws + WS_WIN1), scr, r, F.lane); continue; } r -= I_IN1;
        if (r < I_O1) { p0_transpose_item<0>(A.in[18], RET_VW, DM, nullptr, (bf16*)(ws + WS_WOUT1), scr, r, F.lane); continue; } r -= I_O1;
        if (r < I_G) { p0_transpose_item<1>(A.in[20] + (size_t)DM * DFF, DM, DFF, A.in[19] + DM, (bf16*)(ws + WS_WGU1), scr, r, F.lane); continue; } r -= I_G;
        if (r < I_G) { p0_transpose_item<2>(A.in[21] + (size_t)DM * DFF, DM, DFF, A.in[19] + DM, (bf16*)(ws + WS_WGU1), scr, r, F.lane); continue; } r -= I_G;
        if (r < I_D) { p0_transpose_item<0>(A.in[22] + (size_t)DFF * DM, DFF, DM, nullptr, (bf16*)(ws + WS_WD1), scr, r, F.lane); continue; } r -= I_D;
        if (r < I_BD) { const int blk = r >> 3; p0_transpose_item<0>(A.in[7] + (size_t)blk * 16384, 128, 128, nullptr, (bf16*)(ws + WS_WAT) + (size_t)blk * 16384, scr, r & 7, F.lane); continue; } r -= I_BD;
        { const int blk = r >> 3; p0_transpose_item<0>(A.in[9] + (size_t)blk * 16384, 128, 128, nullptr, (bf16*)(ws + WS_WXT) + (size_t)blk * 16384, scr, r & 7, F.lane); }
    }
    for (int m = gw; m < MP; m += NGW) p0_row(F, A.in[0], A.in[1], A.out, m);
}

__device__ __forceinline__ float sigmoidf_fast(float x) { return __builtin_amdgcn_rcpf(1.0f + __expf(-x)); }
__device__ __forceinline__ float gelu_tanh(float g) { const float z = 0.7978845608028654f * (g + 0.044715f * g * g * g); const float e = __expf(2.0f * z); return 0.5f * g * (2.0f - 2.0f * __builtin_amdgcn_rcpf(e + 1.0f)); }

constexpr int LRU_XA = 0, LRU_XA_STRIDE = 272, LRU_XF = 17408, LRU_XF_STRIDE = 132  , LRU_SA = 51200, LRU_SB = 83968, LRU_CARRY = 116736;
__device__ __forceinline__ void lru_item(Frame& F, const Args& A, int b, int n) {
    const bf16* z0 = (const bf16*)(F.ws + WS_Z); bf16* y0 = (bf16*)(F.ws + WS_Y0);
    const int tid = F.tid, lane = F.lane, w = F.wave, fr = lane & 15, fq = lane >> 4;
    LAS unsigned char* lds = F.lds;
    LAS float* XF = (LAS float*)(lds + LRU_XF); LAS float* SA = (LAS float*)(lds + LRU_SA); LAS float* SB = (LAS float*)(lds + LRU_SB); LAS float* CARRY = (LAS float*)(lds + LRU_CARRY);
    const int c8 = (tid & 15) * 8, r4 = tid >> 4;
    const int ch0 = n * 128 + c8;
    float cw[4][8], cb[8];
#pragma unroll
    for (int e = 0; e < 8; ++e) { cb[e] = A.in[6][ch0 + e];
#pragma unroll
        for (int j = 0; j < 4; ++j) cw[j][e] = A.in[5][j * LRU_W + ch0 + e]; }
    const int dch = n * 128 + 16 * w + fr;
    const float ba = A.in[8][dch], bx = A.in[10][dch];
    const float cneg = -8.0f * log1pf(expf(-A.in[11][dch]));
    bf16x8 bwa[4], bwx[4];
    { const bf16* wat = (const bf16*)(F.ws + WS_WAT) + ((size_t)n * 128 + 16 * w + fr) * 128 + 8 * fq; const bf16* wxt = (const bf16*)(F.ws + WS_WXT) + ((size_t)n * 128 + 16 * w + fr) * 128 + 8 * fq;
#pragma unroll
      for (int ks = 0; ks < 4; ++ks) { bwa[ks] = *(const bf16x8*)(wat + 32 * ks); bwx[ks] = *(const bf16x8*)(wxt + 32 * ks); } }
    if (tid < 128) CARRY[tid] = 0.f;
    for (int tau = 0; tau < 65; ++tau) {
        v4u gv[2];
#pragma unroll
        for (int q = 0; q < 2; ++q) {
            const int rr = r4 + 32 * q, t = 64 * tau + rr - 48;
            float xc[8];
#pragma unroll
            for (int e = 0; e < 8; ++e) xc[e] = cb[e];
            gv[q] = (v4u){0u, 0u, 0u, 0u};
            if (t >= 0) {
                gv[q] = *(const GAS v4u*)(z0 + (size_t)row_of(b, t) * AB_Z + LRU_W + ch0);
#pragma unroll
                for (int j = 0; j < 4; ++j) { const int tj = t - 3 + j;
                    if (tj >= 0) { const v4u xv = *(const GAS v4u*)(z0 + (size_t)row_of(b, tj) * AB_Z + ch0); float xf[8]; unpack8(xv, xf);
#pragma unroll
                        for (int e = 0; e < 8; ++e) xc[e] += cw[j][e] * xf[e]; } }
            }
            *(LAS v4u*)(lds + LRU_XA + rr * LRU_XA_STRIDE + c8 * 2) = pack8f(xc);
            *(LAS f32x4*)(XF + rr * LRU_XF_STRIDE + c8) = (f32x4){xc[0], xc[1], xc[2], xc[3]};
            *(LAS f32x4*)(XF + rr * LRU_XF_STRIDE + c8 + 4) = (f32x4){xc[4], xc[5], xc[6], xc[7]};
        }
        __syncthreads();
        f32x4 accr[4], acci[4];
#pragma unroll
        for (int m = 0; m < 4; ++m) { accr[m] = (f32x4){0.f, 0.f, 0.f, 0.f}; acci[m] = (f32x4){0.f, 0.f, 0.f, 0.f}; }
#pragma unroll
        for (int m = 0; m < 4; ++m)
#pragma unroll
            for (int ks = 0; ks < 4; ++ks) { const bf16x8 a = *(const LAS bf16x8*)(lds + LRU_XA + (16 * m + fr) * LRU_XA_STRIDE + (32 * ks + 8 * fq) * 2);
                accr[m] = mfma16(a, bwa[ks], accr[m]); acci[m] = mfma16(a, bwx[ks], acci[m]); }
#pragma unroll
        for (int m = 0; m < 4; ++m)
#pragma unroll
            for (int g = 0; g < 4; ++g) { const int rr = 16 * m + 4 * fq + g, d = 16 * w + fr;
                const float rg = sigmoidf_fast(accr[m][g] + ba), ig = sigmoidf_fast(acci[m][g] + bx);
                const float la = cneg * rg; const float av = __expf(la); const float mult = sqrtf(fmaxf(1.0f - __expf(2.0f * la), 0.f));
                float bv = mult * (ig * XF[rr * LRU_XF_STRIDE + d]);
                if (tau == 0 && rr < 48) bv = 0.f;
                SA[rr * 128 + d] = av; SB[rr * 128 + d] = bv; }
        __syncthreads();
        if (tid < 128) { float h = CARRY[tid];
#pragma unroll 8
            for (int rr = 0; rr < 64; ++rr) { h = SA[rr * 128 + tid] * h + SB[rr * 128 + tid]; SB[rr * 128 + tid] = h; }
            CARRY[tid] = h; }
        __syncthreads();
#pragma unroll
        for (int q = 0; q < 2; ++q) {
            const int rr = r4 + 32 * q, t = 64 * tau + rr - 48;
            if (t >= 0) { float gf[8], o[8]; unpack8(gv[q], gf);
                const f32x4 h0 = *(const LAS f32x4*)(SB + rr * 128 + c8), h1 = *(const LAS f32x4*)(SB + rr * 128 + c8 + 4);
#pragma unroll
                for (int e = 0; e < 4; ++e) { o[e] = h0[e] * gelu_tanh(gf[e]); o[e + 4] = h1[e] * gelu_tanh(gf[e + 4]); }
                *(GAS v4u*)(y0 + (size_t)row_of(b, t) * DM + ch0) = pack8f(o); }
        }
    }
    __syncthreads();
}

constexpr int AT_KT = 0, AT_KT_STRIDE = 272, AT_VT = 17408, AT_VT_STRIDE = 144, AT_PS = 35840, AT_PS_STRIDE = 144, AT_CUM = 72704, AT_SCAN = 90112;
__device__ __forceinline__ float log_sigmoid(float x) { return fminf(x, 0.f) - log1pf(__expf(-fabsf(x))); }
__device__ __forceinline__ void attn_item(Frame& F, const Args& A, int b, int h, int j) {
    const bf16* z0 = (const bf16*)(F.ws + WS_Z); bf16* y0 = (bf16*)(F.ws + WS_Y0); const float* fbuf = (const float*)(F.ws + WS_FBUF);
    const int tid = F.tid, lane = F.lane, w = F.wave, fr = lane & 15, fq = lane >> 4;
    LAS unsigned char* lds = F.lds;
    LAS float* CUM = (LAS float*)(lds + AT_CUM); LAS float* SCAN = (LAS float*)(lds + AT_SCAN);
    LAS unsigned char* PSw = lds + AT_PS + w * (32 * AT_PS_STRIDE);
    constexpr float LOG2E = 1.4426950408889634f;
    const int nT = NMETA + 256 * j;
    { const float bf_h = A.in[4][h];
      float loc[9]; float run = 0.f;
#pragma unroll
      for (int e = 0; e < 9; ++e) { const int t = 9 * tid + e; float v = 0.f; if (t < nT) v = log_sigmoid(fbuf[(size_t)row_of(b, t) * 16 + h] + bf_h); run += v; loc[e] = run; }
      float inc = run;
#pragma unroll
      for (int o = 1; o < 64; o <<= 1) { const float t = __shfl_up(inc, o); if (lane >= o) inc += t; }
      if (lane == 63) SCAN[w] = inc;
      __syncthreads();
      float off = inc - run;
      for (int k = 0; k < w; ++k) off += SCAN[k];
#pragma unroll
      for (int e = 0; e < 9; ++e) { const int t = 9 * tid + e; if (t < nT) CUM[t + 240] = (off + loc[e]) * LOG2E; }
      if (tid < 240) CUM[tid] = 0.f;
      __syncthreads(); }
    bf16x8 qf[2][4]; float bq[2][4];
    const int ubase = 256 * j + 32 * w;
#pragma unroll
    for (int m = 0; m < 2; ++m) {
        const int u = ubase + 16 * m + fr; const int t = u - 240; const int r = row_of(b, t < 0 ? 0 : t);
        const bf16* qp = z0 + (size_t)r * AB_Z + 4096 + 128 * h + 8 * fq;
        float qv[4][8]; float s = 0.f;
#pragma unroll
        for (int ks = 0; ks < 4; ++ks) { const v4u raw = *(const GAS v4u*)(qp + 32 * ks); unpack8(raw, qv[ks]);
#pragma unroll
            for (int e = 0; e < 8; ++e) s += qv[ks][e] * qv[ks][e]; }
        s += __shfl_xor(s, 16); s += __shfl_xor(s, 32);
        const float rs = (1.0f / sqrtf(s * (1.0f / 128.0f) + RMS_EPS)) * (0.08838834764831845f * LOG2E);
#pragma unroll
        for (int ks = 0; ks < 4; ++ks) { float o[8];
#pragma unroll
            for (int e = 0; e < 8; ++e) o[e] = qv[ks][e] * rs * A.in[12][32 * ks + 8 * fq + e];
            const v4u pk = pack8f(o); qf[m][ks] = __builtin_bit_cast(bf16x8, pk); }
#pragma unroll
        for (int g = 0; g < 4; ++g) bq[m][g] = CUM[ubase + 16 * m + 4 * fq + g];
    }
    f32x4 O[2][8]; float mrow[2][4], lrow[2][4];
#pragma unroll
    for (int m = 0; m < 2; ++m) {
#pragma unroll
        for (int dt = 0; dt < 8; ++dt) O[m][dt] = (f32x4){0.f, 0.f, 0.f, 0.f};
#pragma unroll
        for (int g = 0; g < 4; ++g) { mrow[m][g] = -1e30f; lrow[m][g] = 0.f; } }
    const int imax = 4 * j + 3;
    const int skey = tid >> 3, sdc = (tid & 7) * 16;
    v4u kreg[2], vreg[2];
    { const int t = 64 * 3 + skey - 240; const int r = row_of(b, t < 0 ? 0 : t); const bf16* kp = z0 + (size_t)r * AB_Z + 6144 + 128 * h + sdc; const bf16* vp = z0 + (size_t)r * AB_Z + 8192 + 128 * h + sdc;
      kreg[0] = *(const GAS v4u*)(kp); kreg[1] = *(const GAS v4u*)(kp + 8); vreg[0] = *(const GAS v4u*)(vp); vreg[1] = *(const GAS v4u*)(vp + 8); }
    for (int i = 3; i <= imax; ++i) {
        __syncthreads();
        { float kv[16]; { float a8[8], b8[8]; unpack8(kreg[0], a8); unpack8(kreg[1], b8);
#pragma unroll
            for (int e = 0; e < 8; ++e) { kv[e] = a8[e]; kv[8 + e] = b8[e]; } }
          float s = 0.f;
#pragma unroll
          for (int e = 0; e < 16; ++e) s += kv[e] * kv[e];
          s += __shfl_xor(s, 1); s += __shfl_xor(s, 2); s += __shfl_xor(s, 4);
          const float rs = 1.0f / sqrtf(s * (1.0f / 128.0f) + RMS_EPS);
          float o0[8], o1[8];
          { const f32x4 g0 = *(const GAS f32x4*)(A.in[13] + sdc), g1 = *(const GAS f32x4*)(A.in[13] + sdc + 4), g2 = *(const GAS f32x4*)(A.in[13] + sdc + 8), g3 = *(const GAS f32x4*)(A.in[13] + sdc + 12);
#pragma unroll
          for (int e = 0; e < 4; ++e) { o0[e] = kv[e] * rs * g0[e]; o0[4 + e] = kv[4 + e] * rs * g1[e]; o1[e] = kv[8 + e] * rs * g2[e]; o1[4 + e] = kv[12 + e] * rs * g3[e]; } }
          *(LAS v4u*)(lds + AT_KT + skey * AT_KT_STRIDE + sdc * 2) = pack8f(o0);
          *(LAS v4u*)(lds + AT_KT + skey * AT_KT_STRIDE + sdc * 2 + 16) = pack8f(o1);
          const unsigned vw[8] = {vreg[0].x, vreg[0].y, vreg[0].z, vreg[0].w, vreg[1].x, vreg[1].y, vreg[1].z, vreg[1].w};
#pragma unroll
          for (int e = 0; e < 8; ++e) { *(LAS unsigned short*)(lds + AT_VT + (sdc + 2 * e) * AT_VT_STRIDE + skey * 2) = (unsigned short)(vw[e] & 0xffffu);
              *(LAS unsigned short*)(lds + AT_VT + (sdc + 2 * e + 1) * AT_VT_STRIDE + skey * 2) = (unsigned short)(vw[e] >> 16); } }
        __syncthreads();
        if (i < imax) { const int t = 64 * (i + 1) + skey - 240; const int r = row_of(b, t); const bf16* kp = z0 + (size_t)r * AB_Z + 6144 + 128 * h + sdc; const bf16* vp = z0 + (size_t)r * AB_Z + 8192 + 128 * h + sdc;
            kreg[0] = *(const GAS v4u*)(kp); kreg[1] = *(const GAS v4u*)(kp + 8); vreg[0] = *(const GAS v4u*)(vp); vreg[1] = *(const GAS v4u*)(vp + 8); }
        if (64 * i <= ubase + 31) {
            f32x4 S[2][4];
#pragma unroll
            for (int m = 0; m < 2; ++m)
#pragma unroll
                for (int nt = 0; nt < 4; ++nt) S[m][nt] = (f32x4){0.f, 0.f, 0.f, 0.f};
#pragma unroll
            for (int nt = 0; nt < 4; ++nt)
#pragma unroll
                for (int ks = 0; ks < 4; ++ks) { const bf16x8 kf = *(const LAS bf16x8*)(lds + AT_KT + (16 * nt + fr) * AT_KT_STRIDE + (32 * ks + 8 * fq) * 2);
                    S[0][nt] = mfma16(qf[0][ks], kf, S[0][nt]); S[1][nt] = mfma16(qf[1][ks], kf, S[1][nt]); }
            float bk[4];
#pragma unroll
            for (int nt = 0; nt < 4; ++nt) bk[nt] = CUM[64 * i + 16 * nt + fr];
            const bool need_mask = (i == 3) || (64 * i + 63 > ubase);
            float alpha[2][4];
#pragma unroll
            for (int m = 0; m < 2; ++m)
#pragma unroll
                for (int g = 0; g < 4; ++g) {
                    const int uq = ubase + 16 * m + 4 * fq + g;
                    float mx = -__builtin_inff();
#pragma unroll
                    for (int nt = 0; nt < 4; ++nt) { float sv = S[m][nt][g] + (bq[m][g] - bk[nt]);
                        if (need_mask) { const int uk = 64 * i + 16 * nt + fr; if (uk > uq || uk < 240) sv = -__builtin_inff(); }
                        S[m][nt][g] = sv; mx = fmaxf(mx, sv); }
                    mx = fmaxf(mx, __shfl_xor(mx, 1)); mx = fmaxf(mx, __shfl_xor(mx, 2)); mx = fmaxf(mx, __shfl_xor(mx, 4)); mx = fmaxf(mx, __shfl_xor(mx, 8));
                    const float mn = fmaxf(mrow[m][g], mx);
                    alpha[m][g] = __builtin_amdgcn_exp2f(mrow[m][g] - mn); mrow[m][g] = mn;
                    float ps = 0.f;
#pragma unroll
                    for (int nt = 0; nt < 4; ++nt) { const float p = __builtin_amdgcn_exp2f(S[m][nt][g] - mn); ps += p;
                        *(LAS unsigned short*)(PSw + (16 * m + 4 * fq + g) * AT_PS_STRIDE + (16 * nt + fr) * 2) = (unsigned short)(pk2(p, 0.f) & 0xffffu); }
                    lrow[m][g] = lrow[m][g] * alpha[m][g] + ps;
                }
#pragma unroll
            for (int m = 0; m < 2; ++m)
#pragma unroll
                for (int dt = 0; dt < 8; ++dt)
#pragma unroll
                    for (int g = 0; g < 4; ++g) O[m][dt][g] *= alpha[m][g];
            LDS_WAIT();
            bf16x8 pf[2][2];
#pragma unroll
            for (int m = 0; m < 2; ++m)
#pragma unroll
                for (int k2 = 0; k2 < 2; ++k2) pf[m][k2] = *(const LAS bf16x8*)(PSw + (16 * m + fr) * AT_PS_STRIDE + (32 * k2 + 8 * fq) * 2);
#pragma unroll
            for (int dt = 0; dt < 8; ++dt)
#pragma unroll
                for (int k2 = 0; k2 < 2; ++k2) { const bf16x8 vf = *(const LAS bf16x8*)(lds + AT_VT + (16 * dt + fr) * AT_VT_STRIDE + (32 * k2 + 8 * fq) * 2);
                    O[0][dt] = mfma16(pf[0][k2], vf, O[0][dt]); O[1][dt] = mfma16(pf[1][k2], vf, O[1][dt]); }
        }
    }
#pragma unroll
    for (int m = 0; m < 2; ++m)
#pragma unroll
        for (int g = 0; g < 4; ++g) {
            float l = lrow[m][g]; l += __shfl_xor(l, 1); l += __shfl_xor(l, 2); l += __shfl_xor(l, 4); l += __shfl_xor(l, 8);
            const int t = ubase + 16 * m + 4 * fq + g - 240;
            if (t >= 0) { const float il = 1.0f / l; bf16* op = y0 + (size_t)row_of(b, t) * DM + LRU_W + 128 * h + fr;
#pragma unroll
                for (int dt = 0; dt < 8; ++dt) op[16 * dt] = (bf16)(pk2(O[m][dt][g] * il, 0.f) & 0xffffu); }
        }
    __syncthreads();
}

__device__ __forceinline__ int p2_fetch(Frame& F, gu32* qctr) {
    if (F.tid == 0) F.MISC[0] = __hip_atomic_fetch_add(qctr, 1u, RLX_AGENT);
    __syncthreads();
    const int item = (int)F.MISC[0];
    __syncthreads();
    return item;
}
__device__ __forceinline__ void p2_mixer0(Frame& F, const Args& A) {
    gu32* qctr = (gu32*)(F.ws + WS_CTL) + CW_Q2;
    constexpr int N_LRU = NB * 16, N_ATT = NB * FOX_H * 17;
    int item = p2_fetch(F, qctr);
    while (item < N_LRU) { lru_item(F, A, item >> 4, item & 15); item = p2_fetch(F, qctr); }
    while (item < N_LRU + N_ATT) { const int a = item - N_LRU; const int j = 16 - a / 64, bh = a % 64; attn_item(F, A, bh >> 4, bh & 15, j); item = p2_fetch(F, qctr); }
}

constexpr int RT_QS = 0, RT_QS_STRIDE = 528, RT_KN = 33792, RT_KT = 67584, RT_T_STRIDE = 144, RT_VT = 104448, RT_SS = 122880;
static_assert(RT_SS + 64 * RT_T_STRIDE <= MISC_OFF, "retention LDS map");
__device__ __forceinline__ int ret_row(int b, int c, int idx) { return c == 0 ? (idx < 48 ? -1 : MMETA + NMETA * b + (idx - 48)) : b * SEQ + 64 * (c - 1) + idx; }
__device__ __forceinline__ void ret_item(Frame& F, const Args& A, int b, int h, int es) {
    const bf16* z1 = (const bf16*)(F.ws + WS_Z); bf16* ob = (bf16*)(F.ws + WS_Y1); float* ssqo = (float*)(F.ws + WS_SSQO);
    const int tid = F.tid, lane = F.lane, w = F.wave, fr = lane & 15, fq = lane >> 4;
    LAS unsigned char* lds = F.lds;
    const float lg = log1pf(-exp2f(-5.0f - (float)h)) * 1.4426950408889634f;
    const float cdec = exp2f(lg * 64.0f);
    f32x4 Sacc[16];
#pragma unroll
    for (int dt = 0; dt < 16; ++dt) Sacc[dt] = (f32x4){0.f, 0.f, 0.f, 0.f};
    const int qrow = tid >> 5, qd = (tid & 31) * 8;
    const int vrow = tid >> 4, ve = (tid & 15) * 8;
    v4u qreg[4], kreg[4], vreg[2];
    const size_t qcol = (size_t)h * RET_QK + qd, kcol = 4096 + (size_t)h * RET_QK + qd, vcol = 8192 + (size_t)h * RET_V + 128 * es + ve;
#define RT_PREFETCH(c) do { \
        _Pragma("unroll") for (int k = 0; k < 4; ++k) { const int r = ret_row(b, (c), qrow + 16 * k); \
            if (r >= 0) { qreg[k] = *(const GAS v4u*)(z1 + (size_t)r * RET_IN + qcol); kreg[k] = *(const GAS v4u*)(z1 + (size_t)r * RET_IN + kcol); } \
            else { qreg[k] = (v4u){0u, 0u, 0u, 0u}; kreg[k] = (v4u){0u, 0u, 0u, 0u}; } } \
        _Pragma("unroll") for (int k = 0; k < 2; ++k) { const int r = ret_row(b, (c), vrow + 32 * k); \
            if (r >= 0) vreg[k] = *(const GAS v4u*)(z1 + (size_t)r * RET_IN + vcol); else vreg[k] = (v4u){0u, 0u, 0u, 0u}; } } while (0)
    RT_PREFETCH(0);
    for (int c = 0; c < 65; ++c) {
        __syncthreads();
#pragma unroll
        for (int k = 0; k < 4; ++k) { const int m = qrow + 16 * k;
            *(LAS v4u*)(lds + RT_QS + m * RT_QS_STRIDE + qd * 2) = qreg[k];
            *(LAS v4u*)(lds + RT_KN + m * RT_QS_STRIDE + qd * 2) = kreg[k];
            float kf[8]; unpack8(kreg[k], kf); const float kd = exp2f(lg * (float)(63 - m));
#pragma unroll
            for (int e = 0; e < 8; e += 2) { const unsigned pk = pk2(kf[e] * kd, kf[e + 1] * kd);
                *(LAS unsigned short*)(lds + RT_KT + (qd + e) * RT_T_STRIDE + m * 2) = (unsigned short)(pk & 0xffffu);
                *(LAS unsigned short*)(lds + RT_KT + (qd + e + 1) * RT_T_STRIDE + m * 2) = (unsigned short)(pk >> 16); } }
#pragma unroll
        for (int k = 0; k < 2; ++k) { const int m = vrow + 32 * k; const unsigned vw[4] = {vreg[k].x, vreg[k].y, vreg[k].z, vreg[k].w};
#pragma unroll
            for (int e = 0; e < 4; ++e) { *(LAS unsigned short*)(lds + RT_VT + (ve + 2 * e) * RT_T_STRIDE + m * 2) = (unsigned short)(vw[e] & 0xffffu);
                *(LAS unsigned short*)(lds + RT_VT + (ve + 2 * e + 1) * RT_T_STRIDE + m * 2) = (unsigned short)(vw[e] >> 16); } }
        __syncthreads();
        if (c < 64) RT_PREFETCH(c + 1);
        { const int it = w >> 1, mt0 = 2 * (w & 1);
          f32x4 sacc[2] = {(f32x4){0.f, 0.f, 0.f, 0.f}, (f32x4){0.f, 0.f, 0.f, 0.f}};
#pragma unroll
          for (int ks = 0; ks < 8; ++ks) { const bf16x8 a = *(const LAS bf16x8*)(lds + RT_QS + (16 * it + fr) * RT_QS_STRIDE + (32 * ks + 8 * fq) * 2);
#pragma unroll
              for (int q = 0; q < 2; ++q) { const bf16x8 kb = *(const LAS bf16x8*)(lds + RT_KN + (16 * (mt0 + q) + fr) * RT_QS_STRIDE + (32 * ks + 8 * fq) * 2); sacc[q] = mfma16(a, kb, sacc[q]); } }
#pragma unroll
          for (int q = 0; q < 2; ++q)
#pragma unroll
              for (int g = 0; g < 4; ++g) { const int i = 16 * it + 4 * fq + g, m = 16 * (mt0 + q) + fr; const int dd = i > m ? i - m : m - i;
                  const float sv = sacc[q][g] * exp2f(lg * (float)dd);
                  *(LAS unsigned short*)(lds + RT_SS + i * RT_T_STRIDE + m * 2) = (unsigned short)(pk2(sv, 0.f) & 0xffffu); } }
        __syncthreads();
        f32x4 acc[4];
#pragma unroll
        for (int mi = 0; mi < 4; ++mi) acc[mi] = (f32x4){0.f, 0.f, 0.f, 0.f};
#pragma unroll
        for (int kk = 0; kk < 8; ++kk) {
            v4u bw; bw.x = pk2(Sacc[2 * kk][0], Sacc[2 * kk][1]); bw.y = pk2(Sacc[2 * kk][2], Sacc[2 * kk][3]); bw.z = pk2(Sacc[2 * kk + 1][0], Sacc[2 * kk + 1][1]); bw.w = pk2(Sacc[2 * kk + 1][2], Sacc[2 * kk + 1][3]);
            const bf16x8 bfrag = __builtin_bit_cast(bf16x8, bw);
#pragma unroll
            for (int mi = 0; mi < 4; ++mi) { const LAS unsigned char* qp = lds + RT_QS + (16 * mi + fr) * RT_QS_STRIDE + (32 * kk + 4 * fq) * 2;
                const v2u lo = *(const LAS v2u*)(qp), hi = *(const LAS v2u*)(qp + 32);
                v4u aw; aw.x = lo.x; aw.y = lo.y; aw.z = hi.x; aw.w = hi.y;
                acc[mi] = mfma16(__builtin_bit_cast(bf16x8, aw), bfrag, acc[mi]); } }
#pragma unroll
        for (int mi = 0; mi < 4; ++mi)
#pragma unroll
            for (int g = 0; g < 4; ++g) acc[mi][g] *= exp2f(lg * (float)(16 * mi + 4 * fq + g + 1));
        bf16x8 vf[2];
#pragma unroll
        for (int k2 = 0; k2 < 2; ++k2) vf[k2] = *(const LAS bf16x8*)(lds + RT_VT + (16 * w + fr) * RT_T_STRIDE + (32 * k2 + 8 * fq) * 2);
#pragma unroll
        for (int mi = 0; mi < 4; ++mi)
#pragma unroll
            for (int k2 = 0; k2 < 2; ++k2) { const bf16x8 a = *(const LAS bf16x8*)(lds + RT_SS + (16 * mi + fr) * RT_T_STRIDE + (32 * k2 + 8 * fq) * 2); acc[mi] = mfma16(a, vf[k2], acc[mi]); }
        if (c > 0) {
#pragma unroll
            for (int mi = 0; mi < 4; ++mi)
#pragma unroll
                for (int g = 0; g < 4; ++g) { const int r = b * SEQ + 64 * (c - 1) + 16 * mi + 4 * fq + g; const float v = acc[mi][g];
                    ob[(size_t)r * RET_VW + h * RET_V + 128 * es + 16 * w + fr] = (bf16)(pk2(v, 0.f) & 0xffffu);
                    float sq = v * v; sq += __shfl_xor(sq, 1); sq += __shfl_xor(sq, 2); sq += __shfl_xor(sq, 4); sq += __shfl_xor(sq, 8);
                    if (fr == 0) atomicAdd(ssqo + (size_t)r * 16 + h, sq); }
        }
#pragma unroll
        for (int dt = 0; dt < 16; ++dt) { Sacc[dt] *= cdec;
#pragma unroll
            for (int k2 = 0; k2 < 2; ++k2) { const bf16x8 a = *(const LAS bf16x8*)(lds + RT_KT + (16 * dt + fr) * RT_T_STRIDE + (32 * k2 + 8 * fq) * 2); Sacc[dt] = mfma16(a, vf[k2], Sacc[dt]); } }
    }
#undef RT_PREFETCH
    __syncthreads();
}
__device__ __forceinline__ void p7_retention(Frame& F, const Args& A) {
    for (int item = blockIdx.x; item < NB * RET_H * 4; item += F.G) ret_item(F, A, item >> 6, (item >> 2) & 15, item & 3);
}
__device__ __forceinline__ void p8_gate(Frame& F, const Args& A) {
    const bf16* z1 = (const bf16*)(F.ws + WS_Z); bf16* ob = (bf16*)(F.ws + WS_Y1); const float* ssqo = (const float*)(F.ws + WS_SSQO); const float* gain = A.in[17];
    const size_t total = (size_t)MTOK * (RET_VW / 8), stride = (size_t)F.G * NTHREADS;
    for (size_t idx = (size_t)blockIdx.x * NTHREADS + F.tid; idx < total; idx += stride) {
        const int r = (int)(idx >> 10), c = (int)(idx & 1023) * 8, hd = c >> 9;
        const v4u gw = *(const GAS v4u*)(z1 + (size_t)r * RET_IN + 16384 + c); const v4u ow = *(const GAS v4u*)(ob + (size_t)r * RET_VW + c);
        const f32x4 g0 = *(const GAS f32x4*)(gain + c), g1 = *(const GAS f32x4*)(gain + c + 4);
        const float rs = 1.0f / sqrtf(ssqo[(size_t)r * 16 + hd] * (1.0f / 512.0f) + RMS_EPS);
        float gf[8], of[8], y[8]; unpack8(gw, gf); unpack8(ow, of);
#pragma unroll
        for (int e = 0; e < 8; ++e) { const float gn = e < 4 ? g0[e] : g1[e - 4]; y[e] = gf[e] * sigmoidf_fast(gf[e]) * (of[e] * rs * gn); }
        *(GAS v4u*)(ob + (size_t)r * RET_VW + c) = pack8f(y);
    }
}

__global__ void __launch_bounds__(NTHREADS, 2) hybrid_fwd(Args args) {
    extern __shared__ __attribute__((aligned(16))) unsigned char lds_raw[];
    Frame F;
    F.lds = (LAS unsigned char*)lds_raw;
    F.MISC = (volatile LAS unsigned*)(F.lds + MISC_OFF);
    F.tid = threadIdx.x; F.lane = F.tid & 63; F.wave = __builtin_amdgcn_readfirstlane(F.tid >> 6);
    F.G = gridDim.x; F.ws = args.ws;
    if (F.tid < 64) F.MISC[F.tid] = 0u;
    __syncthreads();
    unsigned* ctl = (unsigned*)(F.ws + WS_CTL);
#if !MK_PER_PHASE
    const XcdBarrier bar = xcd_barrier_post(ctl + CW_BAR, F.MISC + 8);
#define GRID_BAR() xcd_barrier(bar)
#else
#define GRID_BAR() do { } while (0)
#endif
    const int lo = args.ph_lo, hi = args.ph_hi;
#ifndef PHASE_MASK
#define PHASE_MASK 0xFFF
#endif
#define IN(k) ((((PHASE_MASK) >> (k)) & 1) && lo <= (k) && (k) < hi)
#define BOTH(k) (IN(k) && IN((k) + 1))
    unsigned char* ws = F.ws;
    bf16* XB = (bf16*)(ws + WS_XB); float* Htok = args.out; float* Hmeta = (float*)(ws + WS_HMETA); bf16* Z = (bf16*)(ws + WS_Z); bf16* Y0 = (bf16*)(ws + WS_Y0); bf16* Y1 = (bf16*)(ws + WS_Y1);
    float* SSQ0 = (float*)(ws + WS_SSQ0); float* SSQ1 = (float*)(ws + WS_SSQ1); float* SSQ2 = (float*)(ws + WS_SSQ2); float* SSQ3 = (float*)(ws + WS_SSQ3);
    const int c = (int)blockIdx.x;

    if (IN(0)) { p0_prologue(F, args); if (BOTH(0)) GRID_BAR(); }
    if (IN(1)) {
        pg8::Gemm g{XB, (const bf16*)(ws + WS_WIN0), MP, 41 * 256, DM}; pg8::StaticOrder S; S.init(MP, 41 * 256, F.G, c);
        pg8::EpiIn0 E{Z, (float*)(ws + WS_FBUF), SSQ0};
        pg8::gemm_phase<pg8::EpiIn0, pg8::StaticOrder, true, true>(F.lds, g, S, E);
        if (BOTH(1)) GRID_BAR();
    }
    if (IN(2)) { p2_mixer0(F, args); if (BOTH(2)) GRID_BAR(); }
    if (IN(3)) {
        pg8::Gemm g{Y0, (const bf16*)(ws + WS_WOUT0), MP, DM, DM}; pg8::StaticOrder S; S.init(MP, DM, F.G, c);
        pg8::EpiRes E{Htok, Hmeta, XB, SSQ1};
        pg8::gemm_phase<pg8::EpiRes, pg8::StaticOrder, true, true>(F.lds, g, S, E);
        if (BOTH(3)) GRID_BAR();
    }
    if (IN(4)) {
        pg8::Gemm g{XB, (const bf16*)(ws + WS_WGU0), MP, 2 * DFF, DM}; pg8::StaticOrder S; S.init(MP, 2 * DFF, F.G, c);
        pg8::EpiGU E{Z, SSQ1};
        pg8::gemm_phase<pg8::EpiGU, pg8::StaticOrder, true, true>(F.lds, g, S, E);
        if (BOTH(4)) GRID_BAR();
    }
    if (IN(5)) {
        pg8::Gemm g{Z, (const bf16*)(ws + WS_WD0), MP, DM, DFF}; pg8::StaticOrder S; S.init(MP, DM, F.G, c);
        pg8::EpiRes E{Htok, Hmeta, XB, SSQ2};
        pg8::gemm_phase<pg8::EpiRes, pg8::StaticOrder, true, true>(F.lds, g, S, E);
        if (BOTH(5)) GRID_BAR();
    }
    if (IN(6)) {
        pg8::Gemm g{XB, (const bf16*)(ws + WS_WIN1), MP, RET_IN, DM}; pg8::StaticOrder S; S.init(MP, RET_IN, F.G, c);
        pg8::EpiIn1 E{Z, SSQ2};
        pg8::gemm_phase<pg8::EpiIn1, pg8::StaticOrder, true, true>(F.lds, g, S, E);
        if (BOTH(6)) GRID_BAR();
    }
    if (IN(7)) { p7_retention(F, args); if (BOTH(7)) GRID_BAR(); }
    if (IN(8)) { p8_gate(F, args); if (BOTH(8)) GRID_BAR(); }
    if (IN(9)) {
        pg8::Gemm g{Y1, (const bf16*)(ws + WS_WOUT1), MTOK, DM, RET_VW}; pg8::StaticOrder S; S.init(MTOK, DM, F.G, c);
        pg8::EpiRes E{Htok, Hmeta, XB, SSQ3};
        pg8::gemm_phase<pg8::EpiRes, pg8::StaticOrder, true, true>(F.lds, g, S, E);
        if (BOTH(9)) GRID_BAR();
    }
    if (IN(10)) {
        pg8::Gemm g{XB, (const bf16*)(ws + WS_WGU1), MTOK, 2 * DFF, DM}; pg8::StaticOrder S; S.init(MTOK, 2 * DFF, F.G, c);
        pg8::EpiGU E{Z, SSQ3};
        pg8::gemm_phase<pg8::EpiGU, pg8::StaticOrder, true, true>(F.lds, g, S, E);
        if (BOTH(10)) GRID_BAR();
    }
    if (IN(11)) {
        pg8::Gemm g{Z, (const bf16*)(ws + WS_WD1), MTOK, DM, DFF}; pg8::StaticOrder S; S.init(MTOK, DM, F.G, c);
        pg8::EpiFinal E{args.out};
        pg8::gemm_phase<pg8::EpiFinal, pg8::StaticOrder, true, true>(F.lds, g, S, E);
    }
#undef IN
#undef BOTH
}

extern "C" void kernel_launch(void* const* d_in, const int* in_sizes, int n_in, void* d_out, int out_size, void* d_ws, size_t ws_size, hipStream_t stream) {
    static int grid = 0;
    if (grid == 0) {
        if (n_in != 23 || in_sizes[0] != MTOK * DM || out_size != MTOK * DM || ws_size < WS_END) { fprintf(stderr, "kernel_launch: unexpected shapes (n_in %d, in0 %d, out %d, ws %zu < %zu); nothing launched\n", n_in, n_in > 0 ? in_sizes[0] : -1, out_size, ws_size, (size_t)WS_END); grid = -1; return; }
        int dev = 0, cus = 0, per_cu = 0;
        if (hipGetDevice(&dev) != hipSuccess || hipDeviceGetAttribute(&cus, hipDeviceAttributeMultiprocessorCount, dev) != hipSuccess) { fprintf(stderr, "kernel_launch: device query failed\n"); grid = -1; return; }
        if (hipFuncSetAttribute((const void*)hybrid_fwd, hipFuncAttributeMaxDynamicSharedMemorySize, LDS_BYTES) != hipSuccess) { fprintf(stderr, "kernel_launch: hipFuncSetAttribute failed\n"); grid = -1; return; }
        if (hipOccupancyMaxActiveBlocksPerMultiprocessor(&per_cu, (const void*)hybrid_fwd, NTHREADS, LDS_BYTES) != hipSuccess || per_cu < 1) { fprintf(stderr, "kernel_launch: occupancy query reports %d workgroups per CU\n", per_cu); }
        (void)hipGetLastError();
        grid = cus;
    }
    if (grid < 0) return;
    if (hipMemsetAsync((char*)d_ws + WS_CTL, 0, CTL_ZERO_BYTES, stream) != hipSuccess) { fprintf(stderr, "kernel_launch: memset failed\n"); return; }
    Args a{};
    for (int i = 0; i < 23; ++i) a.in[i] = (const float*)d_in[i];
    a.out = (float*)d_out; a.ws = (unsigned char*)d_ws;
#if MK_PER_PHASE
    for (int p = 0; p < NPHASES; ++p) { a.ph_lo = p; a.ph_hi = p + 1; hipLaunchKernelGGL(hybrid_fwd, dim3(grid), dim3(NTHREADS), LDS_BYTES, stream, a); }
#else
    a.ph_lo = 0; a.ph_hi = NPHASES;
    hipLaunchKernelGGL(hybrid_fwd, dim3(grid), dim3(NTHREADS), LDS_BYTES, stream, a);
#endif
    const hipError_t le = hipPeekAtLastError();
    if (le != hipSuccess) fprintf(stderr, "kernel_launch: launch failed: %s\n", hipGetErrorName(le));
}
```

```cpp
#include <hip/hip_runtime.h>
#include <cstdio>
#include <cstdint>
#ifndef MK_PER_PHASE
#define MK_PER_PHASE 0
#endif
constexpr int DM = 4096, NB = 4, SEQ = 4096, NMETA = 16, LSEQ = NMETA + SEQ;
constexpr int MTOK = NB * SEQ;
constexpr int MMETA = MTOK;
constexpr int MP = 65 * 256;
constexpr int LRU_W = 2048, FOX_H = 16, FOX_D = 128, AB_IN = 10256, AB_Z = 10240;
constexpr int RET_H = 16, RET_QK = 256, RET_V = 512, RET_IN = 24576, RET_VW = 8192;
constexpr int DFF = 11008;
constexpr float RMS_EPS = 1e-6f;
namespace pg8 {
#define PG8_LAS __attribute__((address_space(3)))
typedef unsigned short bf16_t;
typedef short bf16x8 __attribute__((ext_vector_type(8)));
typedef float f32x4 __attribute__((ext_vector_type(4)));
typedef unsigned u32x4 __attribute__((ext_vector_type(4)));
constexpr int BM = 256, BK = 64, HALF = 128, HTB = HALF * BK * 2  , STAGE_BYTES = 8 * HTB, NXCD = 8, WGM = 8;

__host__ __device__ __forceinline__ int lds_byte(int r, int c) { const int st = (r >> 4) * 2 + (c >> 5), rr = r & 15, cc = c & 31, ob = rr * 64 + cc * 2; return st * 1024 + (ob ^ (((ob >> 9) & 1) << 5)); }
__host__ __device__ __forceinline__ void stage_rc(int b, int& R, int& C) { const int st = b / 1024, sb = b % 1024, swz = sb ^ (((sb >> 9) & 1) << 5); R = (st >> 1) * 16 + swz / 64; C = (st & 1) * 32 + (swz % 64) / 2; }
__host__ __device__ __forceinline__ int perm32(int rho) { const int n = rho >> 4, i = rho & 15; return 8 * (i >> 2) + 4 * n + (i & 3); }

struct Unit { int pm, pn; };
struct Gemm { const bf16_t* A; const bf16_t* Bt; int M, N, K; };

struct StaticOrder {
    int nM, nN, nwg, G, c;
    __host__ __device__ void init(int M, int N, int G_, int c_) { nM = M / BM; nN = N / BM; nwg = nM * nN; G = G_; c = c_; }
    __host__ __device__ bool next(int i, Unit& u) const {
        const long L = (long)i * G + c; if (L >= nwg) return false;
        int wgid = (int)L; { const int q = nwg / NXCD, r = nwg % NXCD, xcd = wgid % NXCD, off = wgid / NXCD; wgid = (xcd < r ? xcd * (q + 1) : r * (q + 1) + (xcd - r) * q) + off; }
        const int nig = WGM * nN, gid = wgid / nig, fm = gid * WGM, gsz = (nM - fm) < WGM ? (nM - fm) : WGM;
        u.pm = fm + ((wgid % nig) % gsz); u.pn = (wgid % nig) / gsz; return true;
    }
    __device__ __forceinline__ void a_ready(const Unit&) const {}
    __device__ __forceinline__ void done(const Unit&) const {}
};

__device__ __forceinline__ unsigned cvt_pk_bf16(float lo, float hi) { unsigned r; asm volatile("v_cvt_pk_bf16_f32 %0, %1, %2" : "=v"(r) : "v"(lo), "v"(hi)); return r; }
__device__ __forceinline__ u32x4 pack8(const f32x4 a, const f32x4 b) { u32x4 w; w.x = cvt_pk_bf16(a[0], a[1]); w.y = cvt_pk_bf16(a[2], a[3]); w.z = cvt_pk_bf16(b[0], b[1]); w.w = cvt_pk_bf16(b[2], b[3]); return w; }
__device__ __forceinline__ float row_rstd(const float* ssq, int r) { return 1.0f / sqrtf(ssq[r] * (1.0f / 4096.0f) + RMS_EPS); }

struct EpiIn0 {
    static constexpr bool PERM = true, AFTER_DRAIN = false;
    bf16_t* Z; float* F; const float* ssq;
    __device__ __forceinline__ void operator()(const f32x4 (&acc)[2][2][4][2], const Unit& u, int wr, int wc, int fr, int fq) const {
        const int row0 = u.pm * BM + wr * 64 + fr;
        if (u.pn < 40) {
            const int col0 = u.pn * BM + wc * 32 + 8 * fq;
#pragma unroll
            for (int ai = 0; ai < 2; ++ai)
#pragma unroll
                for (int m = 0; m < 4; ++m) { const int r = row0 + ai * HALF + m * 16; const float rs = row_rstd(ssq, r); bf16_t* rowp = Z + (size_t)r * AB_Z + col0;
#pragma unroll
                    for (int bj = 0; bj < 2; ++bj) *(u32x4*)(rowp + bj * HALF) = pack8(acc[ai][bj][m][0] * rs, acc[ai][bj][m][1] * rs); }
        } else if (wc == 0 && fq < 2) {
#pragma unroll
            for (int ai = 0; ai < 2; ++ai)
#pragma unroll
                for (int m = 0; m < 4; ++m) { const int r = row0 + ai * HALF + m * 16; const float rs = row_rstd(ssq, r); float* fp = F + (size_t)r * 16 + 8 * fq;
                    *(f32x4*)(fp) = acc[ai][0][m][0] * rs; *(f32x4*)(fp + 4) = acc[ai][0][m][1] * rs; }
        }
    }
};
struct EpiRes {
    static constexpr bool PERM = true, AFTER_DRAIN = false;
    float* Htok; float* Hmeta; bf16_t* XB; float* ssq_out;
    __device__ __forceinline__ void operator()(const f32x4 (&acc)[2][2][4][2], const Unit& u, int wr, int wc, int fr, int fq) const {
        const int row0 = u.pm * BM + wr * 64 + fr, col0 = u.pn * BM + wc * 32 + 8 * fq;
        float* H = u.pm < MTOK / BM ? Htok : Hmeta - (size_t)MTOK * DM;
#pragma unroll
        for (int ai = 0; ai < 2; ++ai)
#pragma unroll
            for (int m = 0; m < 4; ++m) { const int r = row0 + ai * HALF + m * 16; float* hp = H + (size_t)r * DM + col0; bf16_t* xp = XB + (size_t)r * DM + col0; float s = 0.f;
#pragma unroll
                for (int bj = 0; bj < 2; ++bj) { const f32x4 v0 = *(const f32x4*)(hp + bj * HALF) + acc[ai][bj][m][0], v1 = *(const f32x4*)(hp + bj * HALF + 4) + acc[ai][bj][m][1];
                    *(f32x4*)(hp + bj * HALF) = v0; *(f32x4*)(hp + bj * HALF + 4) = v1; *(u32x4*)(xp + bj * HALF) = pack8(v0, v1);
                    s += (v0[0] * v0[0] + v0[1] * v0[1]) + (v0[2] * v0[2] + v0[3] * v0[3]) + (v1[0] * v1[0] + v1[1] * v1[1]) + (v1[2] * v1[2] + v1[3] * v1[3]); }
                s += __shfl_xor(s, 16); s += __shfl_xor(s, 32);
                if (fq == 0) atomicAdd(ssq_out + r, s);
                asm volatile("" ::: "memory"); }
    }
};
struct EpiFinal {
    static constexpr bool PERM = true, AFTER_DRAIN = false;
    float* OUT;
    __device__ __forceinline__ void operator()(const f32x4 (&acc)[2][2][4][2], const Unit& u, int wr, int wc, int fr, int fq) const {
        const int row0 = u.pm * BM + wr * 64 + fr, col0 = u.pn * BM + wc * 32 + 8 * fq;
#pragma unroll
        for (int ai = 0; ai < 2; ++ai)
#pragma unroll
            for (int m = 0; m < 4; ++m) { const int r = row0 + ai * HALF + m * 16; float* op = OUT + (size_t)r * DM + col0; const float* hp = op;
#pragma unroll
                for (int bj = 0; bj < 2; ++bj) { const f32x4 v0 = *(const f32x4*)(hp + bj * HALF) + acc[ai][bj][m][0], v1 = *(const f32x4*)(hp + bj * HALF + 4) + acc[ai][bj][m][1];
                    *(f32x4*)(op + bj * HALF) = v0; *(f32x4*)(op + bj * HALF + 4) = v1; }
                asm volatile("" ::: "memory"); }
    }
};
struct EpiGU {
    static constexpr bool PERM = true, AFTER_DRAIN = false;
    bf16_t* HID; const float* ssq;
    __device__ __forceinline__ void operator()(const f32x4 (&acc)[2][2][4][2], const Unit& u, int wr, int wc, int fr, int fq) const {
        const int row0 = u.pm * BM + wr * 64 + fr, col0 = u.pn * HALF + wc * 32 + 8 * fq;
#pragma unroll
        for (int ai = 0; ai < 2; ++ai)
#pragma unroll
            for (int m = 0; m < 4; ++m) { const int r = row0 + ai * HALF + m * 16; const float rs = row_rstd(ssq, r); f32x4 o[2];
#pragma unroll
                for (int n = 0; n < 2; ++n)
#pragma unroll
                    for (int j = 0; j < 4; ++j) { const float g = acc[ai][0][m][n][j] * rs, uu = acc[ai][1][m][n][j] * rs;
                        o[n][j] = g * uu * __builtin_amdgcn_rcpf(1.0f + __expf(-g)); }
                *(u32x4*)(HID + (size_t)r * DFF + col0) = pack8(o[0], o[1]); }
    }
};
struct EpiIn1 {
    static constexpr bool PERM = true, AFTER_DRAIN = false;
    bf16_t* Z; const float* ssq;
    __device__ __forceinline__ void operator()(const f32x4 (&acc)[2][2][4][2], const Unit& u, int wr, int wc, int fr, int fq) const {
        const int row0 = u.pm * BM + wr * 64 + fr, col0 = u.pn * BM + wc * 32 + 8 * fq;
        if (u.pn < 32) {
            const float sc = u.pn < 16 ? 1.0f : 0.0625f;
            float inv[2][4];
#pragma unroll
            for (int n = 0; n < 2; ++n)
#pragma unroll
                for (int j = 0; j < 4; ++j) inv[n][j] = exp2f(-(float)(wc * 32 + 8 * fq + 4 * n + j) * (13.287712379549449f / 128.0f));
#pragma unroll
            for (int ai = 0; ai < 2; ++ai)
#pragma unroll
                for (int m = 0; m < 4; ++m) { const int r = row0 + ai * HALF + m * 16; const float rs = row_rstd(ssq, r) * sc;
                    const float t = (float)(r < MTOK ? NMETA + (r & (SEQ - 1)) : ((r - MTOK) & 15));
                    f32x4 o1[2], o2[2];
#pragma unroll
                    for (int n = 0; n < 2; ++n)
#pragma unroll
                        for (int j = 0; j < 4; ++j) { const float x1 = acc[ai][0][m][n][j] * rs, x2 = acc[ai][1][m][n][j] * rs;
                            const float ang = t * inv[n][j]; float rev = ang * 0.15915494309189535f; rev = rev - floorf(rev);
                            const float c = __builtin_amdgcn_cosf(rev), s = __builtin_amdgcn_sinf(rev);
                            o1[n][j] = x1 * c - x2 * s; o2[n][j] = x1 * s + x2 * c; }
                    bf16_t* rowp = Z + (size_t)r * RET_IN + col0;
                    *(u32x4*)(rowp) = pack8(o1[0], o1[1]); *(u32x4*)(rowp + HALF) = pack8(o2[0], o2[1]); }
        } else {
#pragma unroll
            for (int ai = 0; ai < 2; ++ai)
#pragma unroll
                for (int m = 0; m < 4; ++m) { const int r = row0 + ai * HALF + m * 16; const float rs = row_rstd(ssq, r); bf16_t* rowp = Z + (size_t)r * RET_IN + col0;
#pragma unroll
                    for (int bj = 0; bj < 2; ++bj) *(u32x4*)(rowp + bj * HALF) = pack8(acc[ai][bj][m][0] * rs, acc[ai][bj][m][1] * rs); }
        }
    }
};

template <class Epi, class Sched, bool ALIGN_EPI = false, bool SP2 = false>
__device__ __forceinline__ void gemm_phase(PG8_LAS unsigned char* lds, const Gemm g, const Sched& S, const Epi& E) {
    const int tid = threadIdx.x, wid = __builtin_amdgcn_readfirstlane(tid >> 6), lane = tid & 63, wr = wid >> 2, wc = wid & 3, fr = lane & 15, fq = lane >> 4;
    const int K = g.K, nt = K / BK;
    unsigned voffA[2], voffB[2];
#pragma unroll
    for (int i = 0; i < 2; ++i) { int R, C; stage_rc(tid * 16 + i * 8192, R, C); const int Rb = Epi::PERM ? ((R & ~31) + perm32(R & 31)) : R;
        voffA[i] = (unsigned)(R * K + C) * 2u; voffB[i] = (unsigned)(Rb * K + C) * 2u; }
    const size_t kstep = (size_t)(BK * 2);
    const size_t hstep = (size_t)HALF * K * 2;
    const size_t tstep = 2 * hstep;
    const unsigned ldsw = (unsigned)wid * 1024u;
    const int aoff = lds_byte(wr * 64 + fr, fq * 8), boff = lds_byte(wc * 32 + fr, fq * 8);
#define PG8_SA(b, h) (((b) * 2 + (h)) * HTB)
#define PG8_SB(b, h) ((4 + (b) * 2 + (h)) * HTB)
#define PG8_STAGE(bufoff, gbase, voff) do { _Pragma("unroll") for (int _i = 0; _i < 2; ++_i) \
        __builtin_amdgcn_global_load_lds((const unsigned*)((const char*)(gbase) + (voff)[_i]), (PG8_LAS unsigned*)(lds + (bufoff) + ldsw + _i * 8192), 16, 0, 0); } while (0)
#define PG8_LDA(dst, b, h) do { _Pragma("unroll") for (int m = 0; m < 4; ++m) _Pragma("unroll") for (int k = 0; k < 2; ++k) dst[m][k] = *(const PG8_LAS bf16x8*)(lds + PG8_SA(b, h) + aoff + m * 2048 + k * 1024); } while (0)
#define PG8_LDB(dst, b, h) do { _Pragma("unroll") for (int n = 0; n < 2; ++n) _Pragma("unroll") for (int k = 0; k < 2; ++k) dst[n][k] = *(const PG8_LAS bf16x8*)(lds + PG8_SB(b, h) + boff + n * 2048 + k * 1024); } while (0)
#define PG8_MMA(ai, bj, At, Bt) do { __builtin_amdgcn_s_setprio(1); _Pragma("unroll") for (int m = 0; m < 4; ++m) _Pragma("unroll") for (int n = 0; n < 2; ++n) _Pragma("unroll") for (int k = 0; k < 2; ++k) \
        acc[ai][bj][m][n] = __builtin_amdgcn_mfma_f32_16x16x32_bf16(Bt[n][k], At[m][k], acc[ai][bj][m][n], 0, 0, 0); __builtin_amdgcn_s_setprio(0); } while (0)
#define PG8_WAIT_V(n) asm volatile("s_waitcnt vmcnt(" #n ")" ::: "memory")
#define PG8_WAIT_L(n) asm volatile("s_waitcnt lgkmcnt(" #n ")" ::: "memory")
#define PG8_BAR __builtin_amdgcn_s_barrier()
#define PG8_SCHED __builtin_amdgcn_sched_barrier(0)
    Unit cur, nxt; int ui = 0;
    if (!S.next(0, cur)) return;
    f32x4 acc[2][2][4][2];
#pragma unroll
    for (int a = 0; a < 2; ++a)
#pragma unroll
        for (int b = 0; b < 2; ++b)
#pragma unroll
            for (int m = 0; m < 4; ++m)
#pragma unroll
                for (int n = 0; n < 2; ++n) acc[a][b][m][n] = (f32x4){0.f, 0.f, 0.f, 0.f};
    bf16x8 At[4][2], B0[2][2], B1[2][2];
    const char* cA = (const char*)g.A + (size_t)cur.pm * tstep; const char* cB = (const char*)g.Bt + (size_t)cur.pn * tstep;
    S.a_ready(cur);
    if constexpr (SP2) {
        PG8_STAGE(PG8_SB(0, 0), cB, voffB); PG8_STAGE(PG8_SB(0, 1), cB + hstep, voffB); PG8_STAGE(PG8_SA(0, 0), cA, voffA); PG8_STAGE(PG8_SA(0, 1), cA + hstep, voffA);
        if (wr == 1) PG8_BAR;
        PG8_WAIT_V(2); PG8_BAR;
        PG8_STAGE(PG8_SB(1, 0), cB + kstep, voffB); PG8_STAGE(PG8_SA(1, 0), cA + kstep, voffA); PG8_STAGE(PG8_SB(1, 1), cB + hstep + kstep, voffB);
        PG8_WAIT_V(6); PG8_BAR;
    } else {
        PG8_STAGE(PG8_SB(0, 0), cB, voffB); PG8_STAGE(PG8_SA(0, 0), cA, voffA); PG8_STAGE(PG8_SB(0, 1), cB + hstep, voffB); PG8_STAGE(PG8_SA(0, 1), cA + hstep, voffA);
        if (wr == 1) PG8_BAR;
        PG8_WAIT_V(4); PG8_BAR;
        PG8_STAGE(PG8_SB(1, 0), cB + kstep, voffB); PG8_STAGE(PG8_SA(1, 0), cA + kstep, voffA); PG8_STAGE(PG8_SB(1, 1), cB + hstep + kstep, voffB);
        PG8_WAIT_V(6); PG8_BAR;
    }
    for (;;) {
        const bool has_next = S.next(ui + 1, nxt);
        const char* nA = has_next ? (const char*)g.A + (size_t)nxt.pm * tstep : cA; const char* nB = has_next ? (const char*)g.Bt + (size_t)nxt.pn * tstep : cB;
        for (int t = 0; t < nt; t += 2) {
            const bool last = (t == nt - 2);
            const char* a1 = cA + (size_t)(t + 1) * kstep;
            const char* a2 = last ? nA : cA + (size_t)(t + 2) * kstep; const char* b2 = last ? nB : cB + (size_t)(t + 2) * kstep;
            const char* a3 = a2 + kstep; const char* b3 = b2 + kstep;
            if (last && has_next) S.a_ready(nxt);
            if constexpr (SP2) {
            PG8_LDB(B0, 0, 0); PG8_LDB(B1, 0, 1); PG8_SCHED; PG8_LDA(At, 0, 0); PG8_STAGE(PG8_SA(1, 1), a1 + hstep, voffA);
            PG8_WAIT_V(8); PG8_WAIT_L(0); PG8_BAR; PG8_MMA(0, 0, At, B0); PG8_MMA(0, 1, At, B1); PG8_BAR; PG8_SCHED;
            PG8_LDA(At, 0, 1); PG8_STAGE(PG8_SB(0, 0), b2, voffB); PG8_STAGE(PG8_SB(0, 1), b2 + hstep, voffB); PG8_STAGE(PG8_SA(0, 0), a2, voffA);
            PG8_WAIT_V(8); PG8_WAIT_L(0); PG8_BAR; PG8_MMA(1, 0, At, B0); PG8_MMA(1, 1, At, B1); PG8_BAR; PG8_SCHED;
            PG8_LDB(B0, 1, 0); PG8_LDB(B1, 1, 1); PG8_SCHED; PG8_LDA(At, 1, 0); PG8_STAGE(PG8_SA(0, 1), a2 + hstep, voffA);
            PG8_WAIT_V(8); PG8_WAIT_L(0); PG8_BAR; PG8_MMA(0, 0, At, B0); PG8_MMA(0, 1, At, B1); PG8_BAR; PG8_SCHED;
            PG8_LDA(At, 1, 1); PG8_STAGE(PG8_SB(1, 0), b3, voffB); PG8_STAGE(PG8_SB(1, 1), b3 + hstep, voffB); PG8_STAGE(PG8_SA(1, 0), a3, voffA);
            PG8_WAIT_V(8); PG8_WAIT_L(0); PG8_BAR; PG8_MMA(1, 0, At, B0); PG8_MMA(1, 1, At, B1); PG8_BAR; PG8_SCHED;
            } else {
            PG8_LDB(B0, 0, 0); PG8_SCHED; PG8_LDA(At, 0, 0); PG8_STAGE(PG8_SA(1, 1), a1 + hstep, voffA);
            PG8_WAIT_L(8); PG8_BAR; PG8_WAIT_L(0); PG8_MMA(0, 0, At, B0); PG8_BAR; PG8_SCHED;
            PG8_LDB(B1, 0, 1); PG8_STAGE(PG8_SB(0, 0), b2, voffB);
            PG8_BAR; PG8_WAIT_L(0); PG8_MMA(0, 1, At, B1); PG8_BAR;
            PG8_LDA(At, 0, 1); PG8_STAGE(PG8_SA(0, 0), a2, voffA);
            PG8_BAR; PG8_WAIT_L(0); PG8_MMA(1, 0, At, B0); PG8_BAR; PG8_SCHED;
            PG8_STAGE(PG8_SB(0, 1), b2 + hstep, voffB);
            PG8_WAIT_V(6); PG8_BAR; PG8_MMA(1, 1, At, B1); PG8_BAR;
            PG8_LDB(B0, 1, 0); PG8_SCHED; PG8_LDA(At, 1, 0); PG8_STAGE(PG8_SA(0, 1), a2 + hstep, voffA);
            PG8_WAIT_L(8); PG8_BAR; PG8_WAIT_L(0); PG8_MMA(0, 0, At, B0); PG8_BAR; PG8_SCHED;
            PG8_LDB(B1, 1, 1); PG8_STAGE(PG8_SB(1, 0), b3, voffB);
            PG8_BAR; PG8_WAIT_L(0); PG8_MMA(0, 1, At, B1); PG8_BAR;
            PG8_LDA(At, 1, 1); PG8_STAGE(PG8_SA(1, 0), a3, voffA);
            PG8_BAR; PG8_WAIT_L(0); PG8_MMA(1, 0, At, B0); PG8_BAR; PG8_SCHED;
            PG8_STAGE(PG8_SB(1, 1), b3 + hstep, voffB);
            PG8_WAIT_V(6); PG8_BAR; PG8_MMA(1, 1, At, B1); PG8_BAR;
            }
        }
        if constexpr (ALIGN_EPI) { if (wr == 0) PG8_BAR; }
        if constexpr (!Epi::AFTER_DRAIN) { E(acc, cur, wr, wc, fr, fq); S.done(cur); }
        if (!has_next) break;
#pragma unroll
        for (int a = 0; a < 2; ++a)
#pragma unroll
            for (int b = 0; b < 2; ++b)
#pragma unroll
                for (int m = 0; m < 4; ++m)
#pragma unroll
                    for (int n = 0; n < 2; ++n) acc[a][b][m][n] = (f32x4){0.f, 0.f, 0.f, 0.f};
        cur = nxt; cA = nA; cB = nB; ++ui;
        if constexpr (ALIGN_EPI) { if (wr == 1) PG8_BAR; }
    }
    PG8_WAIT_V(0);
    if constexpr (!ALIGN_EPI) { if (wr == 0) PG8_BAR; }
    PG8_BAR;
    if constexpr (Epi::AFTER_DRAIN) { E.fused(acc, cur, wr, wc, fr, fq, lds, wid, lane); S.done(cur); }
#undef PG8_SA
#undef PG8_SB
#undef PG8_STAGE
#undef PG8_LDA
#undef PG8_LDB
#undef PG8_MMA
#undef PG8_WAIT_V
#undef PG8_WAIT_L
#undef PG8_BAR
#undef PG8_SCHED
}
}

constexpr size_t MiB = 1u << 20;
constexpr size_t WS_CTL = 0, CTL_ZERO_BYTES = 2 * MiB;
constexpr size_t WS_SSQ1 = 64 * 1024, WS_SSQ2 = 192 * 1024, WS_SSQ3 = 320 * 1024, WS_SSQO = 512 * 1024;
constexpr size_t WS_SSQ0 = 2 * MiB;
constexpr size_t WS_FBUF = 2 * MiB + 512 * 1024;
constexpr size_t WS_HMETA = 4 * MiB;
constexpr size_t WS_WIN0 = 8 * MiB, WS_WOUT0 = 90 * MiB, WS_WGU0 = 122 * MiB, WS_WD0 = 294 * MiB, WS_WIN1 = 380 * MiB, WS_WOUT1 = 572 * MiB, WS_WGU1 = 636 * MiB, WS_WD1 = 808 * MiB;
constexpr size_t WS_WAT = 894 * MiB, WS_WXT = WS_WAT + 512 * 1024;
constexpr size_t WS_XB = 896 * MiB, WS_Z = 1026 * MiB, WS_END = 1806 * MiB;
constexpr size_t WS_Y0 = WS_Z + 400 * MiB;
constexpr size_t WS_Y1 = 8 * MiB;
static_assert(WS_SSQO + (size_t)MP * 16 * 4 <= CTL_ZERO_BYTES && WS_FBUF + (size_t)MP * 16 * 4 <= WS_HMETA && WS_HMETA + (size_t)256 * DM * 4 <= WS_WIN0, "ctl map");
static_assert(WS_WIN0 + (size_t)41 * 256 * DM * 2 <= WS_WOUT0 && WS_WGU0 + (size_t)2 * DFF * DM * 2 <= WS_WD0 && WS_WD0 + (size_t)DM * DFF * 2 <= WS_WIN1 && WS_WIN1 + (size_t)RET_IN * DM * 2 <= WS_WOUT1, "weight map");
static_assert(WS_WOUT1 + (size_t)DM * RET_VW * 2 <= WS_WGU1 && WS_WGU1 + (size_t)2 * DFF * DM * 2 <= WS_WD1 && WS_WD1 + (size_t)DM * DFF * 2 <= WS_WAT, "weight map 2");
static_assert(WS_XB + (size_t)MP * DM * 2 <= WS_Z && WS_Z + (size_t)MP * RET_IN * 2 <= WS_END && WS_Z + (size_t)MP * AB_Z * 2 <= WS_Y0 && WS_Z + (size_t)MP * DFF * 2 <= WS_Y0 && WS_Y0 + (size_t)MP * DM * 2 <= WS_END && WS_Y1 + (size_t)MP * RET_VW * 2 <= WS_WD0, "activation map");
constexpr int CW_TMO = 0, CW_Q2 = 64, CW_BAR = 4096;
constexpr int RING_BYTES = 131072;
constexpr int LDS_BYTES = 147456;
constexpr int MISC_OFF = LDS_BYTES - 256;
constexpr int NWAVES = 8, NTHREADS = 512;
constexpr int NPHASES = 12;

#define GAS __attribute__((address_space(1)))
#define LAS __attribute__((address_space(3)))
typedef unsigned short bf16;
typedef unsigned v4u __attribute__((ext_vector_type(4)));
typedef unsigned v2u __attribute__((ext_vector_type(2)));
typedef float f32x4 __attribute__((ext_vector_type(4)));
typedef short bf16x8 __attribute__((ext_vector_type(8)));
typedef short bf16x4 __attribute__((ext_vector_type(4)));
typedef GAS unsigned gu32;
#define RLX_AGENT __ATOMIC_RELAXED, __HIP_MEMORY_SCOPE_AGENT
#define LDS_WAIT() asm volatile("s_waitcnt lgkmcnt(0)" ::: "memory")
#define VM_WAIT() asm volatile("s_waitcnt vmcnt(0)" ::: "memory")
__device__ __forceinline__ unsigned f2bf(float f) { unsigned u = __builtin_bit_cast(unsigned, f); return (u + 0x7fffu + ((u >> 16) & 1u)) >> 16; }
__device__ __forceinline__ unsigned pk2(float lo, float hi) { return pg8::cvt_pk_bf16(lo, hi); }
__device__ __forceinline__ float bflo(unsigned w) { return __builtin_bit_cast(float, w << 16); }
__device__ __forceinline__ float bfhi(unsigned w) { return __builtin_bit_cast(float, w & 0xffff0000u); }
__device__ __forceinline__ float bf2f(unsigned short h) { return __builtin_bit_cast(float, (unsigned)h << 16); }
__device__ __forceinline__ void unpack8(const v4u w, float (&f)[8]) { f[0] = bflo(w.x); f[1] = bfhi(w.x); f[2] = bflo(w.y); f[3] = bfhi(w.y); f[4] = bflo(w.z); f[5] = bfhi(w.z); f[6] = bflo(w.w); f[7] = bfhi(w.w); }
__device__ __forceinline__ v4u pack8f(const float (&f)[8]) { v4u w; w.x = pk2(f[0], f[1]); w.y = pk2(f[2], f[3]); w.z = pk2(f[4], f[5]); w.w = pk2(f[6], f[7]); return w; }
__device__ __forceinline__ int row_of(int b, int t) { return t < NMETA ? MMETA + NMETA * b + t : b * SEQ + (t - NMETA); }
__device__ __forceinline__ f32x4 mfma16(bf16x8 a, bf16x8 b, f32x4 c) { return __builtin_amdgcn_mfma_f32_16x16x32_bf16(a, b, c, 0, 0, 0); }

#define XB_TMO      128
#define XB_XCNT(j)  (256  + 64 * (j))
#define XB_XSUB(j)  (1280 + 64 * (j))
#define XB_XGEN(j)  (2304 + 64 * (j))
#define XB_TOP      3328
#define XB_TOPGEN   3392
#define XCD_BAR_WORDS 3456
#define XB_SPIN_CAP (1u << 22)

__device__ __forceinline__ unsigned xb_ld(unsigned* p)              { return __hip_atomic_load(p, __ATOMIC_RELAXED, __HIP_MEMORY_SCOPE_AGENT); }
__device__ __forceinline__ unsigned xb_add(unsigned* p, unsigned v) { return __hip_atomic_fetch_add(p, v, __ATOMIC_RELAXED, __HIP_MEMORY_SCOPE_AGENT); }
__device__ __forceinline__ unsigned xb_xcc_id() { return (unsigned)__builtin_amdgcn_s_getreg((3 << 11) | 20) & 0xFu; }
#define XB_SPIN(cond, bar) do { unsigned _sp = 0; while (cond) { __builtin_amdgcn_s_sleep(1); \
    if ((++_sp & 255u) == 0u) { if (xb_ld(&(bar)[XB_TMO])) break; if (_sp > XB_SPIN_CAP) { atomicAdd(&(bar)[XB_TMO], 1u); break; } } } } while (0)

struct XcdBarrier {
    unsigned* bar; unsigned x;
    volatile LAS unsigned* st;
};
__device__ __forceinline__ XcdBarrier xcd_barrier_post(unsigned* bar, volatile LAS unsigned* st) {
    XcdBarrier b; b.bar = bar; b.x = xb_xcc_id(); b.st = st;
    if (threadIdx.x == 0) (void)xb_add(&bar[XB_XCNT(b.x)], 1u);
    return b;
}
__device__ __forceinline__ void xcd_barrier_complete(unsigned* bar, unsigned x, unsigned& nloc, unsigned& nx) {
    const unsigned G = gridDim.x * gridDim.y * gridDim.z;
    unsigned sum, cnt, mine, sp = 0u;
    for (;;) {
        sum = 0u; cnt = 0u; mine = 0u;
#pragma unroll
        for (unsigned j = 0; j < 16; ++j) { const unsigned c = xb_ld(&bar[XB_XCNT(j)]); sum += c; cnt += (c > 0u) ? 1u : 0u; mine = (j == x) ? c : mine; }
        if (sum == G) break;
        __builtin_amdgcn_s_sleep(1);
        if ((++sp & 255u) == 0u) { if (xb_ld(&bar[XB_TMO])) break; if (sp > XB_SPIN_CAP) { atomicAdd(&bar[XB_TMO], 1u); break; } }
    }
    nloc = mine > 0u ? mine : 1u; nx = cnt > 0u ? cnt : 1u;
}
__device__ __forceinline__ void xcd_barrier(const XcdBarrier& b) {
    asm volatile("s_waitcnt vmcnt(0)" ::: "memory");
    __syncthreads();
    if (threadIdx.x == 0) {
        unsigned* bar = b.bar;
        __builtin_amdgcn_s_waitcnt(0);
        unsigned nloc = b.st[0], nx = b.st[1];
        if (nloc == 0u) { xcd_barrier_complete(bar, b.x, nloc, nx); b.st[0] = nloc; b.st[1] = nx; }
        const unsigned old = xb_add(&bar[XB_XSUB(b.x)], 1u);
        const unsigned gen = old / nloc;
        if (old + 1u == (gen + 1u) * nloc) {
            __builtin_amdgcn_fence(__ATOMIC_RELEASE, "agent");
            asm volatile("s_waitcnt vmcnt(0)" ::: "memory");
            const unsigned og = xb_add(&bar[XB_TOP], 1u);
            const unsigned tg = og / nx;
            if (og + 1u == (tg + 1u) * nx) xb_add(&bar[XB_TOPGEN], 1u);
            else XB_SPIN(xb_ld(&bar[XB_TOPGEN]) == tg, bar);
            __builtin_amdgcn_fence(__ATOMIC_ACQUIRE, "agent");
            xb_add(&bar[XB_XGEN(b.x)], 1u);
            asm volatile("s_waitcnt vmcnt(0)" ::: "memory");
        } else {
            XB_SPIN(xb_ld(&bar[XB_XGEN(b.x)]) == gen, bar);
            __builtin_amdgcn_fence(__ATOMIC_ACQUIRE, "agent");
            asm volatile("s_waitcnt vmcnt(0)" ::: "memory");
        }
    }
    __syncthreads();
}

struct Args { const float* in[23]; float* out; unsigned char* ws; int ph_lo, ph_hi; };
__device__ __forceinline__ float* h_row(float* out, unsigned char* ws, int r) { return r < MTOK ? out + (size_t)r * DM : (float*)(ws + WS_HMETA) + (size_t)(r - MTOK) * DM; }
struct Frame {
    LAS unsigned char* lds;
    volatile LAS unsigned* MISC;
    unsigned char* ws;
    int tid, lane, wave, G;
};
__device__ __forceinline__ float wave_sum(float v) {
#pragma unroll
    for (int o = 1; o < 64; o <<= 1) v += __shfl_xor(v, o);
    return v;
}

template <int MODE>
__device__ __forceinline__ void p0_transpose_item(const float* W, int K, int N, const float* gain, bf16* WT, LAS float* scr, int item, int lane) {
    const int nblk = (N + 31) / 32, kb = item / nblk, nb = item - kb * nblk, k0 = 64 * kb, n0 = 32 * nb;
    const int nn = n0 + (lane & 31); const bool ok = nn < N;
#pragma unroll 8
    for (int i = 0; i < 32; ++i) { const int kk = 2 * i + (lane >> 5); float v = ok ? W[(size_t)(k0 + kk) * N + nn] : 0.f; if (gain) v *= gain[k0 + kk]; scr[kk * 33 + (lane & 31)] = v; }
    LDS_WAIT(); asm volatile("" ::: "memory");
    const int c = lane & 7;
#pragma unroll
    for (int j = 0; j < 4; ++j) { const int n = (lane >> 3) + 8 * j; const LAS float* s = scr + (8 * c) * 33 + n;
        v4u o; o.x = pk2(s[0 * 33], s[1 * 33]); o.y = pk2(s[2 * 33], s[3 * 33]); o.z = pk2(s[4 * 33], s[5 * 33]); o.w = pk2(s[6 * 33], s[7 * 33]);
        const int ng = n0 + n; const int drow = MODE == 0 ? ng : (MODE == 1 ? 256 * (ng >> 7) + (ng & 127) : 256 * (ng >> 7) + 128 + (ng & 127));
        *(GAS v4u*)(WT + (size_t)drow * K + k0 + 8 * c) = o; }
    LDS_WAIT(); asm volatile("" ::: "memory");
}
__device__ __forceinline__ void p0_row(Frame& F, const float* x, const float* meta, float* out, int r) {
    float* hrow = h_row(out, F.ws, r); bf16* xrow = (bf16*)(F.ws + WS_XB) + (size_t)r * DM;
    const float* src = r < MTOK ? x + (size_t)r * DM : meta + (size_t)((r - MTOK) & 15) * DM;
    const bool pad = r >= MTOK + NB * NMETA;
    float s = 0.f;
#pragma unroll 4
    for (int j = 0; j < 16; ++j) { const int e = (F.lane + 64 * j) * 4;
        f32x4 v = pad ? (f32x4){0.f, 0.f, 0.f, 0.f} : *(const GAS f32x4*)(src + e);
        s += (v.x * v.x + v.y * v.y) + (v.z * v.z + v.w * v.w);
        *(GAS f32x4*)(hrow + e) = v; v2u w; w.x = pk2(v.x, v.y); w.y = pk2(v.z, v.w); *(GAS v2u*)(xrow + e) = w; }
    s = wave_sum(s);
    if (F.lane == 0) ((float*)(F.ws + WS_SSQ0))[r] = s;
}
__device__ __forceinline__ void p0_prologue(Frame& F, const Args& A) {
    LAS float* scr = (LAS float*)(F.lds + F.wave * 16384);
    const int gw = blockIdx.x * NWAVES + F.wave, NGW = F.G * NWAVES;
    unsigned char* ws = F.ws;
    constexpr int I_IN0 = 64 * 321, I_SQ = 64 * 128, I_G = 64 * 344, I_D = 172 * 128, I_IN1 = 64 * 768, I_O1 = 128 * 128, I_BD = 16 * 8;
    constexpr int NITEMS = I_IN0 + I_SQ + 2 * (2 * I_G + I_D) + I_IN1 + I_O1 + 2 * I_BD;
    for (int it = gw; it < NITEMS; it += NGW) {
        int r = it;
        if (r < I_IN0) { p0_transpose_item<0>(A.in[3], DM, AB_IN, A.in[2], (bf16*)(ws + WS_WIN0), scr, r, F.lane); continue; } r -= I_IN0;
        if (r < I_SQ) { p0_transpose_item<0>(A.in[14], DM, DM, nullptr, (bf16*)(ws + WS_WOUT0), scr, r, F.lane); continue; } r -= I_SQ;
        if (r < I_G) { p0_transpose_item<1>(A.in[20], DM, DFF, A.in[19], (bf16*)(ws + WS_WGU0), scr, r, F.lane); continue; } r -= I_G;
        if (r < I_G) { p0_transpose_item<2>(A.in[21], DM, DFF, A.in[19], (bf16*)(ws + WS_WGU0), scr, r, F.lane); continue; } r -= I_G;
        if (r < I_D) { p0_transpose_item<0>(A.in[22], DFF, DM, nullptr, (bf16*)(ws + WS_WD0), scr, r, F.lane); continue; } r -= I_D;
        if (r < I_IN1) { p0_transpose_item<0>(A.in[16], DM, RET_IN, A.in[15], (bf16*)(ws + WS_WIN1), scr, r, F.lane); continue; } r -= I_IN1;
        if (r < I_O1) { p0_transpose_item<0>(A.in[18], RET_VW, DM, nullptr, (bf16*)(ws + WS_WOUT1), scr, r, F.lane); continue; } r -= I_O1;
        if (r < I_G) { p0_transpose_item<1>(A.in[20] + (size_t)DM * DFF, DM, DFF, A.in[19] + DM, (bf16*)(ws + WS_WGU1), scr, r, F.lane); continue; } r -= I_G;
        if (r < I_G) { p0_transpose_item<2>(A.in[21] + (size_t)DM * DFF, DM, DFF, A.in[19] + DM, (bf16*)(ws + WS_WGU1), scr, r, F.lane); continue; } r -= I_G;
        if (r < I_D) { p0_transpose_item<0>(A.in[22] + (size_t)DFF * DM, DFF, DM, nullptr, (bf16*)(ws + WS_WD1), scr, r, F.lane); continue; } r -= I_D;
        if (r < I_BD) { const int blk = r >> 3; p0_transpose_item<0>(A.in[7] + (size_t)blk * 16384, 128, 128, nullptr, (bf16*)(ws + WS_WAT) + (size_t)blk * 16384, scr, r & 7, F.lane); continue; } r -= I_BD;
        { const int blk = r >> 3; p0_transpose_item<0>(A.in[9] + (size_t)blk * 16384, 128, 128, nullptr, (bf16*)(ws + WS_WXT) + (size_t)blk * 16384, scr, r & 7, F.lane); }
    }
    for (int m = gw; m < MP; m += NGW) p0_row(F, A.in[0], A.in[1], A.out, m);
}

__device__ __forceinline__ float sigmoidf_fast(float x) { return __builtin_amdgcn_rcpf(1.0f + __expf(-x)); }
__device__ __forceinline__ float gelu_tanh(float g) { const float z = 0.7978845608028654f * (g + 0.044715f * g * g * g); const float e = __expf(2.0f * z); return 0.5f * g * (2.0f - 2.0f * __builtin_amdgcn_rcpf(e + 1.0f)); }

constexpr int LRU_XA = 0, LRU_XA_STRIDE = 272, LRU_XF = 17408, LRU_XF_STRIDE = 132  , LRU_SA = 51200, LRU_SB = 83968, LRU_CARRY = 116736;
__device__ __forceinline__ void lru_item(Frame& F, const Args& A, int b, int n) {
    const bf16* z0 = (const bf16*)(F.ws + WS_Z); bf16* y0 = (bf16*)(F.ws + WS_Y0);
    const int tid = F.tid, lane = F.lane, w = F.wave, fr = lane & 15, fq = lane >> 4;
    LAS unsigned char* lds = F.lds;
    LAS float* XF = (LAS float*)(lds + LRU_XF); LAS float* SA = (LAS float*)(lds + LRU_SA); LAS float* SB = (LAS float*)(lds + LRU_SB); LAS float* CARRY = (LAS float*)(lds + LRU_CARRY);
    const int c8 = (tid & 15) * 8, r4 = tid >> 4;
    const int ch0 = n * 128 + c8;
    float cw[4][8], cb[8];
#pragma unroll
    for (int e = 0; e < 8; ++e) { cb[e] = A.in[6][ch0 + e];
#pragma unroll
        for (int j = 0; j < 4; ++j) cw[j][e] = A.in[5][j * LRU_W + ch0 + e]; }
    const int dch = n * 128 + 16 * w + fr;
    const float ba = A.in[8][dch], bx = A.in[10][dch];
    const float cneg = -8.0f * log1pf(expf(-A.in[11][dch]));
    bf16x8 bwa[4], bwx[4];
    { const bf16* wat = (const bf16*)(F.ws + WS_WAT) + ((size_t)n * 128 + 16 * w + fr) * 128 + 8 * fq; const bf16* wxt = (const bf16*)(F.ws + WS_WXT) + ((size_t)n * 128 + 16 * w + fr) * 128 + 8 * fq;
#pragma unroll
      for (int ks = 0; ks < 4; ++ks) { bwa[ks] = *(const bf16x8*)(wat + 32 * ks); bwx[ks] = *(const bf16x8*)(wxt + 32 * ks); } }
    if (tid < 128) CARRY[tid] = 0.f;
    for (int tau = 0; tau < 65; ++tau) {
        v4u gv[2];
#pragma unroll
        for (int q = 0; q < 2; ++q) {
            const int rr = r4 + 32 * q, t = 64 * tau + rr - 48;
            float xc[8];
#pragma unroll
            for (int e = 0; e < 8; ++e) xc[e] = cb[e];
            gv[q] = (v4u){0u, 0u, 0u, 0u};
            if (t >= 0) {
                gv[q] = *(const GAS v4u*)(z0 + (size_t)row_of(b, t) * AB_Z + LRU_W + ch0);
#pragma unroll
                for (int j = 0; j < 4; ++j) { const int tj = t - 3 + j;
                    if (tj >= 0) { const v4u xv = *(const GAS v4u*)(z0 + (size_t)row_of(b, tj) * AB_Z + ch0); float xf[8]; unpack8(xv, xf);
#pragma unroll
                        for (int e = 0; e < 8; ++e) xc[e] += cw[j][e] * xf[e]; } }
            }
            *(LAS v4u*)(lds + LRU_XA + rr * LRU_XA_STRIDE + c8 * 2) = pack8f(xc);
            *(LAS f32x4*)(XF + rr * LRU_XF_STRIDE + c8) = (f32x4){xc[0], xc[1], xc[2], xc[3]};
            *(LAS f32x4*)(XF + rr * LRU_XF_STRIDE + c8 + 4) = (f32x4){xc[4], xc[5], xc[6], xc[7]};
        }
        __syncthreads();
        f32x4 accr[4], acci[4];
#pragma unroll
        for (int m = 0; m < 4; ++m) { accr[m] = (f32x4){0.f, 0.f, 0.f, 0.f}; acci[m] = (f32x4){0.f, 0.f, 0.f, 0.f}; }
#pragma unroll
        for (int m = 0; m < 4; ++m)
#pragma unroll
            for (int ks = 0; ks < 4; ++ks) { const bf16x8 a = *(const LAS bf16x8*)(lds + LRU_XA + (16 * m + fr) * LRU_XA_STRIDE + (32 * ks + 8 * fq) * 2);
                accr[m] = mfma16(a, bwa[ks], accr[m]); acci[m] = mfma16(a, bwx[ks], acci[m]); }
#pragma unroll
        for (int m = 0; m < 4; ++m)
#pragma unroll
            for (int g = 0; g < 4; ++g) { const int rr = 16 * m + 4 * fq + g, d = 16 * w + fr;
                const float rg = sigmoidf_fast(accr[m][g] + ba), ig = sigmoidf_fast(acci[m][g] + bx);
                const float la = cneg * rg; const float av = __expf(la); const float mult = sqrtf(fmaxf(1.0f - __expf(2.0f * la), 0.f));
                float bv = mult * (ig * XF[rr * LRU_XF_STRIDE + d]);
                if (tau == 0 && rr < 48) bv = 0.f;
                SA[rr * 128 + d] = av; SB[rr * 128 + d] = bv; }
        __syncthreads();
        if (tid < 128) { float h = CARRY[tid];
#pragma unroll 8
            for (int rr = 0; rr < 64; ++rr) { h = SA[rr * 128 + tid] * h + SB[rr * 128 + tid]; SB[rr * 128 + tid] = h; }
            CARRY[tid] = h; }
        __syncthreads();
#pragma unroll
        for (int q = 0; q < 2; ++q) {
            const int rr = r4 + 32 * q, t = 64 * tau + rr - 48;
            if (t >= 0) { float gf[8], o[8]; unpack8(gv[q], gf);
                const f32x4 h0 = *(const LAS f32x4*)(SB + rr * 128 + c8), h1 = *(const LAS f32x4*)(SB + rr * 128 + c8 + 4);
#pragma unroll
                for (int e = 0; e < 4; ++e) { o[e] = h0[e] * gelu_tanh(gf[e]); o[e + 4] = h1[e] * gelu_tanh(gf[e + 4]); }
                *(GAS v4u*)(y0 + (size_t)row_of(b, t) * DM + ch0) = pack8f(o); }
        }
    }
    __syncthreads();
}

constexpr int AT_KT = 0, AT_KT_STRIDE = 272, AT_VT = 17408, AT_VT_STRIDE = 144, AT_PS = 35840, AT_PS_STRIDE = 144, AT_CUM = 72704, AT_SCAN = 90112;
__device__ __forceinline__ float log_sigmoid(float x) { return fminf(x, 0.f) - log1pf(__expf(-fabsf(x))); }
__device__ __forceinline__ void attn_item(Frame& F, const Args& A, int b, int h, int j) {
    const bf16* z0 = (const bf16*)(F.ws + WS_Z); bf16* y0 = (bf16*)(F.ws + WS_Y0); const float* fbuf = (const float*)(F.ws + WS_FBUF);
    const int tid = F.tid, lane = F.lane, w = F.wave, fr = lane & 15, fq = lane >> 4;
    LAS unsigned char* lds = F.lds;
    LAS float* CUM = (LAS float*)(lds + AT_CUM); LAS float* SCAN = (LAS float*)(lds + AT_SCAN);
    LAS unsigned char* PSw = lds + AT_PS + w * (32 * AT_PS_STRIDE);
    constexpr float LOG2E = 1.4426950408889634f;
    const int nT = NMETA + 256 * j;
    { const float bf_h = A.in[4][h];
      float loc[9]; float run = 0.f;
#pragma unroll
      for (int e = 0; e < 9; ++e) { const int t = 9 * tid + e; float v = 0.f; if (t < nT) v = log_sigmoid(fbuf[(size_t)row_of(b, t) * 16 + h] + bf_h); run += v; loc[e] = run; }
      float inc = run;
#pragma unroll
      for (int o = 1; o < 64; o <<= 1) { const float t = __shfl_up(inc, o); if (lane >= o) inc += t; }
      if (lane == 63) SCAN[w] = inc;
      __syncthreads();
      float off = inc - run;
      for (int k = 0; k < w; ++k) off += SCAN[k];
#pragma unroll
      for (int e = 0; e < 9; ++e) { const int t = 9 * tid + e; if (t < nT) CUM[t + 240] = (off + loc[e]) * LOG2E; }
      if (tid < 240) CUM[tid] = 0.f;
      __syncthreads(); }
    bf16x8 qf[2][4]; float bq[2][4];
    const int ubase = 256 * j + 32 * w;
#pragma unroll
    for (int m = 0; m < 2; ++m) {
        const int u = ubase + 16 * m + fr; const int t = u - 240; const int r = row_of(b, t < 0 ? 0 : t);
        const bf16* qp = z0 + (size_t)r * AB_Z + 4096 + 128 * h + 8 * fq;
        float qv[4][8]; float s = 0.f;
#pragma unroll
        for (int ks = 0; ks < 4; ++ks) { const v4u raw = *(const GAS v4u*)(qp + 32 * ks); unpack8(raw, qv[ks]);
#pragma unroll
            for (int e = 0; e < 8; ++e) s += qv[ks][e] * qv[ks][e]; }
        s += __shfl_xor(s, 16); s += __shfl_xor(s, 32);
        const float rs = (1.0f / sqrtf(s * (1.0f / 128.0f) + RMS_EPS)) * (0.08838834764831845f * LOG2E);
#pragma unroll
        for (int ks = 0; ks < 4; ++ks) { float o[8];
#pragma unroll
            for (int e = 0; e < 8; ++e) o[e] = qv[ks][e] * rs * A.in[12][32 * ks + 8 * fq + e];
            const v4u pk = pack8f(o); qf[m][ks] = __builtin_bit_cast(bf16x8, pk); }
#pragma unroll
        for (int g = 0; g < 4; ++g) bq[m][g] = CUM[ubase + 16 * m + 4 * fq + g];
    }
    f32x4 O[2][8]; float mrow[2][4], lrow[2][4];
#pragma unroll
    for (int m = 0; m < 2; ++m) {
#pragma unroll
        for (int dt = 0; dt < 8; ++dt) O[m][dt] = (f32x4){0.f, 0.f, 0.f, 0.f};
#pragma unroll
        for (int g = 0; g < 4; ++g) { mrow[m][g] = -1e30f; lrow[m][g] = 0.f; } }
    const int imax = 4 * j + 3;
    const int skey = tid >> 3, sdc = (tid & 7) * 16;
    v4u kreg[2], vreg[2];
    { const int t = 64 * 3 + skey - 240; const int r = row_of(b, t < 0 ? 0 : t); const bf16* kp = z0 + (size_t)r * AB_Z + 6144 + 128 * h + sdc; const bf16* vp = z0 + (size_t)r * AB_Z + 8192 + 128 * h + sdc;
      kreg[0] = *(const GAS v4u*)(kp); kreg[1] = *(const GAS v4u*)(kp + 8); vreg[0] = *(const GAS v4u*)(vp); vreg[1] = *(const GAS v4u*)(vp + 8); }
    for (int i = 3; i <= imax; ++i) {
        __syncthreads();
        { float kv[16]; { float a8[8], b8[8]; unpack8(kreg[0], a8); unpack8(kreg[1], b8);
#pragma unroll
            for (int e = 0; e < 8; ++e) { kv[e] = a8[e]; kv[8 + e] = b8[e]; } }
          float s = 0.f;
#pragma unroll
          for (int e = 0; e < 16; ++e) s += kv[e] * kv[e];
          s += __shfl_xor(s, 1); s += __shfl_xor(s, 2); s += __shfl_xor(s, 4);
          const float rs = 1.0f / sqrtf(s * (1.0f / 128.0f) + RMS_EPS);
          float o0[8], o1[8];
          { const f32x4 g0 = *(const GAS f32x4*)(A.in[13] + sdc), g1 = *(const GAS f32x4*)(A.in[13] + sdc + 4), g2 = *(const GAS f32x4*)(A.in[13] + sdc + 8), g3 = *(const GAS f32x4*)(A.in[13] + sdc + 12);
#pragma unroll
          for (int e = 0; e < 4; ++e) { o0[e] = kv[e] * rs * g0[e]; o0[4 + e] = kv[4 + e] * rs * g1[e]; o1[e] = kv[8 + e] * rs * g2[e]; o1[4 + e] = kv[12 + e] * rs * g3[e]; } }
          *(LAS v4u*)(lds + AT_KT + skey * AT_KT_STRIDE + sdc * 2) = pack8f(o0);
          *(LAS v4u*)(lds + AT_KT + skey * AT_KT_STRIDE + sdc * 2 + 16) = pack8f(o1);
          const unsigned vw[8] = {vreg[0].x, vreg[0].y, vreg[0].z, vreg[0].w, vreg[1].x, vreg[1].y, vreg[1].z, vreg[1].w};
#pragma unroll
          for (int e = 0; e < 8; ++e) { *(LAS unsigned short*)(lds + AT_VT + (sdc + 2 * e) * AT_VT_STRIDE + skey * 2) = (unsigned short)(vw[e] & 0xffffu);
              *(LAS unsigned short*)(lds + AT_VT + (sdc + 2 * e + 1) * AT_VT_STRIDE + skey * 2) = (unsigned short)(vw[e] >> 16); } }
        __syncthreads();
        if (i < imax) { const int t = 64 * (i + 1) + skey - 240; const int r = row_of(b, t); const bf16* kp = z0 + (size_t)r * AB_Z + 6144 + 128 * h + sdc; const bf16* vp = z0 + (size_t)r * AB_Z + 8192 + 128 * h + sdc;
            kreg[0] = *(const GAS v4u*)(kp); kreg[1] = *(const GAS v4u*)(kp + 8); vreg[0] = *(const GAS v4u*)(vp); vreg[1] = *(const GAS v4u*)(vp + 8); }
        if (64 * i <= ubase + 31) {
            f32x4 S[2][4];
#pragma unroll
            for (int m = 0; m < 2; ++m)
#pragma unroll
                for (int nt = 0; nt < 4; ++nt) S[m][nt] = (f32x4){0.f, 0.f, 0.f, 0.f};
#pragma unroll
            for (int nt = 0; nt < 4; ++nt)
#pragma unroll
                for (int ks = 0; ks < 4; ++ks) { const bf16x8 kf = *(const LAS bf16x8*)(lds + AT_KT + (16 * nt + fr) * AT_KT_STRIDE + (32 * ks + 8 * fq) * 2);
                    S[0][nt] = mfma16(qf[0][ks], kf, S[0][nt]); S[1][nt] = mfma16(qf[1][ks], kf, S[1][nt]); }
            float bk[4];
#pragma unroll
            for (int nt = 0; nt < 4; ++nt) bk[nt] = CUM[64 * i + 16 * nt + fr];
            const bool need_mask = (i == 3) || (64 * i + 63 > ubase);
            float alpha[2][4];
#pragma unroll
            for (int m = 0; m < 2; ++m)
#pragma unroll
                for (int g = 0; g < 4; ++g) {
                    const int uq = ubase + 16 * m + 4 * fq + g;
                    float mx = -__builtin_inff();
#pragma unroll
                    for (int nt = 0; nt < 4; ++nt) { float sv = S[m][nt][g] + (bq[m][g] - bk[nt]);
                        if (need_mask) { const int uk = 64 * i + 16 * nt + fr; if (uk > uq || uk < 240) sv = -__builtin_inff(); }
                        S[m][nt][g] = sv; mx = fmaxf(mx, sv); }
                    mx = fmaxf(mx, __shfl_xor(mx, 1)); mx = fmaxf(mx, __shfl_xor(mx, 2)); mx = fmaxf(mx, __shfl_xor(mx, 4)); mx = fmaxf(mx, __shfl_xor(mx, 8));
                    const float mn = fmaxf(mrow[m][g], mx);
                    alpha[m][g] = __builtin_amdgcn_exp2f(mrow[m][g] - mn); mrow[m][g] = mn;
                    float ps = 0.f;
#pragma unroll
                    for (int nt = 0; nt < 4; ++nt) { const float p = __builtin_amdgcn_exp2f(S[m][nt][g] - mn); ps += p;
                        *(LAS unsigned short*)(PSw + (16 * m + 4 * fq + g) * AT_PS_STRIDE + (16 * nt + fr) * 2) = (unsigned short)(pk2(p, 0.f) & 0xffffu); }
                    lrow[m][g] = lrow[m][g] * alpha[m][g] + ps;
                }
#pragma unroll
            for (int m = 0; m < 2; ++m)
#pragma unroll
                for (int dt = 0; dt < 8; ++dt)
#pragma unroll
                    for (int g = 0; g < 4; ++g) O[m][dt][g] *= alpha[m][g];
            LDS_WAIT();
            bf16x8 pf[2][2];
#pragma unroll
            for (int m = 0; m < 2; ++m)
#pragma unroll
                for (int k2 = 0; k2 < 2; ++k2) pf[m][k2] = *(const LAS bf16x8*)(PSw + (16 * m + fr) * AT_PS_STRIDE + (32 * k2 + 8 * fq) * 2);
#pragma unroll
            for (int dt = 0; dt < 8; ++dt)
#pragma unroll
                for (int k2 = 0; k2 < 2; ++k2) { const bf16x8 vf = *(const LAS bf16x8*)(lds + AT_VT + (16 * dt + fr) * AT_VT_STRIDE + (32 * k2 + 8 * fq) * 2);
                    O[0][dt] = mfma16(pf[0][k2], vf, O[0][dt]); O[1][dt] = mfma16(pf[1][k2], vf, O[1][dt]); }
        }
    }
#pragma unroll
    for (int m = 0; m < 2; ++m)
#pragma unroll
        for (int g = 0; g < 4; ++g) {
            float l = lrow[m][g]; l += __shfl_xor(l, 1); l += __shfl_xor(l, 2); l += __shfl_xor(l, 4); l += __shfl_xor(l, 8);
            const int t = ubase + 16 * m + 4 * fq + g - 240;
            if (t >= 0) { const float il = 1.0f / l; bf16* op = y0 + (size_t)row_of(b, t) * DM + LRU_W + 128 * h + fr;
#pragma unroll
                for (int dt = 0; dt < 8; ++dt) op[16 * dt] = (bf16)(pk2(O[m][dt][g] * il, 0.f) & 0xffffu); }
        }
    __syncthreads();
}

__device__ __forceinline__ int p2_fetch(Frame& F, gu32* qctr) {
    if (F.tid == 0) F.MISC[0] = __hip_atomic_fetch_add(qctr, 1u, RLX_AGENT);
    __syncthreads();
    const int item = (int)F.MISC[0];
    __syncthreads();
    return item;
}
__device__ __forceinline__ void p2_mixer0(Frame& F, const Args& A) {
    gu32* qctr = (gu32*)(F.ws + WS_CTL) + CW_Q2;
    constexpr int N_LRU = NB * 16, N_ATT = NB * FOX_H * 17;
    int item = p2_fetch(F, qctr);
    while (item < N_LRU) { lru_item(F, A, item >> 4, item & 15); item = p2_fetch(F, qctr); }
    while (item < N_LRU + N_ATT) { const int a = item - N_LRU; const int j = 16 - a / 64, bh = a % 64; attn_item(F, A, bh >> 4, bh & 15, j); item = p2_fetch(F, qctr); }
}

constexpr int RT_QS = 0, RT_QS_STRIDE = 528, RT_KN = 33792, RT_KT = 67584, RT_T_STRIDE = 144, RT_VT = 104448, RT_SS = 122880;
static_assert(RT_SS + 64 * RT_T_STRIDE <= MISC_OFF, "retention LDS map");
__device__ __forceinline__ int ret_row(int b, int c, int idx) { return c == 0 ? (idx < 48 ? -1 : MMETA + NMETA * b + (idx - 48)) : b * SEQ + 64 * (c - 1) + idx; }
__device__ __forceinline__ void ret_item(Frame& F, const Args& A, int b, int h, int es) {
    const bf16* z1 = (const bf16*)(F.ws + WS_Z); bf16* ob = (bf16*)(F.ws + WS_Y1); float* ssqo = (float*)(F.ws + WS_SSQO);
    const int tid = F.tid, lane = F.lane, w = F.wave, fr = lane & 15, fq = lane >> 4;
    LAS unsigned char* lds = F.lds;
    const float lg = log1pf(-exp2f(-5.0f - (float)h)) * 1.4426950408889634f;
    const float cdec = exp2f(lg * 64.0f);
    f32x4 Sacc[16];
#pragma unroll
    for (int dt = 0; dt < 16; ++dt) Sacc[dt] = (f32x4){0.f, 0.f, 0.f, 0.f};
    const int qrow = tid >> 5, qd = (tid & 31) * 8;
    const int vrow = tid >> 4, ve = (tid & 15) * 8;
    v4u qreg[4], kreg[4], vreg[2];
    const size_t qcol = (size_t)h * RET_QK + qd, kcol = 4096 + (size_t)h * RET_QK + qd, vcol = 8192 + (size_t)h * RET_V + 128 * es + ve;
#define RT_PREFETCH(c) do { \
        _Pragma("unroll") for (int k = 0; k < 4; ++k) { const int r = ret_row(b, (c), qrow + 16 * k); \
            if (r >= 0) { qreg[k] = *(const GAS v4u*)(z1 + (size_t)r * RET_IN + qcol); kreg[k] = *(const GAS v4u*)(z1 + (size_t)r * RET_IN + kcol); } \
            else { qreg[k] = (v4u){0u, 0u, 0u, 0u}; kreg[k] = (v4u){0u, 0u, 0u, 0u}; } } \
        _Pragma("unroll") for (int k = 0; k < 2; ++k) { const int r = ret_row(b, (c), vrow + 32 * k); \
            if (r >= 0) vreg[k] = *(const GAS v4u*)(z1 + (size_t)r * RET_IN + vcol); else vreg[k] = (v4u){0u, 0u, 0u, 0u}; } } while (0)
    RT_PREFETCH(0);
    for (int c = 0; c < 65; ++c) {
        __syncthreads();
#pragma unroll
        for (int k = 0; k < 4; ++k) { const int m = qrow + 16 * k;
            *(LAS v4u*)(lds + RT_QS + m * RT_QS_STRIDE + qd * 2) = qreg[k];
            *(LAS v4u*)(lds + RT_KN + m * RT_QS_STRIDE + qd * 2) = kreg[k];
            float kf[8]; unpack8(kreg[k], kf); const float kd = exp2f(lg * (float)(63 - m));
#pragma unroll
            for (int e = 0; e < 8; e += 2) { const unsigned pk = pk2(kf[e] * kd, kf[e + 1] * kd);
                *(LAS unsigned short*)(lds + RT_KT + (qd + e) * RT_T_STRIDE + m * 2) = (unsigned short)(pk & 0xffffu);
                *(LAS unsigned short*)(lds + RT_KT + (qd + e + 1) * RT_T_STRIDE + m * 2) = (unsigned short)(pk >> 16); } }
#pragma unroll
        for (int k = 0; k < 2; ++k) { const int m = vrow + 32 * k; const unsigned vw[4] = {vreg[k].x, vreg[k].y, vreg[k].z, vreg[k].w};
#pragma unroll
            for (int e = 0; e < 4; ++e) { *(LAS unsigned short*)(lds + RT_VT + (ve + 2 * e) * RT_T_STRIDE + m * 2) = (unsigned short)(vw[e] & 0xffffu);
                *(LAS unsigned short*)(lds + RT_VT + (ve + 2 * e + 1) * RT_T_STRIDE + m * 2) = (unsigned short)(vw[e] >> 16); } }
        __syncthreads();
        if (c < 64) RT_PREFETCH(c + 1);
        { const int it = w >> 1, mt0 = 2 * (w & 1);
          f32x4 sacc[2] = {(f32x4){0.f, 0.f, 0.f, 0.f}, (f32x4){0.f, 0.f, 0.f, 0.f}};
#pragma unroll
          for (int ks = 0; ks < 8; ++ks) { const bf16x8 a = *(const LAS bf16x8*)(lds + RT_QS + (16 * it + fr) * RT_QS_STRIDE + (32 * ks + 8 * fq) * 2);
#pragma unroll
              for (int q = 0; q < 2; ++q) { const bf16x8 kb = *(const LAS bf16x8*)(lds + RT_KN + (16 * (mt0 + q) + fr) * RT_QS_STRIDE + (32 * ks + 8 * fq) * 2); sacc[q] = mfma16(a, kb, sacc[q]); } }
#pragma unroll
          for (int q = 0; q < 2; ++q)
#pragma unroll
              for (int g = 0; g < 4; ++g) { const int i = 16 * it + 4 * fq + g, m = 16 * (mt0 + q) + fr; const int dd = i > m ? i - m : m - i;
                  const float sv = sacc[q][g] * exp2f(lg * (float)dd);
                  *(LAS unsigned short*)(lds + RT_SS + i * RT_T_STRIDE + m * 2) = (unsigned short)(pk2(sv, 0.f) & 0xffffu); } }
        __syncthreads();
        f32x4 acc[4];
#pragma unroll
        for (int mi = 0; mi < 4; ++mi) acc[mi] = (f32x4){0.f, 0.f, 0.f, 0.f};
#pragma unroll
        for (int kk = 0; kk < 8; ++kk) {
            v4u bw; bw.x = pk2(Sacc[2 * kk][0], Sacc[2 * kk][1]); bw.y = pk2(Sacc[2 * kk][2], Sacc[2 * kk][3]); bw.z = pk2(Sacc[2 * kk + 1][0], Sacc[2 * kk + 1][1]); bw.w = pk2(Sacc[2 * kk + 1][2], Sacc[2 * kk + 1][3]);
            const bf16x8 bfrag = __builtin_bit_cast(bf16x8, bw);
#pragma unroll
            for (int mi = 0; mi < 4; ++mi) { const LAS unsigned char* qp = lds + RT_QS + (16 * mi + fr) * RT_QS_STRIDE + (32 * kk + 4 * fq) * 2;
                const v2u lo = *(const LAS v2u*)(qp), hi = *(const LAS v2u*)(qp + 32);
                v4u aw; aw.x = lo.x; aw.y = lo.y; aw.z = hi.x; aw.w = hi.y;
                acc[mi] = mfma16(__builtin_bit_cast(bf16x8, aw), bfrag, acc[mi]); } }
#pragma unroll
        for (int mi = 0; mi < 4; ++mi)
#pragma unroll
            for (int g = 0; g < 4; ++g) acc[mi][g] *= exp2f(lg * (float)(16 * mi + 4 * fq + g + 1));
        bf16x8 vf[2];
#pragma unroll
        for (int k2 = 0; k2 < 2; ++k2) vf[k2] = *(const LAS bf16x8*)(lds + RT_VT + (16 * w + fr) * RT_T_STRIDE + (32 * k2 + 8 * fq) * 2);
#pragma unroll
        for (int mi = 0; mi < 4; ++mi)
#pragma unroll
            for (int k2 = 0; k2 < 2; ++k2) { const bf16x8 a = *(const LAS bf16x8*)(lds + RT_SS + (16 * mi + fr) * RT_T_STRIDE + (32 * k2 + 8 * fq) * 2); acc[mi] = mfma16(a, vf[k2], acc[mi]); }
        if (c > 0) {
#pragma unroll
            for (int mi = 0; mi < 4; ++mi)
#pragma unroll
                for (int g = 0; g < 4; ++g) { const int r = b * SEQ + 64 * (c - 1) + 16 * mi + 4 * fq + g; const float v = acc[mi][g];
                    ob[(size_t)r * RET_VW + h * RET_V + 128 * es + 16 * w + fr] = (bf16)(pk2(v, 0.f) & 0xffffu);
                    float sq = v * v; sq += __shfl_xor(sq, 1); sq += __shfl_xor(sq, 2); sq += __shfl_xor(sq, 4); sq += __shfl_xor(sq, 8);
                    if (fr == 0) atomicAdd(ssqo + (size_t)r * 16 + h, sq); }
        }
#pragma unroll
        for (int dt = 0; dt < 16; ++dt) { Sacc[dt] *= cdec;
#pragma unroll
            for (int k2 = 0; k2 < 2; ++k2) { const bf16x8 a = *(const LAS bf16x8*)(lds + RT_KT + (16 * dt + fr) * RT_T_STRIDE + (32 * k2 + 8 * fq) * 2); Sacc[dt] = mfma16(a, vf[k2], Sacc[dt]); } }
    }
#undef RT_PREFETCH
    __syncthreads();
}
__device__ __forceinline__ void p7_retention(Frame& F, const Args& A) {
    for (int item = blockIdx.x; item < NB * RET_H * 4; item += F.G) ret_item(F, A, item >> 6, (item >> 2) & 15, item & 3);
}
__device__ __forceinline__ void p8_gate(Frame& F, const Args& A) {
    const bf16* z1 = (const bf16*)(F.ws + WS_Z); bf16* ob = (bf16*)(F.ws + WS_Y1); const float* ssqo = (const float*)(F.ws + WS_SSQO); const float* gain = A.in[17];
    const size_t total = (size_t)MTOK * (RET_VW / 8), stride = (size_t)F.G * NTHREADS;
    for (size_t idx = (size_t)blockIdx.x * NTHREADS + F.tid; idx < total; idx += stride) {
        const int r = (int)(idx >> 10), c = (int)(idx & 1023) * 8, hd = c >> 9;
        const v4u gw = *(const GAS v4u*)(z1 + (size_t)r * RET_IN + 16384 + c); const v4u ow = *(const GAS v4u*)(ob + (size_t)r * RET_VW + c);
        const f32x4 g0 = *(const GAS f32x4*)(gain + c), g1 = *(const GAS f32x4*)(gain + c + 4);
        const float rs = 1.0f / sqrtf(ssqo[(size_t)r * 16 + hd] * (1.0f / 512.0f) + RMS_EPS);
        float gf[8], of[8], y[8]; unpack8(gw, gf); unpack8(ow, of);
#pragma unroll
        for (int e = 0; e < 8; ++e) { const float gn = e < 4 ? g0[e] : g1[e - 4]; y[e] = gf[e] * sigmoidf_fast(gf[e]) * (of[e] * rs * gn); }
        *(GAS v4u*)(ob + (size_t)r * RET_VW + c) = pack8f(y);
    }
}

__global__ void __launch_bounds__(NTHREADS, 2) hybrid_fwd(Args args) {
    extern __shared__ __attribute__((aligned(16))) unsigned char lds_raw[];
    Frame F;
    F.lds = (LAS unsigned char*)lds_raw;
    F.MISC = (volatile LAS unsigned*)(F.lds + MISC_OFF);
    F.tid = threadIdx.x; F.lane = F.tid & 63; F.wave = __builtin_amdgcn_readfirstlane(F.tid >> 6);
    F.G = gridDim.x; F.ws = args.ws;
    if (F.tid < 64) F.MISC[F.tid] = 0u;
    __syncthreads();
    unsigned* ctl = (unsigned*)(F.ws + WS_CTL);
#if !MK_PER_PHASE
    const XcdBarrier bar = xcd_barrier_post(ctl + CW_BAR, F.MISC + 8);
#define GRID_BAR() xcd_barrier(bar)
#else
#define GRID_BAR() do { } while (0)
#endif
    const int lo = args.ph_lo, hi = args.ph_hi;
#ifndef PHASE_MASK
#define PHASE_MASK 0xFFF
#endif
#define IN(k) ((((PHASE_MASK) >> (k)) & 1) && lo <= (k) && (k) < hi)
#define BOTH(k) (IN(k) && IN((k) + 1))
    unsigned char* ws = F.ws;
    bf16* XB = (bf16*)(ws + WS_XB); float* Htok = args.out; float* Hmeta = (float*)(ws + WS_HMETA); bf16* Z = (bf16*)(ws + WS_Z); bf16* Y0 = (bf16*)(ws + WS_Y0); bf16* Y1 = (bf16*)(ws + WS_Y1);
    float* SSQ0 = (float*)(ws + WS_SSQ0); float* SSQ1 = (float*)(ws + WS_SSQ1); float* SSQ2 = (float*)(ws + WS_SSQ2); float* SSQ3 = (float*)(ws + WS_SSQ3);
    const int c = (int)blockIdx.x;

    if (IN(0)) { p0_prologue(F, args); if (BOTH(0)) GRID_BAR(); }
    if (IN(1)) {
        pg8::Gemm g{XB, (const bf16*)(ws + WS_WIN0), MP, 41 * 256, DM}; pg8::StaticOrder S; S.init(MP, 41 * 256, F.G, c);
        pg8::EpiIn0 E{Z, (float*)(ws + WS_FBUF), SSQ0};
        pg8::gemm_phase<pg8::EpiIn0, pg8::StaticOrder, true, true>(F.lds, g, S, E);
        if (BOTH(1)) GRID_BAR();
    }
    if (IN(2)) { p2_mixer0(F, args); if (BOTH(2)) GRID_BAR(); }
    if (IN(3)) {
        pg8::Gemm g{Y0, (const bf16*)(ws + WS_WOUT0), MP, DM, DM}; pg8::StaticOrder S; S.init(MP, DM, F.G, c);
        pg8::EpiRes E{Htok, Hmeta, XB, SSQ1};
        pg8::gemm_phase<pg8::EpiRes, pg8::StaticOrder, true, true>(F.lds, g, S, E);
        if (BOTH(3)) GRID_BAR();
    }
    if (IN(4)) {
        pg8::Gemm g{XB, (const bf16*)(ws + WS_WGU0), MP, 2 * DFF, DM}; pg8::StaticOrder S; S.init(MP, 2 * DFF, F.G, c);
        pg8::EpiGU E{Z, SSQ1};
        pg8::gemm_phase<pg8::EpiGU, pg8::StaticOrder, true, true>(F.lds, g, S, E);
        if (BOTH(4)) GRID_BAR();
    }
    if (IN(5)) {
        pg8::Gemm g{Z, (const bf16*)(ws + WS_WD0), MP, DM, DFF}; pg8::StaticOrder S; S.init(MP, DM, F.G, c);
        pg8::EpiRes E{Htok, Hmeta, XB, SSQ2};
        pg8::gemm_phase<pg8::EpiRes, pg8::StaticOrder, true, true>(F.lds, g, S, E);
        if (BOTH(5)) GRID_BAR();
    }
    if (IN(6)) {
        pg8::Gemm g{XB, (const bf16*)(ws + WS_WIN1), MP, RET_IN, DM}; pg8::StaticOrder S; S.init(MP, RET_IN, F.G, c);
        pg8::EpiIn1 E{Z, SSQ2};
        pg8::gemm_phase<pg8::EpiIn1, pg8::StaticOrder, true, true>(F.lds, g, S, E);
        if (BOTH(6)) GRID_BAR();
    }
    if (IN(7)) { p7_retention(F, args); if (BOTH(7)) GRID_BAR(); }
    if (IN(8)) { p8_gate(F, args); if (BOTH(8)) GRID_BAR(); }
    if (IN(9)) {
        pg8::Gemm g{Y1, (const bf16*)(ws + WS_WOUT1), MTOK, DM, RET_VW}; pg8::StaticOrder S; S.init(MTOK, DM, F.G, c);
        pg8::EpiRes E{Htok, Hmeta, XB, SSQ3};
        pg8::gemm_phase<pg8::EpiRes, pg8::StaticOrder, true, true>(F.lds, g, S, E);
        if (BOTH(9)) GRID_BAR();
    }
    if (IN(10)) {
        pg8::Gemm g{XB, (const bf16*)(ws + WS_WGU1), MTOK, 2 * DFF, DM}; pg8::StaticOrder S; S.init(MTOK, 2 * DFF, F.G, c);
        pg8::EpiGU E{Z, SSQ3};
        pg8::gemm_phase<pg8::EpiGU, pg8::StaticOrder, true, true>(F.lds, g, S, E);
        if (BOTH(10)) GRID_BAR();
    }
    if (IN(11)) {
        pg8::Gemm g{Z, (const bf16*)(ws + WS_WD1), MTOK, DM, DFF}; pg8::StaticOrder S; S.init(MTOK, DM, F.G, c);
        pg8::EpiFinal E{args.out};
        pg8::gemm_phase<pg8::EpiFinal, pg8::StaticOrder, true, true>(F.lds, g, S, E);
    }
#undef IN
#undef BOTH
}

extern "C" void kernel_launch(void* const* d_in, const int* in_sizes, int n_in, void* d_out, int out_size, void* d_ws, size_t ws_size, hipStream_t stream) {
    static int grid = 0;
    if (grid == 0) {
        if (n_in != 23 || in_sizes[0] != MTOK * DM || out_size != MTOK * DM || ws_size < WS_END) { fprintf(stderr, "kernel_launch: unexpected shapes (n_in %d, in0 %d, out %d, ws %zu < %zu); nothing launched\n", n_in, n_in > 0 ? in_sizes[0] : -1, out_size, ws_size, (size_t)WS_END); grid = -1; return; }
        int dev = 0, cus = 0, per_cu = 0;
        if (hipGetDevice(&dev) != hipSuccess || hipDeviceGetAttribute(&cus, hipDeviceAttributeMultiprocessorCount, dev) != hipSuccess) { fprintf(stderr, "kernel_launch: device query failed\n"); grid = -1; return; }
        if (hipFuncSetAttribute((const void*)hybrid_fwd, hipFuncAttributeMaxDynamicSharedMemorySize, LDS_BYTES) != hipSuccess) { fprintf(stderr, "kernel_launch: hipFuncSetAttribute failed\n"); grid = -1; return; }
        if (hipOccupancyMaxActiveBlocksPerMultiprocessor(&per_cu, (const void*)hybrid_fwd, NTHREADS, LDS_BYTES) != hipSuccess || per_cu < 1) { fprintf(stderr, "kernel_launch: occupancy query reports %d workgroups per CU\n", per_cu); }
        (void)hipGetLastError();
        grid = cus;
    }
    if (grid < 0) return;
    if (hipMemsetAsync((char*)d_ws + WS_CTL, 0, CTL_ZERO_BYTES, stream) != hipSuccess) { fprintf(stderr, "kernel_launch: memset failed\n"); return; }
    Args a{};
    for (int i = 0; i < 23; ++i) a.in[i] = (const float*)d_in[i];
    a.out = (float*)d_out; a.ws = (unsigned char*)d_ws;
#if MK_PER_PHASE
    for (int p = 0; p < NPHASES; ++p) { a.ph_lo = p; a.ph_hi = p + 1; hipLaunchKernelGGL(hybrid_fwd, dim3(grid), dim3(NTHREADS), LDS_BYTES, stream, a); }
#else
    a.ph_lo = 0; a.ph_hi = NPHASES;
    hipLaunchKernelGGL(hybrid_fwd, dim3(grid), dim3(NTHREADS), LDS_BYTES, stream, a);
#endif
    const hipError_t le = hipPeekAtLastError();
    if (le != hipSuccess) fprintf(stderr, "kernel_launch: launch failed: %s\n", hipGetErrorName(le));
}
```

```cpp
#include <hip/hip_runtime.h>
#include <cstdio>
#include <cstdint>
#ifndef MK_PER_PHASE
#define MK_PER_PHASE 0
#endif
constexpr int DM = 4096, NB = 4, SEQ = 4096, NMETA = 16, LSEQ = NMETA + SEQ;
constexpr int MTOK = NB * SEQ;
constexpr int MMETA = MTOK;
constexpr int MP = 65 * 256;
constexpr int LRU_W = 2048, FOX_H = 16, FOX_D = 128, AB_IN = 10256, AB_Z = 10240;
constexpr int RET_H = 16, RET_QK = 256, RET_V = 512, RET_IN = 24576, RET_VW = 8192;
constexpr int DFF = 11008;
constexpr float RMS_EPS = 1e-6f;
namespace pg8 {
#define PG8_LAS __attribute__((address_space(3)))
typedef unsigned short bf16_t;
typedef short bf16x8 __attribute__((ext_vector_type(8)));
typedef float f32x4 __attribute__((ext_vector_type(4)));
typedef unsigned u32x4 __attribute__((ext_vector_type(4)));
constexpr int BM = 256, BK = 64, HALF = 128, HTB = HALF * BK * 2  , STAGE_BYTES = 8 * HTB, NXCD = 8, WGM = 8;

__host__ __device__ __forceinline__ int lds_byte(int r, int c) { const int st = (r >> 4) * 2 + (c >> 5), rr = r & 15, cc = c & 31, ob = rr * 64 + cc * 2; return st * 1024 + (ob ^ (((ob >> 9) & 1) << 5)); }
__host__ __device__ __forceinline__ void stage_rc(int b, int& R, int& C) { const int st = b / 1024, sb = b % 1024, swz = sb ^ (((sb >> 9) & 1) << 5); R = (st >> 1) * 16 + swz / 64; C = (st & 1) * 32 + (swz % 64) / 2; }
__host__ __device__ __forceinline__ int perm32(int rho) { const int n = rho >> 4, i = rho & 15; return 8 * (i >> 2) + 4 * n + (i & 3); }

struct Unit { int pm, pn, kb, kn; };
struct Gemm { const bf16_t* A; const bf16_t* Bt; int M, N, K; };

struct StaticOrder {
    int nM, nN, nwg, G, c, ntk;
    __host__ __device__ void init(int M, int N, int K, int G_, int c_) { nM = M / BM; nN = N / BM; nwg = nM * nN; G = G_; c = c_; ntk = K / BK; }
    __host__ __device__ bool next(int i, Unit& u) const {
        const long L = (long)i * G + c; if (L >= nwg) return false;
        int wgid = (int)L; { const int q = nwg / NXCD, r = nwg % NXCD, xcd = wgid % NXCD, off = wgid / NXCD; wgid = (xcd < r ? xcd * (q + 1) : r * (q + 1) + (xcd - r) * q) + off; }
        const int nig = WGM * nN, gid = wgid / nig, fm = gid * WGM, gsz = (nM - fm) < WGM ? (nM - fm) : WGM;
        u.pm = fm + ((wgid % nig) % gsz); u.pn = (wgid % nig) / gsz; u.kb = 0; u.kn = ntk; return true;
    }
    __device__ __forceinline__ void a_ready(const Unit&) const {}
    __device__ __forceinline__ void done(const Unit&) const {}
};

struct SplitMetaOrder : StaticOrder {
    int nreg, nsplit; unsigned* ticket; volatile PG8_LAS unsigned* flag;
    __device__ void init2(int N, int K, int G_, int c_, unsigned* ticket_, volatile PG8_LAS unsigned* flag_) { init(64 * BM, N, K, G_, c_); nreg = nwg; nsplit = 16; ticket = ticket_; flag = flag_; }
    __device__ bool next(int i, Unit& u) const {
        const long L = (long)i * G + c;
        if (L < nreg) return StaticOrder::next(i, u);
        const int x = (int)(L - nreg); if (x >= nsplit * nN) return false;
        const int s = x % nsplit; u.pm = 64; u.pn = x / nsplit;
        const int base = (ntk / 2) / nsplit, rem = (ntk / 2) % nsplit;
        u.kb = 2 * (s * base + (s < rem ? s : rem)); u.kn = 2 * (base + (s < rem ? 1 : 0)); return true;
    }
    __device__ __forceinline__ void a_ready(const Unit&) const {}
    __device__ __forceinline__ void done(const Unit& u) const {
        if (u.pm == 64) { asm volatile("s_waitcnt vmcnt(0)" ::: "memory");
            if ((threadIdx.x & 63) == 0) { const unsigned old = __hip_atomic_fetch_add(ticket, 1u, __ATOMIC_RELAXED, __HIP_MEMORY_SCOPE_AGENT); if (old + 1u == (unsigned)(nsplit * nN * 8)) flag[0] = 1u; } }
    }
};
__device__ __forceinline__ unsigned cvt_pk_bf16(float lo, float hi) { unsigned r; asm volatile("v_cvt_pk_bf16_f32 %0, %1, %2" : "=v"(r) : "v"(lo), "v"(hi)); return r; }
__device__ __forceinline__ u32x4 pack8(const f32x4 a, const f32x4 b) { u32x4 w; w.x = cvt_pk_bf16(a[0], a[1]); w.y = cvt_pk_bf16(a[2], a[3]); w.z = cvt_pk_bf16(b[0], b[1]); w.w = cvt_pk_bf16(b[2], b[3]); return w; }
__device__ __forceinline__ float row_rstd(const float* ssq, int r) { return 1.0f / sqrtf(ssq[r] * (1.0f / 4096.0f) + RMS_EPS); }

struct EpiIn0 {
    static constexpr bool PERM = true, AFTER_DRAIN = false;
    bf16_t* Z; float* F; const float* ssq;
    __device__ __forceinline__ void operator()(const f32x4 (&acc)[2][2][4][2], const Unit& u, int wr, int wc, int fr, int fq) const {
        const int row0 = u.pm * BM + wr * 64 + fr;
        if (u.pn < 40) {
            const int col0 = u.pn * BM + wc * 32 + 8 * fq;
#pragma unroll
            for (int ai = 0; ai < 2; ++ai)
#pragma unroll
                for (int m = 0; m < 4; ++m) { const int r = row0 + ai * HALF + m * 16; const float rs = row_rstd(ssq, r); bf16_t* rowp = Z + (size_t)r * AB_Z + col0;
#pragma unroll
                    for (int bj = 0; bj < 2; ++bj) *(u32x4*)(rowp + bj * HALF) = pack8(acc[ai][bj][m][0] * rs, acc[ai][bj][m][1] * rs); }
        } else if (wc == 0 && fq < 2) {
#pragma unroll
            for (int ai = 0; ai < 2; ++ai)
#pragma unroll
                for (int m = 0; m < 4; ++m) { const int r = row0 + ai * HALF + m * 16; const float rs = row_rstd(ssq, r); float* fp = F + (size_t)r * 16 + 8 * fq;
                    *(f32x4*)(fp) = acc[ai][0][m][0] * rs; *(f32x4*)(fp + 4) = acc[ai][0][m][1] * rs; }
        }
    }
};
struct EpiRes {
    static constexpr bool PERM = true, AFTER_DRAIN = false;
    float* Htok; float* Hmeta; bf16_t* XB; float* ssq_out; int K_TILES;
    __device__ __forceinline__ void operator()(const f32x4 (&acc)[2][2][4][2], const Unit& u, int wr, int wc, int fr, int fq) const {
        const int row0 = u.pm * BM + wr * 64 + fr, col0 = u.pn * BM + wc * 32 + 8 * fq;
        if (u.pm == MTOK / BM && u.kn != K_TILES) {
            if (wr == 0) {
#pragma unroll
                for (int m = 0; m < 4; ++m) { float* hp = Hmeta + (size_t)(m * 16 + fr) * DM + col0;
#pragma unroll
                    for (int bj = 0; bj < 2; ++bj)
#pragma unroll
                        for (int n = 0; n < 2; ++n)
#pragma unroll
                            for (int j = 0; j < 4; ++j) atomicAdd(hp + bj * HALF + 4 * n + j, acc[0][bj][m][n][j]); } }
            return; }
        float* H = u.pm < MTOK / BM ? Htok : Hmeta - (size_t)MTOK * DM;
#pragma unroll
        for (int ai = 0; ai < 2; ++ai)
#pragma unroll
            for (int m = 0; m < 4; ++m) { const int r = row0 + ai * HALF + m * 16; float* hp = H + (size_t)r * DM + col0; bf16_t* xp = XB + (size_t)r * DM + col0; float s = 0.f;
#pragma unroll
                for (int bj = 0; bj < 2; ++bj) { const f32x4 v0 = *(const f32x4*)(hp + bj * HALF) + acc[ai][bj][m][0], v1 = *(const f32x4*)(hp + bj * HALF + 4) + acc[ai][bj][m][1];
                    *(f32x4*)(hp + bj * HALF) = v0; *(f32x4*)(hp + bj * HALF + 4) = v1; *(u32x4*)(xp + bj * HALF) = pack8(v0, v1);
                    s += (v0[0] * v0[0] + v0[1] * v0[1]) + (v0[2] * v0[2] + v0[3] * v0[3]) + (v1[0] * v1[0] + v1[1] * v1[1]) + (v1[2] * v1[2] + v1[3] * v1[3]); }
                s += __shfl_xor(s, 16); s += __shfl_xor(s, 32);
                if (fq == 0) atomicAdd(ssq_out + r, s);
                asm volatile("" ::: "memory"); }
    }
};
struct EpiFinal {
    static constexpr bool PERM = true, AFTER_DRAIN = false;
    float* OUT;
    __device__ __forceinline__ void operator()(const f32x4 (&acc)[2][2][4][2], const Unit& u, int wr, int wc, int fr, int fq) const {
        const int row0 = u.pm * BM + wr * 64 + fr, col0 = u.pn * BM + wc * 32 + 8 * fq;
#pragma unroll
        for (int ai = 0; ai < 2; ++ai)
#pragma unroll
            for (int m = 0; m < 4; ++m) { const int r = row0 + ai * HALF + m * 16; float* op = OUT + (size_t)r * DM + col0; const float* hp = op;
#pragma unroll
                for (int bj = 0; bj < 2; ++bj) { const f32x4 v0 = *(const f32x4*)(hp + bj * HALF) + acc[ai][bj][m][0], v1 = *(const f32x4*)(hp + bj * HALF + 4) + acc[ai][bj][m][1];
                    *(f32x4*)(op + bj * HALF) = v0; *(f32x4*)(op + bj * HALF + 4) = v1; }
                asm volatile("" ::: "memory"); }
    }
};
struct EpiGU {
    static constexpr bool PERM = true, AFTER_DRAIN = false;
    bf16_t* HID; const float* ssq;
    __device__ __forceinline__ void operator()(const f32x4 (&acc)[2][2][4][2], const Unit& u, int wr, int wc, int fr, int fq) const {
        const int row0 = u.pm * BM + wr * 64 + fr, col0 = u.pn * HALF + wc * 32 + 8 * fq;
#pragma unroll
        for (int ai = 0; ai < 2; ++ai)
#pragma unroll
            for (int m = 0; m < 4; ++m) { const int r = row0 + ai * HALF + m * 16; const float rs = row_rstd(ssq, r); f32x4 o[2];
#pragma unroll
                for (int n = 0; n < 2; ++n)
#pragma unroll
                    for (int j = 0; j < 4; ++j) { const float g = acc[ai][0][m][n][j] * rs, uu = acc[ai][1][m][n][j] * rs;
                        o[n][j] = g * uu * __builtin_amdgcn_rcpf(1.0f + __expf(-g)); }
                *(u32x4*)(HID + (size_t)r * DFF + col0) = pack8(o[0], o[1]); }
    }
};
struct EpiIn1 {
    static constexpr bool PERM = true, AFTER_DRAIN = false;
    bf16_t* Z; const float* ssq;
    __device__ __forceinline__ void operator()(const f32x4 (&acc)[2][2][4][2], const Unit& u, int wr, int wc, int fr, int fq) const {
        const int row0 = u.pm * BM + wr * 64 + fr, col0 = u.pn * BM + wc * 32 + 8 * fq;
        if (u.pn < 32) {
            const float sc = u.pn < 16 ? 1.0f : 0.0625f;
            float inv[2][4];
#pragma unroll
            for (int n = 0; n < 2; ++n)
#pragma unroll
                for (int j = 0; j < 4; ++j) inv[n][j] = exp2f(-(float)(wc * 32 + 8 * fq + 4 * n + j) * (13.287712379549449f / 128.0f));
#pragma unroll
            for (int ai = 0; ai < 2; ++ai)
#pragma unroll
                for (int m = 0; m < 4; ++m) { const int r = row0 + ai * HALF + m * 16; const float rs = row_rstd(ssq, r) * sc;
                    const float t = (float)(r < MTOK ? NMETA + (r & (SEQ - 1)) : ((r - MTOK) & 15));
                    f32x4 o1[2], o2[2];
#pragma unroll
                    for (int n = 0; n < 2; ++n)
#pragma unroll
                        for (int j = 0; j < 4; ++j) { const float x1 = acc[ai][0][m][n][j] * rs, x2 = acc[ai][1][m][n][j] * rs;
                            const float ang = t * inv[n][j]; float rev = ang * 0.15915494309189535f; rev = rev - floorf(rev);
                            const float c = __builtin_amdgcn_cosf(rev), s = __builtin_amdgcn_sinf(rev);
                            o1[n][j] = x1 * c - x2 * s; o2[n][j] = x1 * s + x2 * c; }
                    bf16_t* rowp = Z + (size_t)r * RET_IN + col0;
                    *(u32x4*)(rowp) = pack8(o1[0], o1[1]); *(u32x4*)(rowp + HALF) = pack8(o2[0], o2[1]); }
        } else {
#pragma unroll
            for (int ai = 0; ai < 2; ++ai)
#pragma unroll
                for (int m = 0; m < 4; ++m) { const int r = row0 + ai * HALF + m * 16; const float rs = row_rstd(ssq, r); bf16_t* rowp = Z + (size_t)r * RET_IN + col0;
#pragma unroll
                    for (int bj = 0; bj < 2; ++bj) *(u32x4*)(rowp + bj * HALF) = pack8(acc[ai][bj][m][0] * rs, acc[ai][bj][m][1] * rs); }
        }
    }
};

template <class Epi, class Sched, bool ALIGN_EPI = false, bool SP2 = false>
__device__ __forceinline__ void gemm_phase(PG8_LAS unsigned char* lds, const Gemm g, const Sched& S, const Epi& E) {
    const int tid = threadIdx.x, wid = __builtin_amdgcn_readfirstlane(tid >> 6), lane = tid & 63, wr = wid >> 2, wc = wid & 3, fr = lane & 15, fq = lane >> 4;
    const int K = g.K; int nt;
    unsigned voffA[2], voffB[2];
#pragma unroll
    for (int i = 0; i < 2; ++i) { int R, C; stage_rc(tid * 16 + i * 8192, R, C); const int Rb = Epi::PERM ? ((R & ~31) + perm32(R & 31)) : R;
        voffA[i] = (unsigned)(R * K + C) * 2u; voffB[i] = (unsigned)(Rb * K + C) * 2u; }
    const size_t kstep = (size_t)(BK * 2);
    const size_t hstep = (size_t)HALF * K * 2;
    const size_t tstep = 2 * hstep;
    const unsigned ldsw = (unsigned)wid * 1024u;
    const int aoff = lds_byte(wr * 64 + fr, fq * 8), boff = lds_byte(wc * 32 + fr, fq * 8);
#define PG8_SA(b, h) (((b) * 2 + (h)) * HTB)
#define PG8_SB(b, h) ((4 + (b) * 2 + (h)) * HTB)
#define PG8_STAGE(bufoff, gbase, voff) do { _Pragma("unroll") for (int _i = 0; _i < 2; ++_i) \
        __builtin_amdgcn_global_load_lds((const unsigned*)((const char*)(gbase) + (voff)[_i]), (PG8_LAS unsigned*)(lds + (bufoff) + ldsw + _i * 8192), 16, 0, 0); } while (0)
#define PG8_LDA(dst, b, h) do { _Pragma("unroll") for (int m = 0; m < 4; ++m) _Pragma("unroll") for (int k = 0; k < 2; ++k) dst[m][k] = *(const PG8_LAS bf16x8*)(lds + PG8_SA(b, h) + aoff + m * 2048 + k * 1024); } while (0)
#define PG8_LDB(dst, b, h) do { _Pragma("unroll") for (int n = 0; n < 2; ++n) _Pragma("unroll") for (int k = 0; k < 2; ++k) dst[n][k] = *(const PG8_LAS bf16x8*)(lds + PG8_SB(b, h) + boff + n * 2048 + k * 1024); } while (0)
#define PG8_MMA(ai, bj, At, Bt) do { __builtin_amdgcn_s_setprio(1); _Pragma("unroll") for (int m = 0; m < 4; ++m) _Pragma("unroll") for (int n = 0; n < 2; ++n) _Pragma("unroll") for (int k = 0; k < 2; ++k) \
        acc[ai][bj][m][n] = __builtin_amdgcn_mfma_f32_16x16x32_bf16(Bt[n][k], At[m][k], acc[ai][bj][m][n], 0, 0, 0); __builtin_amdgcn_s_setprio(0); } while (0)
#define PG8_WAIT_V(n) asm volatile("s_waitcnt vmcnt(" #n ")" ::: "memory")
#define PG8_WAIT_L(n) asm volatile("s_waitcnt lgkmcnt(" #n ")" ::: "memory")
#define PG8_BAR __builtin_amdgcn_s_barrier()
#define PG8_SCHED __builtin_amdgcn_sched_barrier(0)
    Unit cur, nxt; int ui = 0;
    if (!S.next(0, cur)) return;
    nt = cur.kn;
    f32x4 acc[2][2][4][2];
#pragma unroll
    for (int a = 0; a < 2; ++a)
#pragma unroll
        for (int b = 0; b < 2; ++b)
#pragma unroll
            for (int m = 0; m < 4; ++m)
#pragma unroll
                for (int n = 0; n < 2; ++n) acc[a][b][m][n] = (f32x4){0.f, 0.f, 0.f, 0.f};
    bf16x8 At[4][2], B0[2][2], B1[2][2];
    const char* cA = (const char*)g.A + (size_t)cur.pm * tstep + (size_t)cur.kb * kstep; const char* cB = (const char*)g.Bt + (size_t)cur.pn * tstep + (size_t)cur.kb * kstep;
    S.a_ready(cur);
    if constexpr (SP2) {
        PG8_STAGE(PG8_SB(0, 0), cB, voffB); PG8_STAGE(PG8_SB(0, 1), cB + hstep, voffB); PG8_STAGE(PG8_SA(0, 0), cA, voffA); PG8_STAGE(PG8_SA(0, 1), cA + hstep, voffA);
        if (wr == 1) PG8_BAR;
        PG8_WAIT_V(2); PG8_BAR;
        PG8_STAGE(PG8_SB(1, 0), cB + kstep, voffB); PG8_STAGE(PG8_SA(1, 0), cA + kstep, voffA); PG8_STAGE(PG8_SB(1, 1), cB + hstep + kstep, voffB);
        PG8_WAIT_V(6); PG8_BAR;
    } else {
        PG8_STAGE(PG8_SB(0, 0), cB, voffB); PG8_STAGE(PG8_SA(0, 0), cA, voffA); PG8_STAGE(PG8_SB(0, 1), cB + hstep, voffB); PG8_STAGE(PG8_SA(0, 1), cA + hstep, voffA);
        if (wr == 1) PG8_BAR;
        PG8_WAIT_V(4); PG8_BAR;
        PG8_STAGE(PG8_SB(1, 0), cB + kstep, voffB); PG8_STAGE(PG8_SA(1, 0), cA + kstep, voffA); PG8_STAGE(PG8_SB(1, 1), cB + hstep + kstep, voffB);
        PG8_WAIT_V(6); PG8_BAR;
    }
    for (;;) {
        const bool has_next = S.next(ui + 1, nxt);
        const char* nA = has_next ? (const char*)g.A + (size_t)nxt.pm * tstep + (size_t)nxt.kb * kstep : cA; const char* nB = has_next ? (const char*)g.Bt + (size_t)nxt.pn * tstep + (size_t)nxt.kb * kstep : cB;
        for (int t = 0; t < nt; t += 2) {
            const bool last = (t == nt - 2);
            const char* a1 = cA + (size_t)(t + 1) * kstep;
            const char* a2 = last ? nA : cA + (size_t)(t + 2) * kstep; const char* b2 = last ? nB : cB + (size_t)(t + 2) * kstep;
            const char* a3 = a2 + kstep; const char* b3 = b2 + kstep;
            if (last && has_next) S.a_ready(nxt);
            if constexpr (SP2) {
            PG8_LDB(B0, 0, 0); PG8_LDB(B1, 0, 1); PG8_SCHED; PG8_LDA(At, 0, 0); PG8_STAGE(PG8_SA(1, 1), a1 + hstep, voffA);
            PG8_WAIT_V(8); PG8_WAIT_L(0); PG8_BAR; PG8_MMA(0, 0, At, B0); PG8_MMA(0, 1, At, B1); PG8_BAR; PG8_SCHED;
            PG8_LDA(At, 0, 1); PG8_STAGE(PG8_SB(0, 0), b2, voffB); PG8_STAGE(PG8_SB(0, 1), b2 + hstep, voffB); PG8_STAGE(PG8_SA(0, 0), a2, voffA);
            PG8_WAIT_V(8); PG8_WAIT_L(0); PG8_BAR; PG8_MMA(1, 0, At, B0); PG8_MMA(1, 1, At, B1); PG8_BAR; PG8_SCHED;
            PG8_LDB(B0, 1, 0); PG8_LDB(B1, 1, 1); PG8_SCHED; PG8_LDA(At, 1, 0); PG8_STAGE(PG8_SA(0, 1), a2 + hstep, voffA);
            PG8_WAIT_V(8); PG8_WAIT_L(0); PG8_BAR; PG8_MMA(0, 0, At, B0); PG8_MMA(0, 1, At, B1); PG8_BAR; PG8_SCHED;
            PG8_LDA(At, 1, 1); PG8_STAGE(PG8_SB(1, 0), b3, voffB); PG8_STAGE(PG8_SB(1, 1), b3 + hstep, voffB); PG8_STAGE(PG8_SA(1, 0), a3, voffA);
            PG8_WAIT_V(8); PG8_WAIT_L(0); PG8_BAR; PG8_MMA(1, 0, At, B0); PG8_MMA(1, 1, At, B1); PG8_BAR; PG8_SCHED;
            } else {
            PG8_LDB(B0, 0, 0); PG8_SCHED; PG8_LDA(At, 0, 0); PG8_STAGE(PG8_SA(1, 1), a1 + hstep, voffA);
            PG8_WAIT_L(8); PG8_BAR; PG8_WAIT_L(0); PG8_MMA(0, 0, At, B0); PG8_BAR; PG8_SCHED;
            PG8_LDB(B1, 0, 1); PG8_STAGE(PG8_SB(0, 0), b2, voffB);
            PG8_BAR; PG8_WAIT_L(0); PG8_MMA(0, 1, At, B1); PG8_BAR;
            PG8_LDA(At, 0, 1); PG8_STAGE(PG8_SA(0, 0), a2, voffA);
            PG8_BAR; PG8_WAIT_L(0); PG8_MMA(1, 0, At, B0); PG8_BAR; PG8_SCHED;
            PG8_STAGE(PG8_SB(0, 1), b2 + hstep, voffB);
            PG8_WAIT_V(6); PG8_BAR; PG8_MMA(1, 1, At, B1); PG8_BAR;
            PG8_LDB(B0, 1, 0); PG8_SCHED; PG8_LDA(At, 1, 0); PG8_STAGE(PG8_SA(0, 1), a2 + hstep, voffA);
            PG8_WAIT_L(8); PG8_BAR; PG8_WAIT_L(0); PG8_MMA(0, 0, At, B0); PG8_BAR; PG8_SCHED;
            PG8_LDB(B1, 1, 1); PG8_STAGE(PG8_SB(1, 0), b3, voffB);
            PG8_BAR; PG8_WAIT_L(0); PG8_MMA(0, 1, At, B1); PG8_BAR;
            PG8_LDA(At, 1, 1); PG8_STAGE(PG8_SA(1, 0), a3, voffA);
            PG8_BAR; PG8_WAIT_L(0); PG8_MMA(1, 0, At, B0); PG8_BAR; PG8_SCHED;
            PG8_STAGE(PG8_SB(1, 1), b3 + hstep, voffB);
            PG8_WAIT_V(6); PG8_BAR; PG8_MMA(1, 1, At, B1); PG8_BAR;
            }
        }
        if constexpr (ALIGN_EPI) { if (wr == 0) PG8_BAR; }
        if constexpr (!Epi::AFTER_DRAIN) { E(acc, cur, wr, wc, fr, fq); S.done(cur); }
        if (!has_next) break;
#pragma unroll
        for (int a = 0; a < 2; ++a)
#pragma unroll
            for (int b = 0; b < 2; ++b)
#pragma unroll
                for (int m = 0; m < 4; ++m)
#pragma unroll
                    for (int n = 0; n < 2; ++n) acc[a][b][m][n] = (f32x4){0.f, 0.f, 0.f, 0.f};
        cur = nxt; cA = nA; cB = nB; ++ui; nt = cur.kn;
        if constexpr (ALIGN_EPI) { if (wr == 1) PG8_BAR; }
    }
    PG8_WAIT_V(0);
    if constexpr (!ALIGN_EPI) { if (wr == 0) PG8_BAR; }
    PG8_BAR;
    if constexpr (Epi::AFTER_DRAIN) { E.fused(acc, cur, wr, wc, fr, fq, lds, wid, lane); S.done(cur); }
#undef PG8_SA
#undef PG8_SB
#undef PG8_STAGE
#undef PG8_LDA
#undef PG8_LDB
#undef PG8_MMA
#undef PG8_WAIT_V
#undef PG8_WAIT_L
#undef PG8_BAR
#undef PG8_SCHED
}
}

constexpr size_t MiB = 1u << 20;
constexpr size_t WS_CTL = 0, CTL_ZERO_BYTES = 2 * MiB;
constexpr size_t WS_SSQ1 = 64 * 1024, WS_SSQ2 = 192 * 1024, WS_SSQ3 = 320 * 1024, WS_SSQO = 512 * 1024;
constexpr size_t WS_SSQ0 = 2 * MiB;
constexpr size_t WS_FBUF = 2 * MiB + 512 * 1024;
constexpr size_t WS_HMETA = 4 * MiB;
constexpr size_t WS_WIN0 = 8 * MiB, WS_WOUT0 = 90 * MiB, WS_WGU0 = 122 * MiB, WS_WD0 = 294 * MiB, WS_WIN1 = 380 * MiB, WS_WOUT1 = 572 * MiB, WS_WGU1 = 636 * MiB, WS_WD1 = 808 * MiB;
constexpr size_t WS_WAT = 894 * MiB, WS_WXT = WS_WAT + 512 * 1024;
constexpr size_t WS_XB = 896 * MiB, WS_Z = 1026 * MiB, WS_END = 1806 * MiB;
constexpr size_t WS_Y0 = WS_Z + 400 * MiB;
constexpr size_t WS_Y1 = 8 * MiB;
static_assert(WS_SSQO + (size_t)MP * 16 * 4 <= CTL_ZERO_BYTES && WS_FBUF + (size_t)MP * 16 * 4 <= WS_HMETA && WS_HMETA + (size_t)256 * DM * 4 <= WS_WIN0, "ctl map");
static_assert(WS_WIN0 + (size_t)41 * 256 * DM * 2 <= WS_WOUT0 && WS_WGU0 + (size_t)2 * DFF * DM * 2 <= WS_WD0 && WS_WD0 + (size_t)DM * DFF * 2 <= WS_WIN1 && WS_WIN1 + (size_t)RET_IN * DM * 2 <= WS_WOUT1, "weight map");
static_assert(WS_WOUT1 + (size_t)DM * RET_VW * 2 <= WS_WGU1 && WS_WGU1 + (size_t)2 * DFF * DM * 2 <= WS_WD1 && WS_WD1 + (size_t)DM * DFF * 2 <= WS_WAT, "weight map 2");
static_assert(WS_XB + (size_t)MP * DM * 2 <= WS_Z && WS_Z + (size_t)MP * RET_IN * 2 <= WS_END && WS_Z + (size_t)MP * AB_Z * 2 <= WS_Y0 && WS_Z + (size_t)MP * DFF * 2 <= WS_Y0 && WS_Y0 + (size_t)MP * DM * 2 <= WS_END && WS_Y1 + (size_t)MP * RET_VW * 2 <= WS_WD0, "activation map");
constexpr int CW_TMO = 0, CW_Q2 = 64, CW_TK3 = 256, CW_TK5 = 320, CW_BAR = 4096;
constexpr int RING_BYTES = 131072;
constexpr int LDS_BYTES = 147456;
constexpr int MISC_OFF = LDS_BYTES - 256;
constexpr int NWAVES = 8, NTHREADS = 512;
constexpr int NPHASES = 12;

#define GAS __attribute__((address_space(1)))
#define LAS __attribute__((address_space(3)))
typedef unsigned short bf16;
typedef unsigned v4u __attribute__((ext_vector_type(4)));
typedef unsigned v2u __attribute__((ext_vector_type(2)));
typedef float f32x4 __attribute__((ext_vector_type(4)));
typedef short bf16x8 __attribute__((ext_vector_type(8)));
typedef short bf16x4 __attribute__((ext_vector_type(4)));
typedef GAS unsigned gu32;
#define RLX_AGENT __ATOMIC_RELAXED, __HIP_MEMORY_SCOPE_AGENT
#define LDS_WAIT() asm volatile("s_waitcnt lgkmcnt(0)" ::: "memory")
#define VM_WAIT() asm volatile("s_waitcnt vmcnt(0)" ::: "memory")
__device__ __forceinline__ unsigned f2bf(float f) { unsigned u = __builtin_bit_cast(unsigned, f); return (u + 0x7fffu + ((u >> 16) & 1u)) >> 16; }
__device__ __forceinline__ unsigned pk2(float lo, float hi) { return pg8::cvt_pk_bf16(lo, hi); }
__device__ __forceinline__ float bflo(unsigned w) { return __builtin_bit_cast(float, w << 16); }
__device__ __forceinline__ float bfhi(unsigned w) { return __builtin_bit_cast(float, w & 0xffff0000u); }
__device__ __forceinline__ float bf2f(unsigned short h) { return __builtin_bit_cast(float, (unsigned)h << 16); }
__device__ __forceinline__ void unpack8(const v4u w, float (&f)[8]) { f[0] = bflo(w.x); f[1] = bfhi(w.x); f[2] = bflo(w.y); f[3] = bfhi(w.y); f[4] = bflo(w.z); f[5] = bfhi(w.z); f[6] = bflo(w.w); f[7] = bfhi(w.w); }
__device__ __forceinline__ v4u pack8f(const float (&f)[8]) { v4u w; w.x = pk2(f[0], f[1]); w.y = pk2(f[2], f[3]); w.z = pk2(f[4], f[5]); w.w = pk2(f[6], f[7]); return w; }
__device__ __forceinline__ int row_of(int b, int t) { return t < NMETA ? MMETA + NMETA * b + t : b * SEQ + (t - NMETA); }
__device__ __forceinline__ f32x4 mfma16(bf16x8 a, bf16x8 b, f32x4 c) { return __builtin_amdgcn_mfma_f32_16x16x32_bf16(a, b, c, 0, 0, 0); }

#define XB_TMO      128
#define XB_XCNT(j)  (256  + 64 * (j))
#define XB_XSUB(j)  (1280 + 64 * (j))
#define XB_XGEN(j)  (2304 + 64 * (j))
#define XB_TOP      3328
#define XB_TOPGEN   3392
#define XCD_BAR_WORDS 3456
#define XB_SPIN_CAP (1u << 22)

__device__ __forceinline__ unsigned xb_ld(unsigned* p)              { return __hip_atomic_load(p, __ATOMIC_RELAXED, __HIP_MEMORY_SCOPE_AGENT); }
__device__ __forceinline__ unsigned xb_add(unsigned* p, unsigned v) { return __hip_atomic_fetch_add(p, v, __ATOMIC_RELAXED, __HIP_MEMORY_SCOPE_AGENT); }
__device__ __forceinline__ unsigned xb_xcc_id() { return (unsigned)__builtin_amdgcn_s_getreg((3 << 11) | 20) & 0xFu; }
#define XB_SPIN(cond, bar) do { unsigned _sp = 0; while (cond) { __builtin_amdgcn_s_sleep(1); \
    if ((++_sp & 255u) == 0u) { if (xb_ld(&(bar)[XB_TMO])) break; if (_sp > XB_SPIN_CAP) { atomicAdd(&(bar)[XB_TMO], 1u); break; } } } } while (0)

struct XcdBarrier {
    unsigned* bar; unsigned x;
    volatile LAS unsigned* st;
};
__device__ __forceinline__ XcdBarrier xcd_barrier_post(unsigned* bar, volatile LAS unsigned* st) {
    XcdBarrier b; b.bar = bar; b.x = xb_xcc_id(); b.st = st;
    if (threadIdx.x == 0) (void)xb_add(&bar[XB_XCNT(b.x)], 1u);
    return b;
}
__device__ __forceinline__ void xcd_barrier_complete(unsigned* bar, unsigned x, unsigned& nloc, unsigned& nx) {
    const unsigned G = gridDim.x * gridDim.y * gridDim.z;
    unsigned sum, cnt, mine, sp = 0u;
    for (;;) {
        sum = 0u; cnt = 0u; mine = 0u;
#pragma unroll
        for (unsigned j = 0; j < 16; ++j) { const unsigned c = xb_ld(&bar[XB_XCNT(j)]); sum += c; cnt += (c > 0u) ? 1u : 0u; mine = (j == x) ? c : mine; }
        if (sum == G) break;
        __builtin_amdgcn_s_sleep(1);
        if ((++sp & 255u) == 0u) { if (xb_ld(&bar[XB_TMO])) break; if (sp > XB_SPIN_CAP) { atomicAdd(&bar[XB_TMO], 1u); break; } }
    }
    nloc = mine > 0u ? mine : 1u; nx = cnt > 0u ? cnt : 1u;
}
__device__ __forceinline__ void xcd_barrier(const XcdBarrier& b) {
    asm volatile("s_waitcnt vmcnt(0)" ::: "memory");
    __syncthreads();
    if (threadIdx.x == 0) {
        unsigned* bar = b.bar;
        __builtin_amdgcn_s_waitcnt(0);
        unsigned nloc = b.st[0], nx = b.st[1];
        if (nloc == 0u) { xcd_barrier_complete(bar, b.x, nloc, nx); b.st[0] = nloc; b.st[1] = nx; }
        const unsigned old = xb_add(&bar[XB_XSUB(b.x)], 1u);
        const unsigned gen = old / nloc;
        if (old + 1u == (gen + 1u) * nloc) {
            __builtin_amdgcn_fence(__ATOMIC_RELEASE, "agent");
            asm volatile("s_waitcnt vmcnt(0)" ::: "memory");
            const unsigned og = xb_add(&bar[XB_TOP], 1u);
            const unsigned tg = og / nx;
            if (og + 1u == (tg + 1u) * nx) xb_add(&bar[XB_TOPGEN], 1u);
            else XB_SPIN(xb_ld(&bar[XB_TOPGEN]) == tg, bar);
            __builtin_amdgcn_fence(__ATOMIC_ACQUIRE, "agent");
            xb_add(&bar[XB_XGEN(b.x)], 1u);
            asm volatile("s_waitcnt vmcnt(0)" ::: "memory");
        } else {
            XB_SPIN(xb_ld(&bar[XB_XGEN(b.x)]) == gen, bar);
            __builtin_amdgcn_fence(__ATOMIC_ACQUIRE, "agent");
            asm volatile("s_waitcnt vmcnt(0)" ::: "memory");
        }
    }
    __syncthreads();
}

struct Args { const float* in[23]; float* out; unsigned char* ws; int ph_lo, ph_hi; };
__device__ __forceinline__ float* h_row(float* out, unsigned char* ws, int r) { return r < MTOK ? out + (size_t)r * DM : (float*)(ws + WS_HMETA) + (size_t)(r - MTOK) * DM; }
struct Frame {
    LAS unsigned char* lds;
    volatile LAS unsigned* MISC;
    unsigned char* ws;
    int tid, lane, wave, G;
};
__device__ __forceinline__ float wave_sum(float v) {
#pragma unroll
    for (int o = 1; o < 64; o <<= 1) v += __shfl_xor(v, o);
    return v;
}

template <int MODE, int KC>
__device__ __forceinline__ void p0_tr(const float* W, int K, int N, const float* gain, bf16* WT, int item, int lane) {
    const int nnb = (N + 255) / 256, kc = item / nnb, nb = item - kc * nnb, k0 = kc * KC;
    const int n = nb * 256 + 4 * lane; const bool ok = n < N;
    const int d0 = MODE == 0 ? n : (MODE == 1 ? 256 * (n >> 7) + (n & 127) : 256 * (n >> 7) + 128 + (n & 127));
    const float* src = W + (size_t)k0 * N + (ok ? n : 0); bf16* dst = WT + (size_t)d0 * K + k0;
    f32x4 va[8], vb[8];
#define P0_LOAD(v, k8) do { _Pragma("unroll") for (int j = 0; j < 8; ++j) v[j] = *(const GAS f32x4*)(src + (size_t)((k8) * 8 + j) * N); } while (0)
#define P0_STORE(v, k8) do { if (gain) { _Pragma("unroll") for (int j = 0; j < 8; ++j) v[j] *= gain[k0 + (k8) * 8 + j]; } \
        if (ok) { _Pragma("unroll") for (int c = 0; c < 4; ++c) { v4u o; o.x = pk2(v[0][c], v[1][c]); o.y = pk2(v[2][c], v[3][c]); o.z = pk2(v[4][c], v[5][c]); o.w = pk2(v[6][c], v[7][c]); \
            *(GAS v4u*)(dst + (size_t)c * K + (k8) * 8) = o; } } } while (0)
    P0_LOAD(va, 0);
    for (int k8 = 0; k8 < KC / 8; k8 += 2) {
        P0_LOAD(vb, k8 + 1);
        P0_STORE(va, k8);
        if (k8 + 2 < KC / 8) P0_LOAD(va, k8 + 2);
        P0_STORE(vb, k8 + 1);
    }
#undef P0_LOAD
#undef P0_STORE
}
__device__ __forceinline__ void p0_row(Frame& F, const float* x, const float* meta, float* out, int r) {
    float* hrow = h_row(out, F.ws, r); bf16* xrow = (bf16*)(F.ws + WS_XB) + (size_t)r * DM;
    const float* src = r < MTOK ? x + (size_t)r * DM : meta + (size_t)((r - MTOK) & 15) * DM;
    const bool pad = r >= MTOK + NB * NMETA;
    float s = 0.f;
#pragma unroll 4
    for (int j = 0; j < 16; ++j) { const int e = (F.lane + 64 * j) * 4;
        f32x4 v = pad ? (f32x4){0.f, 0.f, 0.f, 0.f} : *(const GAS f32x4*)(src + e);
        s += (v.x * v.x + v.y * v.y) + (v.z * v.z + v.w * v.w);
        *(GAS f32x4*)(hrow + e) = v; v2u w; w.x = pk2(v.x, v.y); w.y = pk2(v.z, v.w); *(GAS v2u*)(xrow + e) = w; }
    s = wave_sum(s);
    if (F.lane == 0) ((float*)(F.ws + WS_SSQ0))[r] = s;
}
__device__ __forceinline__ void p0_prologue(Frame& F, const Args& A) {
    const int gw = __builtin_amdgcn_readfirstlane(blockIdx.x * NWAVES + F.wave), NGW = F.G * NWAVES;
    unsigned char* ws = F.ws;
    constexpr int KC = 128;
    constexpr int I_IN0 = 41 * (DM / KC), I_SQ = 16 * (DM / KC), I_G = 43 * (DM / KC), I_D = 16 * (DFF / KC), I_IN1 = 96 * (DM / KC), I_O1 = 16 * (RET_VW / KC), I_BD = 16 * 1;
    constexpr int NITEMS = I_IN0 + I_SQ + 2 * (2 * I_G + I_D) + I_IN1 + I_O1 + 2 * I_BD;
    for (int it = gw; it < NITEMS; it += NGW) {
        int r = it;
        if (r < I_IN0) { p0_tr<0, KC>(A.in[3], DM, AB_IN, A.in[2], (bf16*)(ws + WS_WIN0), r, F.lane); continue; } r -= I_IN0;
        if (r < I_SQ) { p0_tr<0, KC>(A.in[14], DM, DM, nullptr, (bf16*)(ws + WS_WOUT0), r, F.lane); continue; } r -= I_SQ;
        if (r < I_G) { p0_tr<1, KC>(A.in[20], DM, DFF, A.in[19], (bf16*)(ws + WS_WGU0), r, F.lane); continue; } r -= I_G;
        if (r < I_G) { p0_tr<2, KC>(A.in[21], DM, DFF, A.in[19], (bf16*)(ws + WS_WGU0), r, F.lane); continue; } r -= I_G;
        if (r < I_D) { p0_tr<0, KC>(A.in[22], DFF, DM, nullptr, (bf16*)(ws + WS_WD0), r, F.lane); continue; } r -= I_D;
        if (r < I_IN1) { p0_tr<0, KC>(A.in[16], DM, RET_IN, A.in[15], (bf16*)(ws + WS_WIN1), r, F.lane); continue; } r -= I_IN1;
        if (r < I_O1) { p0_tr<0, KC>(A.in[18], RET_VW, DM, nullptr, (bf16*)(ws + WS_WOUT1), r, F.lane); continue; } r -= I_O1;
        if (r < I_G) { p0_tr<1, KC>(A.in[20] + (size_t)DM * DFF, DM, DFF, A.in[19] + DM, (bf16*)(ws + WS_WGU1), r, F.lane); continue; } r -= I_G;
        if (r < I_G) { p0_tr<2, KC>(A.in[21] + (size_t)DM * DFF, DM, DFF, A.in[19] + DM, (bf16*)(ws + WS_WGU1), r, F.lane); continue; } r -= I_G;
        if (r < I_D) { p0_tr<0, KC>(A.in[22] + (size_t)DFF * DM, DFF, DM, nullptr, (bf16*)(ws + WS_WD1), r, F.lane); continue; } r -= I_D;
        if (r < I_BD) { const int blk = r; p0_tr<0, KC>(A.in[7] + (size_t)blk * 16384, 128, 128, nullptr, (bf16*)(ws + WS_WAT) + (size_t)blk * 16384, 0, F.lane); continue; } r -= I_BD;
        { const int blk = r; p0_tr<0, KC>(A.in[9] + (size_t)blk * 16384, 128, 128, nullptr, (bf16*)(ws + WS_WXT) + (size_t)blk * 16384, 0, F.lane); }
    }
    for (int m = gw; m < MP; m += NGW) p0_row(F, A.in[0], A.in[1], A.out, m);
}

__device__ __forceinline__ float sigmoidf_fast(float x) { return __builtin_amdgcn_rcpf(1.0f + __expf(-x)); }
__device__ __forceinline__ float gelu_tanh(float g) { const float z = 0.7978845608028654f * (g + 0.044715f * g * g * g); const float e = __expf(2.0f * z); return 0.5f * g * (2.0f - 2.0f * __builtin_amdgcn_rcpf(e + 1.0f)); }

constexpr int LRU_XA = 0, LRU_XA_STRIDE = 272, LRU_XF = 17408, LRU_XF_STRIDE = 132  , LRU_SA = 51200, LRU_SB = 83968, LRU_CARRY = 116736;
__device__ __forceinline__ void lru_item(Frame& F, const Args& A, int b, int n) {
    const bf16* z0 = (const bf16*)(F.ws + WS_Z); bf16* y0 = (bf16*)(F.ws + WS_Y0);
    const int tid = F.tid, lane = F.lane, w = F.wave, fr = lane & 15, fq = lane >> 4;
    LAS unsigned char* lds = F.lds;
    LAS float* XF = (LAS float*)(lds + LRU_XF); LAS float* SA = (LAS float*)(lds + LRU_SA); LAS float* SB = (LAS float*)(lds + LRU_SB); LAS float* CARRY = (LAS float*)(lds + LRU_CARRY);
    const int c8 = (tid & 15) * 8, r4 = tid >> 4;
    const int ch0 = n * 128 + c8;
    float cw[4][8], cb[8];
#pragma unroll
    for (int e = 0; e < 8; ++e) { cb[e] = A.in[6][ch0 + e];
#pragma unroll
        for (int j = 0; j < 4; ++j) cw[j][e] = A.in[5][j * LRU_W + ch0 + e]; }
    const int dch = n * 128 + 16 * w + fr;
    const float ba = A.in[8][dch], bx = A.in[10][dch];
    const float cneg = -8.0f * log1pf(expf(-A.in[11][dch]));
    bf16x8 bwa[4], bwx[4];
    { const bf16* wat = (const bf16*)(F.ws + WS_WAT) + ((size_t)n * 128 + 16 * w + fr) * 128 + 8 * fq; const bf16* wxt = (const bf16*)(F.ws + WS_WXT) + ((size_t)n * 128 + 16 * w + fr) * 128 + 8 * fq;
#pragma unroll
      for (int ks = 0; ks < 4; ++ks) { bwa[ks] = *(const bf16x8*)(wat + 32 * ks); bwx[ks] = *(const bf16x8*)(wxt + 32 * ks); } }
    if (tid < 128) CARRY[tid] = 0.f;
    for (int tau = 0; tau < 65; ++tau) {
        v4u gv[2];
#pragma unroll
        for (int q = 0; q < 2; ++q) {
            const int rr = r4 + 32 * q, t = 64 * tau + rr - 48;
            float xc[8];
#pragma unroll
            for (int e = 0; e < 8; ++e) xc[e] = cb[e];
            gv[q] = (v4u){0u, 0u, 0u, 0u};
            if (t >= 0) {
                gv[q] = *(const GAS v4u*)(z0 + (size_t)row_of(b, t) * AB_Z + LRU_W + ch0);
#pragma unroll
                for (int j = 0; j < 4; ++j) { const int tj = t - 3 + j;
                    if (tj >= 0) { const v4u xv = *(const GAS v4u*)(z0 + (size_t)row_of(b, tj) * AB_Z + ch0); float xf[8]; unpack8(xv, xf);
#pragma unroll
                        for (int e = 0; e < 8; ++e) xc[e] += cw[j][e] * xf[e]; } }
            }
            *(LAS v4u*)(lds + LRU_XA + rr * LRU_XA_STRIDE + c8 * 2) = pack8f(xc);
            *(LAS f32x4*)(XF + rr * LRU_XF_STRIDE + c8) = (f32x4){xc[0], xc[1], xc[2], xc[3]};
            *(LAS f32x4*)(XF + rr * LRU_XF_STRIDE + c8 + 4) = (f32x4){xc[4], xc[5], xc[6], xc[7]};
        }
        __syncthreads();
        f32x4 accr[4], acci[4];
#pragma unroll
        for (int m = 0; m < 4; ++m) { accr[m] = (f32x4){0.f, 0.f, 0.f, 0.f}; acci[m] = (f32x4){0.f, 0.f, 0.f, 0.f}; }
#pragma unroll
        for (int m = 0; m < 4; ++m)
#pragma unroll
            for (int ks = 0; ks < 4; ++ks) { const bf16x8 a = *(const LAS bf16x8*)(lds + LRU_XA + (16 * m + fr) * LRU_XA_STRIDE + (32 * ks + 8 * fq) * 2);
                accr[m] = mfma16(a, bwa[ks], accr[m]); acci[m] = mfma16(a, bwx[ks], acci[m]); }
#pragma unroll
        for (int m = 0; m < 4; ++m)
#pragma unroll
            for (int g = 0; g < 4; ++g) { const int rr = 16 * m + 4 * fq + g, d = 16 * w + fr;
                const float rg = sigmoidf_fast(accr[m][g] + ba), ig = sigmoidf_fast(acci[m][g] + bx);
                const float la = cneg * rg; const float av = __expf(la); const float mult = sqrtf(fmaxf(1.0f - __expf(2.0f * la), 0.f));
                float bv = mult * (ig * XF[rr * LRU_XF_STRIDE + d]);
                if (tau == 0 && rr < 48) bv = 0.f;
                SA[rr * 128 + d] = av; SB[rr * 128 + d] = bv; }
        __syncthreads();
        if (tid < 128) { float h = CARRY[tid];
#pragma unroll 8
            for (int rr = 0; rr < 64; ++rr) { h = SA[rr * 128 + tid] * h + SB[rr * 128 + tid]; SB[rr * 128 + tid] = h; }
            CARRY[tid] = h; }
        __syncthreads();
#pragma unroll
        for (int q = 0; q < 2; ++q) {
            const int rr = r4 + 32 * q, t = 64 * tau + rr - 48;
            if (t >= 0) { float gf[8], o[8]; unpack8(gv[q], gf);
                const f32x4 h0 = *(const LAS f32x4*)(SB + rr * 128 + c8), h1 = *(const LAS f32x4*)(SB + rr * 128 + c8 + 4);
#pragma unroll
                for (int e = 0; e < 4; ++e) { o[e] = h0[e] * gelu_tanh(gf[e]); o[e + 4] = h1[e] * gelu_tanh(gf[e + 4]); }
                *(GAS v4u*)(y0 + (size_t)row_of(b, t) * DM + ch0) = pack8f(o); }
        }
    }
    __syncthreads();
}

constexpr int AT_KT = 0, AT_KT_STRIDE = 272, AT_VT = 17408, AT_VT_STRIDE = 144, AT_PS = 35840, AT_PS_STRIDE = 144, AT_CUM = 72704, AT_SCAN = 90112;
__device__ __forceinline__ float log_sigmoid(float x) { return fminf(x, 0.f) - log1pf(__expf(-fabsf(x))); }
__device__ __forceinline__ void attn_item(Frame& F, const Args& A, int b, int h, int j) {
    const bf16* z0 = (const bf16*)(F.ws + WS_Z); bf16* y0 = (bf16*)(F.ws + WS_Y0); const float* fbuf = (const float*)(F.ws + WS_FBUF);
    const int tid = F.tid, lane = F.lane, w = F.wave, fr = lane & 15, fq = lane >> 4;
    LAS unsigned char* lds = F.lds;
    LAS float* CUM = (LAS float*)(lds + AT_CUM); LAS float* SCAN = (LAS float*)(lds + AT_SCAN);
    LAS unsigned char* PSw = lds + AT_PS + w * (32 * AT_PS_STRIDE);
    constexpr float LOG2E = 1.4426950408889634f;
    const int nT = NMETA + 256 * j;
    { const float bf_h = A.in[4][h];
      float loc[9]; float run = 0.f;
#pragma unroll
      for (int e = 0; e < 9; ++e) { const int t = 9 * tid + e; float v = 0.f; if (t < nT) v = log_sigmoid(fbuf[(size_t)row_of(b, t) * 16 + h] + bf_h); run += v; loc[e] = run; }
      float inc = run;
#pragma unroll
      for (int o = 1; o < 64; o <<= 1) { const float t = __shfl_up(inc, o); if (lane >= o) inc += t; }
      if (lane == 63) SCAN[w] = inc;
      __syncthreads();
      float off = inc - run;
      for (int k = 0; k < w; ++k) off += SCAN[k];
#pragma unroll
      for (int e = 0; e < 9; ++e) { const int t = 9 * tid + e; if (t < nT) CUM[t + 240] = (off + loc[e]) * LOG2E; }
      if (tid < 240) CUM[tid] = 0.f;
      __syncthreads(); }
    bf16x8 qf[2][4]; float bq[2][4];
    const int ubase = 256 * j + 32 * w;
#pragma unroll
    for (int m = 0; m < 2; ++m) {
        const int u = ubase + 16 * m + fr; const int t = u - 240; const int r = row_of(b, t < 0 ? 0 : t);
        const bf16* qp = z0 + (size_t)r * AB_Z + 4096 + 128 * h + 8 * fq;
        float qv[4][8]; float s = 0.f;
#pragma unroll
        for (int ks = 0; ks < 4; ++ks) { const v4u raw = *(const GAS v4u*)(qp + 32 * ks); unpack8(raw, qv[ks]);
#pragma unroll
            for (int e = 0; e < 8; ++e) s += qv[ks][e] * qv[ks][e]; }
        s += __shfl_xor(s, 16); s += __shfl_xor(s, 32);
        const float rs = (1.0f / sqrtf(s * (1.0f / 128.0f) + RMS_EPS)) * (0.08838834764831845f * LOG2E);
#pragma unroll
        for (int ks = 0; ks < 4; ++ks) { float o[8];
#pragma unroll
            for (int e = 0; e < 8; ++e) o[e] = qv[ks][e] * rs * A.in[12][32 * ks + 8 * fq + e];
            const v4u pk = pack8f(o); qf[m][ks] = __builtin_bit_cast(bf16x8, pk); }
#pragma unroll
        for (int g = 0; g < 4; ++g) bq[m][g] = CUM[ubase + 16 * m + 4 * fq + g];
    }
    f32x4 O[2][8]; float mrow[2][4], lrow[2][4];
#pragma unroll
    for (int m = 0; m < 2; ++m) {
#pragma unroll
        for (int dt = 0; dt < 8; ++dt) O[m][dt] = (f32x4){0.f, 0.f, 0.f, 0.f};
#pragma unroll
        for (int g = 0; g < 4; ++g) { mrow[m][g] = -1e30f; lrow[m][g] = 0.f; } }
    const int imax = 4 * j + 3;
    const int skey = tid >> 3, sdc = (tid & 7) * 16;
    v4u kreg[2], vreg[2];
    { const int t = 64 * 3 + skey - 240; const int r = row_of(b, t < 0 ? 0 : t); const bf16* kp = z0 + (size_t)r * AB_Z + 6144 + 128 * h + sdc; const bf16* vp = z0 + (size_t)r * AB_Z + 8192 + 128 * h + sdc;
      kreg[0] = *(const GAS v4u*)(kp); kreg[1] = *(const GAS v4u*)(kp + 8); vreg[0] = *(const GAS v4u*)(vp); vreg[1] = *(const GAS v4u*)(vp + 8); }
    for (int i = 3; i <= imax; ++i) {
        __syncthreads();
        { float kv[16]; { float a8[8], b8[8]; unpack8(kreg[0], a8); unpack8(kreg[1], b8);
#pragma unroll
            for (int e = 0; e < 8; ++e) { kv[e] = a8[e]; kv[8 + e] = b8[e]; } }
          float s = 0.f;
#pragma unroll
          for (int e = 0; e < 16; ++e) s += kv[e] * kv[e];
          s += __shfl_xor(s, 1); s += __shfl_xor(s, 2); s += __shfl_xor(s, 4);
          const float rs = 1.0f / sqrtf(s * (1.0f / 128.0f) + RMS_EPS);
          float o0[8], o1[8];
          { const f32x4 g0 = *(const GAS f32x4*)(A.in[13] + sdc), g1 = *(const GAS f32x4*)(A.in[13] + sdc + 4), g2 = *(const GAS f32x4*)(A.in[13] + sdc + 8), g3 = *(const GAS f32x4*)(A.in[13] + sdc + 12);
#pragma unroll
          for (int e = 0; e < 4; ++e) { o0[e] = kv[e] * rs * g0[e]; o0[4 + e] = kv[4 + e] * rs * g1[e]; o1[e] = kv[8 + e] * rs * g2[e]; o1[4 + e] = kv[12 + e] * rs * g3[e]; } }
          *(LAS v4u*)(lds + AT_KT + skey * AT_KT_STRIDE + sdc * 2) = pack8f(o0);
          *(LAS v4u*)(lds + AT_KT + skey * AT_KT_STRIDE + sdc * 2 + 16) = pack8f(o1);
          const unsigned vw[8] = {vreg[0].x, vreg[0].y, vreg[0].z, vreg[0].w, vreg[1].x, vreg[1].y, vreg[1].z, vreg[1].w};
#pragma unroll
          for (int e = 0; e < 8; ++e) { *(LAS unsigned short*)(lds + AT_VT + (sdc + 2 * e) * AT_VT_STRIDE + skey * 2) = (unsigned short)(vw[e] & 0xffffu);
              *(LAS unsigned short*)(lds + AT_VT + (sdc + 2 * e + 1) * AT_VT_STRIDE + skey * 2) = (unsigned short)(vw[e] >> 16); } }
        __syncthreads();
        if (i < imax) { const int t = 64 * (i + 1) + skey - 240; const int r = row_of(b, t); const bf16* kp = z0 + (size_t)r * AB_Z + 6144 + 128 * h + sdc; const bf16* vp = z0 + (size_t)r * AB_Z + 8192 + 128 * h + sdc;
            kreg[0] = *(const GAS v4u*)(kp); kreg[1] = *(const GAS v4u*)(kp + 8); vreg[0] = *(const GAS v4u*)(vp); vreg[1] = *(const GAS v4u*)(vp + 8); }
        if (64 * i <= ubase + 31) {
            f32x4 S[2][4];
#pragma unroll
            for (int m = 0; m < 2; ++m)
#pragma unroll
                for (int nt = 0; nt < 4; ++nt) S[m][nt] = (f32x4){0.f, 0.f, 0.f, 0.f};
#pragma unroll
            for (int nt = 0; nt < 4; ++nt)
#pragma unroll
                for (int ks = 0; ks < 4; ++ks) { const bf16x8 kf = *(const LAS bf16x8*)(lds + AT_KT + (16 * nt + fr) * AT_KT_STRIDE + (32 * ks + 8 * fq) * 2);
                    S[0][nt] = mfma16(qf[0][ks], kf, S[0][nt]); S[1][nt] = mfma16(qf[1][ks], kf, S[1][nt]); }
            float bk[4];
#pragma unroll
            for (int nt = 0; nt < 4; ++nt) bk[nt] = CUM[64 * i + 16 * nt + fr];
            const bool need_mask = (i == 3) || (64 * i + 63 > ubase);
            float alpha[2][4];
#pragma unroll
            for (int m = 0; m < 2; ++m)
#pragma unroll
                for (int g = 0; g < 4; ++g) {
                    const int uq = ubase + 16 * m + 4 * fq + g;
                    float mx = -__builtin_inff();
#pragma unroll
                    for (int nt = 0; nt < 4; ++nt) { float sv = S[m][nt][g] + (bq[m][g] - bk[nt]);
                        if (need_mask) { const int uk = 64 * i + 16 * nt + fr; if (uk > uq || uk < 240) sv = -__builtin_inff(); }
                        S[m][nt][g] = sv; mx = fmaxf(mx, sv); }
                    mx = fmaxf(mx, __shfl_xor(mx, 1)); mx = fmaxf(mx, __shfl_xor(mx, 2)); mx = fmaxf(mx, __shfl_xor(mx, 4)); mx = fmaxf(mx, __shfl_xor(mx, 8));
                    const float mn = fmaxf(mrow[m][g], mx);
                    alpha[m][g] = __builtin_amdgcn_exp2f(mrow[m][g] - mn); mrow[m][g] = mn;
                    float ps = 0.f;
#pragma unroll
                    for (int nt = 0; nt < 4; ++nt) { const float p = __builtin_amdgcn_exp2f(S[m][nt][g] - mn); ps += p;
                        *(LAS unsigned short*)(PSw + (16 * m + 4 * fq + g) * AT_PS_STRIDE + (16 * nt + fr) * 2) = (unsigned short)(pk2(p, 0.f) & 0xffffu); }
                    lrow[m][g] = lrow[m][g] * alpha[m][g] + ps;
                }
#pragma unroll
            for (int m = 0; m < 2; ++m)
#pragma unroll
                for (int dt = 0; dt < 8; ++dt)
#pragma unroll
                    for (int g = 0; g < 4; ++g) O[m][dt][g] *= alpha[m][g];
            LDS_WAIT();
            bf16x8 pf[2][2];
#pragma unroll
            for (int m = 0; m < 2; ++m)
#pragma unroll
                for (int k2 = 0; k2 < 2; ++k2) pf[m][k2] = *(const LAS bf16x8*)(PSw + (16 * m + fr) * AT_PS_STRIDE + (32 * k2 + 8 * fq) * 2);
#pragma unroll
            for (int dt = 0; dt < 8; ++dt)
#pragma unroll
                for (int k2 = 0; k2 < 2; ++k2) { const bf16x8 vf = *(const LAS bf16x8*)(lds + AT_VT + (16 * dt + fr) * AT_VT_STRIDE + (32 * k2 + 8 * fq) * 2);
                    O[0][dt] = mfma16(pf[0][k2], vf, O[0][dt]); O[1][dt] = mfma16(pf[1][k2], vf, O[1][dt]); }
        }
    }
#pragma unroll
    for (int m = 0; m < 2; ++m)
#pragma unroll
        for (int g = 0; g < 4; ++g) {
            float l = lrow[m][g]; l += __shfl_xor(l, 1); l += __shfl_xor(l, 2); l += __shfl_xor(l, 4); l += __shfl_xor(l, 8);
            const int t = ubase + 16 * m + 4 * fq + g - 240;
            if (t >= 0) { const float il = 1.0f / l; bf16* op = y0 + (size_t)row_of(b, t) * DM + LRU_W + 128 * h + fr;
#pragma unroll
                for (int dt = 0; dt < 8; ++dt) op[16 * dt] = (bf16)(pk2(O[m][dt][g] * il, 0.f) & 0xffffu); }
        }
    __syncthreads();
}

__device__ __forceinline__ int p2_fetch(Frame& F, gu32* qctr) {
    if (F.tid == 0) F.MISC[0] = __hip_atomic_fetch_add(qctr, 1u, RLX_AGENT);
    __syncthreads();
    const int item = (int)F.MISC[0];
    __syncthreads();
    return item;
}
__device__ __forceinline__ void p2_mixer0(Frame& F, const Args& A, int rep) {
    gu32* qctr = (gu32*)(F.ws + WS_CTL) + CW_Q2 + 64 * rep;
    constexpr int N_LRU = NB * 16, N_ATT = NB * FOX_H * 17;
    int item = p2_fetch(F, qctr);
    while (item < N_LRU) { lru_item(F, A, item >> 4, item & 15); item = p2_fetch(F, qctr); }
    while (item < N_LRU + N_ATT) { const int a = item - N_LRU; const int j = 16 - a / 64, bh = a % 64; attn_item(F, A, bh >> 4, bh & 15, j); item = p2_fetch(F, qctr); }
}

constexpr int RT_QS = 0, RT_QS_STRIDE = 528, RT_KN = 33792, RT_KT = 67584, RT_T_STRIDE = 144, RT_VT = 104448, RT_SS = 122880;
static_assert(RT_SS + 64 * RT_T_STRIDE <= MISC_OFF, "retention LDS map");
__device__ __forceinline__ int ret_row(int b, int c, int idx) { return c == 0 ? (idx < 48 ? -1 : MMETA + NMETA * b + (idx - 48)) : b * SEQ + 64 * (c - 1) + idx; }
__device__ __forceinline__ void ret_item(Frame& F, const Args& A, int b, int h, int es, bool accum) {
    const bf16* z1 = (const bf16*)(F.ws + WS_Z); bf16* ob = (bf16*)(F.ws + WS_Y1); float* ssqo = (float*)(F.ws + WS_SSQO);
    const int tid = F.tid, lane = F.lane, w = F.wave, fr = lane & 15, fq = lane >> 4;
    LAS unsigned char* lds = F.lds;
    const float lg = log1pf(-exp2f(-5.0f - (float)h)) * 1.4426950408889634f;
    const float cdec = exp2f(lg * 64.0f);
    f32x4 Sacc[16];
#pragma unroll
    for (int dt = 0; dt < 16; ++dt) Sacc[dt] = (f32x4){0.f, 0.f, 0.f, 0.f};
    const int qrow = tid >> 5, qd = (tid & 31) * 8;
    const int vrow = tid >> 4, ve = (tid & 15) * 8;
    v4u qreg[4], kreg[4], vreg[2];
    const size_t qcol = (size_t)h * RET_QK + qd, kcol = 4096 + (size_t)h * RET_QK + qd, vcol = 8192 + (size_t)h * RET_V + 128 * es + ve;
#define RT_PREFETCH(c) do { \
        _Pragma("unroll") for (int k = 0; k < 4; ++k) { const int r = ret_row(b, (c), qrow + 16 * k); \
            if (r >= 0) { qreg[k] = *(const GAS v4u*)(z1 + (size_t)r * RET_IN + qcol); kreg[k] = *(const GAS v4u*)(z1 + (size_t)r * RET_IN + kcol); } \
            else { qreg[k] = (v4u){0u, 0u, 0u, 0u}; kreg[k] = (v4u){0u, 0u, 0u, 0u}; } } \
        _Pragma("unroll") for (int k = 0; k < 2; ++k) { const int r = ret_row(b, (c), vrow + 32 * k); \
            if (r >= 0) vreg[k] = *(const GAS v4u*)(z1 + (size_t)r * RET_IN + vcol); else vreg[k] = (v4u){0u, 0u, 0u, 0u}; } } while (0)
    RT_PREFETCH(0);
    for (int c = 0; c < 65; ++c) {
        __syncthreads();
#pragma unroll
        for (int k = 0; k < 4; ++k) { const int m = qrow + 16 * k;
            *(LAS v4u*)(lds + RT_QS + m * RT_QS_STRIDE + qd * 2) = qreg[k];
            *(LAS v4u*)(lds + RT_KN + m * RT_QS_STRIDE + qd * 2) = kreg[k];
            float kf[8]; unpack8(kreg[k], kf); const float kd = exp2f(lg * (float)(63 - m));
#pragma unroll
            for (int e = 0; e < 8; e += 2) { const unsigned pk = pk2(kf[e] * kd, kf[e + 1] * kd);
                *(LAS unsigned short*)(lds + RT_KT + (qd + e) * RT_T_STRIDE + m * 2) = (unsigned short)(pk & 0xffffu);
                *(LAS unsigned short*)(lds + RT_KT + (qd + e + 1) * RT_T_STRIDE + m * 2) = (unsigned short)(pk >> 16); } }
#pragma unroll
        for (int k = 0; k < 2; ++k) { const int m = vrow + 32 * k; const unsigned vw[4] = {vreg[k].x, vreg[k].y, vreg[k].z, vreg[k].w};
#pragma unroll
            for (int e = 0; e < 4; ++e) { *(LAS unsigned short*)(lds + RT_VT + (ve + 2 * e) * RT_T_STRIDE + m * 2) = (unsigned short)(vw[e] & 0xffffu);
                *(LAS unsigned short*)(lds + RT_VT + (ve + 2 * e + 1) * RT_T_STRIDE + m * 2) = (unsigned short)(vw[e] >> 16); } }
        __syncthreads();
        if (c < 64) RT_PREFETCH(c + 1);
        { const int it = w >> 1, mt0 = 2 * (w & 1);
          f32x4 sacc[2] = {(f32x4){0.f, 0.f, 0.f, 0.f}, (f32x4){0.f, 0.f, 0.f, 0.f}};
#pragma unroll
          for (int ks = 0; ks < 8; ++ks) { const bf16x8 a = *(const LAS bf16x8*)(lds + RT_QS + (16 * it + fr) * RT_QS_STRIDE + (32 * ks + 8 * fq) * 2);
#pragma unroll
              for (int q = 0; q < 2; ++q) { const bf16x8 kb = *(const LAS bf16x8*)(lds + RT_KN + (16 * (mt0 + q) + fr) * RT_QS_STRIDE + (32 * ks + 8 * fq) * 2); sacc[q] = mfma16(a, kb, sacc[q]); } }
#pragma unroll
          for (int q = 0; q < 2; ++q)
#pragma unroll
              for (int g = 0; g < 4; ++g) { const int i = 16 * it + 4 * fq + g, m = 16 * (mt0 + q) + fr; const int dd = i > m ? i - m : m - i;
                  const float sv = sacc[q][g] * exp2f(lg * (float)dd);
                  *(LAS unsigned short*)(lds + RT_SS + i * RT_T_STRIDE + m * 2) = (unsigned short)(pk2(sv, 0.f) & 0xffffu); } }
        __syncthreads();
        f32x4 acc[4];
#pragma unroll
        for (int mi = 0; mi < 4; ++mi) acc[mi] = (f32x4){0.f, 0.f, 0.f, 0.f};
#pragma unroll
        for (int kk = 0; kk < 8; ++kk) {
            v4u bw; bw.x = pk2(Sacc[2 * kk][0], Sacc[2 * kk][1]); bw.y = pk2(Sacc[2 * kk][2], Sacc[2 * kk][3]); bw.z = pk2(Sacc[2 * kk + 1][0], Sacc[2 * kk + 1][1]); bw.w = pk2(Sacc[2 * kk + 1][2], Sacc[2 * kk + 1][3]);
            const bf16x8 bfrag = __builtin_bit_cast(bf16x8, bw);
#pragma unroll
            for (int mi = 0; mi < 4; ++mi) { const LAS unsigned char* qp = lds + RT_QS + (16 * mi + fr) * RT_QS_STRIDE + (32 * kk + 4 * fq) * 2;
                const v2u lo = *(const LAS v2u*)(qp), hi = *(const LAS v2u*)(qp + 32);
                v4u aw; aw.x = lo.x; aw.y = lo.y; aw.z = hi.x; aw.w = hi.y;
                acc[mi] = mfma16(__builtin_bit_cast(bf16x8, aw), bfrag, acc[mi]); } }
#pragma unroll
        for (int mi = 0; mi < 4; ++mi)
#pragma unroll
            for (int g = 0; g < 4; ++g) acc[mi][g] *= exp2f(lg * (float)(16 * mi + 4 * fq + g + 1));
        bf16x8 vf[2];
#pragma unroll
        for (int k2 = 0; k2 < 2; ++k2) vf[k2] = *(const LAS bf16x8*)(lds + RT_VT + (16 * w + fr) * RT_T_STRIDE + (32 * k2 + 8 * fq) * 2);
#pragma unroll
        for (int mi = 0; mi < 4; ++mi)
#pragma unroll
            for (int k2 = 0; k2 < 2; ++k2) { const bf16x8 a = *(const LAS bf16x8*)(lds + RT_SS + (16 * mi + fr) * RT_T_STRIDE + (32 * k2 + 8 * fq) * 2); acc[mi] = mfma16(a, vf[k2], acc[mi]); }
        if (c > 0) {
#pragma unroll
            for (int mi = 0; mi < 4; ++mi)
#pragma unroll
                for (int g = 0; g < 4; ++g) { const int r = b * SEQ + 64 * (c - 1) + 16 * mi + 4 * fq + g; const float v = acc[mi][g];
                    ob[(size_t)r * RET_VW + h * RET_V + 128 * es + 16 * w + fr] = (bf16)(pk2(v, 0.f) & 0xffffu);
                    float sq = v * v; sq += __shfl_xor(sq, 1); sq += __shfl_xor(sq, 2); sq += __shfl_xor(sq, 4); sq += __shfl_xor(sq, 8);
                    if (fr == 0 && accum) atomicAdd(ssqo + (size_t)r * 16 + h, sq); }
        }
#pragma unroll
        for (int dt = 0; dt < 16; ++dt) { Sacc[dt] *= cdec;
#pragma unroll
            for (int k2 = 0; k2 < 2; ++k2) { const bf16x8 a = *(const LAS bf16x8*)(lds + RT_KT + (16 * dt + fr) * RT_T_STRIDE + (32 * k2 + 8 * fq) * 2); Sacc[dt] = mfma16(a, vf[k2], Sacc[dt]); } }
    }
#undef RT_PREFETCH
    __syncthreads();
}
__device__ __forceinline__ void p7_retention(Frame& F, const Args& A, bool accum) {
    for (int item = blockIdx.x; item < NB * RET_H * 4; item += F.G) ret_item(F, A, item >> 6, (item >> 2) & 15, item & 3, accum);
}
__device__ __forceinline__ void p8_gate(Frame& F, const Args& A) {
    const bf16* z1 = (const bf16*)(F.ws + WS_Z); bf16* ob = (bf16*)(F.ws + WS_Y1); const float* ssqo = (const float*)(F.ws + WS_SSQO); const float* gain = A.in[17];
    const size_t total = (size_t)MTOK * (RET_VW / 8), stride = (size_t)F.G * NTHREADS;
    for (size_t idx = (size_t)blockIdx.x * NTHREADS + F.tid; idx < total; idx += stride) {
        const int r = (int)(idx >> 10), c = (int)(idx & 1023) * 8, hd = c >> 9;
        const v4u gw = *(const GAS v4u*)(z1 + (size_t)r * RET_IN + 16384 + c); const v4u ow = *(const GAS v4u*)(ob + (size_t)r * RET_VW + c);
        const f32x4 g0 = *(const GAS f32x4*)(gain + c), g1 = *(const GAS f32x4*)(gain + c + 4);
        const float rs = 1.0f / sqrtf(ssqo[(size_t)r * 16 + hd] * (1.0f / 512.0f) + RMS_EPS);
        float gf[8], of[8], y[8]; unpack8(gw, gf); unpack8(ow, of);
#pragma unroll
        for (int e = 0; e < 8; ++e) { const float gn = e < 4 ? g0[e] : g1[e - 4]; y[e] = gf[e] * sigmoidf_fast(gf[e]) * (of[e] * rs * gn); }
        *(GAS v4u*)(ob + (size_t)r * RET_VW + c) = pack8f(y);
    }
}


__device__ __forceinline__ void meta_fixup(Frame& F, const float* Hmeta, bf16* XB, float* ssq) {
    __syncthreads();
    if (F.MISC[4] != 0u) {
        __builtin_amdgcn_fence(__ATOMIC_ACQUIRE, "agent"); asm volatile("s_waitcnt vmcnt(0)" ::: "memory");
        for (int row = F.wave; row < NB * NMETA; row += NWAVES) { const float* hrow = Hmeta + (size_t)row * DM; bf16* xrow = XB + (size_t)(MTOK + row) * DM; float s = 0.f;
#pragma unroll 4
            for (int j = 0; j < 16; ++j) { const int e = (F.lane + 64 * j) * 4; const f32x4 v = *(const GAS f32x4*)(hrow + e);
                s += (v.x * v.x + v.y * v.y) + (v.z * v.z + v.w * v.w); v2u w; w.x = pk2(v.x, v.y); w.y = pk2(v.z, v.w); *(GAS v2u*)(xrow + e) = w; }
            s = wave_sum(s);
            if (F.lane == 0) ssq[MTOK + row] = s; }
        __syncthreads();
        if (F.tid == 0) F.MISC[4] = 0u;
    }
    __syncthreads();
}

__global__ void __launch_bounds__(NTHREADS, 2) hybrid_fwd(Args args) {
    extern __shared__ __attribute__((aligned(16))) unsigned char lds_raw[];
    Frame F;
    F.lds = (LAS unsigned char*)lds_raw;
    F.MISC = (volatile LAS unsigned*)(F.lds + MISC_OFF);
    F.tid = threadIdx.x; F.lane = F.tid & 63; F.wave = __builtin_amdgcn_readfirstlane(F.tid >> 6);
    F.G = gridDim.x; F.ws = args.ws;
    if (F.tid < 64) F.MISC[F.tid] = 0u;
    __syncthreads();
    unsigned* ctl = (unsigned*)(F.ws + WS_CTL);
#if !MK_PER_PHASE
    const XcdBarrier bar = xcd_barrier_post(ctl + CW_BAR, F.MISC + 8);
#define GRID_BAR() xcd_barrier(bar)
#else
#define GRID_BAR() do { } while (0)
#endif
    const int lo = args.ph_lo, hi = args.ph_hi;
#ifndef PHASE_MASK
#define PHASE_MASK 0xFFF
#endif
#define IN(k) ((((PHASE_MASK) >> (k)) & 1) && lo <= (k) && (k) < hi)
#define BOTH(k) (IN(k) && IN((k) + 1))
#ifndef REPEAT_MASK
#define REPEAT_MASK 0
#endif
#define REPS(k) (1 + (((REPEAT_MASK) >> (k)) & 1))
    unsigned char* ws = F.ws;
    bf16* XB = (bf16*)(ws + WS_XB); float* Htok = args.out; float* Hmeta = (float*)(ws + WS_HMETA); bf16* Z = (bf16*)(ws + WS_Z); bf16* Y0 = (bf16*)(ws + WS_Y0); bf16* Y1 = (bf16*)(ws + WS_Y1);
    float* SSQ0 = (float*)(ws + WS_SSQ0); float* SSQ1 = (float*)(ws + WS_SSQ1); float* SSQ2 = (float*)(ws + WS_SSQ2); float* SSQ3 = (float*)(ws + WS_SSQ3);
    const int c = (int)blockIdx.x;

    if (IN(0)) { for (int rep = 0; rep < REPS(0); ++rep) p0_prologue(F, args); if (BOTH(0)) GRID_BAR(); }
    if (IN(1)) {
        pg8::Gemm g{XB, (const bf16*)(ws + WS_WIN0), MP, 41 * 256, DM}; pg8::StaticOrder S; S.init(MP, 41 * 256, DM, F.G, c);
        pg8::EpiIn0 E{Z, (float*)(ws + WS_FBUF), SSQ0};
        pg8::gemm_phase<pg8::EpiIn0, pg8::StaticOrder, true, true>(F.lds, g, S, E); if (REPS(1) > 1) { pg8::gemm_phase<pg8::EpiIn0, pg8::StaticOrder, true, true>(F.lds, g, S, E); }
        if (BOTH(1)) GRID_BAR();
    }
    if (IN(2)) { p2_mixer0(F, args, 0); if (REPS(2) > 1) { GRID_BAR(); p2_mixer0(F, args, 1); } if (BOTH(2)) GRID_BAR(); }
    if (IN(3)) {
        pg8::Gemm g{Y0, (const bf16*)(ws + WS_WOUT0), MP, DM, DM}; pg8::SplitMetaOrder S; S.init2(DM, DM, F.G, c, ctl + CW_TK3, F.MISC + 4);
        pg8::EpiRes E{Htok, Hmeta, XB, SSQ1, DM / 64};
        pg8::gemm_phase<pg8::EpiRes, pg8::SplitMetaOrder, true, true>(F.lds, g, S, E);
        meta_fixup(F, Hmeta, XB, SSQ1);
        if (BOTH(3)) GRID_BAR();
    }
    if (IN(4)) {
        pg8::Gemm g{XB, (const bf16*)(ws + WS_WGU0), MP, 2 * DFF, DM}; pg8::StaticOrder S; S.init(MP, 2 * DFF, DM, F.G, c);
        pg8::EpiGU E{Z, SSQ1};
        pg8::gemm_phase<pg8::EpiGU, pg8::StaticOrder, true, true>(F.lds, g, S, E); if (REPS(4) > 1) { pg8::gemm_phase<pg8::EpiGU, pg8::StaticOrder, true, true>(F.lds, g, S, E); }
        if (BOTH(4)) GRID_BAR();
    }
    if (IN(5)) {
        pg8::Gemm g{Z, (const bf16*)(ws + WS_WD0), MP, DM, DFF}; pg8::SplitMetaOrder S; S.init2(DM, DFF, F.G, c, ctl + CW_TK5, F.MISC + 4);
        pg8::EpiRes E{Htok, Hmeta, XB, SSQ2, DFF / 64};
        pg8::gemm_phase<pg8::EpiRes, pg8::SplitMetaOrder, true, true>(F.lds, g, S, E);
        meta_fixup(F, Hmeta, XB, SSQ2);
        if (BOTH(5)) GRID_BAR();
    }
    if (IN(6)) {
        pg8::Gemm g{XB, (const bf16*)(ws + WS_WIN1), MP, RET_IN, DM}; pg8::StaticOrder S; S.init(MP, RET_IN, DM, F.G, c);
        pg8::EpiIn1 E{Z, SSQ2};
        pg8::gemm_phase<pg8::EpiIn1, pg8::StaticOrder, true, true>(F.lds, g, S, E); if (REPS(6) > 1) { pg8::gemm_phase<pg8::EpiIn1, pg8::StaticOrder, true, true>(F.lds, g, S, E); }
        if (BOTH(6)) GRID_BAR();
    }
    if (IN(7)) { p7_retention(F, args, true); if (REPS(7) > 1) p7_retention(F, args, false); if (BOTH(7)) GRID_BAR(); }
    if (IN(8)) { p8_gate(F, args); if (BOTH(8)) GRID_BAR(); }
    if (IN(9)) {
        pg8::Gemm g{Y1, (const bf16*)(ws + WS_WOUT1), MTOK, DM, RET_VW}; pg8::StaticOrder S; S.init(MTOK, DM, RET_VW, F.G, c);
        pg8::EpiRes E{Htok, Hmeta, XB, SSQ3, RET_VW / 64};
        pg8::gemm_phase<pg8::EpiRes, pg8::StaticOrder, true, true>(F.lds, g, S, E);
        if (BOTH(9)) GRID_BAR();
    }
    if (IN(10)) {
        pg8::Gemm g{XB, (const bf16*)(ws + WS_WGU1), MTOK, 2 * DFF, DM}; pg8::StaticOrder S; S.init(MTOK, 2 * DFF, DM, F.G, c);
        pg8::EpiGU E{Z, SSQ3};
        pg8::gemm_phase<pg8::EpiGU, pg8::StaticOrder, true, true>(F.lds, g, S, E); if (REPS(10) > 1) { pg8::gemm_phase<pg8::EpiGU, pg8::StaticOrder, true, true>(F.lds, g, S, E); }
        if (BOTH(10)) GRID_BAR();
    }
    if (IN(11)) {
        pg8::Gemm g{Z, (const bf16*)(ws + WS_WD1), MTOK, DM, DFF}; pg8::StaticOrder S; S.init(MTOK, DM, DFF, F.G, c);
        pg8::EpiFinal E{args.out};
        pg8::gemm_phase<pg8::EpiFinal, pg8::StaticOrder, true, true>(F.lds, g, S, E);
    }
#undef IN
#undef BOTH
}

extern "C" void kernel_launch(void* const* d_in, const int* in_sizes, int n_in, void* d_out, int out_size, void* d_ws, size_t ws_size, hipStream_t stream) {
    static int grid = 0;
    if (grid == 0) {
        if (n_in != 23 || in_sizes[0] != MTOK * DM || out_size != MTOK * DM || ws_size < WS_END) { fprintf(stderr, "kernel_launch: unexpected shapes (n_in %d, in0 %d, out %d, ws %zu < %zu); nothing launched\n", n_in, n_in > 0 ? in_sizes[0] : -1, out_size, ws_size, (size_t)WS_END); grid = -1; return; }
        int dev = 0, cus = 0, per_cu = 0;
        if (hipGetDevice(&dev) != hipSuccess || hipDeviceGetAttribute(&cus, hipDeviceAttributeMultiprocessorCount, dev) != hipSuccess) { fprintf(stderr, "kernel_launch: device query failed\n"); grid = -1; return; }
        if (hipFuncSetAttribute((const void*)hybrid_fwd, hipFuncAttributeMaxDynamicSharedMemorySize, LDS_BYTES) != hipSuccess) { fprintf(stderr, "kernel_launch: hipFuncSetAttribute failed\n"); grid = -1; return; }
        if (hipOccupancyMaxActiveBlocksPerMultiprocessor(&per_cu, (const void*)hybrid_fwd, NTHREADS, LDS_BYTES) != hipSuccess || per_cu < 1) { fprintf(stderr, "kernel_launch: occupancy query reports %d workgroups per CU\n", per_cu); }
        (void)hipGetLastError();
        grid = cus;
    }
    if (grid < 0) return;
    if (hipMemsetAsync((char*)d_ws + WS_CTL, 0, CTL_ZERO_BYTES, stream) != hipSuccess) { fprintf(stderr, "kernel_launch: memset failed\n"); return; }
    Args a{};
    for (int i = 0; i < 23; ++i) a.in[i] = (const float*)d_in[i];
    a.out = (float*)d_out; a.ws = (unsigned char*)d_ws;
#if MK_PER_PHASE
    for (int p = 0; p < NPHASES; ++p) { a.ph_lo = p; a.ph_hi = p + 1; hipLaunchKernelGGL(hybrid_fwd, dim3(grid), dim3(NTHREADS), LDS_BYTES, stream, a); }
#else
    a.ph_lo = 0; a.ph_hi = NPHASES;
    hipLaunchKernelGGL(hybrid_fwd, dim3(grid), dim3(NTHREADS), LDS_BYTES, stream, a);
#endif
    const hipError_t le = hipPeekAtLastError();
    if (le != hipSuccess) fprintf(stderr, "kernel_launch: launch failed: %s\n", hipGetErrorName(le));
}
```

```cpp
#include <hip/hip_runtime.h>
#include <cstdio>
#include <cstdint>
#ifndef MK_PER_PHASE
#define MK_PER_PHASE 0
#endif
constexpr int DM = 4096, NB = 4, SEQ = 4096, NMETA = 16, LSEQ = NMETA + SEQ;
constexpr int MTOK = NB * SEQ;
constexpr int MMETA = MTOK;
constexpr int MP = 65 * 256;
constexpr int LRU_W = 2048, FOX_H = 16, FOX_D = 128, AB_IN = 10256, AB_Z = 10240;
constexpr int RET_H = 16, RET_QK = 256, RET_V = 512, RET_IN = 24576, RET_VW = 8192;
constexpr int DFF = 11008;
constexpr float RMS_EPS = 1e-6f;
namespace pg8 {
#define PG8_LAS __attribute__((address_space(3)))
typedef unsigned short bf16_t;
typedef short bf16x8 __attribute__((ext_vector_type(8)));
typedef float f32x4 __attribute__((ext_vector_type(4)));
typedef unsigned u32x4 __attribute__((ext_vector_type(4)));
constexpr int BM = 256, BK = 64, HALF = 128, HTB = HALF * BK * 2  , STAGE_BYTES = 8 * HTB, NXCD = 8, WGM = 8;

__host__ __device__ __forceinline__ int lds_byte(int r, int c) { const int st = (r >> 4) * 2 + (c >> 5), rr = r & 15, cc = c & 31, ob = rr * 64 + cc * 2; return st * 1024 + (ob ^ (((ob >> 9) & 1) << 5)); }
__host__ __device__ __forceinline__ void stage_rc(int b, int& R, int& C) { const int st = b / 1024, sb = b % 1024, swz = sb ^ (((sb >> 9) & 1) << 5); R = (st >> 1) * 16 + swz / 64; C = (st & 1) * 32 + (swz % 64) / 2; }
__host__ __device__ __forceinline__ int perm32(int rho) { const int n = rho >> 4, i = rho & 15; return 8 * (i >> 2) + 4 * n + (i & 3); }

struct Unit { int pm, pn, kb, kn; };
struct Gemm { const bf16_t* A; const bf16_t* Bt; int M, N, K; };

struct StaticOrder {
    int nM, nN, nwg, G, c, ntk;
    __host__ __device__ void init(int M, int N, int K, int G_, int c_) { nM = M / BM; nN = N / BM; nwg = nM * nN; G = G_; c = c_; ntk = K / BK; }
    __host__ __device__ bool next(int i, Unit& u) const {
        const long L = (long)i * G + c; if (L >= nwg) return false;
        int wgid = (int)L; { const int q = nwg / NXCD, r = nwg % NXCD, xcd = wgid % NXCD, off = wgid / NXCD; wgid = (xcd < r ? xcd * (q + 1) : r * (q + 1) + (xcd - r) * q) + off; }
        const int nig = WGM * nN, gid = wgid / nig, fm = gid * WGM, gsz = (nM - fm) < WGM ? (nM - fm) : WGM;
        u.pm = fm + ((wgid % nig) % gsz); u.pn = (wgid % nig) / gsz; u.kb = 0; u.kn = ntk; return true;
    }
    __device__ __forceinline__ void a_ready(const Unit&) const {}
    __device__ __forceinline__ void done(const Unit&) const {}
};

struct SplitMetaOrder : StaticOrder {
    int nreg, nsplit; unsigned* ticket; volatile PG8_LAS unsigned* flag;
    __device__ void init2(int N, int K, int G_, int c_, unsigned* ticket_, volatile PG8_LAS unsigned* flag_) { init(64 * BM, N, K, G_, c_); nreg = nwg; nsplit = 16; ticket = ticket_; flag = flag_; }
    __device__ bool next(int i, Unit& u) const {
        const long L = (long)i * G + c;
        if (L < nreg) return StaticOrder::next(i, u);
        const int x = (int)(L - nreg); if (x >= nsplit * nN) return false;
        const int s = x % nsplit; u.pm = 64; u.pn = x / nsplit;
        const int base = (ntk / 2) / nsplit, rem = (ntk / 2) % nsplit;
        u.kb = 2 * (s * base + (s < rem ? s : rem)); u.kn = 2 * (base + (s < rem ? 1 : 0)); return true;
    }
    __device__ __forceinline__ void a_ready(const Unit&) const {}
    __device__ __forceinline__ void done(const Unit& u) const {
        if (u.pm == 64) { asm volatile("s_waitcnt vmcnt(0)" ::: "memory");
            if ((threadIdx.x & 63) == 0) { const unsigned old = __hip_atomic_fetch_add(ticket, 1u, __ATOMIC_RELAXED, __HIP_MEMORY_SCOPE_AGENT); if (old + 1u == (unsigned)(nsplit * nN * 8)) flag[0] = 1u; } }
    }
};
__device__ __forceinline__ unsigned cvt_pk_bf16(float lo, float hi) { unsigned r; asm volatile("v_cvt_pk_bf16_f32 %0, %1, %2" : "=v"(r) : "v"(lo), "v"(hi)); return r; }
__device__ __forceinline__ u32x4 pack8(const f32x4 a, const f32x4 b) { u32x4 w; w.x = cvt_pk_bf16(a[0], a[1]); w.y = cvt_pk_bf16(a[2], a[3]); w.z = cvt_pk_bf16(b[0], b[1]); w.w = cvt_pk_bf16(b[2], b[3]); return w; }
__device__ __forceinline__ float row_rstd(const float* ssq, int r) { return 1.0f / sqrtf(ssq[r] * (1.0f / 4096.0f) + RMS_EPS); }

struct EpiIn0 {
    static constexpr bool PERM = true, AFTER_DRAIN = false;
    bf16_t* Z; float* F; const float* ssq;
    __device__ __forceinline__ void operator()(const f32x4 (&acc)[2][2][4][2], const Unit& u, int wr, int wc, int fr, int fq) const {
        const int row0 = u.pm * BM + wr * 64 + fr;
        if (u.pn < 40) {
            const int col0 = u.pn * BM + wc * 32 + 8 * fq;
#pragma unroll
            for (int ai = 0; ai < 2; ++ai)
#pragma unroll
                for (int m = 0; m < 4; ++m) { const int r = row0 + ai * HALF + m * 16; const float rs = row_rstd(ssq, r); bf16_t* rowp = Z + (size_t)r * AB_Z + col0;
#pragma unroll
                    for (int bj = 0; bj < 2; ++bj) *(u32x4*)(rowp + bj * HALF) = pack8(acc[ai][bj][m][0] * rs, acc[ai][bj][m][1] * rs); }
        } else if (wc == 0 && fq < 2) {
#pragma unroll
            for (int ai = 0; ai < 2; ++ai)
#pragma unroll
                for (int m = 0; m < 4; ++m) { const int r = row0 + ai * HALF + m * 16; const float rs = row_rstd(ssq, r); float* fp = F + (size_t)r * 16 + 8 * fq;
                    *(f32x4*)(fp) = acc[ai][0][m][0] * rs; *(f32x4*)(fp + 4) = acc[ai][0][m][1] * rs; }
        }
    }
};
struct EpiRes {
    static constexpr bool PERM = true, AFTER_DRAIN = false;
    float* Htok; float* Hmeta; bf16_t* XB; float* ssq_out; int K_TILES;
    __device__ __forceinline__ void operator()(const f32x4 (&acc)[2][2][4][2], const Unit& u, int wr, int wc, int fr, int fq) const {
        const int row0 = u.pm * BM + wr * 64 + fr, col0 = u.pn * BM + wc * 32 + 8 * fq;
        if (u.pm == MTOK / BM && u.kn != K_TILES) {
            if (wr == 0) {
#pragma unroll
                for (int m = 0; m < 4; ++m) { float* hp = Hmeta + (size_t)(m * 16 + fr) * DM + col0;
#pragma unroll
                    for (int bj = 0; bj < 2; ++bj)
#pragma unroll
                        for (int n = 0; n < 2; ++n)
#pragma unroll
                            for (int j = 0; j < 4; ++j) atomicAdd(hp + bj * HALF + 4 * n + j, acc[0][bj][m][n][j]); } }
            return; }
        float* H = u.pm < MTOK / BM ? Htok : Hmeta - (size_t)MTOK * DM;
#pragma unroll
        for (int ai = 0; ai < 2; ++ai)
#pragma unroll
            for (int m = 0; m < 4; ++m) { const int r = row0 + ai * HALF + m * 16; float* hp = H + (size_t)r * DM + col0; bf16_t* xp = XB + (size_t)r * DM + col0; float s = 0.f;
#pragma unroll
                for (int bj = 0; bj < 2; ++bj) { const f32x4 v0 = *(const f32x4*)(hp + bj * HALF) + acc[ai][bj][m][0], v1 = *(const f32x4*)(hp + bj * HALF + 4) + acc[ai][bj][m][1];
                    *(f32x4*)(hp + bj * HALF) = v0; *(f32x4*)(hp + bj * HALF + 4) = v1; *(u32x4*)(xp + bj * HALF) = pack8(v0, v1);
                    s += (v0[0] * v0[0] + v0[1] * v0[1]) + (v0[2] * v0[2] + v0[3] * v0[3]) + (v1[0] * v1[0] + v1[1] * v1[1]) + (v1[2] * v1[2] + v1[3] * v1[3]); }
                s += __shfl_xor(s, 16); s += __shfl_xor(s, 32);
                if (fq == 0) atomicAdd(ssq_out + r, s);
                asm volatile("" ::: "memory"); }
    }
};
struct EpiFinal {
    static constexpr bool PERM = true, AFTER_DRAIN = false;
    float* OUT;
    __device__ __forceinline__ void operator()(const f32x4 (&acc)[2][2][4][2], const Unit& u, int wr, int wc, int fr, int fq) const {
        const int row0 = u.pm * BM + wr * 64 + fr, col0 = u.pn * BM + wc * 32 + 8 * fq;
#pragma unroll
        for (int ai = 0; ai < 2; ++ai)
#pragma unroll
            for (int m = 0; m < 4; ++m) { const int r = row0 + ai * HALF + m * 16; float* op = OUT + (size_t)r * DM + col0; const float* hp = op;
#pragma unroll
                for (int bj = 0; bj < 2; ++bj) { const f32x4 v0 = *(const f32x4*)(hp + bj * HALF) + acc[ai][bj][m][0], v1 = *(const f32x4*)(hp + bj * HALF + 4) + acc[ai][bj][m][1];
                    *(f32x4*)(op + bj * HALF) = v0; *(f32x4*)(op + bj * HALF + 4) = v1; }
                asm volatile("" ::: "memory"); }
    }
};
struct EpiGU {
    static constexpr bool PERM = true, AFTER_DRAIN = false;
    bf16_t* HID; const float* ssq;
    __device__ __forceinline__ void operator()(const f32x4 (&acc)[2][2][4][2], const Unit& u, int wr, int wc, int fr, int fq) const {
        const int row0 = u.pm * BM + wr * 64 + fr, col0 = u.pn * HALF + wc * 32 + 8 * fq;
#pragma unroll
        for (int ai = 0; ai < 2; ++ai)
#pragma unroll
            for (int m = 0; m < 4; ++m) { const int r = row0 + ai * HALF + m * 16; const float rs = row_rstd(ssq, r); f32x4 o[2];
#pragma unroll
                for (int n = 0; n < 2; ++n)
#pragma unroll
                    for (int j = 0; j < 4; ++j) { const float g = acc[ai][0][m][n][j] * rs, uu = acc[ai][1][m][n][j] * rs;
                        o[n][j] = g * uu * __builtin_amdgcn_rcpf(1.0f + __expf(-g)); }
                *(u32x4*)(HID + (size_t)r * DFF + col0) = pack8(o[0], o[1]); }
    }
};
struct EpiIn1 {
    static constexpr bool PERM = true, AFTER_DRAIN = false;
    bf16_t* Z; const float* ssq;
    __device__ __forceinline__ void operator()(const f32x4 (&acc)[2][2][4][2], const Unit& u, int wr, int wc, int fr, int fq) const {
        const int row0 = u.pm * BM + wr * 64 + fr, col0 = u.pn * BM + wc * 32 + 8 * fq;
        if (u.pn < 32) {
            const float sc = u.pn < 16 ? 1.0f : 0.0625f;
            float inv[2][4];
#pragma unroll
            for (int n = 0; n < 2; ++n)
#pragma unroll
                for (int j = 0; j < 4; ++j) inv[n][j] = exp2f(-(float)(wc * 32 + 8 * fq + 4 * n + j) * (13.287712379549449f / 128.0f));
#pragma unroll
            for (int ai = 0; ai < 2; ++ai)
#pragma unroll
                for (int m = 0; m < 4; ++m) { const int r = row0 + ai * HALF + m * 16; const float rs = row_rstd(ssq, r) * sc;
                    const float t = (float)(r < MTOK ? NMETA + (r & (SEQ - 1)) : ((r - MTOK) & 15));
                    f32x4 o1[2], o2[2];
#pragma unroll
                    for (int n = 0; n < 2; ++n)
#pragma unroll
                        for (int j = 0; j < 4; ++j) { const float x1 = acc[ai][0][m][n][j] * rs, x2 = acc[ai][1][m][n][j] * rs;
                            const float ang = t * inv[n][j]; float rev = ang * 0.15915494309189535f; rev = rev - floorf(rev);
                            const float c = __builtin_amdgcn_cosf(rev), s = __builtin_amdgcn_sinf(rev);
                            o1[n][j] = x1 * c - x2 * s; o2[n][j] = x1 * s + x2 * c; }
                    bf16_t* rowp = Z + (size_t)r * RET_IN + col0;
                    *(u32x4*)(rowp) = pack8(o1[0], o1[1]); *(u32x4*)(rowp + HALF) = pack8(o2[0], o2[1]); }
        } else {
#pragma unroll
            for (int ai = 0; ai < 2; ++ai)
#pragma unroll
                for (int m = 0; m < 4; ++m) { const int r = row0 + ai * HALF + m * 16; const float rs = row_rstd(ssq, r); bf16_t* rowp = Z + (size_t)r * RET_IN + col0;
#pragma unroll
                    for (int bj = 0; bj < 2; ++bj) *(u32x4*)(rowp + bj * HALF) = pack8(acc[ai][bj][m][0] * rs, acc[ai][bj][m][1] * rs); }
        }
    }
};

template <class Epi, class Sched, bool ALIGN_EPI = false, bool SP2 = false>
__device__ __forceinline__ void gemm_phase(PG8_LAS unsigned char* lds, const Gemm g, const Sched& S, const Epi& E) {
    const int tid = threadIdx.x, wid = __builtin_amdgcn_readfirstlane(tid >> 6), lane = tid & 63, wr = wid >> 2, wc = wid & 3, fr = lane & 15, fq = lane >> 4;
    const int K = g.K; int nt;
    unsigned voffA[2], voffB[2];
#pragma unroll
    for (int i = 0; i < 2; ++i) { int R, C; stage_rc(tid * 16 + i * 8192, R, C); const int Rb = Epi::PERM ? ((R & ~31) + perm32(R & 31)) : R;
        voffA[i] = (unsigned)(R * K + C) * 2u; voffB[i] = (unsigned)(Rb * K + C) * 2u; }
    const size_t kstep = (size_t)(BK * 2);
    const size_t hstep = (size_t)HALF * K * 2;
    const size_t tstep = 2 * hstep;
    const unsigned ldsw = (unsigned)wid * 1024u;
    const int aoff = lds_byte(wr * 64 + fr, fq * 8), boff = lds_byte(wc * 32 + fr, fq * 8);
#define PG8_SA(b, h) (((b) * 2 + (h)) * HTB)
#define PG8_SB(b, h) ((4 + (b) * 2 + (h)) * HTB)
#define PG8_STAGE(bufoff, gbase, voff) do { _Pragma("unroll") for (int _i = 0; _i < 2; ++_i) \
        __builtin_amdgcn_global_load_lds((const unsigned*)((const char*)(gbase) + (voff)[_i]), (PG8_LAS unsigned*)(lds + (bufoff) + ldsw + _i * 8192), 16, 0, 0); } while (0)
#define PG8_LDA(dst, b, h) do { _Pragma("unroll") for (int m = 0; m < 4; ++m) _Pragma("unroll") for (int k = 0; k < 2; ++k) dst[m][k] = *(const PG8_LAS bf16x8*)(lds + PG8_SA(b, h) + aoff + m * 2048 + k * 1024); } while (0)
#define PG8_LDB(dst, b, h) do { _Pragma("unroll") for (int n = 0; n < 2; ++n) _Pragma("unroll") for (int k = 0; k < 2; ++k) dst[n][k] = *(const PG8_LAS bf16x8*)(lds + PG8_SB(b, h) + boff + n * 2048 + k * 1024); } while (0)
#define PG8_MMA(ai, bj, At, Bt) do { __builtin_amdgcn_s_setprio(1); _Pragma("unroll") for (int m = 0; m < 4; ++m) _Pragma("unroll") for (int n = 0; n < 2; ++n) _Pragma("unroll") for (int k = 0; k < 2; ++k) \
        acc[ai][bj][m][n] = __builtin_amdgcn_mfma_f32_16x16x32_bf16(Bt[n][k], At[m][k], acc[ai][bj][m][n], 0, 0, 0); __builtin_amdgcn_s_setprio(0); } while (0)
#define PG8_WAIT_V(n) asm volatile("s_waitcnt vmcnt(" #n ")" ::: "memory")
#define PG8_WAIT_L(n) asm volatile("s_waitcnt lgkmcnt(" #n ")" ::: "memory")
#define PG8_BAR __builtin_amdgcn_s_barrier()
#define PG8_SCHED __builtin_amdgcn_sched_barrier(0)
    Unit cur, nxt; int ui = 0;
    if (!S.next(0, cur)) return;
    nt = cur.kn;
    f32x4 acc[2][2][4][2];
#pragma unroll
    for (int a = 0; a < 2; ++a)
#pragma unroll
        for (int b = 0; b < 2; ++b)
#pragma unroll
            for (int m = 0; m < 4; ++m)
#pragma unroll
                for (int n = 0; n < 2; ++n) acc[a][b][m][n] = (f32x4){0.f, 0.f, 0.f, 0.f};
    bf16x8 At[4][2], B0[2][2], B1[2][2];
    const char* cA = (const char*)g.A + (size_t)cur.pm * tstep + (size_t)cur.kb * kstep; const char* cB = (const char*)g.Bt + (size_t)cur.pn * tstep + (size_t)cur.kb * kstep;
    S.a_ready(cur);
    if constexpr (SP2) {
        PG8_STAGE(PG8_SB(0, 0), cB, voffB); PG8_STAGE(PG8_SB(0, 1), cB + hstep, voffB); PG8_STAGE(PG8_SA(0, 0), cA, voffA); PG8_STAGE(PG8_SA(0, 1), cA + hstep, voffA);
        if (wr == 1) PG8_BAR;
        PG8_WAIT_V(2); PG8_BAR;
        PG8_STAGE(PG8_SB(1, 0), cB + kstep, voffB); PG8_STAGE(PG8_SA(1, 0), cA + kstep, voffA); PG8_STAGE(PG8_SB(1, 1), cB + hstep + kstep, voffB);
        PG8_WAIT_V(6); PG8_BAR;
    } else {
        PG8_STAGE(PG8_SB(0, 0), cB, voffB); PG8_STAGE(PG8_SA(0, 0), cA, voffA); PG8_STAGE(PG8_SB(0, 1), cB + hstep, voffB); PG8_STAGE(PG8_SA(0, 1), cA + hstep, voffA);
        if (wr == 1) PG8_BAR;
        PG8_WAIT_V(4); PG8_BAR;
        PG8_STAGE(PG8_SB(1, 0), cB + kstep, voffB); PG8_STAGE(PG8_SA(1, 0), cA + kstep, voffA); PG8_STAGE(PG8_SB(1, 1), cB + hstep + kstep, voffB);
        PG8_WAIT_V(6); PG8_BAR;
    }
    for (;;) {
        const bool has_next = S.next(ui + 1, nxt);
        const char* nA = has_next ? (const char*)g.A + (size_t)nxt.pm * tstep + (size_t)nxt.kb * kstep : cA; const char* nB = has_next ? (const char*)g.Bt + (size_t)nxt.pn * tstep + (size_t)nxt.kb * kstep : cB;
        for (int t = 0; t < nt; t += 2) {
            const bool last = (t == nt - 2);
            const char* a1 = cA + (size_t)(t + 1) * kstep;
            const char* a2 = last ? nA : cA + (size_t)(t + 2) * kstep; const char* b2 = last ? nB : cB + (size_t)(t + 2) * kstep;
            const char* a3 = a2 + kstep; const char* b3 = b2 + kstep;
            if (last && has_next) S.a_ready(nxt);
            if constexpr (SP2) {
            PG8_LDB(B0, 0, 0); PG8_LDB(B1, 0, 1); PG8_SCHED; PG8_LDA(At, 0, 0); PG8_STAGE(PG8_SA(1, 1), a1 + hstep, voffA);
            PG8_WAIT_V(8); PG8_WAIT_L(0); PG8_BAR; PG8_MMA(0, 0, At, B0); PG8_MMA(0, 1, At, B1); PG8_BAR; PG8_SCHED;
            PG8_LDA(At, 0, 1); PG8_STAGE(PG8_SB(0, 0), b2, voffB); PG8_STAGE(PG8_SB(0, 1), b2 + hstep, voffB); PG8_STAGE(PG8_SA(0, 0), a2, voffA);
            PG8_WAIT_V(8); PG8_WAIT_L(0); PG8_BAR; PG8_MMA(1, 0, At, B0); PG8_MMA(1, 1, At, B1); PG8_BAR; PG8_SCHED;
            PG8_LDB(B0, 1, 0); PG8_LDB(B1, 1, 1); PG8_SCHED; PG8_LDA(At, 1, 0); PG8_STAGE(PG8_SA(0, 1), a2 + hstep, voffA);
            PG8_WAIT_V(8); PG8_WAIT_L(0); PG8_BAR; PG8_MMA(0, 0, At, B0); PG8_MMA(0, 1, At, B1); PG8_BAR; PG8_SCHED;
            PG8_LDA(At, 1, 1); PG8_STAGE(PG8_SB(1, 0), b3, voffB); PG8_STAGE(PG8_SB(1, 1), b3 + hstep, voffB); PG8_STAGE(PG8_SA(1, 0), a3, voffA);
            PG8_WAIT_V(8); PG8_WAIT_L(0); PG8_BAR; PG8_MMA(1, 0, At, B0); PG8_MMA(1, 1, At, B1); PG8_BAR; PG8_SCHED;
            } else {
            PG8_LDB(B0, 0, 0); PG8_SCHED; PG8_LDA(At, 0, 0); PG8_STAGE(PG8_SA(1, 1), a1 + hstep, voffA);
            PG8_WAIT_L(8); PG8_BAR; PG8_WAIT_L(0); PG8_MMA(0, 0, At, B0); PG8_BAR; PG8_SCHED;
            PG8_LDB(B1, 0, 1); PG8_STAGE(PG8_SB(0, 0), b2, voffB);
            PG8_BAR; PG8_WAIT_L(0); PG8_MMA(0, 1, At, B1); PG8_BAR;
            PG8_LDA(At, 0, 1); PG8_STAGE(PG8_SA(0, 0), a2, voffA);
            PG8_BAR; PG8_WAIT_L(0); PG8_MMA(1, 0, At, B0); PG8_BAR; PG8_SCHED;
            PG8_STAGE(PG8_SB(0, 1), b2 + hstep, voffB);
            PG8_WAIT_V(6); PG8_BAR; PG8_MMA(1, 1, At, B1); PG8_BAR;
            PG8_LDB(B0, 1, 0); PG8_SCHED; PG8_LDA(At, 1, 0); PG8_STAGE(PG8_SA(0, 1), a2 + hstep, voffA);
            PG8_WAIT_L(8); PG8_BAR; PG8_WAIT_L(0); PG8_MMA(0, 0, At, B0); PG8_BAR; PG8_SCHED;
            PG8_LDB(B1, 1, 1); PG8_STAGE(PG8_SB(1, 0), b3, voffB);
            PG8_BAR; PG8_WAIT_L(0); PG8_MMA(0, 1, At, B1); PG8_BAR;
            PG8_LDA(At, 1, 1); PG8_STAGE(PG8_SA(1, 0), a3, voffA);
            PG8_BAR; PG8_WAIT_L(0); PG8_MMA(1, 0, At, B0); PG8_BAR; PG8_SCHED;
            PG8_STAGE(PG8_SB(1, 1), b3 + hstep, voffB);
            PG8_WAIT_V(6); PG8_BAR; PG8_MMA(1, 1, At, B1); PG8_BAR;
            }
        }
        if constexpr (ALIGN_EPI) { if (wr == 0) PG8_BAR; }
        if constexpr (!Epi::AFTER_DRAIN) { E(acc, cur, wr, wc, fr, fq); S.done(cur); }
        if (!has_next) break;
#pragma unroll
        for (int a = 0; a < 2; ++a)
#pragma unroll
            for (int b = 0; b < 2; ++b)
#pragma unroll
                for (int m = 0; m < 4; ++m)
#pragma unroll
                    for (int n = 0; n < 2; ++n) acc[a][b][m][n] = (f32x4){0.f, 0.f, 0.f, 0.f};
        cur = nxt; cA = nA; cB = nB; ++ui; nt = cur.kn;
        if constexpr (ALIGN_EPI) { if (wr == 1) PG8_BAR; }
    }
    PG8_WAIT_V(0);
    if constexpr (!ALIGN_EPI) { if (wr == 0) PG8_BAR; }
    PG8_BAR;
    if constexpr (Epi::AFTER_DRAIN) { E.fused(acc, cur, wr, wc, fr, fq, lds, wid, lane); S.done(cur); }
#undef PG8_SA
#undef PG8_SB
#undef PG8_STAGE
#undef PG8_LDA
#undef PG8_LDB
#undef PG8_MMA
#undef PG8_WAIT_V
#undef PG8_WAIT_L
#undef PG8_BAR
#undef PG8_SCHED
}
}

constexpr size_t MiB = 1u << 20;
constexpr size_t WS_CTL = 0, CTL_ZERO_BYTES = 2 * MiB;
constexpr size_t WS_SSQ1 = 64 * 1024, WS_SSQ2 = 192 * 1024, WS_SSQ3 = 320 * 1024, WS_SSQO = 512 * 1024;
constexpr size_t WS_SSQ0 = 2 * MiB;
constexpr size_t WS_FBUF = 2 * MiB + 512 * 1024;
constexpr size_t WS_HMETA = 4 * MiB;
constexpr size_t WS_WIN0 = 8 * MiB, WS_WOUT0 = 90 * MiB, WS_WGU0 = 122 * MiB, WS_WD0 = 294 * MiB, WS_WIN1 = 380 * MiB, WS_WOUT1 = 572 * MiB, WS_WGU1 = 636 * MiB, WS_WD1 = 808 * MiB;
constexpr size_t WS_WAT = 894 * MiB, WS_WXT = WS_WAT + 512 * 1024;
constexpr size_t WS_XB = 896 * MiB, WS_Z = 1026 * MiB, WS_END = 1806 * MiB;
constexpr size_t WS_Y0 = WS_Z + 400 * MiB;
constexpr size_t WS_Y1 = 8 * MiB;
static_assert(WS_SSQO + (size_t)MP * 16 * 4 <= CTL_ZERO_BYTES && WS_FBUF + (size_t)MP * 16 * 4 <= WS_HMETA && WS_HMETA + (size_t)256 * DM * 4 <= WS_WIN0, "ctl map");
static_assert(WS_WIN0 + (size_t)41 * 256 * DM * 2 <= WS_WOUT0 && WS_WGU0 + (size_t)2 * DFF * DM * 2 <= WS_WD0 && WS_WD0 + (size_t)DM * DFF * 2 <= WS_WIN1 && WS_WIN1 + (size_t)RET_IN * DM * 2 <= WS_WOUT1, "weight map");
static_assert(WS_WOUT1 + (size_t)DM * RET_VW * 2 <= WS_WGU1 && WS_WGU1 + (size_t)2 * DFF * DM * 2 <= WS_WD1 && WS_WD1 + (size_t)DM * DFF * 2 <= WS_WAT, "weight map 2");
static_assert(WS_XB + (size_t)MP * DM * 2 <= WS_Z && WS_Z + (size_t)MP * RET_IN * 2 <= WS_END && WS_Z + (size_t)MP * AB_Z * 2 <= WS_Y0 && WS_Z + (size_t)MP * DFF * 2 <= WS_Y0 && WS_Y0 + (size_t)MP * DM * 2 <= WS_END && WS_Y1 + (size_t)MP * RET_VW * 2 <= WS_WD0, "activation map");
constexpr int CW_TMO = 0, CW_Q2 = 64, CW_TK3 = 256, CW_TK5 = 320, CW_BAR = 4096;
constexpr int RING_BYTES = 131072;
constexpr int LDS_BYTES = 147456;
constexpr int MISC_OFF = LDS_BYTES - 256;
constexpr int NWAVES = 8, NTHREADS = 512;
constexpr int NPHASES = 12;

#define GAS __attribute__((address_space(1)))
#define LAS __attribute__((address_space(3)))
typedef unsigned short bf16;
typedef unsigned v4u __attribute__((ext_vector_type(4)));
typedef unsigned v2u __attribute__((ext_vector_type(2)));
typedef float f32x4 __attribute__((ext_vector_type(4)));
typedef short bf16x8 __attribute__((ext_vector_type(8)));
typedef short bf16x4 __attribute__((ext_vector_type(4)));
typedef GAS unsigned gu32;
#define RLX_AGENT __ATOMIC_RELAXED, __HIP_MEMORY_SCOPE_AGENT
#define LDS_WAIT() asm volatile("s_waitcnt lgkmcnt(0)" ::: "memory")
#define VM_WAIT() asm volatile("s_waitcnt vmcnt(0)" ::: "memory")
__device__ __forceinline__ unsigned f2bf(float f) { unsigned u = __builtin_bit_cast(unsigned, f); return (u + 0x7fffu + ((u >> 16) & 1u)) >> 16; }
__device__ __forceinline__ unsigned pk2(float lo, float hi) { return pg8::cvt_pk_bf16(lo, hi); }
__device__ __forceinline__ float bflo(unsigned w) { return __builtin_bit_cast(float, w << 16); }
__device__ __forceinline__ float bfhi(unsigned w) { return __builtin_bit_cast(float, w & 0xffff0000u); }
__device__ __forceinline__ float bf2f(unsigned short h) { return __builtin_bit_cast(float, (unsigned)h << 16); }
__device__ __forceinline__ void unpack8(const v4u w, float (&f)[8]) { f[0] = bflo(w.x); f[1] = bfhi(w.x); f[2] = bflo(w.y); f[3] = bfhi(w.y); f[4] = bflo(w.z); f[5] = bfhi(w.z); f[6] = bflo(w.w); f[7] = bfhi(w.w); }
__device__ __forceinline__ v4u pack8f(const float (&f)[8]) { v4u w; w.x = pk2(f[0], f[1]); w.y = pk2(f[2], f[3]); w.z = pk2(f[4], f[5]); w.w = pk2(f[6], f[7]); return w; }
__device__ __forceinline__ int row_of(int b, int t) { return t < NMETA ? MMETA + NMETA * b + t : b * SEQ + (t - NMETA); }
__device__ __forceinline__ f32x4 mfma16(bf16x8 a, bf16x8 b, f32x4 c) { return __builtin_amdgcn_mfma_f32_16x16x32_bf16(a, b, c, 0, 0, 0); }

#define XB_TMO      128
#define XB_XCNT(j)  (256  + 64 * (j))
#define XB_XSUB(j)  (1280 + 64 * (j))
#define XB_XGEN(j)  (2304 + 64 * (j))
#define XB_TOP      3328
#define XB_TOPGEN   3392
#define XCD_BAR_WORDS 3456
#define XB_SPIN_CAP (1u << 22)

__device__ __forceinline__ unsigned xb_ld(unsigned* p)              { return __hip_atomic_load(p, __ATOMIC_RELAXED, __HIP_MEMORY_SCOPE_AGENT); }
__device__ __forceinline__ unsigned xb_add(unsigned* p, unsigned v) { return __hip_atomic_fetch_add(p, v, __ATOMIC_RELAXED, __HIP_MEMORY_SCOPE_AGENT); }
__device__ __forceinline__ unsigned xb_xcc_id() { return (unsigned)__builtin_amdgcn_s_getreg((3 << 11) | 20) & 0xFu; }
#define XB_SPIN(cond, bar) do { unsigned _sp = 0; while (cond) { __builtin_amdgcn_s_sleep(1); \
    if ((++_sp & 255u) == 0u) { if (xb_ld(&(bar)[XB_TMO])) break; if (_sp > XB_SPIN_CAP) { atomicAdd(&(bar)[XB_TMO], 1u); break; } } } } while (0)

struct XcdBarrier {
    unsigned* bar; unsigned x;
    volatile LAS unsigned* st;
};
__device__ __forceinline__ XcdBarrier xcd_barrier_post(unsigned* bar, volatile LAS unsigned* st) {
    XcdBarrier b; b.bar = bar; b.x = xb_xcc_id(); b.st = st;
    if (threadIdx.x == 0) (void)xb_add(&bar[XB_XCNT(b.x)], 1u);
    return b;
}
__device__ __forceinline__ void xcd_barrier_complete(unsigned* bar, unsigned x, unsigned& nloc, unsigned& nx) {
    const unsigned G = gridDim.x * gridDim.y * gridDim.z;
    unsigned sum, cnt, mine, sp = 0u;
    for (;;) {
        sum = 0u; cnt = 0u; mine = 0u;
#pragma unroll
        for (unsigned j = 0; j < 16; ++j) { const unsigned c = xb_ld(&bar[XB_XCNT(j)]); sum += c; cnt += (c > 0u) ? 1u : 0u; mine = (j == x) ? c : mine; }
        if (sum == G) break;
        __builtin_amdgcn_s_sleep(1);
        if ((++sp & 255u) == 0u) { if (xb_ld(&bar[XB_TMO])) break; if (sp > XB_SPIN_CAP) { atomicAdd(&bar[XB_TMO], 1u); break; } }
    }
    nloc = mine > 0u ? mine : 1u; nx = cnt > 0u ? cnt : 1u;
}
__device__ __forceinline__ void xcd_barrier(const XcdBarrier& b) {
    asm volatile("s_waitcnt vmcnt(0)" ::: "memory");
    __syncthreads();
    if (threadIdx.x == 0) {
        unsigned* bar = b.bar;
        __builtin_amdgcn_s_waitcnt(0);
        unsigned nloc = b.st[0], nx = b.st[1];
        if (nloc == 0u) { xcd_barrier_complete(bar, b.x, nloc, nx); b.st[0] = nloc; b.st[1] = nx; }
        const unsigned old = xb_add(&bar[XB_XSUB(b.x)], 1u);
        const unsigned gen = old / nloc;
        if (old + 1u == (gen + 1u) * nloc) {
            __builtin_amdgcn_fence(__ATOMIC_RELEASE, "agent");
            asm volatile("s_waitcnt vmcnt(0)" ::: "memory");
            const unsigned og = xb_add(&bar[XB_TOP], 1u);
            const unsigned tg = og / nx;
            if (og + 1u == (tg + 1u) * nx) xb_add(&bar[XB_TOPGEN], 1u);
            else XB_SPIN(xb_ld(&bar[XB_TOPGEN]) == tg, bar);
            __builtin_amdgcn_fence(__ATOMIC_ACQUIRE, "agent");
            xb_add(&bar[XB_XGEN(b.x)], 1u);
            asm volatile("s_waitcnt vmcnt(0)" ::: "memory");
        } else {
            XB_SPIN(xb_ld(&bar[XB_XGEN(b.x)]) == gen, bar);
            __builtin_amdgcn_fence(__ATOMIC_ACQUIRE, "agent");
            asm volatile("s_waitcnt vmcnt(0)" ::: "memory");
        }
    }
    __syncthreads();
}

struct Args { const float* in[23]; float* out; unsigned char* ws; int ph_lo, ph_hi; };
__device__ __forceinline__ float* h_row(float* out, unsigned char* ws, int r) { return r < MTOK ? out + (size_t)r * DM : (float*)(ws + WS_HMETA) + (size_t)(r - MTOK) * DM; }
struct Frame {
    LAS unsigned char* lds;
    volatile LAS unsigned* MISC;
    unsigned char* ws;
    int tid, lane, wave, G;
};
__device__ __forceinline__ float wave_sum(float v) {
#pragma unroll
    for (int o = 1; o < 64; o <<= 1) v += __shfl_xor(v, o);
    return v;
}

template <int MODE, int KCH>
__device__ __forceinline__ void p0_tr(const float* W, int K, int N, const float* gain, bf16* WT, LAS unsigned* tile, int item, int lane) {
    const int nnb = (N + 63) / 64, kc = item / nnb, nb = item - kc * nnb, k0 = kc * KCH, n0 = nb * 64;
    const int kq = lane >> 4, nq = lane & 15; const int n = n0 + 4 * nq; const bool ok = n < N;
    const float* src = W + (size_t)(k0 + 2 * kq) * N + (ok ? n : 0);
    const int nr = lane >> 3, kch = lane & 7;
#pragma unroll 1
    for (int sub = 0; sub < KCH / 64; ++sub) {
        const int kb = k0 + 64 * sub;
#pragma unroll
        for (int half = 0; half < 2; ++half) {
            f32x4 v[4][2];
#pragma unroll
            for (int i = 0; i < 4; ++i) { const float* p = src + (size_t)(64 * sub + 32 * half + 8 * i) * N; v[i][0] = *(const GAS f32x4*)p; v[i][1] = *(const GAS f32x4*)(p + N); }
#pragma unroll
            for (int i = 0; i < 4; ++i) { float g0 = 1.f, g1 = 1.f; if (gain) { g0 = gain[kb + 32 * half + 8 * i + 2 * kq]; g1 = gain[kb + 32 * half + 8 * i + 2 * kq + 1]; }
#pragma unroll
                for (int c = 0; c < 4; ++c) tile[(4 * nq + c) * 33 + 16 * half + 4 * i + kq] = pk2(v[i][0][c] * g0, v[i][1][c] * g1); }
        }
        LDS_WAIT(); asm volatile("" ::: "memory");
#pragma unroll
        for (int st = 0; st < 8; ++st) { const int row = 8 * st + nr; const LAS unsigned* tp = tile + row * 33 + 4 * kch;
            v4u o; o.x = tp[0]; o.y = tp[1]; o.z = tp[2]; o.w = tp[3];
            const int ng = n0 + row; const int drow = MODE == 0 ? ng : (MODE == 1 ? 256 * (ng >> 7) + (ng & 127) : 256 * (ng >> 7) + 128 + (ng & 127));
            if (ng < N) *(GAS v4u*)(WT + (size_t)drow * K + kb + 8 * kch) = o; }
        LDS_WAIT(); asm volatile("" ::: "memory");
    }
}
__device__ __forceinline__ void p0_row(Frame& F, const float* x, const float* meta, float* out, int r) {
    float* hrow = h_row(out, F.ws, r); bf16* xrow = (bf16*)(F.ws + WS_XB) + (size_t)r * DM;
    const float* src = r < MTOK ? x + (size_t)r * DM : meta + (size_t)((r - MTOK) & 15) * DM;
    const bool pad = r >= MTOK + NB * NMETA;
    float s = 0.f;
#pragma unroll 4
    for (int j = 0; j < 16; ++j) { const int e = (F.lane + 64 * j) * 4;
        f32x4 v = pad ? (f32x4){0.f, 0.f, 0.f, 0.f} : *(const GAS f32x4*)(src + e);
        s += (v.x * v.x + v.y * v.y) + (v.z * v.z + v.w * v.w);
        *(GAS f32x4*)(hrow + e) = v; v2u w; w.x = pk2(v.x, v.y); w.y = pk2(v.z, v.w); *(GAS v2u*)(xrow + e) = w; }
    s = wave_sum(s);
    if (F.lane == 0) ((float*)(F.ws + WS_SSQ0))[r] = s;
}
constexpr int P0_KC = 256;
constexpr int CV_G = 172 * (DM / P0_KC), CV_D = 64 * (DFF / P0_KC), CV_IN1 = 384 * (DM / P0_KC), CV_O1 = 64 * (RET_VW / P0_KC);
constexpr int CV_FINE = 2 * (2 * CV_G + CV_D) + CV_IN1 + CV_O1;
constexpr int CV_PER = 32, N_CONV = (CV_FINE + CV_PER - 1) / CV_PER;
struct ConvPtrs { const float *wg, *wu, *wd, *win1, *wo1, *fnorm, *cnorm; };
__device__ __forceinline__ void conv_fine_b2(unsigned char* ws, LAS unsigned* tile, const ConvPtrs P, int it, int lane) {
    int r = it;
    if (r < CV_G) { p0_tr<1, P0_KC>(P.wg, DM, DFF, P.fnorm, (bf16*)(ws + WS_WGU0), tile, r, lane); return; } r -= CV_G;
    if (r < CV_G) { p0_tr<2, P0_KC>(P.wu, DM, DFF, P.fnorm, (bf16*)(ws + WS_WGU0), tile, r, lane); return; } r -= CV_G;
    if (r < CV_D) { p0_tr<0, P0_KC>(P.wd, DFF, DM, nullptr, (bf16*)(ws + WS_WD0), tile, r, lane); return; } r -= CV_D;
    if (r < CV_IN1) { p0_tr<0, P0_KC>(P.win1, DM, RET_IN, P.cnorm, (bf16*)(ws + WS_WIN1), tile, r, lane); return; } r -= CV_IN1;
    if (r < CV_O1) { p0_tr<0, P0_KC>(P.wo1, RET_VW, DM, nullptr, (bf16*)(ws + WS_WOUT1), tile, r, lane); return; } r -= CV_O1;
    if (r < CV_G) { p0_tr<1, P0_KC>(P.wg + (size_t)DM * DFF, DM, DFF, P.fnorm + DM, (bf16*)(ws + WS_WGU1), tile, r, lane); return; } r -= CV_G;
    if (r < CV_G) { p0_tr<2, P0_KC>(P.wu + (size_t)DM * DFF, DM, DFF, P.fnorm + DM, (bf16*)(ws + WS_WGU1), tile, r, lane); return; } r -= CV_G;
    p0_tr<0, P0_KC>(P.wd + (size_t)DFF * DM, DFF, DM, nullptr, (bf16*)(ws + WS_WD1), tile, r, lane);
}
__device__ __forceinline__ void conv_item(unsigned char* ws, LAS unsigned char* ldsb, ConvPtrs P, int ci, int wave, int lane) {
    LAS unsigned* tile = (LAS unsigned*)(ldsb + wave * 8448);
    for (int k = wave; k < CV_PER; k += NWAVES) { const int it = __builtin_amdgcn_readfirstlane(ci * CV_PER + k); if (it < CV_FINE) conv_fine_b2(ws, tile, P, it, lane); }
}
__device__ __forceinline__ void p0_prologue(Frame& F, const Args& A) {
    const int gw = __builtin_amdgcn_readfirstlane(blockIdx.x * NWAVES + F.wave), NGW = F.G * NWAVES;
    unsigned char* ws = F.ws;
    constexpr int KC = P0_KC; LAS unsigned* tile = (LAS unsigned*)(F.lds + F.wave * 8448);
    constexpr int I_IN0 = 161 * (DM / KC), I_SQ = 64 * (DM / KC), I_BD = 16 * 2;
    constexpr int NITEMS = I_IN0 + I_SQ + 2 * I_BD;
    for (int it = gw; it < NITEMS; it += NGW) {
        int r = it;
        if (r < I_IN0) { p0_tr<0, KC>(A.in[3], DM, AB_IN, A.in[2], (bf16*)(ws + WS_WIN0), tile, r, F.lane); continue; } r -= I_IN0;
        if (r < I_SQ) { p0_tr<0, KC>(A.in[14], DM, DM, nullptr, (bf16*)(ws + WS_WOUT0), tile, r, F.lane); continue; } r -= I_SQ;
        if (r < I_BD) { const int blk = r >> 1; p0_tr<0, 128>(A.in[7] + (size_t)blk * 16384, 128, 128, nullptr, (bf16*)(ws + WS_WAT) + (size_t)blk * 16384, tile, r & 1, F.lane); continue; } r -= I_BD;
        { const int blk = r >> 1; p0_tr<0, 128>(A.in[9] + (size_t)blk * 16384, 128, 128, nullptr, (bf16*)(ws + WS_WXT) + (size_t)blk * 16384, tile, r & 1, F.lane); }
    }
    for (int m = gw; m < MP; m += NGW) p0_row(F, A.in[0], A.in[1], A.out, m);
}

__device__ __forceinline__ float sigmoidf_fast(float x) { return __builtin_amdgcn_rcpf(1.0f + __expf(-x)); }
__device__ __forceinline__ float gelu_tanh(float g) { const float z = 0.7978845608028654f * (g + 0.044715f * g * g * g); const float e = __expf(2.0f * z); return 0.5f * g * (2.0f - 2.0f * __builtin_amdgcn_rcpf(e + 1.0f)); }

constexpr int LRU_XA = 0, LRU_XA_STRIDE = 272, LRU_XF = 17408, LRU_XF_STRIDE = 132  , LRU_SA = 51200, LRU_SB = 83968, LRU_CARRY = 116736;
__device__ __forceinline__ void lru_item(Frame& F, const Args& A, int b, int n) {
    const bf16* z0 = (const bf16*)(F.ws + WS_Z); bf16* y0 = (bf16*)(F.ws + WS_Y0);
    const int tid = F.tid, lane = F.lane, w = F.wave, fr = lane & 15, fq = lane >> 4;
    LAS unsigned char* lds = F.lds;
    LAS float* XF = (LAS float*)(lds + LRU_XF); LAS float* SA = (LAS float*)(lds + LRU_SA); LAS float* SB = (LAS float*)(lds + LRU_SB); LAS float* CARRY = (LAS float*)(lds + LRU_CARRY);
    const int c8 = (tid & 15) * 8, r4 = tid >> 4;
    const int ch0 = n * 128 + c8;
    float cw[4][8], cb[8];
#pragma unroll
    for (int e = 0; e < 8; ++e) { cb[e] = A.in[6][ch0 + e];
#pragma unroll
        for (int j = 0; j < 4; ++j) cw[j][e] = A.in[5][j * LRU_W + ch0 + e]; }
    const int dch = n * 128 + 16 * w + fr;
    const float ba = A.in[8][dch], bx = A.in[10][dch];
    const float cneg = -8.0f * log1pf(expf(-A.in[11][dch]));
    bf16x8 bwa[4], bwx[4];
    { const bf16* wat = (const bf16*)(F.ws + WS_WAT) + ((size_t)n * 128 + 16 * w + fr) * 128 + 8 * fq; const bf16* wxt = (const bf16*)(F.ws + WS_WXT) + ((size_t)n * 128 + 16 * w + fr) * 128 + 8 * fq;
#pragma unroll
      for (int ks = 0; ks < 4; ++ks) { bwa[ks] = *(const bf16x8*)(wat + 32 * ks); bwx[ks] = *(const bf16x8*)(wxt + 32 * ks); } }
    if (tid < 128) CARRY[tid] = 0.f;
    for (int tau = 0; tau < 65; ++tau) {
        v4u gv[2];
#pragma unroll
        for (int q = 0; q < 2; ++q) {
            const int rr = r4 + 32 * q, t = 64 * tau + rr - 48;
            float xc[8];
#pragma unroll
            for (int e = 0; e < 8; ++e) xc[e] = cb[e];
            gv[q] = (v4u){0u, 0u, 0u, 0u};
            if (t >= 0) {
                gv[q] = *(const GAS v4u*)(z0 + (size_t)row_of(b, t) * AB_Z + LRU_W + ch0);
#pragma unroll
                for (int j = 0; j < 4; ++j) { const int tj = t - 3 + j;
                    if (tj >= 0) { const v4u xv = *(const GAS v4u*)(z0 + (size_t)row_of(b, tj) * AB_Z + ch0); float xf[8]; unpack8(xv, xf);
#pragma unroll
                        for (int e = 0; e < 8; ++e) xc[e] += cw[j][e] * xf[e]; } }
            }
            *(LAS v4u*)(lds + LRU_XA + rr * LRU_XA_STRIDE + c8 * 2) = pack8f(xc);
            *(LAS f32x4*)(XF + rr * LRU_XF_STRIDE + c8) = (f32x4){xc[0], xc[1], xc[2], xc[3]};
            *(LAS f32x4*)(XF + rr * LRU_XF_STRIDE + c8 + 4) = (f32x4){xc[4], xc[5], xc[6], xc[7]};
        }
        __syncthreads();
        f32x4 accr[4], acci[4];
#pragma unroll
        for (int m = 0; m < 4; ++m) { accr[m] = (f32x4){0.f, 0.f, 0.f, 0.f}; acci[m] = (f32x4){0.f, 0.f, 0.f, 0.f}; }
#pragma unroll
        for (int m = 0; m < 4; ++m)
#pragma unroll
            for (int ks = 0; ks < 4; ++ks) { const bf16x8 a = *(const LAS bf16x8*)(lds + LRU_XA + (16 * m + fr) * LRU_XA_STRIDE + (32 * ks + 8 * fq) * 2);
                accr[m] = mfma16(a, bwa[ks], accr[m]); acci[m] = mfma16(a, bwx[ks], acci[m]); }
#pragma unroll
        for (int m = 0; m < 4; ++m)
#pragma unroll
            for (int g = 0; g < 4; ++g) { const int rr = 16 * m + 4 * fq + g, d = 16 * w + fr;
                const float rg = sigmoidf_fast(accr[m][g] + ba), ig = sigmoidf_fast(acci[m][g] + bx);
                const float la = cneg * rg; const float av = __expf(la); const float mult = sqrtf(fmaxf(1.0f - __expf(2.0f * la), 0.f));
                float bv = mult * (ig * XF[rr * LRU_XF_STRIDE + d]);
                if (tau == 0 && rr < 48) bv = 0.f;
                SA[rr * 128 + d] = av; SB[rr * 128 + d] = bv; }
        __syncthreads();
        if (tid < 128) { float h = CARRY[tid];
#pragma unroll 8
            for (int rr = 0; rr < 64; ++rr) { h = SA[rr * 128 + tid] * h + SB[rr * 128 + tid]; SB[rr * 128 + tid] = h; }
            CARRY[tid] = h; }
        __syncthreads();
#pragma unroll
        for (int q = 0; q < 2; ++q) {
            const int rr = r4 + 32 * q, t = 64 * tau + rr - 48;
            if (t >= 0) { float gf[8], o[8]; unpack8(gv[q], gf);
                const f32x4 h0 = *(const LAS f32x4*)(SB + rr * 128 + c8), h1 = *(const LAS f32x4*)(SB + rr * 128 + c8 + 4);
#pragma unroll
                for (int e = 0; e < 4; ++e) { o[e] = h0[e] * gelu_tanh(gf[e]); o[e + 4] = h1[e] * gelu_tanh(gf[e + 4]); }
                *(GAS v4u*)(y0 + (size_t)row_of(b, t) * DM + ch0) = pack8f(o); }
        }
    }
    __syncthreads();
}

constexpr int AT_KT = 0, AT_STRIDE = 272, AT_VN = 17408, AT_CUM = 34816, AT_SCAN = 52224;
__device__ __forceinline__ float log_sigmoid(float x) { return fminf(x, 0.f) - log1pf(__expf(-fabsf(x))); }
__device__ __forceinline__ void attn_item(Frame& F, const Args& A, int b, int h, int j) {
    const bf16* z0 = (const bf16*)(F.ws + WS_Z); bf16* y0 = (bf16*)(F.ws + WS_Y0); const float* fbuf = (const float*)(F.ws + WS_FBUF);
    const int tid = F.tid, lane = F.lane, w = F.wave, fr = lane & 15, fq = lane >> 4;
    LAS unsigned char* lds = F.lds;
    LAS float* CUM = (LAS float*)(lds + AT_CUM); LAS float* SCAN = (LAS float*)(lds + AT_SCAN);
    constexpr float LOG2E = 1.4426950408889634f;
    const int nT = NMETA + 256 * j;
    { const float bf_h = A.in[4][h];
      float loc[9]; float run = 0.f;
#pragma unroll
      for (int e = 0; e < 9; ++e) { const int t = 9 * tid + e; float v = 0.f; if (t < nT) v = log_sigmoid(fbuf[(size_t)row_of(b, t) * 16 + h] + bf_h); run += v; loc[e] = run; }
      float inc = run;
#pragma unroll
      for (int o = 1; o < 64; o <<= 1) { const float t = __shfl_up(inc, o); if (lane >= o) inc += t; }
      if (lane == 63) SCAN[w] = inc;
      __syncthreads();
      float off = inc - run;
      for (int k = 0; k < w; ++k) off += SCAN[k];
#pragma unroll
      for (int e = 0; e < 9; ++e) { const int t = 9 * tid + e; if (t < nT) CUM[t + 240] = (off + loc[e]) * LOG2E; }
      if (tid < 240) CUM[tid] = 0.f;
      __syncthreads(); }
    bf16x8 qf[2][4]; float bq[2];
    const int ubase = 256 * j + 32 * w;
#pragma unroll
    for (int m = 0; m < 2; ++m) {
        const int u = ubase + 16 * m + fr; const int t = u - 240; const int r = row_of(b, t < 0 ? 0 : t);
        const bf16* qp = z0 + (size_t)r * AB_Z + 4096 + 128 * h + 8 * fq;
        float qv[4][8]; float s = 0.f;
#pragma unroll
        for (int ks = 0; ks < 4; ++ks) { const v4u raw = *(const GAS v4u*)(qp + 32 * ks); unpack8(raw, qv[ks]);
#pragma unroll
            for (int e = 0; e < 8; ++e) s += qv[ks][e] * qv[ks][e]; }
        s += __shfl_xor(s, 16); s += __shfl_xor(s, 32);
        const float rs = (1.0f / sqrtf(s * (1.0f / 128.0f) + RMS_EPS)) * (0.08838834764831845f * LOG2E);
#pragma unroll
        for (int ks = 0; ks < 4; ++ks) { float o[8];
#pragma unroll
            for (int e = 0; e < 8; ++e) o[e] = qv[ks][e] * rs * A.in[12][32 * ks + 8 * fq + e];
            const v4u pk = pack8f(o); qf[m][ks] = __builtin_bit_cast(bf16x8, pk); }
        bq[m] = CUM[u];
    }
    f32x4 O[2][8]; float mrow[2], lrow[2];
#pragma unroll
    for (int m = 0; m < 2; ++m) {
#pragma unroll
        for (int dt = 0; dt < 8; ++dt) O[m][dt] = (f32x4){0.f, 0.f, 0.f, 0.f};
        mrow[m] = -1e30f; lrow[m] = 0.f; }
    const int imax = 4 * j + 3;
    const int skey = tid >> 3, sdc = (tid & 7) * 16;
    const unsigned vbase = (unsigned)(size_t)lds + AT_VN + (4u * fq + ((unsigned)(lane & 15) >> 2)) * AT_STRIDE + 8u * (unsigned)(lane & 3);
    v4u kreg[2], vreg[2];
    { const int t = 64 * 3 + skey - 240; const int r = row_of(b, t < 0 ? 0 : t); const bf16* kp = z0 + (size_t)r * AB_Z + 6144 + 128 * h + sdc; const bf16* vp = z0 + (size_t)r * AB_Z + 8192 + 128 * h + sdc;
      kreg[0] = *(const GAS v4u*)(kp); kreg[1] = *(const GAS v4u*)(kp + 8); vreg[0] = *(const GAS v4u*)(vp); vreg[1] = *(const GAS v4u*)(vp + 8); }
    for (int i = 3; i <= imax; ++i) {
        __syncthreads();
        { float kv[16]; { float a8[8], b8[8]; unpack8(kreg[0], a8); unpack8(kreg[1], b8);
#pragma unroll
            for (int e = 0; e < 8; ++e) { kv[e] = a8[e]; kv[8 + e] = b8[e]; } }
          float s = 0.f;
#pragma unroll
          for (int e = 0; e < 16; ++e) s += kv[e] * kv[e];
          s += __shfl_xor(s, 1); s += __shfl_xor(s, 2); s += __shfl_xor(s, 4);
          const float rs = 1.0f / sqrtf(s * (1.0f / 128.0f) + RMS_EPS);
          float o0[8], o1[8];
          { const f32x4 g0 = *(const GAS f32x4*)(A.in[13] + sdc), g1 = *(const GAS f32x4*)(A.in[13] + sdc + 4), g2 = *(const GAS f32x4*)(A.in[13] + sdc + 8), g3 = *(const GAS f32x4*)(A.in[13] + sdc + 12);
#pragma unroll
          for (int e = 0; e < 4; ++e) { o0[e] = kv[e] * rs * g0[e]; o0[4 + e] = kv[4 + e] * rs * g1[e]; o1[e] = kv[8 + e] * rs * g2[e]; o1[4 + e] = kv[12 + e] * rs * g3[e]; } }
          *(LAS v4u*)(lds + AT_KT + skey * AT_STRIDE + sdc * 2) = pack8f(o0);
          *(LAS v4u*)(lds + AT_KT + skey * AT_STRIDE + sdc * 2 + 16) = pack8f(o1);
          *(LAS v4u*)(lds + AT_VN + skey * AT_STRIDE + sdc * 2) = vreg[0];
          *(LAS v4u*)(lds + AT_VN + skey * AT_STRIDE + sdc * 2 + 16) = vreg[1]; }
        __syncthreads();
        if (i < imax) { const int t = 64 * (i + 1) + skey - 240; const int r = row_of(b, t); const bf16* kp = z0 + (size_t)r * AB_Z + 6144 + 128 * h + sdc; const bf16* vp = z0 + (size_t)r * AB_Z + 8192 + 128 * h + sdc;
            kreg[0] = *(const GAS v4u*)(kp); kreg[1] = *(const GAS v4u*)(kp + 8); vreg[0] = *(const GAS v4u*)(vp); vreg[1] = *(const GAS v4u*)(vp + 8); }
        if (64 * i <= ubase + 31) {
            f32x4 S[2][4];
#pragma unroll
            for (int m = 0; m < 2; ++m)
#pragma unroll
                for (int nt = 0; nt < 4; ++nt) S[m][nt] = (f32x4){0.f, 0.f, 0.f, 0.f};
#pragma unroll
            for (int nt = 0; nt < 4; ++nt)
#pragma unroll
                for (int ks = 0; ks < 4; ++ks) { const bf16x8 kf = *(const LAS bf16x8*)(lds + AT_KT + (16 * nt + fr) * AT_STRIDE + (32 * ks + 8 * fq) * 2);
                    S[0][nt] = mfma16(kf, qf[0][ks], S[0][nt]); S[1][nt] = mfma16(kf, qf[1][ks], S[1][nt]); }
            f32x4 bk[4];
#pragma unroll
            for (int nt = 0; nt < 4; ++nt) bk[nt] = *(const LAS f32x4*)(CUM + 64 * i + 16 * nt + 4 * fq);
            const bool need_mask = (i == 3) || (64 * i + 63 > ubase);
            bf16x8 pb[2][2];
#pragma unroll
            for (int m = 0; m < 2; ++m) {
                const int uq = ubase + 16 * m + fr;
                float mx = -__builtin_inff();
#pragma unroll
                for (int nt = 0; nt < 4; ++nt)
#pragma unroll
                    for (int g = 0; g < 4; ++g) { float sv = S[m][nt][g] + (bq[m] - bk[nt][g]);
                        if (need_mask) { const int uk = 64 * i + 16 * nt + 4 * fq + g; if (uk > uq || uk < 240) sv = -__builtin_inff(); }
                        S[m][nt][g] = sv; mx = fmaxf(mx, sv); }
                mx = fmaxf(mx, __shfl_xor(mx, 16)); mx = fmaxf(mx, __shfl_xor(mx, 32));
                const float mn = fmaxf(mrow[m], mx);
                const float alpha = __builtin_amdgcn_exp2f(mrow[m] - mn); mrow[m] = mn;
                float ps = 0.f;
#pragma unroll
                for (int nt = 0; nt < 4; ++nt)
#pragma unroll
                    for (int g = 0; g < 4; ++g) { const float p = __builtin_amdgcn_exp2f(S[m][nt][g] - mn); ps += p; S[m][nt][g] = p; }
                lrow[m] = lrow[m] * alpha + ps;
#pragma unroll
                for (int dt = 0; dt < 8; ++dt) O[m][dt] *= alpha;
#pragma unroll
                for (int k2 = 0; k2 < 2; ++k2) { v4u pw; pw.x = pk2(S[m][2 * k2][0], S[m][2 * k2][1]); pw.y = pk2(S[m][2 * k2][2], S[m][2 * k2][3]); pw.z = pk2(S[m][2 * k2 + 1][0], S[m][2 * k2 + 1][1]); pw.w = pk2(S[m][2 * k2 + 1][2], S[m][2 * k2 + 1][3]);
                    pb[m][k2] = __builtin_bit_cast(bf16x8, pw); }
            }
            { v2u vp[16]; asm volatile("ds_read_b64_tr_b16 %0, %16 offset:0 \n\tds_read_b64_tr_b16 %1, %16 offset:4352 \n\tds_read_b64_tr_b16 %2, %16 offset:8704 \n\tds_read_b64_tr_b16 %3, %16 offset:13056 \n\tds_read_b64_tr_b16 %4, %16 offset:32 \n\tds_read_b64_tr_b16 %5, %16 offset:4384 \n\tds_read_b64_tr_b16 %6, %16 offset:8736 \n\tds_read_b64_tr_b16 %7, %16 offset:13088 \n\tds_read_b64_tr_b16 %8, %16 offset:64 \n\tds_read_b64_tr_b16 %9, %16 offset:4416 \n\tds_read_b64_tr_b16 %10, %16 offset:8768 \n\tds_read_b64_tr_b16 %11, %16 offset:13120 \n\tds_read_b64_tr_b16 %12, %16 offset:96 \n\tds_read_b64_tr_b16 %13, %16 offset:4448 \n\tds_read_b64_tr_b16 %14, %16 offset:8800 \n\tds_read_b64_tr_b16 %15, %16 offset:13152 \n\ts_waitcnt lgkmcnt(0)" : "=&v"(vp[0]), "=&v"(vp[1]), "=&v"(vp[2]), "=&v"(vp[3]), "=&v"(vp[4]), "=&v"(vp[5]), "=&v"(vp[6]), "=&v"(vp[7]), "=&v"(vp[8]), "=&v"(vp[9]), "=&v"(vp[10]), "=&v"(vp[11]), "=&v"(vp[12]), "=&v"(vp[13]), "=&v"(vp[14]), "=&v"(vp[15]) : "v"(vbase) : "memory");
              { v4u aw; aw.x = vp[0].x; aw.y = vp[0].y; aw.z = vp[1].x; aw.w = vp[1].y; const bf16x8 vfr = __builtin_bit_cast(bf16x8, aw); O[0][0] = mfma16(vfr, pb[0][0], O[0][0]); O[1][0] = mfma16(vfr, pb[1][0], O[1][0]); }
              { v4u aw; aw.x = vp[2].x; aw.y = vp[2].y; aw.z = vp[3].x; aw.w = vp[3].y; const bf16x8 vfr = __builtin_bit_cast(bf16x8, aw); O[0][0] = mfma16(vfr, pb[0][1], O[0][0]); O[1][0] = mfma16(vfr, pb[1][1], O[1][0]); }
              { v4u aw; aw.x = vp[4].x; aw.y = vp[4].y; aw.z = vp[5].x; aw.w = vp[5].y; const bf16x8 vfr = __builtin_bit_cast(bf16x8, aw); O[0][1] = mfma16(vfr, pb[0][0], O[0][1]); O[1][1] = mfma16(vfr, pb[1][0], O[1][1]); }
              { v4u aw; aw.x = vp[6].x; aw.y = vp[6].y; aw.z = vp[7].x; aw.w = vp[7].y; const bf16x8 vfr = __builtin_bit_cast(bf16x8, aw); O[0][1] = mfma16(vfr, pb[0][1], O[0][1]); O[1][1] = mfma16(vfr, pb[1][1], O[1][1]); }
              { v4u aw; aw.x = vp[8].x; aw.y = vp[8].y; aw.z = vp[9].x; aw.w = vp[9].y; const bf16x8 vfr = __builtin_bit_cast(bf16x8, aw); O[0][2] = mfma16(vfr, pb[0][0], O[0][2]); O[1][2] = mfma16(vfr, pb[1][0], O[1][2]); }
              { v4u aw; aw.x = vp[10].x; aw.y = vp[10].y; aw.z = vp[11].x; aw.w = vp[11].y; const bf16x8 vfr = __builtin_bit_cast(bf16x8, aw); O[0][2] = mfma16(vfr, pb[0][1], O[0][2]); O[1][2] = mfma16(vfr, pb[1][1], O[1][2]); }
              { v4u aw; aw.x = vp[12].x; aw.y = vp[12].y; aw.z = vp[13].x; aw.w = vp[13].y; const bf16x8 vfr = __builtin_bit_cast(bf16x8, aw); O[0][3] = mfma16(vfr, pb[0][0], O[0][3]); O[1][3] = mfma16(vfr, pb[1][0], O[1][3]); }
              { v4u aw; aw.x = vp[14].x; aw.y = vp[14].y; aw.z = vp[15].x; aw.w = vp[15].y; const bf16x8 vfr = __builtin_bit_cast(bf16x8, aw); O[0][3] = mfma16(vfr, pb[0][1], O[0][3]); O[1][3] = mfma16(vfr, pb[1][1], O[1][3]); }
            }
            { v2u vp[16]; asm volatile("ds_read_b64_tr_b16 %0, %16 offset:128 \n\tds_read_b64_tr_b16 %1, %16 offset:4480 \n\tds_read_b64_tr_b16 %2, %16 offset:8832 \n\tds_read_b64_tr_b16 %3, %16 offset:13184 \n\tds_read_b64_tr_b16 %4, %16 offset:160 \n\tds_read_b64_tr_b16 %5, %16 offset:4512 \n\tds_read_b64_tr_b16 %6, %16 offset:8864 \n\tds_read_b64_tr_b16 %7, %16 offset:13216 \n\tds_read_b64_tr_b16 %8, %16 offset:192 \n\tds_read_b64_tr_b16 %9, %16 offset:4544 \n\tds_read_b64_tr_b16 %10, %16 offset:8896 \n\tds_read_b64_tr_b16 %11, %16 offset:13248 \n\tds_read_b64_tr_b16 %12, %16 offset:224 \n\tds_read_b64_tr_b16 %13, %16 offset:4576 \n\tds_read_b64_tr_b16 %14, %16 offset:8928 \n\tds_read_b64_tr_b16 %15, %16 offset:13280 \n\ts_waitcnt lgkmcnt(0)" : "=&v"(vp[0]), "=&v"(vp[1]), "=&v"(vp[2]), "=&v"(vp[3]), "=&v"(vp[4]), "=&v"(vp[5]), "=&v"(vp[6]), "=&v"(vp[7]), "=&v"(vp[8]), "=&v"(vp[9]), "=&v"(vp[10]), "=&v"(vp[11]), "=&v"(vp[12]), "=&v"(vp[13]), "=&v"(vp[14]), "=&v"(vp[15]) : "v"(vbase) : "memory");
              { v4u aw; aw.x = vp[0].x; aw.y = vp[0].y; aw.z = vp[1].x; aw.w = vp[1].y; const bf16x8 vfr = __builtin_bit_cast(bf16x8, aw); O[0][4] = mfma16(vfr, pb[0][0], O[0][4]); O[1][4] = mfma16(vfr, pb[1][0], O[1][4]); }
              { v4u aw; aw.x = vp[2].x; aw.y = vp[2].y; aw.z = vp[3].x; aw.w = vp[3].y; const bf16x8 vfr = __builtin_bit_cast(bf16x8, aw); O[0][4] = mfma16(vfr, pb[0][1], O[0][4]); O[1][4] = mfma16(vfr, pb[1][1], O[1][4]); }
              { v4u aw; aw.x = vp[4].x; aw.y = vp[4].y; aw.z = vp[5].x; aw.w = vp[5].y; const bf16x8 vfr = __builtin_bit_cast(bf16x8, aw); O[0][5] = mfma16(vfr, pb[0][0], O[0][5]); O[1][5] = mfma16(vfr, pb[1][0], O[1][5]); }
              { v4u aw; aw.x = vp[6].x; aw.y = vp[6].y; aw.z = vp[7].x; aw.w = vp[7].y; const bf16x8 vfr = __builtin_bit_cast(bf16x8, aw); O[0][5] = mfma16(vfr, pb[0][1], O[0][5]); O[1][5] = mfma16(vfr, pb[1][1], O[1][5]); }
              { v4u aw; aw.x = vp[8].x; aw.y = vp[8].y; aw.z = vp[9].x; aw.w = vp[9].y; const bf16x8 vfr = __builtin_bit_cast(bf16x8, aw); O[0][6] = mfma16(vfr, pb[0][0], O[0][6]); O[1][6] = mfma16(vfr, pb[1][0], O[1][6]); }
              { v4u aw; aw.x = vp[10].x; aw.y = vp[10].y; aw.z = vp[11].x; aw.w = vp[11].y; const bf16x8 vfr = __builtin_bit_cast(bf16x8, aw); O[0][6] = mfma16(vfr, pb[0][1], O[0][6]); O[1][6] = mfma16(vfr, pb[1][1], O[1][6]); }
              { v4u aw; aw.x = vp[12].x; aw.y = vp[12].y; aw.z = vp[13].x; aw.w = vp[13].y; const bf16x8 vfr = __builtin_bit_cast(bf16x8, aw); O[0][7] = mfma16(vfr, pb[0][0], O[0][7]); O[1][7] = mfma16(vfr, pb[1][0], O[1][7]); }
              { v4u aw; aw.x = vp[14].x; aw.y = vp[14].y; aw.z = vp[15].x; aw.w = vp[15].y; const bf16x8 vfr = __builtin_bit_cast(bf16x8, aw); O[0][7] = mfma16(vfr, pb[0][1], O[0][7]); O[1][7] = mfma16(vfr, pb[1][1], O[1][7]); }
            }
        }
    }
#pragma unroll
    for (int m = 0; m < 2; ++m) {
        float l = lrow[m]; l += __shfl_xor(l, 16); l += __shfl_xor(l, 32);
        const int t = ubase + 16 * m + fr - 240;
        if (t >= 0) { const float il = 1.0f / l; bf16* op = y0 + (size_t)row_of(b, t) * DM + LRU_W + 128 * h + 4 * fq;
#pragma unroll
            for (int dt = 0; dt < 8; ++dt) { v2u o; o.x = pk2(O[m][dt][0] * il, O[m][dt][1] * il); o.y = pk2(O[m][dt][2] * il, O[m][dt][3] * il); *(GAS v2u*)(op + 16 * dt) = o; } }
    }
    __syncthreads();
}

__device__ __forceinline__ int p2_fetch(Frame& F, gu32* qctr) {
    if (F.tid == 0) F.MISC[0] = __hip_atomic_fetch_add(qctr, 1u, RLX_AGENT);
    __syncthreads();
    const int item = (int)F.MISC[0];
    __syncthreads();
    return item;
}
__device__ __forceinline__ void p2_mixer0(Frame& F, const Args& A, int rep) {
    gu32* qctr = (gu32*)(F.ws + WS_CTL) + CW_Q2 + 64 * rep;
    constexpr int N_LRU = NB * 16, N_ATT = NB * FOX_H * 17;
    constexpr int RB = (N_ATT / 3) < (N_CONV / 2) ? (N_ATT / 3) : (N_CONV / 2), REM_ATT = N_ATT - 3 * RB, REM_CONV = N_CONV - 2 * RB;
    int item = p2_fetch(F, qctr);
    while (item < N_LRU) { lru_item(F, A, item >> 4, item & 15); item = p2_fetch(F, qctr); }
    while (item < N_LRU + N_ATT + N_CONV) {
        const int y = item - N_LRU; int att = -1, cv = -1;
        if (y < 5 * RB) { const int blk = y / 5, sl = y - 5 * blk; if (sl == 1 || sl == 3) cv = 2 * blk + (sl >> 1); else att = 3 * blk + (sl >> 1); }
        else { const int y2 = y - 5 * RB; if (y2 < REM_ATT) att = 3 * RB + y2; else cv = 2 * RB + (y2 - REM_ATT); }
        if (rep != 0) cv = -2;
        Frame G = F; { int tz = F.tid; asm volatile("" : "+v"(tz)); G.tid = tz; G.lane = tz & 63; G.wave = __builtin_amdgcn_readfirstlane(tz >> 6); }
        if (att >= 0) { const int j = 16 - att / 64, bh = att % 64; attn_item(G, A, bh >> 4, bh & 15, j); }
        else if (cv >= 0) { const ConvPtrs CP{A.in[20], A.in[21], A.in[22], A.in[16], A.in[18], A.in[19], A.in[15]}; conv_item(G.ws, G.lds, CP, cv, G.wave, G.lane); }
        item = p2_fetch(F, qctr);
    }
}

constexpr int RT_SQ = 528, RT_SV = 272, RT_SS_STRIDE = 144;
constexpr int RT_QS = 0, RT_KN = 33792, RT_VN = 67584, RT_VS = 84992, RT_SS = 102400;
static_assert(RT_KN == 64 * RT_SQ && RT_VN == RT_KN + 64 * RT_SQ && RT_VS == RT_VN + 64 * RT_SV && RT_SS == RT_VS + 64 * RT_SV && RT_SS + 64 * RT_SS_STRIDE <= MISC_OFF, "retention LDS map");
__device__ __forceinline__ int ret_row(int b, int c, int idx) { return c == 0 ? (idx < 48 ? -1 : MMETA + NMETA * b + (idx - 48)) : b * SEQ + 64 * (c - 1) + idx; }
__device__ __forceinline__ void ret_item(Frame& F, const Args& A, int b, int h, int es, bool accum) {
    const bf16* z1 = (const bf16*)(F.ws + WS_Z); bf16* ob = (bf16*)(F.ws + WS_Y1); float* ssqo = (float*)(F.ws + WS_SSQO);
    const int tid = F.tid, lane = F.lane, w = F.wave, fr = lane & 15, fq = lane >> 4;
    LAS unsigned char* lds = F.lds;
    const float lg = log1pf(-exp2f(-5.0f - (float)h)) * 1.4426950408889634f;
    const float cdec = __builtin_amdgcn_exp2f(lg * 64.0f);
    f32x4 Sacc[16];
#pragma unroll
    for (int dt = 0; dt < 16; ++dt) Sacc[dt] = (f32x4){0.f, 0.f, 0.f, 0.f};
    const int qrow = tid >> 5, qd = (tid & 31) * 8;
    const int vrow = tid >> 4, ve = (tid & 15) * 8;
    const float kd0 = __builtin_amdgcn_exp2f(lg * (float)(63 - vrow)), kd1 = __builtin_amdgcn_exp2f(lg * (float)(31 - vrow));
    const unsigned lbase = (unsigned)(size_t)lds;
    const unsigned trq = (unsigned)((lane & 15) >> 2), trp = (unsigned)(lane & 3);
    const unsigned kbase = lbase + RT_KN + (8u * fq + trq) * RT_SQ + 8u * trp;
    const unsigned vbase = lbase + RT_VN + (8u * fq + trq) * RT_SV + 32u * w + 8u * trp;
    const unsigned vsbase = vbase + (RT_VS - RT_VN);
    v4u qreg[4], kreg[4], vreg[2];
    const size_t qcol = (size_t)h * RET_QK + qd, kcol = 4096 + (size_t)h * RET_QK + qd, vcol = 8192 + (size_t)h * RET_V + 128 * es + ve;
#define RT_PREFETCH(c) do { \
        _Pragma("unroll") for (int k = 0; k < 4; ++k) { const int r = ret_row(b, (c), qrow + 16 * k); \
            if (r >= 0) { qreg[k] = *(const GAS v4u*)(z1 + (size_t)r * RET_IN + qcol); kreg[k] = *(const GAS v4u*)(z1 + (size_t)r * RET_IN + kcol); } \
            else { qreg[k] = (v4u){0u, 0u, 0u, 0u}; kreg[k] = (v4u){0u, 0u, 0u, 0u}; } } \
        _Pragma("unroll") for (int k = 0; k < 2; ++k) { const int r = ret_row(b, (c), vrow + 32 * k); \
            if (r >= 0) vreg[k] = *(const GAS v4u*)(z1 + (size_t)r * RET_IN + vcol); else vreg[k] = (v4u){0u, 0u, 0u, 0u}; } } while (0)
    RT_PREFETCH(0);
    for (int c = 0; c < 65; ++c) {
        __syncthreads();
#pragma unroll
        for (int k = 0; k < 4; ++k) { const int m = qrow + 16 * k;
            *(LAS v4u*)(lds + RT_QS + m * RT_SQ + qd * 2) = qreg[k];
            *(LAS v4u*)(lds + RT_KN + m * RT_SQ + qd * 2) = kreg[k]; }
#pragma unroll
        for (int k = 0; k < 2; ++k) { const int m = vrow + 32 * k; float vf8[8]; unpack8(vreg[k], vf8); const float kd = k == 0 ? kd0 : kd1;
            *(LAS v4u*)(lds + RT_VN + m * RT_SV + ve * 2) = vreg[k];
#pragma unroll
            for (int e = 0; e < 8; ++e) vf8[e] *= kd;
            *(LAS v4u*)(lds + RT_VS + m * RT_SV + ve * 2) = pack8f(vf8); }
        __syncthreads();
        if (c < 64) RT_PREFETCH(c + 1);
        { const int it = w >> 1, mt0 = 2 * (w & 1);
          f32x4 sacc[2] = {(f32x4){0.f, 0.f, 0.f, 0.f}, (f32x4){0.f, 0.f, 0.f, 0.f}};
#pragma unroll
          for (int ks = 0; ks < 8; ++ks) { const bf16x8 a = *(const LAS bf16x8*)(lds + RT_QS + (16 * it + fr) * RT_SQ + (32 * ks + 8 * fq) * 2);
#pragma unroll
              for (int q = 0; q < 2; ++q) { const bf16x8 kb = *(const LAS bf16x8*)(lds + RT_KN + (16 * (mt0 + q) + fr) * RT_SQ + (32 * ks + 8 * fq) * 2); sacc[q] = mfma16(a, kb, sacc[q]); } }
#pragma unroll
          for (int q = 0; q < 2; ++q)
#pragma unroll
              for (int g = 0; g < 4; ++g) { const int i = 16 * it + 4 * fq + g, m = 16 * (mt0 + q) + fr; const int dd = i > m ? i - m : m - i;
                  const float sv = sacc[q][g] * __builtin_amdgcn_exp2f(lg * (float)dd);
                  *(LAS unsigned short*)(lds + RT_SS + i * RT_SS_STRIDE + m * 2) = (unsigned short)(pk2(sv, 0.f) & 0xffffu); } }
        __syncthreads();
        f32x4 acc[4];
#pragma unroll
        for (int mi = 0; mi < 4; ++mi) acc[mi] = (f32x4){0.f, 0.f, 0.f, 0.f};
#pragma unroll
        for (int kk = 0; kk < 8; ++kk) {
            v4u bw; bw.x = pk2(Sacc[2 * kk][0], Sacc[2 * kk][1]); bw.y = pk2(Sacc[2 * kk][2], Sacc[2 * kk][3]); bw.z = pk2(Sacc[2 * kk + 1][0], Sacc[2 * kk + 1][1]); bw.w = pk2(Sacc[2 * kk + 1][2], Sacc[2 * kk + 1][3]);
            const bf16x8 bfrag = __builtin_bit_cast(bf16x8, bw);
#pragma unroll
            for (int mi = 0; mi < 4; ++mi) { const LAS unsigned char* qp = lds + RT_QS + (16 * mi + fr) * RT_SQ + (32 * kk + 4 * fq) * 2;
                const v2u lo = *(const LAS v2u*)(qp), hi = *(const LAS v2u*)(qp + 32);
                v4u aw; aw.x = lo.x; aw.y = lo.y; aw.z = hi.x; aw.w = hi.y;
                acc[mi] = mfma16(__builtin_bit_cast(bf16x8, aw), bfrag, acc[mi]); } }
#pragma unroll
        for (int mi = 0; mi < 4; ++mi)
#pragma unroll
            for (int g = 0; g < 4; ++g) acc[mi][g] *= __builtin_amdgcn_exp2f(lg * (float)(16 * mi + 4 * fq + g + 1));
        v2u vp[8];
        asm volatile("ds_read_b64_tr_b16 %0, %4 offset:0 \n\tds_read_b64_tr_b16 %1, %4 offset:1088 \n\tds_read_b64_tr_b16 %2, %4 offset:8704 \n\tds_read_b64_tr_b16 %3, %4 offset:9792 \n\ts_waitcnt lgkmcnt(0)" : "=&v"(vp[0]), "=&v"(vp[1]), "=&v"(vp[2]), "=&v"(vp[3]) : "v"(vbase) : "memory");
        asm volatile("ds_read_b64_tr_b16 %0, %4 offset:0 \n\tds_read_b64_tr_b16 %1, %4 offset:1088 \n\tds_read_b64_tr_b16 %2, %4 offset:8704 \n\tds_read_b64_tr_b16 %3, %4 offset:9792 \n\ts_waitcnt lgkmcnt(0)" : "=&v"(vp[4]), "=&v"(vp[5]), "=&v"(vp[6]), "=&v"(vp[7]) : "v"(vsbase) : "memory");
        bf16x8 vf[2], vs[2];
        { v4u t0; t0.x = vp[0].x; t0.y = vp[0].y; t0.z = vp[1].x; t0.w = vp[1].y; vf[0] = __builtin_bit_cast(bf16x8, t0); v4u t1; t1.x = vp[4].x; t1.y = vp[4].y; t1.z = vp[5].x; t1.w = vp[5].y; vs[0] = __builtin_bit_cast(bf16x8, t1); }
        { v4u t0; t0.x = vp[2].x; t0.y = vp[2].y; t0.z = vp[3].x; t0.w = vp[3].y; vf[1] = __builtin_bit_cast(bf16x8, t0); v4u t1; t1.x = vp[6].x; t1.y = vp[6].y; t1.z = vp[7].x; t1.w = vp[7].y; vs[1] = __builtin_bit_cast(bf16x8, t1); }
#pragma unroll
        for (int mi = 0; mi < 4; ++mi)
#pragma unroll
            for (int k2 = 0; k2 < 2; ++k2) { const bf16x8 a = *(const LAS bf16x8*)(lds + RT_SS + (16 * mi + fr) * RT_SS_STRIDE + (32 * k2 + 8 * fq) * 2); acc[mi] = mfma16(a, vf[k2], acc[mi]); }
        if (c > 0) {
#pragma unroll
            for (int mi = 0; mi < 4; ++mi)
#pragma unroll
                for (int g = 0; g < 4; ++g) { const int r = b * SEQ + 64 * (c - 1) + 16 * mi + 4 * fq + g; const float v = acc[mi][g];
                    ob[(size_t)r * RET_VW + h * RET_V + 128 * es + 16 * w + fr] = (bf16)(pk2(v, 0.f) & 0xffffu);
                    float sq = v * v; sq += __shfl_xor(sq, 1); sq += __shfl_xor(sq, 2); sq += __shfl_xor(sq, 4); sq += __shfl_xor(sq, 8);
                    if (fr == 0 && accum) atomicAdd(ssqo + (size_t)r * 16 + h, sq); }
        }
#pragma unroll
        for (int dt = 0; dt < 16; ++dt) Sacc[dt] *= cdec;
        { v2u kp[16]; asm volatile("ds_read_b64_tr_b16 %0, %16 offset:0 \n\tds_read_b64_tr_b16 %1, %16 offset:2112 \n\tds_read_b64_tr_b16 %2, %16 offset:16896 \n\tds_read_b64_tr_b16 %3, %16 offset:19008 \n\tds_read_b64_tr_b16 %4, %16 offset:32 \n\tds_read_b64_tr_b16 %5, %16 offset:2144 \n\tds_read_b64_tr_b16 %6, %16 offset:16928 \n\tds_read_b64_tr_b16 %7, %16 offset:19040 \n\tds_read_b64_tr_b16 %8, %16 offset:64 \n\tds_read_b64_tr_b16 %9, %16 offset:2176 \n\tds_read_b64_tr_b16 %10, %16 offset:16960 \n\tds_read_b64_tr_b16 %11, %16 offset:19072 \n\tds_read_b64_tr_b16 %12, %16 offset:96 \n\tds_read_b64_tr_b16 %13, %16 offset:2208 \n\tds_read_b64_tr_b16 %14, %16 offset:16992 \n\tds_read_b64_tr_b16 %15, %16 offset:19104 \n\ts_waitcnt lgkmcnt(0)" : "=&v"(kp[0]), "=&v"(kp[1]), "=&v"(kp[2]), "=&v"(kp[3]), "=&v"(kp[4]), "=&v"(kp[5]), "=&v"(kp[6]), "=&v"(kp[7]), "=&v"(kp[8]), "=&v"(kp[9]), "=&v"(kp[10]), "=&v"(kp[11]), "=&v"(kp[12]), "=&v"(kp[13]), "=&v"(kp[14]), "=&v"(kp[15]) : "v"(kbase) : "memory");
          { v4u aw; aw.x = kp[0].x; aw.y = kp[0].y; aw.z = kp[1].x; aw.w = kp[1].y; Sacc[0] = mfma16(__builtin_bit_cast(bf16x8, aw), vs[0], Sacc[0]); }
          { v4u aw; aw.x = kp[2].x; aw.y = kp[2].y; aw.z = kp[3].x; aw.w = kp[3].y; Sacc[0] = mfma16(__builtin_bit_cast(bf16x8, aw), vs[1], Sacc[0]); }
          { v4u aw; aw.x = kp[4].x; aw.y = kp[4].y; aw.z = kp[5].x; aw.w = kp[5].y; Sacc[1] = mfma16(__builtin_bit_cast(bf16x8, aw), vs[0], Sacc[1]); }
          { v4u aw; aw.x = kp[6].x; aw.y = kp[6].y; aw.z = kp[7].x; aw.w = kp[7].y; Sacc[1] = mfma16(__builtin_bit_cast(bf16x8, aw), vs[1], Sacc[1]); }
          { v4u aw; aw.x = kp[8].x; aw.y = kp[8].y; aw.z = kp[9].x; aw.w = kp[9].y; Sacc[2] = mfma16(__builtin_bit_cast(bf16x8, aw), vs[0], Sacc[2]); }
          { v4u aw; aw.x = kp[10].x; aw.y = kp[10].y; aw.z = kp[11].x; aw.w = kp[11].y; Sacc[2] = mfma16(__builtin_bit_cast(bf16x8, aw), vs[1], Sacc[2]); }
          { v4u aw; aw.x = kp[12].x; aw.y = kp[12].y; aw.z = kp[13].x; aw.w = kp[13].y; Sacc[3] = mfma16(__builtin_bit_cast(bf16x8, aw), vs[0], Sacc[3]); }
          { v4u aw; aw.x = kp[14].x; aw.y = kp[14].y; aw.z = kp[15].x; aw.w = kp[15].y; Sacc[3] = mfma16(__builtin_bit_cast(bf16x8, aw), vs[1], Sacc[3]); }
        }
        { v2u kp[16]; asm volatile("ds_read_b64_tr_b16 %0, %16 offset:128 \n\tds_read_b64_tr_b16 %1, %16 offset:2240 \n\tds_read_b64_tr_b16 %2, %16 offset:17024 \n\tds_read_b64_tr_b16 %3, %16 offset:19136 \n\tds_read_b64_tr_b16 %4, %16 offset:160 \n\tds_read_b64_tr_b16 %5, %16 offset:2272 \n\tds_read_b64_tr_b16 %6, %16 offset:17056 \n\tds_read_b64_tr_b16 %7, %16 offset:19168 \n\tds_read_b64_tr_b16 %8, %16 offset:192 \n\tds_read_b64_tr_b16 %9, %16 offset:2304 \n\tds_read_b64_tr_b16 %10, %16 offset:17088 \n\tds_read_b64_tr_b16 %11, %16 offset:19200 \n\tds_read_b64_tr_b16 %12, %16 offset:224 \n\tds_read_b64_tr_b16 %13, %16 offset:2336 \n\tds_read_b64_tr_b16 %14, %16 offset:17120 \n\tds_read_b64_tr_b16 %15, %16 offset:19232 \n\ts_waitcnt lgkmcnt(0)" : "=&v"(kp[0]), "=&v"(kp[1]), "=&v"(kp[2]), "=&v"(kp[3]), "=&v"(kp[4]), "=&v"(kp[5]), "=&v"(kp[6]), "=&v"(kp[7]), "=&v"(kp[8]), "=&v"(kp[9]), "=&v"(kp[10]), "=&v"(kp[11]), "=&v"(kp[12]), "=&v"(kp[13]), "=&v"(kp[14]), "=&v"(kp[15]) : "v"(kbase) : "memory");
          { v4u aw; aw.x = kp[0].x; aw.y = kp[0].y; aw.z = kp[1].x; aw.w = kp[1].y; Sacc[4] = mfma16(__builtin_bit_cast(bf16x8, aw), vs[0], Sacc[4]); }
          { v4u aw; aw.x = kp[2].x; aw.y = kp[2].y; aw.z = kp[3].x; aw.w = kp[3].y; Sacc[4] = mfma16(__builtin_bit_cast(bf16x8, aw), vs[1], Sacc[4]); }
          { v4u aw; aw.x = kp[4].x; aw.y = kp[4].y; aw.z = kp[5].x; aw.w = kp[5].y; Sacc[5] = mfma16(__builtin_bit_cast(bf16x8, aw), vs[0], Sacc[5]); }
          { v4u aw; aw.x = kp[6].x; aw.y = kp[6].y; aw.z = kp[7].x; aw.w = kp[7].y; Sacc[5] = mfma16(__builtin_bit_cast(bf16x8, aw), vs[1], Sacc[5]); }
          { v4u aw; aw.x = kp[8].x; aw.y = kp[8].y; aw.z = kp[9].x; aw.w = kp[9].y; Sacc[6] = mfma16(__builtin_bit_cast(bf16x8, aw), vs[0], Sacc[6]); }
          { v4u aw; aw.x = kp[10].x; aw.y = kp[10].y; aw.z = kp[11].x; aw.w = kp[11].y; Sacc[6] = mfma16(__builtin_bit_cast(bf16x8, aw), vs[1], Sacc[6]); }
          { v4u aw; aw.x = kp[12].x; aw.y = kp[12].y; aw.z = kp[13].x; aw.w = kp[13].y; Sacc[7] = mfma16(__builtin_bit_cast(bf16x8, aw), vs[0], Sacc[7]); }
          { v4u aw; aw.x = kp[14].x; aw.y = kp[14].y; aw.z = kp[15].x; aw.w = kp[15].y; Sacc[7] = mfma16(__builtin_bit_cast(bf16x8, aw), vs[1], Sacc[7]); }
        }
        { v2u kp[16]; asm volatile("ds_read_b64_tr_b16 %0, %16 offset:256 \n\tds_read_b64_tr_b16 %1, %16 offset:2368 \n\tds_read_b64_tr_b16 %2, %16 offset:17152 \n\tds_read_b64_tr_b16 %3, %16 offset:19264 \n\tds_read_b64_tr_b16 %4, %16 offset:288 \n\tds_read_b64_tr_b16 %5, %16 offset:2400 \n\tds_read_b64_tr_b16 %6, %16 offset:17184 \n\tds_read_b64_tr_b16 %7, %16 offset:19296 \n\tds_read_b64_tr_b16 %8, %16 offset:320 \n\tds_read_b64_tr_b16 %9, %16 offset:2432 \n\tds_read_b64_tr_b16 %10, %16 offset:17216 \n\tds_read_b64_tr_b16 %11, %16 offset:19328 \n\tds_read_b64_tr_b16 %12, %16 offset:352 \n\tds_read_b64_tr_b16 %13, %16 offset:2464 \n\tds_read_b64_tr_b16 %14, %16 offset:17248 \n\tds_read_b64_tr_b16 %15, %16 offset:19360 \n\ts_waitcnt lgkmcnt(0)" : "=&v"(kp[0]), "=&v"(kp[1]), "=&v"(kp[2]), "=&v"(kp[3]), "=&v"(kp[4]), "=&v"(kp[5]), "=&v"(kp[6]), "=&v"(kp[7]), "=&v"(kp[8]), "=&v"(kp[9]), "=&v"(kp[10]), "=&v"(kp[11]), "=&v"(kp[12]), "=&v"(kp[13]), "=&v"(kp[14]), "=&v"(kp[15]) : "v"(kbase) : "memory");
          { v4u aw; aw.x = kp[0].x; aw.y = kp[0].y; aw.z = kp[1].x; aw.w = kp[1].y; Sacc[8] = mfma16(__builtin_bit_cast(bf16x8, aw), vs[0], Sacc[8]); }
          { v4u aw; aw.x = kp[2].x; aw.y = kp[2].y; aw.z = kp[3].x; aw.w = kp[3].y; Sacc[8] = mfma16(__builtin_bit_cast(bf16x8, aw), vs[1], Sacc[8]); }
          { v4u aw; aw.x = kp[4].x; aw.y = kp[4].y; aw.z = kp[5].x; aw.w = kp[5].y; Sacc[9] = mfma16(__builtin_bit_cast(bf16x8, aw), vs[0], Sacc[9]); }
          { v4u aw; aw.x = kp[6].x; aw.y = kp[6].y; aw.z = kp[7].x; aw.w = kp[7].y; Sacc[9] = mfma16(__builtin_bit_cast(bf16x8, aw), vs[1], Sacc[9]); }
          { v4u aw; aw.x = kp[8].x; aw.y = kp[8].y; aw.z = kp[9].x; aw.w = kp[9].y; Sacc[10] = mfma16(__builtin_bit_cast(bf16x8, aw), vs[0], Sacc[10]); }
          { v4u aw; aw.x = kp[10].x; aw.y = kp[10].y; aw.z = kp[11].x; aw.w = kp[11].y; Sacc[10] = mfma16(__builtin_bit_cast(bf16x8, aw), vs[1], Sacc[10]); }
          { v4u aw; aw.x = kp[12].x; aw.y = kp[12].y; aw.z = kp[13].x; aw.w = kp[13].y; Sacc[11] = mfma16(__builtin_bit_cast(bf16x8, aw), vs[0], Sacc[11]); }
          { v4u aw; aw.x = kp[14].x; aw.y = kp[14].y; aw.z = kp[15].x; aw.w = kp[15].y; Sacc[11] = mfma16(__builtin_bit_cast(bf16x8, aw), vs[1], Sacc[11]); }
        }
        { v2u kp[16]; asm volatile("ds_read_b64_tr_b16 %0, %16 offset:384 \n\tds_read_b64_tr_b16 %1, %16 offset:2496 \n\tds_read_b64_tr_b16 %2, %16 offset:17280 \n\tds_read_b64_tr_b16 %3, %16 offset:19392 \n\tds_read_b64_tr_b16 %4, %16 offset:416 \n\tds_read_b64_tr_b16 %5, %16 offset:2528 \n\tds_read_b64_tr_b16 %6, %16 offset:17312 \n\tds_read_b64_tr_b16 %7, %16 offset:19424 \n\tds_read_b64_tr_b16 %8, %16 offset:448 \n\tds_read_b64_tr_b16 %9, %16 offset:2560 \n\tds_read_b64_tr_b16 %10, %16 offset:17344 \n\tds_read_b64_tr_b16 %11, %16 offset:19456 \n\tds_read_b64_tr_b16 %12, %16 offset:480 \n\tds_read_b64_tr_b16 %13, %16 offset:2592 \n\tds_read_b64_tr_b16 %14, %16 offset:17376 \n\tds_read_b64_tr_b16 %15, %16 offset:19488 \n\ts_waitcnt lgkmcnt(0)" : "=&v"(kp[0]), "=&v"(kp[1]), "=&v"(kp[2]), "=&v"(kp[3]), "=&v"(kp[4]), "=&v"(kp[5]), "=&v"(kp[6]), "=&v"(kp[7]), "=&v"(kp[8]), "=&v"(kp[9]), "=&v"(kp[10]), "=&v"(kp[11]), "=&v"(kp[12]), "=&v"(kp[13]), "=&v"(kp[14]), "=&v"(kp[15]) : "v"(kbase) : "memory");
          { v4u aw; aw.x = kp[0].x; aw.y = kp[0].y; aw.z = kp[1].x; aw.w = kp[1].y; Sacc[12] = mfma16(__builtin_bit_cast(bf16x8, aw), vs[0], Sacc[12]); }
          { v4u aw; aw.x = kp[2].x; aw.y = kp[2].y; aw.z = kp[3].x; aw.w = kp[3].y; Sacc[12] = mfma16(__builtin_bit_cast(bf16x8, aw), vs[1], Sacc[12]); }
          { v4u aw; aw.x = kp[4].x; aw.y = kp[4].y; aw.z = kp[5].x; aw.w = kp[5].y; Sacc[13] = mfma16(__builtin_bit_cast(bf16x8, aw), vs[0], Sacc[13]); }
          { v4u aw; aw.x = kp[6].x; aw.y = kp[6].y; aw.z = kp[7].x; aw.w = kp[7].y; Sacc[13] = mfma16(__builtin_bit_cast(bf16x8, aw), vs[1], Sacc[13]); }
          { v4u aw; aw.x = kp[8].x; aw.y = kp[8].y; aw.z = kp[9].x; aw.w = kp[9].y; Sacc[14] = mfma16(__builtin_bit_cast(bf16x8, aw), vs[0], Sacc[14]); }
          { v4u aw; aw.x = kp[10].x; aw.y = kp[10].y; aw.z = kp[11].x; aw.w = kp[11].y; Sacc[14] = mfma16(__builtin_bit_cast(bf16x8, aw), vs[1], Sacc[14]); }
          { v4u aw; aw.x = kp[12].x; aw.y = kp[12].y; aw.z = kp[13].x; aw.w = kp[13].y; Sacc[15] = mfma16(__builtin_bit_cast(bf16x8, aw), vs[0], Sacc[15]); }
          { v4u aw; aw.x = kp[14].x; aw.y = kp[14].y; aw.z = kp[15].x; aw.w = kp[15].y; Sacc[15] = mfma16(__builtin_bit_cast(bf16x8, aw), vs[1], Sacc[15]); }
        }
    }
#undef RT_PREFETCH
    __syncthreads();
}
__device__ __forceinline__ void p7_retention(Frame& F, const Args& A, bool accum) {
    for (int item = blockIdx.x; item < NB * RET_H * 4; item += F.G) ret_item(F, A, item >> 6, (item >> 2) & 15, item & 3, accum);
}
__device__ __forceinline__ void p8_gate(Frame& F, const Args& A) {
    const bf16* z1 = (const bf16*)(F.ws + WS_Z); bf16* ob = (bf16*)(F.ws + WS_Y1); const float* ssqo = (const float*)(F.ws + WS_SSQO); const float* gain = A.in[17];
    const size_t total = (size_t)MTOK * (RET_VW / 8), stride = (size_t)F.G * NTHREADS;
    for (size_t idx = (size_t)blockIdx.x * NTHREADS + F.tid; idx < total; idx += stride) {
        const int r = (int)(idx >> 10), c = (int)(idx & 1023) * 8, hd = c >> 9;
        const v4u gw = *(const GAS v4u*)(z1 + (size_t)r * RET_IN + 16384 + c); const v4u ow = *(const GAS v4u*)(ob + (size_t)r * RET_VW + c);
        const f32x4 g0 = *(const GAS f32x4*)(gain + c), g1 = *(const GAS f32x4*)(gain + c + 4);
        const float rs = 1.0f / sqrtf(ssqo[(size_t)r * 16 + hd] * (1.0f / 512.0f) + RMS_EPS);
        float gf[8], of[8], y[8]; unpack8(gw, gf); unpack8(ow, of);
#pragma unroll
        for (int e = 0; e < 8; ++e) { const float gn = e < 4 ? g0[e] : g1[e - 4]; y[e] = gf[e] * sigmoidf_fast(gf[e]) * (of[e] * rs * gn); }
        *(GAS v4u*)(ob + (size_t)r * RET_VW + c) = pack8f(y);
    }
}


__device__ __forceinline__ void meta_fixup(Frame& F, const float* Hmeta, bf16* XB, float* ssq) {
    __syncthreads();
    if (F.MISC[4] != 0u) {
        __builtin_amdgcn_fence(__ATOMIC_ACQUIRE, "agent"); asm volatile("s_waitcnt vmcnt(0)" ::: "memory");
        for (int row = F.wave; row < NB * NMETA; row += NWAVES) { const float* hrow = Hmeta + (size_t)row * DM; bf16* xrow = XB + (size_t)(MTOK + row) * DM; float s = 0.f;
#pragma unroll 4
            for (int j = 0; j < 16; ++j) { const int e = (F.lane + 64 * j) * 4; const f32x4 v = *(const GAS f32x4*)(hrow + e);
                s += (v.x * v.x + v.y * v.y) + (v.z * v.z + v.w * v.w); v2u w; w.x = pk2(v.x, v.y); w.y = pk2(v.z, v.w); *(GAS v2u*)(xrow + e) = w; }
            s = wave_sum(s);
            if (F.lane == 0) ssq[MTOK + row] = s; }
        __syncthreads();
        if (F.tid == 0) F.MISC[4] = 0u;
    }
    __syncthreads();
}

__global__ void __launch_bounds__(NTHREADS, 2) hybrid_fwd(Args args) {
    extern __shared__ __attribute__((aligned(16))) unsigned char lds_raw[];
    Frame F;
    F.lds = (LAS unsigned char*)lds_raw;
    F.MISC = (volatile LAS unsigned*)(F.lds + MISC_OFF);
    F.tid = threadIdx.x; F.lane = F.tid & 63; F.wave = __builtin_amdgcn_readfirstlane(F.tid >> 6);
    F.G = gridDim.x; F.ws = args.ws;
    if (F.tid < 64) F.MISC[F.tid] = 0u;
    __syncthreads();
    unsigned* ctl = (unsigned*)(F.ws + WS_CTL);
#if !MK_PER_PHASE
    const XcdBarrier bar = xcd_barrier_post(ctl + CW_BAR, F.MISC + 8);
#define GRID_BAR() xcd_barrier(bar)
#else
#define GRID_BAR() do { } while (0)
#endif
    const int lo = args.ph_lo, hi = args.ph_hi;
#ifndef PHASE_MASK
#define PHASE_MASK 0xFFF
#endif
#define IN(k) ((((PHASE_MASK) >> (k)) & 1) && lo <= (k) && (k) < hi)
#define BOTH(k) (IN(k) && IN((k) + 1))
#ifndef REPEAT_MASK
#define REPEAT_MASK 0
#endif
#define REPS(k) (1 + (((REPEAT_MASK) >> (k)) & 1))
    unsigned char* ws = F.ws;
    bf16* XB = (bf16*)(ws + WS_XB); float* Htok = args.out; float* Hmeta = (float*)(ws + WS_HMETA); bf16* Z = (bf16*)(ws + WS_Z); bf16* Y0 = (bf16*)(ws + WS_Y0); bf16* Y1 = (bf16*)(ws + WS_Y1);
    float* SSQ0 = (float*)(ws + WS_SSQ0); float* SSQ1 = (float*)(ws + WS_SSQ1); float* SSQ2 = (float*)(ws + WS_SSQ2); float* SSQ3 = (float*)(ws + WS_SSQ3);
    const int c = (int)blockIdx.x;

    if (IN(0)) { for (int rep = 0; rep < REPS(0); ++rep) p0_prologue(F, args); if (BOTH(0)) GRID_BAR(); }
    if (IN(1)) {
        pg8::Gemm g{XB, (const bf16*)(ws + WS_WIN0), MP, 41 * 256, DM}; pg8::StaticOrder S; S.init(MP, 41 * 256, DM, F.G, c);
        pg8::EpiIn0 E{Z, (float*)(ws + WS_FBUF), SSQ0};
        pg8::gemm_phase<pg8::EpiIn0, pg8::StaticOrder, true, true>(F.lds, g, S, E); if (REPS(1) > 1) { pg8::gemm_phase<pg8::EpiIn0, pg8::StaticOrder, true, true>(F.lds, g, S, E); }
        if (BOTH(1)) GRID_BAR();
    }
    if (IN(2)) { p2_mixer0(F, args, 0); if (REPS(2) > 1) { GRID_BAR(); p2_mixer0(F, args, 1); } if (BOTH(2)) GRID_BAR(); }
    if (IN(3)) {
        pg8::Gemm g{Y0, (const bf16*)(ws + WS_WOUT0), MP, DM, DM}; pg8::SplitMetaOrder S; S.init2(DM, DM, F.G, c, ctl + CW_TK3, F.MISC + 4);
        pg8::EpiRes E{Htok, Hmeta, XB, SSQ1, DM / 64};
        pg8::gemm_phase<pg8::EpiRes, pg8::SplitMetaOrder, true, true>(F.lds, g, S, E);
        meta_fixup(F, Hmeta, XB, SSQ1);
        if (BOTH(3)) GRID_BAR();
    }
    if (IN(4)) {
        pg8::Gemm g{XB, (const bf16*)(ws + WS_WGU0), MP, 2 * DFF, DM}; pg8::StaticOrder S; S.init(MP, 2 * DFF, DM, F.G, c);
        pg8::EpiGU E{Z, SSQ1};
        pg8::gemm_phase<pg8::EpiGU, pg8::StaticOrder, true, true>(F.lds, g, S, E); if (REPS(4) > 1) { pg8::gemm_phase<pg8::EpiGU, pg8::StaticOrder, true, true>(F.lds, g, S, E); }
        if (BOTH(4)) GRID_BAR();
    }
    if (IN(5)) {
        pg8::Gemm g{Z, (const bf16*)(ws + WS_WD0), MP, DM, DFF}; pg8::SplitMetaOrder S; S.init2(DM, DFF, F.G, c, ctl + CW_TK5, F.MISC + 4);
        pg8::EpiRes E{Htok, Hmeta, XB, SSQ2, DFF / 64};
        pg8::gemm_phase<pg8::EpiRes, pg8::SplitMetaOrder, true, true>(F.lds, g, S, E);
        meta_fixup(F, Hmeta, XB, SSQ2);
        if (BOTH(5)) GRID_BAR();
    }
    if (IN(6)) {
        pg8::Gemm g{XB, (const bf16*)(ws + WS_WIN1), MP, RET_IN, DM}; pg8::StaticOrder S; S.init(MP, RET_IN, DM, F.G, c);
        pg8::EpiIn1 E{Z, SSQ2};
        pg8::gemm_phase<pg8::EpiIn1, pg8::StaticOrder, true, true>(F.lds, g, S, E); if (REPS(6) > 1) { pg8::gemm_phase<pg8::EpiIn1, pg8::StaticOrder, true, true>(F.lds, g, S, E); }
        if (BOTH(6)) GRID_BAR();
    }
    if (IN(7)) { p7_retention(F, args, true); if (REPS(7) > 1) p7_retention(F, args, false); if (BOTH(7)) GRID_BAR(); }
    if (IN(8)) { p8_gate(F, args); if (BOTH(8)) GRID_BAR(); }
    if (IN(9)) {
        pg8::Gemm g{Y1, (const bf16*)(ws + WS_WOUT1), MTOK, DM, RET_VW}; pg8::StaticOrder S; S.init(MTOK, DM, RET_VW, F.G, c);
        pg8::EpiRes E{Htok, Hmeta, XB, SSQ3, RET_VW / 64};
        pg8::gemm_phase<pg8::EpiRes, pg8::StaticOrder, true, true>(F.lds, g, S, E);
        if (BOTH(9)) GRID_BAR();
    }
    if (IN(10)) {
        pg8::Gemm g{XB, (const bf16*)(ws + WS_WGU1), MTOK, 2 * DFF, DM}; pg8::StaticOrder S; S.init(MTOK, 2 * DFF, DM, F.G, c);
        pg8::EpiGU E{Z, SSQ3};
        pg8::gemm_phase<pg8::EpiGU, pg8::StaticOrder, true, true>(F.lds, g, S, E); if (REPS(10) > 1) { pg8::gemm_phase<pg8::EpiGU, pg8::StaticOrder, true, true>(F.lds, g, S, E); }
        if (BOTH(10)) GRID_BAR();
    }
    if (IN(11)) {
        pg8::Gemm g{Z, (const bf16*)(ws + WS_WD1), MTOK, DM, DFF}; pg8::StaticOrder S; S.init(MTOK, DM, DFF, F.G, c);
        pg8::EpiFinal E{args.out};
        pg8::gemm_phase<pg8::EpiFinal, pg8::StaticOrder, true, true>(F.lds, g, S, E);
    }
#undef IN
#undef BOTH
}

extern "C" void kernel_launch(void* const* d_in, const int* in_sizes, int n_in, void* d_out, int out_size, void* d_ws, size_t ws_size, hipStream_t stream) {
    static int grid = 0;
    if (grid == 0) {
        if (n_in != 23 || in_sizes[0] != MTOK * DM || out_size != MTOK * DM || ws_size < WS_END) { fprintf(stderr, "kernel_launch: unexpected shapes (n_in %d, in0 %d, out %d, ws %zu < %zu); nothing launched\n", n_in, n_in > 0 ? in_sizes[0] : -1, out_size, ws_size, (size_t)WS_END); grid = -1; return; }
        int dev = 0, cus = 0, per_cu = 0;
        if (hipGetDevice(&dev) != hipSuccess || hipDeviceGetAttribute(&cus, hipDeviceAttributeMultiprocessorCount, dev) != hipSuccess) { fprintf(stderr, "kernel_launch: device query failed\n"); grid = -1; return; }
        if (hipFuncSetAttribute((const void*)hybrid_fwd, hipFuncAttributeMaxDynamicSharedMemorySize, LDS_BYTES) != hipSuccess) { fprintf(stderr, "kernel_launch: hipFuncSetAttribute failed\n"); grid = -1; return; }
        if (hipOccupancyMaxActiveBlocksPerMultiprocessor(&per_cu, (const void*)hybrid_fwd, NTHREADS, LDS_BYTES) != hipSuccess || per_cu < 1) { fprintf(stderr, "kernel_launch: occupancy query reports %d workgroups per CU\n", per_cu); }
        (void)hipGetLastError();
        grid = cus;
    }
    if (grid < 0) return;
    if (hipMemsetAsync((char*)d_ws + WS_CTL, 0, CTL_ZERO_BYTES, stream) != hipSuccess) { fprintf(stderr, "kernel_launch: memset failed\n"); return; }
    Args a{};
    for (int i = 0; i < 23; ++i) a.in[i] = (const float*)d_in[i];
    a.out = (float*)d_out; a.ws = (unsigned char*)d_ws;
#if MK_PER_PHASE
    for (int p = 0; p < NPHASES; ++p) { a.ph_lo = p; a.ph_hi = p + 1; hipLaunchKernelGGL(hybrid_fwd, dim3(grid), dim3(NTHREADS), LDS_BYTES, stream, a); }
#else
    a.ph_lo = 0; a.ph_hi = NPHASES;
    hipLaunchKernelGGL(hybrid_fwd, dim3(grid), dim3(NTHREADS), LDS_BYTES, stream, a);
#endif
    const hipError_t le = hipPeekAtLastError();
    if (le != hipSuccess) fprintf(stderr, "kernel_launch: launch failed: %s\n", hipGetErrorName(le));
}
```

```cpp
#include <hip/hip_runtime.h>
#include <cstdio>
#include <cstdint>
#ifndef MK_PER_PHASE
#define MK_PER_PHASE 0
#endif
constexpr int DM = 4096, NB = 4, SEQ = 4096, NMETA = 16, LSEQ = NMETA + SEQ;
constexpr int MTOK = NB * SEQ;
constexpr int MMETA = MTOK;
constexpr int MP = 65 * 256;
constexpr int LRU_W = 2048, FOX_H = 16, FOX_D = 128, AB_IN = 10256, AB_Z = 10240;
constexpr int RET_H = 16, RET_QK = 256, RET_V = 512, RET_IN = 24576, RET_VW = 8192;
constexpr int DFF = 11008;
constexpr float RMS_EPS = 1e-6f;
namespace pg8 {
#define PG8_LAS __attribute__((address_space(3)))
typedef unsigned short bf16_t;
typedef short bf16x8 __attribute__((ext_vector_type(8)));
typedef float f32x4 __attribute__((ext_vector_type(4)));
typedef unsigned u32x4 __attribute__((ext_vector_type(4)));
constexpr int BM = 256, BK = 64, HALF = 128, HTB = HALF * BK * 2  , STAGE_BYTES = 8 * HTB, NXCD = 8, WGM = 8;

__host__ __device__ __forceinline__ int lds_byte(int r, int c) { const int st = (r >> 4) * 2 + (c >> 5), rr = r & 15, cc = c & 31, ob = rr * 64 + cc * 2; return st * 1024 + (ob ^ (((ob >> 9) & 1) << 5)); }
__host__ __device__ __forceinline__ void stage_rc(int b, int& R, int& C) { const int st = b / 1024, sb = b % 1024, swz = sb ^ (((sb >> 9) & 1) << 5); R = (st >> 1) * 16 + swz / 64; C = (st & 1) * 32 + (swz % 64) / 2; }
__host__ __device__ __forceinline__ int perm32(int rho) { const int n = rho >> 4, i = rho & 15; return 8 * (i >> 2) + 4 * n + (i & 3); }

struct Unit { int pm, pn, kb, kn; };
struct Gemm { const bf16_t* A; const bf16_t* Bt; int M, N, K; };

struct StaticOrder {
    int nM, nN, nwg, G, c, ntk;
    __host__ __device__ void init(int M, int N, int K, int G_, int c_) { nM = M / BM; nN = N / BM; nwg = nM * nN; G = G_; c = c_; ntk = K / BK; }
    __host__ __device__ bool next(int i, Unit& u) const {
        const long L = (long)i * G + c; if (L >= nwg) return false;
        int wgid = (int)L; { const int q = nwg / NXCD, r = nwg % NXCD, xcd = wgid % NXCD, off = wgid / NXCD; wgid = (xcd < r ? xcd * (q + 1) : r * (q + 1) + (xcd - r) * q) + off; }
        const int nig = WGM * nN, gid = wgid / nig, fm = gid * WGM, gsz = (nM - fm) < WGM ? (nM - fm) : WGM;
        u.pm = fm + ((wgid % nig) % gsz); u.pn = (wgid % nig) / gsz; u.kb = 0; u.kn = ntk; return true;
    }
    __device__ __forceinline__ void a_ready(const Unit&) const {}
    __device__ __forceinline__ void done(const Unit&) const {}
};

struct SplitMetaOrder : StaticOrder {
    int nreg, nsplit; unsigned* ticket; volatile PG8_LAS unsigned* flag;
    __device__ void init2(int N, int K, int G_, int c_, unsigned* ticket_, volatile PG8_LAS unsigned* flag_) { init(64 * BM, N, K, G_, c_); nreg = nwg; nsplit = 16; ticket = ticket_; flag = flag_; }
    __device__ bool next(int i, Unit& u) const {
        const long L = (long)i * G + c;
        if (L < nreg) return StaticOrder::next(i, u);
        const int x = (int)(L - nreg); if (x >= nsplit * nN) return false;
        const int s = x % nsplit; u.pm = 64; u.pn = x / nsplit;
        const int base = (ntk / 2) / nsplit, rem = (ntk / 2) % nsplit;
        u.kb = 2 * (s * base + (s < rem ? s : rem)); u.kn = 2 * (base + (s < rem ? 1 : 0)); return true;
    }
    __device__ __forceinline__ void a_ready(const Unit&) const {}
    __device__ __forceinline__ void done(const Unit& u) const {
        if (u.pm == 64) { asm volatile("s_waitcnt vmcnt(0)" ::: "memory");
            if ((threadIdx.x & 63) == 0) { const unsigned old = __hip_atomic_fetch_add(ticket, 1u, __ATOMIC_RELAXED, __HIP_MEMORY_SCOPE_AGENT); if (old + 1u == (unsigned)(nsplit * nN * 8)) flag[0] = 1u; } }
    }
};
__device__ __forceinline__ unsigned cvt_pk_bf16(float lo, float hi) { unsigned r; asm volatile("v_cvt_pk_bf16_f32 %0, %1, %2" : "=v"(r) : "v"(lo), "v"(hi)); return r; }
__device__ __forceinline__ u32x4 pack8(const f32x4 a, const f32x4 b) { u32x4 w; w.x = cvt_pk_bf16(a[0], a[1]); w.y = cvt_pk_bf16(a[2], a[3]); w.z = cvt_pk_bf16(b[0], b[1]); w.w = cvt_pk_bf16(b[2], b[3]); return w; }
__device__ __forceinline__ float row_rstd(const float* ssq, int r) { return 1.0f / sqrtf(ssq[r] * (1.0f / 4096.0f) + RMS_EPS); }

struct EpiIn0 {
    static constexpr bool PERM = true, AFTER_DRAIN = false;
    bf16_t* Z; float* F; const float* ssq;
    __device__ __forceinline__ void operator()(const f32x4 (&acc)[2][2][4][2], const Unit& u, int wr, int wc, int fr, int fq) const {
        const int row0 = u.pm * BM + wr * 64 + fr;
        if (u.pn < 40) {
            const int col0 = u.pn * BM + wc * 32 + 8 * fq;
#pragma unroll
            for (int ai = 0; ai < 2; ++ai)
#pragma unroll
                for (int m = 0; m < 4; ++m) { const int r = row0 + ai * HALF + m * 16; const float rs = row_rstd(ssq, r); bf16_t* rowp = Z + (size_t)r * AB_Z + col0;
#pragma unroll
                    for (int bj = 0; bj < 2; ++bj) *(u32x4*)(rowp + bj * HALF) = pack8(acc[ai][bj][m][0] * rs, acc[ai][bj][m][1] * rs); }
        } else if (wc == 0 && fq < 2) {
#pragma unroll
            for (int ai = 0; ai < 2; ++ai)
#pragma unroll
                for (int m = 0; m < 4; ++m) { const int r = row0 + ai * HALF + m * 16; const float rs = row_rstd(ssq, r); float* fp = F + (size_t)r * 16 + 8 * fq;
                    *(f32x4*)(fp) = acc[ai][0][m][0] * rs; *(f32x4*)(fp + 4) = acc[ai][0][m][1] * rs; }
        }
    }
};
struct EpiRes {
    static constexpr bool PERM = true, AFTER_DRAIN = false;
    float* Htok; float* Hmeta; bf16_t* XB; float* ssq_out; int K_TILES; const float* gnext;
    __device__ __forceinline__ void operator()(const f32x4 (&acc)[2][2][4][2], const Unit& u, int wr, int wc, int fr, int fq) const {
        const int row0 = u.pm * BM + wr * 64 + fr, col0 = u.pn * BM + wc * 32 + 8 * fq;
        if (u.pm == MTOK / BM && u.kn != K_TILES) {
            if (wr == 0) {
#pragma unroll
                for (int m = 0; m < 4; ++m) { float* hp = Hmeta + (size_t)(m * 16 + fr) * DM + col0;
#pragma unroll
                    for (int bj = 0; bj < 2; ++bj)
#pragma unroll
                        for (int n = 0; n < 2; ++n)
#pragma unroll
                            for (int j = 0; j < 4; ++j) atomicAdd(hp + bj * HALF + 4 * n + j, acc[0][bj][m][n][j]); } }
            return; }
        float* H = u.pm < MTOK / BM ? Htok : Hmeta - (size_t)MTOK * DM;
        f32x4 gn[2][2];
#pragma unroll
        for (int bj = 0; bj < 2; ++bj) { gn[bj][0] = *(const f32x4*)(gnext + col0 + bj * HALF); gn[bj][1] = *(const f32x4*)(gnext + col0 + bj * HALF + 4); }
#pragma unroll
        for (int ai = 0; ai < 2; ++ai)
#pragma unroll
            for (int m = 0; m < 4; ++m) { const int r = row0 + ai * HALF + m * 16; float* hp = H + (size_t)r * DM + col0; bf16_t* xp = XB + (size_t)r * DM + col0; float s = 0.f;
#pragma unroll
                for (int bj = 0; bj < 2; ++bj) { const f32x4 v0 = *(const f32x4*)(hp + bj * HALF) + acc[ai][bj][m][0], v1 = *(const f32x4*)(hp + bj * HALF + 4) + acc[ai][bj][m][1];
                    *(f32x4*)(hp + bj * HALF) = v0; *(f32x4*)(hp + bj * HALF + 4) = v1; *(u32x4*)(xp + bj * HALF) = pack8(v0 * gn[bj][0], v1 * gn[bj][1]);
                    s += (v0[0] * v0[0] + v0[1] * v0[1]) + (v0[2] * v0[2] + v0[3] * v0[3]) + (v1[0] * v1[0] + v1[1] * v1[1]) + (v1[2] * v1[2] + v1[3] * v1[3]); }
                s += __shfl_xor(s, 16); s += __shfl_xor(s, 32);
                if (fq == 0) atomicAdd(ssq_out + r, s);
                asm volatile("" ::: "memory"); }
    }
};
struct EpiFinal {
    static constexpr bool PERM = true, AFTER_DRAIN = false;
    float* OUT;
    __device__ __forceinline__ void operator()(const f32x4 (&acc)[2][2][4][2], const Unit& u, int wr, int wc, int fr, int fq) const {
        const int row0 = u.pm * BM + wr * 64 + fr, col0 = u.pn * BM + wc * 32 + 8 * fq;
#pragma unroll
        for (int ai = 0; ai < 2; ++ai)
#pragma unroll
            for (int m = 0; m < 4; ++m) { const int r = row0 + ai * HALF + m * 16; float* op = OUT + (size_t)r * DM + col0; const float* hp = op;
#pragma unroll
                for (int bj = 0; bj < 2; ++bj) { const f32x4 v0 = *(const f32x4*)(hp + bj * HALF) + acc[ai][bj][m][0], v1 = *(const f32x4*)(hp + bj * HALF + 4) + acc[ai][bj][m][1];
                    *(f32x4*)(op + bj * HALF) = v0; *(f32x4*)(op + bj * HALF + 4) = v1; }
                asm volatile("" ::: "memory"); }
    }
};
struct EpiGU {
    static constexpr bool PERM = true, AFTER_DRAIN = false;
    bf16_t* HID; const float* ssq;
    __device__ __forceinline__ void operator()(const f32x4 (&acc)[2][2][4][2], const Unit& u, int wr, int wc, int fr, int fq) const {
        const int row0 = u.pm * BM + wr * 64 + fr, col0 = u.pn * HALF + wc * 32 + 8 * fq;
#pragma unroll
        for (int ai = 0; ai < 2; ++ai)
#pragma unroll
            for (int m = 0; m < 4; ++m) { const int r = row0 + ai * HALF + m * 16; const float rs = row_rstd(ssq, r); f32x4 o[2];
#pragma unroll
                for (int n = 0; n < 2; ++n)
#pragma unroll
                    for (int j = 0; j < 4; ++j) { const float g = acc[ai][0][m][n][j] * rs, uu = acc[ai][1][m][n][j] * rs;
                        o[n][j] = g * uu * __builtin_amdgcn_rcpf(1.0f + __expf(-g)); }
                *(u32x4*)(HID + (size_t)r * DFF + col0) = pack8(o[0], o[1]); }
    }
};
struct EpiIn1 {
    static constexpr bool PERM = true, AFTER_DRAIN = false;
    bf16_t* Z; const float* ssq;
    __device__ __forceinline__ void operator()(const f32x4 (&acc)[2][2][4][2], const Unit& u, int wr, int wc, int fr, int fq) const {
        const int row0 = u.pm * BM + wr * 64 + fr, col0 = u.pn * BM + wc * 32 + 8 * fq;
        if (u.pn < 32) {
            const float sc = u.pn < 16 ? 1.0f : 0.0625f;
            float inv[2][4];
#pragma unroll
            for (int n = 0; n < 2; ++n)
#pragma unroll
                for (int j = 0; j < 4; ++j) inv[n][j] = exp2f(-(float)(wc * 32 + 8 * fq + 4 * n + j) * (13.287712379549449f / 128.0f));
#pragma unroll
            for (int ai = 0; ai < 2; ++ai)
#pragma unroll
                for (int m = 0; m < 4; ++m) { const int r = row0 + ai * HALF + m * 16; const float rs = row_rstd(ssq, r) * sc;
                    const float t = (float)(r < MTOK ? NMETA + (r & (SEQ - 1)) : ((r - MTOK) & 15));
                    f32x4 o1[2], o2[2];
#pragma unroll
                    for (int n = 0; n < 2; ++n)
#pragma unroll
                        for (int j = 0; j < 4; ++j) { const float x1 = acc[ai][0][m][n][j] * rs, x2 = acc[ai][1][m][n][j] * rs;
                            const float ang = t * inv[n][j]; float rev = ang * 0.15915494309189535f; rev = rev - floorf(rev);
                            const float c = __builtin_amdgcn_cosf(rev), s = __builtin_amdgcn_sinf(rev);
                            o1[n][j] = x1 * c - x2 * s; o2[n][j] = x1 * s + x2 * c; }
                    bf16_t* rowp = Z + (size_t)r * RET_IN + col0;
                    *(u32x4*)(rowp) = pack8(o1[0], o1[1]); *(u32x4*)(rowp + HALF) = pack8(o2[0], o2[1]); }
        } else {
#pragma unroll
            for (int ai = 0; ai < 2; ++ai)
#pragma unroll
                for (int m = 0; m < 4; ++m) { const int r = row0 + ai * HALF + m * 16; const float rs = row_rstd(ssq, r); bf16_t* rowp = Z + (size_t)r * RET_IN + col0;
#pragma unroll
                    for (int bj = 0; bj < 2; ++bj) *(u32x4*)(rowp + bj * HALF) = pack8(acc[ai][bj][m][0] * rs, acc[ai][bj][m][1] * rs); }
        }
    }
};

template <class Epi, class Sched, bool ALIGN_EPI = false, bool SP2 = false>
__device__ __forceinline__ void gemm_phase(PG8_LAS unsigned char* lds, const Gemm g, const Sched& S, const Epi& E) {
    const int tid = threadIdx.x, wid = __builtin_amdgcn_readfirstlane(tid >> 6), lane = tid & 63, wr = wid >> 2, wc = wid & 3, fr = lane & 15, fq = lane >> 4;
    const int K = g.K; int nt;
    unsigned voffA[2], voffB[2];
#pragma unroll
    for (int i = 0; i < 2; ++i) { int R, C; stage_rc(tid * 16 + i * 8192, R, C); const int Rb = Epi::PERM ? ((R & ~31) + perm32(R & 31)) : R;
        voffA[i] = (unsigned)(R * K + C) * 2u; voffB[i] = (unsigned)(Rb * K + C) * 2u; }
    const size_t kstep = (size_t)(BK * 2);
    const size_t hstep = (size_t)HALF * K * 2;
    const size_t tstep = 2 * hstep;
    const unsigned ldsw = (unsigned)wid * 1024u;
    const int aoff = lds_byte(wr * 64 + fr, fq * 8), boff = lds_byte(wc * 32 + fr, fq * 8);
#define PG8_SA(b, h) (((b) * 2 + (h)) * HTB)
#define PG8_SB(b, h) ((4 + (b) * 2 + (h)) * HTB)
#define PG8_STAGE(bufoff, gbase, voff) do { _Pragma("unroll") for (int _i = 0; _i < 2; ++_i) \
        __builtin_amdgcn_global_load_lds((const unsigned*)((const char*)(gbase) + (voff)[_i]), (PG8_LAS unsigned*)(lds + (bufoff) + ldsw + _i * 8192), 16, 0, 0); } while (0)
#define PG8_LDA(dst, b, h) do { _Pragma("unroll") for (int m = 0; m < 4; ++m) _Pragma("unroll") for (int k = 0; k < 2; ++k) dst[m][k] = *(const PG8_LAS bf16x8*)(lds + PG8_SA(b, h) + aoff + m * 2048 + k * 1024); } while (0)
#define PG8_LDB(dst, b, h) do { _Pragma("unroll") for (int n = 0; n < 2; ++n) _Pragma("unroll") for (int k = 0; k < 2; ++k) dst[n][k] = *(const PG8_LAS bf16x8*)(lds + PG8_SB(b, h) + boff + n * 2048 + k * 1024); } while (0)
#define PG8_MMA(ai, bj, At, Bt) do { __builtin_amdgcn_s_setprio(1); _Pragma("unroll") for (int m = 0; m < 4; ++m) _Pragma("unroll") for (int n = 0; n < 2; ++n) _Pragma("unroll") for (int k = 0; k < 2; ++k) \
        acc[ai][bj][m][n] = __builtin_amdgcn_mfma_f32_16x16x32_bf16(Bt[n][k], At[m][k], acc[ai][bj][m][n], 0, 0, 0); __builtin_amdgcn_s_setprio(0); } while (0)
#define PG8_WAIT_V(n) asm volatile("s_waitcnt vmcnt(" #n ")" ::: "memory")
#define PG8_WAIT_L(n) asm volatile("s_waitcnt lgkmcnt(" #n ")" ::: "memory")
#define PG8_BAR __builtin_amdgcn_s_barrier()
#define PG8_SCHED __builtin_amdgcn_sched_barrier(0)
    Unit cur, nxt; int ui = 0;
    if (!S.next(0, cur)) return;
    nt = cur.kn;
    f32x4 acc[2][2][4][2];
#pragma unroll
    for (int a = 0; a < 2; ++a)
#pragma unroll
        for (int b = 0; b < 2; ++b)
#pragma unroll
            for (int m = 0; m < 4; ++m)
#pragma unroll
                for (int n = 0; n < 2; ++n) acc[a][b][m][n] = (f32x4){0.f, 0.f, 0.f, 0.f};
    bf16x8 At[4][2], B0[2][2], B1[2][2];
    const char* cA = (const char*)g.A + (size_t)cur.pm * tstep + (size_t)cur.kb * kstep; const char* cB = (const char*)g.Bt + (size_t)cur.pn * tstep + (size_t)cur.kb * kstep;
    S.a_ready(cur);
    if constexpr (SP2) {
        PG8_STAGE(PG8_SB(0, 0), cB, voffB); PG8_STAGE(PG8_SB(0, 1), cB + hstep, voffB); PG8_STAGE(PG8_SA(0, 0), cA, voffA); PG8_STAGE(PG8_SA(0, 1), cA + hstep, voffA);
        if (wr == 1) PG8_BAR;
        PG8_WAIT_V(2); PG8_BAR;
        PG8_STAGE(PG8_SB(1, 0), cB + kstep, voffB); PG8_STAGE(PG8_SA(1, 0), cA + kstep, voffA); PG8_STAGE(PG8_SB(1, 1), cB + hstep + kstep, voffB);
        PG8_WAIT_V(6); PG8_BAR;
    } else {
        PG8_STAGE(PG8_SB(0, 0), cB, voffB); PG8_STAGE(PG8_SA(0, 0), cA, voffA); PG8_STAGE(PG8_SB(0, 1), cB + hstep, voffB); PG8_STAGE(PG8_SA(0, 1), cA + hstep, voffA);
        if (wr == 1) PG8_BAR;
        PG8_WAIT_V(4); PG8_BAR;
        PG8_STAGE(PG8_SB(1, 0), cB + kstep, voffB); PG8_STAGE(PG8_SA(1, 0), cA + kstep, voffA); PG8_STAGE(PG8_SB(1, 1), cB + hstep + kstep, voffB);
        PG8_WAIT_V(6); PG8_BAR;
    }
    for (;;) {
        const bool has_next = S.next(ui + 1, nxt);
        const char* nA = has_next ? (const char*)g.A + (size_t)nxt.pm * tstep + (size_t)nxt.kb * kstep : cA; const char* nB = has_next ? (const char*)g.Bt + (size_t)nxt.pn * tstep + (size_t)nxt.kb * kstep : cB;
        for (int t = 0; t < nt; t += 2) {
            const bool last = (t == nt - 2);
            const char* a1 = cA + (size_t)(t + 1) * kstep;
            const char* a2 = last ? nA : cA + (size_t)(t + 2) * kstep; const char* b2 = last ? nB : cB + (size_t)(t + 2) * kstep;
            const char* a3 = a2 + kstep; const char* b3 = b2 + kstep;
            if (last && has_next) S.a_ready(nxt);
            if constexpr (SP2) {
            PG8_LDB(B0, 0, 0); PG8_LDB(B1, 0, 1); PG8_SCHED; PG8_LDA(At, 0, 0); PG8_STAGE(PG8_SA(1, 1), a1 + hstep, voffA);
            PG8_WAIT_V(8); PG8_WAIT_L(0); PG8_BAR; PG8_MMA(0, 0, At, B0); PG8_MMA(0, 1, At, B1); PG8_BAR; PG8_SCHED;
            PG8_LDA(At, 0, 1); PG8_STAGE(PG8_SB(0, 0), b2, voffB); PG8_STAGE(PG8_SB(0, 1), b2 + hstep, voffB); PG8_STAGE(PG8_SA(0, 0), a2, voffA);
            PG8_WAIT_V(8); PG8_WAIT_L(0); PG8_BAR; PG8_MMA(1, 0, At, B0); PG8_MMA(1, 1, At, B1); PG8_BAR; PG8_SCHED;
            PG8_LDB(B0, 1, 0); PG8_LDB(B1, 1, 1); PG8_SCHED; PG8_LDA(At, 1, 0); PG8_STAGE(PG8_SA(0, 1), a2 + hstep, voffA);
            PG8_WAIT_V(8); PG8_WAIT_L(0); PG8_BAR; PG8_MMA(0, 0, At, B0); PG8_MMA(0, 1, At, B1); PG8_BAR; PG8_SCHED;
            PG8_LDA(At, 1, 1); PG8_STAGE(PG8_SB(1, 0), b3, voffB); PG8_STAGE(PG8_SB(1, 1), b3 + hstep, voffB); PG8_STAGE(PG8_SA(1, 0), a3, voffA);
            PG8_WAIT_V(8); PG8_WAIT_L(0); PG8_BAR; PG8_MMA(1, 0, At, B0); PG8_MMA(1, 1, At, B1); PG8_BAR; PG8_SCHED;
            } else {
            PG8_LDB(B0, 0, 0); PG8_SCHED; PG8_LDA(At, 0, 0); PG8_STAGE(PG8_SA(1, 1), a1 + hstep, voffA);
            PG8_WAIT_L(8); PG8_BAR; PG8_WAIT_L(0); PG8_MMA(0, 0, At, B0); PG8_BAR; PG8_SCHED;
            PG8_LDB(B1, 0, 1); PG8_STAGE(PG8_SB(0, 0), b2, voffB);
            PG8_BAR; PG8_WAIT_L(0); PG8_MMA(0, 1, At, B1); PG8_BAR;
            PG8_LDA(At, 0, 1); PG8_STAGE(PG8_SA(0, 0), a2, voffA);
            PG8_BAR; PG8_WAIT_L(0); PG8_MMA(1, 0, At, B0); PG8_BAR; PG8_SCHED;
            PG8_STAGE(PG8_SB(0, 1), b2 + hstep, voffB);
            PG8_WAIT_V(6); PG8_BAR; PG8_MMA(1, 1, At, B1); PG8_BAR;
            PG8_LDB(B0, 1, 0); PG8_SCHED; PG8_LDA(At, 1, 0); PG8_STAGE(PG8_SA(0, 1), a2 + hstep, voffA);
            PG8_WAIT_L(8); PG8_BAR; PG8_WAIT_L(0); PG8_MMA(0, 0, At, B0); PG8_BAR; PG8_SCHED;
            PG8_LDB(B1, 1, 1); PG8_STAGE(PG8_SB(1, 0), b3, voffB);
            PG8_BAR; PG8_WAIT_L(0); PG8_MMA(0, 1, At, B1); PG8_BAR;
            PG8_LDA(At, 1, 1); PG8_STAGE(PG8_SA(1, 0), a3, voffA);
            PG8_BAR; PG8_WAIT_L(0); PG8_MMA(1, 0, At, B0); PG8_BAR; PG8_SCHED;
            PG8_STAGE(PG8_SB(1, 1), b3 + hstep, voffB);
            PG8_WAIT_V(6); PG8_BAR; PG8_MMA(1, 1, At, B1); PG8_BAR;
            }
        }
        if constexpr (ALIGN_EPI) { if (wr == 0) PG8_BAR; }
        if constexpr (!Epi::AFTER_DRAIN) { E(acc, cur, wr, wc, fr, fq); S.done(cur); }
        if (!has_next) break;
#pragma unroll
        for (int a = 0; a < 2; ++a)
#pragma unroll
            for (int b = 0; b < 2; ++b)
#pragma unroll
                for (int m = 0; m < 4; ++m)
#pragma unroll
                    for (int n = 0; n < 2; ++n) acc[a][b][m][n] = (f32x4){0.f, 0.f, 0.f, 0.f};
        cur = nxt; cA = nA; cB = nB; ++ui; nt = cur.kn;
        if constexpr (ALIGN_EPI) { if (wr == 1) PG8_BAR; }
    }
    PG8_WAIT_V(0);
    if constexpr (!ALIGN_EPI) { if (wr == 0) PG8_BAR; }
    PG8_BAR;
    if constexpr (Epi::AFTER_DRAIN) { E.fused(acc, cur, wr, wc, fr, fq, lds, wid, lane); S.done(cur); }
#undef PG8_SA
#undef PG8_SB
#undef PG8_STAGE
#undef PG8_LDA
#undef PG8_LDB
#undef PG8_MMA
#undef PG8_WAIT_V
#undef PG8_WAIT_L
#undef PG8_BAR
#undef PG8_SCHED
}
}

constexpr size_t MiB = 1u << 20;
constexpr size_t WS_CTL = 0, CTL_ZERO_BYTES = 2 * MiB;
constexpr size_t WS_SSQ1 = 64 * 1024, WS_SSQ2 = 192 * 1024, WS_SSQ3 = 320 * 1024, WS_SSQO = 512 * 1024;
constexpr size_t WS_SSQ0 = 2 * MiB;
constexpr size_t WS_FBUF = 2 * MiB + 512 * 1024;
constexpr size_t WS_HMETA = 4 * MiB;
constexpr size_t WS_WIN0 = 8 * MiB, WS_WOUT0 = 90 * MiB, WS_WGU0 = 122 * MiB, WS_WD0 = 294 * MiB, WS_WIN1 = 380 * MiB, WS_WOUT1 = 572 * MiB, WS_WGU1 = 636 * MiB, WS_WD1 = 808 * MiB;
constexpr size_t WS_WAT = 894 * MiB, WS_WXT = WS_WAT + 512 * 1024;
constexpr size_t WS_XB = 896 * MiB, WS_Z = 1026 * MiB, WS_END = 1806 * MiB;
constexpr size_t WS_Y0 = WS_Z + 400 * MiB;
constexpr size_t WS_Y1 = 8 * MiB;
static_assert(WS_SSQO + (size_t)MP * 16 * 4 <= CTL_ZERO_BYTES && WS_FBUF + (size_t)MP * 16 * 4 <= WS_HMETA && WS_HMETA + (size_t)256 * DM * 4 <= WS_WIN0, "ctl map");
static_assert(WS_WIN0 + (size_t)41 * 256 * DM * 2 <= WS_WOUT0 && WS_WGU0 + (size_t)2 * DFF * DM * 2 <= WS_WD0 && WS_WD0 + (size_t)DM * DFF * 2 <= WS_WIN1 && WS_WIN1 + (size_t)RET_IN * DM * 2 <= WS_WOUT1, "weight map");
static_assert(WS_WOUT1 + (size_t)DM * RET_VW * 2 <= WS_WGU1 && WS_WGU1 + (size_t)2 * DFF * DM * 2 <= WS_WD1 && WS_WD1 + (size_t)DM * DFF * 2 <= WS_WAT, "weight map 2");
static_assert(WS_XB + (size_t)MP * DM * 2 <= WS_Z && WS_Z + (size_t)MP * RET_IN * 2 <= WS_END && WS_Z + (size_t)MP * AB_Z * 2 <= WS_Y0 && WS_Z + (size_t)MP * DFF * 2 <= WS_Y0 && WS_Y0 + (size_t)MP * DM * 2 <= WS_END && WS_Y1 + (size_t)MP * RET_VW * 2 <= WS_WD0, "activation map");
constexpr int CW_TMO = 0, CW_Q2 = 64, CW_TK3 = 256, CW_TK5 = 320, CW_BAR = 4096;
constexpr int RING_BYTES = 131072;
constexpr int LDS_BYTES = 147456;
constexpr int MISC_OFF = LDS_BYTES - 256;
constexpr int NWAVES = 8, NTHREADS = 512;
constexpr int NPHASES = 12;

#define GAS __attribute__((address_space(1)))
#define LAS __attribute__((address_space(3)))
typedef unsigned short bf16;
typedef unsigned v4u __attribute__((ext_vector_type(4)));
typedef unsigned v2u __attribute__((ext_vector_type(2)));
typedef float f32x4 __attribute__((ext_vector_type(4)));
typedef short bf16x8 __attribute__((ext_vector_type(8)));
typedef short bf16x4 __attribute__((ext_vector_type(4)));
typedef GAS unsigned gu32;
#define RLX_AGENT __ATOMIC_RELAXED, __HIP_MEMORY_SCOPE_AGENT
#define LDS_WAIT() asm volatile("s_waitcnt lgkmcnt(0)" ::: "memory")
#define VM_WAIT() asm volatile("s_waitcnt vmcnt(0)" ::: "memory")
__device__ __forceinline__ unsigned f2bf(float f) { unsigned u = __builtin_bit_cast(unsigned, f); return (u + 0x7fffu + ((u >> 16) & 1u)) >> 16; }
__device__ __forceinline__ unsigned pk2(float lo, float hi) { return pg8::cvt_pk_bf16(lo, hi); }
__device__ __forceinline__ float bflo(unsigned w) { return __builtin_bit_cast(float, w << 16); }
__device__ __forceinline__ float bfhi(unsigned w) { return __builtin_bit_cast(float, w & 0xffff0000u); }
__device__ __forceinline__ float bf2f(unsigned short h) { return __builtin_bit_cast(float, (unsigned)h << 16); }
__device__ __forceinline__ void unpack8(const v4u w, float (&f)[8]) { f[0] = bflo(w.x); f[1] = bfhi(w.x); f[2] = bflo(w.y); f[3] = bfhi(w.y); f[4] = bflo(w.z); f[5] = bfhi(w.z); f[6] = bflo(w.w); f[7] = bfhi(w.w); }
__device__ __forceinline__ v4u pack8f(const float (&f)[8]) { v4u w; w.x = pk2(f[0], f[1]); w.y = pk2(f[2], f[3]); w.z = pk2(f[4], f[5]); w.w = pk2(f[6], f[7]); return w; }
__device__ __forceinline__ int row_of(int b, int t) { return t < NMETA ? MMETA + NMETA * b + t : b * SEQ + (t - NMETA); }
__device__ __forceinline__ f32x4 mfma16(bf16x8 a, bf16x8 b, f32x4 c) { return __builtin_amdgcn_mfma_f32_16x16x32_bf16(a, b, c, 0, 0, 0); }

#define XB_TMO      128
#define XB_XCNT(j)  (256  + 64 * (j))
#define XB_XSUB(j)  (1280 + 64 * (j))
#define XB_XGEN(j)  (2304 + 64 * (j))
#define XB_TOP      3328
#define XB_TOPGEN   3392
#define XCD_BAR_WORDS 3456
#define XB_SPIN_CAP (1u << 22)

__device__ __forceinline__ unsigned xb_ld(unsigned* p)              { return __hip_atomic_load(p, __ATOMIC_RELAXED, __HIP_MEMORY_SCOPE_AGENT); }
__device__ __forceinline__ unsigned xb_add(unsigned* p, unsigned v) { return __hip_atomic_fetch_add(p, v, __ATOMIC_RELAXED, __HIP_MEMORY_SCOPE_AGENT); }
__device__ __forceinline__ unsigned xb_xcc_id() { return (unsigned)__builtin_amdgcn_s_getreg((3 << 11) | 20) & 0xFu; }
#define XB_SPIN(cond, bar) do { unsigned _sp = 0; while (cond) { __builtin_amdgcn_s_sleep(1); \
    if ((++_sp & 255u) == 0u) { if (xb_ld(&(bar)[XB_TMO])) break; if (_sp > XB_SPIN_CAP) { atomicAdd(&(bar)[XB_TMO], 1u); break; } } } } while (0)

struct XcdBarrier {
    unsigned* bar; unsigned x;
    volatile LAS unsigned* st;
};
__device__ __forceinline__ XcdBarrier xcd_barrier_post(unsigned* bar, volatile LAS unsigned* st) {
    XcdBarrier b; b.bar = bar; b.x = xb_xcc_id(); b.st = st;
    if (threadIdx.x == 0) (void)xb_add(&bar[XB_XCNT(b.x)], 1u);
    return b;
}
__device__ __forceinline__ void xcd_barrier_complete(unsigned* bar, unsigned x, unsigned& nloc, unsigned& nx) {
    const unsigned G = gridDim.x * gridDim.y * gridDim.z;
    unsigned sum, cnt, mine, sp = 0u;
    for (;;) {
        sum = 0u; cnt = 0u; mine = 0u;
#pragma unroll
        for (unsigned j = 0; j < 16; ++j) { const unsigned c = xb_ld(&bar[XB_XCNT(j)]); sum += c; cnt += (c > 0u) ? 1u : 0u; mine = (j == x) ? c : mine; }
        if (sum == G) break;
        __builtin_amdgcn_s_sleep(1);
        if ((++sp & 255u) == 0u) { if (xb_ld(&bar[XB_TMO])) break; if (sp > XB_SPIN_CAP) { atomicAdd(&bar[XB_TMO], 1u); break; } }
    }
    nloc = mine > 0u ? mine : 1u; nx = cnt > 0u ? cnt : 1u;
}
__device__ __forceinline__ void xcd_barrier(const XcdBarrier& b) {
    asm volatile("s_waitcnt vmcnt(0)" ::: "memory");
    __syncthreads();
    if (threadIdx.x == 0) {
        unsigned* bar = b.bar;
        __builtin_amdgcn_s_waitcnt(0);
        unsigned nloc = b.st[0], nx = b.st[1];
        if (nloc == 0u) { xcd_barrier_complete(bar, b.x, nloc, nx); b.st[0] = nloc; b.st[1] = nx; }
        const unsigned old = xb_add(&bar[XB_XSUB(b.x)], 1u);
        const unsigned gen = old / nloc;
        if (old + 1u == (gen + 1u) * nloc) {
            __builtin_amdgcn_fence(__ATOMIC_RELEASE, "agent");
            asm volatile("s_waitcnt vmcnt(0)" ::: "memory");
            const unsigned og = xb_add(&bar[XB_TOP], 1u);
            const unsigned tg = og / nx;
            if (og + 1u == (tg + 1u) * nx) xb_add(&bar[XB_TOPGEN], 1u);
            else XB_SPIN(xb_ld(&bar[XB_TOPGEN]) == tg, bar);
            __builtin_amdgcn_fence(__ATOMIC_ACQUIRE, "agent");
            xb_add(&bar[XB_XGEN(b.x)], 1u);
            asm volatile("s_waitcnt vmcnt(0)" ::: "memory");
        } else {
            XB_SPIN(xb_ld(&bar[XB_XGEN(b.x)]) == gen, bar);
            __builtin_amdgcn_fence(__ATOMIC_ACQUIRE, "agent");
            asm volatile("s_waitcnt vmcnt(0)" ::: "memory");
        }
    }
    __syncthreads();
}

struct Args { const float* in[23]; float* out; unsigned char* ws; int ph_lo, ph_hi; };
__device__ __forceinline__ float* h_row(float* out, unsigned char* ws, int r) { return r < MTOK ? out + (size_t)r * DM : (float*)(ws + WS_HMETA) + (size_t)(r - MTOK) * DM; }
struct Frame {
    LAS unsigned char* lds;
    volatile LAS unsigned* MISC;
    unsigned char* ws;
    int tid, lane, wave, G;
};
__device__ __forceinline__ float wave_sum(float v) {
#pragma unroll
    for (int o = 1; o < 64; o <<= 1) v += __shfl_xor(v, o);
    return v;
}

template <int MODE, int KCH>
__device__ __forceinline__ void p0_tr(const float* W, int K, int N, bf16* WT, LAS unsigned* tile, int item, int lane) {
    const int nnb = (N + 63) / 64, kc = item / nnb, nb = item - kc * nnb, k0 = kc * KCH, n0 = nb * 64;
    const int kq = lane >> 4, nq = lane & 15; const int n = n0 + 4 * nq; const bool ok = n < N;
    const float* src = W + (size_t)(k0 + 2 * kq) * N + (ok ? n : 0);
    const int nr = lane >> 3, kch = lane & 7;
    f32x4 va[8][2], vb[8][2];
#define P0_LOAD(v, sub) do { _Pragma("unroll") for (int i = 0; i < 8; ++i) { const float* p_ = src + (size_t)(64 * (sub) + 8 * i) * N; v[i][0] = *(const GAS f32x4*)p_; v[i][1] = *(const GAS f32x4*)(p_ + N); } } while (0)
#define P0_PROC(v, sub) do { const int kb = k0 + 64 * (sub); \
        _Pragma("unroll") for (int i = 0; i < 8; ++i) { \
            _Pragma("unroll") for (int c = 0; c < 4; ++c) tile[(4 * nq + c) * 33 + 4 * i + kq] = pk2(v[i][0][c], v[i][1][c]); } \
        LDS_WAIT(); asm volatile("" ::: "memory"); \
        _Pragma("unroll") for (int st = 0; st < 8; ++st) { const int row = 8 * st + nr; const LAS unsigned* tp = tile + row * 33 + 4 * kch; \
            v4u o; o.x = tp[0]; o.y = tp[1]; o.z = tp[2]; o.w = tp[3]; \
            const int ng = n0 + row; const int drow = MODE == 0 ? ng : (MODE == 1 ? 256 * (ng >> 7) + (ng & 127) : 256 * (ng >> 7) + 128 + (ng & 127)); \
            if (ng < N) *(GAS v4u*)(WT + (size_t)drow * K + kb + 8 * kch) = o; } \
        LDS_WAIT(); asm volatile("" ::: "memory"); } while (0)
    P0_LOAD(va, 0);
#pragma unroll 1
    for (int sub = 0; sub < KCH / 64; sub += 2) {
        P0_LOAD(vb, sub + 1);
        P0_PROC(va, sub);
        if (sub + 2 < KCH / 64) P0_LOAD(va, sub + 2);
        P0_PROC(vb, sub + 1);
    }
#undef P0_LOAD
#undef P0_PROC
}
__device__ __forceinline__ void p0_row(Frame& F, const float* x, const float* meta, const float* gain, float* out, int r) {
    float* hrow = h_row(out, F.ws, r); bf16* xrow = (bf16*)(F.ws + WS_XB) + (size_t)r * DM;
    const float* src = r < MTOK ? x + (size_t)r * DM : meta + (size_t)((r - MTOK) & 15) * DM;
    const bool pad = r >= MTOK + NB * NMETA;
    float s = 0.f;
#pragma unroll 4
    for (int j = 0; j < 16; ++j) { const int e = (F.lane + 64 * j) * 4;
        f32x4 v = pad ? (f32x4){0.f, 0.f, 0.f, 0.f} : *(const GAS f32x4*)(src + e);
        s += (v.x * v.x + v.y * v.y) + (v.z * v.z + v.w * v.w);
        *(GAS f32x4*)(hrow + e) = v; const f32x4 gn = *(const GAS f32x4*)(gain + e); v2u w; w.x = pk2(v.x * gn.x, v.y * gn.y); w.y = pk2(v.z * gn.z, v.w * gn.w); *(GAS v2u*)(xrow + e) = w; }
    s = wave_sum(s);
    if (F.lane == 0) ((float*)(F.ws + WS_SSQ0))[r] = s;
}
#ifndef CONV_IN_P2
#define CONV_IN_P2 1
#endif
constexpr int P0_KC = 256;
constexpr int CV_G = 172 * (DM / P0_KC), CV_D = 64 * (DFF / P0_KC), CV_IN1 = 384 * (DM / P0_KC), CV_O1 = 64 * (RET_VW / P0_KC);
constexpr int CV_FINE = 2 * (2 * CV_G + CV_D) + CV_IN1 + CV_O1;
constexpr int CV_PER = 32, N_CONV = CONV_IN_P2 ? (CV_FINE + CV_PER - 1) / CV_PER : 0;
struct ConvPtrs { const float *wg, *wu, *wd, *win1, *wo1, *fnorm, *cnorm; };
__device__ __forceinline__ void conv_fine_b2(unsigned char* ws, LAS unsigned* tile, const ConvPtrs P, int it, int lane) {
    int r = it;
    if (r < CV_G) { p0_tr<1, P0_KC>(P.wg, DM, DFF, (bf16*)(ws + WS_WGU0), tile, r, lane); return; } r -= CV_G;
    if (r < CV_G) { p0_tr<2, P0_KC>(P.wu, DM, DFF, (bf16*)(ws + WS_WGU0), tile, r, lane); return; } r -= CV_G;
    if (r < CV_D) { p0_tr<0, P0_KC>(P.wd, DFF, DM, (bf16*)(ws + WS_WD0), tile, r, lane); return; } r -= CV_D;
    if (r < CV_IN1) { p0_tr<0, P0_KC>(P.win1, DM, RET_IN, (bf16*)(ws + WS_WIN1), tile, r, lane); return; } r -= CV_IN1;
    if (r < CV_O1) { p0_tr<0, P0_KC>(P.wo1, RET_VW, DM, (bf16*)(ws + WS_WOUT1), tile, r, lane); return; } r -= CV_O1;
    if (r < CV_G) { p0_tr<1, P0_KC>(P.wg + (size_t)DM * DFF, DM, DFF, (bf16*)(ws + WS_WGU1), tile, r, lane); return; } r -= CV_G;
    if (r < CV_G) { p0_tr<2, P0_KC>(P.wu + (size_t)DM * DFF, DM, DFF, (bf16*)(ws + WS_WGU1), tile, r, lane); return; } r -= CV_G;
    p0_tr<0, P0_KC>(P.wd + (size_t)DFF * DM, DFF, DM, (bf16*)(ws + WS_WD1), tile, r, lane);
}
__device__ __forceinline__ void conv_item(unsigned char* ws, LAS unsigned char* ldsb, ConvPtrs P, int ci, int wave, int lane) {
    LAS unsigned* tile = (LAS unsigned*)(ldsb + wave * 8448);
    for (int k = wave; k < CV_PER; k += NWAVES) { const int it = __builtin_amdgcn_readfirstlane(ci * CV_PER + k); if (it < CV_FINE) conv_fine_b2(ws, tile, P, it, lane); }
}
__device__ __forceinline__ void p0_prologue(Frame& F, const Args& A) {
    const int gw = __builtin_amdgcn_readfirstlane(blockIdx.x * NWAVES + F.wave), NGW = F.G * NWAVES;
    unsigned char* ws = F.ws;
    constexpr int KC = P0_KC; LAS unsigned* tile = (LAS unsigned*)(F.lds + F.wave * 8448);
    constexpr int I_IN0 = 161 * (DM / KC), I_SQ = 64 * (DM / KC), I_BD = 16 * 2;
    constexpr int NITEMS = I_IN0 + I_SQ + 2 * I_BD;
    for (int it = gw; it < NITEMS; it += NGW) {
        int r = it;
        if (r < I_IN0) { p0_tr<0, KC>(A.in[3], DM, AB_IN, (bf16*)(ws + WS_WIN0), tile, r, F.lane); continue; } r -= I_IN0;
        if (r < I_SQ) { p0_tr<0, KC>(A.in[14], DM, DM, (bf16*)(ws + WS_WOUT0), tile, r, F.lane); continue; } r -= I_SQ;
        if (r < I_BD) { const int blk = r >> 1; p0_tr<0, 128>(A.in[7] + (size_t)blk * 16384, 128, 128, (bf16*)(ws + WS_WAT) + (size_t)blk * 16384, tile, r & 1, F.lane); continue; } r -= I_BD;
        { const int blk = r >> 1; p0_tr<0, 128>(A.in[9] + (size_t)blk * 16384, 128, 128, (bf16*)(ws + WS_WXT) + (size_t)blk * 16384, tile, r & 1, F.lane); }
    }
#if !CONV_IN_P2
    { const ConvPtrs CP{A.in[20], A.in[21], A.in[22], A.in[16], A.in[18], A.in[19], A.in[15]};
      for (int it = gw; it < CV_FINE; it += NGW) conv_fine_b2(ws, tile, CP, it, F.lane); }
#endif
    for (int m = gw; m < MP; m += NGW) p0_row(F, A.in[0], A.in[1], A.in[2], A.out, m);
}

__device__ __forceinline__ float sigmoidf_fast(float x) { return __builtin_amdgcn_rcpf(1.0f + __expf(-x)); }
__device__ __forceinline__ float gelu_tanh(float g) { const float z = 0.7978845608028654f * (g + 0.044715f * g * g * g); const float e = __expf(2.0f * z); return 0.5f * g * (2.0f - 2.0f * __builtin_amdgcn_rcpf(e + 1.0f)); }

constexpr int LRU_XA = 0, LRU_STRIDE = 272, LRU_XF = 17408, LRU_XF_STRIDE = 132  , LRU_GT = 51200, LRU_YT = 68608;
__device__ __forceinline__ void lru_item(Frame& F, const Args& A, int b, int n) {
    const bf16* z0 = (const bf16*)(F.ws + WS_Z); bf16* y0 = (bf16*)(F.ws + WS_Y0);
    const int tid = F.tid, lane = F.lane, w = F.wave, fr = lane & 15, fq = lane >> 4;
    LAS unsigned char* lds = F.lds;
    LAS float* XF = (LAS float*)(lds + LRU_XF);
    const int c8 = (tid & 15) * 8, r4 = tid >> 4;
    const int ch0 = n * 128 + c8;
    float cw[4][8], cb[8];
#pragma unroll
    for (int e = 0; e < 8; ++e) { cb[e] = A.in[6][ch0 + e];
#pragma unroll
        for (int j = 0; j < 4; ++j) cw[j][e] = A.in[5][j * LRU_W + ch0 + e]; }
    const int dch = n * 128 + 16 * w + fr;
    const float ba = A.in[8][dch], bx = A.in[10][dch];
    const float cneg = -8.0f * log1pf(expf(-A.in[11][dch]));
    bf16x8 bwa[4], bwx[4];
    { const bf16* wat = (const bf16*)(F.ws + WS_WAT) + ((size_t)n * 128 + 16 * w + fr) * 128 + 8 * fq; const bf16* wxt = (const bf16*)(F.ws + WS_WXT) + ((size_t)n * 128 + 16 * w + fr) * 128 + 8 * fq;
#pragma unroll
      for (int ks = 0; ks < 4; ++ks) { bwa[ks] = *(const bf16x8*)(wat + 32 * ks); bwx[ks] = *(const bf16x8*)(wxt + 32 * ks); } }
    float hc = 0.f;
    v4u xr[2][4], gv[2];
#define LRU_LOAD(tau) do { _Pragma("unroll") for (int q = 0; q < 2; ++q) { const int t = 64 * (tau) + r4 + 32 * q - 48; \
            gv[q] = (v4u){0u, 0u, 0u, 0u}; if (t >= 0) gv[q] = *(const GAS v4u*)(z0 + (size_t)row_of(b, t) * AB_Z + LRU_W + ch0); \
            _Pragma("unroll") for (int j = 0; j < 4; ++j) { const int tj = t - 3 + j; xr[q][j] = (v4u){0u, 0u, 0u, 0u}; if (tj >= 0) xr[q][j] = *(const GAS v4u*)(z0 + (size_t)row_of(b, tj) * AB_Z + ch0); } } } while (0)
    LRU_LOAD(0);
    for (int tau = 0; tau < 65; ++tau) {
#pragma unroll
        for (int q = 0; q < 2; ++q) {
            const int rr = r4 + 32 * q;
            float xc[8];
#pragma unroll
            for (int e = 0; e < 8; ++e) xc[e] = cb[e];
#pragma unroll
            for (int j = 0; j < 4; ++j) { float xf[8]; unpack8(xr[q][j], xf);
#pragma unroll
                for (int e = 0; e < 8; ++e) xc[e] += cw[j][e] * xf[e]; }
            *(LAS v4u*)(lds + LRU_XA + rr * LRU_STRIDE + c8 * 2) = pack8f(xc);
            *(LAS f32x4*)(XF + rr * LRU_XF_STRIDE + c8) = (f32x4){xc[0], xc[1], xc[2], xc[3]};
            *(LAS f32x4*)(XF + rr * LRU_XF_STRIDE + c8 + 4) = (f32x4){xc[4], xc[5], xc[6], xc[7]};
            *(LAS v4u*)(lds + LRU_GT + rr * LRU_STRIDE + c8 * 2) = gv[q];
        }
        if (tau < 64) LRU_LOAD(tau + 1);
        __syncthreads();
        f32x4 accr[4], acci[4];
#pragma unroll
        for (int m = 0; m < 4; ++m) { accr[m] = (f32x4){0.f, 0.f, 0.f, 0.f}; acci[m] = (f32x4){0.f, 0.f, 0.f, 0.f}; }
#pragma unroll
        for (int m = 0; m < 4; ++m)
#pragma unroll
            for (int ks = 0; ks < 4; ++ks) { const bf16x8 a = *(const LAS bf16x8*)(lds + LRU_XA + (16 * m + fr) * LRU_STRIDE + (32 * ks + 8 * fq) * 2);
                accr[m] = mfma16(a, bwa[ks], accr[m]); acci[m] = mfma16(a, bwx[ks], acci[m]); }
        const int d = 16 * w + fr;
#pragma unroll
        for (int m = 0; m < 4; ++m) {
            float av[4], bv[4];
#pragma unroll
            for (int g = 0; g < 4; ++g) { const int rr = 16 * m + 4 * fq + g;
                const float rg = sigmoidf_fast(accr[m][g] + ba), ig = sigmoidf_fast(acci[m][g] + bx);
                const float la = cneg * rg; av[g] = __expf(la); const float mult = sqrtf(fmaxf(1.0f - __expf(2.0f * la), 0.f));
                bv[g] = mult * (ig * XF[rr * LRU_XF_STRIDE + d]);
                if (tau == 0 && rr < 48) bv[g] = 0.f; }
            float P = av[0] * av[1], H = bv[0] * av[1] + bv[1]; P *= av[2]; H = H * av[2] + bv[2]; P *= av[3]; H = H * av[3] + bv[3];
            { const float P1 = __shfl_up(P, 16), H1 = __shfl_up(H, 16); if (fq >= 1) { H = P * H1 + H; P = P1 * P; } }
            { const float P2 = __shfl_up(P, 32), H2 = __shfl_up(H, 32); if (fq >= 2) { H = P * H2 + H; P = P2 * P; } }
            float Pe = __shfl_up(P, 16), He = __shfl_up(H, 16); if (fq == 0) { Pe = 1.f; He = 0.f; }
            float h = Pe * hc + He;
            float hv[4];
#pragma unroll
            for (int g = 0; g < 4; ++g) { h = av[g] * h + bv[g]; hv[g] = h; }
            hc = __shfl(h, 48 + fr);
#pragma unroll
            for (int g = 0; g < 4; ++g) { const int rr = 16 * m + 4 * fq + g;
                const float gt = bf2f(*(const LAS unsigned short*)(lds + LRU_GT + rr * LRU_STRIDE + d * 2));
                *(LAS unsigned short*)(lds + LRU_YT + rr * LRU_STRIDE + d * 2) = (unsigned short)(pk2(hv[g] * gelu_tanh(gt), 0.f) & 0xffffu); }
        }
        __syncthreads();
#pragma unroll
        for (int q = 0; q < 2; ++q) { const int rr = r4 + 32 * q, t = 64 * tau + rr - 48;
            if (t >= 0) *(GAS v4u*)(y0 + (size_t)row_of(b, t) * DM + ch0) = *(const LAS v4u*)(lds + LRU_YT + rr * LRU_STRIDE + c8 * 2); }
    }
#undef LRU_LOAD
    __syncthreads();
}

constexpr int AT_STRIDE = 272, AT_TILE = 64 * AT_STRIDE, AT_KT = 0, AT_VN = 2 * AT_TILE, AT_RSK = 4 * AT_TILE, AT_CUM = AT_RSK + 512, AT_SCAN = AT_CUM + 4352 * 4;
static_assert(AT_SCAN + 64 <= RING_BYTES, "attention LDS map");
__device__ __forceinline__ float log_sigmoid(float x) { return fminf(x, 0.f) - log1pf(__expf(-fabsf(x))); }
__device__ __forceinline__ void attn_item(Frame& F, const Args& A, int b, int h, int j) {
    const bf16* z0 = (const bf16*)(F.ws + WS_Z); bf16* y0 = (bf16*)(F.ws + WS_Y0); const float* fbuf = (const float*)(F.ws + WS_FBUF);
    const int tid = F.tid, lane = F.lane, w = F.wave, fr = lane & 15, fq = lane >> 4;
    LAS unsigned char* lds = F.lds;
    LAS float* CUM = (LAS float*)(lds + AT_CUM); LAS float* SCAN = (LAS float*)(lds + AT_SCAN); LAS float* RSK = (LAS float*)(lds + AT_RSK);
    constexpr float LOG2E = 1.4426950408889634f;
    const int nT = NMETA + 256 * j;
    { const float bf_h = A.in[4][h];
      float loc[9]; float run = 0.f;
#pragma unroll
      for (int e = 0; e < 9; ++e) { const int t = 9 * tid + e; float v = 0.f; if (t < nT) v = log_sigmoid(fbuf[(size_t)row_of(b, t) * 16 + h] + bf_h); run += v; loc[e] = run; }
      float inc = run;
#pragma unroll
      for (int o = 1; o < 64; o <<= 1) { const float t = __shfl_up(inc, o); if (lane >= o) inc += t; }
      if (lane == 63) SCAN[w] = inc;
      __syncthreads();
      float off = inc - run;
      for (int k = 0; k < w; ++k) off += SCAN[k];
#pragma unroll
      for (int e = 0; e < 9; ++e) { const int t = 9 * tid + e; if (t < nT) CUM[t + 240] = (off + loc[e]) * LOG2E; }
      if (tid < 240) CUM[tid] = 0.f; }
    bf16x8 qf[2][4];
    const int ubase = 256 * j + 32 * w;
#pragma unroll
    for (int m = 0; m < 2; ++m) {
        const int u = ubase + 16 * m + fr; const int t = u - 240; const int r = row_of(b, t < 0 ? 0 : t);
        const bf16* qp = z0 + (size_t)r * AB_Z + 4096 + 128 * h + 8 * fq;
        float qv[4][8]; float s = 0.f;
#pragma unroll
        for (int ks = 0; ks < 4; ++ks) { const v4u raw = *(const GAS v4u*)(qp + 32 * ks); unpack8(raw, qv[ks]);
#pragma unroll
            for (int e = 0; e < 8; ++e) s += qv[ks][e] * qv[ks][e]; }
        s += __shfl_xor(s, 16); s += __shfl_xor(s, 32);
        const float rs = (1.0f / sqrtf(s * (1.0f / 128.0f) + RMS_EPS)) * (0.08838834764831845f * LOG2E);
#pragma unroll
        for (int ks = 0; ks < 4; ++ks) { float o[8];
#pragma unroll
            for (int e = 0; e < 8; ++e) o[e] = qv[ks][e] * rs * (A.in[12][32 * ks + 8 * fq + e] * A.in[13][32 * ks + 8 * fq + e]);
            const v4u pk = pack8f(o); qf[m][ks] = __builtin_bit_cast(bf16x8, pk); }
    }
    f32x4 O[2][8]; float mrow[2], lrow[2];
#pragma unroll
    for (int m = 0; m < 2; ++m) {
#pragma unroll
        for (int dt = 0; dt < 8; ++dt) O[m][dt] = (f32x4){0.f, 0.f, 0.f, 0.f};
        mrow[m] = -1e30f; lrow[m] = 0.f; }
    const int imax = 4 * j + 3;
    const int skey = tid >> 3, sdc = (tid & 7) * 16;
    const unsigned vbase = (unsigned)(size_t)lds + AT_VN + (4u * fq + ((unsigned)(lane & 15) >> 2)) * AT_STRIDE + 8u * (unsigned)(lane & 3);
    v4u kreg[2], vreg[2];
#define AT_LOAD(i_) do { const int t_ = 64 * (i_) + skey - 240; const int r_ = row_of(b, t_ < 0 ? 0 : t_); const bf16* kp_ = z0 + (size_t)r_ * AB_Z + 6144 + 128 * h + sdc; const bf16* vp_ = z0 + (size_t)r_ * AB_Z + 8192 + 128 * h + sdc; \
        kreg[0] = *(const GAS v4u*)(kp_); kreg[1] = *(const GAS v4u*)(kp_ + 8); vreg[0] = *(const GAS v4u*)(vp_); vreg[1] = *(const GAS v4u*)(vp_ + 8); } while (0)
#define AT_STAGE(buf_) do { float a8_[8], b8_[8]; unpack8(kreg[0], a8_); unpack8(kreg[1], b8_); float s_ = 0.f; \
        _Pragma("unroll") for (int e = 0; e < 8; ++e) s_ += a8_[e] * a8_[e] + b8_[e] * b8_[e]; \
        s_ += __shfl_xor(s_, 1); s_ += __shfl_xor(s_, 2); s_ += __shfl_xor(s_, 4); \
        if ((tid & 7) == 0) RSK[(buf_) * 64 + skey] = 1.0f / sqrtf(s_ * (1.0f / 128.0f) + RMS_EPS); \
        *(LAS v4u*)(lds + AT_KT + (buf_) * AT_TILE + skey * AT_STRIDE + sdc * 2) = kreg[0]; *(LAS v4u*)(lds + AT_KT + (buf_) * AT_TILE + skey * AT_STRIDE + sdc * 2 + 16) = kreg[1]; \
        *(LAS v4u*)(lds + AT_VN + (buf_) * AT_TILE + skey * AT_STRIDE + sdc * 2) = vreg[0]; *(LAS v4u*)(lds + AT_VN + (buf_) * AT_TILE + skey * AT_STRIDE + sdc * 2 + 16) = vreg[1]; } while (0)
    AT_LOAD(3); AT_STAGE(1);
    if (imax > 3) AT_LOAD(4);
    __syncthreads();
    float bq[2];
#pragma unroll
    for (int m = 0; m < 2; ++m) bq[m] = CUM[ubase + 16 * m + fr];
    for (int i = 3; i <= imax; ++i) {
        const int buf = i & 1;
        if (i < imax) { AT_STAGE(buf ^ 1); if (i + 1 < imax) AT_LOAD(i + 2); }
        if (64 * i <= ubase + 31) {
            f32x4 S[2][4];
#pragma unroll
            for (int m = 0; m < 2; ++m)
#pragma unroll
                for (int nt = 0; nt < 4; ++nt) S[m][nt] = (f32x4){0.f, 0.f, 0.f, 0.f};
#pragma unroll
            for (int nt = 0; nt < 4; ++nt)
#pragma unroll
                for (int ks = 0; ks < 4; ++ks) { const bf16x8 kf = *(const LAS bf16x8*)(lds + AT_KT + buf * AT_TILE + (16 * nt + fr) * AT_STRIDE + (32 * ks + 8 * fq) * 2);
                    S[0][nt] = mfma16(kf, qf[0][ks], S[0][nt]); S[1][nt] = mfma16(kf, qf[1][ks], S[1][nt]); }
            f32x4 bk[4], rk[4];
#pragma unroll
            for (int nt = 0; nt < 4; ++nt) { bk[nt] = *(const LAS f32x4*)(CUM + 64 * i + 16 * nt + 4 * fq); rk[nt] = *(const LAS f32x4*)(RSK + buf * 64 + 16 * nt + 4 * fq); }
            const bool need_mask = (i == 3) || (64 * i + 63 > ubase);
            bf16x8 pb[2][2];
#pragma unroll
            for (int m = 0; m < 2; ++m) {
                const int uq = ubase + 16 * m + fr;
                float mx = -__builtin_inff();
#pragma unroll
                for (int nt = 0; nt < 4; ++nt)
#pragma unroll
                    for (int g = 0; g < 4; ++g) { float sv = S[m][nt][g] * rk[nt][g] + (bq[m] - bk[nt][g]);
                        if (need_mask) { const int uk = 64 * i + 16 * nt + 4 * fq + g; if (uk > uq || uk < 240) sv = -__builtin_inff(); }
                        S[m][nt][g] = sv; mx = fmaxf(mx, sv); }
                mx = fmaxf(mx, __shfl_xor(mx, 16)); mx = fmaxf(mx, __shfl_xor(mx, 32));
                const float mn = fmaxf(mrow[m], mx);
                const float alpha = __builtin_amdgcn_exp2f(mrow[m] - mn); mrow[m] = mn;
                float ps = 0.f;
#pragma unroll
                for (int nt = 0; nt < 4; ++nt)
#pragma unroll
                    for (int g = 0; g < 4; ++g) { const float p = __builtin_amdgcn_exp2f(S[m][nt][g] - mn); ps += p; S[m][nt][g] = p; }
                lrow[m] = lrow[m] * alpha + ps;
                if (!__all(alpha == 1.0f)) {
#pragma unroll
                    for (int dt = 0; dt < 8; ++dt) O[m][dt] *= alpha; }
#pragma unroll
                for (int k2 = 0; k2 < 2; ++k2) { v4u pw; pw.x = pk2(S[m][2 * k2][0], S[m][2 * k2][1]); pw.y = pk2(S[m][2 * k2][2], S[m][2 * k2][3]); pw.z = pk2(S[m][2 * k2 + 1][0], S[m][2 * k2 + 1][1]); pw.w = pk2(S[m][2 * k2 + 1][2], S[m][2 * k2 + 1][3]);
                    pb[m][k2] = __builtin_bit_cast(bf16x8, pw); }
            }
            const unsigned vb = vbase + (unsigned)(buf * AT_TILE);
            { v2u vp[16]; asm volatile("ds_read_b64_tr_b16 %0, %16 offset:0 \n\tds_read_b64_tr_b16 %1, %16 offset:4352 \n\tds_read_b64_tr_b16 %2, %16 offset:8704 \n\tds_read_b64_tr_b16 %3, %16 offset:13056 \n\tds_read_b64_tr_b16 %4, %16 offset:32 \n\tds_read_b64_tr_b16 %5, %16 offset:4384 \n\tds_read_b64_tr_b16 %6, %16 offset:8736 \n\tds_read_b64_tr_b16 %7, %16 offset:13088 \n\tds_read_b64_tr_b16 %8, %16 offset:64 \n\tds_read_b64_tr_b16 %9, %16 offset:4416 \n\tds_read_b64_tr_b16 %10, %16 offset:8768 \n\tds_read_b64_tr_b16 %11, %16 offset:13120 \n\tds_read_b64_tr_b16 %12, %16 offset:96 \n\tds_read_b64_tr_b16 %13, %16 offset:4448 \n\tds_read_b64_tr_b16 %14, %16 offset:8800 \n\tds_read_b64_tr_b16 %15, %16 offset:13152 \n\ts_waitcnt lgkmcnt(0)" : "=&v"(vp[0]), "=&v"(vp[1]), "=&v"(vp[2]), "=&v"(vp[3]), "=&v"(vp[4]), "=&v"(vp[5]), "=&v"(vp[6]), "=&v"(vp[7]), "=&v"(vp[8]), "=&v"(vp[9]), "=&v"(vp[10]), "=&v"(vp[11]), "=&v"(vp[12]), "=&v"(vp[13]), "=&v"(vp[14]), "=&v"(vp[15]) : "v"(vb) : "memory");
              { v4u aw; aw.x = vp[0].x; aw.y = vp[0].y; aw.z = vp[1].x; aw.w = vp[1].y; const bf16x8 vfr = __builtin_bit_cast(bf16x8, aw); O[0][0] = mfma16(vfr, pb[0][0], O[0][0]); O[1][0] = mfma16(vfr, pb[1][0], O[1][0]); }
              { v4u aw; aw.x = vp[2].x; aw.y = vp[2].y; aw.z = vp[3].x; aw.w = vp[3].y; const bf16x8 vfr = __builtin_bit_cast(bf16x8, aw); O[0][0] = mfma16(vfr, pb[0][1], O[0][0]); O[1][0] = mfma16(vfr, pb[1][1], O[1][0]); }
              { v4u aw; aw.x = vp[4].x; aw.y = vp[4].y; aw.z = vp[5].x; aw.w = vp[5].y; const bf16x8 vfr = __builtin_bit_cast(bf16x8, aw); O[0][1] = mfma16(vfr, pb[0][0], O[0][1]); O[1][1] = mfma16(vfr, pb[1][0], O[1][1]); }
              { v4u aw; aw.x = vp[6].x; aw.y = vp[6].y; aw.z = vp[7].x; aw.w = vp[7].y; const bf16x8 vfr = __builtin_bit_cast(bf16x8, aw); O[0][1] = mfma16(vfr, pb[0][1], O[0][1]); O[1][1] = mfma16(vfr, pb[1][1], O[1][1]); }
              { v4u aw; aw.x = vp[8].x; aw.y = vp[8].y; aw.z = vp[9].x; aw.w = vp[9].y; const bf16x8 vfr = __builtin_bit_cast(bf16x8, aw); O[0][2] = mfma16(vfr, pb[0][0], O[0][2]); O[1][2] = mfma16(vfr, pb[1][0], O[1][2]); }
              { v4u aw; aw.x = vp[10].x; aw.y = vp[10].y; aw.z = vp[11].x; aw.w = vp[11].y; const bf16x8 vfr = __builtin_bit_cast(bf16x8, aw); O[0][2] = mfma16(vfr, pb[0][1], O[0][2]); O[1][2] = mfma16(vfr, pb[1][1], O[1][2]); }
              { v4u aw; aw.x = vp[12].x; aw.y = vp[12].y; aw.z = vp[13].x; aw.w = vp[13].y; const bf16x8 vfr = __builtin_bit_cast(bf16x8, aw); O[0][3] = mfma16(vfr, pb[0][0], O[0][3]); O[1][3] = mfma16(vfr, pb[1][0], O[1][3]); }
              { v4u aw; aw.x = vp[14].x; aw.y = vp[14].y; aw.z = vp[15].x; aw.w = vp[15].y; const bf16x8 vfr = __builtin_bit_cast(bf16x8, aw); O[0][3] = mfma16(vfr, pb[0][1], O[0][3]); O[1][3] = mfma16(vfr, pb[1][1], O[1][3]); }
            }
            { v2u vp[16]; asm volatile("ds_read_b64_tr_b16 %0, %16 offset:128 \n\tds_read_b64_tr_b16 %1, %16 offset:4480 \n\tds_read_b64_tr_b16 %2, %16 offset:8832 \n\tds_read_b64_tr_b16 %3, %16 offset:13184 \n\tds_read_b64_tr_b16 %4, %16 offset:160 \n\tds_read_b64_tr_b16 %5, %16 offset:4512 \n\tds_read_b64_tr_b16 %6, %16 offset:8864 \n\tds_read_b64_tr_b16 %7, %16 offset:13216 \n\tds_read_b64_tr_b16 %8, %16 offset:192 \n\tds_read_b64_tr_b16 %9, %16 offset:4544 \n\tds_read_b64_tr_b16 %10, %16 offset:8896 \n\tds_read_b64_tr_b16 %11, %16 offset:13248 \n\tds_read_b64_tr_b16 %12, %16 offset:224 \n\tds_read_b64_tr_b16 %13, %16 offset:4576 \n\tds_read_b64_tr_b16 %14, %16 offset:8928 \n\tds_read_b64_tr_b16 %15, %16 offset:13280 \n\ts_waitcnt lgkmcnt(0)" : "=&v"(vp[0]), "=&v"(vp[1]), "=&v"(vp[2]), "=&v"(vp[3]), "=&v"(vp[4]), "=&v"(vp[5]), "=&v"(vp[6]), "=&v"(vp[7]), "=&v"(vp[8]), "=&v"(vp[9]), "=&v"(vp[10]), "=&v"(vp[11]), "=&v"(vp[12]), "=&v"(vp[13]), "=&v"(vp[14]), "=&v"(vp[15]) : "v"(vb) : "memory");
              { v4u aw; aw.x = vp[0].x; aw.y = vp[0].y; aw.z = vp[1].x; aw.w = vp[1].y; const bf16x8 vfr = __builtin_bit_cast(bf16x8, aw); O[0][4] = mfma16(vfr, pb[0][0], O[0][4]); O[1][4] = mfma16(vfr, pb[1][0], O[1][4]); }
              { v4u aw; aw.x = vp[2].x; aw.y = vp[2].y; aw.z = vp[3].x; aw.w = vp[3].y; const bf16x8 vfr = __builtin_bit_cast(bf16x8, aw); O[0][4] = mfma16(vfr, pb[0][1], O[0][4]); O[1][4] = mfma16(vfr, pb[1][1], O[1][4]); }
              { v4u aw; aw.x = vp[4].x; aw.y = vp[4].y; aw.z = vp[5].x; aw.w = vp[5].y; const bf16x8 vfr = __builtin_bit_cast(bf16x8, aw); O[0][5] = mfma16(vfr, pb[0][0], O[0][5]); O[1][5] = mfma16(vfr, pb[1][0], O[1][5]); }
              { v4u aw; aw.x = vp[6].x; aw.y = vp[6].y; aw.z = vp[7].x; aw.w = vp[7].y; const bf16x8 vfr = __builtin_bit_cast(bf16x8, aw); O[0][5] = mfma16(vfr, pb[0][1], O[0][5]); O[1][5] = mfma16(vfr, pb[1][1], O[1][5]); }
              { v4u aw; aw.x = vp[8].x; aw.y = vp[8].y; aw.z = vp[9].x; aw.w = vp[9].y; const bf16x8 vfr = __builtin_bit_cast(bf16x8, aw); O[0][6] = mfma16(vfr, pb[0][0], O[0][6]); O[1][6] = mfma16(vfr, pb[1][0], O[1][6]); }
              { v4u aw; aw.x = vp[10].x; aw.y = vp[10].y; aw.z = vp[11].x; aw.w = vp[11].y; const bf16x8 vfr = __builtin_bit_cast(bf16x8, aw); O[0][6] = mfma16(vfr, pb[0][1], O[0][6]); O[1][6] = mfma16(vfr, pb[1][1], O[1][6]); }
              { v4u aw; aw.x = vp[12].x; aw.y = vp[12].y; aw.z = vp[13].x; aw.w = vp[13].y; const bf16x8 vfr = __builtin_bit_cast(bf16x8, aw); O[0][7] = mfma16(vfr, pb[0][0], O[0][7]); O[1][7] = mfma16(vfr, pb[1][0], O[1][7]); }
              { v4u aw; aw.x = vp[14].x; aw.y = vp[14].y; aw.z = vp[15].x; aw.w = vp[15].y; const bf16x8 vfr = __builtin_bit_cast(bf16x8, aw); O[0][7] = mfma16(vfr, pb[0][1], O[0][7]); O[1][7] = mfma16(vfr, pb[1][1], O[1][7]); }
            }
        }
        __syncthreads();
    }
#undef AT_LOAD
#undef AT_STAGE
#pragma unroll
    for (int m = 0; m < 2; ++m) {
        float l = lrow[m]; l += __shfl_xor(l, 16); l += __shfl_xor(l, 32);
        const int t = ubase + 16 * m + fr - 240;
        if (t >= 0) { const float il = 1.0f / l; bf16* op = y0 + (size_t)row_of(b, t) * DM + LRU_W + 128 * h + 4 * fq;
#pragma unroll
            for (int dt = 0; dt < 8; ++dt) { v2u o; o.x = pk2(O[m][dt][0] * il, O[m][dt][1] * il); o.y = pk2(O[m][dt][2] * il, O[m][dt][3] * il); *(GAS v2u*)(op + 16 * dt) = o; } }
    }
}

__device__ __forceinline__ int p2_fetch(Frame& F, gu32* qctr) {
    if (F.tid == 0) F.MISC[0] = __hip_atomic_fetch_add(qctr, 1u, RLX_AGENT);
    __syncthreads();
    const int item = (int)F.MISC[0];
    __syncthreads();
    return item;
}
__device__ __forceinline__ void p2_mixer0(Frame& F, const Args& A, int rep) {
    gu32* qctr = (gu32*)(F.ws + WS_CTL) + CW_Q2 + 64 * rep;
    constexpr int N_LRU = NB * 16, N_ATT = NB * FOX_H * 17;
    constexpr int RB = (N_ATT / 3) < (N_CONV / 2) ? (N_ATT / 3) : (N_CONV / 2), REM_ATT = N_ATT - 3 * RB, REM_CONV = N_CONV - 2 * RB;
    int item = p2_fetch(F, qctr);
    while (item < N_LRU) { lru_item(F, A, item >> 4, item & 15); item = p2_fetch(F, qctr); }
    while (item < N_LRU + N_ATT + N_CONV) {
        const int y = item - N_LRU; int att = -1, cv = -1;
        if (y < 5 * RB) { const int blk = y / 5, sl = y - 5 * blk; if (sl == 1 || sl == 3) cv = 2 * blk + (sl >> 1); else att = 3 * blk + (sl >> 1); }
        else { const int y2 = y - 5 * RB; if (y2 < REM_ATT) att = 3 * RB + y2; else cv = 2 * RB + (y2 - REM_ATT); }
        if (rep != 0) cv = -2;
        Frame G = F; { int tz = F.tid; asm volatile("" : "+v"(tz)); G.tid = tz; G.lane = tz & 63; G.wave = __builtin_amdgcn_readfirstlane(tz >> 6); }
        if (att >= 0) { const int j = 16 - att / 64, bh = att % 64; attn_item(G, A, bh >> 4, bh & 15, j); }
        else if (cv >= 0) { const ConvPtrs CP{A.in[20], A.in[21], A.in[22], A.in[16], A.in[18], A.in[19], A.in[15]}; conv_item(G.ws, G.lds, CP, cv, G.wave, G.lane); }
        item = p2_fetch(F, qctr);
    }
}

constexpr int RT_SQ = 528, RT_SV = 272, RT_SS_STRIDE = 144;
constexpr int RT_QS = 0, RT_KN = 33792, RT_VN = 67584, RT_VS = 84992, RT_SS = 102400;
static_assert(RT_KN == 64 * RT_SQ && RT_VN == RT_KN + 64 * RT_SQ && RT_VS == RT_VN + 64 * RT_SV && RT_SS == RT_VS + 64 * RT_SV && RT_SS + 64 * RT_SS_STRIDE <= MISC_OFF, "retention LDS map");
__device__ __forceinline__ int ret_row(int b, int c, int idx) { return c == 0 ? (idx < 48 ? -1 : MMETA + NMETA * b + (idx - 48)) : b * SEQ + 64 * (c - 1) + idx; }
__device__ __forceinline__ void ret_item(Frame& F, const Args& A, int b, int h, int es, bool accum) {
    const bf16* z1 = (const bf16*)(F.ws + WS_Z); bf16* ob = (bf16*)(F.ws + WS_Y1); float* ssqo = (float*)(F.ws + WS_SSQO);
    const int tid = F.tid, lane = F.lane, w = F.wave, fr = lane & 15, fq = lane >> 4;
    LAS unsigned char* lds = F.lds;
    const float lg = log1pf(-exp2f(-5.0f - (float)h)) * 1.4426950408889634f;
    const float cdec = __builtin_amdgcn_exp2f(lg * 64.0f);
    f32x4 Sacc[16];
#pragma unroll
    for (int dt = 0; dt < 16; ++dt) Sacc[dt] = (f32x4){0.f, 0.f, 0.f, 0.f};
    const int qrow = tid >> 5, qd = (tid & 31) * 8;
    const int vrow = tid >> 4, ve = (tid & 15) * 8;
    const float kd0 = __builtin_amdgcn_exp2f(lg * (float)(63 - vrow)), kd1 = __builtin_amdgcn_exp2f(lg * (float)(31 - vrow));
    const unsigned lbase = (unsigned)(size_t)lds;
    const unsigned trq = (unsigned)((lane & 15) >> 2), trp = (unsigned)(lane & 3);
    const unsigned kbase = lbase + RT_KN + (8u * fq + trq) * RT_SQ + 8u * trp;
    const unsigned vbase = lbase + RT_VN + (8u * fq + trq) * RT_SV + 32u * w + 8u * trp;
    const unsigned vsbase = vbase + (RT_VS - RT_VN);
    v4u qreg[4], kreg[4], vreg[2];
    const size_t qcol = (size_t)h * RET_QK + qd, kcol = 4096 + (size_t)h * RET_QK + qd, vcol = 8192 + (size_t)h * RET_V + 128 * es + ve;
#define RT_PREFETCH(c) do { \
        _Pragma("unroll") for (int k = 0; k < 4; ++k) { const int r = ret_row(b, (c), qrow + 16 * k); \
            if (r >= 0) { qreg[k] = *(const GAS v4u*)(z1 + (size_t)r * RET_IN + qcol); kreg[k] = *(const GAS v4u*)(z1 + (size_t)r * RET_IN + kcol); } \
            else { qreg[k] = (v4u){0u, 0u, 0u, 0u}; kreg[k] = (v4u){0u, 0u, 0u, 0u}; } } \
        _Pragma("unroll") for (int k = 0; k < 2; ++k) { const int r = ret_row(b, (c), vrow + 32 * k); \
            if (r >= 0) vreg[k] = *(const GAS v4u*)(z1 + (size_t)r * RET_IN + vcol); else vreg[k] = (v4u){0u, 0u, 0u, 0u}; } } while (0)
    RT_PREFETCH(0);
    for (int c = 0; c < 65; ++c) {
        __syncthreads();
#pragma unroll
        for (int k = 0; k < 4; ++k) { const int m = qrow + 16 * k;
            *(LAS v4u*)(lds + RT_QS + m * RT_SQ + qd * 2) = qreg[k];
            *(LAS v4u*)(lds + RT_KN + m * RT_SQ + qd * 2) = kreg[k]; }
#pragma unroll
        for (int k = 0; k < 2; ++k) { const int m = vrow + 32 * k; float vf8[8]; unpack8(vreg[k], vf8); const float kd = k == 0 ? kd0 : kd1;
            *(LAS v4u*)(lds + RT_VN + m * RT_SV + ve * 2) = vreg[k];
#pragma unroll
            for (int e = 0; e < 8; ++e) vf8[e] *= kd;
            *(LAS v4u*)(lds + RT_VS + m * RT_SV + ve * 2) = pack8f(vf8); }
        __syncthreads();
        if (c < 64) RT_PREFETCH(c + 1);
        { const int it = w >> 1, mt0 = 2 * (w & 1);
          f32x4 sacc[2] = {(f32x4){0.f, 0.f, 0.f, 0.f}, (f32x4){0.f, 0.f, 0.f, 0.f}};
#pragma unroll
          for (int ks = 0; ks < 8; ++ks) { const bf16x8 a = *(const LAS bf16x8*)(lds + RT_QS + (16 * it + fr) * RT_SQ + (32 * ks + 8 * fq) * 2);
#pragma unroll
              for (int q = 0; q < 2; ++q) { const bf16x8 kb = *(const LAS bf16x8*)(lds + RT_KN + (16 * (mt0 + q) + fr) * RT_SQ + (32 * ks + 8 * fq) * 2); sacc[q] = mfma16(a, kb, sacc[q]); } }
#pragma unroll
          for (int q = 0; q < 2; ++q)
#pragma unroll
              for (int g = 0; g < 4; ++g) { const int i = 16 * it + 4 * fq + g, m = 16 * (mt0 + q) + fr; const int dd = i > m ? i - m : m - i;
                  const float sv = sacc[q][g] * __builtin_amdgcn_exp2f(lg * (float)dd);
                  *(LAS unsigned short*)(lds + RT_SS + i * RT_SS_STRIDE + m * 2) = (unsigned short)(pk2(sv, 0.f) & 0xffffu); } }
        __syncthreads();
        f32x4 acc[4];
#pragma unroll
        for (int mi = 0; mi < 4; ++mi) acc[mi] = (f32x4){0.f, 0.f, 0.f, 0.f};
#pragma unroll
        for (int kk = 0; kk < 8; ++kk) {
            v4u bw; bw.x = pk2(Sacc[2 * kk][0], Sacc[2 * kk][1]); bw.y = pk2(Sacc[2 * kk][2], Sacc[2 * kk][3]); bw.z = pk2(Sacc[2 * kk + 1][0], Sacc[2 * kk + 1][1]); bw.w = pk2(Sacc[2 * kk + 1][2], Sacc[2 * kk + 1][3]);
            const bf16x8 bfrag = __builtin_bit_cast(bf16x8, bw);
#pragma unroll
            for (int mi = 0; mi < 4; ++mi) { const LAS unsigned char* qp = lds + RT_QS + (16 * mi + fr) * RT_SQ + (32 * kk + 4 * fq) * 2;
                const v2u lo = *(const LAS v2u*)(qp), hi = *(const LAS v2u*)(qp + 32);
                v4u aw; aw.x = lo.x; aw.y = lo.y; aw.z = hi.x; aw.w = hi.y;
                acc[mi] = mfma16(__builtin_bit_cast(bf16x8, aw), bfrag, acc[mi]); } }
#pragma unroll
        for (int mi = 0; mi < 4; ++mi)
#pragma unroll
            for (int g = 0; g < 4; ++g) acc[mi][g] *= __builtin_amdgcn_exp2f(lg * (float)(16 * mi + 4 * fq + g + 1));
        v2u vp[8];
        asm volatile("ds_read_b64_tr_b16 %0, %4 offset:0 \n\tds_read_b64_tr_b16 %1, %4 offset:1088 \n\tds_read_b64_tr_b16 %2, %4 offset:8704 \n\tds_read_b64_tr_b16 %3, %4 offset:9792 \n\ts_waitcnt lgkmcnt(0)" : "=&v"(vp[0]), "=&v"(vp[1]), "=&v"(vp[2]), "=&v"(vp[3]) : "v"(vbase) : "memory");
        asm volatile("ds_read_b64_tr_b16 %0, %4 offset:0 \n\tds_read_b64_tr_b16 %1, %4 offset:1088 \n\tds_read_b64_tr_b16 %2, %4 offset:8704 \n\tds_read_b64_tr_b16 %3, %4 offset:9792 \n\ts_waitcnt lgkmcnt(0)" : "=&v"(vp[4]), "=&v"(vp[5]), "=&v"(vp[6]), "=&v"(vp[7]) : "v"(vsbase) : "memory");
        bf16x8 vf[2], vs[2];
        { v4u t0; t0.x = vp[0].x; t0.y = vp[0].y; t0.z = vp[1].x; t0.w = vp[1].y; vf[0] = __builtin_bit_cast(bf16x8, t0); v4u t1; t1.x = vp[4].x; t1.y = vp[4].y; t1.z = vp[5].x; t1.w = vp[5].y; vs[0] = __builtin_bit_cast(bf16x8, t1); }
        { v4u t0; t0.x = vp[2].x; t0.y = vp[2].y; t0.z = vp[3].x; t0.w = vp[3].y; vf[1] = __builtin_bit_cast(bf16x8, t0); v4u t1; t1.x = vp[6].x; t1.y = vp[6].y; t1.z = vp[7].x; t1.w = vp[7].y; vs[1] = __builtin_bit_cast(bf16x8, t1); }
#pragma unroll
        for (int mi = 0; mi < 4; ++mi)
#pragma unroll
            for (int k2 = 0; k2 < 2; ++k2) { const bf16x8 a = *(const LAS bf16x8*)(lds + RT_SS + (16 * mi + fr) * RT_SS_STRIDE + (32 * k2 + 8 * fq) * 2); acc[mi] = mfma16(a, vf[k2], acc[mi]); }
        if (c > 0) {
#pragma unroll
            for (int mi = 0; mi < 4; ++mi)
#pragma unroll
                for (int g = 0; g < 4; ++g) { const int r = b * SEQ + 64 * (c - 1) + 16 * mi + 4 * fq + g; const float v = acc[mi][g];
                    ob[(size_t)r * RET_VW + h * RET_V + 128 * es + 16 * w + fr] = (bf16)(pk2(v, 0.f) & 0xffffu);
                    float sq = v * v; sq += __shfl_xor(sq, 1); sq += __shfl_xor(sq, 2); sq += __shfl_xor(sq, 4); sq += __shfl_xor(sq, 8);
                    if (fr == 0 && accum) atomicAdd(ssqo + (size_t)r * 16 + h, sq); }
        }
#pragma unroll
        for (int dt = 0; dt < 16; ++dt) Sacc[dt] *= cdec;
        { v2u kp[16]; asm volatile("ds_read_b64_tr_b16 %0, %16 offset:0 \n\tds_read_b64_tr_b16 %1, %16 offset:2112 \n\tds_read_b64_tr_b16 %2, %16 offset:16896 \n\tds_read_b64_tr_b16 %3, %16 offset:19008 \n\tds_read_b64_tr_b16 %4, %16 offset:32 \n\tds_read_b64_tr_b16 %5, %16 offset:2144 \n\tds_read_b64_tr_b16 %6, %16 offset:16928 \n\tds_read_b64_tr_b16 %7, %16 offset:19040 \n\tds_read_b64_tr_b16 %8, %16 offset:64 \n\tds_read_b64_tr_b16 %9, %16 offset:2176 \n\tds_read_b64_tr_b16 %10, %16 offset:16960 \n\tds_read_b64_tr_b16 %11, %16 offset:19072 \n\tds_read_b64_tr_b16 %12, %16 offset:96 \n\tds_read_b64_tr_b16 %13, %16 offset:2208 \n\tds_read_b64_tr_b16 %14, %16 offset:16992 \n\tds_read_b64_tr_b16 %15, %16 offset:19104 \n\ts_waitcnt lgkmcnt(0)" : "=&v"(kp[0]), "=&v"(kp[1]), "=&v"(kp[2]), "=&v"(kp[3]), "=&v"(kp[4]), "=&v"(kp[5]), "=&v"(kp[6]), "=&v"(kp[7]), "=&v"(kp[8]), "=&v"(kp[9]), "=&v"(kp[10]), "=&v"(kp[11]), "=&v"(kp[12]), "=&v"(kp[13]), "=&v"(kp[14]), "=&v"(kp[15]) : "v"(kbase) : "memory");
          { v4u aw; aw.x = kp[0].x; aw.y = kp[0].y; aw.z = kp[1].x; aw.w = kp[1].y; Sacc[0] = mfma16(__builtin_bit_cast(bf16x8, aw), vs[0], Sacc[0]); }
          { v4u aw; aw.x = kp[2].x; aw.y = kp[2].y; aw.z = kp[3].x; aw.w = kp[3].y; Sacc[0] = mfma16(__builtin_bit_cast(bf16x8, aw), vs[1], Sacc[0]); }
          { v4u aw; aw.x = kp[4].x; aw.y = kp[4].y; aw.z = kp[5].x; aw.w = kp[5].y; Sacc[1] = mfma16(__builtin_bit_cast(bf16x8, aw), vs[0], Sacc[1]); }
          { v4u aw; aw.x = kp[6].x; aw.y = kp[6].y; aw.z = kp[7].x; aw.w = kp[7].y; Sacc[1] = mfma16(__builtin_bit_cast(bf16x8, aw), vs[1], Sacc[1]); }
          { v4u aw; aw.x = kp[8].x; aw.y = kp[8].y; aw.z = kp[9].x; aw.w = kp[9].y; Sacc[2] = mfma16(__builtin_bit_cast(bf16x8, aw), vs[0], Sacc[2]); }
          { v4u aw; aw.x = kp[10].x; aw.y = kp[10].y; aw.z = kp[11].x; aw.w = kp[11].y; Sacc[2] = mfma16(__builtin_bit_cast(bf16x8, aw), vs[1], Sacc[2]); }
          { v4u aw; aw.x = kp[12].x; aw.y = kp[12].y; aw.z = kp[13].x; aw.w = kp[13].y; Sacc[3] = mfma16(__builtin_bit_cast(bf16x8, aw), vs[0], Sacc[3]); }
          { v4u aw; aw.x = kp[14].x; aw.y = kp[14].y; aw.z = kp[15].x; aw.w = kp[15].y; Sacc[3] = mfma16(__builtin_bit_cast(bf16x8, aw), vs[1], Sacc[3]); }
        }
        { v2u kp[16]; asm volatile("ds_read_b64_tr_b16 %0, %16 offset:128 \n\tds_read_b64_tr_b16 %1, %16 offset:2240 \n\tds_read_b64_tr_b16 %2, %16 offset:17024 \n\tds_read_b64_tr_b16 %3, %16 offset:19136 \n\tds_read_b64_tr_b16 %4, %16 offset:160 \n\tds_read_b64_tr_b16 %5, %16 offset:2272 \n\tds_read_b64_tr_b16 %6, %16 offset:17056 \n\tds_read_b64_tr_b16 %7, %16 offset:19168 \n\tds_read_b64_tr_b16 %8, %16 offset:192 \n\tds_read_b64_tr_b16 %9, %16 offset:2304 \n\tds_read_b64_tr_b16 %10, %16 offset:17088 \n\tds_read_b64_tr_b16 %11, %16 offset:19200 \n\tds_read_b64_tr_b16 %12, %16 offset:224 \n\tds_read_b64_tr_b16 %13, %16 offset:2336 \n\tds_read_b64_tr_b16 %14, %16 offset:17120 \n\tds_read_b64_tr_b16 %15, %16 offset:19232 \n\ts_waitcnt lgkmcnt(0)" : "=&v"(kp[0]), "=&v"(kp[1]), "=&v"(kp[2]), "=&v"(kp[3]), "=&v"(kp[4]), "=&v"(kp[5]), "=&v"(kp[6]), "=&v"(kp[7]), "=&v"(kp[8]), "=&v"(kp[9]), "=&v"(kp[10]), "=&v"(kp[11]), "=&v"(kp[12]), "=&v"(kp[13]), "=&v"(kp[14]), "=&v"(kp[15]) : "v"(kbase) : "memory");
          { v4u aw; aw.x = kp[0].x; aw.y = kp[0].y; aw.z = kp[1].x; aw.w = kp[1].y; Sacc[4] = mfma16(__builtin_bit_cast(bf16x8, aw), vs[0], Sacc[4]); }
          { v4u aw; aw.x = kp[2].x; aw.y = kp[2].y; aw.z = kp[3].x; aw.w = kp[3].y; Sacc[4] = mfma16(__builtin_bit_cast(bf16x8, aw), vs[1], Sacc[4]); }
          { v4u aw; aw.x = kp[4].x; aw.y = kp[4].y; aw.z = kp[5].x; aw.w = kp[5].y; Sacc[5] = mfma16(__builtin_bit_cast(bf16x8, aw), vs[0], Sacc[5]); }
          { v4u aw; aw.x = kp[6].x; aw.y = kp[6].y; aw.z = kp[7].x; aw.w = kp[7].y; Sacc[5] = mfma16(__builtin_bit_cast(bf16x8, aw), vs[1], Sacc[5]); }
          { v4u aw; aw.x = kp[8].x; aw.y = kp[8].y; aw.z = kp[9].x; aw.w = kp[9].y; Sacc[6] = mfma16(__builtin_bit_cast(bf16x8, aw), vs[0], Sacc[6]); }
          { v4u aw; aw.x = kp[10].x; aw.y = kp[10].y; aw.z = kp[11].x; aw.w = kp[11].y; Sacc[6] = mfma16(__builtin_bit_cast(bf16x8, aw), vs[1], Sacc[6]); }
          { v4u aw; aw.x = kp[12].x; aw.y = kp[12].y; aw.z = kp[13].x; aw.w = kp[13].y; Sacc[7] = mfma16(__builtin_bit_cast(bf16x8, aw), vs[0], Sacc[7]); }
          { v4u aw; aw.x = kp[14].x; aw.y = kp[14].y; aw.z = kp[15].x; aw.w = kp[15].y; Sacc[7] = mfma16(__builtin_bit_cast(bf16x8, aw), vs[1], Sacc[7]); }
        }
        { v2u kp[16]; asm volatile("ds_read_b64_tr_b16 %0, %16 offset:256 \n\tds_read_b64_tr_b16 %1, %16 offset:2368 \n\tds_read_b64_tr_b16 %2, %16 offset:17152 \n\tds_read_b64_tr_b16 %3, %16 offset:19264 \n\tds_read_b64_tr_b16 %4, %16 offset:288 \n\tds_read_b64_tr_b16 %5, %16 offset:2400 \n\tds_read_b64_tr_b16 %6, %16 offset:17184 \n\tds_read_b64_tr_b16 %7, %16 offset:19296 \n\tds_read_b64_tr_b16 %8, %16 offset:320 \n\tds_read_b64_tr_b16 %9, %16 offset:2432 \n\tds_read_b64_tr_b16 %10, %16 offset:17216 \n\tds_read_b64_tr_b16 %11, %16 offset:19328 \n\tds_read_b64_tr_b16 %12, %16 offset:352 \n\tds_read_b64_tr_b16 %13, %16 offset:2464 \n\tds_read_b64_tr_b16 %14, %16 offset:17248 \n\tds_read_b64_tr_b16 %15, %16 offset:19360 \n\ts_waitcnt lgkmcnt(0)" : "=&v"(kp[0]), "=&v"(kp[1]), "=&v"(kp[2]), "=&v"(kp[3]), "=&v"(kp[4]), "=&v"(kp[5]), "=&v"(kp[6]), "=&v"(kp[7]), "=&v"(kp[8]), "=&v"(kp[9]), "=&v"(kp[10]), "=&v"(kp[11]), "=&v"(kp[12]), "=&v"(kp[13]), "=&v"(kp[14]), "=&v"(kp[15]) : "v"(kbase) : "memory");
          { v4u aw; aw.x = kp[0].x; aw.y = kp[0].y; aw.z = kp[1].x; aw.w = kp[1].y; Sacc[8] = mfma16(__builtin_bit_cast(bf16x8, aw), vs[0], Sacc[8]); }
          { v4u aw; aw.x = kp[2].x; aw.y = kp[2].y; aw.z = kp[3].x; aw.w = kp[3].y; Sacc[8] = mfma16(__builtin_bit_cast(bf16x8, aw), vs[1], Sacc[8]); }
          { v4u aw; aw.x = kp[4].x; aw.y = kp[4].y; aw.z = kp[5].x; aw.w = kp[5].y; Sacc[9] = mfma16(__builtin_bit_cast(bf16x8, aw), vs[0], Sacc[9]); }
          { v4u aw; aw.x = kp[6].x; aw.y = kp[6].y; aw.z = kp[7].x; aw.w = kp[7].y; Sacc[9] = mfma16(__builtin_bit_cast(bf16x8, aw), vs[1], Sacc[9]); }
          { v4u aw; aw.x = kp[8].x; aw.y = kp[8].y; aw.z = kp[9].x; aw.w = kp[9].y; Sacc[10] = mfma16(__builtin_bit_cast(bf16x8, aw), vs[0], Sacc[10]); }
          { v4u aw; aw.x = kp[10].x; aw.y = kp[10].y; aw.z = kp[11].x; aw.w = kp[11].y; Sacc[10] = mfma16(__builtin_bit_cast(bf16x8, aw), vs[1], Sacc[10]); }
          { v4u aw; aw.x = kp[12].x; aw.y = kp[12].y; aw.z = kp[13].x; aw.w = kp[13].y; Sacc[11] = mfma16(__builtin_bit_cast(bf16x8, aw), vs[0], Sacc[11]); }
          { v4u aw; aw.x = kp[14].x; aw.y = kp[14].y; aw.z = kp[15].x; aw.w = kp[15].y; Sacc[11] = mfma16(__builtin_bit_cast(bf16x8, aw), vs[1], Sacc[11]); }
        }
        { v2u kp[16]; asm volatile("ds_read_b64_tr_b16 %0, %16 offset:384 \n\tds_read_b64_tr_b16 %1, %16 offset:2496 \n\tds_read_b64_tr_b16 %2, %16 offset:17280 \n\tds_read_b64_tr_b16 %3, %16 offset:19392 \n\tds_read_b64_tr_b16 %4, %16 offset:416 \n\tds_read_b64_tr_b16 %5, %16 offset:2528 \n\tds_read_b64_tr_b16 %6, %16 offset:17312 \n\tds_read_b64_tr_b16 %7, %16 offset:19424 \n\tds_read_b64_tr_b16 %8, %16 offset:448 \n\tds_read_b64_tr_b16 %9, %16 offset:2560 \n\tds_read_b64_tr_b16 %10, %16 offset:17344 \n\tds_read_b64_tr_b16 %11, %16 offset:19456 \n\tds_read_b64_tr_b16 %12, %16 offset:480 \n\tds_read_b64_tr_b16 %13, %16 offset:2592 \n\tds_read_b64_tr_b16 %14, %16 offset:17376 \n\tds_read_b64_tr_b16 %15, %16 offset:19488 \n\ts_waitcnt lgkmcnt(0)" : "=&v"(kp[0]), "=&v"(kp[1]), "=&v"(kp[2]), "=&v"(kp[3]), "=&v"(kp[4]), "=&v"(kp[5]), "=&v"(kp[6]), "=&v"(kp[7]), "=&v"(kp[8]), "=&v"(kp[9]), "=&v"(kp[10]), "=&v"(kp[11]), "=&v"(kp[12]), "=&v"(kp[13]), "=&v"(kp[14]), "=&v"(kp[15]) : "v"(kbase) : "memory");
          { v4u aw; aw.x = kp[0].x; aw.y = kp[0].y; aw.z = kp[1].x; aw.w = kp[1].y; Sacc[12] = mfma16(__builtin_bit_cast(bf16x8, aw), vs[0], Sacc[12]); }
          { v4u aw; aw.x = kp[2].x; aw.y = kp[2].y; aw.z = kp[3].x; aw.w = kp[3].y; Sacc[12] = mfma16(__builtin_bit_cast(bf16x8, aw), vs[1], Sacc[12]); }
          { v4u aw; aw.x = kp[4].x; aw.y = kp[4].y; aw.z = kp[5].x; aw.w = kp[5].y; Sacc[13] = mfma16(__builtin_bit_cast(bf16x8, aw), vs[0], Sacc[13]); }
          { v4u aw; aw.x = kp[6].x; aw.y = kp[6].y; aw.z = kp[7].x; aw.w = kp[7].y; Sacc[13] = mfma16(__builtin_bit_cast(bf16x8, aw), vs[1], Sacc[13]); }
          { v4u aw; aw.x = kp[8].x; aw.y = kp[8].y; aw.z = kp[9].x; aw.w = kp[9].y; Sacc[14] = mfma16(__builtin_bit_cast(bf16x8, aw), vs[0], Sacc[14]); }
          { v4u aw; aw.x = kp[10].x; aw.y = kp[10].y; aw.z = kp[11].x; aw.w = kp[11].y; Sacc[14] = mfma16(__builtin_bit_cast(bf16x8, aw), vs[1], Sacc[14]); }
          { v4u aw; aw.x = kp[12].x; aw.y = kp[12].y; aw.z = kp[13].x; aw.w = kp[13].y; Sacc[15] = mfma16(__builtin_bit_cast(bf16x8, aw), vs[0], Sacc[15]); }
          { v4u aw; aw.x = kp[14].x; aw.y = kp[14].y; aw.z = kp[15].x; aw.w = kp[15].y; Sacc[15] = mfma16(__builtin_bit_cast(bf16x8, aw), vs[1], Sacc[15]); }
        }
    }
#undef RT_PREFETCH
    __syncthreads();
}
__device__ __forceinline__ void p7_retention(Frame& F, const Args& A, bool accum) {
    for (int item = blockIdx.x; item < NB * RET_H * 4; item += F.G) ret_item(F, A, item >> 6, (item >> 2) & 15, item & 3, accum);
}
__device__ __forceinline__ void p8_gate(Frame& F, const Args& A) {
    const bf16* z1 = (const bf16*)(F.ws + WS_Z); bf16* ob = (bf16*)(F.ws + WS_Y1); const float* ssqo = (const float*)(F.ws + WS_SSQO); const float* gain = A.in[17];
    const int gt = blockIdx.x * NTHREADS + F.tid, nthr = F.G * NTHREADS;
    const int c = (gt & 1023) * 8, hd = c >> 9, rstep = nthr >> 10, r0 = (gt >> 10) < rstep ? (gt >> 10) : MTOK;
    const f32x4 g0 = *(const GAS f32x4*)(gain + c), g1 = *(const GAS f32x4*)(gain + c + 4);
    for (int r = r0; r < MTOK; r += 4 * rstep) {
        v4u gw[4], ow[4]; float ss[4];
#pragma unroll
        for (int k = 0; k < 4; ++k) { const int rr = r + k * rstep; if (rr < MTOK) { gw[k] = *(const GAS v4u*)(z1 + (size_t)rr * RET_IN + 16384 + c); ow[k] = *(const GAS v4u*)(ob + (size_t)rr * RET_VW + c); ss[k] = ssqo[(size_t)rr * 16 + hd]; } }
#pragma unroll
        for (int k = 0; k < 4; ++k) { const int rr = r + k * rstep; if (rr < MTOK) {
            const float rs = 1.0f / sqrtf(ss[k] * (1.0f / 512.0f) + RMS_EPS);
            float gf[8], of[8], y[8]; unpack8(gw[k], gf); unpack8(ow[k], of);
#pragma unroll
            for (int e = 0; e < 8; ++e) { const float gn = e < 4 ? g0[e] : g1[e - 4]; y[e] = gf[e] * sigmoidf_fast(gf[e]) * (of[e] * rs * gn); }
            *(GAS v4u*)(ob + (size_t)rr * RET_VW + c) = pack8f(y); } }
    }
}


__device__ __forceinline__ void meta_fixup(Frame& F, const float* Hmeta, bf16* XB, float* ssq, const float* gain) {
    __syncthreads();
    if (F.MISC[4] != 0u) {
        __builtin_amdgcn_fence(__ATOMIC_ACQUIRE, "agent"); asm volatile("s_waitcnt vmcnt(0)" ::: "memory");
        for (int row = F.wave; row < NB * NMETA; row += NWAVES) { const float* hrow = Hmeta + (size_t)row * DM; bf16* xrow = XB + (size_t)(MTOK + row) * DM; float s = 0.f;
#pragma unroll 4
            for (int j = 0; j < 16; ++j) { const int e = (F.lane + 64 * j) * 4; const f32x4 v = *(const GAS f32x4*)(hrow + e);
                s += (v.x * v.x + v.y * v.y) + (v.z * v.z + v.w * v.w); const f32x4 gn = *(const GAS f32x4*)(gain + e); v2u w; w.x = pk2(v.x * gn.x, v.y * gn.y); w.y = pk2(v.z * gn.z, v.w * gn.w); *(GAS v2u*)(xrow + e) = w; }
            s = wave_sum(s);
            if (F.lane == 0) ssq[MTOK + row] = s; }
        __syncthreads();
        if (F.tid == 0) F.MISC[4] = 0u;
    }
    __syncthreads();
}

__global__ void __launch_bounds__(NTHREADS, 2) hybrid_fwd(Args args) {
    extern __shared__ __attribute__((aligned(16))) unsigned char lds_raw[];
    Frame F;
    F.lds = (LAS unsigned char*)lds_raw;
    F.MISC = (volatile LAS unsigned*)(F.lds + MISC_OFF);
    F.tid = threadIdx.x; F.lane = F.tid & 63; F.wave = __builtin_amdgcn_readfirstlane(F.tid >> 6);
    F.G = gridDim.x; F.ws = args.ws;
    if (F.tid < 64) F.MISC[F.tid] = 0u;
    __syncthreads();
    unsigned* ctl = (unsigned*)(F.ws + WS_CTL);
#if !MK_PER_PHASE
    const XcdBarrier bar = xcd_barrier_post(ctl + CW_BAR, F.MISC + 8);
#define GRID_BAR() xcd_barrier(bar)
#else
#define GRID_BAR() do { } while (0)
#endif
    const int lo = args.ph_lo, hi = args.ph_hi;
#ifndef PHASE_MASK
#define PHASE_MASK 0xFFF
#endif
#define IN(k) ((((PHASE_MASK) >> (k)) & 1) && lo <= (k) && (k) < hi)
#define BOTH(k) (IN(k) && IN((k) + 1))
#ifndef REPEAT_MASK
#define REPEAT_MASK 0
#endif
#define REPS(k) (1 + (((REPEAT_MASK) >> (k)) & 1))
    unsigned char* ws = F.ws;
    bf16* XB = (bf16*)(ws + WS_XB); float* Htok = args.out; float* Hmeta = (float*)(ws + WS_HMETA); bf16* Z = (bf16*)(ws + WS_Z); bf16* Y0 = (bf16*)(ws + WS_Y0); bf16* Y1 = (bf16*)(ws + WS_Y1);
    float* SSQ0 = (float*)(ws + WS_SSQ0); float* SSQ1 = (float*)(ws + WS_SSQ1); float* SSQ2 = (float*)(ws + WS_SSQ2); float* SSQ3 = (float*)(ws + WS_SSQ3);
    const int c = (int)blockIdx.x;

    if (IN(0)) { p0_prologue(F, args); if (REPS(0) > 1) p0_prologue(F, args); if (BOTH(0)) GRID_BAR(); }
    if (IN(1)) {
        pg8::Gemm g{XB, (const bf16*)(ws + WS_WIN0), MP, 41 * 256, DM}; pg8::StaticOrder S; S.init(MP, 41 * 256, DM, F.G, c);
        pg8::EpiIn0 E{Z, (float*)(ws + WS_FBUF), SSQ0};
        pg8::gemm_phase<pg8::EpiIn0, pg8::StaticOrder, true, true>(F.lds, g, S, E); if (REPS(1) > 1) { pg8::gemm_phase<pg8::EpiIn0, pg8::StaticOrder, true, true>(F.lds, g, S, E); }
        if (BOTH(1)) GRID_BAR();
    }
    if (IN(2)) { p2_mixer0(F, args, 0); if (REPS(2) > 1) { GRID_BAR(); p2_mixer0(F, args, 1); } if (BOTH(2)) GRID_BAR(); }
    if (IN(3)) {
        pg8::Gemm g{Y0, (const bf16*)(ws + WS_WOUT0), MP, DM, DM}; pg8::SplitMetaOrder S; S.init2(DM, DM, F.G, c, ctl + CW_TK3, F.MISC + 4);
        pg8::EpiRes E{Htok, Hmeta, XB, SSQ1, DM / 64, args.in[19]};
        pg8::gemm_phase<pg8::EpiRes, pg8::SplitMetaOrder, true, true>(F.lds, g, S, E);
        meta_fixup(F, Hmeta, XB, SSQ1, args.in[19]);
        if (BOTH(3)) GRID_BAR();
    }
    if (IN(4)) {
        pg8::Gemm g{XB, (const bf16*)(ws + WS_WGU0), MP, 2 * DFF, DM}; pg8::StaticOrder S; S.init(MP, 2 * DFF, DM, F.G, c);
        pg8::EpiGU E{Z, SSQ1};
        pg8::gemm_phase<pg8::EpiGU, pg8::StaticOrder, true, true>(F.lds, g, S, E); if (REPS(4) > 1) { pg8::gemm_phase<pg8::EpiGU, pg8::StaticOrder, true, true>(F.lds, g, S, E); }
        if (BOTH(4)) GRID_BAR();
    }
    if (IN(5)) {
        pg8::Gemm g{Z, (const bf16*)(ws + WS_WD0), MP, DM, DFF}; pg8::SplitMetaOrder S; S.init2(DM, DFF, F.G, c, ctl + CW_TK5, F.MISC + 4);
        pg8::EpiRes E{Htok, Hmeta, XB, SSQ2, DFF / 64, args.in[15]};
        pg8::gemm_phase<pg8::EpiRes, pg8::SplitMetaOrder, true, true>(F.lds, g, S, E);
        meta_fixup(F, Hmeta, XB, SSQ2, args.in[15]);
        if (BOTH(5)) GRID_BAR();
    }
    if (IN(6)) {
        pg8::Gemm g{XB, (const bf16*)(ws + WS_WIN1), MP, RET_IN, DM}; pg8::StaticOrder S; S.init(MP, RET_IN, DM, F.G, c);
        pg8::EpiIn1 E{Z, SSQ2};
        pg8::gemm_phase<pg8::EpiIn1, pg8::StaticOrder, true, true>(F.lds, g, S, E); if (REPS(6) > 1) { pg8::gemm_phase<pg8::EpiIn1, pg8::StaticOrder, true, true>(F.lds, g, S, E); }
        if (BOTH(6)) GRID_BAR();
    }
    if (IN(7)) { p7_retention(F, args, true); if (REPS(7) > 1) p7_retention(F, args, false); if (BOTH(7)) GRID_BAR(); }
    if (IN(8)) { p8_gate(F, args); if (BOTH(8)) GRID_BAR(); }
    if (IN(9)) {
        pg8::Gemm g{Y1, (const bf16*)(ws + WS_WOUT1), MTOK, DM, RET_VW}; pg8::StaticOrder S; S.init(MTOK, DM, RET_VW, F.G, c);
        pg8::EpiRes E{Htok, Hmeta, XB, SSQ3, RET_VW / 64, args.in[19] + DM};
        pg8::gemm_phase<pg8::EpiRes, pg8::StaticOrder, true, true>(F.lds, g, S, E);
        if (BOTH(9)) GRID_BAR();
    }
    if (IN(10)) {
        pg8::Gemm g{XB, (const bf16*)(ws + WS_WGU1), MTOK, 2 * DFF, DM}; pg8::StaticOrder S; S.init(MTOK, 2 * DFF, DM, F.G, c);
        pg8::EpiGU E{Z, SSQ3};
        pg8::gemm_phase<pg8::EpiGU, pg8::StaticOrder, true, true>(F.lds, g, S, E); if (REPS(10) > 1) { pg8::gemm_phase<pg8::EpiGU, pg8::StaticOrder, true, true>(F.lds, g, S, E); }
        if (BOTH(10)) GRID_BAR();
    }
    if (IN(11)) {
        pg8::Gemm g{Z, (const bf16*)(ws + WS_WD1), MTOK, DM, DFF}; pg8::StaticOrder S; S.init(MTOK, DM, DFF, F.G, c);
        pg8::EpiFinal E{args.out};
        pg8::gemm_phase<pg8::EpiFinal, pg8::StaticOrder, true, true>(F.lds, g, S, E);
    }
#undef IN
#undef BOTH
}

extern "C" void kernel_launch(void* const* d_in, const int* in_sizes, int n_in, void* d_out, int out_size, void* d_ws, size_t ws_size, hipStream_t stream) {
    static int grid = 0;
    if (grid == 0) {
        if (n_in != 23 || in_sizes[0] != MTOK * DM || out_size != MTOK * DM || ws_size < WS_END) { fprintf(stderr, "kernel_launch: unexpected shapes (n_in %d, in0 %d, out %d, ws %zu < %zu); nothing launched\n", n_in, n_in > 0 ? in_sizes[0] : -1, out_size, ws_size, (size_t)WS_END); grid = -1; return; }
        int dev = 0, cus = 0, per_cu = 0;
        if (hipGetDevice(&dev) != hipSuccess || hipDeviceGetAttribute(&cus, hipDeviceAttributeMultiprocessorCount, dev) != hipSuccess) { fprintf(stderr, "kernel_launch: device query failed\n"); grid = -1; return; }
        if (hipFuncSetAttribute((const void*)hybrid_fwd, hipFuncAttributeMaxDynamicSharedMemorySize, LDS_BYTES) != hipSuccess) { fprintf(stderr, "kernel_launch: hipFuncSetAttribute failed\n"); grid = -1; return; }
        if (hipOccupancyMaxActiveBlocksPerMultiprocessor(&per_cu, (const void*)hybrid_fwd, NTHREADS, LDS_BYTES) != hipSuccess || per_cu < 1) { fprintf(stderr, "kernel_launch: occupancy query reports %d workgroups per CU\n", per_cu); }
        (void)hipGetLastError();
        grid = cus;
    }
    if (grid < 0) return;
    if (hipMemsetAsync((char*)d_ws + WS_CTL, 0, CTL_ZERO_BYTES, stream) != hipSuccess) { fprintf(stderr, "kernel_launch: memset failed\n"); return; }
    Args a{};
    for (int i = 0; i < 23; ++i) a.in[i] = (const float*)d_in[i];
    a.out = (float*)d_out; a.ws = (unsigned char*)d_ws;
#if MK_PER_PHASE
    for (int p = 0; p < NPHASES; ++p) { a.ph_lo = p; a.ph_hi = p + 1; hipLaunchKernelGGL(hybrid_fwd, dim3(grid), dim3(NTHREADS), LDS_BYTES, stream, a); }
#else
    a.ph_lo = 0; a.ph_hi = NPHASES;
    hipLaunchKernelGGL(hybrid_fwd, dim3(grid), dim3(NTHREADS), LDS_BYTES, stream, a);
#endif
    const hipError_t le = hipPeekAtLastError();
    if (le != hipSuccess) fprintf(stderr, "kernel_launch: launch failed: %s\n", hipGetErrorName(le));
}
```

```cpp
#include <hip/hip_runtime.h>
#include <cstdio>
#include <cstdint>
#ifndef MK_PER_PHASE
#define MK_PER_PHASE 0
#endif
constexpr int DM = 4096, NB = 4, SEQ = 4096, NMETA = 16, LSEQ = NMETA + SEQ;
constexpr int MTOK = NB * SEQ;
constexpr int MMETA = MTOK;
constexpr int MP = 65 * 256;
constexpr int LRU_W = 2048, FOX_H = 16, FOX_D = 128, AB_IN = 10256, AB_Z = 10240;
constexpr int RET_H = 16, RET_QK = 256, RET_V = 512, RET_IN = 24576, RET_VW = 8192;
constexpr int DFF = 11008;
constexpr float RMS_EPS = 1e-6f;
namespace pg8 {
#define PG8_LAS __attribute__((address_space(3)))
typedef unsigned short bf16_t;
typedef short bf16x8 __attribute__((ext_vector_type(8)));
typedef float f32x4 __attribute__((ext_vector_type(4)));
typedef unsigned u32x4 __attribute__((ext_vector_type(4)));
constexpr int BM = 256, BK = 64, HALF = 128, HTB = HALF * BK * 2  , STAGE_BYTES = 8 * HTB, NXCD = 8, WGM = 8;

__host__ __device__ __forceinline__ int lds_byte(int r, int c) { const int st = (r >> 4) * 2 + (c >> 5), rr = r & 15, cc = c & 31, ob = rr * 64 + cc * 2; return st * 1024 + (ob ^ (((ob >> 9) & 1) << 5)); }
__host__ __device__ __forceinline__ void stage_rc(int b, int& R, int& C) { const int st = b / 1024, sb = b % 1024, swz = sb ^ (((sb >> 9) & 1) << 5); R = (st >> 1) * 16 + swz / 64; C = (st & 1) * 32 + (swz % 64) / 2; }
__host__ __device__ __forceinline__ int perm32(int rho) { const int n = rho >> 4, i = rho & 15; return 8 * (i >> 2) + 4 * n + (i & 3); }

struct Unit { int pm, pn, kb, kn; };
struct Gemm { const bf16_t* A; const bf16_t* Bt; int M, N, K; };

struct StaticOrder {
    int nM, nN, nwg, G, c, ntk;
    __host__ __device__ void init(int M, int N, int K, int G_, int c_) { nM = M / BM; nN = N / BM; nwg = nM * nN; G = G_; c = c_; ntk = K / BK; }
    __host__ __device__ bool next(int i, Unit& u) const {
        const long L = (long)i * G + c; if (L >= nwg) return false;
        int wgid = (int)L; { const int q = nwg / NXCD, r = nwg % NXCD, xcd = wgid % NXCD, off = wgid / NXCD; wgid = (xcd < r ? xcd * (q + 1) : r * (q + 1) + (xcd - r) * q) + off; }
        const int nig = WGM * nN, gid = wgid / nig, fm = gid * WGM, gsz = (nM - fm) < WGM ? (nM - fm) : WGM;
        u.pm = fm + ((wgid % nig) % gsz); u.pn = (wgid % nig) / gsz; u.kb = 0; u.kn = ntk; return true;
    }
    __device__ __forceinline__ void a_ready(const Unit&) const {}
    __device__ __forceinline__ void done(const Unit&) const {}
};

struct SplitMetaOrder : StaticOrder {
    int nreg, nsplit; unsigned* ticket; volatile PG8_LAS unsigned* flag;
    __device__ void init2(int N, int K, int G_, int c_, unsigned* ticket_, volatile PG8_LAS unsigned* flag_) { init(64 * BM, N, K, G_, c_); nreg = nwg; nsplit = 16; ticket = ticket_; flag = flag_; }
    __device__ bool next(int i, Unit& u) const {
        const long L = (long)i * G + c;
        if (L < nreg) return StaticOrder::next(i, u);
        const int x = (int)(L - nreg); if (x >= nsplit * nN) return false;
        const int s = x % nsplit; u.pm = 64; u.pn = x / nsplit;
        const int base = (ntk / 2) / nsplit, rem = (ntk / 2) % nsplit;
        u.kb = 2 * (s * base + (s < rem ? s : rem)); u.kn = 2 * (base + (s < rem ? 1 : 0)); return true;
    }
    __device__ __forceinline__ void a_ready(const Unit&) const {}
    __device__ __forceinline__ void done(const Unit& u) const {
        if (u.pm == 64) { asm volatile("s_waitcnt vmcnt(0)" ::: "memory");
            if ((threadIdx.x & 63) == 0) { const unsigned old = __hip_atomic_fetch_add(ticket, 1u, __ATOMIC_RELAXED, __HIP_MEMORY_SCOPE_AGENT); if (old + 1u == (unsigned)(nsplit * nN * 8)) flag[0] = 1u; } }
    }
};
__device__ __forceinline__ unsigned cvt_pk_bf16(float lo, float hi) { unsigned r; asm volatile("v_cvt_pk_bf16_f32 %0, %1, %2" : "=v"(r) : "v"(lo), "v"(hi)); return r; }
__device__ __forceinline__ u32x4 pack8(const f32x4 a, const f32x4 b) { u32x4 w; w.x = cvt_pk_bf16(a[0], a[1]); w.y = cvt_pk_bf16(a[2], a[3]); w.z = cvt_pk_bf16(b[0], b[1]); w.w = cvt_pk_bf16(b[2], b[3]); return w; }
__device__ __forceinline__ float row_rstd(const float* ssq, int r) { return 1.0f / sqrtf(ssq[r] * (1.0f / 4096.0f) + RMS_EPS); }

struct EpiIn0 {
    static constexpr bool PERM = true, AFTER_DRAIN = false;
    bf16_t* Z; float* F; const float* ssq;
    __device__ __forceinline__ void operator()(const f32x4 (&acc)[2][2][4][2], const Unit& u, int wr, int wc, int fr, int fq) const {
        const int row0 = u.pm * BM + wr * 64 + fr;
        if (u.pn < 40) {
            const int col0 = u.pn * BM + wc * 32 + 8 * fq;
#pragma unroll
            for (int ai = 0; ai < 2; ++ai)
#pragma unroll
                for (int m = 0; m < 4; ++m) { const int r = row0 + ai * HALF + m * 16; const float rs = row_rstd(ssq, r); bf16_t* rowp = Z + (size_t)r * AB_Z + col0;
#pragma unroll
                    for (int bj = 0; bj < 2; ++bj) *(u32x4*)(rowp + bj * HALF) = pack8(acc[ai][bj][m][0] * rs, acc[ai][bj][m][1] * rs); }
        } else if (wc == 0 && fq < 2) {
#pragma unroll
            for (int ai = 0; ai < 2; ++ai)
#pragma unroll
                for (int m = 0; m < 4; ++m) { const int r = row0 + ai * HALF + m * 16; const float rs = row_rstd(ssq, r); float* fp = F + (size_t)r * 16 + 8 * fq;
                    *(f32x4*)(fp) = acc[ai][0][m][0] * rs; *(f32x4*)(fp + 4) = acc[ai][0][m][1] * rs; }
        }
    }
};
struct EpiRes {
    static constexpr bool PERM = true, AFTER_DRAIN = false;
    const float* Hin; float* Htok; float* Hmeta; bf16_t* XB; float* ssq_out; int K_TILES; const float* gnext;
    __device__ __forceinline__ void operator()(const f32x4 (&acc)[2][2][4][2], const Unit& u, int wr, int wc, int fr, int fq) const {
        const int row0 = u.pm * BM + wr * 64 + fr, col0 = u.pn * BM + wc * 32 + 8 * fq;
        if (u.pm == MTOK / BM && u.kn != K_TILES) {
            if (wr == 0) {
#pragma unroll
                for (int m = 0; m < 4; ++m) { float* hp = Hmeta + (size_t)(m * 16 + fr) * DM + col0;
#pragma unroll
                    for (int bj = 0; bj < 2; ++bj)
#pragma unroll
                        for (int n = 0; n < 2; ++n)
#pragma unroll
                            for (int j = 0; j < 4; ++j) atomicAdd(hp + bj * HALF + 4 * n + j, acc[0][bj][m][n][j]); } }
            return; }
        float* H = u.pm < MTOK / BM ? Htok : Hmeta - (size_t)MTOK * DM;
        const float* HI = u.pm < MTOK / BM ? Hin : Hmeta - (size_t)MTOK * DM;
        f32x4 gn[2][2];
#pragma unroll
        for (int bj = 0; bj < 2; ++bj) { gn[bj][0] = *(const f32x4*)(gnext + col0 + bj * HALF); gn[bj][1] = *(const f32x4*)(gnext + col0 + bj * HALF + 4); }
#pragma unroll
        for (int ai = 0; ai < 2; ++ai)
#pragma unroll
            for (int m = 0; m < 4; ++m) { const int r = row0 + ai * HALF + m * 16; float* hp = H + (size_t)r * DM + col0; const float* hi = HI + (size_t)r * DM + col0; bf16_t* xp = XB + (size_t)r * DM + col0; float s = 0.f;
#pragma unroll
                for (int bj = 0; bj < 2; ++bj) { const f32x4 v0 = *(const f32x4*)(hi + bj * HALF) + acc[ai][bj][m][0], v1 = *(const f32x4*)(hi + bj * HALF + 4) + acc[ai][bj][m][1];
                    *(f32x4*)(hp + bj * HALF) = v0; *(f32x4*)(hp + bj * HALF + 4) = v1; *(u32x4*)(xp + bj * HALF) = pack8(v0 * gn[bj][0], v1 * gn[bj][1]);
                    s += (v0[0] * v0[0] + v0[1] * v0[1]) + (v0[2] * v0[2] + v0[3] * v0[3]) + (v1[0] * v1[0] + v1[1] * v1[1]) + (v1[2] * v1[2] + v1[3] * v1[3]); }
                s += __shfl_xor(s, 16); s += __shfl_xor(s, 32);
                if (fq == 0) atomicAdd(ssq_out + r, s);
                if (m & 1) asm volatile("" ::: "memory"); }
    }
};
struct EpiFinal {
    static constexpr bool PERM = true, AFTER_DRAIN = false;
    float* OUT;
    __device__ __forceinline__ void operator()(const f32x4 (&acc)[2][2][4][2], const Unit& u, int wr, int wc, int fr, int fq) const {
        const int row0 = u.pm * BM + wr * 64 + fr, col0 = u.pn * BM + wc * 32 + 8 * fq;
#pragma unroll
        for (int ai = 0; ai < 2; ++ai)
#pragma unroll
            for (int m = 0; m < 4; ++m) { const int r = row0 + ai * HALF + m * 16; float* op = OUT + (size_t)r * DM + col0; const float* hp = op;
#pragma unroll
                for (int bj = 0; bj < 2; ++bj) { const f32x4 v0 = *(const f32x4*)(hp + bj * HALF) + acc[ai][bj][m][0], v1 = *(const f32x4*)(hp + bj * HALF + 4) + acc[ai][bj][m][1];
                    *(f32x4*)(op + bj * HALF) = v0; *(f32x4*)(op + bj * HALF + 4) = v1; }
                asm volatile("" ::: "memory"); }
    }
};
struct EpiGU {
    static constexpr bool PERM = true, AFTER_DRAIN = false;
    bf16_t* HID; const float* ssq;
    __device__ __forceinline__ void operator()(const f32x4 (&acc)[2][2][4][2], const Unit& u, int wr, int wc, int fr, int fq) const {
        const int row0 = u.pm * BM + wr * 64 + fr, col0 = u.pn * HALF + wc * 32 + 8 * fq;
#pragma unroll
        for (int ai = 0; ai < 2; ++ai)
#pragma unroll
            for (int m = 0; m < 4; ++m) { const int r = row0 + ai * HALF + m * 16; const float rs = row_rstd(ssq, r); f32x4 o[2];
#pragma unroll
                for (int n = 0; n < 2; ++n)
#pragma unroll
                    for (int j = 0; j < 4; ++j) { const float g = acc[ai][0][m][n][j] * rs, uu = acc[ai][1][m][n][j] * rs;
                        o[n][j] = g * uu * __builtin_amdgcn_rcpf(1.0f + __expf(-g)); }
                *(u32x4*)(HID + (size_t)r * DFF + col0) = pack8(o[0], o[1]); }
    }
};
struct EpiIn1 {
    static constexpr bool PERM = true, AFTER_DRAIN = false;
    bf16_t* Z; const float* ssq;
    __device__ __forceinline__ void operator()(const f32x4 (&acc)[2][2][4][2], const Unit& u, int wr, int wc, int fr, int fq) const {
        const int row0 = u.pm * BM + wr * 64 + fr, col0 = u.pn * BM + wc * 32 + 8 * fq;
        if (u.pn < 32) {
            const float sc = u.pn < 16 ? 1.0f : 0.0625f;
            float inv[2][4];
#pragma unroll
            for (int n = 0; n < 2; ++n)
#pragma unroll
                for (int j = 0; j < 4; ++j) inv[n][j] = exp2f(-(float)(wc * 32 + 8 * fq + 4 * n + j) * (13.287712379549449f / 128.0f));
#pragma unroll
            for (int ai = 0; ai < 2; ++ai)
#pragma unroll
                for (int m = 0; m < 4; ++m) { const int r = row0 + ai * HALF + m * 16; const float rs = row_rstd(ssq, r) * sc;
                    const float t = (float)(r < MTOK ? NMETA + (r & (SEQ - 1)) : ((r - MTOK) & 15));
                    f32x4 o1[2], o2[2];
#pragma unroll
                    for (int n = 0; n < 2; ++n)
#pragma unroll
                        for (int j = 0; j < 4; ++j) { const float x1 = acc[ai][0][m][n][j] * rs, x2 = acc[ai][1][m][n][j] * rs;
                            const float ang = t * inv[n][j]; float rev = ang * 0.15915494309189535f; rev = rev - floorf(rev);
                            const float c = __builtin_amdgcn_cosf(rev), s = __builtin_amdgcn_sinf(rev);
                            o1[n][j] = x1 * c - x2 * s; o2[n][j] = x1 * s + x2 * c; }
                    bf16_t* rowp = Z + (size_t)r * RET_IN + col0;
                    *(u32x4*)(rowp) = pack8(o1[0], o1[1]); *(u32x4*)(rowp + HALF) = pack8(o2[0], o2[1]); }
        } else {
#pragma unroll
            for (int ai = 0; ai < 2; ++ai)
#pragma unroll
                for (int m = 0; m < 4; ++m) { const int r = row0 + ai * HALF + m * 16; const float rs = row_rstd(ssq, r); bf16_t* rowp = Z + (size_t)r * RET_IN + col0;
#pragma unroll
                    for (int bj = 0; bj < 2; ++bj) *(u32x4*)(rowp + bj * HALF) = pack8(acc[ai][bj][m][0] * rs, acc[ai][bj][m][1] * rs); }
        }
    }
};

template <class Epi, class Sched, bool ALIGN_EPI = false, bool SP2 = false>
__device__ __forceinline__ void gemm_phase(PG8_LAS unsigned char* lds, const Gemm g, const Sched& S, const Epi& E) {
    const int tid = threadIdx.x, wid = __builtin_amdgcn_readfirstlane(tid >> 6), lane = tid & 63, wr = wid >> 2, wc = wid & 3, fr = lane & 15, fq = lane >> 4;
    const int K = g.K; int nt;
    unsigned voffA[2], voffB[2];
#pragma unroll
    for (int i = 0; i < 2; ++i) { int R, C; stage_rc(tid * 16 + i * 8192, R, C); const int Rb = Epi::PERM ? ((R & ~31) + perm32(R & 31)) : R;
        voffA[i] = (unsigned)(R * K + C) * 2u; voffB[i] = (unsigned)(Rb * K + C) * 2u; }
    const size_t kstep = (size_t)(BK * 2);
    const size_t hstep = (size_t)HALF * K * 2;
    const size_t tstep = 2 * hstep;
    const unsigned ldsw = (unsigned)wid * 1024u;
    const int aoff = lds_byte(wr * 64 + fr, fq * 8), boff = lds_byte(wc * 32 + fr, fq * 8);
#define PG8_SA(b, h) (((b) * 2 + (h)) * HTB)
#define PG8_SB(b, h) ((4 + (b) * 2 + (h)) * HTB)
#define PG8_STAGE(bufoff, gbase, voff) do { _Pragma("unroll") for (int _i = 0; _i < 2; ++_i) \
        __builtin_amdgcn_global_load_lds((const unsigned*)((const char*)(gbase) + (voff)[_i]), (PG8_LAS unsigned*)(lds + (bufoff) + ldsw + _i * 8192), 16, 0, 0); } while (0)
#define PG8_LDA(dst, b, h) do { _Pragma("unroll") for (int m = 0; m < 4; ++m) _Pragma("unroll") for (int k = 0; k < 2; ++k) dst[m][k] = *(const PG8_LAS bf16x8*)(lds + PG8_SA(b, h) + aoff + m * 2048 + k * 1024); } while (0)
#define PG8_LDB(dst, b, h) do { _Pragma("unroll") for (int n = 0; n < 2; ++n) _Pragma("unroll") for (int k = 0; k < 2; ++k) dst[n][k] = *(const PG8_LAS bf16x8*)(lds + PG8_SB(b, h) + boff + n * 2048 + k * 1024); } while (0)
#define PG8_MMA(ai, bj, At, Bt) do { __builtin_amdgcn_s_setprio(1); _Pragma("unroll") for (int m = 0; m < 4; ++m) _Pragma("unroll") for (int n = 0; n < 2; ++n) _Pragma("unroll") for (int k = 0; k < 2; ++k) \
        acc[ai][bj][m][n] = __builtin_amdgcn_mfma_f32_16x16x32_bf16(Bt[n][k], At[m][k], acc[ai][bj][m][n], 0, 0, 0); __builtin_amdgcn_s_setprio(0); } while (0)
#define PG8_WAIT_V(n) asm volatile("s_waitcnt vmcnt(" #n ")" ::: "memory")
#define PG8_WAIT_L(n) asm volatile("s_waitcnt lgkmcnt(" #n ")" ::: "memory")
#define PG8_BAR __builtin_amdgcn_s_barrier()
#define PG8_SCHED __builtin_amdgcn_sched_barrier(0)
    Unit cur, nxt; int ui = 0;
    if (!S.next(0, cur)) return;
    nt = cur.kn;
    f32x4 acc[2][2][4][2];
#pragma unroll
    for (int a = 0; a < 2; ++a)
#pragma unroll
        for (int b = 0; b < 2; ++b)
#pragma unroll
            for (int m = 0; m < 4; ++m)
#pragma unroll
                for (int n = 0; n < 2; ++n) acc[a][b][m][n] = (f32x4){0.f, 0.f, 0.f, 0.f};
    bf16x8 At[4][2], B0[2][2], B1[2][2];
    const char* cA = (const char*)g.A + (size_t)cur.pm * tstep + (size_t)cur.kb * kstep; const char* cB = (const char*)g.Bt + (size_t)cur.pn * tstep + (size_t)cur.kb * kstep;
    S.a_ready(cur);
    if constexpr (SP2) {
        PG8_STAGE(PG8_SB(0, 0), cB, voffB); PG8_STAGE(PG8_SB(0, 1), cB + hstep, voffB); PG8_STAGE(PG8_SA(0, 0), cA, voffA); PG8_STAGE(PG8_SA(0, 1), cA + hstep, voffA);
        if (wr == 1) PG8_BAR;
        PG8_WAIT_V(2); PG8_BAR;
        PG8_STAGE(PG8_SB(1, 0), cB + kstep, voffB); PG8_STAGE(PG8_SA(1, 0), cA + kstep, voffA); PG8_STAGE(PG8_SB(1, 1), cB + hstep + kstep, voffB);
        PG8_WAIT_V(6); PG8_BAR;
    } else {
        PG8_STAGE(PG8_SB(0, 0), cB, voffB); PG8_STAGE(PG8_SA(0, 0), cA, voffA); PG8_STAGE(PG8_SB(0, 1), cB + hstep, voffB); PG8_STAGE(PG8_SA(0, 1), cA + hstep, voffA);
        if (wr == 1) PG8_BAR;
        PG8_WAIT_V(4); PG8_BAR;
        PG8_STAGE(PG8_SB(1, 0), cB + kstep, voffB); PG8_STAGE(PG8_SA(1, 0), cA + kstep, voffA); PG8_STAGE(PG8_SB(1, 1), cB + hstep + kstep, voffB);
        PG8_WAIT_V(6); PG8_BAR;
    }
    for (;;) {
        const bool has_next = S.next(ui + 1, nxt);
        const char* nA = has_next ? (const char*)g.A + (size_t)nxt.pm * tstep + (size_t)nxt.kb * kstep : cA; const char* nB = has_next ? (const char*)g.Bt + (size_t)nxt.pn * tstep + (size_t)nxt.kb * kstep : cB;
        for (int t = 0; t < nt; t += 2) {
            const bool last = (t == nt - 2);
            const char* a1 = cA + (size_t)(t + 1) * kstep;
            const char* a2 = last ? nA : cA + (size_t)(t + 2) * kstep; const char* b2 = last ? nB : cB + (size_t)(t + 2) * kstep;
            const char* a3 = a2 + kstep; const char* b3 = b2 + kstep;
            if (last && has_next) S.a_ready(nxt);
            if constexpr (SP2) {
            PG8_LDB(B0, 0, 0); PG8_LDB(B1, 0, 1); PG8_SCHED; PG8_LDA(At, 0, 0); PG8_STAGE(PG8_SA(1, 1), a1 + hstep, voffA);
            PG8_WAIT_V(8); PG8_WAIT_L(0); PG8_BAR; PG8_MMA(0, 0, At, B0); PG8_MMA(0, 1, At, B1); PG8_BAR; PG8_SCHED;
            PG8_LDA(At, 0, 1); PG8_STAGE(PG8_SB(0, 0), b2, voffB); PG8_STAGE(PG8_SB(0, 1), b2 + hstep, voffB); PG8_STAGE(PG8_SA(0, 0), a2, voffA);
            PG8_WAIT_V(8); PG8_WAIT_L(0); PG8_BAR; PG8_MMA(1, 0, At, B0); PG8_MMA(1, 1, At, B1); PG8_BAR; PG8_SCHED;
            PG8_LDB(B0, 1, 0); PG8_LDB(B1, 1, 1); PG8_SCHED; PG8_LDA(At, 1, 0); PG8_STAGE(PG8_SA(0, 1), a2 + hstep, voffA);
            PG8_WAIT_V(8); PG8_WAIT_L(0); PG8_BAR; PG8_MMA(0, 0, At, B0); PG8_MMA(0, 1, At, B1); PG8_BAR; PG8_SCHED;
            PG8_LDA(At, 1, 1); PG8_STAGE(PG8_SB(1, 0), b3, voffB); PG8_STAGE(PG8_SB(1, 1), b3 + hstep, voffB); PG8_STAGE(PG8_SA(1, 0), a3, voffA);
            PG8_WAIT_V(8); PG8_WAIT_L(0); PG8_BAR; PG8_MMA(1, 0, At, B0); PG8_MMA(1, 1, At, B1); PG8_BAR; PG8_SCHED;
            } else {
            PG8_LDB(B0, 0, 0); PG8_SCHED; PG8_LDA(At, 0, 0); PG8_STAGE(PG8_SA(1, 1), a1 + hstep, voffA);
            PG8_WAIT_L(8); PG8_BAR; PG8_WAIT_L(0); PG8_MMA(0, 0, At, B0); PG8_BAR; PG8_SCHED;
            PG8_LDB(B1, 0, 1); PG8_STAGE(PG8_SB(0, 0), b2, voffB);
            PG8_BAR; PG8_WAIT_L(0); PG8_MMA(0, 1, At, B1); PG8_BAR;
            PG8_LDA(At, 0, 1); PG8_STAGE(PG8_SA(0, 0), a2, voffA);
            PG8_BAR; PG8_WAIT_L(0); PG8_MMA(1, 0, At, B0); PG8_BAR; PG8_SCHED;
            PG8_STAGE(PG8_SB(0, 1), b2 + hstep, voffB);
            PG8_WAIT_V(6); PG8_BAR; PG8_MMA(1, 1, At, B1); PG8_BAR;
            PG8_LDB(B0, 1, 0); PG8_SCHED; PG8_LDA(At, 1, 0); PG8_STAGE(PG8_SA(0, 1), a2 + hstep, voffA);
            PG8_WAIT_L(8); PG8_BAR; PG8_WAIT_L(0); PG8_MMA(0, 0, At, B0); PG8_BAR; PG8_SCHED;
            PG8_LDB(B1, 1, 1); PG8_STAGE(PG8_SB(1, 0), b3, voffB);
            PG8_BAR; PG8_WAIT_L(0); PG8_MMA(0, 1, At, B1); PG8_BAR;
            PG8_LDA(At, 1, 1); PG8_STAGE(PG8_SA(1, 0), a3, voffA);
            PG8_BAR; PG8_WAIT_L(0); PG8_MMA(1, 0, At, B0); PG8_BAR; PG8_SCHED;
            PG8_STAGE(PG8_SB(1, 1), b3 + hstep, voffB);
            PG8_WAIT_V(6); PG8_BAR; PG8_MMA(1, 1, At, B1); PG8_BAR;
            }
        }
        if constexpr (ALIGN_EPI) { if (wr == 0) PG8_BAR; }
        if constexpr (!Epi::AFTER_DRAIN) { E(acc, cur, wr, wc, fr, fq); S.done(cur); }
        if (!has_next) break;
#pragma unroll
        for (int a = 0; a < 2; ++a)
#pragma unroll
            for (int b = 0; b < 2; ++b)
#pragma unroll
                for (int m = 0; m < 4; ++m)
#pragma unroll
                    for (int n = 0; n < 2; ++n) acc[a][b][m][n] = (f32x4){0.f, 0.f, 0.f, 0.f};
        cur = nxt; cA = nA; cB = nB; ++ui; nt = cur.kn;
        if constexpr (ALIGN_EPI) { if (wr == 1) PG8_BAR; }
    }
    PG8_WAIT_V(0);
    if constexpr (!ALIGN_EPI) { if (wr == 0) PG8_BAR; }
    PG8_BAR;
    if constexpr (Epi::AFTER_DRAIN) { E.fused(acc, cur, wr, wc, fr, fq, lds, wid, lane); S.done(cur); }
#undef PG8_SA
#undef PG8_SB
#undef PG8_STAGE
#undef PG8_LDA
#undef PG8_LDB
#undef PG8_MMA
#undef PG8_WAIT_V
#undef PG8_WAIT_L
#undef PG8_BAR
#undef PG8_SCHED
}
}

constexpr size_t MiB = 1u << 20;
constexpr size_t WS_CTL = 0, CTL_ZERO_BYTES = 2 * MiB;
constexpr size_t WS_SSQ1 = 64 * 1024, WS_SSQ2 = 192 * 1024, WS_SSQ3 = 320 * 1024, WS_SSQO = 512 * 1024;
constexpr size_t WS_SSQ0 = 2 * MiB;
constexpr size_t WS_FBUF = 2 * MiB + 512 * 1024;
constexpr size_t WS_HMETA = 4 * MiB;
constexpr size_t WS_WIN0 = 8 * MiB, WS_WOUT0 = 90 * MiB, WS_WGU0 = 122 * MiB, WS_WD0 = 294 * MiB, WS_WIN1 = 380 * MiB, WS_WOUT1 = 572 * MiB, WS_WGU1 = 636 * MiB, WS_WD1 = 808 * MiB;
constexpr size_t WS_WAT = 894 * MiB, WS_WXT = WS_WAT + 512 * 1024;
constexpr size_t WS_XB = 896 * MiB, WS_Z = 1026 * MiB, WS_END = 1806 * MiB;
constexpr size_t WS_Y0 = WS_Z + 400 * MiB;
constexpr size_t WS_Y1 = 8 * MiB;
static_assert(WS_SSQO + (size_t)MP * 16 * 4 <= CTL_ZERO_BYTES && WS_FBUF + (size_t)MP * 16 * 4 <= WS_HMETA && WS_HMETA + (size_t)256 * DM * 4 <= WS_WIN0, "ctl map");
static_assert(WS_WIN0 + (size_t)41 * 256 * DM * 2 <= WS_WOUT0 && WS_WGU0 + (size_t)2 * DFF * DM * 2 <= WS_WD0 && WS_WD0 + (size_t)DM * DFF * 2 <= WS_WIN1 && WS_WIN1 + (size_t)RET_IN * DM * 2 <= WS_WOUT1, "weight map");
static_assert(WS_WOUT1 + (size_t)DM * RET_VW * 2 <= WS_WGU1 && WS_WGU1 + (size_t)2 * DFF * DM * 2 <= WS_WD1 && WS_WD1 + (size_t)DM * DFF * 2 <= WS_WAT, "weight map 2");
static_assert(WS_XB + (size_t)MP * DM * 2 <= WS_Z && WS_Z + (size_t)MP * RET_IN * 2 <= WS_END && WS_Z + (size_t)MP * AB_Z * 2 <= WS_Y0 && WS_Z + (size_t)MP * DFF * 2 <= WS_Y0 && WS_Y0 + (size_t)MP * DM * 2 <= WS_END && WS_Y1 + (size_t)MP * RET_VW * 2 <= WS_WD0, "activation map");
constexpr int CW_TMO = 0, CW_Q2 = 64, CW_TK3 = 256, CW_TK5 = 320, CW_BAR = 4096;
constexpr int RING_BYTES = 131072;
constexpr int LDS_BYTES = 147456;
constexpr int MISC_OFF = LDS_BYTES - 256;
constexpr int NWAVES = 8, NTHREADS = 512;
constexpr int NPHASES = 12;

#define GAS __attribute__((address_space(1)))
#define LAS __attribute__((address_space(3)))
typedef unsigned short bf16;
typedef unsigned v4u __attribute__((ext_vector_type(4)));
typedef unsigned v2u __attribute__((ext_vector_type(2)));
typedef float f32x4 __attribute__((ext_vector_type(4)));
typedef short bf16x8 __attribute__((ext_vector_type(8)));
typedef short bf16x4 __attribute__((ext_vector_type(4)));
typedef GAS unsigned gu32;
#define RLX_AGENT __ATOMIC_RELAXED, __HIP_MEMORY_SCOPE_AGENT
#define LDS_WAIT() asm volatile("s_waitcnt lgkmcnt(0)" ::: "memory")
#define VM_WAIT() asm volatile("s_waitcnt vmcnt(0)" ::: "memory")
__device__ __forceinline__ unsigned f2bf(float f) { unsigned u = __builtin_bit_cast(unsigned, f); return (u + 0x7fffu + ((u >> 16) & 1u)) >> 16; }
__device__ __forceinline__ unsigned pk2(float lo, float hi) { return pg8::cvt_pk_bf16(lo, hi); }
__device__ __forceinline__ float bflo(unsigned w) { return __builtin_bit_cast(float, w << 16); }
__device__ __forceinline__ float bfhi(unsigned w) { return __builtin_bit_cast(float, w & 0xffff0000u); }
__device__ __forceinline__ float bf2f(unsigned short h) { return __builtin_bit_cast(float, (unsigned)h << 16); }
__device__ __forceinline__ void unpack8(const v4u w, float (&f)[8]) { f[0] = bflo(w.x); f[1] = bfhi(w.x); f[2] = bflo(w.y); f[3] = bfhi(w.y); f[4] = bflo(w.z); f[5] = bfhi(w.z); f[6] = bflo(w.w); f[7] = bfhi(w.w); }
__device__ __forceinline__ v4u pack8f(const float (&f)[8]) { v4u w; w.x = pk2(f[0], f[1]); w.y = pk2(f[2], f[3]); w.z = pk2(f[4], f[5]); w.w = pk2(f[6], f[7]); return w; }
__device__ __forceinline__ int row_of(int b, int t) { return t < NMETA ? MMETA + NMETA * b + t : b * SEQ + (t - NMETA); }
__device__ __forceinline__ f32x4 mfma16(bf16x8 a, bf16x8 b, f32x4 c) { return __builtin_amdgcn_mfma_f32_16x16x32_bf16(a, b, c, 0, 0, 0); }

#define XB_TMO      128
#define XB_XCNT(j)  (256  + 64 * (j))
#define XB_XSUB(j)  (1280 + 64 * (j))
#define XB_XGEN(j)  (2304 + 64 * (j))
#define XB_TOP      3328
#define XB_TOPGEN   3392
#define XCD_BAR_WORDS 3456
#define XB_SPIN_CAP (1u << 22)

__device__ __forceinline__ unsigned xb_ld(unsigned* p)              { return __hip_atomic_load(p, __ATOMIC_RELAXED, __HIP_MEMORY_SCOPE_AGENT); }
__device__ __forceinline__ unsigned xb_add(unsigned* p, unsigned v) { return __hip_atomic_fetch_add(p, v, __ATOMIC_RELAXED, __HIP_MEMORY_SCOPE_AGENT); }
__device__ __forceinline__ unsigned xb_xcc_id() { return (unsigned)__builtin_amdgcn_s_getreg((3 << 11) | 20) & 0xFu; }
#define XB_SPIN(cond, bar) do { unsigned _sp = 0; while (cond) { __builtin_amdgcn_s_sleep(1); \
    if ((++_sp & 255u) == 0u) { if (xb_ld(&(bar)[XB_TMO])) break; if (_sp > XB_SPIN_CAP) { atomicAdd(&(bar)[XB_TMO], 1u); break; } } } } while (0)

struct XcdBarrier {
    unsigned* bar; unsigned x;
    volatile LAS unsigned* st;
};
__device__ __forceinline__ XcdBarrier xcd_barrier_post(unsigned* bar, volatile LAS unsigned* st) {
    XcdBarrier b; b.bar = bar; b.x = xb_xcc_id(); b.st = st;
    if (threadIdx.x == 0) (void)xb_add(&bar[XB_XCNT(b.x)], 1u);
    return b;
}
__device__ __forceinline__ void xcd_barrier_complete(unsigned* bar, unsigned x, unsigned& nloc, unsigned& nx) {
    const unsigned G = gridDim.x * gridDim.y * gridDim.z;
    unsigned sum, cnt, mine, sp = 0u;
    for (;;) {
        sum = 0u; cnt = 0u; mine = 0u;
#pragma unroll
        for (unsigned j = 0; j < 16; ++j) { const unsigned c = xb_ld(&bar[XB_XCNT(j)]); sum += c; cnt += (c > 0u) ? 1u : 0u; mine = (j == x) ? c : mine; }
        if (sum == G) break;
        __builtin_amdgcn_s_sleep(1);
        if ((++sp & 255u) == 0u) { if (xb_ld(&bar[XB_TMO])) break; if (sp > XB_SPIN_CAP) { atomicAdd(&bar[XB_TMO], 1u); break; } }
    }
    nloc = mine > 0u ? mine : 1u; nx = cnt > 0u ? cnt : 1u;
}
__device__ __forceinline__ void xcd_barrier(const XcdBarrier& b) {
    asm volatile("s_waitcnt vmcnt(0)" ::: "memory");
    __syncthreads();
    if (threadIdx.x == 0) {
        unsigned* bar = b.bar;
        __builtin_amdgcn_s_waitcnt(0);
        unsigned nloc = b.st[0], nx = b.st[1];
        if (nloc == 0u) { xcd_barrier_complete(bar, b.x, nloc, nx); b.st[0] = nloc; b.st[1] = nx; }
        const unsigned old = xb_add(&bar[XB_XSUB(b.x)], 1u);
        const unsigned gen = old / nloc;
        if (old + 1u == (gen + 1u) * nloc) {
            __builtin_amdgcn_fence(__ATOMIC_RELEASE, "agent");
            asm volatile("s_waitcnt vmcnt(0)" ::: "memory");
            const unsigned og = xb_add(&bar[XB_TOP], 1u);
            const unsigned tg = og / nx;
            if (og + 1u == (tg + 1u) * nx) xb_add(&bar[XB_TOPGEN], 1u);
            else XB_SPIN(xb_ld(&bar[XB_TOPGEN]) == tg, bar);
            __builtin_amdgcn_fence(__ATOMIC_ACQUIRE, "agent");
            xb_add(&bar[XB_XGEN(b.x)], 1u);
            asm volatile("s_waitcnt vmcnt(0)" ::: "memory");
        } else {
            XB_SPIN(xb_ld(&bar[XB_XGEN(b.x)]) == gen, bar);
            __builtin_amdgcn_fence(__ATOMIC_ACQUIRE, "agent");
            asm volatile("s_waitcnt vmcnt(0)" ::: "memory");
        }
    }
    __syncthreads();
}

struct Args { const float* in[23]; float* out; unsigned char* ws; int ph_lo, ph_hi; };
__device__ __forceinline__ float* h_row(float* out, unsigned char* ws, int r) { return r < MTOK ? out + (size_t)r * DM : (float*)(ws + WS_HMETA) + (size_t)(r - MTOK) * DM; }
struct Frame {
    LAS unsigned char* lds;
    volatile LAS unsigned* MISC;
    unsigned char* ws;
    int tid, lane, wave, G;
};
__device__ __forceinline__ float wave_sum(float v) {
#pragma unroll
    for (int o = 1; o < 64; o <<= 1) v += __shfl_xor(v, o);
    return v;
}

template <int MODE, int KCH>
__device__ __forceinline__ void p0_tr(const float* W, int K, int N, bf16* WT, LAS unsigned* tile, int item, int lane) {
    const int nkc = K / KCH, nb = item / nkc, kc = item - nb * nkc, k0 = kc * KCH, n0 = nb * 64;
    const int kq = lane >> 4, nq = lane & 15; const int n = n0 + 4 * nq; const bool ok = n < N;
    const float* src = W + (size_t)(k0 + 2 * kq) * N + (ok ? n : 0);
    const int nr = lane >> 3, kch = lane & 7;
    f32x4 va[8][2];
#define P0_LOAD(v, sub) do { _Pragma("unroll") for (int i = 0; i < 8; ++i) { const float* p_ = src + (size_t)(64 * (sub) + 8 * i) * N; v[i][0] = __builtin_nontemporal_load((const GAS f32x4*)p_); v[i][1] = __builtin_nontemporal_load((const GAS f32x4*)(p_ + N)); } } while (0)
#define P0_PROC(v, sub) do { const int kb = k0 + 64 * (sub); \
        _Pragma("unroll") for (int i = 0; i < 8; ++i) { \
            _Pragma("unroll") for (int c = 0; c < 4; ++c) tile[(4 * nq + c) * 33 + 4 * i + kq] = pk2(v[i][0][c], v[i][1][c]); } \
        LDS_WAIT(); asm volatile("" ::: "memory"); \
        _Pragma("unroll") for (int st = 0; st < 8; ++st) { const int row = 8 * st + nr; const LAS unsigned* tp = tile + row * 33 + 4 * kch; \
            v4u o; o.x = tp[0]; o.y = tp[1]; o.z = tp[2]; o.w = tp[3]; \
            const int ng = n0 + row; const int drow = MODE == 0 ? ng : (MODE == 1 ? 256 * (ng >> 7) + (ng & 127) : 256 * (ng >> 7) + 128 + (ng & 127)); \
            if (ng < N) __builtin_nontemporal_store(o, (GAS v4u*)(WT + (size_t)drow * K + kb + 8 * kch)); } \
        LDS_WAIT(); asm volatile("" ::: "memory"); } while (0)
#pragma unroll 1
    for (int sub = 0; sub < KCH / 64; ++sub) { P0_LOAD(va, sub); P0_PROC(va, sub); }
#undef P0_LOAD
#undef P0_PROC
}
__device__ __forceinline__ void p0_row(Frame& F, const float* x, const float* meta, const float* gain, float* out, int r) {
    float* hrow = h_row(out, F.ws, r); bf16* xrow = (bf16*)(F.ws + WS_XB) + (size_t)r * DM;
    const float* src = r < MTOK ? x + (size_t)r * DM : meta + (size_t)((r - MTOK) & 15) * DM;
    const bool pad = r >= MTOK + NB * NMETA;
    float s = 0.f;
#pragma unroll 4
    for (int j = 0; j < 16; ++j) { const int e = (F.lane + 64 * j) * 4;
        f32x4 v = pad ? (f32x4){0.f, 0.f, 0.f, 0.f} : *(const GAS f32x4*)(src + e);
        s += (v.x * v.x + v.y * v.y) + (v.z * v.z + v.w * v.w);
        if (r >= MTOK) *(GAS f32x4*)(hrow + e) = v;
        const f32x4 gn = *(const GAS f32x4*)(gain + e); v2u w; w.x = pk2(v.x * gn.x, v.y * gn.y); w.y = pk2(v.z * gn.z, v.w * gn.w); *(GAS v2u*)(xrow + e) = w; }
    s = wave_sum(s);
    if (F.lane == 0) ((float*)(F.ws + WS_SSQ0))[r] = s;
}
#ifndef CONV_IN_P2
#define CONV_IN_P2 1
#endif
constexpr int P0_KC = 256;
constexpr int CV_G = 172 * (DM / P0_KC), CV_D = 64 * (DFF / P0_KC), CV_IN1 = 384 * (DM / P0_KC), CV_O1 = 64 * (RET_VW / P0_KC);
constexpr int CV_FINE = 2 * (2 * CV_G + CV_D) + CV_IN1 + CV_O1;
constexpr int CV_PER = 32, N_CONV = CONV_IN_P2 ? (CV_FINE + CV_PER - 1) / CV_PER : 0;
struct ConvPtrs { const float *wg, *wu, *wd, *win1, *wo1, *fnorm, *cnorm; };
__device__ __forceinline__ void conv_fine_b2(unsigned char* ws, LAS unsigned* tile, const ConvPtrs P, int it, int lane) {
    int r = it;
    if (r < CV_G) { p0_tr<1, P0_KC>(P.wg, DM, DFF, (bf16*)(ws + WS_WGU0), tile, r, lane); return; } r -= CV_G;
    if (r < CV_G) { p0_tr<2, P0_KC>(P.wu, DM, DFF, (bf16*)(ws + WS_WGU0), tile, r, lane); return; } r -= CV_G;
    if (r < CV_D) { p0_tr<0, P0_KC>(P.wd, DFF, DM, (bf16*)(ws + WS_WD0), tile, r, lane); return; } r -= CV_D;
    if (r < CV_IN1) { p0_tr<0, P0_KC>(P.win1, DM, RET_IN, (bf16*)(ws + WS_WIN1), tile, r, lane); return; } r -= CV_IN1;
    if (r < CV_O1) { p0_tr<0, P0_KC>(P.wo1, RET_VW, DM, (bf16*)(ws + WS_WOUT1), tile, r, lane); return; } r -= CV_O1;
    if (r < CV_G) { p0_tr<1, P0_KC>(P.wg + (size_t)DM * DFF, DM, DFF, (bf16*)(ws + WS_WGU1), tile, r, lane); return; } r -= CV_G;
    if (r < CV_G) { p0_tr<2, P0_KC>(P.wu + (size_t)DM * DFF, DM, DFF, (bf16*)(ws + WS_WGU1), tile, r, lane); return; } r -= CV_G;
    p0_tr<0, P0_KC>(P.wd + (size_t)DFF * DM, DFF, DM, (bf16*)(ws + WS_WD1), tile, r, lane);
}
__device__ __forceinline__ void conv_item(unsigned char* ws, LAS unsigned char* ldsb, ConvPtrs P, int ci, int wave, int lane) {
    LAS unsigned* tile = (LAS unsigned*)(ldsb + wave * 8448);
    for (int k = wave; k < CV_PER; k += NWAVES) { const int it = __builtin_amdgcn_readfirstlane(ci * CV_PER + k); if (it < CV_FINE) conv_fine_b2(ws, tile, P, it, lane); }
}
__device__ __forceinline__ void p0_prologue(Frame& F, const Args& A) {
    const int gw = __builtin_amdgcn_readfirstlane(blockIdx.x * NWAVES + F.wave), NGW = F.G * NWAVES;
    unsigned char* ws = F.ws;
    constexpr int KC = P0_KC; LAS unsigned* tile = (LAS unsigned*)(F.lds + F.wave * 8448);
    constexpr int I_IN0 = 161 * (DM / KC), I_SQ = 64 * (DM / KC), I_BD = 16 * 2;
    constexpr int NITEMS = I_IN0 + I_SQ + 2 * I_BD;
    for (int it = gw; it < NITEMS; it += NGW) {
        int r = it;
        if (r < I_IN0) { p0_tr<0, KC>(A.in[3], DM, AB_IN, (bf16*)(ws + WS_WIN0), tile, r, F.lane); continue; } r -= I_IN0;
        if (r < I_SQ) { p0_tr<0, KC>(A.in[14], DM, DM, (bf16*)(ws + WS_WOUT0), tile, r, F.lane); continue; } r -= I_SQ;
        if (r < I_BD) { const int blk = r >> 1; p0_tr<0, 128>(A.in[7] + (size_t)blk * 16384, 128, 128, (bf16*)(ws + WS_WAT) + (size_t)blk * 16384, tile, r & 1, F.lane); continue; } r -= I_BD;
        { const int blk = r >> 1; p0_tr<0, 128>(A.in[9] + (size_t)blk * 16384, 128, 128, (bf16*)(ws + WS_WXT) + (size_t)blk * 16384, tile, r & 1, F.lane); }
    }
#if !CONV_IN_P2
    { const ConvPtrs CP{A.in[20], A.in[21], A.in[22], A.in[16], A.in[18], A.in[19], A.in[15]};
      for (int it = gw; it < CV_FINE; it += NGW) conv_fine_b2(ws, tile, CP, it, F.lane); }
#endif
    for (int m = gw; m < MP; m += NGW) p0_row(F, A.in[0], A.in[1], A.in[2], A.out, m);
}

__device__ __forceinline__ float sigmoidf_fast(float x) { return __builtin_amdgcn_rcpf(1.0f + __expf(-x)); }
__device__ __forceinline__ float gelu_tanh(float g) { const float z = 0.7978845608028654f * (g + 0.044715f * g * g * g); const float e = __expf(2.0f * z); return 0.5f * g * (2.0f - 2.0f * __builtin_amdgcn_rcpf(e + 1.0f)); }

constexpr int LRU_XA = 0, LRU_STRIDE = 272, LRU_XF = 17408, LRU_XF_STRIDE = 132  , LRU_GT = 51200, LRU_YT = 68608;
__device__ __forceinline__ void lru_item(Frame& F, const Args& A, int b, int n) {
    const bf16* z0 = (const bf16*)(F.ws + WS_Z); bf16* y0 = (bf16*)(F.ws + WS_Y0);
    const int tid = F.tid, lane = F.lane, w = F.wave, fr = lane & 15, fq = lane >> 4;
    LAS unsigned char* lds = F.lds;
    LAS float* XF = (LAS float*)(lds + LRU_XF);
    const int c8 = (tid & 15) * 8, r4 = tid >> 4;
    const int ch0 = n * 128 + c8;
    float cw[4][8], cb[8];
#pragma unroll
    for (int e = 0; e < 8; ++e) { cb[e] = A.in[6][ch0 + e];
#pragma unroll
        for (int j = 0; j < 4; ++j) cw[j][e] = A.in[5][j * LRU_W + ch0 + e]; }
    const int dch = n * 128 + 16 * w + fr;
    const float ba = A.in[8][dch], bx = A.in[10][dch];
    const float cneg = -8.0f * log1pf(expf(-A.in[11][dch]));
    bf16x8 bwa[4], bwx[4];
    { const bf16* wat = (const bf16*)(F.ws + WS_WAT) + ((size_t)n * 128 + 16 * w + fr) * 128 + 8 * fq; const bf16* wxt = (const bf16*)(F.ws + WS_WXT) + ((size_t)n * 128 + 16 * w + fr) * 128 + 8 * fq;
#pragma unroll
      for (int ks = 0; ks < 4; ++ks) { bwa[ks] = *(const bf16x8*)(wat + 32 * ks); bwx[ks] = *(const bf16x8*)(wxt + 32 * ks); } }
    float hc = 0.f;
    v4u xr[2][4], gv[2];
#define LRU_LOAD(tau) do { _Pragma("unroll") for (int q = 0; q < 2; ++q) { const int t = 64 * (tau) + r4 + 32 * q - 48; \
            gv[q] = (v4u){0u, 0u, 0u, 0u}; if (t >= 0) gv[q] = *(const GAS v4u*)(z0 + (size_t)row_of(b, t) * AB_Z + LRU_W + ch0); \
            _Pragma("unroll") for (int j = 0; j < 4; ++j) { const int tj = t - 3 + j; xr[q][j] = (v4u){0u, 0u, 0u, 0u}; if (tj >= 0) xr[q][j] = *(const GAS v4u*)(z0 + (size_t)row_of(b, tj) * AB_Z + ch0); } } } while (0)
    LRU_LOAD(0);
    for (int tau = 0; tau < 65; ++tau) {
#pragma unroll
        for (int q = 0; q < 2; ++q) {
            const int rr = r4 + 32 * q;
            float xc[8];
#pragma unroll
            for (int e = 0; e < 8; ++e) xc[e] = cb[e];
#pragma unroll
            for (int j = 0; j < 4; ++j) { float xf[8]; unpack8(xr[q][j], xf);
#pragma unroll
                for (int e = 0; e < 8; ++e) xc[e] += cw[j][e] * xf[e]; }
            *(LAS v4u*)(lds + LRU_XA + rr * LRU_STRIDE + c8 * 2) = pack8f(xc);
            *(LAS f32x4*)(XF + rr * LRU_XF_STRIDE + c8) = (f32x4){xc[0], xc[1], xc[2], xc[3]};
            *(LAS f32x4*)(XF + rr * LRU_XF_STRIDE + c8 + 4) = (f32x4){xc[4], xc[5], xc[6], xc[7]};
            *(LAS v4u*)(lds + LRU_GT + rr * LRU_STRIDE + c8 * 2) = gv[q];
        }
        if (tau < 64) LRU_LOAD(tau + 1);
        __syncthreads();
        f32x4 accr[4], acci[4];
#pragma unroll
        for (int m = 0; m < 4; ++m) { accr[m] = (f32x4){0.f, 0.f, 0.f, 0.f}; acci[m] = (f32x4){0.f, 0.f, 0.f, 0.f}; }
#pragma unroll
        for (int m = 0; m < 4; ++m)
#pragma unroll
            for (int ks = 0; ks < 4; ++ks) { const bf16x8 a = *(const LAS bf16x8*)(lds + LRU_XA + (16 * m + fr) * LRU_STRIDE + (32 * ks + 8 * fq) * 2);
                accr[m] = mfma16(a, bwa[ks], accr[m]); acci[m] = mfma16(a, bwx[ks], acci[m]); }
        const int d = 16 * w + fr;
#pragma unroll
        for (int m = 0; m < 4; ++m) {
            float av[4], bv[4];
#pragma unroll
            for (int g = 0; g < 4; ++g) { const int rr = 16 * m + 4 * fq + g;
                const float rg = sigmoidf_fast(accr[m][g] + ba), ig = sigmoidf_fast(acci[m][g] + bx);
                const float la = cneg * rg; av[g] = __expf(la); const float mult = sqrtf(fmaxf(1.0f - __expf(2.0f * la), 0.f));
                bv[g] = mult * (ig * XF[rr * LRU_XF_STRIDE + d]);
                if (tau == 0 && rr < 48) bv[g] = 0.f; }
            float P = av[0] * av[1], H = bv[0] * av[1] + bv[1]; P *= av[2]; H = H * av[2] + bv[2]; P *= av[3]; H = H * av[3] + bv[3];
            { const float P1 = __shfl_up(P, 16), H1 = __shfl_up(H, 16); if (fq >= 1) { H = P * H1 + H; P = P1 * P; } }
            { const float P2 = __shfl_up(P, 32), H2 = __shfl_up(H, 32); if (fq >= 2) { H = P * H2 + H; P = P2 * P; } }
            float Pe = __shfl_up(P, 16), He = __shfl_up(H, 16); if (fq == 0) { Pe = 1.f; He = 0.f; }
            float h = Pe * hc + He;
            float hv[4];
#pragma unroll
            for (int g = 0; g < 4; ++g) { h = av[g] * h + bv[g]; hv[g] = h; }
            hc = __shfl(h, 48 + fr);
#pragma unroll
            for (int g = 0; g < 4; ++g) { const int rr = 16 * m + 4 * fq + g;
                const float gt = bf2f(*(const LAS unsigned short*)(lds + LRU_GT + rr * LRU_STRIDE + d * 2));
                *(LAS unsigned short*)(lds + LRU_YT + rr * LRU_STRIDE + d * 2) = (unsigned short)(pk2(hv[g] * gelu_tanh(gt), 0.f) & 0xffffu); }
        }
        __syncthreads();
#pragma unroll
        for (int q = 0; q < 2; ++q) { const int rr = r4 + 32 * q, t = 64 * tau + rr - 48;
            if (t >= 0) *(GAS v4u*)(y0 + (size_t)row_of(b, t) * DM + ch0) = *(const LAS v4u*)(lds + LRU_YT + rr * LRU_STRIDE + c8 * 2); }
    }
#undef LRU_LOAD
    __syncthreads();
}

constexpr int AT_STRIDE = 272, AT_TILE = 64 * AT_STRIDE, AT_KT = 0, AT_VN = 2 * AT_TILE, AT_RSK = 4 * AT_TILE, AT_CUM = AT_RSK + 512, AT_SCAN = AT_CUM + 4352 * 4;
static_assert(AT_SCAN + 64 <= RING_BYTES, "attention LDS map");
__device__ __forceinline__ float log_sigmoid(float x) { return fminf(x, 0.f) - log1pf(__expf(-fabsf(x))); }
__device__ __forceinline__ void attn_item(Frame& F, const Args& A, int b, int h, int j) {
    const bf16* z0 = (const bf16*)(F.ws + WS_Z); bf16* y0 = (bf16*)(F.ws + WS_Y0); const float* fbuf = (const float*)(F.ws + WS_FBUF);
    const int tid = F.tid, lane = F.lane, w = F.wave, fr = lane & 15, fq = lane >> 4;
    LAS unsigned char* lds = F.lds;
    LAS float* CUM = (LAS float*)(lds + AT_CUM); LAS float* SCAN = (LAS float*)(lds + AT_SCAN); LAS float* RSK = (LAS float*)(lds + AT_RSK);
    constexpr float LOG2E = 1.4426950408889634f;
    const int nT = NMETA + 256 * j;
    { const float bf_h = A.in[4][h];
      float loc[9]; float run = 0.f;
#pragma unroll
      for (int e = 0; e < 9; ++e) { const int t = 9 * tid + e; float v = 0.f; if (t < nT) v = log_sigmoid(fbuf[(size_t)row_of(b, t) * 16 + h] + bf_h); run += v; loc[e] = run; }
      float inc = run;
#pragma unroll
      for (int o = 1; o < 64; o <<= 1) { const float t = __shfl_up(inc, o); if (lane >= o) inc += t; }
      if (lane == 63) SCAN[w] = inc;
      __syncthreads();
      float off = inc - run;
      for (int k = 0; k < w; ++k) off += SCAN[k];
#pragma unroll
      for (int e = 0; e < 9; ++e) { const int t = 9 * tid + e; if (t < nT) CUM[t + 240] = (off + loc[e]) * LOG2E; }
      if (tid < 240) CUM[tid] = 0.f; }
    bf16x8 qf[2][4];
    const int ubase = 256 * j + 32 * w;
#pragma unroll
    for (int m = 0; m < 2; ++m) {
        const int u = ubase + 16 * m + fr; const int t = u - 240; const int r = row_of(b, t < 0 ? 0 : t);
        const bf16* qp = z0 + (size_t)r * AB_Z + 4096 + 128 * h + 8 * fq;
        float qv[4][8]; float s = 0.f;
#pragma unroll
        for (int ks = 0; ks < 4; ++ks) { const v4u raw = *(const GAS v4u*)(qp + 32 * ks); unpack8(raw, qv[ks]);
#pragma unroll
            for (int e = 0; e < 8; ++e) s += qv[ks][e] * qv[ks][e]; }
        s += __shfl_xor(s, 16); s += __shfl_xor(s, 32);
        const float rs = (1.0f / sqrtf(s * (1.0f / 128.0f) + RMS_EPS)) * (0.08838834764831845f * LOG2E);
#pragma unroll
        for (int ks = 0; ks < 4; ++ks) { float o[8];
#pragma unroll
            for (int e = 0; e < 8; ++e) o[e] = qv[ks][e] * rs * (A.in[12][32 * ks + 8 * fq + e] * A.in[13][32 * ks + 8 * fq + e]);
            const v4u pk = pack8f(o); qf[m][ks] = __builtin_bit_cast(bf16x8, pk); }
    }
    f32x4 O[2][8]; float mrow[2], lrow[2];
#pragma unroll
    for (int m = 0; m < 2; ++m) {
#pragma unroll
        for (int dt = 0; dt < 8; ++dt) O[m][dt] = (f32x4){0.f, 0.f, 0.f, 0.f};
        mrow[m] = -1e30f; lrow[m] = 0.f; }
    const int imax = 4 * j + 3;
    const int skey = tid >> 3, sdc = (tid & 7) * 16;
    const unsigned vbase = (unsigned)(size_t)lds + AT_VN + (4u * fq + ((unsigned)(lane & 15) >> 2)) * AT_STRIDE + 8u * (unsigned)(lane & 3);
    v4u kreg[2], vreg[2];
#define AT_LOAD(i_) do { const int t_ = 64 * (i_) + skey - 240; const int r_ = row_of(b, t_ < 0 ? 0 : t_); const bf16* kp_ = z0 + (size_t)r_ * AB_Z + 6144 + 128 * h + sdc; const bf16* vp_ = z0 + (size_t)r_ * AB_Z + 8192 + 128 * h + sdc; \
        kreg[0] = *(const GAS v4u*)(kp_); kreg[1] = *(const GAS v4u*)(kp_ + 8); vreg[0] = *(const GAS v4u*)(vp_); vreg[1] = *(const GAS v4u*)(vp_ + 8); } while (0)
#define AT_STAGE(buf_) do { float a8_[8], b8_[8]; unpack8(kreg[0], a8_); unpack8(kreg[1], b8_); float s_ = 0.f; \
        _Pragma("unroll") for (int e = 0; e < 8; ++e) s_ += a8_[e] * a8_[e] + b8_[e] * b8_[e]; \
        s_ += __shfl_xor(s_, 1); s_ += __shfl_xor(s_, 2); s_ += __shfl_xor(s_, 4); \
        if ((tid & 7) == 0) RSK[(buf_) * 64 + skey] = 1.0f / sqrtf(s_ * (1.0f / 128.0f) + RMS_EPS); \
        *(LAS v4u*)(lds + AT_KT + (buf_) * AT_TILE + skey * AT_STRIDE + sdc * 2) = kreg[0]; *(LAS v4u*)(lds + AT_KT + (buf_) * AT_TILE + skey * AT_STRIDE + sdc * 2 + 16) = kreg[1]; \
        *(LAS v4u*)(lds + AT_VN + (buf_) * AT_TILE + skey * AT_STRIDE + sdc * 2) = vreg[0]; *(LAS v4u*)(lds + AT_VN + (buf_) * AT_TILE + skey * AT_STRIDE + sdc * 2 + 16) = vreg[1]; } while (0)
    AT_LOAD(3); AT_STAGE(1);
    if (imax > 3) AT_LOAD(4);
    __syncthreads();
    float bq[2];
#pragma unroll
    for (int m = 0; m < 2; ++m) bq[m] = CUM[ubase + 16 * m + fr];
    for (int i = 3; i <= imax; ++i) {
        const int buf = i & 1;
        if (i < imax) { AT_STAGE(buf ^ 1); if (i + 1 < imax) AT_LOAD(i + 2); }
        if (64 * i <= ubase + 31) {
            f32x4 S[2][4];
#pragma unroll
            for (int m = 0; m < 2; ++m)
#pragma unroll
                for (int nt = 0; nt < 4; ++nt) S[m][nt] = (f32x4){0.f, 0.f, 0.f, 0.f};
#pragma unroll
            for (int nt = 0; nt < 4; ++nt)
#pragma unroll
                for (int ks = 0; ks < 4; ++ks) { const bf16x8 kf = *(const LAS bf16x8*)(lds + AT_KT + buf * AT_TILE + (16 * nt + fr) * AT_STRIDE + (32 * ks + 8 * fq) * 2);
                    S[0][nt] = mfma16(kf, qf[0][ks], S[0][nt]); S[1][nt] = mfma16(kf, qf[1][ks], S[1][nt]); }
            f32x4 bk[4], rk[4];
#pragma unroll
            for (int nt = 0; nt < 4; ++nt) { bk[nt] = *(const LAS f32x4*)(CUM + 64 * i + 16 * nt + 4 * fq); rk[nt] = *(const LAS f32x4*)(RSK + buf * 64 + 16 * nt + 4 * fq); }
            const bool need_mask = (i == 3) || (64 * i + 63 > ubase);
            bf16x8 pb[2][2];
#pragma unroll
            for (int m = 0; m < 2; ++m) {
                const int uq = ubase + 16 * m + fr;
                float mx = -__builtin_inff();
#pragma unroll
                for (int nt = 0; nt < 4; ++nt)
#pragma unroll
                    for (int g = 0; g < 4; ++g) { float sv = S[m][nt][g] * rk[nt][g] + (bq[m] - bk[nt][g]);
                        if (need_mask) { const int uk = 64 * i + 16 * nt + 4 * fq + g; if (uk > uq || uk < 240) sv = -__builtin_inff(); }
                        S[m][nt][g] = sv; mx = fmaxf(mx, sv); }
                mx = fmaxf(mx, __shfl_xor(mx, 16)); mx = fmaxf(mx, __shfl_xor(mx, 32));
                const float mn = fmaxf(mrow[m], mx);
                const float alpha = __builtin_amdgcn_exp2f(mrow[m] - mn); mrow[m] = mn;
                float ps = 0.f;
#pragma unroll
                for (int nt = 0; nt < 4; ++nt)
#pragma unroll
                    for (int g = 0; g < 4; ++g) { const float p = __builtin_amdgcn_exp2f(S[m][nt][g] - mn); ps += p; S[m][nt][g] = p; }
                lrow[m] = lrow[m] * alpha + ps;
                if (!__all(alpha == 1.0f)) {
#pragma unroll
                    for (int dt = 0; dt < 8; ++dt) O[m][dt] *= alpha; }
#pragma unroll
                for (int k2 = 0; k2 < 2; ++k2) { v4u pw; pw.x = pk2(S[m][2 * k2][0], S[m][2 * k2][1]); pw.y = pk2(S[m][2 * k2][2], S[m][2 * k2][3]); pw.z = pk2(S[m][2 * k2 + 1][0], S[m][2 * k2 + 1][1]); pw.w = pk2(S[m][2 * k2 + 1][2], S[m][2 * k2 + 1][3]);
                    pb[m][k2] = __builtin_bit_cast(bf16x8, pw); }
            }
            const unsigned vb = vbase + (unsigned)(buf * AT_TILE);
            { v2u vp[16]; asm volatile("ds_read_b64_tr_b16 %0, %16 offset:0 \n\tds_read_b64_tr_b16 %1, %16 offset:4352 \n\tds_read_b64_tr_b16 %2, %16 offset:8704 \n\tds_read_b64_tr_b16 %3, %16 offset:13056 \n\tds_read_b64_tr_b16 %4, %16 offset:32 \n\tds_read_b64_tr_b16 %5, %16 offset:4384 \n\tds_read_b64_tr_b16 %6, %16 offset:8736 \n\tds_read_b64_tr_b16 %7, %16 offset:13088 \n\tds_read_b64_tr_b16 %8, %16 offset:64 \n\tds_read_b64_tr_b16 %9, %16 offset:4416 \n\tds_read_b64_tr_b16 %10, %16 offset:8768 \n\tds_read_b64_tr_b16 %11, %16 offset:13120 \n\tds_read_b64_tr_b16 %12, %16 offset:96 \n\tds_read_b64_tr_b16 %13, %16 offset:4448 \n\tds_read_b64_tr_b16 %14, %16 offset:8800 \n\tds_read_b64_tr_b16 %15, %16 offset:13152 \n\ts_waitcnt lgkmcnt(0)" : "=&v"(vp[0]), "=&v"(vp[1]), "=&v"(vp[2]), "=&v"(vp[3]), "=&v"(vp[4]), "=&v"(vp[5]), "=&v"(vp[6]), "=&v"(vp[7]), "=&v"(vp[8]), "=&v"(vp[9]), "=&v"(vp[10]), "=&v"(vp[11]), "=&v"(vp[12]), "=&v"(vp[13]), "=&v"(vp[14]), "=&v"(vp[15]) : "v"(vb) : "memory");
              { v4u aw; aw.x = vp[0].x; aw.y = vp[0].y; aw.z = vp[1].x; aw.w = vp[1].y; const bf16x8 vfr = __builtin_bit_cast(bf16x8, aw); O[0][0] = mfma16(vfr, pb[0][0], O[0][0]); O[1][0] = mfma16(vfr, pb[1][0], O[1][0]); }
              { v4u aw; aw.x = vp[2].x; aw.y = vp[2].y; aw.z = vp[3].x; aw.w = vp[3].y; const bf16x8 vfr = __builtin_bit_cast(bf16x8, aw); O[0][0] = mfma16(vfr, pb[0][1], O[0][0]); O[1][0] = mfma16(vfr, pb[1][1], O[1][0]); }
              { v4u aw; aw.x = vp[4].x; aw.y = vp[4].y; aw.z = vp[5].x; aw.w = vp[5].y; const bf16x8 vfr = __builtin_bit_cast(bf16x8, aw); O[0][1] = mfma16(vfr, pb[0][0], O[0][1]); O[1][1] = mfma16(vfr, pb[1][0], O[1][1]); }
              { v4u aw; aw.x = vp[6].x; aw.y = vp[6].y; aw.z = vp[7].x; aw.w = vp[7].y; const bf16x8 vfr = __builtin_bit_cast(bf16x8, aw); O[0][1] = mfma16(vfr, pb[0][1], O[0][1]); O[1][1] = mfma16(vfr, pb[1][1], O[1][1]); }
              { v4u aw; aw.x = vp[8].x; aw.y = vp[8].y; aw.z = vp[9].x; aw.w = vp[9].y; const bf16x8 vfr = __builtin_bit_cast(bf16x8, aw); O[0][2] = mfma16(vfr, pb[0][0], O[0][2]); O[1][2] = mfma16(vfr, pb[1][0], O[1][2]); }
              { v4u aw; aw.x = vp[10].x; aw.y = vp[10].y; aw.z = vp[11].x; aw.w = vp[11].y; const bf16x8 vfr = __builtin_bit_cast(bf16x8, aw); O[0][2] = mfma16(vfr, pb[0][1], O[0][2]); O[1][2] = mfma16(vfr, pb[1][1], O[1][2]); }
              { v4u aw; aw.x = vp[12].x; aw.y = vp[12].y; aw.z = vp[13].x; aw.w = vp[13].y; const bf16x8 vfr = __builtin_bit_cast(bf16x8, aw); O[0][3] = mfma16(vfr, pb[0][0], O[0][3]); O[1][3] = mfma16(vfr, pb[1][0], O[1][3]); }
              { v4u aw; aw.x = vp[14].x; aw.y = vp[14].y; aw.z = vp[15].x; aw.w = vp[15].y; const bf16x8 vfr = __builtin_bit_cast(bf16x8, aw); O[0][3] = mfma16(vfr, pb[0][1], O[0][3]); O[1][3] = mfma16(vfr, pb[1][1], O[1][3]); }
            }
            { v2u vp[16]; asm volatile("ds_read_b64_tr_b16 %0, %16 offset:128 \n\tds_read_b64_tr_b16 %1, %16 offset:4480 \n\tds_read_b64_tr_b16 %2, %16 offset:8832 \n\tds_read_b64_tr_b16 %3, %16 offset:13184 \n\tds_read_b64_tr_b16 %4, %16 offset:160 \n\tds_read_b64_tr_b16 %5, %16 offset:4512 \n\tds_read_b64_tr_b16 %6, %16 offset:8864 \n\tds_read_b64_tr_b16 %7, %16 offset:13216 \n\tds_read_b64_tr_b16 %8, %16 offset:192 \n\tds_read_b64_tr_b16 %9, %16 offset:4544 \n\tds_read_b64_tr_b16 %10, %16 offset:8896 \n\tds_read_b64_tr_b16 %11, %16 offset:13248 \n\tds_read_b64_tr_b16 %12, %16 offset:224 \n\tds_read_b64_tr_b16 %13, %16 offset:4576 \n\tds_read_b64_tr_b16 %14, %16 offset:8928 \n\tds_read_b64_tr_b16 %15, %16 offset:13280 \n\ts_waitcnt lgkmcnt(0)" : "=&v"(vp[0]), "=&v"(vp[1]), "=&v"(vp[2]), "=&v"(vp[3]), "=&v"(vp[4]), "=&v"(vp[5]), "=&v"(vp[6]), "=&v"(vp[7]), "=&v"(vp[8]), "=&v"(vp[9]), "=&v"(vp[10]), "=&v"(vp[11]), "=&v"(vp[12]), "=&v"(vp[13]), "=&v"(vp[14]), "=&v"(vp[15]) : "v"(vb) : "memory");
              { v4u aw; aw.x = vp[0].x; aw.y = vp[0].y; aw.z = vp[1].x; aw.w = vp[1].y; const bf16x8 vfr = __builtin_bit_cast(bf16x8, aw); O[0][4] = mfma16(vfr, pb[0][0], O[0][4]); O[1][4] = mfma16(vfr, pb[1][0], O[1][4]); }
              { v4u aw; aw.x = vp[2].x; aw.y = vp[2].y; aw.z = vp[3].x; aw.w = vp[3].y; const bf16x8 vfr = __builtin_bit_cast(bf16x8, aw); O[0][4] = mfma16(vfr, pb[0][1], O[0][4]); O[1][4] = mfma16(vfr, pb[1][1], O[1][4]); }
              { v4u aw; aw.x = vp[4].x; aw.y = vp[4].y; aw.z = vp[5].x; aw.w = vp[5].y; const bf16x8 vfr = __builtin_bit_cast(bf16x8, aw); O[0][5] = mfma16(vfr, pb[0][0], O[0][5]); O[1][5] = mfma16(vfr, pb[1][0], O[1][5]); }
              { v4u aw; aw.x = vp[6].x; aw.y = vp[6].y; aw.z = vp[7].x; aw.w = vp[7].y; const bf16x8 vfr = __builtin_bit_cast(bf16x8, aw); O[0][5] = mfma16(vfr, pb[0][1], O[0][5]); O[1][5] = mfma16(vfr, pb[1][1], O[1][5]); }
              { v4u aw; aw.x = vp[8].x; aw.y = vp[8].y; aw.z = vp[9].x; aw.w = vp[9].y; const bf16x8 vfr = __builtin_bit_cast(bf16x8, aw); O[0][6] = mfma16(vfr, pb[0][0], O[0][6]); O[1][6] = mfma16(vfr, pb[1][0], O[1][6]); }
              { v4u aw; aw.x = vp[10].x; aw.y = vp[10].y; aw.z = vp[11].x; aw.w = vp[11].y; const bf16x8 vfr = __builtin_bit_cast(bf16x8, aw); O[0][6] = mfma16(vfr, pb[0][1], O[0][6]); O[1][6] = mfma16(vfr, pb[1][1], O[1][6]); }
              { v4u aw; aw.x = vp[12].x; aw.y = vp[12].y; aw.z = vp[13].x; aw.w = vp[13].y; const bf16x8 vfr = __builtin_bit_cast(bf16x8, aw); O[0][7] = mfma16(vfr, pb[0][0], O[0][7]); O[1][7] = mfma16(vfr, pb[1][0], O[1][7]); }
              { v4u aw; aw.x = vp[14].x; aw.y = vp[14].y; aw.z = vp[15].x; aw.w = vp[15].y; const bf16x8 vfr = __builtin_bit_cast(bf16x8, aw); O[0][7] = mfma16(vfr, pb[0][1], O[0][7]); O[1][7] = mfma16(vfr, pb[1][1], O[1][7]); }
            }
        }
        __syncthreads();
    }
#undef AT_LOAD
#undef AT_STAGE
#pragma unroll
    for (int m = 0; m < 2; ++m) {
        float l = lrow[m]; l += __shfl_xor(l, 16); l += __shfl_xor(l, 32);
        const int t = ubase + 16 * m + fr - 240;
        if (t >= 0) { const float il = 1.0f / l; bf16* op = y0 + (size_t)row_of(b, t) * DM + LRU_W + 128 * h + 4 * fq;
#pragma unroll
            for (int dt = 0; dt < 8; ++dt) { v2u o; o.x = pk2(O[m][dt][0] * il, O[m][dt][1] * il); o.y = pk2(O[m][dt][2] * il, O[m][dt][3] * il); *(GAS v2u*)(op + 16 * dt) = o; } }
    }
}

__device__ __forceinline__ int p2_fetch(Frame& F, gu32* qctr) {
    if (F.tid == 0) F.MISC[0] = __hip_atomic_fetch_add(qctr, 1u, RLX_AGENT);
    __syncthreads();
    const int item = (int)F.MISC[0];
    __syncthreads();
    return item;
}
__device__ __forceinline__ void p2_mixer0(Frame& F, const Args& A, int rep) {
    gu32* qctr = (gu32*)(F.ws + WS_CTL) + CW_Q2 + 64 * rep;
    constexpr int N_LRU = NB * 16, N_ATT = NB * FOX_H * 17;
    constexpr int RB = (N_ATT / 3) < (N_CONV / 2) ? (N_ATT / 3) : (N_CONV / 2), REM_ATT = N_ATT - 3 * RB, REM_CONV = N_CONV - 2 * RB;
    int item = p2_fetch(F, qctr);
    while (item < N_LRU) { lru_item(F, A, item >> 4, item & 15); item = p2_fetch(F, qctr); }
    while (item < N_LRU + N_ATT + N_CONV) {
        const int y = item - N_LRU; int att = -1, cv = -1;
        if (y < 5 * RB) { const int blk = y / 5, sl = y - 5 * blk; if (sl == 1 || sl == 3) cv = 2 * blk + (sl >> 1); else att = 3 * blk + (sl >> 1); }
        else { const int y2 = y - 5 * RB; if (y2 < REM_ATT) att = 3 * RB + y2; else cv = 2 * RB + (y2 - REM_ATT); }
        if (rep != 0) cv = -2;
        Frame G = F; { int tz = F.tid; asm volatile("" : "+v"(tz)); G.tid = tz; G.lane = tz & 63; G.wave = __builtin_amdgcn_readfirstlane(tz >> 6); }
        if (att >= 0) { const int j = 16 - att / 64, bh = att % 64; attn_item(G, A, bh >> 4, bh & 15, j); }
        else if (cv >= 0) { const ConvPtrs CP{A.in[20], A.in[21], A.in[22], A.in[16], A.in[18], A.in[19], A.in[15]}; conv_item(G.ws, G.lds, CP, cv, G.wave, G.lane); }
        item = p2_fetch(F, qctr);
    }
}

constexpr int RT_SQ = 528, RT_SV = 272, RT_SS_STRIDE = 144;
constexpr int RT_QS = 0, RT_KN = 33792, RT_VN = 67584, RT_VS = 84992, RT_SS = 102400;
static_assert(RT_KN == 64 * RT_SQ && RT_VN == RT_KN + 64 * RT_SQ && RT_VS == RT_VN + 64 * RT_SV && RT_SS == RT_VS + 64 * RT_SV && RT_SS + 64 * RT_SS_STRIDE <= MISC_OFF, "retention LDS map");
__device__ __forceinline__ int ret_row(int b, int c, int idx) { return c == 0 ? (idx < 48 ? -1 : MMETA + NMETA * b + (idx - 48)) : b * SEQ + 64 * (c - 1) + idx; }
__device__ __forceinline__ void ret_item(Frame& F, const Args& A, int b, int h, int es, bool accum) {
    const bf16* z1 = (const bf16*)(F.ws + WS_Z); bf16* ob = (bf16*)(F.ws + WS_Y1); float* ssqo = (float*)(F.ws + WS_SSQO);
    const int tid = F.tid, lane = F.lane, w = F.wave, fr = lane & 15, fq = lane >> 4;
    LAS unsigned char* lds = F.lds;
    const float lg = log1pf(-exp2f(-5.0f - (float)h)) * 1.4426950408889634f;
    const float cdec = __builtin_amdgcn_exp2f(lg * 64.0f);
    f32x4 Sacc[16];
#pragma unroll
    for (int dt = 0; dt < 16; ++dt) Sacc[dt] = (f32x4){0.f, 0.f, 0.f, 0.f};
    const int qrow = tid >> 5, qd = (tid & 31) * 8;
    const int vrow = tid >> 4, ve = (tid & 15) * 8;
    const float kd0 = __builtin_amdgcn_exp2f(lg * (float)(63 - vrow)), kd1 = __builtin_amdgcn_exp2f(lg * (float)(31 - vrow));
    const unsigned lbase = (unsigned)(size_t)lds;
    const unsigned trq = (unsigned)((lane & 15) >> 2), trp = (unsigned)(lane & 3);
    const unsigned kbase = lbase + RT_KN + (8u * fq + trq) * RT_SQ + 8u * trp;
    const unsigned vbase = lbase + RT_VN + (8u * fq + trq) * RT_SV + 32u * w + 8u * trp;
    const unsigned vsbase = vbase + (RT_VS - RT_VN);
    v4u qreg[4], kreg[4], vreg[2];
    const size_t qcol = (size_t)h * RET_QK + qd, kcol = 4096 + (size_t)h * RET_QK + qd, vcol = 8192 + (size_t)h * RET_V + 128 * es + ve;
#define RT_PREFETCH(c) do { \
        _Pragma("unroll") for (int k = 0; k < 4; ++k) { const int r = ret_row(b, (c), qrow + 16 * k); \
            if (r >= 0) { qreg[k] = *(const GAS v4u*)(z1 + (size_t)r * RET_IN + qcol); kreg[k] = *(const GAS v4u*)(z1 + (size_t)r * RET_IN + kcol); } \
            else { qreg[k] = (v4u){0u, 0u, 0u, 0u}; kreg[k] = (v4u){0u, 0u, 0u, 0u}; } } \
        _Pragma("unroll") for (int k = 0; k < 2; ++k) { const int r = ret_row(b, (c), vrow + 32 * k); \
            if (r >= 0) vreg[k] = *(const GAS v4u*)(z1 + (size_t)r * RET_IN + vcol); else vreg[k] = (v4u){0u, 0u, 0u, 0u}; } } while (0)
    RT_PREFETCH(0);
    for (int c = 0; c < 65; ++c) {
        __syncthreads();
#pragma unroll
        for (int k = 0; k < 4; ++k) { const int m = qrow + 16 * k;
            *(LAS v4u*)(lds + RT_QS + m * RT_SQ + qd * 2) = qreg[k];
            *(LAS v4u*)(lds + RT_KN + m * RT_SQ + qd * 2) = kreg[k]; }
#pragma unroll
        for (int k = 0; k < 2; ++k) { const int m = vrow + 32 * k; float vf8[8]; unpack8(vreg[k], vf8); const float kd = k == 0 ? kd0 : kd1;
            *(LAS v4u*)(lds + RT_VN + m * RT_SV + ve * 2) = vreg[k];
#pragma unroll
            for (int e = 0; e < 8; ++e) vf8[e] *= kd;
            *(LAS v4u*)(lds + RT_VS + m * RT_SV + ve * 2) = pack8f(vf8); }
        __syncthreads();
        if (c < 64) RT_PREFETCH(c + 1);
        { const int it = w >> 1, mt0 = 2 * (w & 1);
          f32x4 sacc[2] = {(f32x4){0.f, 0.f, 0.f, 0.f}, (f32x4){0.f, 0.f, 0.f, 0.f}};
#pragma unroll
          for (int ks = 0; ks < 8; ++ks) { const bf16x8 a = *(const LAS bf16x8*)(lds + RT_QS + (16 * it + fr) * RT_SQ + (32 * ks + 8 * fq) * 2);
#pragma unroll
              for (int q = 0; q < 2; ++q) { const bf16x8 kb = *(const LAS bf16x8*)(lds + RT_KN + (16 * (mt0 + q) + fr) * RT_SQ + (32 * ks + 8 * fq) * 2); sacc[q] = mfma16(a, kb, sacc[q]); } }
#pragma unroll
          for (int q = 0; q < 2; ++q)
#pragma unroll
              for (int g = 0; g < 4; ++g) { const int i = 16 * it + 4 * fq + g, m = 16 * (mt0 + q) + fr; const int dd = i > m ? i - m : m - i;
                  const float sv = sacc[q][g] * __builtin_amdgcn_exp2f(lg * (float)dd);
                  *(LAS unsigned short*)(lds + RT_SS + i * RT_SS_STRIDE + m * 2) = (unsigned short)(pk2(sv, 0.f) & 0xffffu); } }
        __syncthreads();
        f32x4 acc[4];
#pragma unroll
        for (int mi = 0; mi < 4; ++mi) acc[mi] = (f32x4){0.f, 0.f, 0.f, 0.f};
#pragma unroll
        for (int kk = 0; kk < 8; ++kk) {
            v4u bw; bw.x = pk2(Sacc[2 * kk][0], Sacc[2 * kk][1]); bw.y = pk2(Sacc[2 * kk][2], Sacc[2 * kk][3]); bw.z = pk2(Sacc[2 * kk + 1][0], Sacc[2 * kk + 1][1]); bw.w = pk2(Sacc[2 * kk + 1][2], Sacc[2 * kk + 1][3]);
            const bf16x8 bfrag = __builtin_bit_cast(bf16x8, bw);
#pragma unroll
            for (int mi = 0; mi < 4; ++mi) { const LAS unsigned char* qp = lds + RT_QS + (16 * mi + fr) * RT_SQ + (32 * kk + 4 * fq) * 2;
                const v2u lo = *(const LAS v2u*)(qp), hi = *(const LAS v2u*)(qp + 32);
                v4u aw; aw.x = lo.x; aw.y = lo.y; aw.z = hi.x; aw.w = hi.y;
                acc[mi] = mfma16(__builtin_bit_cast(bf16x8, aw), bfrag, acc[mi]); } }
#pragma unroll
        for (int mi = 0; mi < 4; ++mi)
#pragma unroll
            for (int g = 0; g < 4; ++g) acc[mi][g] *= __builtin_amdgcn_exp2f(lg * (float)(16 * mi + 4 * fq + g + 1));
        v2u vp[8];
        asm volatile("ds_read_b64_tr_b16 %0, %4 offset:0 \n\tds_read_b64_tr_b16 %1, %4 offset:1088 \n\tds_read_b64_tr_b16 %2, %4 offset:8704 \n\tds_read_b64_tr_b16 %3, %4 offset:9792 \n\ts_waitcnt lgkmcnt(0)" : "=&v"(vp[0]), "=&v"(vp[1]), "=&v"(vp[2]), "=&v"(vp[3]) : "v"(vbase) : "memory");
        asm volatile("ds_read_b64_tr_b16 %0, %4 offset:0 \n\tds_read_b64_tr_b16 %1, %4 offset:1088 \n\tds_read_b64_tr_b16 %2, %4 offset:8704 \n\tds_read_b64_tr_b16 %3, %4 offset:9792 \n\ts_waitcnt lgkmcnt(0)" : "=&v"(vp[4]), "=&v"(vp[5]), "=&v"(vp[6]), "=&v"(vp[7]) : "v"(vsbase) : "memory");
        bf16x8 vf[2], vs[2];
        { v4u t0; t0.x = vp[0].x; t0.y = vp[0].y; t0.z = vp[1].x; t0.w = vp[1].y; vf[0] = __builtin_bit_cast(bf16x8, t0); v4u t1; t1.x = vp[4].x; t1.y = vp[4].y; t1.z = vp[5].x; t1.w = vp[5].y; vs[0] = __builtin_bit_cast(bf16x8, t1); }
        { v4u t0; t0.x = vp[2].x; t0.y = vp[2].y; t0.z = vp[3].x; t0.w = vp[3].y; vf[1] = __builtin_bit_cast(bf16x8, t0); v4u t1; t1.x = vp[6].x; t1.y = vp[6].y; t1.z = vp[7].x; t1.w = vp[7].y; vs[1] = __builtin_bit_cast(bf16x8, t1); }
#pragma unroll
        for (int mi = 0; mi < 4; ++mi)
#pragma unroll
            for (int k2 = 0; k2 < 2; ++k2) { const bf16x8 a = *(const LAS bf16x8*)(lds + RT_SS + (16 * mi + fr) * RT_SS_STRIDE + (32 * k2 + 8 * fq) * 2); acc[mi] = mfma16(a, vf[k2], acc[mi]); }
        if (c > 0) {
#pragma unroll
            for (int mi = 0; mi < 4; ++mi)
#pragma unroll
                for (int g = 0; g < 4; ++g) { const int r = b * SEQ + 64 * (c - 1) + 16 * mi + 4 * fq + g; const float v = acc[mi][g];
                    ob[(size_t)r * RET_VW + h * RET_V + 128 * es + 16 * w + fr] = (bf16)(pk2(v, 0.f) & 0xffffu);
                    float sq = v * v; sq += __shfl_xor(sq, 1); sq += __shfl_xor(sq, 2); sq += __shfl_xor(sq, 4); sq += __shfl_xor(sq, 8);
                    if (fr == 0 && accum) atomicAdd(ssqo + (size_t)r * 16 + h, sq); }
        }
#pragma unroll
        for (int dt = 0; dt < 16; ++dt) Sacc[dt] *= cdec;
        { v2u kp[16]; asm volatile("ds_read_b64_tr_b16 %0, %16 offset:0 \n\tds_read_b64_tr_b16 %1, %16 offset:2112 \n\tds_read_b64_tr_b16 %2, %16 offset:16896 \n\tds_read_b64_tr_b16 %3, %16 offset:19008 \n\tds_read_b64_tr_b16 %4, %16 offset:32 \n\tds_read_b64_tr_b16 %5, %16 offset:2144 \n\tds_read_b64_tr_b16 %6, %16 offset:16928 \n\tds_read_b64_tr_b16 %7, %16 offset:19040 \n\tds_read_b64_tr_b16 %8, %16 offset:64 \n\tds_read_b64_tr_b16 %9, %16 offset:2176 \n\tds_read_b64_tr_b16 %10, %16 offset:16960 \n\tds_read_b64_tr_b16 %11, %16 offset:19072 \n\tds_read_b64_tr_b16 %12, %16 offset:96 \n\tds_read_b64_tr_b16 %13, %16 offset:2208 \n\tds_read_b64_tr_b16 %14, %16 offset:16992 \n\tds_read_b64_tr_b16 %15, %16 offset:19104 \n\ts_waitcnt lgkmcnt(0)" : "=&v"(kp[0]), "=&v"(kp[1]), "=&v"(kp[2]), "=&v"(kp[3]), "=&v"(kp[4]), "=&v"(kp[5]), "=&v"(kp[6]), "=&v"(kp[7]), "=&v"(kp[8]), "=&v"(kp[9]), "=&v"(kp[10]), "=&v"(kp[11]), "=&v"(kp[12]), "=&v"(kp[13]), "=&v"(kp[14]), "=&v"(kp[15]) : "v"(kbase) : "memory");
          { v4u aw; aw.x = kp[0].x; aw.y = kp[0].y; aw.z = kp[1].x; aw.w = kp[1].y; Sacc[0] = mfma16(__builtin_bit_cast(bf16x8, aw), vs[0], Sacc[0]); }
          { v4u aw; aw.x = kp[2].x; aw.y = kp[2].y; aw.z = kp[3].x; aw.w = kp[3].y; Sacc[0] = mfma16(__builtin_bit_cast(bf16x8, aw), vs[1], Sacc[0]); }
          { v4u aw; aw.x = kp[4].x; aw.y = kp[4].y; aw.z = kp[5].x; aw.w = kp[5].y; Sacc[1] = mfma16(__builtin_bit_cast(bf16x8, aw), vs[0], Sacc[1]); }
          { v4u aw; aw.x = kp[6].x; aw.y = kp[6].y; aw.z = kp[7].x; aw.w = kp[7].y; Sacc[1] = mfma16(__builtin_bit_cast(bf16x8, aw), vs[1], Sacc[1]); }
          { v4u aw; aw.x = kp[8].x; aw.y = kp[8].y; aw.z = kp[9].x; aw.w = kp[9].y; Sacc[2] = mfma16(__builtin_bit_cast(bf16x8, aw), vs[0], Sacc[2]); }
          { v4u aw; aw.x = kp[10].x; aw.y = kp[10].y; aw.z = kp[11].x; aw.w = kp[11].y; Sacc[2] = mfma16(__builtin_bit_cast(bf16x8, aw), vs[1], Sacc[2]); }
          { v4u aw; aw.x = kp[12].x; aw.y = kp[12].y; aw.z = kp[13].x; aw.w = kp[13].y; Sacc[3] = mfma16(__builtin_bit_cast(bf16x8, aw), vs[0], Sacc[3]); }
          { v4u aw; aw.x = kp[14].x; aw.y = kp[14].y; aw.z = kp[15].x; aw.w = kp[15].y; Sacc[3] = mfma16(__builtin_bit_cast(bf16x8, aw), vs[1], Sacc[3]); }
        }
        { v2u kp[16]; asm volatile("ds_read_b64_tr_b16 %0, %16 offset:128 \n\tds_read_b64_tr_b16 %1, %16 offset:2240 \n\tds_read_b64_tr_b16 %2, %16 offset:17024 \n\tds_read_b64_tr_b16 %3, %16 offset:19136 \n\tds_read_b64_tr_b16 %4, %16 offset:160 \n\tds_read_b64_tr_b16 %5, %16 offset:2272 \n\tds_read_b64_tr_b16 %6, %16 offset:17056 \n\tds_read_b64_tr_b16 %7, %16 offset:19168 \n\tds_read_b64_tr_b16 %8, %16 offset:192 \n\tds_read_b64_tr_b16 %9, %16 offset:2304 \n\tds_read_b64_tr_b16 %10, %16 offset:17088 \n\tds_read_b64_tr_b16 %11, %16 offset:19200 \n\tds_read_b64_tr_b16 %12, %16 offset:224 \n\tds_read_b64_tr_b16 %13, %16 offset:2336 \n\tds_read_b64_tr_b16 %14, %16 offset:17120 \n\tds_read_b64_tr_b16 %15, %16 offset:19232 \n\ts_waitcnt lgkmcnt(0)" : "=&v"(kp[0]), "=&v"(kp[1]), "=&v"(kp[2]), "=&v"(kp[3]), "=&v"(kp[4]), "=&v"(kp[5]), "=&v"(kp[6]), "=&v"(kp[7]), "=&v"(kp[8]), "=&v"(kp[9]), "=&v"(kp[10]), "=&v"(kp[11]), "=&v"(kp[12]), "=&v"(kp[13]), "=&v"(kp[14]), "=&v"(kp[15]) : "v"(kbase) : "memory");
          { v4u aw; aw.x = kp[0].x; aw.y = kp[0].y; aw.z = kp[1].x; aw.w = kp[1].y; Sacc[4] = mfma16(__builtin_bit_cast(bf16x8, aw), vs[0], Sacc[4]); }
          { v4u aw; aw.x = kp[2].x; aw.y = kp[2].y; aw.z = kp[3].x; aw.w = kp[3].y; Sacc[4] = mfma16(__builtin_bit_cast(bf16x8, aw), vs[1], Sacc[4]); }
          { v4u aw; aw.x = kp[4].x; aw.y = kp[4].y; aw.z = kp[5].x; aw.w = kp[5].y; Sacc[5] = mfma16(__builtin_bit_cast(bf16x8, aw), vs[0], Sacc[5]); }
          { v4u aw; aw.x = kp[6].x; aw.y = kp[6].y; aw.z = kp[7].x; aw.w = kp[7].y; Sacc[5] = mfma16(__builtin_bit_cast(bf16x8, aw), vs[1], Sacc[5]); }
          { v4u aw; aw.x = kp[8].x; aw.y = kp[8].y; aw.z = kp[9].x; aw.w = kp[9].y; Sacc[6] = mfma16(__builtin_bit_cast(bf16x8, aw), vs[0], Sacc[6]); }
          { v4u aw; aw.x = kp[10].x; aw.y = kp[10].y; aw.z = kp[11].x; aw.w = kp[11].y; Sacc[6] = mfma16(__builtin_bit_cast(bf16x8, aw), vs[1], Sacc[6]); }
          { v4u aw; aw.x = kp[12].x; aw.y = kp[12].y; aw.z = kp[13].x; aw.w = kp[13].y; Sacc[7] = mfma16(__builtin_bit_cast(bf16x8, aw), vs[0], Sacc[7]); }
          { v4u aw; aw.x = kp[14].x; aw.y = kp[14].y; aw.z = kp[15].x; aw.w = kp[15].y; Sacc[7] = mfma16(__builtin_bit_cast(bf16x8, aw), vs[1], Sacc[7]); }
        }
        { v2u kp[16]; asm volatile("ds_read_b64_tr_b16 %0, %16 offset:256 \n\tds_read_b64_tr_b16 %1, %16 offset:2368 \n\tds_read_b64_tr_b16 %2, %16 offset:17152 \n\tds_read_b64_tr_b16 %3, %16 offset:19264 \n\tds_read_b64_tr_b16 %4, %16 offset:288 \n\tds_read_b64_tr_b16 %5, %16 offset:2400 \n\tds_read_b64_tr_b16 %6, %16 offset:17184 \n\tds_read_b64_tr_b16 %7, %16 offset:19296 \n\tds_read_b64_tr_b16 %8, %16 offset:320 \n\tds_read_b64_tr_b16 %9, %16 offset:2432 \n\tds_read_b64_tr_b16 %10, %16 offset:17216 \n\tds_read_b64_tr_b16 %11, %16 offset:19328 \n\tds_read_b64_tr_b16 %12, %16 offset:352 \n\tds_read_b64_tr_b16 %13, %16 offset:2464 \n\tds_read_b64_tr_b16 %14, %16 offset:17248 \n\tds_read_b64_tr_b16 %15, %16 offset:19360 \n\ts_waitcnt lgkmcnt(0)" : "=&v"(kp[0]), "=&v"(kp[1]), "=&v"(kp[2]), "=&v"(kp[3]), "=&v"(kp[4]), "=&v"(kp[5]), "=&v"(kp[6]), "=&v"(kp[7]), "=&v"(kp[8]), "=&v"(kp[9]), "=&v"(kp[10]), "=&v"(kp[11]), "=&v"(kp[12]), "=&v"(kp[13]), "=&v"(kp[14]), "=&v"(kp[15]) : "v"(kbase) : "memory");
          { v4u aw; aw.x = kp[0].x; aw.y = kp[0].y; aw.z = kp[1].x; aw.w = kp[1].y; Sacc[8] = mfma16(__builtin_bit_cast(bf16x8, aw), vs[0], Sacc[8]); }
          { v4u aw; aw.x = kp[2].x; aw.y = kp[2].y; aw.z = kp[3].x; aw.w = kp[3].y; Sacc[8] = mfma16(__builtin_bit_cast(bf16x8, aw), vs[1], Sacc[8]); }
          { v4u aw; aw.x = kp[4].x; aw.y = kp[4].y; aw.z = kp[5].x; aw.w = kp[5].y; Sacc[9] = mfma16(__builtin_bit_cast(bf16x8, aw), vs[0], Sacc[9]); }
          { v4u aw; aw.x = kp[6].x; aw.y = kp[6].y; aw.z = kp[7].x; aw.w = kp[7].y; Sacc[9] = mfma16(__builtin_bit_cast(bf16x8, aw), vs[1], Sacc[9]); }
          { v4u aw; aw.x = kp[8].x; aw.y = kp[8].y; aw.z = kp[9].x; aw.w = kp[9].y; Sacc[10] = mfma16(__builtin_bit_cast(bf16x8, aw), vs[0], Sacc[10]); }
          { v4u aw; aw.x = kp[10].x; aw.y = kp[10].y; aw.z = kp[11].x; aw.w = kp[11].y; Sacc[10] = mfma16(__builtin_bit_cast(bf16x8, aw), vs[1], Sacc[10]); }
          { v4u aw; aw.x = kp[12].x; aw.y = kp[12].y; aw.z = kp[13].x; aw.w = kp[13].y; Sacc[11] = mfma16(__builtin_bit_cast(bf16x8, aw), vs[0], Sacc[11]); }
          { v4u aw; aw.x = kp[14].x; aw.y = kp[14].y; aw.z = kp[15].x; aw.w = kp[15].y; Sacc[11] = mfma16(__builtin_bit_cast(bf16x8, aw), vs[1], Sacc[11]); }
        }
        { v2u kp[16]; asm volatile("ds_read_b64_tr_b16 %0, %16 offset:384 \n\tds_read_b64_tr_b16 %1, %16 offset:2496 \n\tds_read_b64_tr_b16 %2, %16 offset:17280 \n\tds_read_b64_tr_b16 %3, %16 offset:19392 \n\tds_read_b64_tr_b16 %4, %16 offset:416 \n\tds_read_b64_tr_b16 %5, %16 offset:2528 \n\tds_read_b64_tr_b16 %6, %16 offset:17312 \n\tds_read_b64_tr_b16 %7, %16 offset:19424 \n\tds_read_b64_tr_b16 %8, %16 offset:448 \n\tds_read_b64_tr_b16 %9, %16 offset:2560 \n\tds_read_b64_tr_b16 %10, %16 offset:17344 \n\tds_read_b64_tr_b16 %11, %16 offset:19456 \n\tds_read_b64_tr_b16 %12, %16 offset:480 \n\tds_read_b64_tr_b16 %13, %16 offset:2592 \n\tds_read_b64_tr_b16 %14, %16 offset:17376 \n\tds_read_b64_tr_b16 %15, %16 offset:19488 \n\ts_waitcnt lgkmcnt(0)" : "=&v"(kp[0]), "=&v"(kp[1]), "=&v"(kp[2]), "=&v"(kp[3]), "=&v"(kp[4]), "=&v"(kp[5]), "=&v"(kp[6]), "=&v"(kp[7]), "=&v"(kp[8]), "=&v"(kp[9]), "=&v"(kp[10]), "=&v"(kp[11]), "=&v"(kp[12]), "=&v"(kp[13]), "=&v"(kp[14]), "=&v"(kp[15]) : "v"(kbase) : "memory");
          { v4u aw; aw.x = kp[0].x; aw.y = kp[0].y; aw.z = kp[1].x; aw.w = kp[1].y; Sacc[12] = mfma16(__builtin_bit_cast(bf16x8, aw), vs[0], Sacc[12]); }
          { v4u aw; aw.x = kp[2].x; aw.y = kp[2].y; aw.z = kp[3].x; aw.w = kp[3].y; Sacc[12] = mfma16(__builtin_bit_cast(bf16x8, aw), vs[1], Sacc[12]); }
          { v4u aw; aw.x = kp[4].x; aw.y = kp[4].y; aw.z = kp[5].x; aw.w = kp[5].y; Sacc[13] = mfma16(__builtin_bit_cast(bf16x8, aw), vs[0], Sacc[13]); }
          { v4u aw; aw.x = kp[6].x; aw.y = kp[6].y; aw.z = kp[7].x; aw.w = kp[7].y; Sacc[13] = mfma16(__builtin_bit_cast(bf16x8, aw), vs[1], Sacc[13]); }
          { v4u aw; aw.x = kp[8].x; aw.y = kp[8].y; aw.z = kp[9].x; aw.w = kp[9].y; Sacc[14] = mfma16(__builtin_bit_cast(bf16x8, aw), vs[0], Sacc[14]); }
          { v4u aw; aw.x = kp[10].x; aw.y = kp[10].y; aw.z = kp[11].x; aw.w = kp[11].y; Sacc[14] = mfma16(__builtin_bit_cast(bf16x8, aw), vs[1], Sacc[14]); }
          { v4u aw; aw.x = kp[12].x; aw.y = kp[12].y; aw.z = kp[13].x; aw.w = kp[13].y; Sacc[15] = mfma16(__builtin_bit_cast(bf16x8, aw), vs[0], Sacc[15]); }
          { v4u aw; aw.x = kp[14].x; aw.y = kp[14].y; aw.z = kp[15].x; aw.w = kp[15].y; Sacc[15] = mfma16(__builtin_bit_cast(bf16x8, aw), vs[1], Sacc[15]); }
        }
    }
#undef RT_PREFETCH
    __syncthreads();
}
__device__ __forceinline__ void p7_retention(Frame& F, const Args& A, bool accum) {
    for (int item = blockIdx.x; item < NB * RET_H * 4; item += F.G) ret_item(F, A, item >> 6, (item >> 2) & 15, item & 3, accum);
}
__device__ __forceinline__ void p8_gate(Frame& F, const Args& A) {
    const bf16* z1 = (const bf16*)(F.ws + WS_Z); bf16* ob = (bf16*)(F.ws + WS_Y1); const float* ssqo = (const float*)(F.ws + WS_SSQO); const float* gain = A.in[17];
    const int gt = blockIdx.x * NTHREADS + F.tid, nthr = F.G * NTHREADS;
    const int c = (gt & 1023) * 8, hd = c >> 9, rstep = nthr >> 10, r0 = (gt >> 10) < rstep ? (gt >> 10) : MTOK;
    const f32x4 g0 = *(const GAS f32x4*)(gain + c), g1 = *(const GAS f32x4*)(gain + c + 4);
    for (int r = r0; r < MTOK; r += 4 * rstep) {
        v4u gw[4], ow[4]; float ss[4];
#pragma unroll
        for (int k = 0; k < 4; ++k) { const int rr = r + k * rstep; if (rr < MTOK) { gw[k] = *(const GAS v4u*)(z1 + (size_t)rr * RET_IN + 16384 + c); ow[k] = *(const GAS v4u*)(ob + (size_t)rr * RET_VW + c); ss[k] = ssqo[(size_t)rr * 16 + hd]; } }
#pragma unroll
        for (int k = 0; k < 4; ++k) { const int rr = r + k * rstep; if (rr < MTOK) {
            const float rs = 1.0f / sqrtf(ss[k] * (1.0f / 512.0f) + RMS_EPS);
            float gf[8], of[8], y[8]; unpack8(gw[k], gf); unpack8(ow[k], of);
#pragma unroll
            for (int e = 0; e < 8; ++e) { const float gn = e < 4 ? g0[e] : g1[e - 4]; y[e] = gf[e] * sigmoidf_fast(gf[e]) * (of[e] * rs * gn); }
            *(GAS v4u*)(ob + (size_t)rr * RET_VW + c) = pack8f(y); } }
    }
}


__device__ __forceinline__ void meta_fixup(Frame& F, const float* Hmeta, bf16* XB, float* ssq, const float* gain) {
    __syncthreads();
    if (F.MISC[4] != 0u) {
        __builtin_amdgcn_fence(__ATOMIC_ACQUIRE, "agent"); asm volatile("s_waitcnt vmcnt(0)" ::: "memory");
        for (int row = F.wave; row < NB * NMETA; row += NWAVES) { const float* hrow = Hmeta + (size_t)row * DM; bf16* xrow = XB + (size_t)(MTOK + row) * DM; float s = 0.f;
#pragma unroll 4
            for (int j = 0; j < 16; ++j) { const int e = (F.lane + 64 * j) * 4; const f32x4 v = *(const GAS f32x4*)(hrow + e);
                s += (v.x * v.x + v.y * v.y) + (v.z * v.z + v.w * v.w); const f32x4 gn = *(const GAS f32x4*)(gain + e); v2u w; w.x = pk2(v.x * gn.x, v.y * gn.y); w.y = pk2(v.z * gn.z, v.w * gn.w); *(GAS v2u*)(xrow + e) = w; }
            s = wave_sum(s);
            if (F.lane == 0) ssq[MTOK + row] = s; }
        __syncthreads();
        if (F.tid == 0) F.MISC[4] = 0u;
    }
    __syncthreads();
}

__global__ void __launch_bounds__(NTHREADS, 2) hybrid_fwd(Args args) {
    extern __shared__ __attribute__((aligned(16))) unsigned char lds_raw[];
    Frame F;
    F.lds = (LAS unsigned char*)lds_raw;
    F.MISC = (volatile LAS unsigned*)(F.lds + MISC_OFF);
    F.tid = threadIdx.x; F.lane = F.tid & 63; F.wave = __builtin_amdgcn_readfirstlane(F.tid >> 6);
    F.G = gridDim.x; F.ws = args.ws;
    if (F.tid < 64) F.MISC[F.tid] = 0u;
    __syncthreads();
    unsigned* ctl = (unsigned*)(F.ws + WS_CTL);
#if !MK_PER_PHASE
    const XcdBarrier bar = xcd_barrier_post(ctl + CW_BAR, F.MISC + 8);
#define GRID_BAR() xcd_barrier(bar)
#else
#define GRID_BAR() do { } while (0)
#endif
    const int lo = args.ph_lo, hi = args.ph_hi;
#ifndef PHASE_MASK
#define PHASE_MASK 0xFFF
#endif
#define IN(k) ((((PHASE_MASK) >> (k)) & 1) && lo <= (k) && (k) < hi)
#define BOTH(k) (IN(k) && IN((k) + 1))
#ifndef REPEAT_MASK
#define REPEAT_MASK 0
#endif
#define REPS(k) (1 + (((REPEAT_MASK) >> (k)) & 1))
    unsigned char* ws = F.ws;
    bf16* XB = (bf16*)(ws + WS_XB); float* Htok = args.out; float* Hmeta = (float*)(ws + WS_HMETA); bf16* Z = (bf16*)(ws + WS_Z); bf16* Y0 = (bf16*)(ws + WS_Y0); bf16* Y1 = (bf16*)(ws + WS_Y1);
    float* SSQ0 = (float*)(ws + WS_SSQ0); float* SSQ1 = (float*)(ws + WS_SSQ1); float* SSQ2 = (float*)(ws + WS_SSQ2); float* SSQ3 = (float*)(ws + WS_SSQ3);
    const int c = (int)blockIdx.x;

    if (IN(0)) { p0_prologue(F, args); if (REPS(0) > 1) p0_prologue(F, args); if (BOTH(0)) GRID_BAR(); }
    if (IN(1)) {
        pg8::Gemm g{XB, (const bf16*)(ws + WS_WIN0), MP, 41 * 256, DM}; pg8::StaticOrder S; S.init(MP, 41 * 256, DM, F.G, c);
        pg8::EpiIn0 E{Z, (float*)(ws + WS_FBUF), SSQ0};
        pg8::gemm_phase<pg8::EpiIn0, pg8::StaticOrder, true, true>(F.lds, g, S, E); if (REPS(1) > 1) { pg8::gemm_phase<pg8::EpiIn0, pg8::StaticOrder, true, true>(F.lds, g, S, E); }
        if (BOTH(1)) GRID_BAR();
    }
    if (IN(2)) { p2_mixer0(F, args, 0); if (REPS(2) > 1) { GRID_BAR(); p2_mixer0(F, args, 1); } if (BOTH(2)) GRID_BAR(); }
    if (IN(3)) {
        pg8::Gemm g{Y0, (const bf16*)(ws + WS_WOUT0), MP, DM, DM}; pg8::SplitMetaOrder S; S.init2(DM, DM, F.G, c, ctl + CW_TK3, F.MISC + 4);
        pg8::EpiRes E{args.in[0], Htok, Hmeta, XB, SSQ1, DM / 64, args.in[19]};
        pg8::gemm_phase<pg8::EpiRes, pg8::SplitMetaOrder, true, true>(F.lds, g, S, E);
        meta_fixup(F, Hmeta, XB, SSQ1, args.in[19]);
        if (BOTH(3)) GRID_BAR();
    }
    if (IN(4)) {
        pg8::Gemm g{XB, (const bf16*)(ws + WS_WGU0), MP, 2 * DFF, DM}; pg8::StaticOrder S; S.init(MP, 2 * DFF, DM, F.G, c);
        pg8::EpiGU E{Z, SSQ1};
        pg8::gemm_phase<pg8::EpiGU, pg8::StaticOrder, true, true>(F.lds, g, S, E); if (REPS(4) > 1) { pg8::gemm_phase<pg8::EpiGU, pg8::StaticOrder, true, true>(F.lds, g, S, E); }
        if (BOTH(4)) GRID_BAR();
    }
    if (IN(5)) {
        pg8::Gemm g{Z, (const bf16*)(ws + WS_WD0), MP, DM, DFF}; pg8::SplitMetaOrder S; S.init2(DM, DFF, F.G, c, ctl + CW_TK5, F.MISC + 4);
        pg8::EpiRes E{Htok, Htok, Hmeta, XB, SSQ2, DFF / 64, args.in[15]};
        pg8::gemm_phase<pg8::EpiRes, pg8::SplitMetaOrder, true, true>(F.lds, g, S, E);
        meta_fixup(F, Hmeta, XB, SSQ2, args.in[15]);
        if (BOTH(5)) GRID_BAR();
    }
    if (IN(6)) {
        pg8::Gemm g{XB, (const bf16*)(ws + WS_WIN1), MP, RET_IN, DM}; pg8::StaticOrder S; S.init(MP, RET_IN, DM, F.G, c);
        pg8::EpiIn1 E{Z, SSQ2};
        pg8::gemm_phase<pg8::EpiIn1, pg8::StaticOrder, true, true>(F.lds, g, S, E); if (REPS(6) > 1) { pg8::gemm_phase<pg8::EpiIn1, pg8::StaticOrder, true, true>(F.lds, g, S, E); }
        if (BOTH(6)) GRID_BAR();
    }
    if (IN(7)) { p7_retention(F, args, true); if (REPS(7) > 1) p7_retention(F, args, false); if (BOTH(7)) GRID_BAR(); }
    if (IN(8)) { p8_gate(F, args); if (BOTH(8)) GRID_BAR(); }
    if (IN(9)) {
        pg8::Gemm g{Y1, (const bf16*)(ws + WS_WOUT1), MTOK, DM, RET_VW}; pg8::StaticOrder S; S.init(MTOK, DM, RET_VW, F.G, c);
        pg8::EpiRes E{Htok, Htok, Hmeta, XB, SSQ3, RET_VW / 64, args.in[19] + DM};
        pg8::gemm_phase<pg8::EpiRes, pg8::StaticOrder, true, true>(F.lds, g, S, E);
        if (BOTH(9)) GRID_BAR();
    }
    if (IN(10)) {
        pg8::Gemm g{XB, (const bf16*)(ws + WS_WGU1), MTOK, 2 * DFF, DM}; pg8::StaticOrder S; S.init(MTOK, 2 * DFF, DM, F.G, c);
        pg8::EpiGU E{Z, SSQ3};
        pg8::gemm_phase<pg8::EpiGU, pg8::StaticOrder, true, true>(F.lds, g, S, E); if (REPS(10) > 1) { pg8::gemm_phase<pg8::EpiGU, pg8::StaticOrder, true, true>(F.lds, g, S, E); }
        if (BOTH(10)) GRID_BAR();
    }
    if (IN(11)) {
        pg8::Gemm g{Z, (const bf16*)(ws + WS_WD1), MTOK, DM, DFF}; pg8::StaticOrder S; S.init(MTOK, DM, DFF, F.G, c);
        pg8::EpiFinal E{args.out};
        pg8::gemm_phase<pg8::EpiFinal, pg8::StaticOrder, true, true>(F.lds, g, S, E);
    }
#undef IN
#undef BOTH
}

extern "C" void kernel_launch(void* const* d_in, const int* in_sizes, int n_in, void* d_out, int out_size, void* d_ws, size_t ws_size, hipStream_t stream) {
    static int grid = 0;
    if (grid == 0) {
        if (n_in != 23 || in_sizes[0] != MTOK * DM || out_size != MTOK * DM || ws_size < WS_END) { fprintf(stderr, "kernel_launch: unexpected shapes (n_in %d, in0 %d, out %d, ws %zu < %zu); nothing launched\n", n_in, n_in > 0 ? in_sizes[0] : -1, out_size, ws_size, (size_t)WS_END); grid = -1; return; }
        int dev = 0, cus = 0, per_cu = 0;
        if (hipGetDevice(&dev) != hipSuccess || hipDeviceGetAttribute(&cus, hipDeviceAttributeMultiprocessorCount, dev) != hipSuccess) { fprintf(stderr, "kernel_launch: device query failed\n"); grid = -1; return; }
        if (hipFuncSetAttribute((const void*)hybrid_fwd, hipFuncAttributeMaxDynamicSharedMemorySize, LDS_BYTES) != hipSuccess) { fprintf(stderr, "kernel_launch: hipFuncSetAttribute failed\n"); grid = -1; return; }
        if (hipOccupancyMaxActiveBlocksPerMultiprocessor(&per_cu, (const void*)hybrid_fwd, NTHREADS, LDS_BYTES) != hipSuccess || per_cu < 1) { fprintf(stderr, "kernel_launch: occupancy query reports %d workgroups per CU\n", per_cu); }
        (void)hipGetLastError();
        grid = cus;
    }
    if (grid < 0) return;
    if (hipMemsetAsync((char*)d_ws + WS_CTL, 0, CTL_ZERO_BYTES, stream) != hipSuccess) { fprintf(stderr, "kernel_launch: memset failed\n"); return; }
    Args a{};
    for (int i = 0; i < 23; ++i) a.in[i] = (const float*)d_in[i];
    a.out = (float*)d_out; a.ws = (unsigned char*)d_ws;
#if MK_PER_PHASE
    for (int p = 0; p < NPHASES; ++p) { a.ph_lo = p; a.ph_hi = p + 1; hipLaunchKernelGGL(hybrid_fwd, dim3(grid), dim3(NTHREADS), LDS_BYTES, stream, a); }
#else
    a.ph_lo = 0; a.ph_hi = NPHASES;
    hipLaunchKernelGGL(hybrid_fwd, dim3(grid), dim3(NTHREADS), LDS_BYTES, stream, a);
#endif
    const hipError_t le = hipPeekAtLastError();
    if (le != hipSuccess) fprintf(stderr, "kernel_launch: launch failed: %s\n", hipGetErrorName(le));
}
```

```cpp
#include <hip/hip_runtime.h>
#include <cstdio>
#include <cstdint>
#ifndef MK_PER_PHASE
#define MK_PER_PHASE 0
#endif
constexpr int DM = 4096, NB = 4, SEQ = 4096, NMETA = 16, LSEQ = NMETA + SEQ;
constexpr int MTOK = NB * SEQ;
constexpr int MMETA = MTOK;
constexpr int MP = 65 * 256;
constexpr int LRU_W = 2048, FOX_H = 16, FOX_D = 128, AB_IN = 10256, AB_Z = 10240;
constexpr int RET_H = 16, RET_QK = 256, RET_V = 512, RET_IN = 24576, RET_VW = 8192;
constexpr int DFF = 11008;
constexpr float RMS_EPS = 1e-6f;
namespace pg8 {
#define PG8_LAS __attribute__((address_space(3)))
typedef unsigned short bf16_t;
typedef short bf16x8 __attribute__((ext_vector_type(8)));
typedef float f32x4 __attribute__((ext_vector_type(4)));
typedef unsigned u32x4 __attribute__((ext_vector_type(4)));
constexpr int BM = 256, BK = 64, HALF = 128, HTB = HALF * BK * 2  , STAGE_BYTES = 8 * HTB, NXCD = 8, WGM = 4;

__host__ __device__ __forceinline__ int lds_byte(int r, int c) { const int st = (r >> 4) * 2 + (c >> 5), rr = r & 15, cc = c & 31, ob = rr * 64 + cc * 2; return st * 1024 + (ob ^ (((ob >> 9) & 1) << 5)); }
__host__ __device__ __forceinline__ void stage_rc(int b, int& R, int& C) { const int st = b / 1024, sb = b % 1024, swz = sb ^ (((sb >> 9) & 1) << 5); R = (st >> 1) * 16 + swz / 64; C = (st & 1) * 32 + (swz % 64) / 2; }
__host__ __device__ __forceinline__ int perm32(int rho) { const int n = rho >> 4, i = rho & 15; return 8 * (i >> 2) + 4 * n + (i & 3); }

struct Unit { int pm, pn, kb, kn; };
struct Gemm { const bf16_t* A; const bf16_t* Bt; int M, N, K; };

struct StaticOrder {
    int nM, nN, nwg, G, c, ntk;
    __host__ __device__ void init(int M, int N, int K, int G_, int c_) { nM = M / BM; nN = N / BM; nwg = nM * nN; G = G_; c = c_; ntk = K / BK; }
    __host__ __device__ bool next(int i, Unit& u) const {
        const long L = (long)i * G + c; if (L >= nwg) return false;
        int wgid = (int)L; { const int q = nwg / NXCD, r = nwg % NXCD, xcd = wgid % NXCD, off = wgid / NXCD; wgid = (xcd < r ? xcd * (q + 1) : r * (q + 1) + (xcd - r) * q) + off; }
        const int nig = WGM * nN, gid = wgid / nig, fm = gid * WGM, gsz = (nM - fm) < WGM ? (nM - fm) : WGM;
        u.pm = fm + ((wgid % nig) % gsz); u.pn = (wgid % nig) / gsz; u.kb = 0; u.kn = ntk; return true;
    }
    __device__ __forceinline__ void a_ready(const Unit&) const {}
    __device__ __forceinline__ void done(const Unit&) const {}
};

struct SplitMetaOrder : StaticOrder {
    int nreg, nsplit; unsigned* ticket; volatile PG8_LAS unsigned* flag;
    __device__ void init2(int N, int K, int G_, int c_, unsigned* ticket_, volatile PG8_LAS unsigned* flag_) { init(64 * BM, N, K, G_, c_); nreg = nwg; nsplit = 16; ticket = ticket_; flag = flag_; }
    __device__ bool next(int i, Unit& u) const {
        const long L = (long)i * G + c;
        if (L < nreg) return StaticOrder::next(i, u);
        const int x = (int)(L - nreg); if (x >= nsplit * nN) return false;
        const int s = x % nsplit; u.pm = 64; u.pn = x / nsplit;
        const int base = (ntk / 2) / nsplit, rem = (ntk / 2) % nsplit;
        u.kb = 2 * (s * base + (s < rem ? s : rem)); u.kn = 2 * (base + (s < rem ? 1 : 0)); return true;
    }
    __device__ __forceinline__ void a_ready(const Unit&) const {}
    __device__ __forceinline__ void done(const Unit& u) const {
        if (u.pm == 64) { asm volatile("s_waitcnt vmcnt(0)" ::: "memory");
            if ((threadIdx.x & 63) == 0) { const unsigned old = __hip_atomic_fetch_add(ticket, 1u, __ATOMIC_RELAXED, __HIP_MEMORY_SCOPE_AGENT); if (old + 1u == (unsigned)(nsplit * nN * 8)) flag[0] = 1u; } }
    }
};
__device__ __forceinline__ unsigned cvt_pk_bf16(float lo, float hi) { unsigned r; asm volatile("v_cvt_pk_bf16_f32 %0, %1, %2" : "=v"(r) : "v"(lo), "v"(hi)); return r; }
__device__ __forceinline__ u32x4 pack8(const f32x4 a, const f32x4 b) { u32x4 w; w.x = cvt_pk_bf16(a[0], a[1]); w.y = cvt_pk_bf16(a[2], a[3]); w.z = cvt_pk_bf16(b[0], b[1]); w.w = cvt_pk_bf16(b[2], b[3]); return w; }
__device__ __forceinline__ float row_rstd(const float* ssq, int r) { return 1.0f / sqrtf(ssq[r] * (1.0f / 4096.0f) + RMS_EPS); }

struct EpiIn0 {
    static constexpr bool PERM = true, AFTER_DRAIN = false;
    bf16_t* Z; float* F; const float* ssq;
    __device__ __forceinline__ void operator()(const f32x4 (&acc)[2][2][4][2], const Unit& u, int wr, int wc, int fr, int fq) const {
        const int row0 = u.pm * BM + wr * 64 + fr;
        if (u.pn < 40) {
            const int col0 = u.pn * BM + wc * 32 + 8 * fq;
#pragma unroll
            for (int ai = 0; ai < 2; ++ai)
#pragma unroll
                for (int m = 0; m < 4; ++m) { const int r = row0 + ai * HALF + m * 16; const float rs = row_rstd(ssq, r); bf16_t* rowp = Z + (size_t)r * AB_Z + col0;
#pragma unroll
                    for (int bj = 0; bj < 2; ++bj) *(u32x4*)(rowp + bj * HALF) = pack8(acc[ai][bj][m][0] * rs, acc[ai][bj][m][1] * rs); }
        } else if (wc == 0 && fq < 2) {
#pragma unroll
            for (int ai = 0; ai < 2; ++ai)
#pragma unroll
                for (int m = 0; m < 4; ++m) { const int r = row0 + ai * HALF + m * 16; const float rs = row_rstd(ssq, r); float* fp = F + (size_t)r * 16 + 8 * fq;
                    *(f32x4*)(fp) = acc[ai][0][m][0] * rs; *(f32x4*)(fp + 4) = acc[ai][0][m][1] * rs; }
        }
    }
};
struct EpiRes {
    static constexpr bool PERM = true, AFTER_DRAIN = false;
    const float* Hin; float* Htok; float* Hmeta; bf16_t* XB; float* ssq_out; int K_TILES; const float* gnext;
    __device__ __forceinline__ void operator()(const f32x4 (&acc)[2][2][4][2], const Unit& u, int wr, int wc, int fr, int fq) const {
        const int row0 = u.pm * BM + wr * 64 + fr, col0 = u.pn * BM + wc * 32 + 8 * fq;
        if (u.pm == MTOK / BM && u.kn != K_TILES) {
            if (wr == 0) {
#pragma unroll
                for (int m = 0; m < 4; ++m) { float* hp = Hmeta + (size_t)(m * 16 + fr) * DM + col0;
#pragma unroll
                    for (int bj = 0; bj < 2; ++bj)
#pragma unroll
                        for (int n = 0; n < 2; ++n)
#pragma unroll
                            for (int j = 0; j < 4; ++j) atomicAdd(hp + bj * HALF + 4 * n + j, acc[0][bj][m][n][j]); } }
            return; }
        float* H = u.pm < MTOK / BM ? Htok : Hmeta - (size_t)MTOK * DM;
        const float* HI = u.pm < MTOK / BM ? Hin : Hmeta - (size_t)MTOK * DM;
        f32x4 gn[2][2];
#pragma unroll
        for (int bj = 0; bj < 2; ++bj) { gn[bj][0] = *(const f32x4*)(gnext + col0 + bj * HALF); gn[bj][1] = *(const f32x4*)(gnext + col0 + bj * HALF + 4); }
#pragma unroll
        for (int ai = 0; ai < 2; ++ai)
#pragma unroll
            for (int m = 0; m < 4; ++m) { const int r = row0 + ai * HALF + m * 16; float* hp = H + (size_t)r * DM + col0; const float* hi = HI + (size_t)r * DM + col0; bf16_t* xp = XB + (size_t)r * DM + col0; float s = 0.f;
#pragma unroll
                for (int bj = 0; bj < 2; ++bj) { const f32x4 v0 = *(const f32x4*)(hi + bj * HALF) + acc[ai][bj][m][0], v1 = *(const f32x4*)(hi + bj * HALF + 4) + acc[ai][bj][m][1];
                    *(f32x4*)(hp + bj * HALF) = v0; *(f32x4*)(hp + bj * HALF + 4) = v1; *(u32x4*)(xp + bj * HALF) = pack8(v0 * gn[bj][0], v1 * gn[bj][1]);
                    s += (v0[0] * v0[0] + v0[1] * v0[1]) + (v0[2] * v0[2] + v0[3] * v0[3]) + (v1[0] * v1[0] + v1[1] * v1[1]) + (v1[2] * v1[2] + v1[3] * v1[3]); }
                s += __shfl_xor(s, 16); s += __shfl_xor(s, 32);
                if (fq == 0) atomicAdd(ssq_out + r, s);
                if (m & 1) asm volatile("" ::: "memory"); }
    }
};
struct EpiFinal {
    static constexpr bool PERM = true, AFTER_DRAIN = false;
    float* OUT;
    __device__ __forceinline__ void operator()(const f32x4 (&acc)[2][2][4][2], const Unit& u, int wr, int wc, int fr, int fq) const {
        const int row0 = u.pm * BM + wr * 64 + fr, col0 = u.pn * BM + wc * 32 + 8 * fq;
#pragma unroll
        for (int ai = 0; ai < 2; ++ai)
#pragma unroll
            for (int m = 0; m < 4; ++m) { const int r = row0 + ai * HALF + m * 16; float* op = OUT + (size_t)r * DM + col0; const float* hp = op;
#pragma unroll
                for (int bj = 0; bj < 2; ++bj) { const f32x4 v0 = *(const f32x4*)(hp + bj * HALF) + acc[ai][bj][m][0], v1 = *(const f32x4*)(hp + bj * HALF + 4) + acc[ai][bj][m][1];
                    *(f32x4*)(op + bj * HALF) = v0; *(f32x4*)(op + bj * HALF + 4) = v1; }
                asm volatile("" ::: "memory"); }
    }
};
struct EpiGU {
    static constexpr bool PERM = true, AFTER_DRAIN = false;
    bf16_t* HID; const float* ssq;
    __device__ __forceinline__ void operator()(const f32x4 (&acc)[2][2][4][2], const Unit& u, int wr, int wc, int fr, int fq) const {
        const int row0 = u.pm * BM + wr * 64 + fr, col0 = u.pn * HALF + wc * 32 + 8 * fq;
#pragma unroll
        for (int ai = 0; ai < 2; ++ai)
#pragma unroll
            for (int m = 0; m < 4; ++m) { const int r = row0 + ai * HALF + m * 16; const float rs = row_rstd(ssq, r); f32x4 o[2];
#pragma unroll
                for (int n = 0; n < 2; ++n)
#pragma unroll
                    for (int j = 0; j < 4; ++j) { const float g = acc[ai][0][m][n][j] * rs, uu = acc[ai][1][m][n][j] * rs;
                        o[n][j] = g * uu * __builtin_amdgcn_rcpf(1.0f + __expf(-g)); }
                *(u32x4*)(HID + (size_t)r * DFF + col0) = pack8(o[0], o[1]); }
    }
};
struct EpiIn1 {
    static constexpr bool PERM = true, AFTER_DRAIN = false;
    bf16_t* Z; const float* ssq;
    __device__ __forceinline__ void operator()(const f32x4 (&acc)[2][2][4][2], const Unit& u, int wr, int wc, int fr, int fq) const {
        const int row0 = u.pm * BM + wr * 64 + fr, col0 = u.pn * BM + wc * 32 + 8 * fq;
        if (u.pn < 32) {
            const float sc = u.pn < 16 ? 1.0f : 0.0625f;
            float inv[2][4];
#pragma unroll
            for (int n = 0; n < 2; ++n)
#pragma unroll
                for (int j = 0; j < 4; ++j) inv[n][j] = exp2f(-(float)(wc * 32 + 8 * fq + 4 * n + j) * (13.287712379549449f / 128.0f));
#pragma unroll
            for (int ai = 0; ai < 2; ++ai)
#pragma unroll
                for (int m = 0; m < 4; ++m) { const int r = row0 + ai * HALF + m * 16; const float rs = row_rstd(ssq, r) * sc;
                    const float t = (float)(r < MTOK ? NMETA + (r & (SEQ - 1)) : ((r - MTOK) & 15));
                    f32x4 o1[2], o2[2];
#pragma unroll
                    for (int n = 0; n < 2; ++n)
#pragma unroll
                        for (int j = 0; j < 4; ++j) { const float x1 = acc[ai][0][m][n][j] * rs, x2 = acc[ai][1][m][n][j] * rs;
                            const float ang = t * inv[n][j]; float rev = ang * 0.15915494309189535f; rev = rev - floorf(rev);
                            const float c = __builtin_amdgcn_cosf(rev), s = __builtin_amdgcn_sinf(rev);
                            o1[n][j] = x1 * c - x2 * s; o2[n][j] = x1 * s + x2 * c; }
                    bf16_t* rowp = Z + (size_t)r * RET_IN + col0;
                    *(u32x4*)(rowp) = pack8(o1[0], o1[1]); *(u32x4*)(rowp + HALF) = pack8(o2[0], o2[1]); }
        } else {
#pragma unroll
            for (int ai = 0; ai < 2; ++ai)
#pragma unroll
                for (int m = 0; m < 4; ++m) { const int r = row0 + ai * HALF + m * 16; const float rs = row_rstd(ssq, r); bf16_t* rowp = Z + (size_t)r * RET_IN + col0;
#pragma unroll
                    for (int bj = 0; bj < 2; ++bj) *(u32x4*)(rowp + bj * HALF) = pack8(acc[ai][bj][m][0] * rs, acc[ai][bj][m][1] * rs); }
        }
    }
};

template <class Epi, class Sched, bool ALIGN_EPI = false, bool SP2 = false>
__device__ __forceinline__ void gemm_phase(PG8_LAS unsigned char* lds, const Gemm g, const Sched& S, const Epi& E) {
    const int tid = threadIdx.x, wid = __builtin_amdgcn_readfirstlane(tid >> 6), lane = tid & 63, wr = wid >> 2, wc = wid & 3, fr = lane & 15, fq = lane >> 4;
    const int K = g.K; int nt;
    unsigned voffA[2], voffB[2];
#pragma unroll
    for (int i = 0; i < 2; ++i) { int R, C; stage_rc(tid * 16 + i * 8192, R, C); const int Rb = Epi::PERM ? ((R & ~31) + perm32(R & 31)) : R;
        voffA[i] = (unsigned)(R * K + C) * 2u; voffB[i] = (unsigned)(Rb * K + C) * 2u; }
    const size_t kstep = (size_t)(BK * 2);
    const size_t hstep = (size_t)HALF * K * 2;
    const size_t tstep = 2 * hstep;
    const unsigned ldsw = (unsigned)wid * 1024u;
    const int aoff = lds_byte(wr * 64 + fr, fq * 8), boff = lds_byte(wc * 32 + fr, fq * 8);
#define PG8_SA(b, h) (((b) * 2 + (h)) * HTB)
#define PG8_SB(b, h) ((4 + (b) * 2 + (h)) * HTB)
#define PG8_STAGE(bufoff, gbase, voff) do { _Pragma("unroll") for (int _i = 0; _i < 2; ++_i) \
        __builtin_amdgcn_global_load_lds((const unsigned*)((const char*)(gbase) + (voff)[_i]), (PG8_LAS unsigned*)(lds + (bufoff) + ldsw + _i * 8192), 16, 0, 0); } while (0)
#define PG8_LDA(dst, b, h) do { _Pragma("unroll") for (int m = 0; m < 4; ++m) _Pragma("unroll") for (int k = 0; k < 2; ++k) dst[m][k] = *(const PG8_LAS bf16x8*)(lds + PG8_SA(b, h) + aoff + m * 2048 + k * 1024); } while (0)
#define PG8_LDB(dst, b, h) do { _Pragma("unroll") for (int n = 0; n < 2; ++n) _Pragma("unroll") for (int k = 0; k < 2; ++k) dst[n][k] = *(const PG8_LAS bf16x8*)(lds + PG8_SB(b, h) + boff + n * 2048 + k * 1024); } while (0)
#define PG8_MMA(ai, bj, At, Bt) do { __builtin_amdgcn_s_setprio(1); _Pragma("unroll") for (int m = 0; m < 4; ++m) _Pragma("unroll") for (int n = 0; n < 2; ++n) _Pragma("unroll") for (int k = 0; k < 2; ++k) \
        acc[ai][bj][m][n] = __builtin_amdgcn_mfma_f32_16x16x32_bf16(Bt[n][k], At[m][k], acc[ai][bj][m][n], 0, 0, 0); __builtin_amdgcn_s_setprio(0); } while (0)
#define PG8_WAIT_V(n) asm volatile("s_waitcnt vmcnt(" #n ")" ::: "memory")
#define PG8_WAIT_L(n) asm volatile("s_waitcnt lgkmcnt(" #n ")" ::: "memory")
#define PG8_BAR __builtin_amdgcn_s_barrier()
#define PG8_SCHED __builtin_amdgcn_sched_barrier(0)
    Unit cur, nxt; int ui = 0;
    if (!S.next(0, cur)) return;
    nt = cur.kn;
    f32x4 acc[2][2][4][2];
#pragma unroll
    for (int a = 0; a < 2; ++a)
#pragma unroll
        for (int b = 0; b < 2; ++b)
#pragma unroll
            for (int m = 0; m < 4; ++m)
#pragma unroll
                for (int n = 0; n < 2; ++n) acc[a][b][m][n] = (f32x4){0.f, 0.f, 0.f, 0.f};
    bf16x8 At[4][2], B0[2][2], B1[2][2];
    const char* cA = (const char*)g.A + (size_t)cur.pm * tstep + (size_t)cur.kb * kstep; const char* cB = (const char*)g.Bt + (size_t)cur.pn * tstep + (size_t)cur.kb * kstep;
    S.a_ready(cur);
    if constexpr (SP2) {
        PG8_STAGE(PG8_SB(0, 0), cB, voffB); PG8_STAGE(PG8_SB(0, 1), cB + hstep, voffB); PG8_STAGE(PG8_SA(0, 0), cA, voffA); PG8_STAGE(PG8_SA(0, 1), cA + hstep, voffA);
        if (wr == 1) PG8_BAR;
        PG8_WAIT_V(2); PG8_BAR;
        PG8_STAGE(PG8_SB(1, 0), cB + kstep, voffB); PG8_STAGE(PG8_SA(1, 0), cA + kstep, voffA); PG8_STAGE(PG8_SB(1, 1), cB + hstep + kstep, voffB);
        PG8_WAIT_V(6); PG8_BAR;
    } else {
        PG8_STAGE(PG8_SB(0, 0), cB, voffB); PG8_STAGE(PG8_SA(0, 0), cA, voffA); PG8_STAGE(PG8_SB(0, 1), cB + hstep, voffB); PG8_STAGE(PG8_SA(0, 1), cA + hstep, voffA);
        if (wr == 1) PG8_BAR;
        PG8_WAIT_V(4); PG8_BAR;
        PG8_STAGE(PG8_SB(1, 0), cB + kstep, voffB); PG8_STAGE(PG8_SA(1, 0), cA + kstep, voffA); PG8_STAGE(PG8_SB(1, 1), cB + hstep + kstep, voffB);
        PG8_WAIT_V(6); PG8_BAR;
    }
    for (;;) {
        const bool has_next = S.next(ui + 1, nxt);
        const char* nA = has_next ? (const char*)g.A + (size_t)nxt.pm * tstep + (size_t)nxt.kb * kstep : cA; const char* nB = has_next ? (const char*)g.Bt + (size_t)nxt.pn * tstep + (size_t)nxt.kb * kstep : cB;
        for (int t = 0; t < nt; t += 2) {
            const bool last = (t == nt - 2);
            const char* a1 = cA + (size_t)(t + 1) * kstep;
            const char* a2 = last ? nA : cA + (size_t)(t + 2) * kstep; const char* b2 = last ? nB : cB + (size_t)(t + 2) * kstep;
            const char* a3 = a2 + kstep; const char* b3 = b2 + kstep;
            if (last && has_next) S.a_ready(nxt);
            if constexpr (SP2) {
            PG8_LDB(B0, 0, 0); PG8_LDB(B1, 0, 1); PG8_SCHED; PG8_LDA(At, 0, 0); PG8_STAGE(PG8_SA(1, 1), a1 + hstep, voffA);
            PG8_WAIT_V(8); PG8_WAIT_L(0); PG8_BAR; PG8_MMA(0, 0, At, B0); PG8_MMA(0, 1, At, B1); PG8_BAR; PG8_SCHED;
            PG8_LDA(At, 0, 1); PG8_STAGE(PG8_SB(0, 0), b2, voffB); PG8_STAGE(PG8_SB(0, 1), b2 + hstep, voffB); PG8_STAGE(PG8_SA(0, 0), a2, voffA);
            PG8_WAIT_V(8); PG8_WAIT_L(0); PG8_BAR; PG8_MMA(1, 0, At, B0); PG8_MMA(1, 1, At, B1); PG8_BAR; PG8_SCHED;
            PG8_LDB(B0, 1, 0); PG8_LDB(B1, 1, 1); PG8_SCHED; PG8_LDA(At, 1, 0); PG8_STAGE(PG8_SA(0, 1), a2 + hstep, voffA);
            PG8_WAIT_V(8); PG8_WAIT_L(0); PG8_BAR; PG8_MMA(0, 0, At, B0); PG8_MMA(0, 1, At, B1); PG8_BAR; PG8_SCHED;
            PG8_LDA(At, 1, 1); PG8_STAGE(PG8_SB(1, 0), b3, voffB); PG8_STAGE(PG8_SB(1, 1), b3 + hstep, voffB); PG8_STAGE(PG8_SA(1, 0), a3, voffA);
            PG8_WAIT_V(8); PG8_WAIT_L(0); PG8_BAR; PG8_MMA(1, 0, At, B0); PG8_MMA(1, 1, At, B1); PG8_BAR; PG8_SCHED;
            } else {
            PG8_LDB(B0, 0, 0); PG8_SCHED; PG8_LDA(At, 0, 0); PG8_STAGE(PG8_SA(1, 1), a1 + hstep, voffA);
            PG8_WAIT_L(8); PG8_BAR; PG8_WAIT_L(0); PG8_MMA(0, 0, At, B0); PG8_BAR; PG8_SCHED;
            PG8_LDB(B1, 0, 1); PG8_STAGE(PG8_SB(0, 0), b2, voffB);
            PG8_BAR; PG8_WAIT_L(0); PG8_MMA(0, 1, At, B1); PG8_BAR;
            PG8_LDA(At, 0, 1); PG8_STAGE(PG8_SA(0, 0), a2, voffA);
            PG8_BAR; PG8_WAIT_L(0); PG8_MMA(1, 0, At, B0); PG8_BAR; PG8_SCHED;
            PG8_STAGE(PG8_SB(0, 1), b2 + hstep, voffB);
            PG8_WAIT_V(6); PG8_BAR; PG8_MMA(1, 1, At, B1); PG8_BAR;
            PG8_LDB(B0, 1, 0); PG8_SCHED; PG8_LDA(At, 1, 0); PG8_STAGE(PG8_SA(0, 1), a2 + hstep, voffA);
            PG8_WAIT_L(8); PG8_BAR; PG8_WAIT_L(0); PG8_MMA(0, 0, At, B0); PG8_BAR; PG8_SCHED;
            PG8_LDB(B1, 1, 1); PG8_STAGE(PG8_SB(1, 0), b3, voffB);
            PG8_BAR; PG8_WAIT_L(0); PG8_MMA(0, 1, At, B1); PG8_BAR;
            PG8_LDA(At, 1, 1); PG8_STAGE(PG8_SA(1, 0), a3, voffA);
            PG8_BAR; PG8_WAIT_L(0); PG8_MMA(1, 0, At, B0); PG8_BAR; PG8_SCHED;
            PG8_STAGE(PG8_SB(1, 1), b3 + hstep, voffB);
            PG8_WAIT_V(6); PG8_BAR; PG8_MMA(1, 1, At, B1); PG8_BAR;
            }
        }
        if constexpr (ALIGN_EPI) { if (wr == 0) PG8_BAR; }
        if constexpr (!Epi::AFTER_DRAIN) { E(acc, cur, wr, wc, fr, fq); S.done(cur); }
        if (!has_next) break;
#pragma unroll
        for (int a = 0; a < 2; ++a)
#pragma unroll
            for (int b = 0; b < 2; ++b)
#pragma unroll
                for (int m = 0; m < 4; ++m)
#pragma unroll
                    for (int n = 0; n < 2; ++n) acc[a][b][m][n] = (f32x4){0.f, 0.f, 0.f, 0.f};
        cur = nxt; cA = nA; cB = nB; ++ui; nt = cur.kn;
        if constexpr (ALIGN_EPI) { if (wr == 1) PG8_BAR; }
    }
    PG8_WAIT_V(0);
    if constexpr (!ALIGN_EPI) { if (wr == 0) PG8_BAR; }
    PG8_BAR;
    if constexpr (Epi::AFTER_DRAIN) { E.fused(acc, cur, wr, wc, fr, fq, lds, wid, lane); S.done(cur); }
#undef PG8_SA
#undef PG8_SB
#undef PG8_STAGE
#undef PG8_LDA
#undef PG8_LDB
#undef PG8_MMA
#undef PG8_WAIT_V
#undef PG8_WAIT_L
#undef PG8_BAR
#undef PG8_SCHED
}
}

constexpr size_t MiB = 1u << 20;
constexpr size_t WS_CTL = 0, CTL_ZERO_BYTES = 2 * MiB;
constexpr size_t WS_SSQ1 = 64 * 1024, WS_SSQ2 = 192 * 1024, WS_SSQ3 = 320 * 1024, WS_SSQO = 512 * 1024;
constexpr size_t WS_SSQ0 = 2 * MiB;
constexpr size_t WS_FBUF = 2 * MiB + 512 * 1024;
constexpr size_t WS_HMETA = 4 * MiB;
constexpr size_t WS_WIN0 = 8 * MiB, WS_WOUT0 = 90 * MiB, WS_WGU0 = 122 * MiB, WS_WD0 = 294 * MiB, WS_WIN1 = 380 * MiB, WS_WOUT1 = 572 * MiB, WS_WGU1 = 636 * MiB, WS_WD1 = 808 * MiB;
constexpr size_t WS_WAT = 894 * MiB, WS_WXT = WS_WAT + 512 * 1024;
constexpr size_t WS_XB = 896 * MiB, WS_Z = 1026 * MiB, WS_END = 1806 * MiB;
constexpr size_t WS_Y0 = WS_Z + 400 * MiB;
constexpr size_t WS_Y1 = 8 * MiB;
static_assert(WS_SSQO + (size_t)MP * 16 * 4 <= CTL_ZERO_BYTES && WS_FBUF + (size_t)MP * 16 * 4 <= WS_HMETA && WS_HMETA + (size_t)256 * DM * 4 <= WS_WIN0, "ctl map");
static_assert(WS_WIN0 + (size_t)41 * 256 * DM * 2 <= WS_WOUT0 && WS_WGU0 + (size_t)2 * DFF * DM * 2 <= WS_WD0 && WS_WD0 + (size_t)DM * DFF * 2 <= WS_WIN1 && WS_WIN1 + (size_t)RET_IN * DM * 2 <= WS_WOUT1, "weight map");
static_assert(WS_WOUT1 + (size_t)DM * RET_VW * 2 <= WS_WGU1 && WS_WGU1 + (size_t)2 * DFF * DM * 2 <= WS_WD1 && WS_WD1 + (size_t)DM * DFF * 2 <= WS_WAT, "weight map 2");
static_assert(WS_XB + (size_t)MP * DM * 2 <= WS_Z && WS_Z + (size_t)MP * RET_IN * 2 <= WS_END && WS_Z + (size_t)MP * AB_Z * 2 <= WS_Y0 && WS_Z + (size_t)MP * DFF * 2 <= WS_Y0 && WS_Y0 + (size_t)MP * DM * 2 <= WS_END && WS_Y1 + (size_t)MP * RET_VW * 2 <= WS_WD0, "activation map");
constexpr int CW_TMO = 0, CW_Q2 = 64, CW_TK3 = 256, CW_TK5 = 320, CW_BAR = 4096;
constexpr int RING_BYTES = 131072;
constexpr int LDS_BYTES = 147456;
constexpr int MISC_OFF = LDS_BYTES - 256;
constexpr int NWAVES = 8, NTHREADS = 512;
constexpr int NPHASES = 12;

#define GAS __attribute__((address_space(1)))
#define LAS __attribute__((address_space(3)))
typedef unsigned short bf16;
typedef unsigned v4u __attribute__((ext_vector_type(4)));
typedef unsigned v2u __attribute__((ext_vector_type(2)));
typedef float f32x4 __attribute__((ext_vector_type(4)));
typedef short bf16x8 __attribute__((ext_vector_type(8)));
typedef short bf16x4 __attribute__((ext_vector_type(4)));
typedef GAS unsigned gu32;
#define RLX_AGENT __ATOMIC_RELAXED, __HIP_MEMORY_SCOPE_AGENT
#define LDS_WAIT() asm volatile("s_waitcnt lgkmcnt(0)" ::: "memory")
#define VM_WAIT() asm volatile("s_waitcnt vmcnt(0)" ::: "memory")
__device__ __forceinline__ unsigned f2bf(float f) { unsigned u = __builtin_bit_cast(unsigned, f); return (u + 0x7fffu + ((u >> 16) & 1u)) >> 16; }
__device__ __forceinline__ unsigned pk2(float lo, float hi) { return pg8::cvt_pk_bf16(lo, hi); }
__device__ __forceinline__ float bflo(unsigned w) { return __builtin_bit_cast(float, w << 16); }
__device__ __forceinline__ float bfhi(unsigned w) { return __builtin_bit_cast(float, w & 0xffff0000u); }
__device__ __forceinline__ float bf2f(unsigned short h) { return __builtin_bit_cast(float, (unsigned)h << 16); }
__device__ __forceinline__ void unpack8(const v4u w, float (&f)[8]) { f[0] = bflo(w.x); f[1] = bfhi(w.x); f[2] = bflo(w.y); f[3] = bfhi(w.y); f[4] = bflo(w.z); f[5] = bfhi(w.z); f[6] = bflo(w.w); f[7] = bfhi(w.w); }
__device__ __forceinline__ v4u pack8f(const float (&f)[8]) { v4u w; w.x = pk2(f[0], f[1]); w.y = pk2(f[2], f[3]); w.z = pk2(f[4], f[5]); w.w = pk2(f[6], f[7]); return w; }
__device__ __forceinline__ int row_of(int b, int t) { return t < NMETA ? MMETA + NMETA * b + t : b * SEQ + (t - NMETA); }
__device__ __forceinline__ f32x4 mfma16(bf16x8 a, bf16x8 b, f32x4 c) { return __builtin_amdgcn_mfma_f32_16x16x32_bf16(a, b, c, 0, 0, 0); }

#define XB_TMO      128
#define XB_XCNT(j)  (256  + 64 * (j))
#define XB_XSUB(j)  (1280 + 64 * (j))
#define XB_XGEN(j)  (2304 + 64 * (j))
#define XB_TOP      3328
#define XB_TOPGEN   3392
#define XCD_BAR_WORDS 3456
#define XB_SPIN_CAP (1u << 22)

__device__ __forceinline__ unsigned xb_ld(unsigned* p)              { return __hip_atomic_load(p, __ATOMIC_RELAXED, __HIP_MEMORY_SCOPE_AGENT); }
__device__ __forceinline__ unsigned xb_add(unsigned* p, unsigned v) { return __hip_atomic_fetch_add(p, v, __ATOMIC_RELAXED, __HIP_MEMORY_SCOPE_AGENT); }
__device__ __forceinline__ unsigned xb_xcc_id() { return (unsigned)__builtin_amdgcn_s_getreg((3 << 11) | 20) & 0xFu; }
#define XB_SPIN(cond, bar) do { unsigned _sp = 0; while (cond) { __builtin_amdgcn_s_sleep(1); \
    if ((++_sp & 255u) == 0u) { if (xb_ld(&(bar)[XB_TMO])) break; if (_sp > XB_SPIN_CAP) { atomicAdd(&(bar)[XB_TMO], 1u); break; } } } } while (0)

struct XcdBarrier {
    unsigned* bar; unsigned x;
    volatile LAS unsigned* st;
};
__device__ __forceinline__ XcdBarrier xcd_barrier_post(unsigned* bar, volatile LAS unsigned* st) {
    XcdBarrier b; b.bar = bar; b.x = xb_xcc_id(); b.st = st;
    if (threadIdx.x == 0) (void)xb_add(&bar[XB_XCNT(b.x)], 1u);
    return b;
}
__device__ __forceinline__ void xcd_barrier_complete(unsigned* bar, unsigned x, unsigned& nloc, unsigned& nx) {
    const unsigned G = gridDim.x * gridDim.y * gridDim.z;
    unsigned sum, cnt, mine, sp = 0u;
    for (;;) {
        sum = 0u; cnt = 0u; mine = 0u;
#pragma unroll
        for (unsigned j = 0; j < 16; ++j) { const unsigned c = xb_ld(&bar[XB_XCNT(j)]); sum += c; cnt += (c > 0u) ? 1u : 0u; mine = (j == x) ? c : mine; }
        if (sum == G) break;
        __builtin_amdgcn_s_sleep(1);
        if ((++sp & 255u) == 0u) { if (xb_ld(&bar[XB_TMO])) break; if (sp > XB_SPIN_CAP) { atomicAdd(&bar[XB_TMO], 1u); break; } }
    }
    nloc = mine > 0u ? mine : 1u; nx = cnt > 0u ? cnt : 1u;
}
__device__ __forceinline__ void xcd_barrier(const XcdBarrier& b) {
    asm volatile("s_waitcnt vmcnt(0)" ::: "memory");
    __syncthreads();
    if (threadIdx.x == 0) {
        unsigned* bar = b.bar;
        __builtin_amdgcn_s_waitcnt(0);
        unsigned nloc = b.st[0], nx = b.st[1];
        if (nloc == 0u) { xcd_barrier_complete(bar, b.x, nloc, nx); b.st[0] = nloc; b.st[1] = nx; }
        const unsigned old = xb_add(&bar[XB_XSUB(b.x)], 1u);
        const unsigned gen = old / nloc;
        if (old + 1u == (gen + 1u) * nloc) {
            __builtin_amdgcn_fence(__ATOMIC_RELEASE, "agent");
            asm volatile("s_waitcnt vmcnt(0)" ::: "memory");
            const unsigned og = xb_add(&bar[XB_TOP], 1u);
            const unsigned tg = og / nx;
            if (og + 1u == (tg + 1u) * nx) xb_add(&bar[XB_TOPGEN], 1u);
            else XB_SPIN(xb_ld(&bar[XB_TOPGEN]) == tg, bar);
            __builtin_amdgcn_fence(__ATOMIC_ACQUIRE, "agent");
            xb_add(&bar[XB_XGEN(b.x)], 1u);
            asm volatile("s_waitcnt vmcnt(0)" ::: "memory");
        } else {
            XB_SPIN(xb_ld(&bar[XB_XGEN(b.x)]) == gen, bar);
            __builtin_amdgcn_fence(__ATOMIC_ACQUIRE, "agent");
            asm volatile("s_waitcnt vmcnt(0)" ::: "memory");
        }
    }
    __syncthreads();
}

struct Args { const float* in[23]; float* out; unsigned char* ws; int ph_lo, ph_hi; };
__device__ __forceinline__ float* h_row(float* out, unsigned char* ws, int r) { return r < MTOK ? out + (size_t)r * DM : (float*)(ws + WS_HMETA) + (size_t)(r - MTOK) * DM; }
struct Frame {
    LAS unsigned char* lds;
    volatile LAS unsigned* MISC;
    unsigned char* ws;
    int tid, lane, wave, G;
};
__device__ __forceinline__ float wave_sum(float v) {
#pragma unroll
    for (int o = 1; o < 64; o <<= 1) v += __shfl_xor(v, o);
    return v;
}

template <int MODE, int KCH>
__device__ __forceinline__ void p0_tr(const float* W, int K, int N, bf16* WT, LAS unsigned* tile, int item, int lane) {
    const int nkc = K / KCH, nb = item / nkc, kc = item - nb * nkc, k0 = kc * KCH, n0 = nb * 64;
    const int kq = lane >> 4, nq = lane & 15; const int n = n0 + 4 * nq; const bool ok = n < N;
    const float* src = W + (size_t)(k0 + 2 * kq) * N + (ok ? n : 0);
    const int nr = lane >> 3, kch = lane & 7;
    f32x4 va[8][2];
#define P0_LOAD(v, sub) do { _Pragma("unroll") for (int i = 0; i < 8; ++i) { const float* p_ = src + (size_t)(64 * (sub) + 8 * i) * N; v[i][0] = __builtin_nontemporal_load((const GAS f32x4*)p_); v[i][1] = __builtin_nontemporal_load((const GAS f32x4*)(p_ + N)); } } while (0)
#define P0_PROC(v, sub) do { const int kb = k0 + 64 * (sub); \
        _Pragma("unroll") for (int i = 0; i < 8; ++i) { \
            _Pragma("unroll") for (int c = 0; c < 4; ++c) tile[(4 * nq + c) * 33 + 4 * i + kq] = pk2(v[i][0][c], v[i][1][c]); } \
        LDS_WAIT(); asm volatile("" ::: "memory"); \
        _Pragma("unroll") for (int st = 0; st < 8; ++st) { const int row = 8 * st + nr; const LAS unsigned* tp = tile + row * 33 + 4 * kch; \
            v4u o; o.x = tp[0]; o.y = tp[1]; o.z = tp[2]; o.w = tp[3]; \
            const int ng = n0 + row; const int drow = MODE == 0 ? ng : (MODE == 1 ? 256 * (ng >> 7) + (ng & 127) : 256 * (ng >> 7) + 128 + (ng & 127)); \
            if (ng < N) __builtin_nontemporal_store(o, (GAS v4u*)(WT + (size_t)drow * K + kb + 8 * kch)); } \
        LDS_WAIT(); asm volatile("" ::: "memory"); } while (0)
#pragma unroll 1
    for (int sub = 0; sub < KCH / 64; ++sub) { P0_LOAD(va, sub); P0_PROC(va, sub); }
#undef P0_LOAD
#undef P0_PROC
}
__device__ __forceinline__ void p0_row(Frame& F, const float* x, const float* meta, const float* gain, float* out, int r) {
    float* hrow = h_row(out, F.ws, r); bf16* xrow = (bf16*)(F.ws + WS_XB) + (size_t)r * DM;
    const float* src = r < MTOK ? x + (size_t)r * DM : meta + (size_t)((r - MTOK) & 15) * DM;
    const bool pad = r >= MTOK + NB * NMETA;
    float s = 0.f;
#pragma unroll 4
    for (int j = 0; j < 16; ++j) { const int e = (F.lane + 64 * j) * 4;
        f32x4 v = pad ? (f32x4){0.f, 0.f, 0.f, 0.f} : *(const GAS f32x4*)(src + e);
        s += (v.x * v.x + v.y * v.y) + (v.z * v.z + v.w * v.w);
        if (r >= MTOK) *(GAS f32x4*)(hrow + e) = v;
        const f32x4 gn = *(const GAS f32x4*)(gain + e); v2u w; w.x = pk2(v.x * gn.x, v.y * gn.y); w.y = pk2(v.z * gn.z, v.w * gn.w); *(GAS v2u*)(xrow + e) = w; }
    s = wave_sum(s);
    if (F.lane == 0) ((float*)(F.ws + WS_SSQ0))[r] = s;
}
#ifndef CONV_IN_P2
#define CONV_IN_P2 1
#endif
constexpr int P0_KC = 256;
constexpr int CV_G = 172 * (DM / P0_KC), CV_D = 64 * (DFF / P0_KC), CV_IN1 = 384 * (DM / P0_KC), CV_O1 = 64 * (RET_VW / P0_KC);
constexpr int CV_FINE = 2 * (2 * CV_G + CV_D) + CV_IN1 + CV_O1;
constexpr int CV_PER = 32, N_CONV = CONV_IN_P2 ? (CV_FINE + CV_PER - 1) / CV_PER : 0;
struct ConvPtrs { const float *wg, *wu, *wd, *win1, *wo1, *fnorm, *cnorm; };
__device__ __forceinline__ void conv_fine_b2(unsigned char* ws, LAS unsigned* tile, const ConvPtrs P, int it, int lane) {
    int r = it;
    if (r < CV_G) { p0_tr<1, P0_KC>(P.wg, DM, DFF, (bf16*)(ws + WS_WGU0), tile, r, lane); return; } r -= CV_G;
    if (r < CV_G) { p0_tr<2, P0_KC>(P.wu, DM, DFF, (bf16*)(ws + WS_WGU0), tile, r, lane); return; } r -= CV_G;
    if (r < CV_D) { p0_tr<0, P0_KC>(P.wd, DFF, DM, (bf16*)(ws + WS_WD0), tile, r, lane); return; } r -= CV_D;
    if (r < CV_IN1) { p0_tr<0, P0_KC>(P.win1, DM, RET_IN, (bf16*)(ws + WS_WIN1), tile, r, lane); return; } r -= CV_IN1;
    if (r < CV_O1) { p0_tr<0, P0_KC>(P.wo1, RET_VW, DM, (bf16*)(ws + WS_WOUT1), tile, r, lane); return; } r -= CV_O1;
    if (r < CV_G) { p0_tr<1, P0_KC>(P.wg + (size_t)DM * DFF, DM, DFF, (bf16*)(ws + WS_WGU1), tile, r, lane); return; } r -= CV_G;
    if (r < CV_G) { p0_tr<2, P0_KC>(P.wu + (size_t)DM * DFF, DM, DFF, (bf16*)(ws + WS_WGU1), tile, r, lane); return; } r -= CV_G;
    p0_tr<0, P0_KC>(P.wd + (size_t)DFF * DM, DFF, DM, (bf16*)(ws + WS_WD1), tile, r, lane);
}
__device__ __forceinline__ void conv_item(unsigned char* ws, LAS unsigned char* ldsb, ConvPtrs P, int ci, int wave, int lane) {
    LAS unsigned* tile = (LAS unsigned*)(ldsb + wave * 8448);
    for (int k = wave; k < CV_PER; k += NWAVES) { const int it = __builtin_amdgcn_readfirstlane(ci * CV_PER + k); if (it < CV_FINE) conv_fine_b2(ws, tile, P, it, lane); }
}
__device__ __forceinline__ void p0_prologue(Frame& F, const Args& A) {
    const int gw = __builtin_amdgcn_readfirstlane(blockIdx.x * NWAVES + F.wave), NGW = F.G * NWAVES;
    unsigned char* ws = F.ws;
    constexpr int KC = P0_KC; LAS unsigned* tile = (LAS unsigned*)(F.lds + F.wave * 8448);
    constexpr int I_IN0 = 161 * (DM / KC), I_SQ = 64 * (DM / KC), I_BD = 16 * 2;
    constexpr int NITEMS = I_IN0 + I_SQ + 2 * I_BD;
    for (int it = gw; it < NITEMS; it += NGW) {
        int r = it;
        if (r < I_IN0) { p0_tr<0, KC>(A.in[3], DM, AB_IN, (bf16*)(ws + WS_WIN0), tile, r, F.lane); continue; } r -= I_IN0;
        if (r < I_SQ) { p0_tr<0, KC>(A.in[14], DM, DM, (bf16*)(ws + WS_WOUT0), tile, r, F.lane); continue; } r -= I_SQ;
        if (r < I_BD) { const int blk = r >> 1; p0_tr<0, 128>(A.in[7] + (size_t)blk * 16384, 128, 128, (bf16*)(ws + WS_WAT) + (size_t)blk * 16384, tile, r & 1, F.lane); continue; } r -= I_BD;
        { const int blk = r >> 1; p0_tr<0, 128>(A.in[9] + (size_t)blk * 16384, 128, 128, (bf16*)(ws + WS_WXT) + (size_t)blk * 16384, tile, r & 1, F.lane); }
    }
#if !CONV_IN_P2
    { const ConvPtrs CP{A.in[20], A.in[21], A.in[22], A.in[16], A.in[18], A.in[19], A.in[15]};
      for (int it = gw; it < CV_FINE; it += NGW) conv_fine_b2(ws, tile, CP, it, F.lane); }
#endif
    for (int m = gw; m < MP; m += NGW) p0_row(F, A.in[0], A.in[1], A.in[2], A.out, m);
}

__device__ __forceinline__ float sigmoidf_fast(float x) { return __builtin_amdgcn_rcpf(1.0f + __expf(-x)); }
__device__ __forceinline__ float gelu_tanh(float g) { const float z = 0.7978845608028654f * (g + 0.044715f * g * g * g); const float e = __expf(2.0f * z); return 0.5f * g * (2.0f - 2.0f * __builtin_amdgcn_rcpf(e + 1.0f)); }

constexpr int LRU_XA = 0, LRU_STRIDE = 272, LRU_XF = 17408, LRU_XF_STRIDE = 132  , LRU_GT = 51200, LRU_YT = 68608;
__device__ __forceinline__ void lru_item(Frame& F, const Args& A, int b, int n) {
    const bf16* z0 = (const bf16*)(F.ws + WS_Z); bf16* y0 = (bf16*)(F.ws + WS_Y0);
    const int tid = F.tid, lane = F.lane, w = F.wave, fr = lane & 15, fq = lane >> 4;
    LAS unsigned char* lds = F.lds;
    LAS float* XF = (LAS float*)(lds + LRU_XF);
    const int c8 = (tid & 15) * 8, r4 = tid >> 4;
    const int ch0 = n * 128 + c8;
    float cw[4][8], cb[8];
#pragma unroll
    for (int e = 0; e < 8; ++e) { cb[e] = A.in[6][ch0 + e];
#pragma unroll
        for (int j = 0; j < 4; ++j) cw[j][e] = A.in[5][j * LRU_W + ch0 + e]; }
    const int dch = n * 128 + 16 * w + fr;
    const float ba = A.in[8][dch], bx = A.in[10][dch];
    const float cneg = -8.0f * log1pf(expf(-A.in[11][dch]));
    bf16x8 bwa[4], bwx[4];
    { const bf16* wat = (const bf16*)(F.ws + WS_WAT) + ((size_t)n * 128 + 16 * w + fr) * 128 + 8 * fq; const bf16* wxt = (const bf16*)(F.ws + WS_WXT) + ((size_t)n * 128 + 16 * w + fr) * 128 + 8 * fq;
#pragma unroll
      for (int ks = 0; ks < 4; ++ks) { bwa[ks] = *(const bf16x8*)(wat + 32 * ks); bwx[ks] = *(const bf16x8*)(wxt + 32 * ks); } }
    float hc = 0.f;
    v4u xr[2][4], gv[2];
#define LRU_LOAD(tau) do { _Pragma("unroll") for (int q = 0; q < 2; ++q) { const int t = 64 * (tau) + r4 + 32 * q - 48; \
            gv[q] = (v4u){0u, 0u, 0u, 0u}; if (t >= 0) gv[q] = *(const GAS v4u*)(z0 + (size_t)row_of(b, t) * AB_Z + LRU_W + ch0); \
            _Pragma("unroll") for (int j = 0; j < 4; ++j) { const int tj = t - 3 + j; xr[q][j] = (v4u){0u, 0u, 0u, 0u}; if (tj >= 0) xr[q][j] = *(const GAS v4u*)(z0 + (size_t)row_of(b, tj) * AB_Z + ch0); } } } while (0)
    LRU_LOAD(0);
    for (int tau = 0; tau < 65; ++tau) {
#pragma unroll
        for (int q = 0; q < 2; ++q) {
            const int rr = r4 + 32 * q;
            float xc[8];
#pragma unroll
            for (int e = 0; e < 8; ++e) xc[e] = cb[e];
#pragma unroll
            for (int j = 0; j < 4; ++j) { float xf[8]; unpack8(xr[q][j], xf);
#pragma unroll
                for (int e = 0; e < 8; ++e) xc[e] += cw[j][e] * xf[e]; }
            *(LAS v4u*)(lds + LRU_XA + rr * LRU_STRIDE + c8 * 2) = pack8f(xc);
            *(LAS f32x4*)(XF + rr * LRU_XF_STRIDE + c8) = (f32x4){xc[0], xc[1], xc[2], xc[3]};
            *(LAS f32x4*)(XF + rr * LRU_XF_STRIDE + c8 + 4) = (f32x4){xc[4], xc[5], xc[6], xc[7]};
            *(LAS v4u*)(lds + LRU_GT + rr * LRU_STRIDE + c8 * 2) = gv[q];
        }
        if (tau < 64) LRU_LOAD(tau + 1);
        __syncthreads();
        f32x4 accr[4], acci[4];
#pragma unroll
        for (int m = 0; m < 4; ++m) { accr[m] = (f32x4){0.f, 0.f, 0.f, 0.f}; acci[m] = (f32x4){0.f, 0.f, 0.f, 0.f}; }
#pragma unroll
        for (int m = 0; m < 4; ++m)
#pragma unroll
            for (int ks = 0; ks < 4; ++ks) { const bf16x8 a = *(const LAS bf16x8*)(lds + LRU_XA + (16 * m + fr) * LRU_STRIDE + (32 * ks + 8 * fq) * 2);
                accr[m] = mfma16(a, bwa[ks], accr[m]); acci[m] = mfma16(a, bwx[ks], acci[m]); }
        const int d = 16 * w + fr;
#pragma unroll
        for (int m = 0; m < 4; ++m) {
            float av[4], bv[4];
#pragma unroll
            for (int g = 0; g < 4; ++g) { const int rr = 16 * m + 4 * fq + g;
                const float rg = sigmoidf_fast(accr[m][g] + ba), ig = sigmoidf_fast(acci[m][g] + bx);
                const float la = cneg * rg; av[g] = __expf(la); const float mult = sqrtf(fmaxf(1.0f - __expf(2.0f * la), 0.f));
                bv[g] = mult * (ig * XF[rr * LRU_XF_STRIDE + d]);
                if (tau == 0 && rr < 48) bv[g] = 0.f; }
            float P = av[0] * av[1], H = bv[0] * av[1] + bv[1]; P *= av[2]; H = H * av[2] + bv[2]; P *= av[3]; H = H * av[3] + bv[3];
            { const float P1 = __shfl_up(P, 16), H1 = __shfl_up(H, 16); if (fq >= 1) { H = P * H1 + H; P = P1 * P; } }
            { const float P2 = __shfl_up(P, 32), H2 = __shfl_up(H, 32); if (fq >= 2) { H = P * H2 + H; P = P2 * P; } }
            float Pe = __shfl_up(P, 16), He = __shfl_up(H, 16); if (fq == 0) { Pe = 1.f; He = 0.f; }
            float h = Pe * hc + He;
            float hv[4];
#pragma unroll
            for (int g = 0; g < 4; ++g) { h = av[g] * h + bv[g]; hv[g] = h; }
            hc = __shfl(h, 48 + fr);
#pragma unroll
            for (int g = 0; g < 4; ++g) { const int rr = 16 * m + 4 * fq + g;
                const float gt = bf2f(*(const LAS unsigned short*)(lds + LRU_GT + rr * LRU_STRIDE + d * 2));
                *(LAS unsigned short*)(lds + LRU_YT + rr * LRU_STRIDE + d * 2) = (unsigned short)(pk2(hv[g] * gelu_tanh(gt), 0.f) & 0xffffu); }
        }
        __syncthreads();
#pragma unroll
        for (int q = 0; q < 2; ++q) { const int rr = r4 + 32 * q, t = 64 * tau + rr - 48;
            if (t >= 0) *(GAS v4u*)(y0 + (size_t)row_of(b, t) * DM + ch0) = *(const LAS v4u*)(lds + LRU_YT + rr * LRU_STRIDE + c8 * 2); }
    }
#undef LRU_LOAD
    __syncthreads();
}

constexpr int AT_STRIDE = 272, AT_TILE = 64 * AT_STRIDE, AT_KT = 0, AT_VN = 2 * AT_TILE, AT_RSK = 4 * AT_TILE, AT_CUM = AT_RSK + 512, AT_SCAN = AT_CUM + 4352 * 4;
static_assert(AT_SCAN + 64 <= RING_BYTES, "attention LDS map");
__device__ __forceinline__ float log_sigmoid(float x) { return fminf(x, 0.f) - log1pf(__expf(-fabsf(x))); }
__device__ __forceinline__ void attn_item(Frame& F, const Args& A, int b, int h, int j) {
    const bf16* z0 = (const bf16*)(F.ws + WS_Z); bf16* y0 = (bf16*)(F.ws + WS_Y0); const float* fbuf = (const float*)(F.ws + WS_FBUF);
    const int tid = F.tid, lane = F.lane, w = F.wave, fr = lane & 15, fq = lane >> 4;
    LAS unsigned char* lds = F.lds;
    LAS float* CUM = (LAS float*)(lds + AT_CUM); LAS float* SCAN = (LAS float*)(lds + AT_SCAN); LAS float* RSK = (LAS float*)(lds + AT_RSK);
    constexpr float LOG2E = 1.4426950408889634f;
    const int nT = NMETA + 256 * j;
    { const float bf_h = A.in[4][h];
      float loc[9]; float run = 0.f;
#pragma unroll
      for (int e = 0; e < 9; ++e) { const int t = 9 * tid + e; float v = 0.f; if (t < nT) v = log_sigmoid(fbuf[(size_t)row_of(b, t) * 16 + h] + bf_h); run += v; loc[e] = run; }
      float inc = run;
#pragma unroll
      for (int o = 1; o < 64; o <<= 1) { const float t = __shfl_up(inc, o); if (lane >= o) inc += t; }
      if (lane == 63) SCAN[w] = inc;
      __syncthreads();
      float off = inc - run;
      for (int k = 0; k < w; ++k) off += SCAN[k];
#pragma unroll
      for (int e = 0; e < 9; ++e) { const int t = 9 * tid + e; if (t < nT) CUM[t + 240] = (off + loc[e]) * LOG2E; }
      if (tid < 240) CUM[tid] = 0.f; }
    bf16x8 qf[2][4];
    const int ubase = 256 * j + 32 * w;
#pragma unroll
    for (int m = 0; m < 2; ++m) {
        const int u = ubase + 16 * m + fr; const int t = u - 240; const int r = row_of(b, t < 0 ? 0 : t);
        const bf16* qp = z0 + (size_t)r * AB_Z + 4096 + 128 * h + 8 * fq;
        float qv[4][8]; float s = 0.f;
#pragma unroll
        for (int ks = 0; ks < 4; ++ks) { const v4u raw = *(const GAS v4u*)(qp + 32 * ks); unpack8(raw, qv[ks]);
#pragma unroll
            for (int e = 0; e < 8; ++e) s += qv[ks][e] * qv[ks][e]; }
        s += __shfl_xor(s, 16); s += __shfl_xor(s, 32);
        const float rs = (1.0f / sqrtf(s * (1.0f / 128.0f) + RMS_EPS)) * (0.08838834764831845f * LOG2E);
#pragma unroll
        for (int ks = 0; ks < 4; ++ks) { float o[8];
#pragma unroll
            for (int e = 0; e < 8; ++e) o[e] = qv[ks][e] * rs * (A.in[12][32 * ks + 8 * fq + e] * A.in[13][32 * ks + 8 * fq + e]);
            const v4u pk = pack8f(o); qf[m][ks] = __builtin_bit_cast(bf16x8, pk); }
    }
    f32x4 O[2][8]; float mrow[2], lrow[2];
#pragma unroll
    for (int m = 0; m < 2; ++m) {
#pragma unroll
        for (int dt = 0; dt < 8; ++dt) O[m][dt] = (f32x4){0.f, 0.f, 0.f, 0.f};
        mrow[m] = -1e30f; lrow[m] = 0.f; }
    const int imax = 4 * j + 3;
    const int skey = tid >> 3, sdc = (tid & 7) * 16;
    const unsigned vbase = (unsigned)(size_t)lds + AT_VN + (4u * fq + ((unsigned)(lane & 15) >> 2)) * AT_STRIDE + 8u * (unsigned)(lane & 3);
    v4u kreg[2], vreg[2];
#define AT_LOAD(i_) do { const int t_ = 64 * (i_) + skey - 240; const int r_ = row_of(b, t_ < 0 ? 0 : t_); const bf16* kp_ = z0 + (size_t)r_ * AB_Z + 6144 + 128 * h + sdc; const bf16* vp_ = z0 + (size_t)r_ * AB_Z + 8192 + 128 * h + sdc; \
        kreg[0] = *(const GAS v4u*)(kp_); kreg[1] = *(const GAS v4u*)(kp_ + 8); vreg[0] = *(const GAS v4u*)(vp_); vreg[1] = *(const GAS v4u*)(vp_ + 8); } while (0)
#define AT_STAGE(buf_) do { float a8_[8], b8_[8]; unpack8(kreg[0], a8_); unpack8(kreg[1], b8_); float s_ = 0.f; \
        _Pragma("unroll") for (int e = 0; e < 8; ++e) s_ += a8_[e] * a8_[e] + b8_[e] * b8_[e]; \
        s_ += __shfl_xor(s_, 1); s_ += __shfl_xor(s_, 2); s_ += __shfl_xor(s_, 4); \
        if ((tid & 7) == 0) RSK[(buf_) * 64 + skey] = 1.0f / sqrtf(s_ * (1.0f / 128.0f) + RMS_EPS); \
        *(LAS v4u*)(lds + AT_KT + (buf_) * AT_TILE + skey * AT_STRIDE + sdc * 2) = kreg[0]; *(LAS v4u*)(lds + AT_KT + (buf_) * AT_TILE + skey * AT_STRIDE + sdc * 2 + 16) = kreg[1]; \
        *(LAS v4u*)(lds + AT_VN + (buf_) * AT_TILE + skey * AT_STRIDE + sdc * 2) = vreg[0]; *(LAS v4u*)(lds + AT_VN + (buf_) * AT_TILE + skey * AT_STRIDE + sdc * 2 + 16) = vreg[1]; } while (0)
    AT_LOAD(3); AT_STAGE(1);
    if (imax > 3) AT_LOAD(4);
    __syncthreads();
    float bq[2];
#pragma unroll
    for (int m = 0; m < 2; ++m) bq[m] = CUM[ubase + 16 * m + fr];
    for (int i = 3; i <= imax; ++i) {
        const int buf = i & 1;
        if (i < imax) { AT_STAGE(buf ^ 1); if (i + 1 < imax) AT_LOAD(i + 2); }
        if (64 * i <= ubase + 31) {
            f32x4 S[2][4];
#pragma unroll
            for (int m = 0; m < 2; ++m)
#pragma unroll
                for (int nt = 0; nt < 4; ++nt) S[m][nt] = (f32x4){0.f, 0.f, 0.f, 0.f};
#pragma unroll
            for (int nt = 0; nt < 4; ++nt)
#pragma unroll
                for (int ks = 0; ks < 4; ++ks) { const bf16x8 kf = *(const LAS bf16x8*)(lds + AT_KT + buf * AT_TILE + (16 * nt + fr) * AT_STRIDE + (32 * ks + 8 * fq) * 2);
                    S[0][nt] = mfma16(kf, qf[0][ks], S[0][nt]); S[1][nt] = mfma16(kf, qf[1][ks], S[1][nt]); }
            f32x4 bk[4], rk[4];
#pragma unroll
            for (int nt = 0; nt < 4; ++nt) { bk[nt] = *(const LAS f32x4*)(CUM + 64 * i + 16 * nt + 4 * fq); rk[nt] = *(const LAS f32x4*)(RSK + buf * 64 + 16 * nt + 4 * fq); }
            const bool need_mask = (i == 3) || (64 * i + 63 > ubase);
            bf16x8 pb[2][2];
#pragma unroll
            for (int m = 0; m < 2; ++m) {
                const int uq = ubase + 16 * m + fr;
                float mx = -__builtin_inff();
#pragma unroll
                for (int nt = 0; nt < 4; ++nt)
#pragma unroll
                    for (int g = 0; g < 4; ++g) { float sv = S[m][nt][g] * rk[nt][g] + (bq[m] - bk[nt][g]);
                        if (need_mask) { const int uk = 64 * i + 16 * nt + 4 * fq + g; if (uk > uq || uk < 240) sv = -__builtin_inff(); }
                        S[m][nt][g] = sv; mx = fmaxf(mx, sv); }
                mx = fmaxf(mx, __shfl_xor(mx, 16)); mx = fmaxf(mx, __shfl_xor(mx, 32));
                const float mn = fmaxf(mrow[m], mx);
                const float alpha = __builtin_amdgcn_exp2f(mrow[m] - mn); mrow[m] = mn;
                float ps = 0.f;
#pragma unroll
                for (int nt = 0; nt < 4; ++nt)
#pragma unroll
                    for (int g = 0; g < 4; ++g) { const float p = __builtin_amdgcn_exp2f(S[m][nt][g] - mn); ps += p; S[m][nt][g] = p; }
                lrow[m] = lrow[m] * alpha + ps;
                if (!__all(alpha == 1.0f)) {
#pragma unroll
                    for (int dt = 0; dt < 8; ++dt) O[m][dt] *= alpha; }
#pragma unroll
                for (int k2 = 0; k2 < 2; ++k2) { v4u pw; pw.x = pk2(S[m][2 * k2][0], S[m][2 * k2][1]); pw.y = pk2(S[m][2 * k2][2], S[m][2 * k2][3]); pw.z = pk2(S[m][2 * k2 + 1][0], S[m][2 * k2 + 1][1]); pw.w = pk2(S[m][2 * k2 + 1][2], S[m][2 * k2 + 1][3]);
                    pb[m][k2] = __builtin_bit_cast(bf16x8, pw); }
            }
            const unsigned vb = vbase + (unsigned)(buf * AT_TILE);
            { v2u vp[16]; asm volatile("ds_read_b64_tr_b16 %0, %16 offset:0 \n\tds_read_b64_tr_b16 %1, %16 offset:4352 \n\tds_read_b64_tr_b16 %2, %16 offset:8704 \n\tds_read_b64_tr_b16 %3, %16 offset:13056 \n\tds_read_b64_tr_b16 %4, %16 offset:32 \n\tds_read_b64_tr_b16 %5, %16 offset:4384 \n\tds_read_b64_tr_b16 %6, %16 offset:8736 \n\tds_read_b64_tr_b16 %7, %16 offset:13088 \n\tds_read_b64_tr_b16 %8, %16 offset:64 \n\tds_read_b64_tr_b16 %9, %16 offset:4416 \n\tds_read_b64_tr_b16 %10, %16 offset:8768 \n\tds_read_b64_tr_b16 %11, %16 offset:13120 \n\tds_read_b64_tr_b16 %12, %16 offset:96 \n\tds_read_b64_tr_b16 %13, %16 offset:4448 \n\tds_read_b64_tr_b16 %14, %16 offset:8800 \n\tds_read_b64_tr_b16 %15, %16 offset:13152 \n\ts_waitcnt lgkmcnt(0)" : "=&v"(vp[0]), "=&v"(vp[1]), "=&v"(vp[2]), "=&v"(vp[3]), "=&v"(vp[4]), "=&v"(vp[5]), "=&v"(vp[6]), "=&v"(vp[7]), "=&v"(vp[8]), "=&v"(vp[9]), "=&v"(vp[10]), "=&v"(vp[11]), "=&v"(vp[12]), "=&v"(vp[13]), "=&v"(vp[14]), "=&v"(vp[15]) : "v"(vb) : "memory");
              { v4u aw; aw.x = vp[0].x; aw.y = vp[0].y; aw.z = vp[1].x; aw.w = vp[1].y; const bf16x8 vfr = __builtin_bit_cast(bf16x8, aw); O[0][0] = mfma16(vfr, pb[0][0], O[0][0]); O[1][0] = mfma16(vfr, pb[1][0], O[1][0]); }
              { v4u aw; aw.x = vp[2].x; aw.y = vp[2].y; aw.z = vp[3].x; aw.w = vp[3].y; const bf16x8 vfr = __builtin_bit_cast(bf16x8, aw); O[0][0] = mfma16(vfr, pb[0][1], O[0][0]); O[1][0] = mfma16(vfr, pb[1][1], O[1][0]); }
              { v4u aw; aw.x = vp[4].x; aw.y = vp[4].y; aw.z = vp[5].x; aw.w = vp[5].y; const bf16x8 vfr = __builtin_bit_cast(bf16x8, aw); O[0][1] = mfma16(vfr, pb[0][0], O[0][1]); O[1][1] = mfma16(vfr, pb[1][0], O[1][1]); }
              { v4u aw; aw.x = vp[6].x; aw.y = vp[6].y; aw.z = vp[7].x; aw.w = vp[7].y; const bf16x8 vfr = __builtin_bit_cast(bf16x8, aw); O[0][1] = mfma16(vfr, pb[0][1], O[0][1]); O[1][1] = mfma16(vfr, pb[1][1], O[1][1]); }
              { v4u aw; aw.x = vp[8].x; aw.y = vp[8].y; aw.z = vp[9].x; aw.w = vp[9].y; const bf16x8 vfr = __builtin_bit_cast(bf16x8, aw); O[0][2] = mfma16(vfr, pb[0][0], O[0][2]); O[1][2] = mfma16(vfr, pb[1][0], O[1][2]); }
              { v4u aw; aw.x = vp[10].x; aw.y = vp[10].y; aw.z = vp[11].x; aw.w = vp[11].y; const bf16x8 vfr = __builtin_bit_cast(bf16x8, aw); O[0][2] = mfma16(vfr, pb[0][1], O[0][2]); O[1][2] = mfma16(vfr, pb[1][1], O[1][2]); }
              { v4u aw; aw.x = vp[12].x; aw.y = vp[12].y; aw.z = vp[13].x; aw.w = vp[13].y; const bf16x8 vfr = __builtin_bit_cast(bf16x8, aw); O[0][3] = mfma16(vfr, pb[0][0], O[0][3]); O[1][3] = mfma16(vfr, pb[1][0], O[1][3]); }
              { v4u aw; aw.x = vp[14].x; aw.y = vp[14].y; aw.z = vp[15].x; aw.w = vp[15].y; const bf16x8 vfr = __builtin_bit_cast(bf16x8, aw); O[0][3] = mfma16(vfr, pb[0][1], O[0][3]); O[1][3] = mfma16(vfr, pb[1][1], O[1][3]); }
            }
            { v2u vp[16]; asm volatile("ds_read_b64_tr_b16 %0, %16 offset:128 \n\tds_read_b64_tr_b16 %1, %16 offset:4480 \n\tds_read_b64_tr_b16 %2, %16 offset:8832 \n\tds_read_b64_tr_b16 %3, %16 offset:13184 \n\tds_read_b64_tr_b16 %4, %16 offset:160 \n\tds_read_b64_tr_b16 %5, %16 offset:4512 \n\tds_read_b64_tr_b16 %6, %16 offset:8864 \n\tds_read_b64_tr_b16 %7, %16 offset:13216 \n\tds_read_b64_tr_b16 %8, %16 offset:192 \n\tds_read_b64_tr_b16 %9, %16 offset:4544 \n\tds_read_b64_tr_b16 %10, %16 offset:8896 \n\tds_read_b64_tr_b16 %11, %16 offset:13248 \n\tds_read_b64_tr_b16 %12, %16 offset:224 \n\tds_read_b64_tr_b16 %13, %16 offset:4576 \n\tds_read_b64_tr_b16 %14, %16 offset:8928 \n\tds_read_b64_tr_b16 %15, %16 offset:13280 \n\ts_waitcnt lgkmcnt(0)" : "=&v"(vp[0]), "=&v"(vp[1]), "=&v"(vp[2]), "=&v"(vp[3]), "=&v"(vp[4]), "=&v"(vp[5]), "=&v"(vp[6]), "=&v"(vp[7]), "=&v"(vp[8]), "=&v"(vp[9]), "=&v"(vp[10]), "=&v"(vp[11]), "=&v"(vp[12]), "=&v"(vp[13]), "=&v"(vp[14]), "=&v"(vp[15]) : "v"(vb) : "memory");
              { v4u aw; aw.x = vp[0].x; aw.y = vp[0].y; aw.z = vp[1].x; aw.w = vp[1].y; const bf16x8 vfr = __builtin_bit_cast(bf16x8, aw); O[0][4] = mfma16(vfr, pb[0][0], O[0][4]); O[1][4] = mfma16(vfr, pb[1][0], O[1][4]); }
              { v4u aw; aw.x = vp[2].x; aw.y = vp[2].y; aw.z = vp[3].x; aw.w = vp[3].y; const bf16x8 vfr = __builtin_bit_cast(bf16x8, aw); O[0][4] = mfma16(vfr, pb[0][1], O[0][4]); O[1][4] = mfma16(vfr, pb[1][1], O[1][4]); }
              { v4u aw; aw.x = vp[4].x; aw.y = vp[4].y; aw.z = vp[5].x; aw.w = vp[5].y; const bf16x8 vfr = __builtin_bit_cast(bf16x8, aw); O[0][5] = mfma16(vfr, pb[0][0], O[0][5]); O[1][5] = mfma16(vfr, pb[1][0], O[1][5]); }
              { v4u aw; aw.x = vp[6].x; aw.y = vp[6].y; aw.z = vp[7].x; aw.w = vp[7].y; const bf16x8 vfr = __builtin_bit_cast(bf16x8, aw); O[0][5] = mfma16(vfr, pb[0][1], O[0][5]); O[1][5] = mfma16(vfr, pb[1][1], O[1][5]); }
              { v4u aw; aw.x = vp[8].x; aw.y = vp[8].y; aw.z = vp[9].x; aw.w = vp[9].y; const bf16x8 vfr = __builtin_bit_cast(bf16x8, aw); O[0][6] = mfma16(vfr, pb[0][0], O[0][6]); O[1][6] = mfma16(vfr, pb[1][0], O[1][6]); }
              { v4u aw; aw.x = vp[10].x; aw.y = vp[10].y; aw.z = vp[11].x; aw.w = vp[11].y; const bf16x8 vfr = __builtin_bit_cast(bf16x8, aw); O[0][6] = mfma16(vfr, pb[0][1], O[0][6]); O[1][6] = mfma16(vfr, pb[1][1], O[1][6]); }
              { v4u aw; aw.x = vp[12].x; aw.y = vp[12].y; aw.z = vp[13].x; aw.w = vp[13].y; const bf16x8 vfr = __builtin_bit_cast(bf16x8, aw); O[0][7] = mfma16(vfr, pb[0][0], O[0][7]); O[1][7] = mfma16(vfr, pb[1][0], O[1][7]); }
              { v4u aw; aw.x = vp[14].x; aw.y = vp[14].y; aw.z = vp[15].x; aw.w = vp[15].y; const bf16x8 vfr = __builtin_bit_cast(bf16x8, aw); O[0][7] = mfma16(vfr, pb[0][1], O[0][7]); O[1][7] = mfma16(vfr, pb[1][1], O[1][7]); }
            }
        }
        __syncthreads();
    }
#undef AT_LOAD
#undef AT_STAGE
#pragma unroll
    for (int m = 0; m < 2; ++m) {
        float l = lrow[m]; l += __shfl_xor(l, 16); l += __shfl_xor(l, 32);
        const int t = ubase + 16 * m + fr - 240;
        if (t >= 0) { const float il = 1.0f / l; bf16* op = y0 + (size_t)row_of(b, t) * DM + LRU_W + 128 * h + 4 * fq;
#pragma unroll
            for (int dt = 0; dt < 8; ++dt) { v2u o; o.x = pk2(O[m][dt][0] * il, O[m][dt][1] * il); o.y = pk2(O[m][dt][2] * il, O[m][dt][3] * il); *(GAS v2u*)(op + 16 * dt) = o; } }
    }
}

__device__ __forceinline__ int p2_fetch(Frame& F, gu32* qctr) {
    if (F.tid == 0) F.MISC[0] = __hip_atomic_fetch_add(qctr, 1u, RLX_AGENT);
    __syncthreads();
    const int item = (int)F.MISC[0];
    __syncthreads();
    return item;
}
__device__ __forceinline__ void p2_mixer0(Frame& F, const Args& A, int rep) {
    gu32* qctr = (gu32*)(F.ws + WS_CTL) + CW_Q2 + 64 * rep;
    constexpr int N_LRU = NB * 16, N_ATT = NB * FOX_H * 17;
    constexpr int RB = (N_ATT / 3) < (N_CONV / 2) ? (N_ATT / 3) : (N_CONV / 2), REM_ATT = N_ATT - 3 * RB, REM_CONV = N_CONV - 2 * RB;
    int item = p2_fetch(F, qctr);
    while (item < N_LRU) { lru_item(F, A, item >> 4, item & 15); item = p2_fetch(F, qctr); }
    while (item < N_LRU + N_ATT + N_CONV) {
        const int y = item - N_LRU; int att = -1, cv = -1;
        if (y < 5 * RB) { const int blk = y / 5, sl = y - 5 * blk; if (sl == 1 || sl == 3) cv = 2 * blk + (sl >> 1); else att = 3 * blk + (sl >> 1); }
        else { const int y2 = y - 5 * RB; if (y2 < REM_ATT) att = 3 * RB + y2; else cv = 2 * RB + (y2 - REM_ATT); }
        if (rep != 0) cv = -2;
        Frame G = F; { int tz = F.tid; asm volatile("" : "+v"(tz)); G.tid = tz; G.lane = tz & 63; G.wave = __builtin_amdgcn_readfirstlane(tz >> 6); }
        if (att >= 0) { const int j = 16 - att / 64, bh = att % 64; attn_item(G, A, bh >> 4, bh & 15, j); }
        else if (cv >= 0) { const ConvPtrs CP{A.in[20], A.in[21], A.in[22], A.in[16], A.in[18], A.in[19], A.in[15]}; conv_item(G.ws, G.lds, CP, cv, G.wave, G.lane); }
        item = p2_fetch(F, qctr);
    }
}

constexpr int RT_SQ = 528, RT_SV = 272, RT_SS_STRIDE = 144;
constexpr int RT_QS = 0, RT_KN = 33792, RT_VN = 67584, RT_VS = 84992, RT_SS = 102400;
static_assert(RT_KN == 64 * RT_SQ && RT_VN == RT_KN + 64 * RT_SQ && RT_VS == RT_VN + 64 * RT_SV && RT_SS == RT_VS + 64 * RT_SV && RT_SS + 64 * RT_SS_STRIDE <= MISC_OFF, "retention LDS map");
__device__ __forceinline__ int ret_row(int b, int c, int idx) { return c == 0 ? (idx < 48 ? -1 : MMETA + NMETA * b + (idx - 48)) : b * SEQ + 64 * (c - 1) + idx; }
__device__ __forceinline__ void ret_item(Frame& F, const Args& A, int b, int h, int es, bool accum) {
    const bf16* z1 = (const bf16*)(F.ws + WS_Z); bf16* ob = (bf16*)(F.ws + WS_Y1); float* ssqo = (float*)(F.ws + WS_SSQO);
    const int tid = F.tid, lane = F.lane, w = F.wave, fr = lane & 15, fq = lane >> 4;
    LAS unsigned char* lds = F.lds;
    const float lg = log1pf(-exp2f(-5.0f - (float)h)) * 1.4426950408889634f;
    const float cdec = __builtin_amdgcn_exp2f(lg * 64.0f);
    f32x4 Sacc[16];
#pragma unroll
    for (int dt = 0; dt < 16; ++dt) Sacc[dt] = (f32x4){0.f, 0.f, 0.f, 0.f};
    const int qrow = tid >> 5, qd = (tid & 31) * 8;
    const int vrow = tid >> 4, ve = (tid & 15) * 8;
    const float kd0 = __builtin_amdgcn_exp2f(lg * (float)(63 - vrow)), kd1 = __builtin_amdgcn_exp2f(lg * (float)(31 - vrow));
    const unsigned lbase = (unsigned)(size_t)lds;
    const unsigned trq = (unsigned)((lane & 15) >> 2), trp = (unsigned)(lane & 3);
    const unsigned kbase = lbase + RT_KN + (8u * fq + trq) * RT_SQ + 8u * trp;
    const unsigned vbase = lbase + RT_VN + (8u * fq + trq) * RT_SV + 32u * w + 8u * trp;
    const unsigned vsbase = vbase + (RT_VS - RT_VN);
    v4u qreg[4], kreg[4], vreg[2];
    const size_t qcol = (size_t)h * RET_QK + qd, kcol = 4096 + (size_t)h * RET_QK + qd, vcol = 8192 + (size_t)h * RET_V + 128 * es + ve;
#define RT_PREFETCH(c) do { \
        _Pragma("unroll") for (int k = 0; k < 4; ++k) { const int r = ret_row(b, (c), qrow + 16 * k); \
            if (r >= 0) { qreg[k] = *(const GAS v4u*)(z1 + (size_t)r * RET_IN + qcol); kreg[k] = *(const GAS v4u*)(z1 + (size_t)r * RET_IN + kcol); } \
            else { qreg[k] = (v4u){0u, 0u, 0u, 0u}; kreg[k] = (v4u){0u, 0u, 0u, 0u}; } } \
        _Pragma("unroll") for (int k = 0; k < 2; ++k) { const int r = ret_row(b, (c), vrow + 32 * k); \
            if (r >= 0) vreg[k] = *(const GAS v4u*)(z1 + (size_t)r * RET_IN + vcol); else vreg[k] = (v4u){0u, 0u, 0u, 0u}; } } while (0)
    RT_PREFETCH(0);
    for (int c = 0; c < 65; ++c) {
        __syncthreads();
#pragma unroll
        for (int k = 0; k < 4; ++k) { const int m = qrow + 16 * k;
            *(LAS v4u*)(lds + RT_QS + m * RT_SQ + qd * 2) = qreg[k];
            *(LAS v4u*)(lds + RT_KN + m * RT_SQ + qd * 2) = kreg[k]; }
#pragma unroll
        for (int k = 0; k < 2; ++k) { const int m = vrow + 32 * k; float vf8[8]; unpack8(vreg[k], vf8); const float kd = k == 0 ? kd0 : kd1;
            *(LAS v4u*)(lds + RT_VN + m * RT_SV + ve * 2) = vreg[k];
#pragma unroll
            for (int e = 0; e < 8; ++e) vf8[e] *= kd;
            *(LAS v4u*)(lds + RT_VS + m * RT_SV + ve * 2) = pack8f(vf8); }
        __syncthreads();
        if (c < 64) RT_PREFETCH(c + 1);
        { const int it = w >> 1, mt0 = 2 * (w & 1);
          f32x4 sacc[2] = {(f32x4){0.f, 0.f, 0.f, 0.f}, (f32x4){0.f, 0.f, 0.f, 0.f}};
#pragma unroll
          for (int ks = 0; ks < 8; ++ks) { const bf16x8 a = *(const LAS bf16x8*)(lds + RT_QS + (16 * it + fr) * RT_SQ + (32 * ks + 8 * fq) * 2);
#pragma unroll
              for (int q = 0; q < 2; ++q) { const bf16x8 kb = *(const LAS bf16x8*)(lds + RT_KN + (16 * (mt0 + q) + fr) * RT_SQ + (32 * ks + 8 * fq) * 2); sacc[q] = mfma16(a, kb, sacc[q]); } }
#pragma unroll
          for (int q = 0; q < 2; ++q)
#pragma unroll
              for (int g = 0; g < 4; ++g) { const int i = 16 * it + 4 * fq + g, m = 16 * (mt0 + q) + fr; const int dd = i > m ? i - m : m - i;
                  const float sv = sacc[q][g] * __builtin_amdgcn_exp2f(lg * (float)dd);
                  *(LAS unsigned short*)(lds + RT_SS + i * RT_SS_STRIDE + m * 2) = (unsigned short)(pk2(sv, 0.f) & 0xffffu); } }
        __syncthreads();
        f32x4 acc[4];
#pragma unroll
        for (int mi = 0; mi < 4; ++mi) acc[mi] = (f32x4){0.f, 0.f, 0.f, 0.f};
#pragma unroll
        for (int kk = 0; kk < 8; ++kk) {
            v4u bw; bw.x = pk2(Sacc[2 * kk][0], Sacc[2 * kk][1]); bw.y = pk2(Sacc[2 * kk][2], Sacc[2 * kk][3]); bw.z = pk2(Sacc[2 * kk + 1][0], Sacc[2 * kk + 1][1]); bw.w = pk2(Sacc[2 * kk + 1][2], Sacc[2 * kk + 1][3]);
            const bf16x8 bfrag = __builtin_bit_cast(bf16x8, bw);
#pragma unroll
            for (int mi = 0; mi < 4; ++mi) { const LAS unsigned char* qp = lds + RT_QS + (16 * mi + fr) * RT_SQ + (32 * kk + 4 * fq) * 2;
                const v2u lo = *(const LAS v2u*)(qp), hi = *(const LAS v2u*)(qp + 32);
                v4u aw; aw.x = lo.x; aw.y = lo.y; aw.z = hi.x; aw.w = hi.y;
                acc[mi] = mfma16(__builtin_bit_cast(bf16x8, aw), bfrag, acc[mi]); } }
#pragma unroll
        for (int mi = 0; mi < 4; ++mi)
#pragma unroll
            for (int g = 0; g < 4; ++g) acc[mi][g] *= __builtin_amdgcn_exp2f(lg * (float)(16 * mi + 4 * fq + g + 1));
        v2u vp[8];
        asm volatile("ds_read_b64_tr_b16 %0, %4 offset:0 \n\tds_read_b64_tr_b16 %1, %4 offset:1088 \n\tds_read_b64_tr_b16 %2, %4 offset:8704 \n\tds_read_b64_tr_b16 %3, %4 offset:9792 \n\ts_waitcnt lgkmcnt(0)" : "=&v"(vp[0]), "=&v"(vp[1]), "=&v"(vp[2]), "=&v"(vp[3]) : "v"(vbase) : "memory");
        asm volatile("ds_read_b64_tr_b16 %0, %4 offset:0 \n\tds_read_b64_tr_b16 %1, %4 offset:1088 \n\tds_read_b64_tr_b16 %2, %4 offset:8704 \n\tds_read_b64_tr_b16 %3, %4 offset:9792 \n\ts_waitcnt lgkmcnt(0)" : "=&v"(vp[4]), "=&v"(vp[5]), "=&v"(vp[6]), "=&v"(vp[7]) : "v"(vsbase) : "memory");
        bf16x8 vf[2], vs[2];
        { v4u t0; t0.x = vp[0].x; t0.y = vp[0].y; t0.z = vp[1].x; t0.w = vp[1].y; vf[0] = __builtin_bit_cast(bf16x8, t0); v4u t1; t1.x = vp[4].x; t1.y = vp[4].y; t1.z = vp[5].x; t1.w = vp[5].y; vs[0] = __builtin_bit_cast(bf16x8, t1); }
        { v4u t0; t0.x = vp[2].x; t0.y = vp[2].y; t0.z = vp[3].x; t0.w = vp[3].y; vf[1] = __builtin_bit_cast(bf16x8, t0); v4u t1; t1.x = vp[6].x; t1.y = vp[6].y; t1.z = vp[7].x; t1.w = vp[7].y; vs[1] = __builtin_bit_cast(bf16x8, t1); }
#pragma unroll
        for (int mi = 0; mi < 4; ++mi)
#pragma unroll
            for (int k2 = 0; k2 < 2; ++k2) { const bf16x8 a = *(const LAS bf16x8*)(lds + RT_SS + (16 * mi + fr) * RT_SS_STRIDE + (32 * k2 + 8 * fq) * 2); acc[mi] = mfma16(a, vf[k2], acc[mi]); }
        if (c > 0) {
#pragma unroll
            for (int mi = 0; mi < 4; ++mi)
#pragma unroll
                for (int g = 0; g < 4; ++g) { const int r = b * SEQ + 64 * (c - 1) + 16 * mi + 4 * fq + g; const float v = acc[mi][g];
                    ob[(size_t)r * RET_VW + h * RET_V + 128 * es + 16 * w + fr] = (bf16)(pk2(v, 0.f) & 0xffffu);
                    float sq = v * v; sq += __shfl_xor(sq, 1); sq += __shfl_xor(sq, 2); sq += __shfl_xor(sq, 4); sq += __shfl_xor(sq, 8);
                    if (fr == 0 && accum) atomicAdd(ssqo + (size_t)r * 16 + h, sq); }
        }
#pragma unroll
        for (int dt = 0; dt < 16; ++dt) Sacc[dt] *= cdec;
        { v2u kp[16]; asm volatile("ds_read_b64_tr_b16 %0, %16 offset:0 \n\tds_read_b64_tr_b16 %1, %16 offset:2112 \n\tds_read_b64_tr_b16 %2, %16 offset:16896 \n\tds_read_b64_tr_b16 %3, %16 offset:19008 \n\tds_read_b64_tr_b16 %4, %16 offset:32 \n\tds_read_b64_tr_b16 %5, %16 offset:2144 \n\tds_read_b64_tr_b16 %6, %16 offset:16928 \n\tds_read_b64_tr_b16 %7, %16 offset:19040 \n\tds_read_b64_tr_b16 %8, %16 offset:64 \n\tds_read_b64_tr_b16 %9, %16 offset:2176 \n\tds_read_b64_tr_b16 %10, %16 offset:16960 \n\tds_read_b64_tr_b16 %11, %16 offset:19072 \n\tds_read_b64_tr_b16 %12, %16 offset:96 \n\tds_read_b64_tr_b16 %13, %16 offset:2208 \n\tds_read_b64_tr_b16 %14, %16 offset:16992 \n\tds_read_b64_tr_b16 %15, %16 offset:19104 \n\ts_waitcnt lgkmcnt(0)" : "=&v"(kp[0]), "=&v"(kp[1]), "=&v"(kp[2]), "=&v"(kp[3]), "=&v"(kp[4]), "=&v"(kp[5]), "=&v"(kp[6]), "=&v"(kp[7]), "=&v"(kp[8]), "=&v"(kp[9]), "=&v"(kp[10]), "=&v"(kp[11]), "=&v"(kp[12]), "=&v"(kp[13]), "=&v"(kp[14]), "=&v"(kp[15]) : "v"(kbase) : "memory");
          { v4u aw; aw.x = kp[0].x; aw.y = kp[0].y; aw.z = kp[1].x; aw.w = kp[1].y; Sacc[0] = mfma16(__builtin_bit_cast(bf16x8, aw), vs[0], Sacc[0]); }
          { v4u aw; aw.x = kp[2].x; aw.y = kp[2].y; aw.z = kp[3].x; aw.w = kp[3].y; Sacc[0] = mfma16(__builtin_bit_cast(bf16x8, aw), vs[1], Sacc[0]); }
          { v4u aw; aw.x = kp[4].x; aw.y = kp[4].y; aw.z = kp[5].x; aw.w = kp[5].y; Sacc[1] = mfma16(__builtin_bit_cast(bf16x8, aw), vs[0], Sacc[1]); }
          { v4u aw; aw.x = kp[6].x; aw.y = kp[6].y; aw.z = kp[7].x; aw.w = kp[7].y; Sacc[1] = mfma16(__builtin_bit_cast(bf16x8, aw), vs[1], Sacc[1]); }
          { v4u aw; aw.x = kp[8].x; aw.y = kp[8].y; aw.z = kp[9].x; aw.w = kp[9].y; Sacc[2] = mfma16(__builtin_bit_cast(bf16x8, aw), vs[0], Sacc[2]); }
          { v4u aw; aw.x = kp[10].x; aw.y = kp[10].y; aw.z = kp[11].x; aw.w = kp[11].y; Sacc[2] = mfma16(__builtin_bit_cast(bf16x8, aw), vs[1], Sacc[2]); }
          { v4u aw; aw.x = kp[12].x; aw.y = kp[12].y; aw.z = kp[13].x; aw.w = kp[13].y; Sacc[3] = mfma16(__builtin_bit_cast(bf16x8, aw), vs[0], Sacc[3]); }
          { v4u aw; aw.x = kp[14].x; aw.y = kp[14].y; aw.z = kp[15].x; aw.w = kp[15].y; Sacc[3] = mfma16(__builtin_bit_cast(bf16x8, aw), vs[1], Sacc[3]); }
        }
        { v2u kp[16]; asm volatile("ds_read_b64_tr_b16 %0, %16 offset:128 \n\tds_read_b64_tr_b16 %1, %16 offset:2240 \n\tds_read_b64_tr_b16 %2, %16 offset:17024 \n\tds_read_b64_tr_b16 %3, %16 offset:19136 \n\tds_read_b64_tr_b16 %4, %16 offset:160 \n\tds_read_b64_tr_b16 %5, %16 offset:2272 \n\tds_read_b64_tr_b16 %6, %16 offset:17056 \n\tds_read_b64_tr_b16 %7, %16 offset:19168 \n\tds_read_b64_tr_b16 %8, %16 offset:192 \n\tds_read_b64_tr_b16 %9, %16 offset:2304 \n\tds_read_b64_tr_b16 %10, %16 offset:17088 \n\tds_read_b64_tr_b16 %11, %16 offset:19200 \n\tds_read_b64_tr_b16 %12, %16 offset:224 \n\tds_read_b64_tr_b16 %13, %16 offset:2336 \n\tds_read_b64_tr_b16 %14, %16 offset:17120 \n\tds_read_b64_tr_b16 %15, %16 offset:19232 \n\ts_waitcnt lgkmcnt(0)" : "=&v"(kp[0]), "=&v"(kp[1]), "=&v"(kp[2]), "=&v"(kp[3]), "=&v"(kp[4]), "=&v"(kp[5]), "=&v"(kp[6]), "=&v"(kp[7]), "=&v"(kp[8]), "=&v"(kp[9]), "=&v"(kp[10]), "=&v"(kp[11]), "=&v"(kp[12]), "=&v"(kp[13]), "=&v"(kp[14]), "=&v"(kp[15]) : "v"(kbase) : "memory");
          { v4u aw; aw.x = kp[0].x; aw.y = kp[0].y; aw.z = kp[1].x; aw.w = kp[1].y; Sacc[4] = mfma16(__builtin_bit_cast(bf16x8, aw), vs[0], Sacc[4]); }
          { v4u aw; aw.x = kp[2].x; aw.y = kp[2].y; aw.z = kp[3].x; aw.w = kp[3].y; Sacc[4] = mfma16(__builtin_bit_cast(bf16x8, aw), vs[1], Sacc[4]); }
          { v4u aw; aw.x = kp[4].x; aw.y = kp[4].y; aw.z = kp[5].x; aw.w = kp[5].y; Sacc[5] = mfma16(__builtin_bit_cast(bf16x8, aw), vs[0], Sacc[5]); }
          { v4u aw; aw.x = kp[6].x; aw.y = kp[6].y; aw.z = kp[7].x; aw.w = kp[7].y; Sacc[5] = mfma16(__builtin_bit_cast(bf16x8, aw), vs[1], Sacc[5]); }
          { v4u aw; aw.x = kp[8].x; aw.y = kp[8].y; aw.z = kp[9].x; aw.w = kp[9].y; Sacc[6] = mfma16(__builtin_bit_cast(bf16x8, aw), vs[0], Sacc[6]); }
          { v4u aw; aw.x = kp[10].x; aw.y = kp[10].y; aw.z = kp[11].x; aw.w = kp[11].y; Sacc[6] = mfma16(__builtin_bit_cast(bf16x8, aw), vs[1], Sacc[6]); }
          { v4u aw; aw.x = kp[12].x; aw.y = kp[12].y; aw.z = kp[13].x; aw.w = kp[13].y; Sacc[7] = mfma16(__builtin_bit_cast(bf16x8, aw), vs[0], Sacc[7]); }
          { v4u aw; aw.x = kp[14].x; aw.y = kp[14].y; aw.z = kp[15].x; aw.w = kp[15].y; Sacc[7] = mfma16(__builtin_bit_cast(bf16x8, aw), vs[1], Sacc[7]); }
        }
        { v2u kp[16]; asm volatile("ds_read_b64_tr_b16 %0, %16 offset:256 \n\tds_read_b64_tr_b16 %1, %16 offset:2368 \n\tds_read_b64_tr_b16 %2, %16 offset:17152 \n\tds_read_b64_tr_b16 %3, %16 offset:19264 \n\tds_read_b64_tr_b16 %4, %16 offset:288 \n\tds_read_b64_tr_b16 %5, %16 offset:2400 \n\tds_read_b64_tr_b16 %6, %16 offset:17184 \n\tds_read_b64_tr_b16 %7, %16 offset:19296 \n\tds_read_b64_tr_b16 %8, %16 offset:320 \n\tds_read_b64_tr_b16 %9, %16 offset:2432 \n\tds_read_b64_tr_b16 %10, %16 offset:17216 \n\tds_read_b64_tr_b16 %11, %16 offset:19328 \n\tds_read_b64_tr_b16 %12, %16 offset:352 \n\tds_read_b64_tr_b16 %13, %16 offset:2464 \n\tds_read_b64_tr_b16 %14, %16 offset:17248 \n\tds_read_b64_tr_b16 %15, %16 offset:19360 \n\ts_waitcnt lgkmcnt(0)" : "=&v"(kp[0]), "=&v"(kp[1]), "=&v"(kp[2]), "=&v"(kp[3]), "=&v"(kp[4]), "=&v"(kp[5]), "=&v"(kp[6]), "=&v"(kp[7]), "=&v"(kp[8]), "=&v"(kp[9]), "=&v"(kp[10]), "=&v"(kp[11]), "=&v"(kp[12]), "=&v"(kp[13]), "=&v"(kp[14]), "=&v"(kp[15]) : "v"(kbase) : "memory");
          { v4u aw; aw.x = kp[0].x; aw.y = kp[0].y; aw.z = kp[1].x; aw.w = kp[1].y; Sacc[8] = mfma16(__builtin_bit_cast(bf16x8, aw), vs[0], Sacc[8]); }
          { v4u aw; aw.x = kp[2].x; aw.y = kp[2].y; aw.z = kp[3].x; aw.w = kp[3].y; Sacc[8] = mfma16(__builtin_bit_cast(bf16x8, aw), vs[1], Sacc[8]); }
          { v4u aw; aw.x = kp[4].x; aw.y = kp[4].y; aw.z = kp[5].x; aw.w = kp[5].y; Sacc[9] = mfma16(__builtin_bit_cast(bf16x8, aw), vs[0], Sacc[9]); }
          { v4u aw; aw.x = kp[6].x; aw.y = kp[6].y; aw.z = kp[7].x; aw.w = kp[7].y; Sacc[9] = mfma16(__builtin_bit_cast(bf16x8, aw), vs[1], Sacc[9]); }
          { v4u aw; aw.x = kp[8].x; aw.y = kp[8].y; aw.z = kp[9].x; aw.w = kp[9].y; Sacc[10] = mfma16(__builtin_bit_cast(bf16x8, aw), vs[0], Sacc[10]); }
          { v4u aw; aw.x = kp[10].x; aw.y = kp[10].y; aw.z = kp[11].x; aw.w = kp[11].y; Sacc[10] = mfma16(__builtin_bit_cast(bf16x8, aw), vs[1], Sacc[10]); }
          { v4u aw; aw.x = kp[12].x; aw.y = kp[12].y; aw.z = kp[13].x; aw.w = kp[13].y; Sacc[11] = mfma16(__builtin_bit_cast(bf16x8, aw), vs[0], Sacc[11]); }
          { v4u aw; aw.x = kp[14].x; aw.y = kp[14].y; aw.z = kp[15].x; aw.w = kp[15].y; Sacc[11] = mfma16(__builtin_bit_cast(bf16x8, aw), vs[1], Sacc[11]); }
        }
        { v2u kp[16]; asm volatile("ds_read_b64_tr_b16 %0, %16 offset:384 \n\tds_read_b64_tr_b16 %1, %16 offset:2496 \n\tds_read_b64_tr_b16 %2, %16 offset:17280 \n\tds_read_b64_tr_b16 %3, %16 offset:19392 \n\tds_read_b64_tr_b16 %4, %16 offset:416 \n\tds_read_b64_tr_b16 %5, %16 offset:2528 \n\tds_read_b64_tr_b16 %6, %16 offset:17312 \n\tds_read_b64_tr_b16 %7, %16 offset:19424 \n\tds_read_b64_tr_b16 %8, %16 offset:448 \n\tds_read_b64_tr_b16 %9, %16 offset:2560 \n\tds_read_b64_tr_b16 %10, %16 offset:17344 \n\tds_read_b64_tr_b16 %11, %16 offset:19456 \n\tds_read_b64_tr_b16 %12, %16 offset:480 \n\tds_read_b64_tr_b16 %13, %16 offset:2592 \n\tds_read_b64_tr_b16 %14, %16 offset:17376 \n\tds_read_b64_tr_b16 %15, %16 offset:19488 \n\ts_waitcnt lgkmcnt(0)" : "=&v"(kp[0]), "=&v"(kp[1]), "=&v"(kp[2]), "=&v"(kp[3]), "=&v"(kp[4]), "=&v"(kp[5]), "=&v"(kp[6]), "=&v"(kp[7]), "=&v"(kp[8]), "=&v"(kp[9]), "=&v"(kp[10]), "=&v"(kp[11]), "=&v"(kp[12]), "=&v"(kp[13]), "=&v"(kp[14]), "=&v"(kp[15]) : "v"(kbase) : "memory");
          { v4u aw; aw.x = kp[0].x; aw.y = kp[0].y; aw.z = kp[1].x; aw.w = kp[1].y; Sacc[12] = mfma16(__builtin_bit_cast(bf16x8, aw), vs[0], Sacc[12]); }
          { v4u aw; aw.x = kp[2].x; aw.y = kp[2].y; aw.z = kp[3].x; aw.w = kp[3].y; Sacc[12] = mfma16(__builtin_bit_cast(bf16x8, aw), vs[1], Sacc[12]); }
          { v4u aw; aw.x = kp[4].x; aw.y = kp[4].y; aw.z = kp[5].x; aw.w = kp[5].y; Sacc[13] = mfma16(__builtin_bit_cast(bf16x8, aw), vs[0], Sacc[13]); }
          { v4u aw; aw.x = kp[6].x; aw.y = kp[6].y; aw.z = kp[7].x; aw.w = kp[7].y; Sacc[13] = mfma16(__builtin_bit_cast(bf16x8, aw), vs[1], Sacc[13]); }
          { v4u aw; aw.x = kp[8].x; aw.y = kp[8].y; aw.z = kp[9].x; aw.w = kp[9].y; Sacc[14] = mfma16(__builtin_bit_cast(bf16x8, aw), vs[0], Sacc[14]); }
          { v4u aw; aw.x = kp[10].x; aw.y = kp[10].y; aw.z = kp[11].x; aw.w = kp[11].y; Sacc[14] = mfma16(__builtin_bit_cast(bf16x8, aw), vs[1], Sacc[14]); }
          { v4u aw; aw.x = kp[12].x; aw.y = kp[12].y; aw.z = kp[13].x; aw.w = kp[13].y; Sacc[15] = mfma16(__builtin_bit_cast(bf16x8, aw), vs[0], Sacc[15]); }
          { v4u aw; aw.x = kp[14].x; aw.y = kp[14].y; aw.z = kp[15].x; aw.w = kp[15].y; Sacc[15] = mfma16(__builtin_bit_cast(bf16x8, aw), vs[1], Sacc[15]); }
        }
    }
#undef RT_PREFETCH
    __syncthreads();
}
__device__ __forceinline__ void p7_retention(Frame& F, const Args& A, bool accum) {
    for (int item = blockIdx.x; item < NB * RET_H * 4; item += F.G) ret_item(F, A, item >> 6, (item >> 2) & 15, item & 3, accum);
}
__device__ __forceinline__ void p8_gate(Frame& F, const Args& A) {
    const bf16* z1 = (const bf16*)(F.ws + WS_Z); bf16* ob = (bf16*)(F.ws + WS_Y1); const float* ssqo = (const float*)(F.ws + WS_SSQO); const float* gain = A.in[17];
    const int gt = blockIdx.x * NTHREADS + F.tid, nthr = F.G * NTHREADS;
    const int c = (gt & 1023) * 8, hd = c >> 9, rstep = nthr >> 10, r0 = (gt >> 10) < rstep ? (gt >> 10) : MTOK;
    const f32x4 g0 = *(const GAS f32x4*)(gain + c), g1 = *(const GAS f32x4*)(gain + c + 4);
    for (int r = r0; r < MTOK; r += 4 * rstep) {
        v4u gw[4], ow[4]; float ss[4];
#pragma unroll
        for (int k = 0; k < 4; ++k) { const int rr = r + k * rstep; if (rr < MTOK) { gw[k] = *(const GAS v4u*)(z1 + (size_t)rr * RET_IN + 16384 + c); ow[k] = *(const GAS v4u*)(ob + (size_t)rr * RET_VW + c); ss[k] = ssqo[(size_t)rr * 16 + hd]; } }
#pragma unroll
        for (int k = 0; k < 4; ++k) { const int rr = r + k * rstep; if (rr < MTOK) {
            const float rs = 1.0f / sqrtf(ss[k] * (1.0f / 512.0f) + RMS_EPS);
            float gf[8], of[8], y[8]; unpack8(gw[k], gf); unpack8(ow[k], of);
#pragma unroll
            for (int e = 0; e < 8; ++e) { const float gn = e < 4 ? g0[e] : g1[e - 4]; y[e] = gf[e] * sigmoidf_fast(gf[e]) * (of[e] * rs * gn); }
            *(GAS v4u*)(ob + (size_t)rr * RET_VW + c) = pack8f(y); } }
    }
}


__device__ __forceinline__ void meta_fixup(Frame& F, const float* Hmeta, bf16* XB, float* ssq, const float* gain) {
    __syncthreads();
    if (F.MISC[4] != 0u) {
        __builtin_amdgcn_fence(__ATOMIC_ACQUIRE, "agent"); asm volatile("s_waitcnt vmcnt(0)" ::: "memory");
        for (int row = F.wave; row < NB * NMETA; row += NWAVES) { const float* hrow = Hmeta + (size_t)row * DM; bf16* xrow = XB + (size_t)(MTOK + row) * DM; float s = 0.f;
#pragma unroll 4
            for (int j = 0; j < 16; ++j) { const int e = (F.lane + 64 * j) * 4; const f32x4 v = *(const GAS f32x4*)(hrow + e);
                s += (v.x * v.x + v.y * v.y) + (v.z * v.z + v.w * v.w); const f32x4 gn = *(const GAS f32x4*)(gain + e); v2u w; w.x = pk2(v.x * gn.x, v.y * gn.y); w.y = pk2(v.z * gn.z, v.w * gn.w); *(GAS v2u*)(xrow + e) = w; }
            s = wave_sum(s);
            if (F.lane == 0) ssq[MTOK + row] = s; }
        __syncthreads();
        if (F.tid == 0) F.MISC[4] = 0u;
    }
    __syncthreads();
}

__global__ void __launch_bounds__(NTHREADS, 2) hybrid_fwd(Args args) {
    extern __shared__ __attribute__((aligned(16))) unsigned char lds_raw[];
    Frame F;
    F.lds = (LAS unsigned char*)lds_raw;
    F.MISC = (volatile LAS unsigned*)(F.lds + MISC_OFF);
    F.tid = threadIdx.x; F.lane = F.tid & 63; F.wave = __builtin_amdgcn_readfirstlane(F.tid >> 6);
    F.G = gridDim.x; F.ws = args.ws;
    if (F.tid < 64) F.MISC[F.tid] = 0u;
    __syncthreads();
    unsigned* ctl = (unsigned*)(F.ws + WS_CTL);
#if !MK_PER_PHASE
    const XcdBarrier bar = xcd_barrier_post(ctl + CW_BAR, F.MISC + 8);
#define GRID_BAR() xcd_barrier(bar)
#else
#define GRID_BAR() do { } while (0)
#endif
    const int lo = args.ph_lo, hi = args.ph_hi;
#ifndef PHASE_MASK
#define PHASE_MASK 0xFFF
#endif
#define IN(k) ((((PHASE_MASK) >> (k)) & 1) && lo <= (k) && (k) < hi)
#define BOTH(k) (IN(k) && IN((k) + 1))
#ifndef REPEAT_MASK
#define REPEAT_MASK 0
#endif
#define REPS(k) (1 + (((REPEAT_MASK) >> (k)) & 1))
    unsigned char* ws = F.ws;
    bf16* XB = (bf16*)(ws + WS_XB); float* Htok = args.out; float* Hmeta = (float*)(ws + WS_HMETA); bf16* Z = (bf16*)(ws + WS_Z); bf16* Y0 = (bf16*)(ws + WS_Y0); bf16* Y1 = (bf16*)(ws + WS_Y1);
    float* SSQ0 = (float*)(ws + WS_SSQ0); float* SSQ1 = (float*)(ws + WS_SSQ1); float* SSQ2 = (float*)(ws + WS_SSQ2); float* SSQ3 = (float*)(ws + WS_SSQ3);
    const int c = (int)blockIdx.x;

    if (IN(0)) { p0_prologue(F, args); if (REPS(0) > 1) p0_prologue(F, args); if (BOTH(0)) GRID_BAR(); }
    if (IN(1)) {
        pg8::Gemm g{XB, (const bf16*)(ws + WS_WIN0), MP, 41 * 256, DM}; pg8::StaticOrder S; S.init(MP, 41 * 256, DM, F.G, c);
        pg8::EpiIn0 E{Z, (float*)(ws + WS_FBUF), SSQ0};
        pg8::gemm_phase<pg8::EpiIn0, pg8::StaticOrder, true, true>(F.lds, g, S, E); if (REPS(1) > 1) { pg8::gemm_phase<pg8::EpiIn0, pg8::StaticOrder, true, true>(F.lds, g, S, E); }
        if (BOTH(1)) GRID_BAR();
    }
    if (IN(2)) { p2_mixer0(F, args, 0); if (REPS(2) > 1) { GRID_BAR(); p2_mixer0(F, args, 1); } if (BOTH(2)) GRID_BAR(); }
    if (IN(3)) {
        pg8::Gemm g{Y0, (const bf16*)(ws + WS_WOUT0), MP, DM, DM}; pg8::SplitMetaOrder S; S.init2(DM, DM, F.G, c, ctl + CW_TK3, F.MISC + 4);
        pg8::EpiRes E{args.in[0], Htok, Hmeta, XB, SSQ1, DM / 64, args.in[19]};
        pg8::gemm_phase<pg8::EpiRes, pg8::SplitMetaOrder, true, true>(F.lds, g, S, E);
        meta_fixup(F, Hmeta, XB, SSQ1, args.in[19]);
        if (BOTH(3)) GRID_BAR();
    }
    if (IN(4)) {
        pg8::Gemm g{XB, (const bf16*)(ws + WS_WGU0), MP, 2 * DFF, DM}; pg8::StaticOrder S; S.init(MP, 2 * DFF, DM, F.G, c);
        pg8::EpiGU E{Z, SSQ1};
        pg8::gemm_phase<pg8::EpiGU, pg8::StaticOrder, true, true>(F.lds, g, S, E); if (REPS(4) > 1) { pg8::gemm_phase<pg8::EpiGU, pg8::StaticOrder, true, true>(F.lds, g, S, E); }
        if (BOTH(4)) GRID_BAR();
    }
    if (IN(5)) {
        pg8::Gemm g{Z, (const bf16*)(ws + WS_WD0), MP, DM, DFF}; pg8::SplitMetaOrder S; S.init2(DM, DFF, F.G, c, ctl + CW_TK5, F.MISC + 4);
        pg8::EpiRes E{Htok, Htok, Hmeta, XB, SSQ2, DFF / 64, args.in[15]};
        pg8::gemm_phase<pg8::EpiRes, pg8::SplitMetaOrder, true, true>(F.lds, g, S, E);
        meta_fixup(F, Hmeta, XB, SSQ2, args.in[15]);
        if (BOTH(5)) GRID_BAR();
    }
    if (IN(6)) {
        pg8::Gemm g{XB, (const bf16*)(ws + WS_WIN1), MP, RET_IN, DM}; pg8::StaticOrder S; S.init(MP, RET_IN, DM, F.G, c);
        pg8::EpiIn1 E{Z, SSQ2};
        pg8::gemm_phase<pg8::EpiIn1, pg8::StaticOrder, true, true>(F.lds, g, S, E); if (REPS(6) > 1) { pg8::gemm_phase<pg8::EpiIn1, pg8::StaticOrder, true, true>(F.lds, g, S, E); }
        if (BOTH(6)) GRID_BAR();
    }
    if (IN(7)) { p7_retention(F, args, true); if (REPS(7) > 1) p7_retention(F, args, false); if (BOTH(7)) GRID_BAR(); }
    if (IN(8)) { p8_gate(F, args); if (BOTH(8)) GRID_BAR(); }
    if (IN(9)) {
        pg8::Gemm g{Y1, (const bf16*)(ws + WS_WOUT1), MTOK, DM, RET_VW}; pg8::StaticOrder S; S.init(MTOK, DM, RET_VW, F.G, c);
        pg8::EpiRes E{Htok, Htok, Hmeta, XB, SSQ3, RET_VW / 64, args.in[19] + DM};
        pg8::gemm_phase<pg8::EpiRes, pg8::StaticOrder, true, true>(F.lds, g, S, E);
        if (BOTH(9)) GRID_BAR();
    }
    if (IN(10)) {
        pg8::Gemm g{XB, (const bf16*)(ws + WS_WGU1), MTOK, 2 * DFF, DM}; pg8::StaticOrder S; S.init(MTOK, 2 * DFF, DM, F.G, c);
        pg8::EpiGU E{Z, SSQ3};
        pg8::gemm_phase<pg8::EpiGU, pg8::StaticOrder, true, true>(F.lds, g, S, E); if (REPS(10) > 1) { pg8::gemm_phase<pg8::EpiGU, pg8::StaticOrder, true, true>(F.lds, g, S, E); }
        if (BOTH(10)) GRID_BAR();
    }
    if (IN(11)) {
        pg8::Gemm g{Z, (const bf16*)(ws + WS_WD1), MTOK, DM, DFF}; pg8::StaticOrder S; S.init(MTOK, DM, DFF, F.G, c);
        pg8::EpiFinal E{args.out};
        pg8::gemm_phase<pg8::EpiFinal, pg8::StaticOrder, true, true>(F.lds, g, S, E);
    }
#undef IN
#undef BOTH
}

extern "C" void kernel_launch(void* const* d_in, const int* in_sizes, int n_in, void* d_out, int out_size, void* d_ws, size_t ws_size, hipStream_t stream) {
    static int grid = 0;
    if (grid == 0) {
        if (n_in != 23 || in_sizes[0] != MTOK * DM || out_size != MTOK * DM || ws_size < WS_END) { fprintf(stderr, "kernel_launch: unexpected shapes (n_in %d, in0 %d, out %d, ws %zu < %zu); nothing launched\n", n_in, n_in > 0 ? in_sizes[0] : -1, out_size, ws_size, (size_t)WS_END); grid = -1; return; }
        int dev = 0, cus = 0, per_cu = 0;
        if (hipGetDevice(&dev) != hipSuccess || hipDeviceGetAttribute(&cus, hipDeviceAttributeMultiprocessorCount, dev) != hipSuccess) { fprintf(stderr, "kernel_launch: device query failed\n"); grid = -1; return; }
        if (hipFuncSetAttribute((const void*)hybrid_fwd, hipFuncAttributeMaxDynamicSharedMemorySize, LDS_BYTES) != hipSuccess) { fprintf(stderr, "kernel_launch: hipFuncSetAttribute failed\n"); grid = -1; return; }
        if (hipOccupancyMaxActiveBlocksPerMultiprocessor(&per_cu, (const void*)hybrid_fwd, NTHREADS, LDS_BYTES) != hipSuccess || per_cu < 1) { fprintf(stderr, "kernel_launch: occupancy query reports %d workgroups per CU\n", per_cu); }
        (void)hipGetLastError();
        grid = cus;
    }
    if (grid < 0) return;
    if (hipMemsetAsync((char*)d_ws + WS_CTL, 0, CTL_ZERO_BYTES, stream) != hipSuccess) { fprintf(stderr, "kernel_launch: memset failed\n"); return; }
    Args a{};
    for (int i = 0; i < 23; ++i) a.in[i] = (const float*)d_in[i];
    a.out = (float*)d_out; a.ws = (unsigned char*)d_ws;
#if MK_PER_PHASE
    for (int p = 0; p < NPHASES; ++p) { a.ph_lo = p; a.ph_hi = p + 1; hipLaunchKernelGGL(hybrid_fwd, dim3(grid), dim3(NTHREADS), LDS_BYTES, stream, a); }
#else
    a.ph_lo = 0; a.ph_hi = NPHASES;
    hipLaunchKernelGGL(hybrid_fwd, dim3(grid), dim3(NTHREADS), LDS_BYTES, stream, a);
#endif
    const hipError_t le = hipPeekAtLastError();
    if (le != hipSuccess) fprintf(stderr, "kernel_launch: launch failed: %s\n", hipGetErrorName(le));
}
```

```cpp
#include <hip/hip_runtime.h>
#include <cstdio>
#include <cstdint>
#ifndef MK_PER_PHASE
#define MK_PER_PHASE 0
#endif
constexpr int DM = 4096, NB = 4, SEQ = 4096, NMETA = 16, LSEQ = NMETA + SEQ;
constexpr int MTOK = NB * SEQ;
constexpr int MMETA = MTOK;
constexpr int MP = 65 * 256;
constexpr int LRU_W = 2048, FOX_H = 16, FOX_D = 128, AB_IN = 10256, AB_Z = 10240;
constexpr int RET_H = 16, RET_QK = 256, RET_V = 512, RET_IN = 24576, RET_VW = 8192;
constexpr int DFF = 11008;
constexpr float RMS_EPS = 1e-6f;
typedef unsigned long long u64;
__device__ __forceinline__ u64 fx_from_pos(float s) { const float fl = floorf(s); return ((u64)(unsigned)fl << 32) | (u64)(unsigned)((s - fl) * 4294967296.0f); }
__device__ __forceinline__ float fx_to_pos(u64 x) { return (float)(unsigned)(x >> 32) + (float)(unsigned)x * (1.0f / 4294967296.0f); }
__device__ __forceinline__ u64 fx_from(float v) { return (u64)(long long)(v * 4294967296.0f); }
__device__ __forceinline__ float fx_to(u64 x) { return (float)(long long)x * (1.0f / 4294967296.0f); }
__device__ __forceinline__ int hw_lane() { int l; asm volatile("v_mbcnt_lo_u32_b32 %0, -1, 0\n\tv_mbcnt_hi_u32_b32 %0, -1, %0" : "=v"(l)); return l; }
template <int CTRL> __device__ __forceinline__ float dpp_mov(float x) { return __builtin_bit_cast(float, __builtin_amdgcn_update_dpp(0, __builtin_bit_cast(int, x), CTRL, 0xF, 0xF, true)); }
__device__ __forceinline__ float row16_sum(float x) { x += dpp_mov<0x128>(x); x += dpp_mov<0x124>(x); x += dpp_mov<0x122>(x); x += dpp_mov<0x121>(x); return x; }
__device__ __forceinline__ float oct_sum(float x) { x += dpp_mov<0xB1>(x); x += dpp_mov<0x4E>(x); x += dpp_mov<0x141>(x); return x; }
__device__ __forceinline__ float sum_x16(float x) { auto r = __builtin_amdgcn_permlane16_swap(__float_as_uint(x), __float_as_uint(x), false, false); return __uint_as_float(r[0]) + __uint_as_float(r[1]); }
__device__ __forceinline__ float sum_x32(float x) { auto r = __builtin_amdgcn_permlane32_swap(__float_as_uint(x), __float_as_uint(x), false, false); return __uint_as_float(r[0]) + __uint_as_float(r[1]); }
__device__ __forceinline__ float max_x16(float x) { auto r = __builtin_amdgcn_permlane16_swap(__float_as_uint(x), __float_as_uint(x), false, false); return fmaxf(__uint_as_float(r[0]), __uint_as_float(r[1])); }
__device__ __forceinline__ float max_x32(float x) { auto r = __builtin_amdgcn_permlane32_swap(__float_as_uint(x), __float_as_uint(x), false, false); return fmaxf(__uint_as_float(r[0]), __uint_as_float(r[1])); }

namespace pg8 {
#define PG8_LAS __attribute__((address_space(3)))
typedef unsigned short bf16_t;
typedef short bf16x8 __attribute__((ext_vector_type(8)));
typedef float f32x4 __attribute__((ext_vector_type(4)));
typedef unsigned u32x4 __attribute__((ext_vector_type(4)));
constexpr int BM = 256, BK = 64, HALF = 128, HTB = HALF * BK * 2  , STAGE_BYTES = 8 * HTB, NXCD = 8, WGM = 4;

__host__ __device__ __forceinline__ int lds_byte(int r, int c) { const int st = (r >> 4) * 2 + (c >> 5), rr = r & 15, cc = c & 31, ob = rr * 64 + cc * 2; return st * 1024 + (ob ^ (((ob >> 9) & 1) << 5)); }
__host__ __device__ __forceinline__ void stage_rc(int b, int& R, int& C) { const int st = b / 1024, sb = b % 1024, swz = sb ^ (((sb >> 9) & 1) << 5); R = (st >> 1) * 16 + swz / 64; C = (st & 1) * 32 + (swz % 64) / 2; }
__host__ __device__ __forceinline__ int perm32(int rho) { const int n = rho >> 4, i = rho & 15; return 8 * (i >> 2) + 4 * n + (i & 3); }

struct Unit { int pm, pn, kb, kn; };
struct Gemm { const bf16_t* A; const bf16_t* Bt; int M, N, K; };

struct StaticOrder {
    int nM, nN, nwg, G, c, ntk;
    __host__ __device__ void init(int M, int N, int K, int G_, int c_) { nM = M / BM; nN = N / BM; nwg = nM * nN; G = G_; c = c_; ntk = K / BK; }
    __host__ __device__ bool next(int i, Unit& u) const {
        const long L = (long)i * G + c; if (L >= nwg) return false;
        int wgid = (int)L; { const int q = nwg / NXCD, r = nwg % NXCD, xcd = wgid % NXCD, off = wgid / NXCD; wgid = (xcd < r ? xcd * (q + 1) : r * (q + 1) + (xcd - r) * q) + off; }
        const int nig = WGM * nN, gid = wgid / nig, fm = gid * WGM, gsz = (nM - fm) < WGM ? (nM - fm) : WGM;
        u.pm = fm + ((wgid % nig) % gsz); u.pn = (wgid % nig) / gsz; u.kb = 0; u.kn = ntk; return true;
    }
    __device__ __forceinline__ void a_ready(const Unit&) const {}
    __device__ __forceinline__ void done(const Unit&) const {}
};

struct SplitMetaOrder : StaticOrder {
    int nreg, nsplit; unsigned* ticket; volatile PG8_LAS unsigned* flag;
    __device__ void init2(int N, int K, int G_, int c_, unsigned* ticket_, volatile PG8_LAS unsigned* flag_) { init(64 * BM, N, K, G_, c_); nreg = nwg; nsplit = 16; ticket = ticket_; flag = flag_; }
    __device__ bool next(int i, Unit& u) const {
        const long L = (long)i * G + c;
        if (L < nreg) return StaticOrder::next(i, u);
        const int x = (int)(L - nreg); if (x >= nsplit * nN) return false;
        const int s = x % nsplit; u.pm = 64; u.pn = x / nsplit;
        const int base = (ntk / 2) / nsplit, rem = (ntk / 2) % nsplit;
        u.kb = 2 * (s * base + (s < rem ? s : rem)); u.kn = 2 * (base + (s < rem ? 1 : 0)); return true;
    }
    __device__ __forceinline__ void a_ready(const Unit&) const {}
    __device__ __forceinline__ void done(const Unit& u) const {
        if (u.pm == 64) { asm volatile("s_waitcnt vmcnt(0)" ::: "memory");
            if (hw_lane() == 0) { const unsigned old = __hip_atomic_fetch_add(ticket, 1u, __ATOMIC_RELAXED, __HIP_MEMORY_SCOPE_AGENT); if (old + 1u == (unsigned)(nsplit * nN * 8)) flag[0] = 1u; } }
    }
};
__device__ __forceinline__ unsigned cvt_pk_bf16(float lo, float hi) { unsigned r; asm volatile("v_cvt_pk_bf16_f32 %0, %1, %2" : "=v"(r) : "v"(lo), "v"(hi)); return r; }
__device__ __forceinline__ u32x4 pack8(const f32x4 a, const f32x4 b) { u32x4 w; w.x = cvt_pk_bf16(a[0], a[1]); w.y = cvt_pk_bf16(a[2], a[3]); w.z = cvt_pk_bf16(b[0], b[1]); w.w = cvt_pk_bf16(b[2], b[3]); return w; }
__device__ __forceinline__ float row_rstd(const u64* ssq, int r) { return __builtin_amdgcn_rsqf(fx_to_pos(ssq[r]) * (1.0f / 4096.0f) + RMS_EPS); }

struct EpiIn0 {
    static constexpr bool PERM = true, AFTER_DRAIN = false;
    bf16_t* Z; float* F; const u64* ssq;
    __device__ __forceinline__ void operator()(const f32x4 (&acc)[2][2][4][2], const Unit& u, int wr, int wc, int fr, int fq) const {
        const int row0 = u.pm * BM + wr * 64 + fr;
        if (u.pn < 40) {
            const int col0 = u.pn * BM + wc * 32 + 8 * fq;
#pragma unroll
            for (int ai = 0; ai < 2; ++ai)
#pragma unroll
                for (int m = 0; m < 4; ++m) { const int r = row0 + ai * HALF + m * 16; const float rs = row_rstd(ssq, r); bf16_t* rowp = Z + (size_t)r * AB_Z + col0;
#pragma unroll
                    for (int bj = 0; bj < 2; ++bj) *(u32x4*)(rowp + bj * HALF) = pack8(acc[ai][bj][m][0] * rs, acc[ai][bj][m][1] * rs); }
        } else if (wc == 0 && fq < 2) {
#pragma unroll
            for (int ai = 0; ai < 2; ++ai)
#pragma unroll
                for (int m = 0; m < 4; ++m) { const int r = row0 + ai * HALF + m * 16; const float rs = row_rstd(ssq, r); float* fp = F + (size_t)r * 16 + 8 * fq;
                    *(f32x4*)(fp) = acc[ai][0][m][0] * rs; *(f32x4*)(fp + 4) = acc[ai][0][m][1] * rs; }
        }
    }
};
template <bool F32IN>
struct EpiResT {
    static constexpr bool PERM = true, AFTER_DRAIN = false;
    const float* Hin; u64* Hmeta; bf16_t* XB; u64* ssq_out; int K_TILES;
    __device__ __forceinline__ void operator()(const f32x4 (&acc)[2][2][4][2], const Unit& u, int wr, int wc, int fr, int fq) const {
        const int row0 = u.pm * BM + wr * 64 + fr, col0 = u.pn * BM + wc * 32 + 8 * fq;
        if (u.pm == MTOK / BM) {
            if (wr == 0) {
#pragma unroll
                for (int m = 0; m < 4; ++m) { u64* hp = Hmeta + (size_t)(m * 16 + fr) * DM + col0;
#pragma unroll
                    for (int bj = 0; bj < 2; ++bj)
#pragma unroll
                        for (int n = 0; n < 2; ++n)
#pragma unroll
                            for (int j = 0; j < 4; ++j) atomicAdd(hp + bj * HALF + 4 * n + j, fx_from(acc[0][bj][m][n][j])); } }
            return; }
        if (F32IN) {
#pragma unroll
            for (int ai = 0; ai < 2; ++ai)
#pragma unroll
                for (int mp = 0; mp < 4; mp += 2) {
                    f32x4 hv[2][2][2];
#pragma unroll
                    for (int q = 0; q < 2; ++q) { const float* hi = Hin + (size_t)(row0 + ai * HALF + (mp + q) * 16) * DM + col0;
#pragma unroll
                        for (int bj = 0; bj < 2; ++bj) { hv[q][bj][0] = *(const f32x4*)(hi + bj * HALF); hv[q][bj][1] = *(const f32x4*)(hi + bj * HALF + 4); } }
#pragma unroll
                    for (int q = 0; q < 2; ++q) { const int m = mp + q; const int r = row0 + ai * HALF + m * 16; bf16_t* xp = XB + (size_t)r * DM + col0; float s = 0.f;
#pragma unroll
                        for (int bj = 0; bj < 2; ++bj) { const f32x4 v0 = hv[q][bj][0] + acc[ai][bj][m][0], v1 = hv[q][bj][1] + acc[ai][bj][m][1];
                            *(u32x4*)(xp + bj * HALF) = pack8(v0, v1);
                            s += (v0[0] * v0[0] + v0[1] * v0[1]) + (v0[2] * v0[2] + v0[3] * v0[3]) + (v1[0] * v1[0] + v1[1] * v1[1]) + (v1[2] * v1[2] + v1[3] * v1[3]); }
                        s = sum_x32(sum_x16(s));
                        if (fq == 0) atomicAdd(ssq_out + r, fx_from_pos(s)); }
                    asm volatile("" ::: "memory"); }
        } else {
#pragma unroll
            for (int ai = 0; ai < 2; ++ai) {
                u32x4 hb[4][2];
#pragma unroll
                for (int m = 0; m < 4; ++m) { const bf16_t* xi = XB + (size_t)(row0 + ai * HALF + m * 16) * DM + col0;
#pragma unroll
                    for (int bj = 0; bj < 2; ++bj) hb[m][bj] = *(const u32x4*)(xi + bj * HALF); }
#pragma unroll
                for (int m = 0; m < 4; ++m) { const int r = row0 + ai * HALF + m * 16; bf16_t* xp = XB + (size_t)r * DM + col0; float s = 0.f;
#pragma unroll
                    for (int bj = 0; bj < 2; ++bj) { const u32x4 w = hb[m][bj];
                        const f32x4 h0 = {__builtin_bit_cast(float, w[0] << 16), __builtin_bit_cast(float, w[0] & 0xffff0000u), __builtin_bit_cast(float, w[1] << 16), __builtin_bit_cast(float, w[1] & 0xffff0000u)};
                        const f32x4 h1 = {__builtin_bit_cast(float, w[2] << 16), __builtin_bit_cast(float, w[2] & 0xffff0000u), __builtin_bit_cast(float, w[3] << 16), __builtin_bit_cast(float, w[3] & 0xffff0000u)};
                        const f32x4 v0 = h0 + acc[ai][bj][m][0], v1 = h1 + acc[ai][bj][m][1];
                        *(u32x4*)(xp + bj * HALF) = pack8(v0, v1);
                        s += (v0[0] * v0[0] + v0[1] * v0[1]) + (v0[2] * v0[2] + v0[3] * v0[3]) + (v1[0] * v1[0] + v1[1] * v1[1]) + (v1[2] * v1[2] + v1[3] * v1[3]); }
                    s = sum_x32(sum_x16(s));
                    if (fq == 0) atomicAdd(ssq_out + r, fx_from_pos(s)); }
                asm volatile("" ::: "memory"); }
        }
    }
};
typedef EpiResT<true> EpiResX;
typedef EpiResT<false> EpiRes;
struct EpiFinal {
    static constexpr bool PERM = true, AFTER_DRAIN = false;
    const bf16_t* XB; float* OUT;
    __device__ __forceinline__ void operator()(const f32x4 (&acc)[2][2][4][2], const Unit& u, int wr, int wc, int fr, int fq) const {
        const int row0 = u.pm * BM + wr * 64 + fr, col0 = u.pn * BM + wc * 32 + 8 * fq;
#pragma unroll
        for (int ai = 0; ai < 2; ++ai) {
            u32x4 hb[4][2];
#pragma unroll
            for (int m = 0; m < 4; ++m) { const bf16_t* xi = XB + (size_t)(row0 + ai * HALF + m * 16) * DM + col0;
#pragma unroll
                for (int bj = 0; bj < 2; ++bj) hb[m][bj] = *(const u32x4*)(xi + bj * HALF); }
#pragma unroll
            for (int m = 0; m < 4; ++m) { float* op = OUT + (size_t)(row0 + ai * HALF + m * 16) * DM + col0;
#pragma unroll
                for (int bj = 0; bj < 2; ++bj) { const u32x4 w = hb[m][bj];
                    const f32x4 h0 = {__builtin_bit_cast(float, w[0] << 16), __builtin_bit_cast(float, w[0] & 0xffff0000u), __builtin_bit_cast(float, w[1] << 16), __builtin_bit_cast(float, w[1] & 0xffff0000u)};
                    const f32x4 h1 = {__builtin_bit_cast(float, w[2] << 16), __builtin_bit_cast(float, w[2] & 0xffff0000u), __builtin_bit_cast(float, w[3] << 16), __builtin_bit_cast(float, w[3] & 0xffff0000u)};
                    *(f32x4*)(op + bj * HALF) = h0 + acc[ai][bj][m][0]; *(f32x4*)(op + bj * HALF + 4) = h1 + acc[ai][bj][m][1]; } }
            asm volatile("" ::: "memory"); }
    }
};
struct EpiGU {
    static constexpr bool PERM = true, AFTER_DRAIN = false;
    bf16_t* HID; const u64* ssq;
    __device__ __forceinline__ void operator()(const f32x4 (&acc)[2][2][4][2], const Unit& u, int wr, int wc, int fr, int fq) const {
        const int row0 = u.pm * BM + wr * 64 + fr, col0 = u.pn * HALF + wc * 32 + 8 * fq;
#pragma unroll
        for (int ai = 0; ai < 2; ++ai)
#pragma unroll
            for (int m = 0; m < 4; ++m) { const int r = row0 + ai * HALF + m * 16; const float rs = row_rstd(ssq, r); f32x4 o[2];
#pragma unroll
                for (int n = 0; n < 2; ++n)
#pragma unroll
                    for (int j = 0; j < 4; ++j) { const float g = acc[ai][0][m][n][j] * rs, uu = acc[ai][1][m][n][j] * rs;
                        o[n][j] = g * uu * __builtin_amdgcn_rcpf(1.0f + __expf(-g)); }
                *(u32x4*)(HID + (size_t)r * DFF + col0) = pack8(o[0], o[1]); }
    }
};
struct EpiIn1 {
    static constexpr bool PERM = true, AFTER_DRAIN = false;
    bf16_t* Z; const u64* ssq;
    __device__ __forceinline__ void operator()(const f32x4 (&acc)[2][2][4][2], const Unit& u, int wr, int wc, int fr, int fq) const {
        const int row0 = u.pm * BM + wr * 64 + fr, col0 = u.pn * BM + wc * 32 + 8 * fq;
        if (u.pn < 32) {
            const float sc = u.pn < 16 ? 1.0f : 0.0625f;
            float inv[2][4];
#pragma unroll
            for (int n = 0; n < 2; ++n)
#pragma unroll
                for (int j = 0; j < 4; ++j) inv[n][j] = exp2f(-(float)(wc * 32 + 8 * fq + 4 * n + j) * (13.287712379549449f / 128.0f));
#pragma unroll
            for (int ai = 0; ai < 2; ++ai)
#pragma unroll
                for (int m = 0; m < 4; ++m) { const int r = row0 + ai * HALF + m * 16; const float rs = row_rstd(ssq, r) * sc;
                    const float t = (float)(r < MTOK ? NMETA + (r & (SEQ - 1)) : ((r - MTOK) & 15));
                    f32x4 o1[2], o2[2];
#pragma unroll
                    for (int n = 0; n < 2; ++n)
#pragma unroll
                        for (int j = 0; j < 4; ++j) { const float x1 = acc[ai][0][m][n][j] * rs, x2 = acc[ai][1][m][n][j] * rs;
                            const float ang = t * inv[n][j]; float rev = ang * 0.15915494309189535f; rev = rev - floorf(rev);
                            const float c = __builtin_amdgcn_cosf(rev), s = __builtin_amdgcn_sinf(rev);
                            o1[n][j] = x1 * c - x2 * s; o2[n][j] = x1 * s + x2 * c; }
                    bf16_t* rowp = Z + (size_t)r * RET_IN + col0;
                    *(u32x4*)(rowp) = pack8(o1[0], o1[1]); *(u32x4*)(rowp + HALF) = pack8(o2[0], o2[1]); }
        } else {
#pragma unroll
            for (int ai = 0; ai < 2; ++ai)
#pragma unroll
                for (int m = 0; m < 4; ++m) { const int r = row0 + ai * HALF + m * 16; const float rs = row_rstd(ssq, r); bf16_t* rowp = Z + (size_t)r * RET_IN + col0;
#pragma unroll
                    for (int bj = 0; bj < 2; ++bj) *(u32x4*)(rowp + bj * HALF) = pack8(acc[ai][bj][m][0] * rs, acc[ai][bj][m][1] * rs); }
        }
    }
};

struct EpiNone {
    static constexpr bool PERM = true, AFTER_DRAIN = false;
    __device__ __forceinline__ void operator()(const f32x4 (&acc)[2][2][4][2], const Unit&, int, int, int, int) const {
#pragma unroll
        for (int ai = 0; ai < 2; ++ai)
#pragma unroll
            for (int bj = 0; bj < 2; ++bj)
#pragma unroll
                for (int m = 0; m < 4; ++m) asm volatile("" :: "v"(acc[ai][bj][m][0]), "v"(acc[ai][bj][m][1]));
    }
};
struct HotOrder : StaticOrder {
    __device__ bool next(int i, Unit& u) const { const bool ok = StaticOrder::next(i, u); u.pm = 0; u.pn = 0; return ok; }
    __device__ __forceinline__ void a_ready(const Unit&) const {}
    __device__ __forceinline__ void done(const Unit&) const {}
};
template <class Epi, class Sched, bool ALIGN_EPI = false, bool SP2 = false>
__device__ __forceinline__ void gemm_phase(PG8_LAS unsigned char* lds, const Gemm g, const Sched& S, const Epi& E, const int wid) {
    const int lane = hw_lane(), tid = wid * 64 + lane, wr = wid >> 2, wc = wid & 3, fr = lane & 15, fq = lane >> 4;
    const int K = g.K; int nt;
    unsigned voffA[2], voffB[2];
#pragma unroll
    for (int i = 0; i < 2; ++i) { int R, C; stage_rc(tid * 16 + i * 8192, R, C); const int Rb = Epi::PERM ? ((R & ~31) + perm32(R & 31)) : R;
        voffA[i] = (unsigned)(R * K + C) * 2u; voffB[i] = (unsigned)(Rb * K + C) * 2u; }
    const size_t kstep = (size_t)(BK * 2);
    const size_t hstep = (size_t)HALF * K * 2;
    const size_t tstep = 2 * hstep;
    const unsigned ldsw = (unsigned)wid * 1024u;
    const int aoff = lds_byte(wr * 64 + fr, fq * 8), boff = lds_byte(wc * 32 + fr, fq * 8);
#define PG8_SA(b, h) (((b) * 2 + (h)) * HTB)
#define PG8_SB(b, h) ((4 + (b) * 2 + (h)) * HTB)
#define PG8_STAGE(bufoff, gbase, voff) do { _Pragma("unroll") for (int _i = 0; _i < 2; ++_i) \
        __builtin_amdgcn_global_load_lds((const unsigned*)((const char*)(gbase) + (voff)[_i]), (PG8_LAS unsigned*)(lds + (bufoff) + ldsw + _i * 8192), 16, 0, 0); } while (0)
#define PG8_LDA(dst, b, h) do { _Pragma("unroll") for (int m = 0; m < 4; ++m) _Pragma("unroll") for (int k = 0; k < 2; ++k) dst[m][k] = *(const PG8_LAS bf16x8*)(lds + PG8_SA(b, h) + aoff + m * 2048 + k * 1024); } while (0)
#define PG8_LDB(dst, b, h) do { _Pragma("unroll") for (int n = 0; n < 2; ++n) _Pragma("unroll") for (int k = 0; k < 2; ++k) dst[n][k] = *(const PG8_LAS bf16x8*)(lds + PG8_SB(b, h) + boff + n * 2048 + k * 1024); } while (0)
#define PG8_MMA(ai, bj, At, Bt) do { __builtin_amdgcn_s_setprio(1); _Pragma("unroll") for (int m = 0; m < 4; ++m) _Pragma("unroll") for (int n = 0; n < 2; ++n) _Pragma("unroll") for (int k = 0; k < 2; ++k) \
        acc[ai][bj][m][n] = __builtin_amdgcn_mfma_f32_16x16x32_bf16(Bt[n][k], At[m][k], acc[ai][bj][m][n], 0, 0, 0); __builtin_amdgcn_s_setprio(0); } while (0)
#define PG8_WAIT_V(n) asm volatile("s_waitcnt vmcnt(" #n ")" ::: "memory")
#define PG8_WAIT_L(n) asm volatile("s_waitcnt lgkmcnt(" #n ")" ::: "memory")
#define PG8_BAR __builtin_amdgcn_s_barrier()
#define PG8_SCHED __builtin_amdgcn_sched_barrier(0)
    Unit cur, nxt; int ui = 0;
    if (!S.next(0, cur)) return;
    nt = cur.kn;
    f32x4 acc[2][2][4][2];
#pragma unroll
    for (int a = 0; a < 2; ++a)
#pragma unroll
        for (int b = 0; b < 2; ++b)
#pragma unroll
            for (int m = 0; m < 4; ++m)
#pragma unroll
                for (int n = 0; n < 2; ++n) acc[a][b][m][n] = (f32x4){0.f, 0.f, 0.f, 0.f};
    bf16x8 At[4][2], B0[2][2], B1[2][2];
    const char* cA = (const char*)g.A + (size_t)cur.pm * tstep + (size_t)cur.kb * kstep; const char* cB = (const char*)g.Bt + (size_t)cur.pn * tstep + (size_t)cur.kb * kstep;
    S.a_ready(cur);
    if constexpr (SP2) {
        PG8_STAGE(PG8_SB(0, 0), cB, voffB); PG8_STAGE(PG8_SB(0, 1), cB + hstep, voffB); PG8_STAGE(PG8_SA(0, 0), cA, voffA); PG8_STAGE(PG8_SA(0, 1), cA + hstep, voffA);
        if (wr == 1) PG8_BAR;
        PG8_WAIT_V(2); PG8_BAR;
        PG8_STAGE(PG8_SB(1, 0), cB + kstep, voffB); PG8_STAGE(PG8_SA(1, 0), cA + kstep, voffA); PG8_STAGE(PG8_SB(1, 1), cB + hstep + kstep, voffB);
        PG8_WAIT_V(6); PG8_BAR;
    } else {
        PG8_STAGE(PG8_SB(0, 0), cB, voffB); PG8_STAGE(PG8_SA(0, 0), cA, voffA); PG8_STAGE(PG8_SB(0, 1), cB + hstep, voffB); PG8_STAGE(PG8_SA(0, 1), cA + hstep, voffA);
        if (wr == 1) PG8_BAR;
        PG8_WAIT_V(4); PG8_BAR;
        PG8_STAGE(PG8_SB(1, 0), cB + kstep, voffB); PG8_STAGE(PG8_SA(1, 0), cA + kstep, voffA); PG8_STAGE(PG8_SB(1, 1), cB + hstep + kstep, voffB);
        PG8_WAIT_V(6); PG8_BAR;
    }
    for (;;) {
        const bool has_next = S.next(ui + 1, nxt);
        const char* nA = has_next ? (const char*)g.A + (size_t)nxt.pm * tstep + (size_t)nxt.kb * kstep : cA; const char* nB = has_next ? (const char*)g.Bt + (size_t)nxt.pn * tstep + (size_t)nxt.kb * kstep : cB;
        for (int t = 0; t < nt; t += 2) {
            const bool last = (t == nt - 2);
            const char* a1 = cA + (size_t)(t + 1) * kstep;
            const char* a2 = last ? nA : cA + (size_t)(t + 2) * kstep; const char* b2 = last ? nB : cB + (size_t)(t + 2) * kstep;
            const char* a3 = a2 + kstep; const char* b3 = b2 + kstep;
            if (last && has_next) S.a_ready(nxt);
            if constexpr (SP2) {
            PG8_LDB(B0, 0, 0); PG8_LDB(B1, 0, 1); PG8_SCHED; PG8_LDA(At, 0, 0); PG8_STAGE(PG8_SA(1, 1), a1 + hstep, voffA);
            PG8_WAIT_V(8); PG8_WAIT_L(0); PG8_BAR; PG8_MMA(0, 0, At, B0); PG8_MMA(0, 1, At, B1); PG8_BAR; PG8_SCHED;
            PG8_LDA(At, 0, 1); PG8_STAGE(PG8_SB(0, 0), b2, voffB); PG8_STAGE(PG8_SB(0, 1), b2 + hstep, voffB); PG8_STAGE(PG8_SA(0, 0), a2, voffA);
            PG8_WAIT_V(8); PG8_WAIT_L(0); PG8_BAR; PG8_MMA(1, 0, At, B0); PG8_MMA(1, 1, At, B1); PG8_BAR; PG8_SCHED;
            PG8_LDB(B0, 1, 0); PG8_LDB(B1, 1, 1); PG8_SCHED; PG8_LDA(At, 1, 0); PG8_STAGE(PG8_SA(0, 1), a2 + hstep, voffA);
            PG8_WAIT_V(8); PG8_WAIT_L(0); PG8_BAR; PG8_MMA(0, 0, At, B0); PG8_MMA(0, 1, At, B1); PG8_BAR; PG8_SCHED;
            PG8_LDA(At, 1, 1); PG8_STAGE(PG8_SB(1, 0), b3, voffB); PG8_STAGE(PG8_SB(1, 1), b3 + hstep, voffB); PG8_STAGE(PG8_SA(1, 0), a3, voffA);
            PG8_WAIT_V(8); PG8_WAIT_L(0); PG8_BAR; PG8_MMA(1, 0, At, B0); PG8_MMA(1, 1, At, B1); PG8_BAR; PG8_SCHED;
            } else {
            PG8_LDB(B0, 0, 0); PG8_SCHED; PG8_LDA(At, 0, 0); PG8_STAGE(PG8_SA(1, 1), a1 + hstep, voffA);
            PG8_WAIT_L(8); PG8_BAR; PG8_WAIT_L(0); PG8_MMA(0, 0, At, B0); PG8_BAR; PG8_SCHED;
            PG8_LDB(B1, 0, 1); PG8_STAGE(PG8_SB(0, 0), b2, voffB);
            PG8_BAR; PG8_WAIT_L(0); PG8_MMA(0, 1, At, B1); PG8_BAR;
            PG8_LDA(At, 0, 1); PG8_STAGE(PG8_SA(0, 0), a2, voffA);
            PG8_BAR; PG8_WAIT_L(0); PG8_MMA(1, 0, At, B0); PG8_BAR; PG8_SCHED;
            PG8_STAGE(PG8_SB(0, 1), b2 + hstep, voffB);
            PG8_WAIT_V(6); PG8_BAR; PG8_MMA(1, 1, At, B1); PG8_BAR;
            PG8_LDB(B0, 1, 0); PG8_SCHED; PG8_LDA(At, 1, 0); PG8_STAGE(PG8_SA(0, 1), a2 + hstep, voffA);
            PG8_WAIT_L(8); PG8_BAR; PG8_WAIT_L(0); PG8_MMA(0, 0, At, B0); PG8_BAR; PG8_SCHED;
            PG8_LDB(B1, 1, 1); PG8_STAGE(PG8_SB(1, 0), b3, voffB);
            PG8_BAR; PG8_WAIT_L(0); PG8_MMA(0, 1, At, B1); PG8_BAR;
            PG8_LDA(At, 1, 1); PG8_STAGE(PG8_SA(1, 0), a3, voffA);
            PG8_BAR; PG8_WAIT_L(0); PG8_MMA(1, 0, At, B0); PG8_BAR; PG8_SCHED;
            PG8_STAGE(PG8_SB(1, 1), b3 + hstep, voffB);
            PG8_WAIT_V(6); PG8_BAR; PG8_MMA(1, 1, At, B1); PG8_BAR;
            }
        }
        if constexpr (ALIGN_EPI) { if (wr == 0) PG8_BAR; }
        if constexpr (!Epi::AFTER_DRAIN) { E(acc, cur, wr, wc, fr, fq); S.done(cur); }
        if (!has_next) break;
#pragma unroll
        for (int a = 0; a < 2; ++a)
#pragma unroll
            for (int b = 0; b < 2; ++b)
#pragma unroll
                for (int m = 0; m < 4; ++m)
#pragma unroll
                    for (int n = 0; n < 2; ++n) acc[a][b][m][n] = (f32x4){0.f, 0.f, 0.f, 0.f};
        cur = nxt; cA = nA; cB = nB; ++ui; nt = cur.kn;
        if constexpr (ALIGN_EPI) { if (wr == 1) PG8_BAR; }
    }
    PG8_WAIT_V(0);
    if constexpr (!ALIGN_EPI) { if (wr == 0) PG8_BAR; }
    PG8_BAR;
    if constexpr (Epi::AFTER_DRAIN) { E.fused(acc, cur, wr, wc, fr, fq, lds, wid, lane); S.done(cur); }
#undef PG8_SA
#undef PG8_SB
#undef PG8_STAGE
#undef PG8_LDA
#undef PG8_LDB
#undef PG8_MMA
#undef PG8_WAIT_V
#undef PG8_WAIT_L
#undef PG8_BAR
#undef PG8_SCHED
}
}

constexpr size_t MiB = 1u << 20;
constexpr size_t WS_CTL = 0, CTL_ZERO_BYTES = 4 * MiB;
constexpr size_t WS_SSQ1 = 64 * 1024, WS_SSQ2 = 256 * 1024, WS_SSQ3 = 448 * 1024, WS_SSQO = 640 * 1024;
constexpr size_t WS_SSQ0 = 4 * MiB;
constexpr size_t WS_FBUF = 4 * MiB + 256 * 1024;
constexpr size_t WS_HMETA = 6 * MiB;
constexpr size_t WS_WIN0 = 8 * MiB, WS_WOUT0 = 90 * MiB, WS_WGU0 = 122 * MiB, WS_WD0 = 294 * MiB, WS_WIN1 = 380 * MiB, WS_WOUT1 = 572 * MiB, WS_WGU1 = 636 * MiB, WS_WD1 = 808 * MiB;
constexpr size_t WS_WAT = 894 * MiB, WS_WXT = WS_WAT + 512 * 1024;
constexpr size_t WS_XB = 896 * MiB, WS_Z = 1026 * MiB, WS_END = 1806 * MiB;
constexpr size_t WS_Y0 = WS_Z + 400 * MiB;
constexpr size_t WS_Y1 = 8 * MiB;
static_assert(WS_SSQ1 + (size_t)MP * 8 <= WS_SSQ2 && WS_SSQ2 + (size_t)MP * 8 <= WS_SSQ3 && WS_SSQ3 + (size_t)MP * 8 <= WS_SSQO && WS_SSQO + (size_t)MP * 16 * 8 <= CTL_ZERO_BYTES && WS_SSQ0 + (size_t)MP * 8 <= WS_FBUF && WS_FBUF + (size_t)MP * 16 * 4 <= WS_HMETA && WS_HMETA + (size_t)64 * DM * 8 <= WS_WIN0, "ctl map");
static_assert(WS_WIN0 + (size_t)41 * 256 * DM * 2 <= WS_WOUT0 && WS_WGU0 + (size_t)2 * DFF * DM * 2 <= WS_WD0 && WS_WD0 + (size_t)DM * DFF * 2 <= WS_WIN1 && WS_WIN1 + (size_t)RET_IN * DM * 2 <= WS_WOUT1, "weight map");
static_assert(WS_WOUT1 + (size_t)DM * RET_VW * 2 <= WS_WGU1 && WS_WGU1 + (size_t)2 * DFF * DM * 2 <= WS_WD1 && WS_WD1 + (size_t)DM * DFF * 2 <= WS_WAT, "weight map 2");
static_assert(WS_XB + (size_t)MP * DM * 2 <= WS_Z && WS_Z + (size_t)MP * RET_IN * 2 <= WS_END && WS_Z + (size_t)MP * AB_Z * 2 <= WS_Y0 && WS_Z + (size_t)MP * DFF * 2 <= WS_Y0 && WS_Y0 + (size_t)MP * DM * 2 <= WS_END && WS_Y1 + (size_t)MP * RET_VW * 2 <= WS_WD0, "activation map");
constexpr int CW_TMO = 0, CW_Q2 = 64, CW_TK3 = 256, CW_TK5 = 320, CW_QC = 384, CW_ACT = 512, CW_TL1 = 640, CW_TL4 = 704, CW_TL6 = 768, CW_TL10 = 832, CW_BAR = 4096;
constexpr int RING_BYTES = 131072;
constexpr int LDS_BYTES = 147456;
constexpr int MISC_OFF = LDS_BYTES - 256;
constexpr int NWAVES = 8, NTHREADS = 512;
constexpr int NPHASES = 12;

#define GAS __attribute__((address_space(1)))
#define LAS __attribute__((address_space(3)))
typedef unsigned short bf16;
typedef unsigned v4u __attribute__((ext_vector_type(4)));
typedef unsigned v2u __attribute__((ext_vector_type(2)));
typedef float f32x4 __attribute__((ext_vector_type(4)));
typedef float v2f __attribute__((ext_vector_type(2)));
typedef short bf16x8 __attribute__((ext_vector_type(8)));
typedef short bf16x4 __attribute__((ext_vector_type(4)));
typedef GAS unsigned gu32;
#define RLX_AGENT __ATOMIC_RELAXED, __HIP_MEMORY_SCOPE_AGENT
#define LDS_WAIT() asm volatile("s_waitcnt lgkmcnt(0)" ::: "memory")
#define VM_WAIT() asm volatile("s_waitcnt vmcnt(0)" ::: "memory")
__device__ __forceinline__ unsigned f2bf(float f) { unsigned u = __builtin_bit_cast(unsigned, f); return (u + 0x7fffu + ((u >> 16) & 1u)) >> 16; }
__device__ __forceinline__ unsigned pk2(float lo, float hi) { return pg8::cvt_pk_bf16(lo, hi); }
__device__ __forceinline__ float bflo(unsigned w) { return __builtin_bit_cast(float, w << 16); }
__device__ __forceinline__ float bfhi(unsigned w) { return __builtin_bit_cast(float, w & 0xffff0000u); }
__device__ __forceinline__ float bf2f(unsigned short h) { return __builtin_bit_cast(float, (unsigned)h << 16); }
__device__ __forceinline__ void unpack8(const v4u w, float (&f)[8]) { f[0] = bflo(w.x); f[1] = bfhi(w.x); f[2] = bflo(w.y); f[3] = bfhi(w.y); f[4] = bflo(w.z); f[5] = bfhi(w.z); f[6] = bflo(w.w); f[7] = bfhi(w.w); }
__device__ __forceinline__ v4u pack8f(const float (&f)[8]) { v4u w; w.x = pk2(f[0], f[1]); w.y = pk2(f[2], f[3]); w.z = pk2(f[4], f[5]); w.w = pk2(f[6], f[7]); return w; }
__device__ __forceinline__ int row_of(int b, int t) { return t < NMETA ? MMETA + NMETA * b + t : b * SEQ + (t - NMETA); }
__device__ __forceinline__ f32x4 mfma16(bf16x8 a, bf16x8 b, f32x4 c) { return __builtin_amdgcn_mfma_f32_16x16x32_bf16(a, b, c, 0, 0, 0); }

#define XB_TMO      128
#define XB_XCNT(j)  (256  + 64 * (j))
#define XB_XSUB(j)  (1280 + 64 * (j))
#define XB_XGEN(j)  (2304 + 64 * (j))
#define XB_TOP      3328
#define XB_TOPGEN   3392
#define XCD_BAR_WORDS 3456
#define XB_SPIN_CAP (1u << 22)

__device__ __forceinline__ unsigned xb_ld(unsigned* p)              { return __hip_atomic_load(p, __ATOMIC_RELAXED, __HIP_MEMORY_SCOPE_AGENT); }
__device__ __forceinline__ unsigned xb_add(unsigned* p, unsigned v) { return __hip_atomic_fetch_add(p, v, __ATOMIC_RELAXED, __HIP_MEMORY_SCOPE_AGENT); }
__device__ __forceinline__ unsigned xb_xcc_id() { return (unsigned)__builtin_amdgcn_s_getreg((3 << 11) | 20) & 0xFu; }
#define XB_SPIN(cond, bar) do { unsigned _sp = 0; while (cond) { __builtin_amdgcn_s_sleep(1); \
    if ((++_sp & 255u) == 0u) { if (xb_ld(&(bar)[XB_TMO])) break; if (_sp > XB_SPIN_CAP) { atomicAdd(&(bar)[XB_TMO], 1u); break; } } } } while (0)

struct XcdBarrier {
    unsigned* bar; unsigned x; int wave;
    volatile LAS unsigned* st;
};
__device__ __forceinline__ XcdBarrier xcd_barrier_post(unsigned* bar, volatile LAS unsigned* st, int wave) {
    XcdBarrier b; b.bar = bar; b.x = xb_xcc_id(); b.st = st; b.wave = wave;
    if (threadIdx.x == 0) (void)xb_add(&bar[XB_XCNT(b.x)], 1u);
    return b;
}
__device__ __forceinline__ void xcd_barrier_complete(unsigned* bar, unsigned x, unsigned& nloc, unsigned& nx) {
    const unsigned G = gridDim.x * gridDim.y * gridDim.z;
    unsigned sum, cnt, mine, sp = 0u;
    for (;;) {
        sum = 0u; cnt = 0u; mine = 0u;
#pragma unroll
        for (unsigned j = 0; j < 16; ++j) { const unsigned c = xb_ld(&bar[XB_XCNT(j)]); sum += c; cnt += (c > 0u) ? 1u : 0u; mine = (j == x) ? c : mine; }
        if (sum == G) break;
        __builtin_amdgcn_s_sleep(1);
        if ((++sp & 255u) == 0u) { if (xb_ld(&bar[XB_TMO])) break; if (sp > XB_SPIN_CAP) { atomicAdd(&bar[XB_TMO], 1u); break; } }
    }
    nloc = mine > 0u ? mine : 1u; nx = cnt > 0u ? cnt : 1u;
}
__device__ __forceinline__ void xcd_barrier(const XcdBarrier& b) {
    asm volatile("s_waitcnt vmcnt(0)" ::: "memory");
    __syncthreads();
    if (b.wave == 0 && hw_lane() == 0) {
        unsigned* bar = b.bar;
        __builtin_amdgcn_s_waitcnt(0);
        unsigned nloc = b.st[0], nx = b.st[1];
        if (nloc == 0u) { xcd_barrier_complete(bar, b.x, nloc, nx); b.st[0] = nloc; b.st[1] = nx; }
        const unsigned old = xb_add(&bar[XB_XSUB(b.x)], 1u);
        const unsigned gen = old / nloc;
        if (old + 1u == (gen + 1u) * nloc) {
            __builtin_amdgcn_fence(__ATOMIC_RELEASE, "agent");
            asm volatile("s_waitcnt vmcnt(0)" ::: "memory");
            const unsigned og = xb_add(&bar[XB_TOP], 1u);
            const unsigned tg = og / nx;
            if (og + 1u == (tg + 1u) * nx) xb_add(&bar[XB_TOPGEN], 1u);
            else XB_SPIN(xb_ld(&bar[XB_TOPGEN]) == tg, bar);
            __builtin_amdgcn_fence(__ATOMIC_ACQUIRE, "agent");
            xb_add(&bar[XB_XGEN(b.x)], 1u);
            asm volatile("s_waitcnt vmcnt(0)" ::: "memory");
        } else {
            XB_SPIN(xb_ld(&bar[XB_XGEN(b.x)]) == gen, bar);
            __builtin_amdgcn_fence(__ATOMIC_ACQUIRE, "agent");
            asm volatile("s_waitcnt vmcnt(0)" ::: "memory");
        }
    }
    __syncthreads();
}

struct Args { const float* in[23]; float* out; unsigned char* ws; int ph_lo, ph_hi; };
__device__ __forceinline__ float* h_row(float* out, unsigned char* ws, int r) { return r < MTOK ? out + (size_t)r * DM : (float*)(ws + WS_HMETA) + (size_t)(r - MTOK) * DM; }
struct Frame {
    LAS unsigned char* lds;
    volatile LAS unsigned* MISC;
    unsigned char* ws;
    int tid, lane, wave, G;
};
__device__ __forceinline__ float wave_sum(float v) {
    return sum_x32(sum_x16(row16_sum(v)));
}

template <int MODE, int KCH, bool GAIN = false>
__device__ __forceinline__ void p0_tr(const float* W, int K, int N, bf16* WT, LAS unsigned* tile, int item, int lane, const float* gk = nullptr) {
    const int nkc = K / KCH, NBk = (N + 63) / 64; int nb, kc;
    if ((nkc & 1) == 0 && (NBk & 3) == 0) { const int g = item >> 3, j = item & 7, gw = NBk >> 2; const int kcg = g / gw, nbg = g - kcg * gw; nb = 4 * nbg + (j & 3); kc = 2 * kcg + (j >> 2); }
    else if ((NBk & 7) == 0) { const int g = item >> 3, j = item & 7, gw = NBk >> 3; const int kcg = g / gw, nbg = g - kcg * gw; nb = 8 * nbg + j; kc = kcg; }
    else { nb = item / nkc; kc = item - nb * nkc; }
    const int k0 = kc * KCH, n0 = nb * 64;
    const int kq = lane >> 4, nq = lane & 15; const int n = n0 + 4 * nq; const bool ok = n < N;
    const float* src = W + (size_t)(k0 + 2 * kq) * N + (ok ? n : 0);
    const int nr = lane >> 3, kch = lane & 7;
    f32x4 va[8][2]; v2f gv[8];
#define P0_LOADH(sub, h) do { _Pragma("unroll") for (int i = 4 * (h); i < 4 * (h) + 4; ++i) { const float* p_ = src + (size_t)(64 * (sub) + 8 * i) * N; va[i][0] = __builtin_nontemporal_load((const GAS f32x4*)p_); va[i][1] = __builtin_nontemporal_load((const GAS f32x4*)(p_ + N)); \
            if (GAIN) gv[i] = *(const GAS v2f*)(gk + k0 + 64 * (sub) + 8 * i + 2 * kq); } } while (0)
#define P0_WRH(h) do { _Pragma("unroll") for (int i = 4 * (h); i < 4 * (h) + 4; ++i) { \
            _Pragma("unroll") for (int c = 0; c < 4; ++c) tile[(4 * nq + c) * 33 + 4 * i + kq] = GAIN ? pk2(va[i][0][c] * gv[i].x, va[i][1][c] * gv[i].y) : pk2(va[i][0][c], va[i][1][c]); } } while (0)
#define P0_OUT(sub) do { const int kb = k0 + 64 * (sub); \
        LDS_WAIT(); asm volatile("" ::: "memory"); \
        _Pragma("unroll") for (int st = 0; st < 8; ++st) { const int row = 8 * st + nr; const LAS unsigned* tp = tile + row * 33 + 4 * kch; \
            v4u o; o.x = tp[0]; o.y = tp[1]; o.z = tp[2]; o.w = tp[3]; \
            const int ng = n0 + row; const int drow = MODE == 0 ? ng : (MODE == 1 ? 256 * (ng >> 7) + (ng & 127) : 256 * (ng >> 7) + 128 + (ng & 127)); \
            if (ng < N) __builtin_nontemporal_store(o, (GAS v4u*)(WT + (size_t)drow * K + kb + 8 * kch)); } \
        LDS_WAIT(); asm volatile("" ::: "memory"); } while (0)
    P0_LOADH(0, 0); P0_LOADH(0, 1);
#pragma unroll 1
    for (int sub = 0; sub < KCH / 64; ++sub) { const bool more = sub + 1 < KCH / 64;
        P0_WRH(0); if (more) P0_LOADH(sub + 1, 0);
        P0_WRH(1); if (more) P0_LOADH(sub + 1, 1);
        P0_OUT(sub); }
#undef P0_LOADH
#undef P0_WRH
#undef P0_OUT
}
__device__ __forceinline__ void p0_row(Frame& F, const float* x, const float* meta, int r) {
    bf16* xrow = (bf16*)(F.ws + WS_XB) + (size_t)r * DM;
    const float* src = r < MTOK ? x + (size_t)r * DM : meta + (size_t)((r - MTOK) & 15) * DM;
    const bool pad = r >= MTOK + NB * NMETA;
    float s = 0.f;
    f32x4 v[16];
#pragma unroll
    for (int j = 0; j < 16; ++j) { const int e = (F.lane + 64 * j) * 4; v[j] = pad ? (f32x4){0.f, 0.f, 0.f, 0.f} : *(const GAS f32x4*)(src + e); }
#pragma unroll
    for (int j = 0; j < 16; ++j) { const int e = (F.lane + 64 * j) * 4;
        s += (v[j].x * v[j].x + v[j].y * v[j].y) + (v[j].z * v[j].z + v[j].w * v[j].w);
        if (r >= MTOK && !pad) { u64* hm = (u64*)(F.ws + WS_HMETA) + (size_t)(r - MTOK) * DM + e; hm[0] = fx_from(v[j].x); hm[1] = fx_from(v[j].y); hm[2] = fx_from(v[j].z); hm[3] = fx_from(v[j].w); }
        v2u w; w.x = pk2(v[j].x, v[j].y); w.y = pk2(v[j].z, v[j].w); *(GAS v2u*)(xrow + e) = w; }
    s = wave_sum(s);
    if (F.lane == 0) ((u64*)(F.ws + WS_SSQ0))[r] = fx_from_pos(s);
}
#ifndef CONV_IN_P2
#define CONV_IN_P2 1
#endif
constexpr int P0_KC = 256;
constexpr int CV_G = 172 * (DM / P0_KC), CV_D = 64 * (DFF / P0_KC), CV_IN1 = 384 * (DM / P0_KC), CV_O1 = 64 * (RET_VW / P0_KC);
constexpr int CV_FINE = 2 * (2 * CV_G + CV_D) + CV_IN1 + CV_O1;
constexpr int TL1_LO = 0, TL1_N = 4224;
constexpr int TL4_LO = 2 * CV_G, TL4_N = 1176;
constexpr int TL6_LO = 2 * CV_G + CV_D + CV_IN1 + CV_O1, TL6_N = 4480;
constexpr int TL10_LO = CV_FINE - CV_D, TL10_N = CV_D;
static_assert(TL6_LO == 2 * CV_G + CV_D + CV_IN1 + CV_O1 && TL1_LO + TL1_N <= TL4_LO && TL4_LO + TL4_N <= TL6_LO && TL6_LO + TL6_N <= TL10_LO && TL10_LO + TL10_N == CV_FINE, "tail ranges");
constexpr int CV_P2 = CONV_IN_P2 ? CV_FINE - TL1_N - TL4_N - TL6_N - TL10_N : 0;
constexpr int CV_PER = 32, N_CONV = (CV_P2 + CV_PER - 1) / CV_PER;
__host__ __device__ constexpr int p2_conv_index(int d) {
    return d < TL4_LO - (TL1_LO + TL1_N) ? TL1_LO + TL1_N + d
         : d < (TL4_LO - (TL1_LO + TL1_N)) + (TL6_LO - (TL4_LO + TL4_N)) ? TL4_LO + TL4_N + (d - (TL4_LO - (TL1_LO + TL1_N)))
         : TL6_LO + TL6_N + (d - (TL4_LO - (TL1_LO + TL1_N)) - (TL6_LO - (TL4_LO + TL4_N))); }
static_assert(p2_conv_index(0) == (TL1_LO + TL1_N < TL4_LO ? TL1_LO + TL1_N : TL4_LO + TL4_N) && p2_conv_index(CV_FINE - TL1_N - TL4_N - TL6_N - TL10_N - 1) == (TL6_LO + TL6_N < TL10_LO ? TL10_LO - 1 : TL6_LO - 1), "P2 conversion index map");
struct ConvPtrs { const float *wg, *wu, *wd, *win1, *wo1, *fnorm, *cnorm; };
__device__ __forceinline__ void conv_fine_b2(unsigned char* ws, LAS unsigned* tile, const ConvPtrs P, int it, int lane) {
    int r = it;
    if (r < CV_G) { p0_tr<1, P0_KC, true>(P.wg, DM, DFF, (bf16*)(ws + WS_WGU0), tile, r, lane, P.fnorm); return; } r -= CV_G;
    if (r < CV_G) { p0_tr<2, P0_KC, true>(P.wu, DM, DFF, (bf16*)(ws + WS_WGU0), tile, r, lane, P.fnorm); return; } r -= CV_G;
    if (r < CV_D) { p0_tr<0, P0_KC>(P.wd, DFF, DM, (bf16*)(ws + WS_WD0), tile, r, lane); return; } r -= CV_D;
    if (r < CV_IN1) { p0_tr<0, P0_KC, true>(P.win1, DM, RET_IN, (bf16*)(ws + WS_WIN1), tile, r, lane, P.cnorm); return; } r -= CV_IN1;
    if (r < CV_O1) { p0_tr<0, P0_KC>(P.wo1, RET_VW, DM, (bf16*)(ws + WS_WOUT1), tile, r, lane); return; } r -= CV_O1;
    if (r < CV_G) { p0_tr<1, P0_KC, true>(P.wg + (size_t)DM * DFF, DM, DFF, (bf16*)(ws + WS_WGU1), tile, r, lane, P.fnorm + DM); return; } r -= CV_G;
    if (r < CV_G) { p0_tr<2, P0_KC, true>(P.wu + (size_t)DM * DFF, DM, DFF, (bf16*)(ws + WS_WGU1), tile, r, lane, P.fnorm + DM); return; } r -= CV_G;
    p0_tr<0, P0_KC>(P.wd + (size_t)DFF * DM, DFF, DM, (bf16*)(ws + WS_WD1), tile, r, lane);
}
__device__ __forceinline__ void conv_item(unsigned char* ws, LAS unsigned char* ldsb, ConvPtrs P, int ci, int wave, int lane) {
    LAS unsigned* tile = (LAS unsigned*)(ldsb + wave * 8448);
    for (int k = wave; k < CV_PER; k += NWAVES) { const int d = __builtin_amdgcn_readfirstlane(ci * CV_PER + k); if (d < CV_P2) conv_fine_b2(ws, tile, P, p2_conv_index(d), lane); }
}
__device__ __forceinline__ void tail_conv(Frame& F, const Args& A, int qword, int lo, int n) {
#if CONV_IN_P2
    gu32* q = (gu32*)(F.ws + WS_CTL) + qword;
    const ConvPtrs CP{A.in[20], A.in[21], A.in[22], A.in[16], A.in[18], A.in[19], A.in[15]};
    LAS unsigned* tile = (LAS unsigned*)(F.lds + F.wave * 8448);
    for (;;) {
        if (F.tid == 0) F.MISC[0] = __hip_atomic_fetch_add(q, 1u, RLX_AGENT);
        __syncthreads();
        const int bt = (int)F.MISC[0];
        __syncthreads();
        if (bt * NWAVES >= n) break;
        const int k = __builtin_amdgcn_readfirstlane(bt * NWAVES + F.wave);
        if (k < n) conv_fine_b2(F.ws, tile, CP, lo + k, F.lane);
    }
#endif
}
__device__ __forceinline__ void p0_prologue(Frame& F, const Args& A) {
    const int gw = __builtin_amdgcn_readfirstlane(blockIdx.x * NWAVES + F.wave), NGW = F.G * NWAVES;
    unsigned char* ws = F.ws;
    constexpr int KC = P0_KC; LAS unsigned* tile = (LAS unsigned*)(F.lds + F.wave * 8448);
    constexpr int I_IN0 = 161 * (DM / KC), I_SQ = 64 * (DM / KC), I_BD = 16 * 2;
    constexpr int NITEMS = I_IN0 + I_SQ + 2 * I_BD;
    for (int it = gw; it < NITEMS; it += NGW) {
        int r = it;
        if (r < I_IN0) { p0_tr<0, KC, true>(A.in[3], DM, AB_IN, (bf16*)(ws + WS_WIN0), tile, r, F.lane, A.in[2]); continue; } r -= I_IN0;
        if (r < I_SQ) { p0_tr<0, KC>(A.in[14], DM, DM, (bf16*)(ws + WS_WOUT0), tile, r, F.lane); continue; } r -= I_SQ;
        if (r < I_BD) { const int blk = r >> 1; p0_tr<0, 128>(A.in[7] + (size_t)blk * 16384, 128, 128, (bf16*)(ws + WS_WAT) + (size_t)blk * 16384, tile, r & 1, F.lane); continue; } r -= I_BD;
        { const int blk = r >> 1; p0_tr<0, 128>(A.in[9] + (size_t)blk * 16384, 128, 128, (bf16*)(ws + WS_WXT) + (size_t)blk * 16384, tile, r & 1, F.lane); }
    }
#if !CONV_IN_P2
    { const ConvPtrs CP{A.in[20], A.in[21], A.in[22], A.in[16], A.in[18], A.in[19], A.in[15]};
      for (int it = gw; it < CV_FINE; it += NGW) conv_fine_b2(ws, tile, CP, it, F.lane); }
#endif
    for (int m = gw; m < MP; m += NGW) p0_row(F, A.in[0], A.in[1], m);
}

__device__ __forceinline__ float sigmoidf_fast(float x) { return __builtin_amdgcn_rcpf(1.0f + __expf(-x)); }
__device__ __forceinline__ float gelu_tanh(float g) { const float z = 0.7978845608028654f * (g + 0.044715f * g * g * g); const float e = __expf(2.0f * z); return 0.5f * g * (2.0f - 2.0f * __builtin_amdgcn_rcpf(e + 1.0f)); }

constexpr int LRU_XA = 0, LRU_STRIDE = 272, LRU_XF = 17408, LRU_XF_STRIDE = 132  , LRU_GT = 51200, LRU_YT = 68608;
__device__ __forceinline__ void lru_item(Frame& F, const Args& A, int b, int n) {
    const bf16* z0 = (const bf16*)(F.ws + WS_Z); bf16* y0 = (bf16*)(F.ws + WS_Y0);
    const int tid = F.tid, lane = F.lane, w = F.wave, fr = lane & 15, fq = lane >> 4;
    LAS unsigned char* lds = F.lds;
    LAS float* XF = (LAS float*)(lds + LRU_XF);
    const int c8 = (tid & 15) * 8, r4 = tid >> 4;
    const int ch0 = n * 128 + c8;
    float cw[4][8], cb[8];
#pragma unroll
    for (int e = 0; e < 8; ++e) { cb[e] = A.in[6][ch0 + e];
#pragma unroll
        for (int j = 0; j < 4; ++j) cw[j][e] = A.in[5][j * LRU_W + ch0 + e]; }
    const int dch = n * 128 + 16 * w + fr;
    const float ba = A.in[8][dch], bx = A.in[10][dch];
    const float cneg = -8.0f * log1pf(expf(-A.in[11][dch]));
    bf16x8 bwa[4], bwx[4];
    { const bf16* wat = (const bf16*)(F.ws + WS_WAT) + ((size_t)n * 128 + 16 * w + fr) * 128 + 8 * fq; const bf16* wxt = (const bf16*)(F.ws + WS_WXT) + ((size_t)n * 128 + 16 * w + fr) * 128 + 8 * fq;
#pragma unroll
      for (int ks = 0; ks < 4; ++ks) { bwa[ks] = *(const bf16x8*)(wat + 32 * ks); bwx[ks] = *(const bf16x8*)(wxt + 32 * ks); } }
    float hc = 0.f;
    v4u xr[2][4], gv[2];
#define LRU_LOAD(tau) do { _Pragma("unroll") for (int q = 0; q < 2; ++q) { const int t = 64 * (tau) + r4 + 32 * q - 48; \
            gv[q] = (v4u){0u, 0u, 0u, 0u}; if (t >= 0) gv[q] = *(const GAS v4u*)(z0 + (size_t)row_of(b, t) * AB_Z + LRU_W + ch0); \
            _Pragma("unroll") for (int j = 0; j < 4; ++j) { const int tj = t - 3 + j; xr[q][j] = (v4u){0u, 0u, 0u, 0u}; if (tj >= 0) xr[q][j] = *(const GAS v4u*)(z0 + (size_t)row_of(b, tj) * AB_Z + ch0); } } } while (0)
    LRU_LOAD(0);
    for (int tau = 0; tau < 65; ++tau) {
#pragma unroll
        for (int q = 0; q < 2; ++q) {
            const int rr = r4 + 32 * q;
            float xc[8];
#pragma unroll
            for (int e = 0; e < 8; ++e) xc[e] = cb[e];
#pragma unroll
            for (int j = 0; j < 4; ++j) { float xf[8]; unpack8(xr[q][j], xf);
#pragma unroll
                for (int e = 0; e < 8; ++e) xc[e] += cw[j][e] * xf[e]; }
            *(LAS v4u*)(lds + LRU_XA + rr * LRU_STRIDE + c8 * 2) = pack8f(xc);
            *(LAS f32x4*)(XF + rr * LRU_XF_STRIDE + c8) = (f32x4){xc[0], xc[1], xc[2], xc[3]};
            *(LAS f32x4*)(XF + rr * LRU_XF_STRIDE + c8 + 4) = (f32x4){xc[4], xc[5], xc[6], xc[7]};
            *(LAS v4u*)(lds + LRU_GT + rr * LRU_STRIDE + c8 * 2) = gv[q];
        }
        if (tau < 64) LRU_LOAD(tau + 1);
        __syncthreads();
        f32x4 accr[4], acci[4];
#pragma unroll
        for (int m = 0; m < 4; ++m) { accr[m] = (f32x4){0.f, 0.f, 0.f, 0.f}; acci[m] = (f32x4){0.f, 0.f, 0.f, 0.f}; }
#pragma unroll
        for (int m = 0; m < 4; ++m)
#pragma unroll
            for (int ks = 0; ks < 4; ++ks) { const bf16x8 a = *(const LAS bf16x8*)(lds + LRU_XA + (16 * m + fr) * LRU_STRIDE + (32 * ks + 8 * fq) * 2);
                accr[m] = mfma16(a, bwa[ks], accr[m]); acci[m] = mfma16(a, bwx[ks], acci[m]); }
        const int d = 16 * w + fr;
#pragma unroll
        for (int m = 0; m < 4; ++m) {
            float av[4], bv[4];
#pragma unroll
            for (int g = 0; g < 4; ++g) { const int rr = 16 * m + 4 * fq + g;
                const float rg = sigmoidf_fast(accr[m][g] + ba), ig = sigmoidf_fast(acci[m][g] + bx);
                const float la = cneg * rg; av[g] = __expf(la); const float mult = __builtin_amdgcn_sqrtf(fmaxf(1.0f - __expf(2.0f * la), 0.f));
                bv[g] = mult * (ig * XF[rr * LRU_XF_STRIDE + d]);
                if (tau == 0 && rr < 48) bv[g] = 0.f; }
            float P = av[0] * av[1], H = bv[0] * av[1] + bv[1]; P *= av[2]; H = H * av[2] + bv[2]; P *= av[3]; H = H * av[3] + bv[3];
            { const float P1 = __shfl_up(P, 16), H1 = __shfl_up(H, 16); if (fq >= 1) { H = P * H1 + H; P = P1 * P; } }
            { const float P2 = __shfl_up(P, 32), H2 = __shfl_up(H, 32); if (fq >= 2) { H = P * H2 + H; P = P2 * P; } }
            float Pe = __shfl_up(P, 16), He = __shfl_up(H, 16); if (fq == 0) { Pe = 1.f; He = 0.f; }
            float h = Pe * hc + He;
            float hv[4];
#pragma unroll
            for (int g = 0; g < 4; ++g) { h = av[g] * h + bv[g]; hv[g] = h; }
            hc = __shfl(h, 48 + fr);
#pragma unroll
            for (int g = 0; g < 4; ++g) { const int rr = 16 * m + 4 * fq + g;
                const float gt = bf2f(*(const LAS unsigned short*)(lds + LRU_GT + rr * LRU_STRIDE + d * 2));
                *(LAS unsigned short*)(lds + LRU_YT + rr * LRU_STRIDE + d * 2) = (unsigned short)(pk2(hv[g] * gelu_tanh(gt), 0.f) & 0xffffu); }
        }
        __syncthreads();
#pragma unroll
        for (int q = 0; q < 2; ++q) { const int rr = r4 + 32 * q, t = 64 * tau + rr - 48;
            if (t >= 0) *(GAS v4u*)(y0 + (size_t)row_of(b, t) * DM + ch0) = *(const LAS v4u*)(lds + LRU_YT + rr * LRU_STRIDE + c8 * 2); }
    }
#undef LRU_LOAD
    __syncthreads();
}

constexpr int AT_STRIDE = 272, AT_TILE = 64 * AT_STRIDE, AT_KT = 0, AT_VN = 2 * AT_TILE, AT_RSK = 4 * AT_TILE, AT_CUM = AT_RSK + 512, AT_SCAN = AT_CUM + 4352 * 4;
static_assert(AT_SCAN + 64 <= RING_BYTES, "attention LDS map");
__device__ __forceinline__ float log_sigmoid(float x) { return fminf(x, 0.f) - log1pf(__expf(-fabsf(x))); }
__device__ __forceinline__ void attn_item(Frame& F, const Args& A, int b, int h, int j) {
    const bf16* z0 = (const bf16*)(F.ws + WS_Z); bf16* y0 = (bf16*)(F.ws + WS_Y0); const float* fbuf = (const float*)(F.ws + WS_FBUF);
    const int tid = F.tid, lane = F.lane, w = F.wave, fr = lane & 15, fq = lane >> 4;
    LAS unsigned char* lds = F.lds;
    LAS float* CUM = (LAS float*)(lds + AT_CUM); LAS float* SCAN = (LAS float*)(lds + AT_SCAN); LAS float* RSK = (LAS float*)(lds + AT_RSK);
    constexpr float LOG2E = 1.4426950408889634f;
    const int nT = NMETA + 256 * j;
    { const float bf_h = A.in[4][h];
      float loc[9]; float run = 0.f;
#pragma unroll
      for (int e = 0; e < 9; ++e) { const int t = 9 * tid + e; float v = 0.f; if (t < nT) v = log_sigmoid(fbuf[(size_t)row_of(b, t) * 16 + h] + bf_h); run += v; loc[e] = run; }
      float inc = run;
#pragma unroll
      for (int o = 1; o < 64; o <<= 1) { const float t = __shfl_up(inc, o); if (lane >= o) inc += t; }
      if (lane == 63) SCAN[w] = inc;
      __syncthreads();
      float off = inc - run;
      for (int k = 0; k < w; ++k) off += SCAN[k];
#pragma unroll
      for (int e = 0; e < 9; ++e) { const int t = 9 * tid + e; if (t < nT) CUM[t + 240] = (off + loc[e]) * LOG2E; }
      if (tid < 240) CUM[tid] = 0.f; }
    bf16x8 qf[2][4];
    const int ubase = 256 * j + 32 * w;
#pragma unroll
    for (int m = 0; m < 2; ++m) {
        const int u = ubase + 16 * m + fr; const int t = u - 240; const int r = row_of(b, t < 0 ? 0 : t);
        const bf16* qp = z0 + (size_t)r * AB_Z + 4096 + 128 * h + 8 * fq;
        float qv[4][8]; float s = 0.f;
#pragma unroll
        for (int ks = 0; ks < 4; ++ks) { const v4u raw = *(const GAS v4u*)(qp + 32 * ks); unpack8(raw, qv[ks]);
#pragma unroll
            for (int e = 0; e < 8; ++e) s += qv[ks][e] * qv[ks][e]; }
        s = sum_x32(sum_x16(s));
        const float rs = __builtin_amdgcn_rsqf(s * (1.0f / 128.0f) + RMS_EPS) * (0.08838834764831845f * LOG2E);
#pragma unroll
        for (int ks = 0; ks < 4; ++ks) { float o[8];
#pragma unroll
            for (int e = 0; e < 8; ++e) o[e] = qv[ks][e] * rs * (A.in[12][32 * ks + 8 * fq + e] * A.in[13][32 * ks + 8 * fq + e]);
            const v4u pk = pack8f(o); qf[m][ks] = __builtin_bit_cast(bf16x8, pk); }
    }
    f32x4 O[2][8]; float mrow[2], lrow[2];
#pragma unroll
    for (int m = 0; m < 2; ++m) {
#pragma unroll
        for (int dt = 0; dt < 8; ++dt) O[m][dt] = (f32x4){0.f, 0.f, 0.f, 0.f};
        mrow[m] = -1e30f; lrow[m] = 0.f; }
    const int imax = 4 * j + 3;
    const int skey = tid >> 3, sdc = (tid & 7) * 16;
    const unsigned vbase = (unsigned)(size_t)lds + AT_VN + (4u * fq + ((unsigned)(lane & 15) >> 2)) * AT_STRIDE + 8u * (unsigned)(lane & 3);
    v4u kreg[2], vreg[2];
#define AT_LOAD(i_) do { const int t_ = 64 * (i_) + skey - 240; const int r_ = row_of(b, t_ < 0 ? 0 : t_); const bf16* kp_ = z0 + (size_t)r_ * AB_Z + 6144 + 128 * h + sdc; const bf16* vp_ = z0 + (size_t)r_ * AB_Z + 8192 + 128 * h + sdc; \
        kreg[0] = *(const GAS v4u*)(kp_); kreg[1] = *(const GAS v4u*)(kp_ + 8); vreg[0] = *(const GAS v4u*)(vp_); vreg[1] = *(const GAS v4u*)(vp_ + 8); } while (0)
#define AT_STAGE(buf_) do { float a8_[8], b8_[8]; unpack8(kreg[0], a8_); unpack8(kreg[1], b8_); float s_ = 0.f; \
        _Pragma("unroll") for (int e = 0; e < 8; ++e) s_ += a8_[e] * a8_[e] + b8_[e] * b8_[e]; \
        s_ = oct_sum(s_); \
        if ((tid & 7) == 0) RSK[(buf_) * 64 + skey] = __builtin_amdgcn_rsqf(s_ * (1.0f / 128.0f) + RMS_EPS); \
        *(LAS v4u*)(lds + AT_KT + (buf_) * AT_TILE + skey * AT_STRIDE + sdc * 2) = kreg[0]; *(LAS v4u*)(lds + AT_KT + (buf_) * AT_TILE + skey * AT_STRIDE + sdc * 2 + 16) = kreg[1]; \
        *(LAS v4u*)(lds + AT_VN + (buf_) * AT_TILE + skey * AT_STRIDE + sdc * 2) = vreg[0]; *(LAS v4u*)(lds + AT_VN + (buf_) * AT_TILE + skey * AT_STRIDE + sdc * 2 + 16) = vreg[1]; } while (0)
    AT_LOAD(3); AT_STAGE(1);
    if (imax > 3) AT_LOAD(4);
    __syncthreads();
    float bq[2];
#pragma unroll
    for (int m = 0; m < 2; ++m) bq[m] = CUM[ubase + 16 * m + fr];
#ifdef PROBE_ATT_A
    unsigned long long atm_t0 = 0, atm_acc = 0;
#define ATM(n) do { if ((n) == PROBE_ATT_A) atm_t0 = __builtin_amdgcn_s_memrealtime(); if ((n) == PROBE_ATT_B) atm_acc += __builtin_amdgcn_s_memrealtime() - atm_t0; } while (0)
#else
#define ATM(n) do { } while (0)
#endif
    for (int i = 3; i <= imax; ++i) {
        const int buf = i & 1;
        ATM(0);
        if (i < imax) { AT_STAGE(buf ^ 1); if (i + 1 < imax) AT_LOAD(i + 2); }
        ATM(1);
        if (64 * i <= ubase + 31) {
            f32x4 S[2][4];
#pragma unroll
            for (int m = 0; m < 2; ++m)
#pragma unroll
                for (int nt = 0; nt < 4; ++nt) S[m][nt] = (f32x4){0.f, 0.f, 0.f, 0.f};
#pragma unroll
            for (int nt = 0; nt < 4; ++nt)
#pragma unroll
                for (int ks = 0; ks < 4; ++ks) { const bf16x8 kf = *(const LAS bf16x8*)(lds + AT_KT + buf * AT_TILE + (16 * nt + fr) * AT_STRIDE + (32 * ks + 8 * fq) * 2);
                    S[0][nt] = mfma16(kf, qf[0][ks], S[0][nt]); S[1][nt] = mfma16(kf, qf[1][ks], S[1][nt]); }
            ATM(2);
            const bool need_mask = (i == 3) || (64 * i + 63 > ubase);
            bf16x8 pb[2][2];
#pragma unroll
            for (int m = 0; m < 2; ++m) {
                const int uq = ubase + 16 * m + fr;
                float mx = -__builtin_inff();
#pragma unroll
                for (int nt = 0; nt < 4; ++nt) { const f32x4 bkv = *(const LAS f32x4*)(CUM + 64 * i + 16 * nt + 4 * fq), rkv = *(const LAS f32x4*)(RSK + buf * 64 + 16 * nt + 4 * fq);
#pragma unroll
                    for (int g = 0; g < 4; ++g) { float sv = S[m][nt][g] * rkv[g] + (bq[m] - bkv[g]);
                        if (need_mask) { const int uk = 64 * i + 16 * nt + 4 * fq + g; if (uk > uq || uk < 240) sv = -__builtin_inff(); }
                        S[m][nt][g] = sv; mx = fmaxf(mx, sv); } }
                mx = max_x32(max_x16(mx));
                const float mn = fmaxf(mrow[m], mx);
                const float alpha = __builtin_amdgcn_exp2f(mrow[m] - mn); mrow[m] = mn;
                float ps = 0.f;
#pragma unroll
                for (int nt = 0; nt < 4; ++nt)
#pragma unroll
                    for (int g = 0; g < 4; ++g) { const float p = __builtin_amdgcn_exp2f(S[m][nt][g] - mn); ps += p; S[m][nt][g] = p; }
                lrow[m] = lrow[m] * alpha + ps;
                if (!__all(alpha == 1.0f)) {
#pragma unroll
                    for (int dt = 0; dt < 8; ++dt) O[m][dt] *= alpha; }
#pragma unroll
                for (int k2 = 0; k2 < 2; ++k2) { v4u pw; pw.x = pk2(S[m][2 * k2][0], S[m][2 * k2][1]); pw.y = pk2(S[m][2 * k2][2], S[m][2 * k2][3]); pw.z = pk2(S[m][2 * k2 + 1][0], S[m][2 * k2 + 1][1]); pw.w = pk2(S[m][2 * k2 + 1][2], S[m][2 * k2 + 1][3]);
                    pb[m][k2] = __builtin_bit_cast(bf16x8, pw); }
            }
            ATM(3);
            const unsigned vb = vbase + (unsigned)(buf * AT_TILE);
            { v2u vp[16]; asm volatile("ds_read_b64_tr_b16 %0, %16 offset:0 \n\tds_read_b64_tr_b16 %1, %16 offset:4352 \n\tds_read_b64_tr_b16 %2, %16 offset:8704 \n\tds_read_b64_tr_b16 %3, %16 offset:13056 \n\tds_read_b64_tr_b16 %4, %16 offset:32 \n\tds_read_b64_tr_b16 %5, %16 offset:4384 \n\tds_read_b64_tr_b16 %6, %16 offset:8736 \n\tds_read_b64_tr_b16 %7, %16 offset:13088 \n\tds_read_b64_tr_b16 %8, %16 offset:64 \n\tds_read_b64_tr_b16 %9, %16 offset:4416 \n\tds_read_b64_tr_b16 %10, %16 offset:8768 \n\tds_read_b64_tr_b16 %11, %16 offset:13120 \n\tds_read_b64_tr_b16 %12, %16 offset:96 \n\tds_read_b64_tr_b16 %13, %16 offset:4448 \n\tds_read_b64_tr_b16 %14, %16 offset:8800 \n\tds_read_b64_tr_b16 %15, %16 offset:13152 \n\ts_waitcnt lgkmcnt(0)" : "=&v"(vp[0]), "=&v"(vp[1]), "=&v"(vp[2]), "=&v"(vp[3]), "=&v"(vp[4]), "=&v"(vp[5]), "=&v"(vp[6]), "=&v"(vp[7]), "=&v"(vp[8]), "=&v"(vp[9]), "=&v"(vp[10]), "=&v"(vp[11]), "=&v"(vp[12]), "=&v"(vp[13]), "=&v"(vp[14]), "=&v"(vp[15]) : "v"(vb) : "memory");
              { v4u aw; aw.x = vp[0].x; aw.y = vp[0].y; aw.z = vp[1].x; aw.w = vp[1].y; const bf16x8 vfr = __builtin_bit_cast(bf16x8, aw); O[0][0] = mfma16(vfr, pb[0][0], O[0][0]); O[1][0] = mfma16(vfr, pb[1][0], O[1][0]); }
              { v4u aw; aw.x = vp[2].x; aw.y = vp[2].y; aw.z = vp[3].x; aw.w = vp[3].y; const bf16x8 vfr = __builtin_bit_cast(bf16x8, aw); O[0][0] = mfma16(vfr, pb[0][1], O[0][0]); O[1][0] = mfma16(vfr, pb[1][1], O[1][0]); }
              { v4u aw; aw.x = vp[4].x; aw.y = vp[4].y; aw.z = vp[5].x; aw.w = vp[5].y; const bf16x8 vfr = __builtin_bit_cast(bf16x8, aw); O[0][1] = mfma16(vfr, pb[0][0], O[0][1]); O[1][1] = mfma16(vfr, pb[1][0], O[1][1]); }
              { v4u aw; aw.x = vp[6].x; aw.y = vp[6].y; aw.z = vp[7].x; aw.w = vp[7].y; const bf16x8 vfr = __builtin_bit_cast(bf16x8, aw); O[0][1] = mfma16(vfr, pb[0][1], O[0][1]); O[1][1] = mfma16(vfr, pb[1][1], O[1][1]); }
              { v4u aw; aw.x = vp[8].x; aw.y = vp[8].y; aw.z = vp[9].x; aw.w = vp[9].y; const bf16x8 vfr = __builtin_bit_cast(bf16x8, aw); O[0][2] = mfma16(vfr, pb[0][0], O[0][2]); O[1][2] = mfma16(vfr, pb[1][0], O[1][2]); }
              { v4u aw; aw.x = vp[10].x; aw.y = vp[10].y; aw.z = vp[11].x; aw.w = vp[11].y; const bf16x8 vfr = __builtin_bit_cast(bf16x8, aw); O[0][2] = mfma16(vfr, pb[0][1], O[0][2]); O[1][2] = mfma16(vfr, pb[1][1], O[1][2]); }
              { v4u aw; aw.x = vp[12].x; aw.y = vp[12].y; aw.z = vp[13].x; aw.w = vp[13].y; const bf16x8 vfr = __builtin_bit_cast(bf16x8, aw); O[0][3] = mfma16(vfr, pb[0][0], O[0][3]); O[1][3] = mfma16(vfr, pb[1][0], O[1][3]); }
              { v4u aw; aw.x = vp[14].x; aw.y = vp[14].y; aw.z = vp[15].x; aw.w = vp[15].y; const bf16x8 vfr = __builtin_bit_cast(bf16x8, aw); O[0][3] = mfma16(vfr, pb[0][1], O[0][3]); O[1][3] = mfma16(vfr, pb[1][1], O[1][3]); }
            }
            { v2u vp[16]; asm volatile("ds_read_b64_tr_b16 %0, %16 offset:128 \n\tds_read_b64_tr_b16 %1, %16 offset:4480 \n\tds_read_b64_tr_b16 %2, %16 offset:8832 \n\tds_read_b64_tr_b16 %3, %16 offset:13184 \n\tds_read_b64_tr_b16 %4, %16 offset:160 \n\tds_read_b64_tr_b16 %5, %16 offset:4512 \n\tds_read_b64_tr_b16 %6, %16 offset:8864 \n\tds_read_b64_tr_b16 %7, %16 offset:13216 \n\tds_read_b64_tr_b16 %8, %16 offset:192 \n\tds_read_b64_tr_b16 %9, %16 offset:4544 \n\tds_read_b64_tr_b16 %10, %16 offset:8896 \n\tds_read_b64_tr_b16 %11, %16 offset:13248 \n\tds_read_b64_tr_b16 %12, %16 offset:224 \n\tds_read_b64_tr_b16 %13, %16 offset:4576 \n\tds_read_b64_tr_b16 %14, %16 offset:8928 \n\tds_read_b64_tr_b16 %15, %16 offset:13280 \n\ts_waitcnt lgkmcnt(0)" : "=&v"(vp[0]), "=&v"(vp[1]), "=&v"(vp[2]), "=&v"(vp[3]), "=&v"(vp[4]), "=&v"(vp[5]), "=&v"(vp[6]), "=&v"(vp[7]), "=&v"(vp[8]), "=&v"(vp[9]), "=&v"(vp[10]), "=&v"(vp[11]), "=&v"(vp[12]), "=&v"(vp[13]), "=&v"(vp[14]), "=&v"(vp[15]) : "v"(vb) : "memory");
              { v4u aw; aw.x = vp[0].x; aw.y = vp[0].y; aw.z = vp[1].x; aw.w = vp[1].y; const bf16x8 vfr = __builtin_bit_cast(bf16x8, aw); O[0][4] = mfma16(vfr, pb[0][0], O[0][4]); O[1][4] = mfma16(vfr, pb[1][0], O[1][4]); }
              { v4u aw; aw.x = vp[2].x; aw.y = vp[2].y; aw.z = vp[3].x; aw.w = vp[3].y; const bf16x8 vfr = __builtin_bit_cast(bf16x8, aw); O[0][4] = mfma16(vfr, pb[0][1], O[0][4]); O[1][4] = mfma16(vfr, pb[1][1], O[1][4]); }
              { v4u aw; aw.x = vp[4].x; aw.y = vp[4].y; aw.z = vp[5].x; aw.w = vp[5].y; const bf16x8 vfr = __builtin_bit_cast(bf16x8, aw); O[0][5] = mfma16(vfr, pb[0][0], O[0][5]); O[1][5] = mfma16(vfr, pb[1][0], O[1][5]); }
              { v4u aw; aw.x = vp[6].x; aw.y = vp[6].y; aw.z = vp[7].x; aw.w = vp[7].y; const bf16x8 vfr = __builtin_bit_cast(bf16x8, aw); O[0][5] = mfma16(vfr, pb[0][1], O[0][5]); O[1][5] = mfma16(vfr, pb[1][1], O[1][5]); }
              { v4u aw; aw.x = vp[8].x; aw.y = vp[8].y; aw.z = vp[9].x; aw.w = vp[9].y; const bf16x8 vfr = __builtin_bit_cast(bf16x8, aw); O[0][6] = mfma16(vfr, pb[0][0], O[0][6]); O[1][6] = mfma16(vfr, pb[1][0], O[1][6]); }
              { v4u aw; aw.x = vp[10].x; aw.y = vp[10].y; aw.z = vp[11].x; aw.w = vp[11].y; const bf16x8 vfr = __builtin_bit_cast(bf16x8, aw); O[0][6] = mfma16(vfr, pb[0][1], O[0][6]); O[1][6] = mfma16(vfr, pb[1][1], O[1][6]); }
              { v4u aw; aw.x = vp[12].x; aw.y = vp[12].y; aw.z = vp[13].x; aw.w = vp[13].y; const bf16x8 vfr = __builtin_bit_cast(bf16x8, aw); O[0][7] = mfma16(vfr, pb[0][0], O[0][7]); O[1][7] = mfma16(vfr, pb[1][0], O[1][7]); }
              { v4u aw; aw.x = vp[14].x; aw.y = vp[14].y; aw.z = vp[15].x; aw.w = vp[15].y; const bf16x8 vfr = __builtin_bit_cast(bf16x8, aw); O[0][7] = mfma16(vfr, pb[0][1], O[0][7]); O[1][7] = mfma16(vfr, pb[1][1], O[1][7]); }
            }
        }
        ATM(4);
        __syncthreads();
        ATM(5);
    }
#ifdef PROBE_ATT_A
    if (w == 0 && lane == 0 && blockIdx.x == 0) { const unsigned long long a_ = (((unsigned long long)F.MISC[23] << 32) | F.MISC[22]) + atm_acc; F.MISC[22] = (unsigned)a_; F.MISC[23] = (unsigned)(a_ >> 32); }
#endif
#undef ATM
#undef AT_LOAD
#undef AT_STAGE
#pragma unroll
    for (int m = 0; m < 2; ++m) {
        float l = sum_x32(sum_x16(lrow[m]));
        const int t = ubase + 16 * m + fr - 240;
        if (t >= 0) { const float il = __builtin_amdgcn_rcpf(l); bf16* op = y0 + (size_t)row_of(b, t) * DM + LRU_W + 128 * h + 4 * fq;
#pragma unroll
            for (int dt = 0; dt < 8; ++dt) { v2u o; o.x = pk2(O[m][dt][0] * il, O[m][dt][1] * il); o.y = pk2(O[m][dt][2] * il, O[m][dt][3] * il); *(GAS v2u*)(op + 16 * dt) = o; } }
    }
}

__device__ __forceinline__ int p2_fetch(Frame& F, gu32* qctr) {
    if ((F.wave == 0 && hw_lane() == 0)) F.MISC[0] = __hip_atomic_fetch_add(qctr, 1u, RLX_AGENT);
    __syncthreads();
    const int item = (int)F.MISC[0];
    __syncthreads();
    return item;
}
#ifndef CONV_CAP
#define CONV_CAP 96
#endif
__device__ __forceinline__ int p2_next(Frame& F, gu32* qa, gu32* qc, gu32* act, int nconv, int qa_end, int pending) {
    if ((F.wave == 0 && hw_lane() == 0)) {
        int code = -1;
        bool done_att = F.MISC[3] != 0u;
        if (!done_att) {
            if (pending >= 0) { if (pending < qa_end) code = pending; else done_att = true; }
            else {
                if ((int)__hip_atomic_load(qc, RLX_AGENT) < nconv && (int)__hip_atomic_load(act, RLX_AGENT) < CONV_CAP) {
                    const int a = (int)__hip_atomic_fetch_add(act, 1u, RLX_AGENT);
                    if (a < CONV_CAP) { const int c = (int)__hip_atomic_fetch_add(qc, 1u, RLX_AGENT); if (c < nconv) code = -3 - c; }
                    if (code == -1) (void)__hip_atomic_fetch_add(act, 0xFFFFFFFFu, RLX_AGENT); }
                if (code == -1) { const int t = (int)__hip_atomic_fetch_add(qa, 1u, RLX_AGENT); if (t < qa_end) code = t; else done_att = true; } } }
        if (code == -1) { const int c = (int)__hip_atomic_fetch_add(qc, 1u, RLX_AGENT); if (c < nconv) { code = -3 - c; (void)__hip_atomic_fetch_add(act, 1u, RLX_AGENT); } else code = -2; }
        F.MISC[3] = done_att ? 1u : 0u; F.MISC[0] = (unsigned)code; }
    __syncthreads();
    const int code = (int)F.MISC[0];
    __syncthreads();
    return code;
}
__device__ __forceinline__ void p2_mixer0(Frame& F, const Args& A, int rep) {
    gu32* ctl = (gu32*)(F.ws + WS_CTL);
    gu32* qa = ctl + CW_Q2 + 64 * rep; gu32* qc = ctl + CW_QC + 64 * rep; gu32* act = ctl + CW_ACT + 64 * rep;
    constexpr int N_LRU = NB * 16, N_ATT = NB * FOX_H * 17;
    const int nconv = (rep == 0) ? N_CONV : 0;
    if ((F.wave == 0 && hw_lane() == 0)) F.MISC[3] = 0u;
    int item = p2_fetch(F, qa);
    while (item < N_LRU) { lru_item(F, A, item >> 4, item & 15); item = p2_fetch(F, qa); }
    int code = p2_next(F, qa, qc, act, nconv, N_LRU + N_ATT, item);
    while (code != -2) {
        Frame G = F; { const int ln = hw_lane(); G.lane = ln; G.tid = F.wave * 64 + ln; G.wave = F.wave; }
        if (code >= 0) { const int a = code - N_LRU; const int j = 16 - a / 64, bh = a % 64; attn_item(G, A, bh >> 4, bh & 15, j); }
        else { const ConvPtrs CP{A.in[20], A.in[21], A.in[22], A.in[16], A.in[18], A.in[19], A.in[15]}; conv_item(G.ws, G.lds, CP, -3 - code, G.wave, G.lane);
            __syncthreads(); if ((F.wave == 0 && hw_lane() == 0)) (void)__hip_atomic_fetch_add(act, 0xFFFFFFFFu, RLX_AGENT); }
        code = p2_next(F, qa, qc, act, nconv, N_LRU + N_ATT, -1);
    }
}

constexpr int RT_SQ = 528, RT_SV = 272, RT_SS_STRIDE = 144;
constexpr int RT_QS = 0, RT_KN = 33792, RT_VN = 67584, RT_VS = 84992, RT_SS = 102400, RT_OB = 111616, RT_OB_STRIDE = 272;
static_assert(RT_KN == 64 * RT_SQ && RT_VN == RT_KN + 64 * RT_SQ && RT_VS == RT_VN + 64 * RT_SV && RT_SS == RT_VS + 64 * RT_SV && RT_OB == RT_SS + 64 * RT_SS_STRIDE && RT_OB + 64 * RT_OB_STRIDE <= MISC_OFF, "retention LDS map");
__device__ __forceinline__ int ret_row(int b, int c, int idx) { return c == 0 ? (idx < 48 ? -1 : MMETA + NMETA * b + (idx - 48)) : b * SEQ + 64 * (c - 1) + idx; }
__device__ __forceinline__ void ret_item(Frame& F, const Args& A, int b, int h, int es, bool accum) {
    const bf16* z1 = (const bf16*)(F.ws + WS_Z); bf16* ob = (bf16*)(F.ws + WS_Y1); u64* ssqo = (u64*)(F.ws + WS_SSQO);
    const int tid = F.tid, lane = F.lane, w = F.wave, fr = lane & 15, fq = lane >> 4;
    LAS unsigned char* lds = F.lds;
    const float lg = log1pf(-exp2f(-5.0f - (float)h)) * 1.4426950408889634f;
    const float cdec = __builtin_amdgcn_exp2f(lg * 64.0f);
    f32x4 Sacc[16];
#pragma unroll
    for (int dt = 0; dt < 16; ++dt) Sacc[dt] = (f32x4){0.f, 0.f, 0.f, 0.f};
    const int qrow = tid >> 5, qd = (tid & 31) * 8;
    const int vrow = tid >> 4, ve = (tid & 15) * 8;
    const float kd0 = __builtin_amdgcn_exp2f(lg * (float)(63 - vrow)), kd1 = __builtin_amdgcn_exp2f(lg * (float)(31 - vrow));
    const unsigned lbase = (unsigned)(size_t)lds;
    const unsigned trq = (unsigned)((lane & 15) >> 2), trp = (unsigned)(lane & 3);
    const unsigned kbase = lbase + RT_KN + (8u * fq + trq) * RT_SQ + 8u * trp;
    const unsigned vbase = lbase + RT_VN + (8u * fq + trq) * RT_SV + 32u * w + 8u * trp;
    const unsigned vsbase = vbase + (RT_VS - RT_VN);
    v4u qreg[4], kreg[4], vreg[2];
    const size_t qcol = (size_t)h * RET_QK + qd, kcol = 4096 + (size_t)h * RET_QK + qd, vcol = 8192 + (size_t)h * RET_V + 128 * es + ve;
#define RT_PREFETCH(c) do { \
        _Pragma("unroll") for (int k = 0; k < 4; ++k) { const int r = ret_row(b, (c), qrow + 16 * k); \
            if (r >= 0) { qreg[k] = *(const GAS v4u*)(z1 + (size_t)r * RET_IN + qcol); kreg[k] = *(const GAS v4u*)(z1 + (size_t)r * RET_IN + kcol); } \
            else { qreg[k] = (v4u){0u, 0u, 0u, 0u}; kreg[k] = (v4u){0u, 0u, 0u, 0u}; } } \
        _Pragma("unroll") for (int k = 0; k < 2; ++k) { const int r = ret_row(b, (c), vrow + 32 * k); \
            if (r >= 0) vreg[k] = *(const GAS v4u*)(z1 + (size_t)r * RET_IN + vcol); else vreg[k] = (v4u){0u, 0u, 0u, 0u}; } } while (0)
    RT_PREFETCH(0);
#define RT_BAR() do { asm volatile("s_waitcnt lgkmcnt(0)" ::: "memory"); __builtin_amdgcn_s_barrier(); asm volatile("" ::: "memory"); } while (0)
#define RT_FLUSH(cc) do { const int row_ = tid >> 3, seg_ = tid & 7; const LAS unsigned char* sp_ = lds + RT_OB + row_ * RT_OB_STRIDE + seg_ * 32; \
        const v4u o0_ = *(const LAS v4u*)(sp_), o1_ = *(const LAS v4u*)(sp_ + 16); \
        bf16* dp_ = ob + (size_t)(b * SEQ + 64 * ((cc) - 1) + row_) * RET_VW + h * RET_V + 128 * es + 16 * seg_; \
        *(GAS v4u*)(dp_) = o0_; *(GAS v4u*)(dp_ + 8) = o1_; } while (0)
#ifdef PROBE_ATT_A
    unsigned long long rtm_t0 = 0, rtm_acc = 0;
#define RTM(n) do { if ((n) + 100 == PROBE_ATT_A) rtm_t0 = __builtin_amdgcn_s_memrealtime(); if ((n) + 100 == PROBE_ATT_B) rtm_acc += __builtin_amdgcn_s_memrealtime() - rtm_t0; } while (0)
#else
#define RTM(n) do { } while (0)
#endif
    for (int c = 0; c < 65; ++c) {
        RTM(0);
        RT_BAR();
        RTM(1);
#pragma unroll
        for (int k = 0; k < 4; ++k) { const int m = qrow + 16 * k;
            *(LAS v4u*)(lds + RT_QS + m * RT_SQ + qd * 2) = qreg[k];
            *(LAS v4u*)(lds + RT_KN + m * RT_SQ + qd * 2) = kreg[k]; }
#pragma unroll
        for (int k = 0; k < 2; ++k) { const int m = vrow + 32 * k; float vf8[8]; unpack8(vreg[k], vf8); const float kd = k == 0 ? kd0 : kd1;
            *(LAS v4u*)(lds + RT_VN + m * RT_SV + ve * 2) = vreg[k];
#pragma unroll
            for (int e = 0; e < 8; ++e) vf8[e] *= kd;
            *(LAS v4u*)(lds + RT_VS + m * RT_SV + ve * 2) = pack8f(vf8); }
        RTM(15);
        RT_BAR();
        if (c < 64) RT_PREFETCH(c + 1);
        if (c >= 2) RT_FLUSH(c - 1);
        RTM(2);
        { const int it = w >> 1, mt0 = 2 * (w & 1);
          f32x4 sacc[2] = {(f32x4){0.f, 0.f, 0.f, 0.f}, (f32x4){0.f, 0.f, 0.f, 0.f}};
#pragma unroll
          for (int ks = 0; ks < 8; ++ks) { const bf16x8 a = *(const LAS bf16x8*)(lds + RT_QS + (16 * it + fr) * RT_SQ + (32 * ks + 8 * fq) * 2);
#pragma unroll
              for (int q = 0; q < 2; ++q) { const bf16x8 kb = *(const LAS bf16x8*)(lds + RT_KN + (16 * (mt0 + q) + fr) * RT_SQ + (32 * ks + 8 * fq) * 2); sacc[q] = mfma16(a, kb, sacc[q]); } }
#pragma unroll
          for (int q = 0; q < 2; ++q)
#pragma unroll
              for (int g = 0; g < 4; ++g) { const int i = 16 * it + 4 * fq + g, m = 16 * (mt0 + q) + fr; const int dd = i > m ? i - m : m - i;
                  const float sv = sacc[q][g] * __builtin_amdgcn_exp2f(lg * (float)dd);
                  *(LAS unsigned short*)(lds + RT_SS + i * RT_SS_STRIDE + m * 2) = (unsigned short)(pk2(sv, 0.f) & 0xffffu); } }
        RTM(3);
        RT_BAR();
        RTM(4);
        f32x4 acc[4];
#pragma unroll
        for (int mi = 0; mi < 4; ++mi) acc[mi] = (f32x4){0.f, 0.f, 0.f, 0.f};
        const unsigned qbase = lbase + RT_QS + (unsigned)fr * RT_SQ + 8u * (unsigned)fq;
        { v4u bw; bw.x = pk2(Sacc[0][0], Sacc[0][1]); bw.y = pk2(Sacc[0][2], Sacc[0][3]); bw.z = pk2(Sacc[1][0], Sacc[1][1]); bw.w = pk2(Sacc[1][2], Sacc[1][3]);
          const bf16x8 bfrag = __builtin_bit_cast(bf16x8, bw); v2u qq[8];
          asm volatile("ds_read_b64 %0, %8 offset:0 \n\tds_read_b64 %1, %8 offset:32 \n\tds_read_b64 %2, %8 offset:8448 \n\tds_read_b64 %3, %8 offset:8480 \n\tds_read_b64 %4, %8 offset:16896 \n\tds_read_b64 %5, %8 offset:16928 \n\tds_read_b64 %6, %8 offset:25344 \n\tds_read_b64 %7, %8 offset:25376 \n\ts_waitcnt lgkmcnt(0)" : "=&v"(qq[0]), "=&v"(qq[1]), "=&v"(qq[2]), "=&v"(qq[3]), "=&v"(qq[4]), "=&v"(qq[5]), "=&v"(qq[6]), "=&v"(qq[7]) : "v"(qbase) : "memory");
          { v4u aw; aw.x = qq[0].x; aw.y = qq[0].y; aw.z = qq[1].x; aw.w = qq[1].y; acc[0] = mfma16(__builtin_bit_cast(bf16x8, aw), bfrag, acc[0]); }
          { v4u aw; aw.x = qq[2].x; aw.y = qq[2].y; aw.z = qq[3].x; aw.w = qq[3].y; acc[1] = mfma16(__builtin_bit_cast(bf16x8, aw), bfrag, acc[1]); }
          { v4u aw; aw.x = qq[4].x; aw.y = qq[4].y; aw.z = qq[5].x; aw.w = qq[5].y; acc[2] = mfma16(__builtin_bit_cast(bf16x8, aw), bfrag, acc[2]); }
          { v4u aw; aw.x = qq[6].x; aw.y = qq[6].y; aw.z = qq[7].x; aw.w = qq[7].y; acc[3] = mfma16(__builtin_bit_cast(bf16x8, aw), bfrag, acc[3]); }
        }
        { v4u bw; bw.x = pk2(Sacc[2][0], Sacc[2][1]); bw.y = pk2(Sacc[2][2], Sacc[2][3]); bw.z = pk2(Sacc[3][0], Sacc[3][1]); bw.w = pk2(Sacc[3][2], Sacc[3][3]);
          const bf16x8 bfrag = __builtin_bit_cast(bf16x8, bw); v2u qq[8];
          asm volatile("ds_read_b64 %0, %8 offset:64 \n\tds_read_b64 %1, %8 offset:96 \n\tds_read_b64 %2, %8 offset:8512 \n\tds_read_b64 %3, %8 offset:8544 \n\tds_read_b64 %4, %8 offset:16960 \n\tds_read_b64 %5, %8 offset:16992 \n\tds_read_b64 %6, %8 offset:25408 \n\tds_read_b64 %7, %8 offset:25440 \n\ts_waitcnt lgkmcnt(0)" : "=&v"(qq[0]), "=&v"(qq[1]), "=&v"(qq[2]), "=&v"(qq[3]), "=&v"(qq[4]), "=&v"(qq[5]), "=&v"(qq[6]), "=&v"(qq[7]) : "v"(qbase) : "memory");
          { v4u aw; aw.x = qq[0].x; aw.y = qq[0].y; aw.z = qq[1].x; aw.w = qq[1].y; acc[0] = mfma16(__builtin_bit_cast(bf16x8, aw), bfrag, acc[0]); }
          { v4u aw; aw.x = qq[2].x; aw.y = qq[2].y; aw.z = qq[3].x; aw.w = qq[3].y; acc[1] = mfma16(__builtin_bit_cast(bf16x8, aw), bfrag, acc[1]); }
          { v4u aw; aw.x = qq[4].x; aw.y = qq[4].y; aw.z = qq[5].x; aw.w = qq[5].y; acc[2] = mfma16(__builtin_bit_cast(bf16x8, aw), bfrag, acc[2]); }
          { v4u aw; aw.x = qq[6].x; aw.y = qq[6].y; aw.z = qq[7].x; aw.w = qq[7].y; acc[3] = mfma16(__builtin_bit_cast(bf16x8, aw), bfrag, acc[3]); }
        }
        { v4u bw; bw.x = pk2(Sacc[4][0], Sacc[4][1]); bw.y = pk2(Sacc[4][2], Sacc[4][3]); bw.z = pk2(Sacc[5][0], Sacc[5][1]); bw.w = pk2(Sacc[5][2], Sacc[5][3]);
          const bf16x8 bfrag = __builtin_bit_cast(bf16x8, bw); v2u qq[8];
          asm volatile("ds_read_b64 %0, %8 offset:128 \n\tds_read_b64 %1, %8 offset:160 \n\tds_read_b64 %2, %8 offset:8576 \n\tds_read_b64 %3, %8 offset:8608 \n\tds_read_b64 %4, %8 offset:17024 \n\tds_read_b64 %5, %8 offset:17056 \n\tds_read_b64 %6, %8 offset:25472 \n\tds_read_b64 %7, %8 offset:25504 \n\ts_waitcnt lgkmcnt(0)" : "=&v"(qq[0]), "=&v"(qq[1]), "=&v"(qq[2]), "=&v"(qq[3]), "=&v"(qq[4]), "=&v"(qq[5]), "=&v"(qq[6]), "=&v"(qq[7]) : "v"(qbase) : "memory");
          { v4u aw; aw.x = qq[0].x; aw.y = qq[0].y; aw.z = qq[1].x; aw.w = qq[1].y; acc[0] = mfma16(__builtin_bit_cast(bf16x8, aw), bfrag, acc[0]); }
          { v4u aw; aw.x = qq[2].x; aw.y = qq[2].y; aw.z = qq[3].x; aw.w = qq[3].y; acc[1] = mfma16(__builtin_bit_cast(bf16x8, aw), bfrag, acc[1]); }
          { v4u aw; aw.x = qq[4].x; aw.y = qq[4].y; aw.z = qq[5].x; aw.w = qq[5].y; acc[2] = mfma16(__builtin_bit_cast(bf16x8, aw), bfrag, acc[2]); }
          { v4u aw; aw.x = qq[6].x; aw.y = qq[6].y; aw.z = qq[7].x; aw.w = qq[7].y; acc[3] = mfma16(__builtin_bit_cast(bf16x8, aw), bfrag, acc[3]); }
        }
        { v4u bw; bw.x = pk2(Sacc[6][0], Sacc[6][1]); bw.y = pk2(Sacc[6][2], Sacc[6][3]); bw.z = pk2(Sacc[7][0], Sacc[7][1]); bw.w = pk2(Sacc[7][2], Sacc[7][3]);
          const bf16x8 bfrag = __builtin_bit_cast(bf16x8, bw); v2u qq[8];
          asm volatile("ds_read_b64 %0, %8 offset:192 \n\tds_read_b64 %1, %8 offset:224 \n\tds_read_b64 %2, %8 offset:8640 \n\tds_read_b64 %3, %8 offset:8672 \n\tds_read_b64 %4, %8 offset:17088 \n\tds_read_b64 %5, %8 offset:17120 \n\tds_read_b64 %6, %8 offset:25536 \n\tds_read_b64 %7, %8 offset:25568 \n\ts_waitcnt lgkmcnt(0)" : "=&v"(qq[0]), "=&v"(qq[1]), "=&v"(qq[2]), "=&v"(qq[3]), "=&v"(qq[4]), "=&v"(qq[5]), "=&v"(qq[6]), "=&v"(qq[7]) : "v"(qbase) : "memory");
          { v4u aw; aw.x = qq[0].x; aw.y = qq[0].y; aw.z = qq[1].x; aw.w = qq[1].y; acc[0] = mfma16(__builtin_bit_cast(bf16x8, aw), bfrag, acc[0]); }
          { v4u aw; aw.x = qq[2].x; aw.y = qq[2].y; aw.z = qq[3].x; aw.w = qq[3].y; acc[1] = mfma16(__builtin_bit_cast(bf16x8, aw), bfrag, acc[1]); }
          { v4u aw; aw.x = qq[4].x; aw.y = qq[4].y; aw.z = qq[5].x; aw.w = qq[5].y; acc[2] = mfma16(__builtin_bit_cast(bf16x8, aw), bfrag, acc[2]); }
          { v4u aw; aw.x = qq[6].x; aw.y = qq[6].y; aw.z = qq[7].x; aw.w = qq[7].y; acc[3] = mfma16(__builtin_bit_cast(bf16x8, aw), bfrag, acc[3]); }
        }
        { v4u bw; bw.x = pk2(Sacc[8][0], Sacc[8][1]); bw.y = pk2(Sacc[8][2], Sacc[8][3]); bw.z = pk2(Sacc[9][0], Sacc[9][1]); bw.w = pk2(Sacc[9][2], Sacc[9][3]);
          const bf16x8 bfrag = __builtin_bit_cast(bf16x8, bw); v2u qq[8];
          asm volatile("ds_read_b64 %0, %8 offset:256 \n\tds_read_b64 %1, %8 offset:288 \n\tds_read_b64 %2, %8 offset:8704 \n\tds_read_b64 %3, %8 offset:8736 \n\tds_read_b64 %4, %8 offset:17152 \n\tds_read_b64 %5, %8 offset:17184 \n\tds_read_b64 %6, %8 offset:25600 \n\tds_read_b64 %7, %8 offset:25632 \n\ts_waitcnt lgkmcnt(0)" : "=&v"(qq[0]), "=&v"(qq[1]), "=&v"(qq[2]), "=&v"(qq[3]), "=&v"(qq[4]), "=&v"(qq[5]), "=&v"(qq[6]), "=&v"(qq[7]) : "v"(qbase) : "memory");
          { v4u aw; aw.x = qq[0].x; aw.y = qq[0].y; aw.z = qq[1].x; aw.w = qq[1].y; acc[0] = mfma16(__builtin_bit_cast(bf16x8, aw), bfrag, acc[0]); }
          { v4u aw; aw.x = qq[2].x; aw.y = qq[2].y; aw.z = qq[3].x; aw.w = qq[3].y; acc[1] = mfma16(__builtin_bit_cast(bf16x8, aw), bfrag, acc[1]); }
          { v4u aw; aw.x = qq[4].x; aw.y = qq[4].y; aw.z = qq[5].x; aw.w = qq[5].y; acc[2] = mfma16(__builtin_bit_cast(bf16x8, aw), bfrag, acc[2]); }
          { v4u aw; aw.x = qq[6].x; aw.y = qq[6].y; aw.z = qq[7].x; aw.w = qq[7].y; acc[3] = mfma16(__builtin_bit_cast(bf16x8, aw), bfrag, acc[3]); }
        }
        { v4u bw; bw.x = pk2(Sacc[10][0], Sacc[10][1]); bw.y = pk2(Sacc[10][2], Sacc[10][3]); bw.z = pk2(Sacc[11][0], Sacc[11][1]); bw.w = pk2(Sacc[11][2], Sacc[11][3]);
          const bf16x8 bfrag = __builtin_bit_cast(bf16x8, bw); v2u qq[8];
          asm volatile("ds_read_b64 %0, %8 offset:320 \n\tds_read_b64 %1, %8 offset:352 \n\tds_read_b64 %2, %8 offset:8768 \n\tds_read_b64 %3, %8 offset:8800 \n\tds_read_b64 %4, %8 offset:17216 \n\tds_read_b64 %5, %8 offset:17248 \n\tds_read_b64 %6, %8 offset:25664 \n\tds_read_b64 %7, %8 offset:25696 \n\ts_waitcnt lgkmcnt(0)" : "=&v"(qq[0]), "=&v"(qq[1]), "=&v"(qq[2]), "=&v"(qq[3]), "=&v"(qq[4]), "=&v"(qq[5]), "=&v"(qq[6]), "=&v"(qq[7]) : "v"(qbase) : "memory");
          { v4u aw; aw.x = qq[0].x; aw.y = qq[0].y; aw.z = qq[1].x; aw.w = qq[1].y; acc[0] = mfma16(__builtin_bit_cast(bf16x8, aw), bfrag, acc[0]); }
          { v4u aw; aw.x = qq[2].x; aw.y = qq[2].y; aw.z = qq[3].x; aw.w = qq[3].y; acc[1] = mfma16(__builtin_bit_cast(bf16x8, aw), bfrag, acc[1]); }
          { v4u aw; aw.x = qq[4].x; aw.y = qq[4].y; aw.z = qq[5].x; aw.w = qq[5].y; acc[2] = mfma16(__builtin_bit_cast(bf16x8, aw), bfrag, acc[2]); }
          { v4u aw; aw.x = qq[6].x; aw.y = qq[6].y; aw.z = qq[7].x; aw.w = qq[7].y; acc[3] = mfma16(__builtin_bit_cast(bf16x8, aw), bfrag, acc[3]); }
        }
        { v4u bw; bw.x = pk2(Sacc[12][0], Sacc[12][1]); bw.y = pk2(Sacc[12][2], Sacc[12][3]); bw.z = pk2(Sacc[13][0], Sacc[13][1]); bw.w = pk2(Sacc[13][2], Sacc[13][3]);
          const bf16x8 bfrag = __builtin_bit_cast(bf16x8, bw); v2u qq[8];
          asm volatile("ds_read_b64 %0, %8 offset:384 \n\tds_read_b64 %1, %8 offset:416 \n\tds_read_b64 %2, %8 offset:8832 \n\tds_read_b64 %3, %8 offset:8864 \n\tds_read_b64 %4, %8 offset:17280 \n\tds_read_b64 %5, %8 offset:17312 \n\tds_read_b64 %6, %8 offset:25728 \n\tds_read_b64 %7, %8 offset:25760 \n\ts_waitcnt lgkmcnt(0)" : "=&v"(qq[0]), "=&v"(qq[1]), "=&v"(qq[2]), "=&v"(qq[3]), "=&v"(qq[4]), "=&v"(qq[5]), "=&v"(qq[6]), "=&v"(qq[7]) : "v"(qbase) : "memory");
          { v4u aw; aw.x = qq[0].x; aw.y = qq[0].y; aw.z = qq[1].x; aw.w = qq[1].y; acc[0] = mfma16(__builtin_bit_cast(bf16x8, aw), bfrag, acc[0]); }
          { v4u aw; aw.x = qq[2].x; aw.y = qq[2].y; aw.z = qq[3].x; aw.w = qq[3].y; acc[1] = mfma16(__builtin_bit_cast(bf16x8, aw), bfrag, acc[1]); }
          { v4u aw; aw.x = qq[4].x; aw.y = qq[4].y; aw.z = qq[5].x; aw.w = qq[5].y; acc[2] = mfma16(__builtin_bit_cast(bf16x8, aw), bfrag, acc[2]); }
          { v4u aw; aw.x = qq[6].x; aw.y = qq[6].y; aw.z = qq[7].x; aw.w = qq[7].y; acc[3] = mfma16(__builtin_bit_cast(bf16x8, aw), bfrag, acc[3]); }
        }
        { v4u bw; bw.x = pk2(Sacc[14][0], Sacc[14][1]); bw.y = pk2(Sacc[14][2], Sacc[14][3]); bw.z = pk2(Sacc[15][0], Sacc[15][1]); bw.w = pk2(Sacc[15][2], Sacc[15][3]);
          const bf16x8 bfrag = __builtin_bit_cast(bf16x8, bw); v2u qq[8];
          asm volatile("ds_read_b64 %0, %8 offset:448 \n\tds_read_b64 %1, %8 offset:480 \n\tds_read_b64 %2, %8 offset:8896 \n\tds_read_b64 %3, %8 offset:8928 \n\tds_read_b64 %4, %8 offset:17344 \n\tds_read_b64 %5, %8 offset:17376 \n\tds_read_b64 %6, %8 offset:25792 \n\tds_read_b64 %7, %8 offset:25824 \n\ts_waitcnt lgkmcnt(0)" : "=&v"(qq[0]), "=&v"(qq[1]), "=&v"(qq[2]), "=&v"(qq[3]), "=&v"(qq[4]), "=&v"(qq[5]), "=&v"(qq[6]), "=&v"(qq[7]) : "v"(qbase) : "memory");
          { v4u aw; aw.x = qq[0].x; aw.y = qq[0].y; aw.z = qq[1].x; aw.w = qq[1].y; acc[0] = mfma16(__builtin_bit_cast(bf16x8, aw), bfrag, acc[0]); }
          { v4u aw; aw.x = qq[2].x; aw.y = qq[2].y; aw.z = qq[3].x; aw.w = qq[3].y; acc[1] = mfma16(__builtin_bit_cast(bf16x8, aw), bfrag, acc[1]); }
          { v4u aw; aw.x = qq[4].x; aw.y = qq[4].y; aw.z = qq[5].x; aw.w = qq[5].y; acc[2] = mfma16(__builtin_bit_cast(bf16x8, aw), bfrag, acc[2]); }
          { v4u aw; aw.x = qq[6].x; aw.y = qq[6].y; aw.z = qq[7].x; aw.w = qq[7].y; acc[3] = mfma16(__builtin_bit_cast(bf16x8, aw), bfrag, acc[3]); }
        }
#pragma unroll
        for (int mi = 0; mi < 4; ++mi)
#pragma unroll
            for (int g = 0; g < 4; ++g) acc[mi][g] *= __builtin_amdgcn_exp2f(lg * (float)(16 * mi + 4 * fq + g + 1));
        RTM(45);
        v2u vp[8];
        asm volatile("ds_read_b64_tr_b16 %0, %4 offset:0 \n\tds_read_b64_tr_b16 %1, %4 offset:1088 \n\tds_read_b64_tr_b16 %2, %4 offset:8704 \n\tds_read_b64_tr_b16 %3, %4 offset:9792 \n\ts_waitcnt lgkmcnt(0)" : "=&v"(vp[0]), "=&v"(vp[1]), "=&v"(vp[2]), "=&v"(vp[3]) : "v"(vbase) : "memory");
        asm volatile("ds_read_b64_tr_b16 %0, %4 offset:0 \n\tds_read_b64_tr_b16 %1, %4 offset:1088 \n\tds_read_b64_tr_b16 %2, %4 offset:8704 \n\tds_read_b64_tr_b16 %3, %4 offset:9792 \n\ts_waitcnt lgkmcnt(0)" : "=&v"(vp[4]), "=&v"(vp[5]), "=&v"(vp[6]), "=&v"(vp[7]) : "v"(vsbase) : "memory");
        bf16x8 vf[2], vs[2];
        { v4u t0; t0.x = vp[0].x; t0.y = vp[0].y; t0.z = vp[1].x; t0.w = vp[1].y; vf[0] = __builtin_bit_cast(bf16x8, t0); v4u t1; t1.x = vp[4].x; t1.y = vp[4].y; t1.z = vp[5].x; t1.w = vp[5].y; vs[0] = __builtin_bit_cast(bf16x8, t1); }
        { v4u t0; t0.x = vp[2].x; t0.y = vp[2].y; t0.z = vp[3].x; t0.w = vp[3].y; vf[1] = __builtin_bit_cast(bf16x8, t0); v4u t1; t1.x = vp[6].x; t1.y = vp[6].y; t1.z = vp[7].x; t1.w = vp[7].y; vs[1] = __builtin_bit_cast(bf16x8, t1); }
#pragma unroll
        for (int mi = 0; mi < 4; ++mi)
#pragma unroll
            for (int k2 = 0; k2 < 2; ++k2) { const bf16x8 a = *(const LAS bf16x8*)(lds + RT_SS + (16 * mi + fr) * RT_SS_STRIDE + (32 * k2 + 8 * fq) * 2); acc[mi] = mfma16(a, vf[k2], acc[mi]); }
        RTM(5);
        if (c > 0) {
            float sel = 0.f;
#pragma unroll
            for (int mi = 0; mi < 4; ++mi)
#pragma unroll
                for (int g = 0; g < 4; ++g) { const float v = acc[mi][g];
                    *(LAS unsigned short*)(lds + RT_OB + (16 * mi + 4 * fq + g) * RT_OB_STRIDE + (16 * w + fr) * 2) = (unsigned short)(pk2(v, 0.f) & 0xffffu);
                    const float sq = row16_sum(v * v);
                    sel = (fr == 4 * mi + g) ? sq : sel; }
            if (accum) { const int rj = b * SEQ + 64 * (c - 1) + 16 * (fr >> 2) + 4 * fq + (fr & 3); atomicAdd(ssqo + (size_t)rj * 16 + h, fx_from_pos(sel)); }
        }
        RTM(6);
#pragma unroll
        for (int dt = 0; dt < 16; ++dt) Sacc[dt] *= cdec;
        { v2u kp[16]; asm volatile("ds_read_b64_tr_b16 %0, %16 offset:0 \n\tds_read_b64_tr_b16 %1, %16 offset:2112 \n\tds_read_b64_tr_b16 %2, %16 offset:16896 \n\tds_read_b64_tr_b16 %3, %16 offset:19008 \n\tds_read_b64_tr_b16 %4, %16 offset:32 \n\tds_read_b64_tr_b16 %5, %16 offset:2144 \n\tds_read_b64_tr_b16 %6, %16 offset:16928 \n\tds_read_b64_tr_b16 %7, %16 offset:19040 \n\tds_read_b64_tr_b16 %8, %16 offset:64 \n\tds_read_b64_tr_b16 %9, %16 offset:2176 \n\tds_read_b64_tr_b16 %10, %16 offset:16960 \n\tds_read_b64_tr_b16 %11, %16 offset:19072 \n\tds_read_b64_tr_b16 %12, %16 offset:96 \n\tds_read_b64_tr_b16 %13, %16 offset:2208 \n\tds_read_b64_tr_b16 %14, %16 offset:16992 \n\tds_read_b64_tr_b16 %15, %16 offset:19104 \n\ts_waitcnt lgkmcnt(0)" : "=&v"(kp[0]), "=&v"(kp[1]), "=&v"(kp[2]), "=&v"(kp[3]), "=&v"(kp[4]), "=&v"(kp[5]), "=&v"(kp[6]), "=&v"(kp[7]), "=&v"(kp[8]), "=&v"(kp[9]), "=&v"(kp[10]), "=&v"(kp[11]), "=&v"(kp[12]), "=&v"(kp[13]), "=&v"(kp[14]), "=&v"(kp[15]) : "v"(kbase) : "memory");
          { v4u aw; aw.x = kp[0].x; aw.y = kp[0].y; aw.z = kp[1].x; aw.w = kp[1].y; Sacc[0] = mfma16(__builtin_bit_cast(bf16x8, aw), vs[0], Sacc[0]); }
          { v4u aw; aw.x = kp[2].x; aw.y = kp[2].y; aw.z = kp[3].x; aw.w = kp[3].y; Sacc[0] = mfma16(__builtin_bit_cast(bf16x8, aw), vs[1], Sacc[0]); }
          { v4u aw; aw.x = kp[4].x; aw.y = kp[4].y; aw.z = kp[5].x; aw.w = kp[5].y; Sacc[1] = mfma16(__builtin_bit_cast(bf16x8, aw), vs[0], Sacc[1]); }
          { v4u aw; aw.x = kp[6].x; aw.y = kp[6].y; aw.z = kp[7].x; aw.w = kp[7].y; Sacc[1] = mfma16(__builtin_bit_cast(bf16x8, aw), vs[1], Sacc[1]); }
          { v4u aw; aw.x = kp[8].x; aw.y = kp[8].y; aw.z = kp[9].x; aw.w = kp[9].y; Sacc[2] = mfma16(__builtin_bit_cast(bf16x8, aw), vs[0], Sacc[2]); }
          { v4u aw; aw.x = kp[10].x; aw.y = kp[10].y; aw.z = kp[11].x; aw.w = kp[11].y; Sacc[2] = mfma16(__builtin_bit_cast(bf16x8, aw), vs[1], Sacc[2]); }
          { v4u aw; aw.x = kp[12].x; aw.y = kp[12].y; aw.z = kp[13].x; aw.w = kp[13].y; Sacc[3] = mfma16(__builtin_bit_cast(bf16x8, aw), vs[0], Sacc[3]); }
          { v4u aw; aw.x = kp[14].x; aw.y = kp[14].y; aw.z = kp[15].x; aw.w = kp[15].y; Sacc[3] = mfma16(__builtin_bit_cast(bf16x8, aw), vs[1], Sacc[3]); }
        }
        { v2u kp[16]; asm volatile("ds_read_b64_tr_b16 %0, %16 offset:128 \n\tds_read_b64_tr_b16 %1, %16 offset:2240 \n\tds_read_b64_tr_b16 %2, %16 offset:17024 \n\tds_read_b64_tr_b16 %3, %16 offset:19136 \n\tds_read_b64_tr_b16 %4, %16 offset:160 \n\tds_read_b64_tr_b16 %5, %16 offset:2272 \n\tds_read_b64_tr_b16 %6, %16 offset:17056 \n\tds_read_b64_tr_b16 %7, %16 offset:19168 \n\tds_read_b64_tr_b16 %8, %16 offset:192 \n\tds_read_b64_tr_b16 %9, %16 offset:2304 \n\tds_read_b64_tr_b16 %10, %16 offset:17088 \n\tds_read_b64_tr_b16 %11, %16 offset:19200 \n\tds_read_b64_tr_b16 %12, %16 offset:224 \n\tds_read_b64_tr_b16 %13, %16 offset:2336 \n\tds_read_b64_tr_b16 %14, %16 offset:17120 \n\tds_read_b64_tr_b16 %15, %16 offset:19232 \n\ts_waitcnt lgkmcnt(0)" : "=&v"(kp[0]), "=&v"(kp[1]), "=&v"(kp[2]), "=&v"(kp[3]), "=&v"(kp[4]), "=&v"(kp[5]), "=&v"(kp[6]), "=&v"(kp[7]), "=&v"(kp[8]), "=&v"(kp[9]), "=&v"(kp[10]), "=&v"(kp[11]), "=&v"(kp[12]), "=&v"(kp[13]), "=&v"(kp[14]), "=&v"(kp[15]) : "v"(kbase) : "memory");
          { v4u aw; aw.x = kp[0].x; aw.y = kp[0].y; aw.z = kp[1].x; aw.w = kp[1].y; Sacc[4] = mfma16(__builtin_bit_cast(bf16x8, aw), vs[0], Sacc[4]); }
          { v4u aw; aw.x = kp[2].x; aw.y = kp[2].y; aw.z = kp[3].x; aw.w = kp[3].y; Sacc[4] = mfma16(__builtin_bit_cast(bf16x8, aw), vs[1], Sacc[4]); }
          { v4u aw; aw.x = kp[4].x; aw.y = kp[4].y; aw.z = kp[5].x; aw.w = kp[5].y; Sacc[5] = mfma16(__builtin_bit_cast(bf16x8, aw), vs[0], Sacc[5]); }
          { v4u aw; aw.x = kp[6].x; aw.y = kp[6].y; aw.z = kp[7].x; aw.w = kp[7].y; Sacc[5] = mfma16(__builtin_bit_cast(bf16x8, aw), vs[1], Sacc[5]); }
          { v4u aw; aw.x = kp[8].x; aw.y = kp[8].y; aw.z = kp[9].x; aw.w = kp[9].y; Sacc[6] = mfma16(__builtin_bit_cast(bf16x8, aw), vs[0], Sacc[6]); }
          { v4u aw; aw.x = kp[10].x; aw.y = kp[10].y; aw.z = kp[11].x; aw.w = kp[11].y; Sacc[6] = mfma16(__builtin_bit_cast(bf16x8, aw), vs[1], Sacc[6]); }
          { v4u aw; aw.x = kp[12].x; aw.y = kp[12].y; aw.z = kp[13].x; aw.w = kp[13].y; Sacc[7] = mfma16(__builtin_bit_cast(bf16x8, aw), vs[0], Sacc[7]); }
          { v4u aw; aw.x = kp[14].x; aw.y = kp[14].y; aw.z = kp[15].x; aw.w = kp[15].y; Sacc[7] = mfma16(__builtin_bit_cast(bf16x8, aw), vs[1], Sacc[7]); }
        }
        { v2u kp[16]; asm volatile("ds_read_b64_tr_b16 %0, %16 offset:256 \n\tds_read_b64_tr_b16 %1, %16 offset:2368 \n\tds_read_b64_tr_b16 %2, %16 offset:17152 \n\tds_read_b64_tr_b16 %3, %16 offset:19264 \n\tds_read_b64_tr_b16 %4, %16 offset:288 \n\tds_read_b64_tr_b16 %5, %16 offset:2400 \n\tds_read_b64_tr_b16 %6, %16 offset:17184 \n\tds_read_b64_tr_b16 %7, %16 offset:19296 \n\tds_read_b64_tr_b16 %8, %16 offset:320 \n\tds_read_b64_tr_b16 %9, %16 offset:2432 \n\tds_read_b64_tr_b16 %10, %16 offset:17216 \n\tds_read_b64_tr_b16 %11, %16 offset:19328 \n\tds_read_b64_tr_b16 %12, %16 offset:352 \n\tds_read_b64_tr_b16 %13, %16 offset:2464 \n\tds_read_b64_tr_b16 %14, %16 offset:17248 \n\tds_read_b64_tr_b16 %15, %16 offset:19360 \n\ts_waitcnt lgkmcnt(0)" : "=&v"(kp[0]), "=&v"(kp[1]), "=&v"(kp[2]), "=&v"(kp[3]), "=&v"(kp[4]), "=&v"(kp[5]), "=&v"(kp[6]), "=&v"(kp[7]), "=&v"(kp[8]), "=&v"(kp[9]), "=&v"(kp[10]), "=&v"(kp[11]), "=&v"(kp[12]), "=&v"(kp[13]), "=&v"(kp[14]), "=&v"(kp[15]) : "v"(kbase) : "memory");
          { v4u aw; aw.x = kp[0].x; aw.y = kp[0].y; aw.z = kp[1].x; aw.w = kp[1].y; Sacc[8] = mfma16(__builtin_bit_cast(bf16x8, aw), vs[0], Sacc[8]); }
          { v4u aw; aw.x = kp[2].x; aw.y = kp[2].y; aw.z = kp[3].x; aw.w = kp[3].y; Sacc[8] = mfma16(__builtin_bit_cast(bf16x8, aw), vs[1], Sacc[8]); }
          { v4u aw; aw.x = kp[4].x; aw.y = kp[4].y; aw.z = kp[5].x; aw.w = kp[5].y; Sacc[9] = mfma16(__builtin_bit_cast(bf16x8, aw), vs[0], Sacc[9]); }
          { v4u aw; aw.x = kp[6].x; aw.y = kp[6].y; aw.z = kp[7].x; aw.w = kp[7].y; Sacc[9] = mfma16(__builtin_bit_cast(bf16x8, aw), vs[1], Sacc[9]); }
          { v4u aw; aw.x = kp[8].x; aw.y = kp[8].y; aw.z = kp[9].x; aw.w = kp[9].y; Sacc[10] = mfma16(__builtin_bit_cast(bf16x8, aw), vs[0], Sacc[10]); }
          { v4u aw; aw.x = kp[10].x; aw.y = kp[10].y; aw.z = kp[11].x; aw.w = kp[11].y; Sacc[10] = mfma16(__builtin_bit_cast(bf16x8, aw), vs[1], Sacc[10]); }
          { v4u aw; aw.x = kp[12].x; aw.y = kp[12].y; aw.z = kp[13].x; aw.w = kp[13].y; Sacc[11] = mfma16(__builtin_bit_cast(bf16x8, aw), vs[0], Sacc[11]); }
          { v4u aw; aw.x = kp[14].x; aw.y = kp[14].y; aw.z = kp[15].x; aw.w = kp[15].y; Sacc[11] = mfma16(__builtin_bit_cast(bf16x8, aw), vs[1], Sacc[11]); }
        }
        { v2u kp[16]; asm volatile("ds_read_b64_tr_b16 %0, %16 offset:384 \n\tds_read_b64_tr_b16 %1, %16 offset:2496 \n\tds_read_b64_tr_b16 %2, %16 offset:17280 \n\tds_read_b64_tr_b16 %3, %16 offset:19392 \n\tds_read_b64_tr_b16 %4, %16 offset:416 \n\tds_read_b64_tr_b16 %5, %16 offset:2528 \n\tds_read_b64_tr_b16 %6, %16 offset:17312 \n\tds_read_b64_tr_b16 %7, %16 offset:19424 \n\tds_read_b64_tr_b16 %8, %16 offset:448 \n\tds_read_b64_tr_b16 %9, %16 offset:2560 \n\tds_read_b64_tr_b16 %10, %16 offset:17344 \n\tds_read_b64_tr_b16 %11, %16 offset:19456 \n\tds_read_b64_tr_b16 %12, %16 offset:480 \n\tds_read_b64_tr_b16 %13, %16 offset:2592 \n\tds_read_b64_tr_b16 %14, %16 offset:17376 \n\tds_read_b64_tr_b16 %15, %16 offset:19488 \n\ts_waitcnt lgkmcnt(0)" : "=&v"(kp[0]), "=&v"(kp[1]), "=&v"(kp[2]), "=&v"(kp[3]), "=&v"(kp[4]), "=&v"(kp[5]), "=&v"(kp[6]), "=&v"(kp[7]), "=&v"(kp[8]), "=&v"(kp[9]), "=&v"(kp[10]), "=&v"(kp[11]), "=&v"(kp[12]), "=&v"(kp[13]), "=&v"(kp[14]), "=&v"(kp[15]) : "v"(kbase) : "memory");
          { v4u aw; aw.x = kp[0].x; aw.y = kp[0].y; aw.z = kp[1].x; aw.w = kp[1].y; Sacc[12] = mfma16(__builtin_bit_cast(bf16x8, aw), vs[0], Sacc[12]); }
          { v4u aw; aw.x = kp[2].x; aw.y = kp[2].y; aw.z = kp[3].x; aw.w = kp[3].y; Sacc[12] = mfma16(__builtin_bit_cast(bf16x8, aw), vs[1], Sacc[12]); }
          { v4u aw; aw.x = kp[4].x; aw.y = kp[4].y; aw.z = kp[5].x; aw.w = kp[5].y; Sacc[13] = mfma16(__builtin_bit_cast(bf16x8, aw), vs[0], Sacc[13]); }
          { v4u aw; aw.x = kp[6].x; aw.y = kp[6].y; aw.z = kp[7].x; aw.w = kp[7].y; Sacc[13] = mfma16(__builtin_bit_cast(bf16x8, aw), vs[1], Sacc[13]); }
          { v4u aw; aw.x = kp[8].x; aw.y = kp[8].y; aw.z = kp[9].x; aw.w = kp[9].y; Sacc[14] = mfma16(__builtin_bit_cast(bf16x8, aw), vs[0], Sacc[14]); }
          { v4u aw; aw.x = kp[10].x; aw.y = kp[10].y; aw.z = kp[11].x; aw.w = kp[11].y; Sacc[14] = mfma16(__builtin_bit_cast(bf16x8, aw), vs[1], Sacc[14]); }
          { v4u aw; aw.x = kp[12].x; aw.y = kp[12].y; aw.z = kp[13].x; aw.w = kp[13].y; Sacc[15] = mfma16(__builtin_bit_cast(bf16x8, aw), vs[0], Sacc[15]); }
          { v4u aw; aw.x = kp[14].x; aw.y = kp[14].y; aw.z = kp[15].x; aw.w = kp[15].y; Sacc[15] = mfma16(__builtin_bit_cast(bf16x8, aw), vs[1], Sacc[15]); }
        }
        RTM(7);
    }
#undef RT_BAR
#undef RT_PREFETCH
#ifdef PROBE_ATT_A
    if (w == 0 && lane == 0 && blockIdx.x == 0) { const unsigned long long a_ = (((unsigned long long)F.MISC[23] << 32) | F.MISC[22]) + rtm_acc; F.MISC[22] = (unsigned)a_; F.MISC[23] = (unsigned)(a_ >> 32); }
#endif
#undef RTM
    __syncthreads();
    RT_FLUSH(64);
#undef RT_FLUSH
    __syncthreads();
}
__device__ __forceinline__ void p7_retention(Frame& F, const Args& A, bool accum) {
    for (int item = blockIdx.x; item < NB * RET_H * 4; item += F.G) ret_item(F, A, item >> 6, (item >> 2) & 15, item & 3, accum);
}
__device__ __forceinline__ void p8_gate(Frame& F, const Args& A, bool probe = false) {
    const bf16* z1 = (const bf16*)(F.ws + WS_Z); bf16* ob = (bf16*)(F.ws + WS_Y1); const u64* ssqo = (const u64*)(F.ws + WS_SSQO); const float* gain = A.in[17];
    const int gt = blockIdx.x * NTHREADS + F.tid, nthr = F.G * NTHREADS;
    const int c = (gt & 1023) * 8, hd = c >> 9, rstep = nthr >> 10, r0 = (gt >> 10) < rstep ? (gt >> 10) : MTOK;
    const f32x4 g0 = *(const GAS f32x4*)(gain + c), g1 = *(const GAS f32x4*)(gain + c + 4);
    for (int r = r0; r < MTOK; r += 4 * rstep) {
        v4u gw[4], ow[4]; float ss[4];
#pragma unroll
        for (int k = 0; k < 4; ++k) { const int rr = r + k * rstep; if (rr < MTOK) { gw[k] = *(const GAS v4u*)(z1 + (size_t)rr * RET_IN + 16384 + c); ow[k] = *(const GAS v4u*)(ob + (size_t)rr * RET_VW + c); ss[k] = fx_to_pos(ssqo[(size_t)rr * 16 + hd]); } }
#pragma unroll
        for (int k = 0; k < 4; ++k) { const int rr = r + k * rstep; if (rr < MTOK) {
            const float rs = __builtin_amdgcn_rsqf(ss[k] * (1.0f / 512.0f) + RMS_EPS);
            float gf[8], of[8], y[8]; unpack8(gw[k], gf); unpack8(ow[k], of);
#pragma unroll
            for (int e = 0; e < 8; ++e) { const float gn = e < 4 ? g0[e] : g1[e - 4]; y[e] = gf[e] * sigmoidf_fast(gf[e]) * (of[e] * rs * gn); }
            bf16* dst = probe ? (bf16*)(F.ws + WS_XB) + (size_t)(rr & (MTOK / 2 - 1)) * RET_VW + c : ob + (size_t)rr * RET_VW + c;
            *(GAS v4u*)dst = pack8f(y); } }
    }
}


__device__ __forceinline__ void meta_fixup(Frame& F, const u64* Hmeta, bf16* XB, u64* ssq) {
    __syncthreads();
    if (F.MISC[4] != 0u) {
        __builtin_amdgcn_fence(__ATOMIC_ACQUIRE, "agent"); asm volatile("s_waitcnt vmcnt(0)" ::: "memory");
        for (int row = F.wave; row < NB * NMETA; row += NWAVES) { const u64* hrow = Hmeta + (size_t)row * DM; bf16* xrow = XB + (size_t)(MTOK + row) * DM; float s = 0.f;
#pragma unroll 4
            for (int j = 0; j < 16; ++j) { const int e = (F.lane + 64 * j) * 4; const f32x4 v = {fx_to(hrow[e]), fx_to(hrow[e + 1]), fx_to(hrow[e + 2]), fx_to(hrow[e + 3])};
                s += (v.x * v.x + v.y * v.y) + (v.z * v.z + v.w * v.w); v2u w; w.x = pk2(v.x, v.y); w.y = pk2(v.z, v.w); *(GAS v2u*)(xrow + e) = w; }
            s = wave_sum(s);
            if (F.lane == 0) ssq[MTOK + row] = fx_from_pos(s); }
        __syncthreads();
        if (F.tid == 0) F.MISC[4] = 0u;
    }
    __syncthreads();
}


__device__ __forceinline__ void phase_stagger(int us) {
    if (us <= 0) return;
    const unsigned long long t0 = __builtin_amdgcn_s_memrealtime(), ticks = (unsigned long long)(((blockIdx.x >> 3) & 3) * us * 100);
    while (__builtin_amdgcn_s_memrealtime() - t0 < ticks) __builtin_amdgcn_s_sleep(16);
}

__global__ void __launch_bounds__(NTHREADS, 2) hybrid_fwd(Args args) {
    extern __shared__ __attribute__((aligned(16))) unsigned char lds_raw[];
    Frame F;
    F.lds = (LAS unsigned char*)lds_raw;
    F.MISC = (volatile LAS unsigned*)(F.lds + MISC_OFF);
    F.tid = threadIdx.x; F.lane = F.tid & 63; F.wave = __builtin_amdgcn_readfirstlane(F.tid >> 6);
    F.G = gridDim.x; F.ws = args.ws;
    if (F.tid < 64) F.MISC[F.tid] = 0u;
    __syncthreads();
    unsigned* ctl = (unsigned*)(F.ws + WS_CTL);
#if !MK_PER_PHASE
    const XcdBarrier bar = xcd_barrier_post(ctl + CW_BAR, F.MISC + 8, F.wave);
#define GRID_BAR() xcd_barrier(bar)
#else
#define GRID_BAR() do { } while (0)
#endif
    const int lo = args.ph_lo, hi = args.ph_hi;
#ifndef PHASE_MASK
#define PHASE_MASK 0xFFF
#endif
#define IN(k) ((((PHASE_MASK) >> (k)) & 1) && lo <= (k) && (k) < hi)
#define BOTH(k) (IN(k) && IN((k) + 1))
#ifndef STAGGER_US
#define STAGGER_US 0
#endif
#ifndef REPEAT_MASK
#define REPEAT_MASK 0
#endif
#define RETID() do { const int ln_ = hw_lane(); F.lane = ln_; F.tid = F.wave * 64 + ln_; } while (0)
#define REPS(k) (1 + (((REPEAT_MASK) >> (k)) & 1))
    unsigned char* ws = F.ws;
    bf16* XB = (bf16*)(ws + WS_XB); u64* Hmeta = (u64*)(ws + WS_HMETA); bf16* Z = (bf16*)(ws + WS_Z); bf16* Y0 = (bf16*)(ws + WS_Y0); bf16* Y1 = (bf16*)(ws + WS_Y1);
    u64* SSQ0 = (u64*)(ws + WS_SSQ0); u64* SSQ1 = (u64*)(ws + WS_SSQ1); u64* SSQ2 = (u64*)(ws + WS_SSQ2); u64* SSQ3 = (u64*)(ws + WS_SSQ3);
    const int c = (int)blockIdx.x;
#ifdef PROBE_TSUM_MASK
    if (F.tid == 0) { const unsigned long long t_ = __builtin_amdgcn_s_memrealtime(); F.MISC[20] = (unsigned)t_; F.MISC[21] = (unsigned)(t_ >> 32); F.MISC[22] = 0u; F.MISC[23] = 0u; }
#define PT(k) do { if (F.wave == 0 && hw_lane() == 0) { const unsigned long long now_ = __builtin_amdgcn_s_memrealtime(), prev_ = ((unsigned long long)F.MISC[21] << 32) | F.MISC[20]; \
        if (((PROBE_TSUM_MASK) >> (k)) & 1) { const unsigned long long a_ = (((unsigned long long)F.MISC[23] << 32) | F.MISC[22]) + (now_ - prev_); F.MISC[22] = (unsigned)a_; F.MISC[23] = (unsigned)(a_ >> 32); } \
        F.MISC[20] = (unsigned)now_; F.MISC[21] = (unsigned)(now_ >> 32); } } while (0)
#else
#define PT(k) do { } while (0)
#endif

    if (IN(0)) { RETID(); p0_prologue(F, args); if (REPS(0) > 1) p0_prologue(F, args); if (BOTH(0)) GRID_BAR(); PT(0); }
#ifdef PROBE_EXTRA_BARRIERS
    for (int k = 0; k < PROBE_EXTRA_BARRIERS; ++k) GRID_BAR();
#endif
    if (IN(1)) { RETID();
        pg8::Gemm g{XB, (const bf16*)(ws + WS_WIN0), MP, 41 * 256, DM}; pg8::StaticOrder S; S.init(MP, 41 * 256, DM, F.G, c);
        pg8::EpiIn0 E{Z, (float*)(ws + WS_FBUF), SSQ0};
        pg8::gemm_phase<pg8::EpiIn0, pg8::StaticOrder, true, true>(F.lds, g, S, E, F.wave); if (REPS(1) > 1) { pg8::gemm_phase<pg8::EpiIn0, pg8::StaticOrder, true, true>(F.lds, g, S, E, F.wave); }
        tail_conv(F, args, CW_TL1, TL1_LO, TL1_N);
        if (BOTH(1)) GRID_BAR(); PT(1);
    }
    if (IN(2)) { RETID(); p2_mixer0(F, args, 0); if (REPS(2) > 1) { GRID_BAR(); p2_mixer0(F, args, 1); } if (BOTH(2)) GRID_BAR(); PT(2); }
    if (IN(3)) { RETID();
        pg8::Gemm g{Y0, (const bf16*)(ws + WS_WOUT0), MP, DM, DM}; pg8::SplitMetaOrder S; S.init2(DM, DM, F.G, c, ctl + CW_TK3, F.MISC + 4);
        pg8::EpiResX E{args.in[0], Hmeta, XB, SSQ1, DM / 64};
        phase_stagger(STAGGER_US);
        pg8::gemm_phase<pg8::EpiResX, pg8::SplitMetaOrder, true, true>(F.lds, g, S, E, F.wave);
        meta_fixup(F, Hmeta, XB, SSQ1);
        if (REPS(3) > 1) { pg8::EpiNone EN; pg8::StaticOrder S2; S2.init(MP, DM, DM, F.G, c); pg8::gemm_phase<pg8::EpiNone, pg8::StaticOrder, true, true>(F.lds, g, S2, EN, F.wave); }
        if (BOTH(3)) GRID_BAR(); PT(3);
    }
    if (IN(4)) { RETID();
        pg8::Gemm g{XB, (const bf16*)(ws + WS_WGU0), MP, 2 * DFF, DM}; pg8::StaticOrder S; S.init(MP, 2 * DFF, DM, F.G, c);
        pg8::EpiGU E{Z, SSQ1};
#ifdef PROBE_CLOCK
        const unsigned long long ck_t0 = __builtin_amdgcn_s_memtime(), ck_r0 = __builtin_amdgcn_s_memrealtime();
#endif
        pg8::gemm_phase<pg8::EpiGU, pg8::StaticOrder, true, true>(F.lds, g, S, E, F.wave);
#ifdef PROBE_CLOCK
        { const unsigned long long ck_t1 = __builtin_amdgcn_s_memtime(), ck_r1 = __builtin_amdgcn_s_memrealtime();
          if (F.tid == 0) F.MISC[16] = (unsigned)(((ck_t1 - ck_t0) * 100ull) / (ck_r1 - ck_r0 + 1ull)); }
#endif
#ifndef PROBE_P4_MODE
#define PROBE_P4_MODE 1
#endif
        if (REPS(4) > 1) {
            if (PROBE_P4_MODE == 1) { pg8::gemm_phase<pg8::EpiGU, pg8::StaticOrder, true, true>(F.lds, g, S, E, F.wave); }
            else if (PROBE_P4_MODE == 2) { pg8::EpiNone EN; pg8::gemm_phase<pg8::EpiNone, pg8::StaticOrder, true, true>(F.lds, g, S, EN, F.wave); }
            else { pg8::EpiNone EN; pg8::HotOrder HS; HS.init(MP, 2 * DFF, DM, F.G, c); pg8::gemm_phase<pg8::EpiNone, pg8::HotOrder, true, true>(F.lds, g, HS, EN, F.wave); }
        }
        tail_conv(F, args, CW_TL4, TL4_LO, TL4_N);
        if (BOTH(4)) GRID_BAR(); PT(4);
    }
    if (IN(5)) { RETID();
        pg8::Gemm g{Z, (const bf16*)(ws + WS_WD0), MP, DM, DFF}; pg8::SplitMetaOrder S; S.init2(DM, DFF, F.G, c, ctl + CW_TK5, F.MISC + 4);
        pg8::EpiRes E{nullptr, Hmeta, XB, SSQ2, DFF / 64};
        phase_stagger(STAGGER_US);
        pg8::gemm_phase<pg8::EpiRes, pg8::SplitMetaOrder, true, true>(F.lds, g, S, E, F.wave);
        meta_fixup(F, Hmeta, XB, SSQ2);
        if (REPS(5) > 1) { pg8::StaticOrder S2; S2.init(MTOK, DM, DFF, F.G, c); pg8::EpiNone EN; pg8::gemm_phase<pg8::EpiNone, pg8::StaticOrder, true, true>(F.lds, g, S2, EN, F.wave); }
        if (BOTH(5)) GRID_BAR(); PT(5);
    }
    if (IN(6)) { RETID();
        pg8::Gemm g{XB, (const bf16*)(ws + WS_WIN1), MP, RET_IN, DM}; pg8::StaticOrder S; S.init(MP, RET_IN, DM, F.G, c);
        pg8::EpiIn1 E{Z, SSQ2};
        pg8::gemm_phase<pg8::EpiIn1, pg8::StaticOrder, true, true>(F.lds, g, S, E, F.wave); if (REPS(6) > 1) { pg8::gemm_phase<pg8::EpiIn1, pg8::StaticOrder, true, true>(F.lds, g, S, E, F.wave); }
        tail_conv(F, args, CW_TL6, TL6_LO, TL6_N);
        if (BOTH(6)) GRID_BAR(); PT(6);
    }
    if (IN(7)) { RETID(); p7_retention(F, args, true); if (REPS(7) > 1) p7_retention(F, args, false); if (BOTH(7)) GRID_BAR(); PT(7); }
    if (IN(8)) { RETID(); p8_gate(F, args); if (REPS(8) > 1) p8_gate(F, args, true); if (BOTH(8)) GRID_BAR(); PT(8); }
    if (IN(9)) { RETID();
        pg8::Gemm g{Y1, (const bf16*)(ws + WS_WOUT1), MTOK, DM, RET_VW}; pg8::StaticOrder S; S.init(MTOK, DM, RET_VW, F.G, c);
        pg8::EpiRes E{nullptr, Hmeta, XB, SSQ3, RET_VW / 64};
        phase_stagger(STAGGER_US);
        pg8::gemm_phase<pg8::EpiRes, pg8::StaticOrder, true, true>(F.lds, g, S, E, F.wave);
        if (REPS(9) > 1) { pg8::EpiNone EN; pg8::gemm_phase<pg8::EpiNone, pg8::StaticOrder, true, true>(F.lds, g, S, EN, F.wave); }
        if (BOTH(9)) GRID_BAR(); PT(9);
    }
    if (IN(10)) { RETID();
        pg8::Gemm g{XB, (const bf16*)(ws + WS_WGU1), MTOK, 2 * DFF, DM}; pg8::StaticOrder S; S.init(MTOK, 2 * DFF, DM, F.G, c);
        pg8::EpiGU E{Z, SSQ3};
        pg8::gemm_phase<pg8::EpiGU, pg8::StaticOrder, true, true>(F.lds, g, S, E, F.wave); if (REPS(10) > 1) { pg8::gemm_phase<pg8::EpiGU, pg8::StaticOrder, true, true>(F.lds, g, S, E, F.wave); }
        tail_conv(F, args, CW_TL10, TL10_LO, TL10_N);
        if (BOTH(10)) GRID_BAR(); PT(10);
    }
    if (IN(11)) { RETID();
        pg8::Gemm g{Z, (const bf16*)(ws + WS_WD1), MTOK, DM, DFF}; pg8::StaticOrder S; S.init(MTOK, DM, DFF, F.G, c);
        pg8::EpiFinal E{XB, args.out};
        phase_stagger(STAGGER_US);
        pg8::gemm_phase<pg8::EpiFinal, pg8::StaticOrder, true, true>(F.lds, g, S, E, F.wave);
        if (REPS(11) > 1) { pg8::EpiNone EN; pg8::gemm_phase<pg8::EpiNone, pg8::StaticOrder, true, true>(F.lds, g, S, EN, F.wave); }
        PT(11);
    }
#ifdef PROBE_CLOCK
    if (blockIdx.x == 0 && F.tid == 0) { const unsigned long long r0 = __builtin_amdgcn_s_memrealtime(), ticks = (unsigned long long)F.MISC[16] * 100ull;
        while (__builtin_amdgcn_s_memrealtime() - r0 < ticks) __builtin_amdgcn_s_sleep(32); }
#endif
#ifdef PROBE_TSUM_MASK
    if (blockIdx.x == 0 && F.wave == 0 && hw_lane() == 0) { const unsigned long long r0 = __builtin_amdgcn_s_memrealtime(), ticks = ((((unsigned long long)F.MISC[23] << 32) | F.MISC[22])) * (unsigned long long)(PROBE_TSUM_MULT);
        while (__builtin_amdgcn_s_memrealtime() - r0 < ticks) __builtin_amdgcn_s_sleep(32); }
#endif
#undef IN
#undef BOTH
}

extern "C" void kernel_launch(void* const* d_in, const int* in_sizes, int n_in, void* d_out, int out_size, void* d_ws, size_t ws_size, hipStream_t stream) {
    static int grid = 0;
    if (grid == 0) {
        if (n_in != 23 || in_sizes[0] != MTOK * DM || out_size != MTOK * DM || ws_size < WS_END) { fprintf(stderr, "kernel_launch: unexpected shapes (n_in %d, in0 %d, out %d, ws %zu < %zu); nothing launched\n", n_in, n_in > 0 ? in_sizes[0] : -1, out_size, ws_size, (size_t)WS_END); grid = -1; return; }
        int dev = 0, cus = 0, per_cu = 0;
        if (hipGetDevice(&dev) != hipSuccess || hipDeviceGetAttribute(&cus, hipDeviceAttributeMultiprocessorCount, dev) != hipSuccess) { fprintf(stderr, "kernel_launch: device query failed\n"); grid = -1; return; }
        if (hipFuncSetAttribute((const void*)hybrid_fwd, hipFuncAttributeMaxDynamicSharedMemorySize, LDS_BYTES) != hipSuccess) { fprintf(stderr, "kernel_launch: hipFuncSetAttribute failed\n"); grid = -1; return; }
        if (hipOccupancyMaxActiveBlocksPerMultiprocessor(&per_cu, (const void*)hybrid_fwd, NTHREADS, LDS_BYTES) != hipSuccess || per_cu < 1) { fprintf(stderr, "kernel_launch: occupancy query reports %d workgroups per CU\n", per_cu); }
        (void)hipGetLastError();
        grid = cus;
    }
    if (grid < 0) return;
    if (hipMemsetAsync((char*)d_ws + WS_CTL, 0, CTL_ZERO_BYTES, stream) != hipSuccess) { fprintf(stderr, "kernel_launch: memset failed\n"); return; }
    Args a{};
    for (int i = 0; i < 23; ++i) a.in[i] = (const float*)d_in[i];
    a.out = (float*)d_out; a.ws = (unsigned char*)d_ws;
#if MK_PER_PHASE
    for (int p = 0; p < NPHASES; ++p) { a.ph_lo = p; a.ph_hi = p + 1; hipLaunchKernelGGL(hybrid_fwd, dim3(grid), dim3(NTHREADS), LDS_BYTES, stream, a); }
#else
    a.ph_lo = 0; a.ph_hi = NPHASES;
    hipLaunchKernelGGL(hybrid_fwd, dim3(grid), dim3(NTHREADS), LDS_BYTES, stream, a);
#endif
    const hipError_t le = hipPeekAtLastError();
    if (le != hipSuccess) fprintf(stderr, "kernel_launch: launch failed: %s\n", hipGetErrorName(le));
}
```

```cpp
#include <hip/hip_runtime.h>
#include <cstdio>
#include <cstdint>
#ifndef MK_PER_PHASE
#define MK_PER_PHASE 0
#endif
constexpr int DM = 4096, NB = 4, SEQ = 4096, NMETA = 16, LSEQ = NMETA + SEQ;
constexpr int MTOK = NB * SEQ;
constexpr int MMETA = MTOK;
constexpr int MP = 65 * 256;
constexpr int LRU_W = 2048, FOX_H = 16, FOX_D = 128, AB_IN = 10256, AB_Z = 10240;
constexpr int RET_H = 16, RET_QK = 256, RET_V = 512, RET_IN = 24576, RET_VW = 8192;
constexpr int DFF = 11008;
constexpr float RMS_EPS = 1e-6f;
typedef unsigned long long u64;
__device__ __forceinline__ u64 fx_from_pos(float s) { const float fl = floorf(s); return ((u64)(unsigned)fl << 32) | (u64)(unsigned)((s - fl) * 4294967296.0f); }
__device__ __forceinline__ float fx_to_pos(u64 x) { return (float)(unsigned)(x >> 32) + (float)(unsigned)x * (1.0f / 4294967296.0f); }
__device__ __forceinline__ u64 fx_from(float v) { return (u64)(long long)(v * 4294967296.0f); }
__device__ __forceinline__ float fx_to(u64 x) { return (float)(long long)x * (1.0f / 4294967296.0f); }
__device__ __forceinline__ int hw_lane() { int l; asm volatile("v_mbcnt_lo_u32_b32 %0, -1, 0\n\tv_mbcnt_hi_u32_b32 %0, -1, %0" : "=v"(l)); return l; }
template <int CTRL> __device__ __forceinline__ float dpp_mov(float x) { return __builtin_bit_cast(float, __builtin_amdgcn_update_dpp(0, __builtin_bit_cast(int, x), CTRL, 0xF, 0xF, true)); }
__device__ __forceinline__ float row16_sum(float x) { x += dpp_mov<0x128>(x); x += dpp_mov<0x124>(x); x += dpp_mov<0x122>(x); x += dpp_mov<0x121>(x); return x; }
__device__ __forceinline__ float oct_sum(float x) { x += dpp_mov<0xB1>(x); x += dpp_mov<0x4E>(x); x += dpp_mov<0x141>(x); return x; }
__device__ __forceinline__ float sum_x16(float x) { auto r = __builtin_amdgcn_permlane16_swap(__float_as_uint(x), __float_as_uint(x), false, false); return __uint_as_float(r[0]) + __uint_as_float(r[1]); }
__device__ __forceinline__ float sum_x32(float x) { auto r = __builtin_amdgcn_permlane32_swap(__float_as_uint(x), __float_as_uint(x), false, false); return __uint_as_float(r[0]) + __uint_as_float(r[1]); }
__device__ __forceinline__ float max_x16(float x) { auto r = __builtin_amdgcn_permlane16_swap(__float_as_uint(x), __float_as_uint(x), false, false); return fmaxf(__uint_as_float(r[0]), __uint_as_float(r[1])); }
__device__ __forceinline__ float max_x32(float x) { auto r = __builtin_amdgcn_permlane32_swap(__float_as_uint(x), __float_as_uint(x), false, false); return fmaxf(__uint_as_float(r[0]), __uint_as_float(r[1])); }

namespace pg8 {
#define PG8_LAS __attribute__((address_space(3)))
typedef unsigned short bf16_t;
typedef short bf16x8 __attribute__((ext_vector_type(8)));
typedef float f32x4 __attribute__((ext_vector_type(4)));
typedef unsigned u32x4 __attribute__((ext_vector_type(4)));
constexpr int BM = 256, BK = 64, HALF = 128, HTB = HALF * BK * 2  , STAGE_BYTES = 8 * HTB, NXCD = 8, WGM = 4;

__host__ __device__ __forceinline__ int lds_byte(int r, int c) { const int st = (r >> 4) * 2 + (c >> 5), rr = r & 15, cc = c & 31, ob = rr * 64 + cc * 2; return st * 1024 + (ob ^ (((ob >> 9) & 1) << 5)); }
__host__ __device__ __forceinline__ void stage_rc(int b, int& R, int& C) { const int st = b / 1024, sb = b % 1024, swz = sb ^ (((sb >> 9) & 1) << 5); R = (st >> 1) * 16 + swz / 64; C = (st & 1) * 32 + (swz % 64) / 2; }
__host__ __device__ __forceinline__ int perm32(int rho) { const int n = rho >> 4, i = rho & 15; return 8 * (i >> 2) + 4 * n + (i & 3); }

struct Unit { int pm, pn, kb, kn; };
struct Gemm { const bf16_t* A; const bf16_t* Bt; int M, N, K; };

struct StaticOrder {
    int nM, nN, nwg, G, c, ntk;
    __host__ __device__ void init(int M, int N, int K, int G_, int c_) { nM = M / BM; nN = N / BM; nwg = nM * nN; G = G_; c = c_; ntk = K / BK; }
    __host__ __device__ bool next(int i, Unit& u) const {
        const long L = (long)i * G + c; if (L >= nwg) return false;
        int wgid = (int)L; { const int q = nwg / NXCD, r = nwg % NXCD, xcd = wgid % NXCD, off = wgid / NXCD; wgid = (xcd < r ? xcd * (q + 1) : r * (q + 1) + (xcd - r) * q) + off; }
        const int nig = WGM * nN, gid = wgid / nig, fm = gid * WGM, gsz = (nM - fm) < WGM ? (nM - fm) : WGM;
        u.pm = fm + ((wgid % nig) % gsz); u.pn = (wgid % nig) / gsz; u.kb = 0; u.kn = ntk; return true;
    }
    __device__ __forceinline__ void a_ready(const Unit&) const {}
    __device__ __forceinline__ void done(const Unit&) const {}
};

struct SplitMetaOrder : StaticOrder {
    int nreg, nsplit; unsigned* ticket; volatile PG8_LAS unsigned* flag;
    __device__ void init2(int N, int K, int G_, int c_, unsigned* ticket_, volatile PG8_LAS unsigned* flag_) { init(64 * BM, N, K, G_, c_); nreg = nwg; nsplit = 16; ticket = ticket_; flag = flag_; }
    __device__ bool next(int i, Unit& u) const {
        const long L = (long)i * G + c;
        if (L < nreg) return StaticOrder::next(i, u);
        const int x = (int)(L - nreg); if (x >= nsplit * nN) return false;
        const int s = x % nsplit; u.pm = 64; u.pn = x / nsplit;
        const int base = (ntk / 2) / nsplit, rem = (ntk / 2) % nsplit;
        u.kb = 2 * (s * base + (s < rem ? s : rem)); u.kn = 2 * (base + (s < rem ? 1 : 0)); return true;
    }
    __device__ __forceinline__ void a_ready(const Unit&) const {}
    __device__ __forceinline__ void done(const Unit& u) const {
        if (u.pm == 64) { asm volatile("s_waitcnt vmcnt(0)" ::: "memory");
            if (hw_lane() == 0) { const unsigned old = __hip_atomic_fetch_add(ticket, 1u, __ATOMIC_RELAXED, __HIP_MEMORY_SCOPE_AGENT); if (old + 1u == (unsigned)(nsplit * nN * 8)) flag[0] = 1u; } }
    }
};
__device__ __forceinline__ unsigned cvt_pk_bf16(float lo, float hi) { unsigned r; asm volatile("v_cvt_pk_bf16_f32 %0, %1, %2" : "=v"(r) : "v"(lo), "v"(hi)); return r; }
__device__ __forceinline__ u32x4 pack8(const f32x4 a, const f32x4 b) { u32x4 w; w.x = cvt_pk_bf16(a[0], a[1]); w.y = cvt_pk_bf16(a[2], a[3]); w.z = cvt_pk_bf16(b[0], b[1]); w.w = cvt_pk_bf16(b[2], b[3]); return w; }
__device__ __forceinline__ float row_rstd(const u64* ssq, int r) { return __builtin_amdgcn_rsqf(fx_to_pos(ssq[r]) * (1.0f / 4096.0f) + RMS_EPS); }

struct EpiIn0 {
    static constexpr bool PERM = true, AFTER_DRAIN = false;
    bf16_t* Z; float* F; const u64* ssq;
    __device__ __forceinline__ void operator()(const f32x4 (&acc)[2][2][4][2], const Unit& u, int wr, int wc, int fr, int fq) const {
        const int row0 = u.pm * BM + wr * 64 + fr;
        if (u.pn < 40) {
            const int col0 = u.pn * BM + wc * 32 + 8 * fq;
#pragma unroll
            for (int ai = 0; ai < 2; ++ai)
#pragma unroll
                for (int m = 0; m < 4; ++m) { const int r = row0 + ai * HALF + m * 16; const float rs = row_rstd(ssq, r); bf16_t* rowp = Z + (size_t)r * AB_Z + col0;
#pragma unroll
                    for (int bj = 0; bj < 2; ++bj) *(u32x4*)(rowp + bj * HALF) = pack8(acc[ai][bj][m][0] * rs, acc[ai][bj][m][1] * rs); }
        } else if (wc == 0 && fq < 2) {
#pragma unroll
            for (int ai = 0; ai < 2; ++ai)
#pragma unroll
                for (int m = 0; m < 4; ++m) { const int r = row0 + ai * HALF + m * 16; const float rs = row_rstd(ssq, r); float* fp = F + (size_t)r * 16 + 8 * fq;
                    *(f32x4*)(fp) = acc[ai][0][m][0] * rs; *(f32x4*)(fp + 4) = acc[ai][0][m][1] * rs; }
        }
    }
};
template <bool F32IN>
struct EpiResT {
    static constexpr bool PERM = true, AFTER_DRAIN = false;
    const float* Hin; u64* Hmeta; bf16_t* XB; u64* ssq_out; int K_TILES;
    __device__ __forceinline__ void operator()(const f32x4 (&acc)[2][2][4][2], const Unit& u, int wr, int wc, int fr, int fq) const {
        const int row0 = u.pm * BM + wr * 64 + fr, col0 = u.pn * BM + wc * 32 + 8 * fq;
        if (u.pm == MTOK / BM) {
            if (wr == 0) {
#pragma unroll
                for (int m = 0; m < 4; ++m) { u64* hp = Hmeta + (size_t)(m * 16 + fr) * DM + col0;
#pragma unroll
                    for (int bj = 0; bj < 2; ++bj)
#pragma unroll
                        for (int n = 0; n < 2; ++n)
#pragma unroll
                            for (int j = 0; j < 4; ++j) atomicAdd(hp + bj * HALF + 4 * n + j, fx_from(acc[0][bj][m][n][j])); } }
            return; }
        if (F32IN) {
#pragma unroll
            for (int ai = 0; ai < 2; ++ai)
#pragma unroll
                for (int mp = 0; mp < 4; mp += 2) {
                    f32x4 hv[2][2][2];
#pragma unroll
                    for (int q = 0; q < 2; ++q) { const float* hi = Hin + (size_t)(row0 + ai * HALF + (mp + q) * 16) * DM + col0;
#pragma unroll
                        for (int bj = 0; bj < 2; ++bj) { hv[q][bj][0] = *(const f32x4*)(hi + bj * HALF); hv[q][bj][1] = *(const f32x4*)(hi + bj * HALF + 4); } }
#pragma unroll
                    for (int q = 0; q < 2; ++q) { const int m = mp + q; const int r = row0 + ai * HALF + m * 16; bf16_t* xp = XB + (size_t)r * DM + col0; float s = 0.f;
#pragma unroll
                        for (int bj = 0; bj < 2; ++bj) { const f32x4 v0 = hv[q][bj][0] + acc[ai][bj][m][0], v1 = hv[q][bj][1] + acc[ai][bj][m][1];
                            *(u32x4*)(xp + bj * HALF) = pack8(v0, v1);
                            s += (v0[0] * v0[0] + v0[1] * v0[1]) + (v0[2] * v0[2] + v0[3] * v0[3]) + (v1[0] * v1[0] + v1[1] * v1[1]) + (v1[2] * v1[2] + v1[3] * v1[3]); }
                        s = sum_x32(sum_x16(s));
                        if (fq == 0) atomicAdd(ssq_out + r, fx_from_pos(s)); }
                    asm volatile("" ::: "memory"); }
        } else {
#pragma unroll
            for (int ai = 0; ai < 2; ++ai) {
                u32x4 hb[4][2];
#pragma unroll
                for (int m = 0; m < 4; ++m) { const bf16_t* xi = XB + (size_t)(row0 + ai * HALF + m * 16) * DM + col0;
#pragma unroll
                    for (int bj = 0; bj < 2; ++bj) hb[m][bj] = *(const u32x4*)(xi + bj * HALF); }
#pragma unroll
                for (int m = 0; m < 4; ++m) { const int r = row0 + ai * HALF + m * 16; bf16_t* xp = XB + (size_t)r * DM + col0; float s = 0.f;
#pragma unroll
                    for (int bj = 0; bj < 2; ++bj) { const u32x4 w = hb[m][bj];
                        const f32x4 h0 = {__builtin_bit_cast(float, w[0] << 16), __builtin_bit_cast(float, w[0] & 0xffff0000u), __builtin_bit_cast(float, w[1] << 16), __builtin_bit_cast(float, w[1] & 0xffff0000u)};
                        const f32x4 h1 = {__builtin_bit_cast(float, w[2] << 16), __builtin_bit_cast(float, w[2] & 0xffff0000u), __builtin_bit_cast(float, w[3] << 16), __builtin_bit_cast(float, w[3] & 0xffff0000u)};
                        const f32x4 v0 = h0 + acc[ai][bj][m][0], v1 = h1 + acc[ai][bj][m][1];
                        *(u32x4*)(xp + bj * HALF) = pack8(v0, v1);
                        s += (v0[0] * v0[0] + v0[1] * v0[1]) + (v0[2] * v0[2] + v0[3] * v0[3]) + (v1[0] * v1[0] + v1[1] * v1[1]) + (v1[2] * v1[2] + v1[3] * v1[3]); }
                    s = sum_x32(sum_x16(s));
                    if (fq == 0) atomicAdd(ssq_out + r, fx_from_pos(s)); }
                asm volatile("" ::: "memory"); }
        }
    }
};
typedef EpiResT<true> EpiResX;
typedef EpiResT<false> EpiRes;
struct EpiFinal {
    static constexpr bool PERM = true, AFTER_DRAIN = false;
    const bf16_t* XB; float* OUT;
    __device__ __forceinline__ void operator()(const f32x4 (&acc)[2][2][4][2], const Unit& u, int wr, int wc, int fr, int fq) const {
        const int row0 = u.pm * BM + wr * 64 + fr, col0 = u.pn * BM + wc * 32 + 8 * fq;
#pragma unroll
        for (int ai = 0; ai < 2; ++ai) {
            u32x4 hb[4][2];
#pragma unroll
            for (int m = 0; m < 4; ++m) { const bf16_t* xi = XB + (size_t)(row0 + ai * HALF + m * 16) * DM + col0;
#pragma unroll
                for (int bj = 0; bj < 2; ++bj) hb[m][bj] = *(const u32x4*)(xi + bj * HALF); }
#pragma unroll
            for (int m = 0; m < 4; ++m) { float* op = OUT + (size_t)(row0 + ai * HALF + m * 16) * DM + col0;
#pragma unroll
                for (int bj = 0; bj < 2; ++bj) { const u32x4 w = hb[m][bj];
                    const f32x4 h0 = {__builtin_bit_cast(float, w[0] << 16), __builtin_bit_cast(float, w[0] & 0xffff0000u), __builtin_bit_cast(float, w[1] << 16), __builtin_bit_cast(float, w[1] & 0xffff0000u)};
                    const f32x4 h1 = {__builtin_bit_cast(float, w[2] << 16), __builtin_bit_cast(float, w[2] & 0xffff0000u), __builtin_bit_cast(float, w[3] << 16), __builtin_bit_cast(float, w[3] & 0xffff0000u)};
                    *(f32x4*)(op + bj * HALF) = h0 + acc[ai][bj][m][0]; *(f32x4*)(op + bj * HALF + 4) = h1 + acc[ai][bj][m][1]; } }
            asm volatile("" ::: "memory"); }
    }
};
struct EpiGU {
    static constexpr bool PERM = true, AFTER_DRAIN = false;
    bf16_t* HID; const u64* ssq;
    __device__ __forceinline__ void operator()(const f32x4 (&acc)[2][2][4][2], const Unit& u, int wr, int wc, int fr, int fq) const {
        const int row0 = u.pm * BM + wr * 64 + fr, col0 = u.pn * HALF + wc * 32 + 8 * fq;
#pragma unroll
        for (int ai = 0; ai < 2; ++ai)
#pragma unroll
            for (int m = 0; m < 4; ++m) { const int r = row0 + ai * HALF + m * 16; const float rs = row_rstd(ssq, r); f32x4 o[2];
#pragma unroll
                for (int n = 0; n < 2; ++n)
#pragma unroll
                    for (int j = 0; j < 4; ++j) { const float g = acc[ai][0][m][n][j] * rs, uu = acc[ai][1][m][n][j] * rs;
                        o[n][j] = g * uu * __builtin_amdgcn_rcpf(1.0f + __expf(-g)); }
                *(u32x4*)(HID + (size_t)r * DFF + col0) = pack8(o[0], o[1]); }
    }
};
struct EpiIn1 {
    static constexpr bool PERM = true, AFTER_DRAIN = false;
    bf16_t* Z; const u64* ssq;
    __device__ __forceinline__ void operator()(const f32x4 (&acc)[2][2][4][2], const Unit& u, int wr, int wc, int fr, int fq) const {
        const int row0 = u.pm * BM + wr * 64 + fr, col0 = u.pn * BM + wc * 32 + 8 * fq;
        if (u.pn < 32) {
            const float sc = u.pn < 16 ? 1.0f : 0.0625f;
            float inv[2][4];
#pragma unroll
            for (int n = 0; n < 2; ++n)
#pragma unroll
                for (int j = 0; j < 4; ++j) inv[n][j] = exp2f(-(float)(wc * 32 + 8 * fq + 4 * n + j) * (13.287712379549449f / 128.0f));
#pragma unroll
            for (int ai = 0; ai < 2; ++ai)
#pragma unroll
                for (int m = 0; m < 4; ++m) { const int r = row0 + ai * HALF + m * 16; const float rs = row_rstd(ssq, r) * sc;
                    const float t = (float)(r < MTOK ? NMETA + (r & (SEQ - 1)) : ((r - MTOK) & 15));
                    f32x4 o1[2], o2[2];
#pragma unroll
                    for (int n = 0; n < 2; ++n)
#pragma unroll
                        for (int j = 0; j < 4; ++j) { const float x1 = acc[ai][0][m][n][j] * rs, x2 = acc[ai][1][m][n][j] * rs;
                            const float ang = t * inv[n][j]; float rev = ang * 0.15915494309189535f; rev = rev - floorf(rev);
                            const float c = __builtin_amdgcn_cosf(rev), s = __builtin_amdgcn_sinf(rev);
                            o1[n][j] = x1 * c - x2 * s; o2[n][j] = x1 * s + x2 * c; }
                    bf16_t* rowp = Z + (size_t)r * RET_IN + col0;
                    *(u32x4*)(rowp) = pack8(o1[0], o1[1]); *(u32x4*)(rowp + HALF) = pack8(o2[0], o2[1]); }
        } else {
#pragma unroll
            for (int ai = 0; ai < 2; ++ai)
#pragma unroll
                for (int m = 0; m < 4; ++m) { const int r = row0 + ai * HALF + m * 16; const float rs = row_rstd(ssq, r); bf16_t* rowp = Z + (size_t)r * RET_IN + col0;
#pragma unroll
                    for (int bj = 0; bj < 2; ++bj) *(u32x4*)(rowp + bj * HALF) = pack8(acc[ai][bj][m][0] * rs, acc[ai][bj][m][1] * rs); }
        }
    }
};

struct EpiNone {
    static constexpr bool PERM = true, AFTER_DRAIN = false;
    __device__ __forceinline__ void operator()(const f32x4 (&acc)[2][2][4][2], const Unit&, int, int, int, int) const {
#pragma unroll
        for (int ai = 0; ai < 2; ++ai)
#pragma unroll
            for (int bj = 0; bj < 2; ++bj)
#pragma unroll
                for (int m = 0; m < 4; ++m) asm volatile("" :: "v"(acc[ai][bj][m][0]), "v"(acc[ai][bj][m][1]));
    }
};
struct HotOrder : StaticOrder {
    __device__ bool next(int i, Unit& u) const { const bool ok = StaticOrder::next(i, u); u.pm = 0; u.pn = 0; return ok; }
    __device__ __forceinline__ void a_ready(const Unit&) const {}
    __device__ __forceinline__ void done(const Unit&) const {}
};
template <class Epi, class Sched, bool ALIGN_EPI = false, bool SP2 = false>
__device__ __forceinline__ void gemm_phase(PG8_LAS unsigned char* lds, const Gemm g, const Sched& S, const Epi& E, const int wid) {
    const int lane = hw_lane(), tid = wid * 64 + lane, wr = wid >> 2, wc = wid & 3, fr = lane & 15, fq = lane >> 4;
    const int K = g.K; int nt;
    unsigned voffA[2], voffB[2];
#pragma unroll
    for (int i = 0; i < 2; ++i) { int R, C; stage_rc(tid * 16 + i * 8192, R, C); const int Rb = Epi::PERM ? ((R & ~31) + perm32(R & 31)) : R;
        voffA[i] = (unsigned)(R * K + C) * 2u; voffB[i] = (unsigned)(Rb * K + C) * 2u; }
    const size_t kstep = (size_t)(BK * 2);
    const size_t hstep = (size_t)HALF * K * 2;
    const size_t tstep = 2 * hstep;
    const unsigned ldsw = (unsigned)wid * 1024u;
    const int aoff = lds_byte(wr * 64 + fr, fq * 8), boff = lds_byte(wc * 32 + fr, fq * 8);
#define PG8_SA(b, h) (((b) * 2 + (h)) * HTB)
#define PG8_SB(b, h) ((4 + (b) * 2 + (h)) * HTB)
#define PG8_STAGE(bufoff, gbase, voff) do { _Pragma("unroll") for (int _i = 0; _i < 2; ++_i) \
        __builtin_amdgcn_global_load_lds((const unsigned*)((const char*)(gbase) + (voff)[_i]), (PG8_LAS unsigned*)(lds + (bufoff) + ldsw + _i * 8192), 16, 0, 0); } while (0)
#define PG8_LDA(dst, b, h) do { _Pragma("unroll") for (int m = 0; m < 4; ++m) _Pragma("unroll") for (int k = 0; k < 2; ++k) dst[m][k] = *(const PG8_LAS bf16x8*)(lds + PG8_SA(b, h) + aoff + m * 2048 + k * 1024); } while (0)
#define PG8_LDB(dst, b, h) do { _Pragma("unroll") for (int n = 0; n < 2; ++n) _Pragma("unroll") for (int k = 0; k < 2; ++k) dst[n][k] = *(const PG8_LAS bf16x8*)(lds + PG8_SB(b, h) + boff + n * 2048 + k * 1024); } while (0)
#define PG8_MMA(ai, bj, At, Bt) do { __builtin_amdgcn_s_setprio(1); _Pragma("unroll") for (int m = 0; m < 4; ++m) _Pragma("unroll") for (int n = 0; n < 2; ++n) _Pragma("unroll") for (int k = 0; k < 2; ++k) \
        acc[ai][bj][m][n] = __builtin_amdgcn_mfma_f32_16x16x32_bf16(Bt[n][k], At[m][k], acc[ai][bj][m][n], 0, 0, 0); __builtin_amdgcn_s_setprio(0); } while (0)
#define PG8_WAIT_V(n) asm volatile("s_waitcnt vmcnt(" #n ")" ::: "memory")
#define PG8_WAIT_L(n) asm volatile("s_waitcnt lgkmcnt(" #n ")" ::: "memory")
#define PG8_BAR __builtin_amdgcn_s_barrier()
#define PG8_SCHED __builtin_amdgcn_sched_barrier(0)
    Unit cur, nxt; int ui = 0;
    if (!S.next(0, cur)) return;
    nt = cur.kn;
    f32x4 acc[2][2][4][2];
#pragma unroll
    for (int a = 0; a < 2; ++a)
#pragma unroll
        for (int b = 0; b < 2; ++b)
#pragma unroll
            for (int m = 0; m < 4; ++m)
#pragma unroll
                for (int n = 0; n < 2; ++n) acc[a][b][m][n] = (f32x4){0.f, 0.f, 0.f, 0.f};
    bf16x8 At[4][2], B0[2][2], B1[2][2];
    const char* cA = (const char*)g.A + (size_t)cur.pm * tstep + (size_t)cur.kb * kstep; const char* cB = (const char*)g.Bt + (size_t)cur.pn * tstep + (size_t)cur.kb * kstep;
    S.a_ready(cur);
    if constexpr (SP2) {
        PG8_STAGE(PG8_SB(0, 0), cB, voffB); PG8_STAGE(PG8_SB(0, 1), cB + hstep, voffB); PG8_STAGE(PG8_SA(0, 0), cA, voffA); PG8_STAGE(PG8_SA(0, 1), cA + hstep, voffA);
        if (wr == 1) PG8_BAR;
        PG8_WAIT_V(2); PG8_BAR;
        PG8_STAGE(PG8_SB(1, 0), cB + kstep, voffB); PG8_STAGE(PG8_SA(1, 0), cA + kstep, voffA); PG8_STAGE(PG8_SB(1, 1), cB + hstep + kstep, voffB);
        PG8_WAIT_V(6); PG8_BAR;
    } else {
        PG8_STAGE(PG8_SB(0, 0), cB, voffB); PG8_STAGE(PG8_SA(0, 0), cA, voffA); PG8_STAGE(PG8_SB(0, 1), cB + hstep, voffB); PG8_STAGE(PG8_SA(0, 1), cA + hstep, voffA);
        if (wr == 1) PG8_BAR;
        PG8_WAIT_V(4); PG8_BAR;
        PG8_STAGE(PG8_SB(1, 0), cB + kstep, voffB); PG8_STAGE(PG8_SA(1, 0), cA + kstep, voffA); PG8_STAGE(PG8_SB(1, 1), cB + hstep + kstep, voffB);
        PG8_WAIT_V(6); PG8_BAR;
    }
    for (;;) {
        const bool has_next = S.next(ui + 1, nxt);
        const char* nA = has_next ? (const char*)g.A + (size_t)nxt.pm * tstep + (size_t)nxt.kb * kstep : cA; const char* nB = has_next ? (const char*)g.Bt + (size_t)nxt.pn * tstep + (size_t)nxt.kb * kstep : cB;
        for (int t = 0; t < nt; t += 2) {
            const bool last = (t == nt - 2);
            const char* a1 = cA + (size_t)(t + 1) * kstep;
            const char* a2 = last ? nA : cA + (size_t)(t + 2) * kstep; const char* b2 = last ? nB : cB + (size_t)(t + 2) * kstep;
            const char* a3 = a2 + kstep; const char* b3 = b2 + kstep;
            if (last && has_next) S.a_ready(nxt);
            if constexpr (SP2) {
            PG8_LDB(B0, 0, 0); PG8_LDB(B1, 0, 1); PG8_SCHED; PG8_LDA(At, 0, 0); PG8_STAGE(PG8_SA(1, 1), a1 + hstep, voffA);
            PG8_WAIT_V(8); PG8_WAIT_L(0); PG8_BAR; PG8_MMA(0, 0, At, B0); PG8_MMA(0, 1, At, B1); PG8_BAR; PG8_SCHED;
            PG8_LDA(At, 0, 1); PG8_STAGE(PG8_SB(0, 0), b2, voffB); PG8_STAGE(PG8_SB(0, 1), b2 + hstep, voffB); PG8_STAGE(PG8_SA(0, 0), a2, voffA);
            PG8_WAIT_V(8); PG8_WAIT_L(0); PG8_BAR; PG8_MMA(1, 0, At, B0); PG8_MMA(1, 1, At, B1); PG8_BAR; PG8_SCHED;
            PG8_LDB(B0, 1, 0); PG8_LDB(B1, 1, 1); PG8_SCHED; PG8_LDA(At, 1, 0); PG8_STAGE(PG8_SA(0, 1), a2 + hstep, voffA);
            PG8_WAIT_V(8); PG8_WAIT_L(0); PG8_BAR; PG8_MMA(0, 0, At, B0); PG8_MMA(0, 1, At, B1); PG8_BAR; PG8_SCHED;
            PG8_LDA(At, 1, 1); PG8_STAGE(PG8_SB(1, 0), b3, voffB); PG8_STAGE(PG8_SB(1, 1), b3 + hstep, voffB); PG8_STAGE(PG8_SA(1, 0), a3, voffA);
            PG8_WAIT_V(8); PG8_WAIT_L(0); PG8_BAR; PG8_MMA(1, 0, At, B0); PG8_MMA(1, 1, At, B1); PG8_BAR; PG8_SCHED;
            } else {
            PG8_LDB(B0, 0, 0); PG8_SCHED; PG8_LDA(At, 0, 0); PG8_STAGE(PG8_SA(1, 1), a1 + hstep, voffA);
            PG8_WAIT_L(8); PG8_BAR; PG8_WAIT_L(0); PG8_MMA(0, 0, At, B0); PG8_BAR; PG8_SCHED;
            PG8_LDB(B1, 0, 1); PG8_STAGE(PG8_SB(0, 0), b2, voffB);
            PG8_BAR; PG8_WAIT_L(0); PG8_MMA(0, 1, At, B1); PG8_BAR;
            PG8_LDA(At, 0, 1); PG8_STAGE(PG8_SA(0, 0), a2, voffA);
            PG8_BAR; PG8_WAIT_L(0); PG8_MMA(1, 0, At, B0); PG8_BAR; PG8_SCHED;
            PG8_STAGE(PG8_SB(0, 1), b2 + hstep, voffB);
            PG8_WAIT_V(6); PG8_BAR; PG8_MMA(1, 1, At, B1); PG8_BAR;
            PG8_LDB(B0, 1, 0); PG8_SCHED; PG8_LDA(At, 1, 0); PG8_STAGE(PG8_SA(0, 1), a2 + hstep, voffA);
            PG8_WAIT_L(8); PG8_BAR; PG8_WAIT_L(0); PG8_MMA(0, 0, At, B0); PG8_BAR; PG8_SCHED;
            PG8_LDB(B1, 1, 1); PG8_STAGE(PG8_SB(1, 0), b3, voffB);
            PG8_BAR; PG8_WAIT_L(0); PG8_MMA(0, 1, At, B1); PG8_BAR;
            PG8_LDA(At, 1, 1); PG8_STAGE(PG8_SA(1, 0), a3, voffA);
            PG8_BAR; PG8_WAIT_L(0); PG8_MMA(1, 0, At, B0); PG8_BAR; PG8_SCHED;
            PG8_STAGE(PG8_SB(1, 1), b3 + hstep, voffB);
            PG8_WAIT_V(6); PG8_BAR; PG8_MMA(1, 1, At, B1); PG8_BAR;
            }
        }
        if constexpr (ALIGN_EPI) { if (wr == 0) PG8_BAR; }
        if constexpr (!Epi::AFTER_DRAIN) { E(acc, cur, wr, wc, fr, fq); S.done(cur); }
        if (!has_next) break;
#pragma unroll
        for (int a = 0; a < 2; ++a)
#pragma unroll
            for (int b = 0; b < 2; ++b)
#pragma unroll
                for (int m = 0; m < 4; ++m)
#pragma unroll
                    for (int n = 0; n < 2; ++n) acc[a][b][m][n] = (f32x4){0.f, 0.f, 0.f, 0.f};
        cur = nxt; cA = nA; cB = nB; ++ui; nt = cur.kn;
        if constexpr (ALIGN_EPI) { if (wr == 1) PG8_BAR; }
    }
    PG8_WAIT_V(0);
    if constexpr (!ALIGN_EPI) { if (wr == 0) PG8_BAR; }
    PG8_BAR;
    if constexpr (Epi::AFTER_DRAIN) { E.fused(acc, cur, wr, wc, fr, fq, lds, wid, lane); S.done(cur); }
#undef PG8_SA
#undef PG8_SB
#undef PG8_STAGE
#undef PG8_LDA
#undef PG8_LDB
#undef PG8_MMA
#undef PG8_WAIT_V
#undef PG8_WAIT_L
#undef PG8_BAR
#undef PG8_SCHED
}
}

constexpr size_t MiB = 1u << 20;
constexpr size_t WS_CTL = 0, CTL_ZERO_BYTES = 4 * MiB;
constexpr size_t WS_SSQ1 = 64 * 1024, WS_SSQ2 = 256 * 1024, WS_SSQ3 = 448 * 1024, WS_SSQO = 640 * 1024;
constexpr size_t WS_SSQ0 = 4 * MiB;
constexpr size_t WS_FBUF = 4 * MiB + 256 * 1024;
constexpr size_t WS_HMETA = 6 * MiB;
constexpr size_t WS_WIN0 = 8 * MiB, WS_WOUT0 = 90 * MiB, WS_WGU0 = 122 * MiB, WS_WD0 = 294 * MiB, WS_WIN1 = 380 * MiB, WS_WOUT1 = 572 * MiB, WS_WGU1 = 636 * MiB, WS_WD1 = 808 * MiB;
constexpr size_t WS_WAT = 894 * MiB, WS_WXT = WS_WAT + 512 * 1024;
constexpr size_t WS_XB = 896 * MiB, WS_Z = 1026 * MiB, WS_END = 1806 * MiB;
constexpr size_t WS_Y0 = WS_Z + 400 * MiB;
constexpr size_t WS_Y1 = 8 * MiB;
static_assert(WS_SSQ1 + (size_t)MP * 8 <= WS_SSQ2 && WS_SSQ2 + (size_t)MP * 8 <= WS_SSQ3 && WS_SSQ3 + (size_t)MP * 8 <= WS_SSQO && WS_SSQO + (size_t)MP * 16 * 8 <= CTL_ZERO_BYTES && WS_SSQ0 + (size_t)MP * 8 <= WS_FBUF && WS_FBUF + (size_t)MP * 16 * 4 <= WS_HMETA && WS_HMETA + (size_t)64 * DM * 8 <= WS_WIN0, "ctl map");
static_assert(WS_WIN0 + (size_t)41 * 256 * DM * 2 <= WS_WOUT0 && WS_WGU0 + (size_t)2 * DFF * DM * 2 <= WS_WD0 && WS_WD0 + (size_t)DM * DFF * 2 <= WS_WIN1 && WS_WIN1 + (size_t)RET_IN * DM * 2 <= WS_WOUT1, "weight map");
static_assert(WS_WOUT1 + (size_t)DM * RET_VW * 2 <= WS_WGU1 && WS_WGU1 + (size_t)2 * DFF * DM * 2 <= WS_WD1 && WS_WD1 + (size_t)DM * DFF * 2 <= WS_WAT, "weight map 2");
static_assert(WS_XB + (size_t)MP * DM * 2 <= WS_Z && WS_Z + (size_t)MP * RET_IN * 2 <= WS_END && WS_Z + (size_t)MP * AB_Z * 2 <= WS_Y0 && WS_Z + (size_t)MP * DFF * 2 <= WS_Y0 && WS_Y0 + (size_t)MP * DM * 2 <= WS_END && WS_Y1 + (size_t)MP * RET_VW * 2 <= WS_WD0, "activation map");
constexpr int CW_TMO = 0, CW_Q2 = 64, CW_TK3 = 256, CW_TK5 = 320, CW_QC = 384, CW_ACT = 512, CW_TL1 = 640, CW_TL4 = 704, CW_TL6 = 768, CW_TL10 = 832, CW_BAR = 4096;
constexpr int RING_BYTES = 131072;
constexpr int LDS_BYTES = 147456;
constexpr int MISC_OFF = LDS_BYTES - 256;
constexpr int NWAVES = 8, NTHREADS = 512;
constexpr int NPHASES = 12;

#define GAS __attribute__((address_space(1)))
#define LAS __attribute__((address_space(3)))
typedef unsigned short bf16;
typedef unsigned v4u __attribute__((ext_vector_type(4)));
typedef unsigned v2u __attribute__((ext_vector_type(2)));
typedef float f32x4 __attribute__((ext_vector_type(4)));
typedef float v2f __attribute__((ext_vector_type(2)));
typedef short bf16x8 __attribute__((ext_vector_type(8)));
typedef short bf16x4 __attribute__((ext_vector_type(4)));
typedef GAS unsigned gu32;
#define RLX_AGENT __ATOMIC_RELAXED, __HIP_MEMORY_SCOPE_AGENT
#define LDS_WAIT() asm volatile("s_waitcnt lgkmcnt(0)" ::: "memory")
#define VM_WAIT() asm volatile("s_waitcnt vmcnt(0)" ::: "memory")
__device__ __forceinline__ unsigned f2bf(float f) { unsigned u = __builtin_bit_cast(unsigned, f); return (u + 0x7fffu + ((u >> 16) & 1u)) >> 16; }
__device__ __forceinline__ unsigned pk2(float lo, float hi) { return pg8::cvt_pk_bf16(lo, hi); }
__device__ __forceinline__ float bflo(unsigned w) { return __builtin_bit_cast(float, w << 16); }
__device__ __forceinline__ float bfhi(unsigned w) { return __builtin_bit_cast(float, w & 0xffff0000u); }
__device__ __forceinline__ float bf2f(unsigned short h) { return __builtin_bit_cast(float, (unsigned)h << 16); }
__device__ __forceinline__ void unpack8(const v4u w, float (&f)[8]) { f[0] = bflo(w.x); f[1] = bfhi(w.x); f[2] = bflo(w.y); f[3] = bfhi(w.y); f[4] = bflo(w.z); f[5] = bfhi(w.z); f[6] = bflo(w.w); f[7] = bfhi(w.w); }
__device__ __forceinline__ v4u pack8f(const float (&f)[8]) { v4u w; w.x = pk2(f[0], f[1]); w.y = pk2(f[2], f[3]); w.z = pk2(f[4], f[5]); w.w = pk2(f[6], f[7]); return w; }
__device__ __forceinline__ int row_of(int b, int t) { return t < NMETA ? MMETA + NMETA * b + t : b * SEQ + (t - NMETA); }
__device__ __forceinline__ f32x4 mfma16(bf16x8 a, bf16x8 b, f32x4 c) { return __builtin_amdgcn_mfma_f32_16x16x32_bf16(a, b, c, 0, 0, 0); }

#define XB_TMO      128
#define XB_XCNT(j)  (256  + 64 * (j))
#define XB_XSUB(j)  (1280 + 64 * (j))
#define XB_XGEN(j)  (2304 + 64 * (j))
#define XB_TOP      3328
#define XB_TOPGEN   3392
#define XCD_BAR_WORDS 3456
#define XB_SPIN_CAP (1u << 22)

__device__ __forceinline__ unsigned xb_ld(unsigned* p)              { return __hip_atomic_load(p, __ATOMIC_RELAXED, __HIP_MEMORY_SCOPE_AGENT); }
__device__ __forceinline__ unsigned xb_add(unsigned* p, unsigned v) { return __hip_atomic_fetch_add(p, v, __ATOMIC_RELAXED, __HIP_MEMORY_SCOPE_AGENT); }
__device__ __forceinline__ unsigned xb_xcc_id() { return (unsigned)__builtin_amdgcn_s_getreg((3 << 11) | 20) & 0xFu; }
#define XB_SPIN(cond, bar) do { unsigned _sp = 0; while (cond) { __builtin_amdgcn_s_sleep(1); \
    if ((++_sp & 255u) == 0u) { if (xb_ld(&(bar)[XB_TMO])) break; if (_sp > XB_SPIN_CAP) { atomicAdd(&(bar)[XB_TMO], 1u); break; } } } } while (0)

struct XcdBarrier {
    unsigned* bar; unsigned x; int wave;
    volatile LAS unsigned* st;
};
__device__ __forceinline__ XcdBarrier xcd_barrier_post(unsigned* bar, volatile LAS unsigned* st, int wave) {
    XcdBarrier b; b.bar = bar; b.x = xb_xcc_id(); b.st = st; b.wave = wave;
    if (threadIdx.x == 0) (void)xb_add(&bar[XB_XCNT(b.x)], 1u);
    return b;
}
__device__ __forceinline__ void xcd_barrier_complete(unsigned* bar, unsigned x, unsigned& nloc, unsigned& nx) {
    const unsigned G = gridDim.x * gridDim.y * gridDim.z;
    unsigned sum, cnt, mine, sp = 0u;
    for (;;) {
        sum = 0u; cnt = 0u; mine = 0u;
#pragma unroll
        for (unsigned j = 0; j < 16; ++j) { const unsigned c = xb_ld(&bar[XB_XCNT(j)]); sum += c; cnt += (c > 0u) ? 1u : 0u; mine = (j == x) ? c : mine; }
        if (sum == G) break;
        __builtin_amdgcn_s_sleep(1);
        if ((++sp & 255u) == 0u) { if (xb_ld(&bar[XB_TMO])) break; if (sp > XB_SPIN_CAP) { atomicAdd(&bar[XB_TMO], 1u); break; } }
    }
    nloc = mine > 0u ? mine : 1u; nx = cnt > 0u ? cnt : 1u;
}
__device__ __forceinline__ void xcd_barrier(const XcdBarrier& b) {
    asm volatile("s_waitcnt vmcnt(0)" ::: "memory");
    __syncthreads();
    if (b.wave == 0 && hw_lane() == 0) {
        unsigned* bar = b.bar;
        __builtin_amdgcn_s_waitcnt(0);
        unsigned nloc = b.st[0], nx = b.st[1];
        if (nloc == 0u) { xcd_barrier_complete(bar, b.x, nloc, nx); b.st[0] = nloc; b.st[1] = nx; }
        const unsigned old = xb_add(&bar[XB_XSUB(b.x)], 1u);
        const unsigned gen = old / nloc;
        if (old + 1u == (gen + 1u) * nloc) {
            __builtin_amdgcn_fence(__ATOMIC_RELEASE, "agent");
            asm volatile("s_waitcnt vmcnt(0)" ::: "memory");
            const unsigned og = xb_add(&bar[XB_TOP], 1u);
            const unsigned tg = og / nx;
            if (og + 1u == (tg + 1u) * nx) xb_add(&bar[XB_TOPGEN], 1u);
            else XB_SPIN(xb_ld(&bar[XB_TOPGEN]) == tg, bar);
            __builtin_amdgcn_fence(__ATOMIC_ACQUIRE, "agent");
            xb_add(&bar[XB_XGEN(b.x)], 1u);
            asm volatile("s_waitcnt vmcnt(0)" ::: "memory");
        } else {
            XB_SPIN(xb_ld(&bar[XB_XGEN(b.x)]) == gen, bar);
            __builtin_amdgcn_fence(__ATOMIC_ACQUIRE, "agent");
            asm volatile("s_waitcnt vmcnt(0)" ::: "memory");
        }
    }
    __syncthreads();
}

struct Args { const float* in[23]; float* out; unsigned char* ws; int ph_lo, ph_hi; };
__device__ __forceinline__ float* h_row(float* out, unsigned char* ws, int r) { return r < MTOK ? out + (size_t)r * DM : (float*)(ws + WS_HMETA) + (size_t)(r - MTOK) * DM; }
struct Frame {
    LAS unsigned char* lds;
    volatile LAS unsigned* MISC;
    unsigned char* ws;
    int tid, lane, wave, G;
};
__device__ __forceinline__ float wave_sum(float v) {
    return sum_x32(sum_x16(row16_sum(v)));
}

template <int MODE, int KCH, bool GAIN = false>
__device__ __forceinline__ void p0_tr(const float* W, int K, int N, bf16* WT, LAS unsigned* tile, int item, int lane, const float* gk = nullptr) {
    const int nkc = K / KCH, nb = item / nkc, kc = item - nb * nkc, k0 = kc * KCH, n0 = nb * 64;
    const int kq = lane >> 4, nq = lane & 15; const int n = n0 + 4 * nq; const bool ok = n < N;
    const float* src = W + (size_t)(k0 + 2 * kq) * N + (ok ? n : 0);
    const int nr = lane >> 3, kch = lane & 7;
    f32x4 va[8][2]; v2f gv[8];
#define P0_LOADH(sub, h) do { _Pragma("unroll") for (int i = 4 * (h); i < 4 * (h) + 4; ++i) { const float* p_ = src + (size_t)(64 * (sub) + 8 * i) * N; va[i][0] = __builtin_nontemporal_load((const GAS f32x4*)p_); va[i][1] = __builtin_nontemporal_load((const GAS f32x4*)(p_ + N)); \
            if (GAIN) gv[i] = *(const GAS v2f*)(gk + k0 + 64 * (sub) + 8 * i + 2 * kq); } } while (0)
#define P0_WRH(h) do { _Pragma("unroll") for (int i = 4 * (h); i < 4 * (h) + 4; ++i) { \
            _Pragma("unroll") for (int c = 0; c < 4; ++c) tile[(4 * nq + c) * 33 + 4 * i + kq] = GAIN ? pk2(va[i][0][c] * gv[i].x, va[i][1][c] * gv[i].y) : pk2(va[i][0][c], va[i][1][c]); } } while (0)
#define P0_OUT(sub) do { const int kb = k0 + 64 * (sub); \
        LDS_WAIT(); asm volatile("" ::: "memory"); \
        _Pragma("unroll") for (int st = 0; st < 8; ++st) { const int row = 8 * st + nr; const LAS unsigned* tp = tile + row * 33 + 4 * kch; \
            v4u o; o.x = tp[0]; o.y = tp[1]; o.z = tp[2]; o.w = tp[3]; \
            const int ng = n0 + row; const int drow = MODE == 0 ? ng : (MODE == 1 ? 256 * (ng >> 7) + (ng & 127) : 256 * (ng >> 7) + 128 + (ng & 127)); \
            if (ng < N) __builtin_nontemporal_store(o, (GAS v4u*)(WT + (size_t)drow * K + kb + 8 * kch)); } \
        LDS_WAIT(); asm volatile("" ::: "memory"); } while (0)
    P0_LOADH(0, 0); P0_LOADH(0, 1);
#pragma unroll 1
    for (int sub = 0; sub < KCH / 64; ++sub) { const bool more = sub + 1 < KCH / 64;
        P0_WRH(0); if (more) P0_LOADH(sub + 1, 0);
        P0_WRH(1); if (more) P0_LOADH(sub + 1, 1);
        P0_OUT(sub); }
#undef P0_LOADH
#undef P0_WRH
#undef P0_OUT
}
__device__ __forceinline__ void p0_row(Frame& F, const float* x, const float* meta, int r) {
    bf16* xrow = (bf16*)(F.ws + WS_XB) + (size_t)r * DM;
    const float* src = r < MTOK ? x + (size_t)r * DM : meta + (size_t)((r - MTOK) & 15) * DM;
    const bool pad = r >= MTOK + NB * NMETA;
    float s = 0.f;
    f32x4 v[16];
#pragma unroll
    for (int j = 0; j < 16; ++j) { const int e = (F.lane + 64 * j) * 4; v[j] = pad ? (f32x4){0.f, 0.f, 0.f, 0.f} : *(const GAS f32x4*)(src + e); }
#pragma unroll
    for (int j = 0; j < 16; ++j) { const int e = (F.lane + 64 * j) * 4;
        s += (v[j].x * v[j].x + v[j].y * v[j].y) + (v[j].z * v[j].z + v[j].w * v[j].w);
        if (r >= MTOK && !pad) { u64* hm = (u64*)(F.ws + WS_HMETA) + (size_t)(r - MTOK) * DM + e; hm[0] = fx_from(v[j].x); hm[1] = fx_from(v[j].y); hm[2] = fx_from(v[j].z); hm[3] = fx_from(v[j].w); }
        v2u w; w.x = pk2(v[j].x, v[j].y); w.y = pk2(v[j].z, v[j].w); *(GAS v2u*)(xrow + e) = w; }
    s = wave_sum(s);
    if (F.lane == 0) ((u64*)(F.ws + WS_SSQ0))[r] = fx_from_pos(s);
}
#ifndef CONV_IN_P2
#define CONV_IN_P2 1
#endif
constexpr int P0_KC = 256;
constexpr int CV_G = 172 * (DM / P0_KC), CV_D = 64 * (DFF / P0_KC), CV_IN1 = 384 * (DM / P0_KC), CV_O1 = 64 * (RET_VW / P0_KC);
constexpr int CV_FINE = 2 * (2 * CV_G + CV_D) + CV_IN1 + CV_O1;
constexpr int TL1_LO = 0, TL1_N = 4224;
constexpr int TL4_LO = 2 * CV_G, TL4_N = 1176;
constexpr int TL6_LO = 2 * CV_G + CV_D + CV_IN1 + CV_O1, TL6_N = 4480;
constexpr int TL10_LO = CV_FINE - CV_D, TL10_N = CV_D;
static_assert(TL6_LO == 2 * CV_G + CV_D + CV_IN1 + CV_O1 && TL1_LO + TL1_N <= TL4_LO && TL4_LO + TL4_N <= TL6_LO && TL6_LO + TL6_N <= TL10_LO && TL10_LO + TL10_N == CV_FINE, "tail ranges");
constexpr int CV_P2 = CONV_IN_P2 ? CV_FINE - TL1_N - TL4_N - TL6_N - TL10_N : 0;
constexpr int CV_PER = 32, N_CONV = (CV_P2 + CV_PER - 1) / CV_PER;
__host__ __device__ constexpr int p2_conv_index(int d) {
    return d < TL4_LO - (TL1_LO + TL1_N) ? TL1_LO + TL1_N + d
         : d < (TL4_LO - (TL1_LO + TL1_N)) + (TL6_LO - (TL4_LO + TL4_N)) ? TL4_LO + TL4_N + (d - (TL4_LO - (TL1_LO + TL1_N)))
         : TL6_LO + TL6_N + (d - (TL4_LO - (TL1_LO + TL1_N)) - (TL6_LO - (TL4_LO + TL4_N))); }
static_assert(p2_conv_index(0) == (TL1_LO + TL1_N < TL4_LO ? TL1_LO + TL1_N : TL4_LO + TL4_N) && p2_conv_index(CV_FINE - TL1_N - TL4_N - TL6_N - TL10_N - 1) == (TL6_LO + TL6_N < TL10_LO ? TL10_LO - 1 : TL6_LO - 1), "P2 conversion index map");
struct ConvPtrs { const float *wg, *wu, *wd, *win1, *wo1, *fnorm, *cnorm; };
__device__ __forceinline__ void conv_fine_b2(unsigned char* ws, LAS unsigned* tile, const ConvPtrs P, int it, int lane) {
    int r = it;
    if (r < CV_G) { p0_tr<1, P0_KC, true>(P.wg, DM, DFF, (bf16*)(ws + WS_WGU0), tile, r, lane, P.fnorm); return; } r -= CV_G;
    if (r < CV_G) { p0_tr<2, P0_KC, true>(P.wu, DM, DFF, (bf16*)(ws + WS_WGU0), tile, r, lane, P.fnorm); return; } r -= CV_G;
    if (r < CV_D) { p0_tr<0, P0_KC>(P.wd, DFF, DM, (bf16*)(ws + WS_WD0), tile, r, lane); return; } r -= CV_D;
    if (r < CV_IN1) { p0_tr<0, P0_KC, true>(P.win1, DM, RET_IN, (bf16*)(ws + WS_WIN1), tile, r, lane, P.cnorm); return; } r -= CV_IN1;
    if (r < CV_O1) { p0_tr<0, P0_KC>(P.wo1, RET_VW, DM, (bf16*)(ws + WS_WOUT1), tile, r, lane); return; } r -= CV_O1;
    if (r < CV_G) { p0_tr<1, P0_KC, true>(P.wg + (size_t)DM * DFF, DM, DFF, (bf16*)(ws + WS_WGU1), tile, r, lane, P.fnorm + DM); return; } r -= CV_G;
    if (r < CV_G) { p0_tr<2, P0_KC, true>(P.wu + (size_t)DM * DFF, DM, DFF, (bf16*)(ws + WS_WGU1), tile, r, lane, P.fnorm + DM); return; } r -= CV_G;
    p0_tr<0, P0_KC>(P.wd + (size_t)DFF * DM, DFF, DM, (bf16*)(ws + WS_WD1), tile, r, lane);
}
__device__ __forceinline__ void conv_item(unsigned char* ws, LAS unsigned char* ldsb, ConvPtrs P, int ci, int wave, int lane) {
    LAS unsigned* tile = (LAS unsigned*)(ldsb + wave * 8448);
    for (int k = wave; k < CV_PER; k += NWAVES) { const int d = __builtin_amdgcn_readfirstlane(ci * CV_PER + k); if (d < CV_P2) conv_fine_b2(ws, tile, P, p2_conv_index(d), lane); }
}
__device__ __forceinline__ void tail_conv(Frame& F, const Args& A, int qword, int lo, int n) {
#if CONV_IN_P2
    gu32* q = (gu32*)(F.ws + WS_CTL) + qword;
    const ConvPtrs CP{A.in[20], A.in[21], A.in[22], A.in[16], A.in[18], A.in[19], A.in[15]};
    LAS unsigned* tile = (LAS unsigned*)(F.lds + F.wave * 8448);
    for (;;) {
        if (F.tid == 0) F.MISC[0] = __hip_atomic_fetch_add(q, 1u, RLX_AGENT);
        __syncthreads();
        const int bt = (int)F.MISC[0];
        __syncthreads();
        if (bt * NWAVES >= n) break;
        const int k = __builtin_amdgcn_readfirstlane(bt * NWAVES + F.wave);
        if (k < n) conv_fine_b2(F.ws, tile, CP, lo + k, F.lane);
    }
#endif
}
__device__ __forceinline__ void p0_prologue(Frame& F, const Args& A) {
    const int gw = __builtin_amdgcn_readfirstlane(blockIdx.x * NWAVES + F.wave), NGW = F.G * NWAVES;
    unsigned char* ws = F.ws;
    constexpr int KC = P0_KC; LAS unsigned* tile = (LAS unsigned*)(F.lds + F.wave * 8448);
    constexpr int I_IN0 = 161 * (DM / KC), I_SQ = 64 * (DM / KC), I_BD = 16 * 2;
    constexpr int NITEMS = I_IN0 + I_SQ + 2 * I_BD;
    for (int it = gw; it < NITEMS; it += NGW) {
        int r = it;
        if (r < I_IN0) { p0_tr<0, KC, true>(A.in[3], DM, AB_IN, (bf16*)(ws + WS_WIN0), tile, r, F.lane, A.in[2]); continue; } r -= I_IN0;
        if (r < I_SQ) { p0_tr<0, KC>(A.in[14], DM, DM, (bf16*)(ws + WS_WOUT0), tile, r, F.lane); continue; } r -= I_SQ;
        if (r < I_BD) { const int blk = r >> 1; p0_tr<0, 128>(A.in[7] + (size_t)blk * 16384, 128, 128, (bf16*)(ws + WS_WAT) + (size_t)blk * 16384, tile, r & 1, F.lane); continue; } r -= I_BD;
        { const int blk = r >> 1; p0_tr<0, 128>(A.in[9] + (size_t)blk * 16384, 128, 128, (bf16*)(ws + WS_WXT) + (size_t)blk * 16384, tile, r & 1, F.lane); }
    }
#if !CONV_IN_P2
    { const ConvPtrs CP{A.in[20], A.in[21], A.in[22], A.in[16], A.in[18], A.in[19], A.in[15]};
      for (int it = gw; it < CV_FINE; it += NGW) conv_fine_b2(ws, tile, CP, it, F.lane); }
#endif
    for (int m = gw; m < MP; m += NGW) p0_row(F, A.in[0], A.in[1], m);
}

__device__ __forceinline__ float sigmoidf_fast(float x) { return __builtin_amdgcn_rcpf(1.0f + __expf(-x)); }
__device__ __forceinline__ float gelu_tanh(float g) { const float z = 0.7978845608028654f * (g + 0.044715f * g * g * g); const float e = __expf(2.0f * z); return 0.5f * g * (2.0f - 2.0f * __builtin_amdgcn_rcpf(e + 1.0f)); }

constexpr int LRU_XA = 0, LRU_STRIDE = 272, LRU_XF = 17408, LRU_XF_STRIDE = 132  , LRU_GT = 51200, LRU_YT = 68608;
__device__ __forceinline__ void lru_item(Frame& F, const Args& A, int b, int n) {
    const bf16* z0 = (const bf16*)(F.ws + WS_Z); bf16* y0 = (bf16*)(F.ws + WS_Y0);
    const int tid = F.tid, lane = F.lane, w = F.wave, fr = lane & 15, fq = lane >> 4;
    LAS unsigned char* lds = F.lds;
    LAS float* XF = (LAS float*)(lds + LRU_XF);
    const int c8 = (tid & 15) * 8, r4 = tid >> 4;
    const int ch0 = n * 128 + c8;
    float cw[4][8], cb[8];
#pragma unroll
    for (int e = 0; e < 8; ++e) { cb[e] = A.in[6][ch0 + e];
#pragma unroll
        for (int j = 0; j < 4; ++j) cw[j][e] = A.in[5][j * LRU_W + ch0 + e]; }
    const int dch = n * 128 + 16 * w + fr;
    const float ba = A.in[8][dch], bx = A.in[10][dch];
    const float cneg = -8.0f * log1pf(expf(-A.in[11][dch]));
    bf16x8 bwa[4], bwx[4];
    { const bf16* wat = (const bf16*)(F.ws + WS_WAT) + ((size_t)n * 128 + 16 * w + fr) * 128 + 8 * fq; const bf16* wxt = (const bf16*)(F.ws + WS_WXT) + ((size_t)n * 128 + 16 * w + fr) * 128 + 8 * fq;
#pragma unroll
      for (int ks = 0; ks < 4; ++ks) { bwa[ks] = *(const bf16x8*)(wat + 32 * ks); bwx[ks] = *(const bf16x8*)(wxt + 32 * ks); } }
    float hc = 0.f;
    v4u xr[2][4], gv[2];
#define LRU_LOAD(tau) do { _Pragma("unroll") for (int q = 0; q < 2; ++q) { const int t = 64 * (tau) + r4 + 32 * q - 48; \
            gv[q] = (v4u){0u, 0u, 0u, 0u}; if (t >= 0) gv[q] = *(const GAS v4u*)(z0 + (size_t)row_of(b, t) * AB_Z + LRU_W + ch0); \
            _Pragma("unroll") for (int j = 0; j < 4; ++j) { const int tj = t - 3 + j; xr[q][j] = (v4u){0u, 0u, 0u, 0u}; if (tj >= 0) xr[q][j] = *(const GAS v4u*)(z0 + (size_t)row_of(b, tj) * AB_Z + ch0); } } } while (0)
    LRU_LOAD(0);
    for (int tau = 0; tau < 65; ++tau) {
#pragma unroll
        for (int q = 0; q < 2; ++q) {
            const int rr = r4 + 32 * q;
            float xc[8];
#pragma unroll
            for (int e = 0; e < 8; ++e) xc[e] = cb[e];
#pragma unroll
            for (int j = 0; j < 4; ++j) { float xf[8]; unpack8(xr[q][j], xf);
#pragma unroll
                for (int e = 0; e < 8; ++e) xc[e] += cw[j][e] * xf[e]; }
            *(LAS v4u*)(lds + LRU_XA + rr * LRU_STRIDE + c8 * 2) = pack8f(xc);
            *(LAS f32x4*)(XF + rr * LRU_XF_STRIDE + c8) = (f32x4){xc[0], xc[1], xc[2], xc[3]};
            *(LAS f32x4*)(XF + rr * LRU_XF_STRIDE + c8 + 4) = (f32x4){xc[4], xc[5], xc[6], xc[7]};
            *(LAS v4u*)(lds + LRU_GT + rr * LRU_STRIDE + c8 * 2) = gv[q];
        }
        if (tau < 64) LRU_LOAD(tau + 1);
        __syncthreads();
        f32x4 accr[4], acci[4];
#pragma unroll
        for (int m = 0; m < 4; ++m) { accr[m] = (f32x4){0.f, 0.f, 0.f, 0.f}; acci[m] = (f32x4){0.f, 0.f, 0.f, 0.f}; }
#pragma unroll
        for (int m = 0; m < 4; ++m)
#pragma unroll
            for (int ks = 0; ks < 4; ++ks) { const bf16x8 a = *(const LAS bf16x8*)(lds + LRU_XA + (16 * m + fr) * LRU_STRIDE + (32 * ks + 8 * fq) * 2);
                accr[m] = mfma16(a, bwa[ks], accr[m]); acci[m] = mfma16(a, bwx[ks], acci[m]); }
        const int d = 16 * w + fr;
#pragma unroll
        for (int m = 0; m < 4; ++m) {
            float av[4], bv[4];
#pragma unroll
            for (int g = 0; g < 4; ++g) { const int rr = 16 * m + 4 * fq + g;
                const float rg = sigmoidf_fast(accr[m][g] + ba), ig = sigmoidf_fast(acci[m][g] + bx);
                const float la = cneg * rg; av[g] = __expf(la); const float mult = __builtin_amdgcn_sqrtf(fmaxf(1.0f - __expf(2.0f * la), 0.f));
                bv[g] = mult * (ig * XF[rr * LRU_XF_STRIDE + d]);
                if (tau == 0 && rr < 48) bv[g] = 0.f; }
            float P = av[0] * av[1], H = bv[0] * av[1] + bv[1]; P *= av[2]; H = H * av[2] + bv[2]; P *= av[3]; H = H * av[3] + bv[3];
            { const float P1 = __shfl_up(P, 16), H1 = __shfl_up(H, 16); if (fq >= 1) { H = P * H1 + H; P = P1 * P; } }
            { const float P2 = __shfl_up(P, 32), H2 = __shfl_up(H, 32); if (fq >= 2) { H = P * H2 + H; P = P2 * P; } }
            float Pe = __shfl_up(P, 16), He = __shfl_up(H, 16); if (fq == 0) { Pe = 1.f; He = 0.f; }
            float h = Pe * hc + He;
            float hv[4];
#pragma unroll
            for (int g = 0; g < 4; ++g) { h = av[g] * h + bv[g]; hv[g] = h; }
            hc = __shfl(h, 48 + fr);
#pragma unroll
            for (int g = 0; g < 4; ++g) { const int rr = 16 * m + 4 * fq + g;
                const float gt = bf2f(*(const LAS unsigned short*)(lds + LRU_GT + rr * LRU_STRIDE + d * 2));
                *(LAS unsigned short*)(lds + LRU_YT + rr * LRU_STRIDE + d * 2) = (unsigned short)(pk2(hv[g] * gelu_tanh(gt), 0.f) & 0xffffu); }
        }
        __syncthreads();
#pragma unroll
        for (int q = 0; q < 2; ++q) { const int rr = r4 + 32 * q, t = 64 * tau + rr - 48;
            if (t >= 0) *(GAS v4u*)(y0 + (size_t)row_of(b, t) * DM + ch0) = *(const LAS v4u*)(lds + LRU_YT + rr * LRU_STRIDE + c8 * 2); }
    }
#undef LRU_LOAD
    __syncthreads();
}

constexpr int AT_STRIDE = 272, AT_TILE = 64 * AT_STRIDE, AT_KT = 0, AT_VN = 2 * AT_TILE, AT_RSK = 4 * AT_TILE, AT_CUM = AT_RSK + 512, AT_SCAN = AT_CUM + 4352 * 4;
static_assert(AT_SCAN + 64 <= RING_BYTES, "attention LDS map");
__device__ __forceinline__ float log_sigmoid(float x) { return fminf(x, 0.f) - log1pf(__expf(-fabsf(x))); }
__device__ __forceinline__ void attn_item(Frame& F, const Args& A, int b, int h, int j) {
    const bf16* z0 = (const bf16*)(F.ws + WS_Z); bf16* y0 = (bf16*)(F.ws + WS_Y0); const float* fbuf = (const float*)(F.ws + WS_FBUF);
    const int tid = F.tid, lane = F.lane, w = F.wave, fr = lane & 15, fq = lane >> 4;
    LAS unsigned char* lds = F.lds;
    LAS float* CUM = (LAS float*)(lds + AT_CUM); LAS float* SCAN = (LAS float*)(lds + AT_SCAN); LAS float* RSK = (LAS float*)(lds + AT_RSK);
    constexpr float LOG2E = 1.4426950408889634f;
    const int nT = NMETA + 256 * j;
    { const float bf_h = A.in[4][h];
      float loc[9]; float run = 0.f;
#pragma unroll
      for (int e = 0; e < 9; ++e) { const int t = 9 * tid + e; float v = 0.f; if (t < nT) v = log_sigmoid(fbuf[(size_t)row_of(b, t) * 16 + h] + bf_h); run += v; loc[e] = run; }
      float inc = run;
#pragma unroll
      for (int o = 1; o < 64; o <<= 1) { const float t = __shfl_up(inc, o); if (lane >= o) inc += t; }
      if (lane == 63) SCAN[w] = inc;
      __syncthreads();
      float off = inc - run;
      for (int k = 0; k < w; ++k) off += SCAN[k];
#pragma unroll
      for (int e = 0; e < 9; ++e) { const int t = 9 * tid + e; if (t < nT) CUM[t + 240] = (off + loc[e]) * LOG2E; }
      if (tid < 240) CUM[tid] = 0.f; }
    bf16x8 qf[2][4];
    const int ubase = 256 * j + 32 * w;
#pragma unroll
    for (int m = 0; m < 2; ++m) {
        const int u = ubase + 16 * m + fr; const int t = u - 240; const int r = row_of(b, t < 0 ? 0 : t);
        const bf16* qp = z0 + (size_t)r * AB_Z + 4096 + 128 * h + 8 * fq;
        float qv[4][8]; float s = 0.f;
#pragma unroll
        for (int ks = 0; ks < 4; ++ks) { const v4u raw = *(const GAS v4u*)(qp + 32 * ks); unpack8(raw, qv[ks]);
#pragma unroll
            for (int e = 0; e < 8; ++e) s += qv[ks][e] * qv[ks][e]; }
        s = sum_x32(sum_x16(s));
        const float rs = __builtin_amdgcn_rsqf(s * (1.0f / 128.0f) + RMS_EPS) * (0.08838834764831845f * LOG2E);
#pragma unroll
        for (int ks = 0; ks < 4; ++ks) { float o[8];
#pragma unroll
            for (int e = 0; e < 8; ++e) o[e] = qv[ks][e] * rs * (A.in[12][32 * ks + 8 * fq + e] * A.in[13][32 * ks + 8 * fq + e]);
            const v4u pk = pack8f(o); qf[m][ks] = __builtin_bit_cast(bf16x8, pk); }
    }
    f32x4 O[2][8]; float mrow[2], lrow[2];
#pragma unroll
    for (int m = 0; m < 2; ++m) {
#pragma unroll
        for (int dt = 0; dt < 8; ++dt) O[m][dt] = (f32x4){0.f, 0.f, 0.f, 0.f};
        mrow[m] = -1e30f; lrow[m] = 0.f; }
    const int imax = 4 * j + 3;
    const int skey = tid >> 3, sdc = (tid & 7) * 16;
    const unsigned vbase = (unsigned)(size_t)lds + AT_VN + (4u * fq + ((unsigned)(lane & 15) >> 2)) * AT_STRIDE + 8u * (unsigned)(lane & 3);
    v4u kreg[2], vreg[2];
#define AT_LOAD(i_) do { const int t_ = 64 * (i_) + skey - 240; const int r_ = row_of(b, t_ < 0 ? 0 : t_); const bf16* kp_ = z0 + (size_t)r_ * AB_Z + 6144 + 128 * h + sdc; const bf16* vp_ = z0 + (size_t)r_ * AB_Z + 8192 + 128 * h + sdc; \
        kreg[0] = *(const GAS v4u*)(kp_); kreg[1] = *(const GAS v4u*)(kp_ + 8); vreg[0] = *(const GAS v4u*)(vp_); vreg[1] = *(const GAS v4u*)(vp_ + 8); } while (0)
#define AT_STAGE(buf_) do { float a8_[8], b8_[8]; unpack8(kreg[0], a8_); unpack8(kreg[1], b8_); float s_ = 0.f; \
        _Pragma("unroll") for (int e = 0; e < 8; ++e) s_ += a8_[e] * a8_[e] + b8_[e] * b8_[e]; \
        s_ = oct_sum(s_); \
        if ((tid & 7) == 0) RSK[(buf_) * 64 + skey] = __builtin_amdgcn_rsqf(s_ * (1.0f / 128.0f) + RMS_EPS); \
        *(LAS v4u*)(lds + AT_KT + (buf_) * AT_TILE + skey * AT_STRIDE + sdc * 2) = kreg[0]; *(LAS v4u*)(lds + AT_KT + (buf_) * AT_TILE + skey * AT_STRIDE + sdc * 2 + 16) = kreg[1]; \
        *(LAS v4u*)(lds + AT_VN + (buf_) * AT_TILE + skey * AT_STRIDE + sdc * 2) = vreg[0]; *(LAS v4u*)(lds + AT_VN + (buf_) * AT_TILE + skey * AT_STRIDE + sdc * 2 + 16) = vreg[1]; } while (0)
    AT_LOAD(3); AT_STAGE(1);
    if (imax > 3) AT_LOAD(4);
    __syncthreads();
    float bq[2];
#pragma unroll
    for (int m = 0; m < 2; ++m) bq[m] = CUM[ubase + 16 * m + fr];
#ifdef PROBE_ATT_A
    unsigned long long atm_t0 = 0, atm_acc = 0;
#define ATM(n) do { if ((n) == PROBE_ATT_A) atm_t0 = __builtin_amdgcn_s_memrealtime(); if ((n) == PROBE_ATT_B) atm_acc += __builtin_amdgcn_s_memrealtime() - atm_t0; } while (0)
#else
#define ATM(n) do { } while (0)
#endif
    for (int i = 3; i <= imax; ++i) {
        const int buf = i & 1;
        ATM(0);
        if (i < imax) { AT_STAGE(buf ^ 1); if (i + 1 < imax) AT_LOAD(i + 2); }
        ATM(1);
        if (64 * i <= ubase + 31) {
            f32x4 S[2][4];
#pragma unroll
            for (int m = 0; m < 2; ++m)
#pragma unroll
                for (int nt = 0; nt < 4; ++nt) S[m][nt] = (f32x4){0.f, 0.f, 0.f, 0.f};
#pragma unroll
            for (int nt = 0; nt < 4; ++nt)
#pragma unroll
                for (int ks = 0; ks < 4; ++ks) { const bf16x8 kf = *(const LAS bf16x8*)(lds + AT_KT + buf * AT_TILE + (16 * nt + fr) * AT_STRIDE + (32 * ks + 8 * fq) * 2);
                    S[0][nt] = mfma16(kf, qf[0][ks], S[0][nt]); S[1][nt] = mfma16(kf, qf[1][ks], S[1][nt]); }
            ATM(2);
            const bool need_mask = (i == 3) || (64 * i + 63 > ubase);
            bf16x8 pb[2][2];
#pragma unroll
            for (int m = 0; m < 2; ++m) {
                const int uq = ubase + 16 * m + fr;
                float mx = -__builtin_inff();
#pragma unroll
                for (int nt = 0; nt < 4; ++nt) { const f32x4 bkv = *(const LAS f32x4*)(CUM + 64 * i + 16 * nt + 4 * fq), rkv = *(const LAS f32x4*)(RSK + buf * 64 + 16 * nt + 4 * fq);
#pragma unroll
                    for (int g = 0; g < 4; ++g) S[m][nt][g] = S[m][nt][g] * rkv[g] + (bq[m] - bkv[g]); }
                if (need_mask) {
#pragma unroll
                    for (int nt = 0; nt < 4; ++nt)
#pragma unroll
                        for (int g = 0; g < 4; ++g) { const int uk = 64 * i + 16 * nt + 4 * fq + g; if (uk > uq || uk < 240) S[m][nt][g] = -__builtin_inff(); }
                    asm volatile("" ::: "memory"); }
#pragma unroll
                for (int nt = 0; nt < 4; ++nt)
#pragma unroll
                    for (int g = 0; g < 4; ++g) mx = fmaxf(mx, S[m][nt][g]);
                mx = max_x32(max_x16(mx));
                const float mn = fmaxf(mrow[m], mx);
                const float alpha = __builtin_amdgcn_exp2f(mrow[m] - mn); mrow[m] = mn;
                float ps = 0.f;
#pragma unroll
                for (int nt = 0; nt < 4; ++nt)
#pragma unroll
                    for (int g = 0; g < 4; ++g) { const float p = __builtin_amdgcn_exp2f(S[m][nt][g] - mn); ps += p; S[m][nt][g] = p; }
                lrow[m] = lrow[m] * alpha + ps;
                if (!__all(alpha == 1.0f)) {
#pragma unroll
                    for (int dt = 0; dt < 8; ++dt) O[m][dt] *= alpha; }
#pragma unroll
                for (int k2 = 0; k2 < 2; ++k2) { v4u pw; pw.x = pk2(S[m][2 * k2][0], S[m][2 * k2][1]); pw.y = pk2(S[m][2 * k2][2], S[m][2 * k2][3]); pw.z = pk2(S[m][2 * k2 + 1][0], S[m][2 * k2 + 1][1]); pw.w = pk2(S[m][2 * k2 + 1][2], S[m][2 * k2 + 1][3]);
                    pb[m][k2] = __builtin_bit_cast(bf16x8, pw); }
            }
            ATM(3);
            const unsigned vb = vbase + (unsigned)(buf * AT_TILE);
            { v2u vp[16]; asm volatile("ds_read_b64_tr_b16 %0, %16 offset:0 \n\tds_read_b64_tr_b16 %1, %16 offset:4352 \n\tds_read_b64_tr_b16 %2, %16 offset:8704 \n\tds_read_b64_tr_b16 %3, %16 offset:13056 \n\tds_read_b64_tr_b16 %4, %16 offset:32 \n\tds_read_b64_tr_b16 %5, %16 offset:4384 \n\tds_read_b64_tr_b16 %6, %16 offset:8736 \n\tds_read_b64_tr_b16 %7, %16 offset:13088 \n\tds_read_b64_tr_b16 %8, %16 offset:64 \n\tds_read_b64_tr_b16 %9, %16 offset:4416 \n\tds_read_b64_tr_b16 %10, %16 offset:8768 \n\tds_read_b64_tr_b16 %11, %16 offset:13120 \n\tds_read_b64_tr_b16 %12, %16 offset:96 \n\tds_read_b64_tr_b16 %13, %16 offset:4448 \n\tds_read_b64_tr_b16 %14, %16 offset:8800 \n\tds_read_b64_tr_b16 %15, %16 offset:13152 \n\ts_waitcnt lgkmcnt(0)" : "=&v"(vp[0]), "=&v"(vp[1]), "=&v"(vp[2]), "=&v"(vp[3]), "=&v"(vp[4]), "=&v"(vp[5]), "=&v"(vp[6]), "=&v"(vp[7]), "=&v"(vp[8]), "=&v"(vp[9]), "=&v"(vp[10]), "=&v"(vp[11]), "=&v"(vp[12]), "=&v"(vp[13]), "=&v"(vp[14]), "=&v"(vp[15]) : "v"(vb) : "memory");
              { v4u aw; aw.x = vp[0].x; aw.y = vp[0].y; aw.z = vp[1].x; aw.w = vp[1].y; const bf16x8 vfr = __builtin_bit_cast(bf16x8, aw); O[0][0] = mfma16(vfr, pb[0][0], O[0][0]); O[1][0] = mfma16(vfr, pb[1][0], O[1][0]); }
              { v4u aw; aw.x = vp[2].x; aw.y = vp[2].y; aw.z = vp[3].x; aw.w = vp[3].y; const bf16x8 vfr = __builtin_bit_cast(bf16x8, aw); O[0][0] = mfma16(vfr, pb[0][1], O[0][0]); O[1][0] = mfma16(vfr, pb[1][1], O[1][0]); }
              { v4u aw; aw.x = vp[4].x; aw.y = vp[4].y; aw.z = vp[5].x; aw.w = vp[5].y; const bf16x8 vfr = __builtin_bit_cast(bf16x8, aw); O[0][1] = mfma16(vfr, pb[0][0], O[0][1]); O[1][1] = mfma16(vfr, pb[1][0], O[1][1]); }
              { v4u aw; aw.x = vp[6].x; aw.y = vp[6].y; aw.z = vp[7].x; aw.w = vp[7].y; const bf16x8 vfr = __builtin_bit_cast(bf16x8, aw); O[0][1] = mfma16(vfr, pb[0][1], O[0][1]); O[1][1] = mfma16(vfr, pb[1][1], O[1][1]); }
              { v4u aw; aw.x = vp[8].x; aw.y = vp[8].y; aw.z = vp[9].x; aw.w = vp[9].y; const bf16x8 vfr = __builtin_bit_cast(bf16x8, aw); O[0][2] = mfma16(vfr, pb[0][0], O[0][2]); O[1][2] = mfma16(vfr, pb[1][0], O[1][2]); }
              { v4u aw; aw.x = vp[10].x; aw.y = vp[10].y; aw.z = vp[11].x; aw.w = vp[11].y; const bf16x8 vfr = __builtin_bit_cast(bf16x8, aw); O[0][2] = mfma16(vfr, pb[0][1], O[0][2]); O[1][2] = mfma16(vfr, pb[1][1], O[1][2]); }
              { v4u aw; aw.x = vp[12].x; aw.y = vp[12].y; aw.z = vp[13].x; aw.w = vp[13].y; const bf16x8 vfr = __builtin_bit_cast(bf16x8, aw); O[0][3] = mfma16(vfr, pb[0][0], O[0][3]); O[1][3] = mfma16(vfr, pb[1][0], O[1][3]); }
              { v4u aw; aw.x = vp[14].x; aw.y = vp[14].y; aw.z = vp[15].x; aw.w = vp[15].y; const bf16x8 vfr = __builtin_bit_cast(bf16x8, aw); O[0][3] = mfma16(vfr, pb[0][1], O[0][3]); O[1][3] = mfma16(vfr, pb[1][1], O[1][3]); }
            }
            { v2u vp[16]; asm volatile("ds_read_b64_tr_b16 %0, %16 offset:128 \n\tds_read_b64_tr_b16 %1, %16 offset:4480 \n\tds_read_b64_tr_b16 %2, %16 offset:8832 \n\tds_read_b64_tr_b16 %3, %16 offset:13184 \n\tds_read_b64_tr_b16 %4, %16 offset:160 \n\tds_read_b64_tr_b16 %5, %16 offset:4512 \n\tds_read_b64_tr_b16 %6, %16 offset:8864 \n\tds_read_b64_tr_b16 %7, %16 offset:13216 \n\tds_read_b64_tr_b16 %8, %16 offset:192 \n\tds_read_b64_tr_b16 %9, %16 offset:4544 \n\tds_read_b64_tr_b16 %10, %16 offset:8896 \n\tds_read_b64_tr_b16 %11, %16 offset:13248 \n\tds_read_b64_tr_b16 %12, %16 offset:224 \n\tds_read_b64_tr_b16 %13, %16 offset:4576 \n\tds_read_b64_tr_b16 %14, %16 offset:8928 \n\tds_read_b64_tr_b16 %15, %16 offset:13280 \n\ts_waitcnt lgkmcnt(0)" : "=&v"(vp[0]), "=&v"(vp[1]), "=&v"(vp[2]), "=&v"(vp[3]), "=&v"(vp[4]), "=&v"(vp[5]), "=&v"(vp[6]), "=&v"(vp[7]), "=&v"(vp[8]), "=&v"(vp[9]), "=&v"(vp[10]), "=&v"(vp[11]), "=&v"(vp[12]), "=&v"(vp[13]), "=&v"(vp[14]), "=&v"(vp[15]) : "v"(vb) : "memory");
              { v4u aw; aw.x = vp[0].x; aw.y = vp[0].y; aw.z = vp[1].x; aw.w = vp[1].y; const bf16x8 vfr = __builtin_bit_cast(bf16x8, aw); O[0][4] = mfma16(vfr, pb[0][0], O[0][4]); O[1][4] = mfma16(vfr, pb[1][0], O[1][4]); }
              { v4u aw; aw.x = vp[2].x; aw.y = vp[2].y; aw.z = vp[3].x; aw.w = vp[3].y; const bf16x8 vfr = __builtin_bit_cast(bf16x8, aw); O[0][4] = mfma16(vfr, pb[0][1], O[0][4]); O[1][4] = mfma16(vfr, pb[1][1], O[1][4]); }
              { v4u aw; aw.x = vp[4].x; aw.y = vp[4].y; aw.z = vp[5].x; aw.w = vp[5].y; const bf16x8 vfr = __builtin_bit_cast(bf16x8, aw); O[0][5] = mfma16(vfr, pb[0][0], O[0][5]); O[1][5] = mfma16(vfr, pb[1][0], O[1][5]); }
              { v4u aw; aw.x = vp[6].x; aw.y = vp[6].y; aw.z = vp[7].x; aw.w = vp[7].y; const bf16x8 vfr = __builtin_bit_cast(bf16x8, aw); O[0][5] = mfma16(vfr, pb[0][1], O[0][5]); O[1][5] = mfma16(vfr, pb[1][1], O[1][5]); }
              { v4u aw; aw.x = vp[8].x; aw.y = vp[8].y; aw.z = vp[9].x; aw.w = vp[9].y; const bf16x8 vfr = __builtin_bit_cast(bf16x8, aw); O[0][6] = mfma16(vfr, pb[0][0], O[0][6]); O[1][6] = mfma16(vfr, pb[1][0], O[1][6]); }
              { v4u aw; aw.x = vp[10].x; aw.y = vp[10].y; aw.z = vp[11].x; aw.w = vp[11].y; const bf16x8 vfr = __builtin_bit_cast(bf16x8, aw); O[0][6] = mfma16(vfr, pb[0][1], O[0][6]); O[1][6] = mfma16(vfr, pb[1][1], O[1][6]); }
              { v4u aw; aw.x = vp[12].x; aw.y = vp[12].y; aw.z = vp[13].x; aw.w = vp[13].y; const bf16x8 vfr = __builtin_bit_cast(bf16x8, aw); O[0][7] = mfma16(vfr, pb[0][0], O[0][7]); O[1][7] = mfma16(vfr, pb[1][0], O[1][7]); }
              { v4u aw; aw.x = vp[14].x; aw.y = vp[14].y; aw.z = vp[15].x; aw.w = vp[15].y; const bf16x8 vfr = __builtin_bit_cast(bf16x8, aw); O[0][7] = mfma16(vfr, pb[0][1], O[0][7]); O[1][7] = mfma16(vfr, pb[1][1], O[1][7]); }
            }
        }
        ATM(4);
        __syncthreads();
        ATM(5);
    }
#ifdef PROBE_ATT_A
    if (w == 0 && lane == 0 && blockIdx.x == 0) { const unsigned long long a_ = (((unsigned long long)F.MISC[23] << 32) | F.MISC[22]) + atm_acc; F.MISC[22] = (unsigned)a_; F.MISC[23] = (unsigned)(a_ >> 32); }
#endif
#undef ATM
#undef AT_LOAD
#undef AT_STAGE
#pragma unroll
    for (int m = 0; m < 2; ++m) {
        float l = sum_x32(sum_x16(lrow[m]));
        const int t = ubase + 16 * m + fr - 240;
        if (t >= 0) { const float il = __builtin_amdgcn_rcpf(l); bf16* op = y0 + (size_t)row_of(b, t) * DM + LRU_W + 128 * h + 4 * fq;
#pragma unroll
            for (int dt = 0; dt < 8; ++dt) { v2u o; o.x = pk2(O[m][dt][0] * il, O[m][dt][1] * il); o.y = pk2(O[m][dt][2] * il, O[m][dt][3] * il); *(GAS v2u*)(op + 16 * dt) = o; } }
    }
}

__device__ __forceinline__ int p2_fetch(Frame& F, gu32* qctr) {
    if ((F.wave == 0 && hw_lane() == 0)) F.MISC[0] = __hip_atomic_fetch_add(qctr, 1u, RLX_AGENT);
    __syncthreads();
    const int item = (int)F.MISC[0];
    __syncthreads();
    return item;
}
#ifndef CONV_CAP
#define CONV_CAP 96
#endif
__device__ __forceinline__ int p2_next(Frame& F, gu32* qa, gu32* qc, gu32* act, int nconv, int qa_end, int pending) {
    if ((F.wave == 0 && hw_lane() == 0)) {
        int code = -1;
        bool done_att = F.MISC[3] != 0u;
        if (!done_att) {
            if (pending >= 0) { if (pending < qa_end) code = pending; else done_att = true; }
            else {
                if ((int)__hip_atomic_load(qc, RLX_AGENT) < nconv && (int)__hip_atomic_load(act, RLX_AGENT) < CONV_CAP) {
                    const int a = (int)__hip_atomic_fetch_add(act, 1u, RLX_AGENT);
                    if (a < CONV_CAP) { const int c = (int)__hip_atomic_fetch_add(qc, 1u, RLX_AGENT); if (c < nconv) code = -3 - c; }
                    if (code == -1) (void)__hip_atomic_fetch_add(act, 0xFFFFFFFFu, RLX_AGENT); }
                if (code == -1) { const int t = (int)__hip_atomic_fetch_add(qa, 1u, RLX_AGENT); if (t < qa_end) code = t; else done_att = true; } } }
        if (code == -1) { const int c = (int)__hip_atomic_fetch_add(qc, 1u, RLX_AGENT); if (c < nconv) { code = -3 - c; (void)__hip_atomic_fetch_add(act, 1u, RLX_AGENT); } else code = -2; }
        F.MISC[3] = done_att ? 1u : 0u; F.MISC[0] = (unsigned)code; }
    __syncthreads();
    const int code = (int)F.MISC[0];
    __syncthreads();
    return code;
}
__device__ __forceinline__ void p2_mixer0(Frame& F, const Args& A, int rep) {
    gu32* ctl = (gu32*)(F.ws + WS_CTL);
    gu32* qa = ctl + CW_Q2 + 64 * rep; gu32* qc = ctl + CW_QC + 64 * rep; gu32* act = ctl + CW_ACT + 64 * rep;
    constexpr int N_LRU = NB * 16, N_ATT = NB * FOX_H * 17;
    const int nconv = (rep == 0) ? N_CONV : 0;
    if ((F.wave == 0 && hw_lane() == 0)) F.MISC[3] = 0u;
    int item = p2_fetch(F, qa);
    while (item < N_LRU) { lru_item(F, A, item >> 4, item & 15); item = p2_fetch(F, qa); }
    int code = p2_next(F, qa, qc, act, nconv, N_LRU + N_ATT, item);
    while (code != -2) {
        Frame G = F; { const int ln = hw_lane(); G.lane = ln; G.tid = F.wave * 64 + ln; G.wave = F.wave; }
        if (code >= 0) { const int a = code - N_LRU; const int j = 16 - a / 64, bh = a % 64; attn_item(G, A, bh >> 4, bh & 15, j); }
        else { const ConvPtrs CP{A.in[20], A.in[21], A.in[22], A.in[16], A.in[18], A.in[19], A.in[15]}; conv_item(G.ws, G.lds, CP, -3 - code, G.wave, G.lane);
            __syncthreads(); if ((F.wave == 0 && hw_lane() == 0)) (void)__hip_atomic_fetch_add(act, 0xFFFFFFFFu, RLX_AGENT); }
        code = p2_next(F, qa, qc, act, nconv, N_LRU + N_ATT, -1);
    }
}

constexpr int RT_SQ = 528, RT_SV = 272, RT_SS_STRIDE = 144;
constexpr int RT_QS = 0, RT_KN = 33792, RT_VN = 67584, RT_VS = 84992, RT_SS = 102400, RT_OB = 111616, RT_OB_STRIDE = 272;
static_assert(RT_KN == 64 * RT_SQ && RT_VN == RT_KN + 64 * RT_SQ && RT_VS == RT_VN + 64 * RT_SV && RT_SS == RT_VS + 64 * RT_SV && RT_OB == RT_SS + 64 * RT_SS_STRIDE && RT_OB + 64 * RT_OB_STRIDE <= MISC_OFF, "retention LDS map");
__device__ __forceinline__ int ret_row(int b, int c, int idx) { return c == 0 ? (idx < 48 ? -1 : MMETA + NMETA * b + (idx - 48)) : b * SEQ + 64 * (c - 1) + idx; }
__device__ __forceinline__ void ret_item(Frame& F, const Args& A, int b, int h, int es, bool accum) {
    const bf16* z1 = (const bf16*)(F.ws + WS_Z); bf16* ob = (bf16*)(F.ws + WS_Y1); u64* ssqo = (u64*)(F.ws + WS_SSQO);
    const int tid = F.tid, lane = F.lane, w = F.wave, fr = lane & 15, fq = lane >> 4;
    LAS unsigned char* lds = F.lds;
    const float lg = log1pf(-exp2f(-5.0f - (float)h)) * 1.4426950408889634f;
    const float cdec = __builtin_amdgcn_exp2f(lg * 64.0f);
    f32x4 Sacc[16];
#pragma unroll
    for (int dt = 0; dt < 16; ++dt) Sacc[dt] = (f32x4){0.f, 0.f, 0.f, 0.f};
    const int qrow = tid >> 5, qd = (tid & 31) * 8;
    const int vrow = tid >> 4, ve = (tid & 15) * 8;
    const float kd0 = __builtin_amdgcn_exp2f(lg * (float)(63 - vrow)), kd1 = __builtin_amdgcn_exp2f(lg * (float)(31 - vrow));
    const unsigned lbase = (unsigned)(size_t)lds;
    const unsigned trq = (unsigned)((lane & 15) >> 2), trp = (unsigned)(lane & 3);
    const unsigned kbase = lbase + RT_KN + (8u * fq + trq) * RT_SQ + 8u * trp;
    const unsigned vbase = lbase + RT_VN + (8u * fq + trq) * RT_SV + 32u * w + 8u * trp;
    const unsigned vsbase = vbase + (RT_VS - RT_VN);
    v4u qreg[4], kreg[4], vreg[2];
    const size_t qcol = (size_t)h * RET_QK + qd, kcol = 4096 + (size_t)h * RET_QK + qd, vcol = 8192 + (size_t)h * RET_V + 128 * es + ve;
#define RT_PREFETCH(c) do { \
        _Pragma("unroll") for (int k = 0; k < 4; ++k) { const int r = ret_row(b, (c), qrow + 16 * k); \
            if (r >= 0) { qreg[k] = *(const GAS v4u*)(z1 + (size_t)r * RET_IN + qcol); kreg[k] = *(const GAS v4u*)(z1 + (size_t)r * RET_IN + kcol); } \
            else { qreg[k] = (v4u){0u, 0u, 0u, 0u}; kreg[k] = (v4u){0u, 0u, 0u, 0u}; } } \
        _Pragma("unroll") for (int k = 0; k < 2; ++k) { const int r = ret_row(b, (c), vrow + 32 * k); \
            if (r >= 0) vreg[k] = *(const GAS v4u*)(z1 + (size_t)r * RET_IN + vcol); else vreg[k] = (v4u){0u, 0u, 0u, 0u}; } } while (0)
    RT_PREFETCH(0);
#define RT_BAR() do { asm volatile("s_waitcnt lgkmcnt(0)" ::: "memory"); __builtin_amdgcn_s_barrier(); asm volatile("" ::: "memory"); } while (0)
#define RT_FLUSH(cc) do { const int row_ = tid >> 3, seg_ = tid & 7; const LAS unsigned char* sp_ = lds + RT_OB + row_ * RT_OB_STRIDE + seg_ * 32; \
        const v4u o0_ = *(const LAS v4u*)(sp_), o1_ = *(const LAS v4u*)(sp_ + 16); \
        bf16* dp_ = ob + (size_t)(b * SEQ + 64 * ((cc) - 1) + row_) * RET_VW + h * RET_V + 128 * es + 16 * seg_; \
        *(GAS v4u*)(dp_) = o0_; *(GAS v4u*)(dp_ + 8) = o1_; } while (0)
#ifdef PROBE_ATT_A
    unsigned long long rtm_t0 = 0, rtm_acc = 0;
#define RTM(n) do { if ((n) + 100 == PROBE_ATT_A) rtm_t0 = __builtin_amdgcn_s_memrealtime(); if ((n) + 100 == PROBE_ATT_B) rtm_acc += __builtin_amdgcn_s_memrealtime() - rtm_t0; } while (0)
#else
#define RTM(n) do { } while (0)
#endif
    for (int c = 0; c < 65; ++c) {
        RTM(0);
        RT_BAR();
        RTM(1);
#pragma unroll
        for (int k = 0; k < 4; ++k) { const int m = qrow + 16 * k;
            *(LAS v4u*)(lds + RT_QS + m * RT_SQ + qd * 2) = qreg[k];
            *(LAS v4u*)(lds + RT_KN + m * RT_SQ + qd * 2) = kreg[k]; }
#pragma unroll
        for (int k = 0; k < 2; ++k) { const int m = vrow + 32 * k; float vf8[8]; unpack8(vreg[k], vf8); const float kd = k == 0 ? kd0 : kd1;
            *(LAS v4u*)(lds + RT_VN + m * RT_SV + ve * 2) = vreg[k];
#pragma unroll
            for (int e = 0; e < 8; ++e) vf8[e] *= kd;
            *(LAS v4u*)(lds + RT_VS + m * RT_SV + ve * 2) = pack8f(vf8); }
        RTM(15);
        RT_BAR();
        if (c < 64) RT_PREFETCH(c + 1);
        if (c >= 2) RT_FLUSH(c - 1);
        RTM(2);
        { const int it = w >> 1, mt0 = 2 * (w & 1);
          f32x4 sacc[2] = {(f32x4){0.f, 0.f, 0.f, 0.f}, (f32x4){0.f, 0.f, 0.f, 0.f}};
#pragma unroll
          for (int ks = 0; ks < 8; ++ks) { const bf16x8 a = *(const LAS bf16x8*)(lds + RT_QS + (16 * it + fr) * RT_SQ + (32 * ks + 8 * fq) * 2);
#pragma unroll
              for (int q = 0; q < 2; ++q) { const bf16x8 kb = *(const LAS bf16x8*)(lds + RT_KN + (16 * (mt0 + q) + fr) * RT_SQ + (32 * ks + 8 * fq) * 2); sacc[q] = mfma16(a, kb, sacc[q]); } }
#pragma unroll
          for (int q = 0; q < 2; ++q)
#pragma unroll
              for (int g = 0; g < 4; ++g) { const int i = 16 * it + 4 * fq + g, m = 16 * (mt0 + q) + fr; const int dd = i > m ? i - m : m - i;
                  const float sv = sacc[q][g] * __builtin_amdgcn_exp2f(lg * (float)dd);
                  *(LAS unsigned short*)(lds + RT_SS + i * RT_SS_STRIDE + m * 2) = (unsigned short)(pk2(sv, 0.f) & 0xffffu); } }
        RTM(3);
        RT_BAR();
        RTM(4);
        f32x4 acc[4];
#pragma unroll
        for (int mi = 0; mi < 4; ++mi) acc[mi] = (f32x4){0.f, 0.f, 0.f, 0.f};
        const unsigned qbase = lbase + RT_QS + (unsigned)fr * RT_SQ + 8u * (unsigned)fq;
        { v4u bw; bw.x = pk2(Sacc[0][0], Sacc[0][1]); bw.y = pk2(Sacc[0][2], Sacc[0][3]); bw.z = pk2(Sacc[1][0], Sacc[1][1]); bw.w = pk2(Sacc[1][2], Sacc[1][3]);
          const bf16x8 bfrag = __builtin_bit_cast(bf16x8, bw); v2u qq[8];
          asm volatile("ds_read_b64 %0, %8 offset:0 \n\tds_read_b64 %1, %8 offset:32 \n\tds_read_b64 %2, %8 offset:8448 \n\tds_read_b64 %3, %8 offset:8480 \n\tds_read_b64 %4, %8 offset:16896 \n\tds_read_b64 %5, %8 offset:16928 \n\tds_read_b64 %6, %8 offset:25344 \n\tds_read_b64 %7, %8 offset:25376 \n\ts_waitcnt lgkmcnt(0)" : "=&v"(qq[0]), "=&v"(qq[1]), "=&v"(qq[2]), "=&v"(qq[3]), "=&v"(qq[4]), "=&v"(qq[5]), "=&v"(qq[6]), "=&v"(qq[7]) : "v"(qbase) : "memory");
          { v4u aw; aw.x = qq[0].x; aw.y = qq[0].y; aw.z = qq[1].x; aw.w = qq[1].y; acc[0] = mfma16(__builtin_bit_cast(bf16x8, aw), bfrag, acc[0]); }
          { v4u aw; aw.x = qq[2].x; aw.y = qq[2].y; aw.z = qq[3].x; aw.w = qq[3].y; acc[1] = mfma16(__builtin_bit_cast(bf16x8, aw), bfrag, acc[1]); }
          { v4u aw; aw.x = qq[4].x; aw.y = qq[4].y; aw.z = qq[5].x; aw.w = qq[5].y; acc[2] = mfma16(__builtin_bit_cast(bf16x8, aw), bfrag, acc[2]); }
          { v4u aw; aw.x = qq[6].x; aw.y = qq[6].y; aw.z = qq[7].x; aw.w = qq[7].y; acc[3] = mfma16(__builtin_bit_cast(bf16x8, aw), bfrag, acc[3]); }
        }
        { v4u bw; bw.x = pk2(Sacc[2][0], Sacc[2][1]); bw.y = pk2(Sacc[2][2], Sacc[2][3]); bw.z = pk2(Sacc[3][0], Sacc[3][1]); bw.w = pk2(Sacc[3][2], Sacc[3][3]);
          const bf16x8 bfrag = __builtin_bit_cast(bf16x8, bw); v2u qq[8];
          asm volatile("ds_read_b64 %0, %8 offset:64 \n\tds_read_b64 %1, %8 offset:96 \n\tds_read_b64 %2, %8 offset:8512 \n\tds_read_b64 %3, %8 offset:8544 \n\tds_read_b64 %4, %8 offset:16960 \n\tds_read_b64 %5, %8 offset:16992 \n\tds_read_b64 %6, %8 offset:25408 \n\tds_read_b64 %7, %8 offset:25440 \n\ts_waitcnt lgkmcnt(0)" : "=&v"(qq[0]), "=&v"(qq[1]), "=&v"(qq[2]), "=&v"(qq[3]), "=&v"(qq[4]), "=&v"(qq[5]), "=&v"(qq[6]), "=&v"(qq[7]) : "v"(qbase) : "memory");
          { v4u aw; aw.x = qq[0].x; aw.y = qq[0].y; aw.z = qq[1].x; aw.w = qq[1].y; acc[0] = mfma16(__builtin_bit_cast(bf16x8, aw), bfrag, acc[0]); }
          { v4u aw; aw.x = qq[2].x; aw.y = qq[2].y; aw.z = qq[3].x; aw.w = qq[3].y; acc[1] = mfma16(__builtin_bit_cast(bf16x8, aw), bfrag, acc[1]); }
          { v4u aw; aw.x = qq[4].x; aw.y = qq[4].y; aw.z = qq[5].x; aw.w = qq[5].y; acc[2] = mfma16(__builtin_bit_cast(bf16x8, aw), bfrag, acc[2]); }
          { v4u aw; aw.x = qq[6].x; aw.y = qq[6].y; aw.z = qq[7].x; aw.w = qq[7].y; acc[3] = mfma16(__builtin_bit_cast(bf16x8, aw), bfrag, acc[3]); }
        }
        { v4u bw; bw.x = pk2(Sacc[4][0], Sacc[4][1]); bw.y = pk2(Sacc[4][2], Sacc[4][3]); bw.z = pk2(Sacc[5][0], Sacc[5][1]); bw.w = pk2(Sacc[5][2], Sacc[5][3]);
          const bf16x8 bfrag = __builtin_bit_cast(bf16x8, bw); v2u qq[8];
          asm volatile("ds_read_b64 %0, %8 offset:128 \n\tds_read_b64 %1, %8 offset:160 \n\tds_read_b64 %2, %8 offset:8576 \n\tds_read_b64 %3, %8 offset:8608 \n\tds_read_b64 %4, %8 offset:17024 \n\tds_read_b64 %5, %8 offset:17056 \n\tds_read_b64 %6, %8 offset:25472 \n\tds_read_b64 %7, %8 offset:25504 \n\ts_waitcnt lgkmcnt(0)" : "=&v"(qq[0]), "=&v"(qq[1]), "=&v"(qq[2]), "=&v"(qq[3]), "=&v"(qq[4]), "=&v"(qq[5]), "=&v"(qq[6]), "=&v"(qq[7]) : "v"(qbase) : "memory");
          { v4u aw; aw.x = qq[0].x; aw.y = qq[0].y; aw.z = qq[1].x; aw.w = qq[1].y; acc[0] = mfma16(__builtin_bit_cast(bf16x8, aw), bfrag, acc[0]); }
          { v4u aw; aw.x = qq[2].x; aw.y = qq[2].y; aw.z = qq[3].x; aw.w = qq[3].y; acc[1] = mfma16(__builtin_bit_cast(bf16x8, aw), bfrag, acc[1]); }
          { v4u aw; aw.x = qq[4].x; aw.y = qq[4].y; aw.z = qq[5].x; aw.w = qq[5].y; acc[2] = mfma16(__builtin_bit_cast(bf16x8, aw), bfrag, acc[2]); }
          { v4u aw; aw.x = qq[6].x; aw.y = qq[6].y; aw.z = qq[7].x; aw.w = qq[7].y; acc[3] = mfma16(__builtin_bit_cast(bf16x8, aw), bfrag, acc[3]); }
        }
        { v4u bw; bw.x = pk2(Sacc[6][0], Sacc[6][1]); bw.y = pk2(Sacc[6][2], Sacc[6][3]); bw.z = pk2(Sacc[7][0], Sacc[7][1]); bw.w = pk2(Sacc[7][2], Sacc[7][3]);
          const bf16x8 bfrag = __builtin_bit_cast(bf16x8, bw); v2u qq[8];
          asm volatile("ds_read_b64 %0, %8 offset:192 \n\tds_read_b64 %1, %8 offset:224 \n\tds_read_b64 %2, %8 offset:8640 \n\tds_read_b64 %3, %8 offset:8672 \n\tds_read_b64 %4, %8 offset:17088 \n\tds_read_b64 %5, %8 offset:17120 \n\tds_read_b64 %6, %8 offset:25536 \n\tds_read_b64 %7, %8 offset:25568 \n\ts_waitcnt lgkmcnt(0)" : "=&v"(qq[0]), "=&v"(qq[1]), "=&v"(qq[2]), "=&v"(qq[3]), "=&v"(qq[4]), "=&v"(qq[5]), "=&v"(qq[6]), "=&v"(qq[7]) : "v"(qbase) : "memory");
          { v4u aw; aw.x = qq[0].x; aw.y = qq[0].y; aw.z = qq[1].x; aw.w = qq[1].y; acc[0] = mfma16(__builtin_bit_cast(bf16x8, aw), bfrag, acc[0]); }
          { v4u aw; aw.x = qq[2].x; aw.y = qq[2].y; aw.z = qq[3].x; aw.w = qq[3].y; acc[1] = mfma16(__builtin_bit_cast(bf16x8, aw), bfrag, acc[1]); }
          { v4u aw; aw.x = qq[4].x; aw.y = qq[4].y; aw.z = qq[5].x; aw.w = qq[5].y; acc[2] = mfma16(__builtin_bit_cast(bf16x8, aw), bfrag, acc[2]); }
          { v4u aw; aw.x = qq[6].x; aw.y = qq[6].y; aw.z = qq[7].x; aw.w = qq[7].y; acc[3] = mfma16(__builtin_bit_cast(bf16x8, aw), bfrag, acc[3]); }
        }
        { v4u bw; bw.x = pk2(Sacc[8][0], Sacc[8][1]); bw.y = pk2(Sacc[8][2], Sacc[8][3]); bw.z = pk2(Sacc[9][0], Sacc[9][1]); bw.w = pk2(Sacc[9][2], Sacc[9][3]);
          const bf16x8 bfrag = __builtin_bit_cast(bf16x8, bw); v2u qq[8];
          asm volatile("ds_read_b64 %0, %8 offset:256 \n\tds_read_b64 %1, %8 offset:288 \n\tds_read_b64 %2, %8 offset:8704 \n\tds_read_b64 %3, %8 offset:8736 \n\tds_read_b64 %4, %8 offset:17152 \n\tds_read_b64 %5, %8 offset:17184 \n\tds_read_b64 %6, %8 offset:25600 \n\tds_read_b64 %7, %8 offset:25632 \n\ts_waitcnt lgkmcnt(0)" : "=&v"(qq[0]), "=&v"(qq[1]), "=&v"(qq[2]), "=&v"(qq[3]), "=&v"(qq[4]), "=&v"(qq[5]), "=&v"(qq[6]), "=&v"(qq[7]) : "v"(qbase) : "memory");
          { v4u aw; aw.x = qq[0].x; aw.y = qq[0].y; aw.z = qq[1].x; aw.w = qq[1].y; acc[0] = mfma16(__builtin_bit_cast(bf16x8, aw), bfrag, acc[0]); }
          { v4u aw; aw.x = qq[2].x; aw.y = qq[2].y; aw.z = qq[3].x; aw.w = qq[3].y; acc[1] = mfma16(__builtin_bit_cast(bf16x8, aw), bfrag, acc[1]); }
          { v4u aw; aw.x = qq[4].x; aw.y = qq[4].y; aw.z = qq[5].x; aw.w = qq[5].y; acc[2] = mfma16(__builtin_bit_cast(bf16x8, aw), bfrag, acc[2]); }
          { v4u aw; aw.x = qq[6].x; aw.y = qq[6].y; aw.z = qq[7].x; aw.w = qq[7].y; acc[3] = mfma16(__builtin_bit_cast(bf16x8, aw), bfrag, acc[3]); }
        }
        { v4u bw; bw.x = pk2(Sacc[10][0], Sacc[10][1]); bw.y = pk2(Sacc[10][2], Sacc[10][3]); bw.z = pk2(Sacc[11][0], Sacc[11][1]); bw.w = pk2(Sacc[11][2], Sacc[11][3]);
          const bf16x8 bfrag = __builtin_bit_cast(bf16x8, bw); v2u qq[8];
          asm volatile("ds_read_b64 %0, %8 offset:320 \n\tds_read_b64 %1, %8 offset:352 \n\tds_read_b64 %2, %8 offset:8768 \n\tds_read_b64 %3, %8 offset:8800 \n\tds_read_b64 %4, %8 offset:17216 \n\tds_read_b64 %5, %8 offset:17248 \n\tds_read_b64 %6, %8 offset:25664 \n\tds_read_b64 %7, %8 offset:25696 \n\ts_waitcnt lgkmcnt(0)" : "=&v"(qq[0]), "=&v"(qq[1]), "=&v"(qq[2]), "=&v"(qq[3]), "=&v"(qq[4]), "=&v"(qq[5]), "=&v"(qq[6]), "=&v"(qq[7]) : "v"(qbase) : "memory");
          { v4u aw; aw.x = qq[0].x; aw.y = qq[0].y; aw.z = qq[1].x; aw.w = qq[1].y; acc[0] = mfma16(__builtin_bit_cast(bf16x8, aw), bfrag, acc[0]); }
          { v4u aw; aw.x = qq[2].x; aw.y = qq[2].y; aw.z = qq[3].x; aw.w = qq[3].y; acc[1] = mfma16(__builtin_bit_cast(bf16x8, aw), bfrag, acc[1]); }
          { v4u aw; aw.x = qq[4].x; aw.y = qq[4].y; aw.z = qq[5].x; aw.w = qq[5].y; acc[2] = mfma16(__builtin_bit_cast(bf16x8, aw), bfrag, acc[2]); }
          { v4u aw; aw.x = qq[6].x; aw.y = qq[6].y; aw.z = qq[7].x; aw.w = qq[7].y; acc[3] = mfma16(__builtin_bit_cast(bf16x8, aw), bfrag, acc[3]); }
        }
        { v4u bw; bw.x = pk2(Sacc[12][0], Sacc[12][1]); bw.y = pk2(Sacc[12][2], Sacc[12][3]); bw.z = pk2(Sacc[13][0], Sacc[13][1]); bw.w = pk2(Sacc[13][2], Sacc[13][3]);
          const bf16x8 bfrag = __builtin_bit_cast(bf16x8, bw); v2u qq[8];
          asm volatile("ds_read_b64 %0, %8 offset:384 \n\tds_read_b64 %1, %8 offset:416 \n\tds_read_b64 %2, %8 offset:8832 \n\tds_read_b64 %3, %8 offset:8864 \n\tds_read_b64 %4, %8 offset:17280 \n\tds_read_b64 %5, %8 offset:17312 \n\tds_read_b64 %6, %8 offset:25728 \n\tds_read_b64 %7, %8 offset:25760 \n\ts_waitcnt lgkmcnt(0)" : "=&v"(qq[0]), "=&v"(qq[1]), "=&v"(qq[2]), "=&v"(qq[3]), "=&v"(qq[4]), "=&v"(qq[5]), "=&v"(qq[6]), "=&v"(qq[7]) : "v"(qbase) : "memory");
          { v4u aw; aw.x = qq[0].x; aw.y = qq[0].y; aw.z = qq[1].x; aw.w = qq[1].y; acc[0] = mfma16(__builtin_bit_cast(bf16x8, aw), bfrag, acc[0]); }
          { v4u aw; aw.x = qq[2].x; aw.y = qq[2].y; aw.z = qq[3].x; aw.w = qq[3].y; acc[1] = mfma16(__builtin_bit_cast(bf16x8, aw), bfrag, acc[1]); }
          { v4u aw; aw.x = qq[4].x; aw.y = qq[4].y; aw.z = qq[5].x; aw.w = qq[5].y; acc[2] = mfma16(__builtin_bit_cast(bf16x8, aw), bfrag, acc[2]); }
          { v4u aw; aw.x = qq[6].x; aw.y = qq[6].y; aw.z = qq[7].x; aw.w = qq[7].y; acc[3] = mfma16(__builtin_bit_cast(bf16x8, aw), bfrag, acc[3]); }
        }
        { v4u bw; bw.x = pk2(Sacc[14][0], Sacc[14][1]); bw.y = pk2(Sacc[14][2], Sacc[14][3]); bw.z = pk2(Sacc[15][0], Sacc[15][1]); bw.w = pk2(Sacc[15][2], Sacc[15][3]);
          const bf16x8 bfrag = __builtin_bit_cast(bf16x8, bw); v2u qq[8];
          asm volatile("ds_read_b64 %0, %8 offset:448 \n\tds_read_b64 %1, %8 offset:480 \n\tds_read_b64 %2, %8 offset:8896 \n\tds_read_b64 %3, %8 offset:8928 \n\tds_read_b64 %4, %8 offset:17344 \n\tds_read_b64 %5, %8 offset:17376 \n\tds_read_b64 %6, %8 offset:25792 \n\tds_read_b64 %7, %8 offset:25824 \n\ts_waitcnt lgkmcnt(0)" : "=&v"(qq[0]), "=&v"(qq[1]), "=&v"(qq[2]), "=&v"(qq[3]), "=&v"(qq[4]), "=&v"(qq[5]), "=&v"(qq[6]), "=&v"(qq[7]) : "v"(qbase) : "memory");
          { v4u aw; aw.x = qq[0].x; aw.y = qq[0].y; aw.z = qq[1].x; aw.w = qq[1].y; acc[0] = mfma16(__builtin_bit_cast(bf16x8, aw), bfrag, acc[0]); }
          { v4u aw; aw.x = qq[2].x; aw.y = qq[2].y; aw.z = qq[3].x; aw.w = qq[3].y; acc[1] = mfma16(__builtin_bit_cast(bf16x8, aw), bfrag, acc[1]); }
          { v4u aw; aw.x = qq[4].x; aw.y = qq[4].y; aw.z = qq[5].x; aw.w = qq[5].y; acc[2] = mfma16(__builtin_bit_cast(bf16x8, aw), bfrag, acc[2]); }
          { v4u aw; aw.x = qq[6].x; aw.y = qq[6].y; aw.z = qq[7].x; aw.w = qq[7].y; acc[3] = mfma16(__builtin_bit_cast(bf16x8, aw), bfrag, acc[3]); }
        }
#pragma unroll
        for (int mi = 0; mi < 4; ++mi)
#pragma unroll
            for (int g = 0; g < 4; ++g) acc[mi][g] *= __builtin_amdgcn_exp2f(lg * (float)(16 * mi + 4 * fq + g + 1));
        RTM(45);
        v2u vp[8];
        asm volatile("ds_read_b64_tr_b16 %0, %4 offset:0 \n\tds_read_b64_tr_b16 %1, %4 offset:1088 \n\tds_read_b64_tr_b16 %2, %4 offset:8704 \n\tds_read_b64_tr_b16 %3, %4 offset:9792 \n\ts_waitcnt lgkmcnt(0)" : "=&v"(vp[0]), "=&v"(vp[1]), "=&v"(vp[2]), "=&v"(vp[3]) : "v"(vbase) : "memory");
        asm volatile("ds_read_b64_tr_b16 %0, %4 offset:0 \n\tds_read_b64_tr_b16 %1, %4 offset:1088 \n\tds_read_b64_tr_b16 %2, %4 offset:8704 \n\tds_read_b64_tr_b16 %3, %4 offset:9792 \n\ts_waitcnt lgkmcnt(0)" : "=&v"(vp[4]), "=&v"(vp[5]), "=&v"(vp[6]), "=&v"(vp[7]) : "v"(vsbase) : "memory");
        bf16x8 vf[2], vs[2];
        { v4u t0; t0.x = vp[0].x; t0.y = vp[0].y; t0.z = vp[1].x; t0.w = vp[1].y; vf[0] = __builtin_bit_cast(bf16x8, t0); v4u t1; t1.x = vp[4].x; t1.y = vp[4].y; t1.z = vp[5].x; t1.w = vp[5].y; vs[0] = __builtin_bit_cast(bf16x8, t1); }
        { v4u t0; t0.x = vp[2].x; t0.y = vp[2].y; t0.z = vp[3].x; t0.w = vp[3].y; vf[1] = __builtin_bit_cast(bf16x8, t0); v4u t1; t1.x = vp[6].x; t1.y = vp[6].y; t1.z = vp[7].x; t1.w = vp[7].y; vs[1] = __builtin_bit_cast(bf16x8, t1); }
#pragma unroll
        for (int mi = 0; mi < 4; ++mi)
#pragma unroll
            for (int k2 = 0; k2 < 2; ++k2) { const bf16x8 a = *(const LAS bf16x8*)(lds + RT_SS + (16 * mi + fr) * RT_SS_STRIDE + (32 * k2 + 8 * fq) * 2); acc[mi] = mfma16(a, vf[k2], acc[mi]); }
        RTM(5);
        if (c > 0) {
            float sel = 0.f;
#pragma unroll
            for (int mi = 0; mi < 4; ++mi)
#pragma unroll
                for (int g = 0; g < 4; ++g) { const float v = acc[mi][g];
                    *(LAS unsigned short*)(lds + RT_OB + (16 * mi + 4 * fq + g) * RT_OB_STRIDE + (16 * w + fr) * 2) = (unsigned short)(pk2(v, 0.f) & 0xffffu);
                    const float sq = row16_sum(v * v);
                    sel = (fr == 4 * mi + g) ? sq : sel; }
            if (accum) { const int rj = b * SEQ + 64 * (c - 1) + 16 * (fr >> 2) + 4 * fq + (fr & 3); atomicAdd(ssqo + (size_t)rj * 16 + h, fx_from_pos(sel)); }
        }
        RTM(6);
#pragma unroll
        for (int dt = 0; dt < 16; ++dt) Sacc[dt] *= cdec;
        { v2u kp[16]; asm volatile("ds_read_b64_tr_b16 %0, %16 offset:0 \n\tds_read_b64_tr_b16 %1, %16 offset:2112 \n\tds_read_b64_tr_b16 %2, %16 offset:16896 \n\tds_read_b64_tr_b16 %3, %16 offset:19008 \n\tds_read_b64_tr_b16 %4, %16 offset:32 \n\tds_read_b64_tr_b16 %5, %16 offset:2144 \n\tds_read_b64_tr_b16 %6, %16 offset:16928 \n\tds_read_b64_tr_b16 %7, %16 offset:19040 \n\tds_read_b64_tr_b16 %8, %16 offset:64 \n\tds_read_b64_tr_b16 %9, %16 offset:2176 \n\tds_read_b64_tr_b16 %10, %16 offset:16960 \n\tds_read_b64_tr_b16 %11, %16 offset:19072 \n\tds_read_b64_tr_b16 %12, %16 offset:96 \n\tds_read_b64_tr_b16 %13, %16 offset:2208 \n\tds_read_b64_tr_b16 %14, %16 offset:16992 \n\tds_read_b64_tr_b16 %15, %16 offset:19104 \n\ts_waitcnt lgkmcnt(0)" : "=&v"(kp[0]), "=&v"(kp[1]), "=&v"(kp[2]), "=&v"(kp[3]), "=&v"(kp[4]), "=&v"(kp[5]), "=&v"(kp[6]), "=&v"(kp[7]), "=&v"(kp[8]), "=&v"(kp[9]), "=&v"(kp[10]), "=&v"(kp[11]), "=&v"(kp[12]), "=&v"(kp[13]), "=&v"(kp[14]), "=&v"(kp[15]) : "v"(kbase) : "memory");
          { v4u aw; aw.x = kp[0].x; aw.y = kp[0].y; aw.z = kp[1].x; aw.w = kp[1].y; Sacc[0] = mfma16(__builtin_bit_cast(bf16x8, aw), vs[0], Sacc[0]); }
          { v4u aw; aw.x = kp[2].x; aw.y = kp[2].y; aw.z = kp[3].x; aw.w = kp[3].y; Sacc[0] = mfma16(__builtin_bit_cast(bf16x8, aw), vs[1], Sacc[0]); }
          { v4u aw; aw.x = kp[4].x; aw.y = kp[4].y; aw.z = kp[5].x; aw.w = kp[5].y; Sacc[1] = mfma16(__builtin_bit_cast(bf16x8, aw), vs[0], Sacc[1]); }
          { v4u aw; aw.x = kp[6].x; aw.y = kp[6].y; aw.z = kp[7].x; aw.w = kp[7].y; Sacc[1] = mfma16(__builtin_bit_cast(bf16x8, aw), vs[1], Sacc[1]); }
          { v4u aw; aw.x = kp[8].x; aw.y = kp[8].y; aw.z = kp[9].x; aw.w = kp[9].y; Sacc[2] = mfma16(__builtin_bit_cast(bf16x8, aw), vs[0], Sacc[2]); }
          { v4u aw; aw.x = kp[10].x; aw.y = kp[10].y; aw.z = kp[11].x; aw.w = kp[11].y; Sacc[2] = mfma16(__builtin_bit_cast(bf16x8, aw), vs[1], Sacc[2]); }
          { v4u aw; aw.x = kp[12].x; aw.y = kp[12].y; aw.z = kp[13].x; aw.w = kp[13].y; Sacc[3] = mfma16(__builtin_bit_cast(bf16x8, aw), vs[0], Sacc[3]); }
          { v4u aw; aw.x = kp[14].x; aw.y = kp[14].y; aw.z = kp[15].x; aw.w = kp[15].y; Sacc[3] = mfma16(__builtin_bit_cast(bf16x8, aw), vs[1], Sacc[3]); }
        }
        { v2u kp[16]; asm volatile("ds_read_b64_tr_b16 %0, %16 offset:128 \n\tds_read_b64_tr_b16 %1, %16 offset:2240 \n\tds_read_b64_tr_b16 %2, %16 offset:17024 \n\tds_read_b64_tr_b16 %3, %16 offset:19136 \n\tds_read_b64_tr_b16 %4, %16 offset:160 \n\tds_read_b64_tr_b16 %5, %16 offset:2272 \n\tds_read_b64_tr_b16 %6, %16 offset:17056 \n\tds_read_b64_tr_b16 %7, %16 offset:19168 \n\tds_read_b64_tr_b16 %8, %16 offset:192 \n\tds_read_b64_tr_b16 %9, %16 offset:2304 \n\tds_read_b64_tr_b16 %10, %16 offset:17088 \n\tds_read_b64_tr_b16 %11, %16 offset:19200 \n\tds_read_b64_tr_b16 %12, %16 offset:224 \n\tds_read_b64_tr_b16 %13, %16 offset:2336 \n\tds_read_b64_tr_b16 %14, %16 offset:17120 \n\tds_read_b64_tr_b16 %15, %16 offset:19232 \n\ts_waitcnt lgkmcnt(0)" : "=&v"(kp[0]), "=&v"(kp[1]), "=&v"(kp[2]), "=&v"(kp[3]), "=&v"(kp[4]), "=&v"(kp[5]), "=&v"(kp[6]), "=&v"(kp[7]), "=&v"(kp[8]), "=&v"(kp[9]), "=&v"(kp[10]), "=&v"(kp[11]), "=&v"(kp[12]), "=&v"(kp[13]), "=&v"(kp[14]), "=&v"(kp[15]) : "v"(kbase) : "memory");
          { v4u aw; aw.x = kp[0].x; aw.y = kp[0].y; aw.z = kp[1].x; aw.w = kp[1].y; Sacc[4] = mfma16(__builtin_bit_cast(bf16x8, aw), vs[0], Sacc[4]); }
          { v4u aw; aw.x = kp[2].x; aw.y = kp[2].y; aw.z = kp[3].x; aw.w = kp[3].y; Sacc[4] = mfma16(__builtin_bit_cast(bf16x8, aw), vs[1], Sacc[4]); }
          { v4u aw; aw.x = kp[4].x; aw.y = kp[4].y; aw.z = kp[5].x; aw.w = kp[5].y; Sacc[5] = mfma16(__builtin_bit_cast(bf16x8, aw), vs[0], Sacc[5]); }
          { v4u aw; aw.x = kp[6].x; aw.y = kp[6].y; aw.z = kp[7].x; aw.w = kp[7].y; Sacc[5] = mfma16(__builtin_bit_cast(bf16x8, aw), vs[1], Sacc[5]); }
          { v4u aw; aw.x = kp[8].x; aw.y = kp[8].y; aw.z = kp[9].x; aw.w = kp[9].y; Sacc[6] = mfma16(__builtin_bit_cast(bf16x8, aw), vs[0], Sacc[6]); }
          { v4u aw; aw.x = kp[10].x; aw.y = kp[10].y; aw.z = kp[11].x; aw.w = kp[11].y; Sacc[6] = mfma16(__builtin_bit_cast(bf16x8, aw), vs[1], Sacc[6]); }
          { v4u aw; aw.x = kp[12].x; aw.y = kp[12].y; aw.z = kp[13].x; aw.w = kp[13].y; Sacc[7] = mfma16(__builtin_bit_cast(bf16x8, aw), vs[0], Sacc[7]); }
          { v4u aw; aw.x = kp[14].x; aw.y = kp[14].y; aw.z = kp[15].x; aw.w = kp[15].y; Sacc[7] = mfma16(__builtin_bit_cast(bf16x8, aw), vs[1], Sacc[7]); }
        }
        { v2u kp[16]; asm volatile("ds_read_b64_tr_b16 %0, %16 offset:256 \n\tds_read_b64_tr_b16 %1, %16 offset:2368 \n\tds_read_b64_tr_b16 %2, %16 offset:17152 \n\tds_read_b64_tr_b16 %3, %16 offset:19264 \n\tds_read_b64_tr_b16 %4, %16 offset:288 \n\tds_read_b64_tr_b16 %5, %16 offset:2400 \n\tds_read_b64_tr_b16 %6, %16 offset:17184 \n\tds_read_b64_tr_b16 %7, %16 offset:19296 \n\tds_read_b64_tr_b16 %8, %16 offset:320 \n\tds_read_b64_tr_b16 %9, %16 offset:2432 \n\tds_read_b64_tr_b16 %10, %16 offset:17216 \n\tds_read_b64_tr_b16 %11, %16 offset:19328 \n\tds_read_b64_tr_b16 %12, %16 offset:352 \n\tds_read_b64_tr_b16 %13, %16 offset:2464 \n\tds_read_b64_tr_b16 %14, %16 offset:17248 \n\tds_read_b64_tr_b16 %15, %16 offset:19360 \n\ts_waitcnt lgkmcnt(0)" : "=&v"(kp[0]), "=&v"(kp[1]), "=&v"(kp[2]), "=&v"(kp[3]), "=&v"(kp[4]), "=&v"(kp[5]), "=&v"(kp[6]), "=&v"(kp[7]), "=&v"(kp[8]), "=&v"(kp[9]), "=&v"(kp[10]), "=&v"(kp[11]), "=&v"(kp[12]), "=&v"(kp[13]), "=&v"(kp[14]), "=&v"(kp[15]) : "v"(kbase) : "memory");
          { v4u aw; aw.x = kp[0].x; aw.y = kp[0].y; aw.z = kp[1].x; aw.w = kp[1].y; Sacc[8] = mfma16(__builtin_bit_cast(bf16x8, aw), vs[0], Sacc[8]); }
          { v4u aw; aw.x = kp[2].x; aw.y = kp[2].y; aw.z = kp[3].x; aw.w = kp[3].y; Sacc[8] = mfma16(__builtin_bit_cast(bf16x8, aw), vs[1], Sacc[8]); }
          { v4u aw; aw.x = kp[4].x; aw.y = kp[4].y; aw.z = kp[5].x; aw.w = kp[5].y; Sacc[9] = mfma16(__builtin_bit_cast(bf16x8, aw), vs[0], Sacc[9]); }
          { v4u aw; aw.x = kp[6].x; aw.y = kp[6].y; aw.z = kp[7].x; aw.w = kp[7].y; Sacc[9] = mfma16(__builtin_bit_cast(bf16x8, aw), vs[1], Sacc[9]); }
          { v4u aw; aw.x = kp[8].x; aw.y = kp[8].y; aw.z = kp[9].x; aw.w = kp[9].y; Sacc[10] = mfma16(__builtin_bit_cast(bf16x8, aw), vs[0], Sacc[10]); }
          { v4u aw; aw.x = kp[10].x; aw.y = kp[10].y; aw.z = kp[11].x; aw.w = kp[11].y; Sacc[10] = mfma16(__builtin_bit_cast(bf16x8, aw), vs[1], Sacc[10]); }
          { v4u aw; aw.x = kp[12].x; aw.y = kp[12].y; aw.z = kp[13].x; aw.w = kp[13].y; Sacc[11] = mfma16(__builtin_bit_cast(bf16x8, aw), vs[0], Sacc[11]); }
          { v4u aw; aw.x = kp[14].x; aw.y = kp[14].y; aw.z = kp[15].x; aw.w = kp[15].y; Sacc[11] = mfma16(__builtin_bit_cast(bf16x8, aw), vs[1], Sacc[11]); }
        }
        { v2u kp[16]; asm volatile("ds_read_b64_tr_b16 %0, %16 offset:384 \n\tds_read_b64_tr_b16 %1, %16 offset:2496 \n\tds_read_b64_tr_b16 %2, %16 offset:17280 \n\tds_read_b64_tr_b16 %3, %16 offset:19392 \n\tds_read_b64_tr_b16 %4, %16 offset:416 \n\tds_read_b64_tr_b16 %5, %16 offset:2528 \n\tds_read_b64_tr_b16 %6, %16 offset:17312 \n\tds_read_b64_tr_b16 %7, %16 offset:19424 \n\tds_read_b64_tr_b16 %8, %16 offset:448 \n\tds_read_b64_tr_b16 %9, %16 offset:2560 \n\tds_read_b64_tr_b16 %10, %16 offset:17344 \n\tds_read_b64_tr_b16 %11, %16 offset:19456 \n\tds_read_b64_tr_b16 %12, %16 offset:480 \n\tds_read_b64_tr_b16 %13, %16 offset:2592 \n\tds_read_b64_tr_b16 %14, %16 offset:17376 \n\tds_read_b64_tr_b16 %15, %16 offset:19488 \n\ts_waitcnt lgkmcnt(0)" : "=&v"(kp[0]), "=&v"(kp[1]), "=&v"(kp[2]), "=&v"(kp[3]), "=&v"(kp[4]), "=&v"(kp[5]), "=&v"(kp[6]), "=&v"(kp[7]), "=&v"(kp[8]), "=&v"(kp[9]), "=&v"(kp[10]), "=&v"(kp[11]), "=&v"(kp[12]), "=&v"(kp[13]), "=&v"(kp[14]), "=&v"(kp[15]) : "v"(kbase) : "memory");
          { v4u aw; aw.x = kp[0].x; aw.y = kp[0].y; aw.z = kp[1].x; aw.w = kp[1].y; Sacc[12] = mfma16(__builtin_bit_cast(bf16x8, aw), vs[0], Sacc[12]); }
          { v4u aw; aw.x = kp[2].x; aw.y = kp[2].y; aw.z = kp[3].x; aw.w = kp[3].y; Sacc[12] = mfma16(__builtin_bit_cast(bf16x8, aw), vs[1], Sacc[12]); }
          { v4u aw; aw.x = kp[4].x; aw.y = kp[4].y; aw.z = kp[5].x; aw.w = kp[5].y; Sacc[13] = mfma16(__builtin_bit_cast(bf16x8, aw), vs[0], Sacc[13]); }
          { v4u aw; aw.x = kp[6].x; aw.y = kp[6].y; aw.z = kp[7].x; aw.w = kp[7].y; Sacc[13] = mfma16(__builtin_bit_cast(bf16x8, aw), vs[1], Sacc[13]); }
          { v4u aw; aw.x = kp[8].x; aw.y = kp[8].y; aw.z = kp[9].x; aw.w = kp[9].y; Sacc[14] = mfma16(__builtin_bit_cast(bf16x8, aw), vs[0], Sacc[14]); }
          { v4u aw; aw.x = kp[10].x; aw.y = kp[10].y; aw.z = kp[11].x; aw.w = kp[11].y; Sacc[14] = mfma16(__builtin_bit_cast(bf16x8, aw), vs[1], Sacc[14]); }
          { v4u aw; aw.x = kp[12].x; aw.y = kp[12].y; aw.z = kp[13].x; aw.w = kp[13].y; Sacc[15] = mfma16(__builtin_bit_cast(bf16x8, aw), vs[0], Sacc[15]); }
          { v4u aw; aw.x = kp[14].x; aw.y = kp[14].y; aw.z = kp[15].x; aw.w = kp[15].y; Sacc[15] = mfma16(__builtin_bit_cast(bf16x8, aw), vs[1], Sacc[15]); }
        }
        RTM(7);
    }
#undef RT_BAR
#undef RT_PREFETCH
#ifdef PROBE_ATT_A
    if (w == 0 && lane == 0 && blockIdx.x == 0) { const unsigned long long a_ = (((unsigned long long)F.MISC[23] << 32) | F.MISC[22]) + rtm_acc; F.MISC[22] = (unsigned)a_; F.MISC[23] = (unsigned)(a_ >> 32); }
#endif
#undef RTM
    __syncthreads();
    RT_FLUSH(64);
#undef RT_FLUSH
    __syncthreads();
}
__device__ __forceinline__ void p7_retention(Frame& F, const Args& A, bool accum) {
    for (int item = blockIdx.x; item < NB * RET_H * 4; item += F.G) ret_item(F, A, item >> 6, (item >> 2) & 15, item & 3, accum);
}
__device__ __forceinline__ void p8_gate(Frame& F, const Args& A, bool probe = false) {
    const bf16* z1 = (const bf16*)(F.ws + WS_Z); bf16* ob = (bf16*)(F.ws + WS_Y1); const u64* ssqo = (const u64*)(F.ws + WS_SSQO); const float* gain = A.in[17];
    const int gt = blockIdx.x * NTHREADS + F.tid, nthr = F.G * NTHREADS;
    const int c = (gt & 1023) * 8, hd = c >> 9, rstep = nthr >> 10, r0 = (gt >> 10) < rstep ? (gt >> 10) : MTOK;
    const f32x4 g0 = *(const GAS f32x4*)(gain + c), g1 = *(const GAS f32x4*)(gain + c + 4);
    for (int r = r0; r < MTOK; r += 4 * rstep) {
        v4u gw[4], ow[4]; float ss[4];
#pragma unroll
        for (int k = 0; k < 4; ++k) { const int rr = r + k * rstep; if (rr < MTOK) { gw[k] = *(const GAS v4u*)(z1 + (size_t)rr * RET_IN + 16384 + c); ow[k] = *(const GAS v4u*)(ob + (size_t)rr * RET_VW + c); ss[k] = fx_to_pos(ssqo[(size_t)rr * 16 + hd]); } }
#pragma unroll
        for (int k = 0; k < 4; ++k) { const int rr = r + k * rstep; if (rr < MTOK) {
            const float rs = __builtin_amdgcn_rsqf(ss[k] * (1.0f / 512.0f) + RMS_EPS);
            float gf[8], of[8], y[8]; unpack8(gw[k], gf); unpack8(ow[k], of);
#pragma unroll
            for (int e = 0; e < 8; ++e) { const float gn = e < 4 ? g0[e] : g1[e - 4]; y[e] = gf[e] * sigmoidf_fast(gf[e]) * (of[e] * rs * gn); }
            bf16* dst = probe ? (bf16*)(F.ws + WS_XB) + (size_t)(rr & (MTOK / 2 - 1)) * RET_VW + c : ob + (size_t)rr * RET_VW + c;
            *(GAS v4u*)dst = pack8f(y); } }
    }
}


__device__ __forceinline__ void meta_fixup(Frame& F, const u64* Hmeta, bf16* XB, u64* ssq) {
    __syncthreads();
    if (F.MISC[4] != 0u) {
        __builtin_amdgcn_fence(__ATOMIC_ACQUIRE, "agent"); asm volatile("s_waitcnt vmcnt(0)" ::: "memory");
        for (int row = F.wave; row < NB * NMETA; row += NWAVES) { const u64* hrow = Hmeta + (size_t)row * DM; bf16* xrow = XB + (size_t)(MTOK + row) * DM; float s = 0.f;
#pragma unroll 4
            for (int j = 0; j < 16; ++j) { const int e = (F.lane + 64 * j) * 4; const f32x4 v = {fx_to(hrow[e]), fx_to(hrow[e + 1]), fx_to(hrow[e + 2]), fx_to(hrow[e + 3])};
                s += (v.x * v.x + v.y * v.y) + (v.z * v.z + v.w * v.w); v2u w; w.x = pk2(v.x, v.y); w.y = pk2(v.z, v.w); *(GAS v2u*)(xrow + e) = w; }
            s = wave_sum(s);
            if (F.lane == 0) ssq[MTOK + row] = fx_from_pos(s); }
        __syncthreads();
        if (F.tid == 0) F.MISC[4] = 0u;
    }
    __syncthreads();
}


__device__ __forceinline__ void phase_stagger(int us) {
    if (us <= 0) return;
    const unsigned long long t0 = __builtin_amdgcn_s_memrealtime(), ticks = (unsigned long long)(((blockIdx.x >> 3) & 3) * us * 100);
    while (__builtin_amdgcn_s_memrealtime() - t0 < ticks) __builtin_amdgcn_s_sleep(16);
}

__global__ void __launch_bounds__(NTHREADS, 2) hybrid_fwd(Args args) {
    extern __shared__ __attribute__((aligned(16))) unsigned char lds_raw[];
    Frame F;
    F.lds = (LAS unsigned char*)lds_raw;
    F.MISC = (volatile LAS unsigned*)(F.lds + MISC_OFF);
    F.tid = threadIdx.x; F.lane = F.tid & 63; F.wave = __builtin_amdgcn_readfirstlane(F.tid >> 6);
    F.G = gridDim.x; F.ws = args.ws;
    if (F.tid < 64) F.MISC[F.tid] = 0u;
    __syncthreads();
    unsigned* ctl = (unsigned*)(F.ws + WS_CTL);
#if !MK_PER_PHASE
    const XcdBarrier bar = xcd_barrier_post(ctl + CW_BAR, F.MISC + 8, F.wave);
#define GRID_BAR() xcd_barrier(bar)
#else
#define GRID_BAR() do { } while (0)
#endif
    const int lo = args.ph_lo, hi = args.ph_hi;
#ifndef PHASE_MASK
#define PHASE_MASK 0xFFF
#endif
#define IN(k) ((((PHASE_MASK) >> (k)) & 1) && lo <= (k) && (k) < hi)
#define BOTH(k) (IN(k) && IN((k) + 1))
#ifndef STAGGER_US
#define STAGGER_US 0
#endif
#ifndef REPEAT_MASK
#define REPEAT_MASK 0
#endif
#define RETID() do { const int ln_ = hw_lane(); F.lane = ln_; F.tid = F.wave * 64 + ln_; } while (0)
#define REPS(k) (1 + (((REPEAT_MASK) >> (k)) & 1))
    unsigned char* ws = F.ws;
    bf16* XB = (bf16*)(ws + WS_XB); u64* Hmeta = (u64*)(ws + WS_HMETA); bf16* Z = (bf16*)(ws + WS_Z); bf16* Y0 = (bf16*)(ws + WS_Y0); bf16* Y1 = (bf16*)(ws + WS_Y1);
    u64* SSQ0 = (u64*)(ws + WS_SSQ0); u64* SSQ1 = (u64*)(ws + WS_SSQ1); u64* SSQ2 = (u64*)(ws + WS_SSQ2); u64* SSQ3 = (u64*)(ws + WS_SSQ3);
    const int c = (int)blockIdx.x;
#ifdef PROBE_TSUM_MASK
    if (F.tid == 0) { const unsigned long long t_ = __builtin_amdgcn_s_memrealtime(); F.MISC[20] = (unsigned)t_; F.MISC[21] = (unsigned)(t_ >> 32); F.MISC[22] = 0u; F.MISC[23] = 0u; }
#define PT(k) do { if (F.wave == 0 && hw_lane() == 0) { const unsigned long long now_ = __builtin_amdgcn_s_memrealtime(), prev_ = ((unsigned long long)F.MISC[21] << 32) | F.MISC[20]; \
        if (((PROBE_TSUM_MASK) >> (k)) & 1) { const unsigned long long a_ = (((unsigned long long)F.MISC[23] << 32) | F.MISC[22]) + (now_ - prev_); F.MISC[22] = (unsigned)a_; F.MISC[23] = (unsigned)(a_ >> 32); } \
        F.MISC[20] = (unsigned)now_; F.MISC[21] = (unsigned)(now_ >> 32); } } while (0)
#else
#define PT(k) do { } while (0)
#endif

    if (IN(0)) { RETID(); p0_prologue(F, args); if (REPS(0) > 1) p0_prologue(F, args); if (BOTH(0)) GRID_BAR(); PT(0); }
#ifdef PROBE_EXTRA_BARRIERS
    for (int k = 0; k < PROBE_EXTRA_BARRIERS; ++k) GRID_BAR();
#endif
    if (IN(1)) { RETID();
        pg8::Gemm g{XB, (const bf16*)(ws + WS_WIN0), MP, 41 * 256, DM}; pg8::StaticOrder S; S.init(MP, 41 * 256, DM, F.G, c);
        pg8::EpiIn0 E{Z, (float*)(ws + WS_FBUF), SSQ0};
        pg8::gemm_phase<pg8::EpiIn0, pg8::StaticOrder, true, true>(F.lds, g, S, E, F.wave); if (REPS(1) > 1) { pg8::gemm_phase<pg8::EpiIn0, pg8::StaticOrder, true, true>(F.lds, g, S, E, F.wave); }
        tail_conv(F, args, CW_TL1, TL1_LO, TL1_N);
        if (BOTH(1)) GRID_BAR(); PT(1);
    }
    if (IN(2)) { RETID(); p2_mixer0(F, args, 0); if (REPS(2) > 1) { GRID_BAR(); p2_mixer0(F, args, 1); } if (BOTH(2)) GRID_BAR(); PT(2); }
    if (IN(3)) { RETID();
        pg8::Gemm g{Y0, (const bf16*)(ws + WS_WOUT0), MP, DM, DM}; pg8::SplitMetaOrder S; S.init2(DM, DM, F.G, c, ctl + CW_TK3, F.MISC + 4);
        pg8::EpiResX E{args.in[0], Hmeta, XB, SSQ1, DM / 64};
        phase_stagger(STAGGER_US);
        pg8::gemm_phase<pg8::EpiResX, pg8::SplitMetaOrder, true, true>(F.lds, g, S, E, F.wave);
        meta_fixup(F, Hmeta, XB, SSQ1);
        if (REPS(3) > 1) { pg8::EpiNone EN; pg8::StaticOrder S2; S2.init(MP, DM, DM, F.G, c); pg8::gemm_phase<pg8::EpiNone, pg8::StaticOrder, true, true>(F.lds, g, S2, EN, F.wave); }
        if (BOTH(3)) GRID_BAR(); PT(3);
    }
    if (IN(4)) { RETID();
        pg8::Gemm g{XB, (const bf16*)(ws + WS_WGU0), MP, 2 * DFF, DM}; pg8::StaticOrder S; S.init(MP, 2 * DFF, DM, F.G, c);
        pg8::EpiGU E{Z, SSQ1};
#ifdef PROBE_CLOCK
        const unsigned long long ck_t0 = __builtin_amdgcn_s_memtime(), ck_r0 = __builtin_amdgcn_s_memrealtime();
#endif
        pg8::gemm_phase<pg8::EpiGU, pg8::StaticOrder, true, true>(F.lds, g, S, E, F.wave);
#ifdef PROBE_CLOCK
        { const unsigned long long ck_t1 = __builtin_amdgcn_s_memtime(), ck_r1 = __builtin_amdgcn_s_memrealtime();
          if (F.tid == 0) F.MISC[16] = (unsigned)(((ck_t1 - ck_t0) * 100ull) / (ck_r1 - ck_r0 + 1ull)); }
#endif
#ifndef PROBE_P4_MODE
#define PROBE_P4_MODE 1
#endif
        if (REPS(4) > 1) {
            if (PROBE_P4_MODE == 1) { pg8::gemm_phase<pg8::EpiGU, pg8::StaticOrder, true, true>(F.lds, g, S, E, F.wave); }
            else if (PROBE_P4_MODE == 2) { pg8::EpiNone EN; pg8::gemm_phase<pg8::EpiNone, pg8::StaticOrder, true, true>(F.lds, g, S, EN, F.wave); }
            else { pg8::EpiNone EN; pg8::HotOrder HS; HS.init(MP, 2 * DFF, DM, F.G, c); pg8::gemm_phase<pg8::EpiNone, pg8::HotOrder, true, true>(F.lds, g, HS, EN, F.wave); }
        }
        tail_conv(F, args, CW_TL4, TL4_LO, TL4_N);
        if (BOTH(4)) GRID_BAR(); PT(4);
    }
    if (IN(5)) { RETID();
        pg8::Gemm g{Z, (const bf16*)(ws + WS_WD0), MP, DM, DFF}; pg8::SplitMetaOrder S; S.init2(DM, DFF, F.G, c, ctl + CW_TK5, F.MISC + 4);
        pg8::EpiRes E{nullptr, Hmeta, XB, SSQ2, DFF / 64};
        phase_stagger(STAGGER_US);
        pg8::gemm_phase<pg8::EpiRes, pg8::SplitMetaOrder, true, true>(F.lds, g, S, E, F.wave);
        meta_fixup(F, Hmeta, XB, SSQ2);
        if (REPS(5) > 1) { pg8::StaticOrder S2; S2.init(MTOK, DM, DFF, F.G, c); pg8::EpiNone EN; pg8::gemm_phase<pg8::EpiNone, pg8::StaticOrder, true, true>(F.lds, g, S2, EN, F.wave); }
        if (BOTH(5)) GRID_BAR(); PT(5);
    }
    if (IN(6)) { RETID();
        pg8::Gemm g{XB, (const bf16*)(ws + WS_WIN1), MP, RET_IN, DM}; pg8::StaticOrder S; S.init(MP, RET_IN, DM, F.G, c);
        pg8::EpiIn1 E{Z, SSQ2};
        pg8::gemm_phase<pg8::EpiIn1, pg8::StaticOrder, true, true>(F.lds, g, S, E, F.wave); if (REPS(6) > 1) { pg8::gemm_phase<pg8::EpiIn1, pg8::StaticOrder, true, true>(F.lds, g, S, E, F.wave); }
        tail_conv(F, args, CW_TL6, TL6_LO, TL6_N);
        if (BOTH(6)) GRID_BAR(); PT(6);
    }
    if (IN(7)) { RETID(); p7_retention(F, args, true); if (REPS(7) > 1) p7_retention(F, args, false); if (BOTH(7)) GRID_BAR(); PT(7); }
    if (IN(8)) { RETID(); p8_gate(F, args); if (REPS(8) > 1) p8_gate(F, args, true); if (BOTH(8)) GRID_BAR(); PT(8); }
    if (IN(9)) { RETID();
        pg8::Gemm g{Y1, (const bf16*)(ws + WS_WOUT1), MTOK, DM, RET_VW}; pg8::StaticOrder S; S.init(MTOK, DM, RET_VW, F.G, c);
        pg8::EpiRes E{nullptr, Hmeta, XB, SSQ3, RET_VW / 64};
        phase_stagger(STAGGER_US);
        pg8::gemm_phase<pg8::EpiRes, pg8::StaticOrder, true, true>(F.lds, g, S, E, F.wave);
        if (REPS(9) > 1) { pg8::EpiNone EN; pg8::gemm_phase<pg8::EpiNone, pg8::StaticOrder, true, true>(F.lds, g, S, EN, F.wave); }
        if (BOTH(9)) GRID_BAR(); PT(9);
    }
    if (IN(10)) { RETID();
        pg8::Gemm g{XB, (const bf16*)(ws + WS_WGU1), MTOK, 2 * DFF, DM}; pg8::StaticOrder S; S.init(MTOK, 2 * DFF, DM, F.G, c);
        pg8::EpiGU E{Z, SSQ3};
        pg8::gemm_phase<pg8::EpiGU, pg8::StaticOrder, true, true>(F.lds, g, S, E, F.wave); if (REPS(10) > 1) { pg8::gemm_phase<pg8::EpiGU, pg8::StaticOrder, true, true>(F.lds, g, S, E, F.wave); }
        tail_conv(F, args, CW_TL10, TL10_LO, TL10_N);
        if (BOTH(10)) GRID_BAR(); PT(10);
    }
    if (IN(11)) { RETID();
        pg8::Gemm g{Z, (const bf16*)(ws + WS_WD1), MTOK, DM, DFF}; pg8::StaticOrder S; S.init(MTOK, DM, DFF, F.G, c);
        pg8::EpiFinal E{XB, args.out};
        phase_stagger(STAGGER_US);
        pg8::gemm_phase<pg8::EpiFinal, pg8::StaticOrder, true, true>(F.lds, g, S, E, F.wave);
        if (REPS(11) > 1) { pg8::EpiNone EN; pg8::gemm_phase<pg8::EpiNone, pg8::StaticOrder, true, true>(F.lds, g, S, EN, F.wave); }
        PT(11);
    }
#ifdef PROBE_CLOCK
    if (blockIdx.x == 0 && F.tid == 0) { const unsigned long long r0 = __builtin_amdgcn_s_memrealtime(), ticks = (unsigned long long)F.MISC[16] * 100ull;
        while (__builtin_amdgcn_s_memrealtime() - r0 < ticks) __builtin_amdgcn_s_sleep(32); }
#endif
#ifdef PROBE_TSUM_MASK
    if (blockIdx.x == 0 && F.wave == 0 && hw_lane() == 0) { const unsigned long long r0 = __builtin_amdgcn_s_memrealtime(), ticks = ((((unsigned long long)F.MISC[23] << 32) | F.MISC[22])) * (unsigned long long)(PROBE_TSUM_MULT);
        while (__builtin_amdgcn_s_memrealtime() - r0 < ticks) __builtin_amdgcn_s_sleep(32); }
#endif
#undef IN
#undef BOTH
}

extern "C" void kernel_launch(void* const* d_in, const int* in_sizes, int n_in, void* d_out, int out_size, void* d_ws, size_t ws_size, hipStream_t stream) {
    static int grid = 0;
    if (grid == 0) {
        if (n_in != 23 || in_sizes[0] != MTOK * DM || out_size != MTOK * DM || ws_size < WS_END) { fprintf(stderr, "kernel_launch: unexpected shapes (n_in %d, in0 %d, out %d, ws %zu < %zu); nothing launched\n", n_in, n_in > 0 ? in_sizes[0] : -1, out_size, ws_size, (size_t)WS_END); grid = -1; return; }
        int dev = 0, cus = 0, per_cu = 0;
        if (hipGetDevice(&dev) != hipSuccess || hipDeviceGetAttribute(&cus, hipDeviceAttributeMultiprocessorCount, dev) != hipSuccess) { fprintf(stderr, "kernel_launch: device query failed\n"); grid = -1; return; }
        if (hipFuncSetAttribute((const void*)hybrid_fwd, hipFuncAttributeMaxDynamicSharedMemorySize, LDS_BYTES) != hipSuccess) { fprintf(stderr, "kernel_launch: hipFuncSetAttribute failed\n"); grid = -1; return; }
        if (hipOccupancyMaxActiveBlocksPerMultiprocessor(&per_cu, (const void*)hybrid_fwd, NTHREADS, LDS_BYTES) != hipSuccess || per_cu < 1) { fprintf(stderr, "kernel_launch: occupancy query reports %d workgroups per CU\n", per_cu); }
        (void)hipGetLastError();
        grid = cus;
    }
    if (grid < 0) return;
    if (hipMemsetAsync((char*)d_ws + WS_CTL, 0, CTL_ZERO_BYTES, stream) != hipSuccess) { fprintf(stderr, "kernel_launch: memset failed\n"); return; }
    Args a{};
    for (int i = 0; i < 23; ++i) a.in[i] = (const float*)d_in[i];
    a.out = (float*)d_out; a.ws = (unsigned char*)d_ws;
#if MK_PER_PHASE
    for (int p = 0; p < NPHASES; ++p) { a.ph_lo = p; a.ph_hi = p + 1; hipLaunchKernelGGL(hybrid_fwd, dim3(grid), dim3(NTHREADS), LDS_BYTES, stream, a); }
#else
    a.ph_lo = 0; a.ph_hi = NPHASES;
    hipLaunchKernelGGL(hybrid_fwd, dim3(grid), dim3(NTHREADS), LDS_BYTES, stream, a);
#endif
    const hipError_t le = hipPeekAtLastError();
    if (le != hipSuccess) fprintf(stderr, "kernel_launch: launch failed: %s\n", hipGetErrorName(le));
}
```

```cpp
#include <hip/hip_runtime.h>
#include <cstdio>
#include <cstdint>
#ifndef MK_PER_PHASE
#define MK_PER_PHASE 0
#endif
constexpr int DM = 4096, NB = 4, SEQ = 4096, NMETA = 16, LSEQ = NMETA + SEQ;
constexpr int MTOK = NB * SEQ;
constexpr int MMETA = MTOK;
constexpr int MP = 65 * 256;
constexpr int LRU_W = 2048, FOX_H = 16, FOX_D = 128, AB_IN = 10256, AB_Z = 10240;
constexpr int RET_H = 16, RET_QK = 256, RET_V = 512, RET_IN = 24576, RET_VW = 8192;
constexpr int DFF = 11008;
constexpr float RMS_EPS = 1e-6f;
typedef unsigned long long u64;
__device__ __forceinline__ u64 fx_from_pos(float s) { const float fl = floorf(s); return ((u64)(unsigned)fl << 32) | (u64)(unsigned)((s - fl) * 4294967296.0f); }
__device__ __forceinline__ float fx_to_pos(u64 x) { return (float)(unsigned)(x >> 32) + (float)(unsigned)x * (1.0f / 4294967296.0f); }
__device__ __forceinline__ u64 fx_from(float v) { return (u64)(long long)(v * 4294967296.0f); }
__device__ __forceinline__ float fx_to(u64 x) { return (float)(long long)x * (1.0f / 4294967296.0f); }
__device__ __forceinline__ int hw_lane() { int l; asm volatile("v_mbcnt_lo_u32_b32 %0, -1, 0\n\tv_mbcnt_hi_u32_b32 %0, -1, %0" : "=v"(l)); return l; }
template <int CTRL> __device__ __forceinline__ float dpp_mov(float x) { return __builtin_bit_cast(float, __builtin_amdgcn_update_dpp(0, __builtin_bit_cast(int, x), CTRL, 0xF, 0xF, true)); }
__device__ __forceinline__ float row16_sum(float x) { x += dpp_mov<0x128>(x); x += dpp_mov<0x124>(x); x += dpp_mov<0x122>(x); x += dpp_mov<0x121>(x); return x; }
__device__ __forceinline__ float oct_sum(float x) { x += dpp_mov<0xB1>(x); x += dpp_mov<0x4E>(x); x += dpp_mov<0x141>(x); return x; }
__device__ __forceinline__ float sum_x16(float x) { auto r = __builtin_amdgcn_permlane16_swap(__float_as_uint(x), __float_as_uint(x), false, false); return __uint_as_float(r[0]) + __uint_as_float(r[1]); }
__device__ __forceinline__ float sum_x32(float x) { auto r = __builtin_amdgcn_permlane32_swap(__float_as_uint(x), __float_as_uint(x), false, false); return __uint_as_float(r[0]) + __uint_as_float(r[1]); }
__device__ __forceinline__ float max_x16(float x) { auto r = __builtin_amdgcn_permlane16_swap(__float_as_uint(x), __float_as_uint(x), false, false); return fmaxf(__uint_as_float(r[0]), __uint_as_float(r[1])); }
__device__ __forceinline__ float max_x32(float x) { auto r = __builtin_amdgcn_permlane32_swap(__float_as_uint(x), __float_as_uint(x), false, false); return fmaxf(__uint_as_float(r[0]), __uint_as_float(r[1])); }

namespace pg8 {
#define PG8_LAS __attribute__((address_space(3)))
typedef unsigned short bf16_t;
typedef short bf16x8 __attribute__((ext_vector_type(8)));
typedef float f32x4 __attribute__((ext_vector_type(4)));
typedef unsigned u32x4 __attribute__((ext_vector_type(4)));
constexpr int BM = 256, BK = 64, HALF = 128, HTB = HALF * BK * 2  , STAGE_BYTES = 8 * HTB, NXCD = 8, WGM = 4;

__host__ __device__ __forceinline__ int lds_byte(int r, int c) { const int st = (r >> 4) * 2 + (c >> 5), rr = r & 15, cc = c & 31, ob = rr * 64 + cc * 2; return st * 1024 + (ob ^ (((ob >> 9) & 1) << 5)); }
__host__ __device__ __forceinline__ void stage_rc(int b, int& R, int& C) { const int st = b / 1024, sb = b % 1024, swz = sb ^ (((sb >> 9) & 1) << 5); R = (st >> 1) * 16 + swz / 64; C = (st & 1) * 32 + (swz % 64) / 2; }
__host__ __device__ __forceinline__ int perm32(int rho) { const int n = rho >> 4, i = rho & 15; return 8 * (i >> 2) + 4 * n + (i & 3); }

struct Unit { int pm, pn, kb, kn; };
struct Gemm { const bf16_t* A; const bf16_t* Bt; int M, N, K; };

struct StaticOrder {
    int nM, nN, nwg, G, c, ntk;
    __host__ __device__ void init(int M, int N, int K, int G_, int c_) { nM = M / BM; nN = N / BM; nwg = nM * nN; G = G_; c = c_; ntk = K / BK; }
    __host__ __device__ bool next(int i, Unit& u) const {
        const long L = (long)i * G + c; if (L >= nwg) return false;
        int wgid = (int)L; { const int q = nwg / NXCD, r = nwg % NXCD, xcd = wgid % NXCD, off = wgid / NXCD; wgid = (xcd < r ? xcd * (q + 1) : r * (q + 1) + (xcd - r) * q) + off; }
        const int nig = WGM * nN, gid = wgid / nig, fm = gid * WGM, gsz = (nM - fm) < WGM ? (nM - fm) : WGM;
        u.pm = fm + ((wgid % nig) % gsz); u.pn = (wgid % nig) / gsz; u.kb = 0; u.kn = ntk; return true;
    }
    __device__ __forceinline__ void a_ready(const Unit&) const {}
    __device__ __forceinline__ void done(const Unit&) const {}
};

struct SplitMetaOrder : StaticOrder {
    int nreg, nsplit; unsigned* ticket; volatile PG8_LAS unsigned* flag;
    __device__ void init2(int N, int K, int G_, int c_, unsigned* ticket_, volatile PG8_LAS unsigned* flag_) { init(64 * BM, N, K, G_, c_); nreg = nwg; nsplit = 16; ticket = ticket_; flag = flag_; }
    __device__ bool next(int i, Unit& u) const {
        const long L = (long)i * G + c;
        if (L < nreg) return StaticOrder::next(i, u);
        const int x = (int)(L - nreg); if (x >= nsplit * nN) return false;
        const int s = x % nsplit; u.pm = 64; u.pn = x / nsplit;
        const int base = (ntk / 2) / nsplit, rem = (ntk / 2) % nsplit;
        u.kb = 2 * (s * base + (s < rem ? s : rem)); u.kn = 2 * (base + (s < rem ? 1 : 0)); return true;
    }
    __device__ __forceinline__ void a_ready(const Unit&) const {}
    __device__ __forceinline__ void done(const Unit& u) const {
        if (u.pm == 64) { asm volatile("s_waitcnt vmcnt(0)" ::: "memory");
            if (hw_lane() == 0) { const unsigned old = __hip_atomic_fetch_add(ticket, 1u, __ATOMIC_RELAXED, __HIP_MEMORY_SCOPE_AGENT); if (old + 1u == (unsigned)(nsplit * nN * 8)) flag[0] = 1u; } }
    }
};
__device__ __forceinline__ unsigned cvt_pk_bf16(float lo, float hi) { unsigned r; asm volatile("v_cvt_pk_bf16_f32 %0, %1, %2" : "=v"(r) : "v"(lo), "v"(hi)); return r; }
__device__ __forceinline__ u32x4 pack8(const f32x4 a, const f32x4 b) { u32x4 w; w.x = cvt_pk_bf16(a[0], a[1]); w.y = cvt_pk_bf16(a[2], a[3]); w.z = cvt_pk_bf16(b[0], b[1]); w.w = cvt_pk_bf16(b[2], b[3]); return w; }
__device__ __forceinline__ float row_rstd(const u64* ssq, int r) { return __builtin_amdgcn_rsqf(fx_to_pos(ssq[r]) * (1.0f / 4096.0f) + RMS_EPS); }

struct EpiIn0 {
    static constexpr bool PERM = true, AFTER_DRAIN = false;
    bf16_t* Z; float* F; const u64* ssq;
    __device__ __forceinline__ void operator()(const f32x4 (&acc)[2][2][4][2], const Unit& u, int wr, int wc, int fr, int fq) const {
        const int row0 = u.pm * BM + wr * 64 + fr;
        if (u.pn < 40) {
            const int col0 = u.pn * BM + wc * 32 + 8 * fq;
#pragma unroll
            for (int ai = 0; ai < 2; ++ai)
#pragma unroll
                for (int m = 0; m < 4; ++m) { const int r = row0 + ai * HALF + m * 16; const float rs = row_rstd(ssq, r); bf16_t* rowp = Z + (size_t)r * AB_Z + col0;
#pragma unroll
                    for (int bj = 0; bj < 2; ++bj) *(u32x4*)(rowp + bj * HALF) = pack8(acc[ai][bj][m][0] * rs, acc[ai][bj][m][1] * rs); }
        } else if (wc == 0 && fq < 2) {
#pragma unroll
            for (int ai = 0; ai < 2; ++ai)
#pragma unroll
                for (int m = 0; m < 4; ++m) { const int r = row0 + ai * HALF + m * 16; const float rs = row_rstd(ssq, r); float* fp = F + (size_t)r * 16 + 8 * fq;
                    *(f32x4*)(fp) = acc[ai][0][m][0] * rs; *(f32x4*)(fp + 4) = acc[ai][0][m][1] * rs; }
        }
    }
};
template <bool F32IN>
struct EpiResT {
    static constexpr bool PERM = true, AFTER_DRAIN = false;
    const float* Hin; u64* Hmeta; bf16_t* XB; u64* ssq_out; int K_TILES;
    __device__ __forceinline__ void operator()(const f32x4 (&acc)[2][2][4][2], const Unit& u, int wr, int wc, int fr, int fq) const {
        const int row0 = u.pm * BM + wr * 64 + fr, col0 = u.pn * BM + wc * 32 + 8 * fq;
        if (u.pm == MTOK / BM) {
            if (wr == 0) {
#pragma unroll
                for (int m = 0; m < 4; ++m) { u64* hp = Hmeta + (size_t)(m * 16 + fr) * DM + col0;
#pragma unroll
                    for (int bj = 0; bj < 2; ++bj)
#pragma unroll
                        for (int n = 0; n < 2; ++n)
#pragma unroll
                            for (int j = 0; j < 4; ++j) atomicAdd(hp + bj * HALF + 4 * n + j, fx_from(acc[0][bj][m][n][j])); } }
            return; }
        if (F32IN) {
#pragma unroll
            for (int ai = 0; ai < 2; ++ai)
#pragma unroll
                for (int mp = 0; mp < 4; mp += 2) {
                    f32x4 hv[2][2][2];
#pragma unroll
                    for (int q = 0; q < 2; ++q) { const float* hi = Hin + (size_t)(row0 + ai * HALF + (mp + q) * 16) * DM + col0;
#pragma unroll
                        for (int bj = 0; bj < 2; ++bj) { hv[q][bj][0] = *(const f32x4*)(hi + bj * HALF); hv[q][bj][1] = *(const f32x4*)(hi + bj * HALF + 4); } }
#pragma unroll
                    for (int q = 0; q < 2; ++q) { const int m = mp + q; const int r = row0 + ai * HALF + m * 16; bf16_t* xp = XB + (size_t)r * DM + col0; float s = 0.f;
#pragma unroll
                        for (int bj = 0; bj < 2; ++bj) { const f32x4 v0 = hv[q][bj][0] + acc[ai][bj][m][0], v1 = hv[q][bj][1] + acc[ai][bj][m][1];
                            *(u32x4*)(xp + bj * HALF) = pack8(v0, v1);
                            s += (v0[0] * v0[0] + v0[1] * v0[1]) + (v0[2] * v0[2] + v0[3] * v0[3]) + (v1[0] * v1[0] + v1[1] * v1[1]) + (v1[2] * v1[2] + v1[3] * v1[3]); }
                        s = sum_x32(sum_x16(s));
                        if (fq == 0) atomicAdd(ssq_out + r, fx_from_pos(s)); }
                    asm volatile("" ::: "memory"); }
        } else {
#pragma unroll
            for (int ai = 0; ai < 2; ++ai) {
                u32x4 hb[4][2];
#pragma unroll
                for (int m = 0; m < 4; ++m) { const bf16_t* xi = XB + (size_t)(row0 + ai * HALF + m * 16) * DM + col0;
#pragma unroll
                    for (int bj = 0; bj < 2; ++bj) hb[m][bj] = *(const u32x4*)(xi + bj * HALF); }
#pragma unroll
                for (int m = 0; m < 4; ++m) { const int r = row0 + ai * HALF + m * 16; bf16_t* xp = XB + (size_t)r * DM + col0; float s = 0.f;
#pragma unroll
                    for (int bj = 0; bj < 2; ++bj) { const u32x4 w = hb[m][bj];
                        const f32x4 h0 = {__builtin_bit_cast(float, w[0] << 16), __builtin_bit_cast(float, w[0] & 0xffff0000u), __builtin_bit_cast(float, w[1] << 16), __builtin_bit_cast(float, w[1] & 0xffff0000u)};
                        const f32x4 h1 = {__builtin_bit_cast(float, w[2] << 16), __builtin_bit_cast(float, w[2] & 0xffff0000u), __builtin_bit_cast(float, w[3] << 16), __builtin_bit_cast(float, w[3] & 0xffff0000u)};
                        const f32x4 v0 = h0 + acc[ai][bj][m][0], v1 = h1 + acc[ai][bj][m][1];
                        *(u32x4*)(xp + bj * HALF) = pack8(v0, v1);
                        s += (v0[0] * v0[0] + v0[1] * v0[1]) + (v0[2] * v0[2] + v0[3] * v0[3]) + (v1[0] * v1[0] + v1[1] * v1[1]) + (v1[2] * v1[2] + v1[3] * v1[3]); }
                    s = sum_x32(sum_x16(s));
                    if (fq == 0) atomicAdd(ssq_out + r, fx_from_pos(s)); }
                asm volatile("" ::: "memory"); }
        }
    }
};
typedef EpiResT<true> EpiResX;
typedef EpiResT<false> EpiRes;
struct EpiFinal {
    static constexpr bool PERM = true, AFTER_DRAIN = false;
    const bf16_t* XB; float* OUT;
    __device__ __forceinline__ void operator()(const f32x4 (&acc)[2][2][4][2], const Unit& u, int wr, int wc, int fr, int fq) const {
        const int row0 = u.pm * BM + wr * 64 + fr, col0 = u.pn * BM + wc * 32 + 8 * fq;
#pragma unroll
        for (int ai = 0; ai < 2; ++ai) {
            u32x4 hb[4][2];
#pragma unroll
            for (int m = 0; m < 4; ++m) { const bf16_t* xi = XB + (size_t)(row0 + ai * HALF + m * 16) * DM + col0;
#pragma unroll
                for (int bj = 0; bj < 2; ++bj) hb[m][bj] = *(const u32x4*)(xi + bj * HALF); }
#pragma unroll
            for (int m = 0; m < 4; ++m) { float* op = OUT + (size_t)(row0 + ai * HALF + m * 16) * DM + col0;
#pragma unroll
                for (int bj = 0; bj < 2; ++bj) { const u32x4 w = hb[m][bj];
                    const f32x4 h0 = {__builtin_bit_cast(float, w[0] << 16), __builtin_bit_cast(float, w[0] & 0xffff0000u), __builtin_bit_cast(float, w[1] << 16), __builtin_bit_cast(float, w[1] & 0xffff0000u)};
                    const f32x4 h1 = {__builtin_bit_cast(float, w[2] << 16), __builtin_bit_cast(float, w[2] & 0xffff0000u), __builtin_bit_cast(float, w[3] << 16), __builtin_bit_cast(float, w[3] & 0xffff0000u)};
                    *(f32x4*)(op + bj * HALF) = h0 + acc[ai][bj][m][0]; *(f32x4*)(op + bj * HALF + 4) = h1 + acc[ai][bj][m][1]; } }
            asm volatile("" ::: "memory"); }
    }
};
struct EpiGU {
    static constexpr bool PERM = true, AFTER_DRAIN = false;
    bf16_t* HID; const u64* ssq;
    __device__ __forceinline__ void operator()(const f32x4 (&acc)[2][2][4][2], const Unit& u, int wr, int wc, int fr, int fq) const {
        const int row0 = u.pm * BM + wr * 64 + fr, col0 = u.pn * HALF + wc * 32 + 8 * fq;
#pragma unroll
        for (int ai = 0; ai < 2; ++ai)
#pragma unroll
            for (int m = 0; m < 4; ++m) { const int r = row0 + ai * HALF + m * 16; const float rs = row_rstd(ssq, r); f32x4 o[2];
#pragma unroll
                for (int n = 0; n < 2; ++n)
#pragma unroll
                    for (int j = 0; j < 4; ++j) { const float g = acc[ai][0][m][n][j] * rs, uu = acc[ai][1][m][n][j] * rs;
                        o[n][j] = g * uu * __builtin_amdgcn_rcpf(1.0f + __expf(-g)); }
                *(u32x4*)(HID + (size_t)r * DFF + col0) = pack8(o[0], o[1]); }
    }
};
struct EpiIn1 {
    static constexpr bool PERM = true, AFTER_DRAIN = false;
    bf16_t* Z; const u64* ssq;
    __device__ __forceinline__ void operator()(const f32x4 (&acc)[2][2][4][2], const Unit& u, int wr, int wc, int fr, int fq) const {
        const int row0 = u.pm * BM + wr * 64 + fr, col0 = u.pn * BM + wc * 32 + 8 * fq;
        if (u.pn < 32) {
            const float sc = u.pn < 16 ? 1.0f : 0.0625f;
            float inv[2][4];
#pragma unroll
            for (int n = 0; n < 2; ++n)
#pragma unroll
                for (int j = 0; j < 4; ++j) inv[n][j] = exp2f(-(float)(wc * 32 + 8 * fq + 4 * n + j) * (13.287712379549449f / 128.0f));
#pragma unroll
            for (int ai = 0; ai < 2; ++ai)
#pragma unroll
                for (int m = 0; m < 4; ++m) { const int r = row0 + ai * HALF + m * 16; const float rs = row_rstd(ssq, r) * sc;
                    const float t = (float)(r < MTOK ? NMETA + (r & (SEQ - 1)) : ((r - MTOK) & 15));
                    f32x4 o1[2], o2[2];
#pragma unroll
                    for (int n = 0; n < 2; ++n)
#pragma unroll
                        for (int j = 0; j < 4; ++j) { const float x1 = acc[ai][0][m][n][j] * rs, x2 = acc[ai][1][m][n][j] * rs;
                            const float ang = t * inv[n][j]; float rev = ang * 0.15915494309189535f; rev = rev - floorf(rev);
                            const float c = __builtin_amdgcn_cosf(rev), s = __builtin_amdgcn_sinf(rev);
                            o1[n][j] = x1 * c - x2 * s; o2[n][j] = x1 * s + x2 * c; }
                    bf16_t* rowp = Z + (size_t)r * RET_IN + col0;
                    *(u32x4*)(rowp) = pack8(o1[0], o1[1]); *(u32x4*)(rowp + HALF) = pack8(o2[0], o2[1]); }
        } else {
#pragma unroll
            for (int ai = 0; ai < 2; ++ai)
#pragma unroll
                for (int m = 0; m < 4; ++m) { const int r = row0 + ai * HALF + m * 16; const float rs = row_rstd(ssq, r); bf16_t* rowp = Z + (size_t)r * RET_IN + col0;
#pragma unroll
                    for (int bj = 0; bj < 2; ++bj) *(u32x4*)(rowp + bj * HALF) = pack8(acc[ai][bj][m][0] * rs, acc[ai][bj][m][1] * rs); }
        }
    }
};

struct EpiNone {
    static constexpr bool PERM = true, AFTER_DRAIN = false;
    __device__ __forceinline__ void operator()(const f32x4 (&acc)[2][2][4][2], const Unit&, int, int, int, int) const {
#pragma unroll
        for (int ai = 0; ai < 2; ++ai)
#pragma unroll
            for (int bj = 0; bj < 2; ++bj)
#pragma unroll
                for (int m = 0; m < 4; ++m) asm volatile("" :: "v"(acc[ai][bj][m][0]), "v"(acc[ai][bj][m][1]));
    }
};
struct HotOrder : StaticOrder {
    __device__ bool next(int i, Unit& u) const { const bool ok = StaticOrder::next(i, u); u.pm = 0; u.pn = 0; return ok; }
    __device__ __forceinline__ void a_ready(const Unit&) const {}
    __device__ __forceinline__ void done(const Unit&) const {}
};
template <class Epi, class Sched, bool ALIGN_EPI = false, bool SP2 = false>
__device__ __forceinline__ void gemm_phase(PG8_LAS unsigned char* lds, const Gemm g, const Sched& S, const Epi& E, const int wid) {
    const int lane = hw_lane(), tid = wid * 64 + lane, wr = wid >> 2, wc = wid & 3, fr = lane & 15, fq = lane >> 4;
    const int K = g.K; int nt;
    unsigned voffA[2], voffB[2];
#pragma unroll
    for (int i = 0; i < 2; ++i) { int R, C; stage_rc(tid * 16 + i * 8192, R, C); const int Rb = Epi::PERM ? ((R & ~31) + perm32(R & 31)) : R;
        voffA[i] = (unsigned)(R * K + C) * 2u; voffB[i] = (unsigned)(Rb * K + C) * 2u; }
    const size_t kstep = (size_t)(BK * 2);
    const size_t hstep = (size_t)HALF * K * 2;
    const size_t tstep = 2 * hstep;
    const unsigned ldsw = (unsigned)wid * 1024u;
    const int aoff = lds_byte(wr * 64 + fr, fq * 8), boff = lds_byte(wc * 32 + fr, fq * 8);
#define PG8_SA(b, h) (((b) * 2 + (h)) * HTB)
#define PG8_SB(b, h) ((4 + (b) * 2 + (h)) * HTB)
#define PG8_STAGE(bufoff, gbase, voff) do { _Pragma("unroll") for (int _i = 0; _i < 2; ++_i) \
        __builtin_amdgcn_global_load_lds((const unsigned*)((const char*)(gbase) + (voff)[_i]), (PG8_LAS unsigned*)(lds + (bufoff) + ldsw + _i * 8192), 16, 0, 0); } while (0)
#define PG8_LDA(dst, b, h) do { _Pragma("unroll") for (int m = 0; m < 4; ++m) _Pragma("unroll") for (int k = 0; k < 2; ++k) dst[m][k] = *(const PG8_LAS bf16x8*)(lds + PG8_SA(b, h) + aoff + m * 2048 + k * 1024); } while (0)
#define PG8_LDB(dst, b, h) do { _Pragma("unroll") for (int n = 0; n < 2; ++n) _Pragma("unroll") for (int k = 0; k < 2; ++k) dst[n][k] = *(const PG8_LAS bf16x8*)(lds + PG8_SB(b, h) + boff + n * 2048 + k * 1024); } while (0)
#define PG8_MMA(ai, bj, At, Bt) do { __builtin_amdgcn_s_setprio(1); _Pragma("unroll") for (int m = 0; m < 4; ++m) _Pragma("unroll") for (int n = 0; n < 2; ++n) _Pragma("unroll") for (int k = 0; k < 2; ++k) \
        acc[ai][bj][m][n] = __builtin_amdgcn_mfma_f32_16x16x32_bf16(Bt[n][k], At[m][k], acc[ai][bj][m][n], 0, 0, 0); __builtin_amdgcn_s_setprio(0); } while (0)
#define PG8_WAIT_V(n) asm volatile("s_waitcnt vmcnt(" #n ")" ::: "memory")
#define PG8_WAIT_L(n) asm volatile("s_waitcnt lgkmcnt(" #n ")" ::: "memory")
#define PG8_BAR __builtin_amdgcn_s_barrier()
#define PG8_SCHED __builtin_amdgcn_sched_barrier(0)
    Unit cur, nxt; int ui = 0;
    if (!S.next(0, cur)) return;
    nt = cur.kn;
    f32x4 acc[2][2][4][2];
#pragma unroll
    for (int a = 0; a < 2; ++a)
#pragma unroll
        for (int b = 0; b < 2; ++b)
#pragma unroll
            for (int m = 0; m < 4; ++m)
#pragma unroll
                for (int n = 0; n < 2; ++n) acc[a][b][m][n] = (f32x4){0.f, 0.f, 0.f, 0.f};
    bf16x8 At[4][2], B0[2][2], B1[2][2];
    const char* cA = (const char*)g.A + (size_t)cur.pm * tstep + (size_t)cur.kb * kstep; const char* cB = (const char*)g.Bt + (size_t)cur.pn * tstep + (size_t)cur.kb * kstep;
    S.a_ready(cur);
    if constexpr (SP2) {
        PG8_STAGE(PG8_SB(0, 0), cB, voffB); PG8_STAGE(PG8_SB(0, 1), cB + hstep, voffB); PG8_STAGE(PG8_SA(0, 0), cA, voffA); PG8_STAGE(PG8_SA(0, 1), cA + hstep, voffA);
        if (wr == 1) PG8_BAR;
        PG8_WAIT_V(2); PG8_BAR;
        PG8_STAGE(PG8_SB(1, 0), cB + kstep, voffB); PG8_STAGE(PG8_SA(1, 0), cA + kstep, voffA); PG8_STAGE(PG8_SB(1, 1), cB + hstep + kstep, voffB);
        PG8_WAIT_V(6); PG8_BAR;
    } else {
        PG8_STAGE(PG8_SB(0, 0), cB, voffB); PG8_STAGE(PG8_SA(0, 0), cA, voffA); PG8_STAGE(PG8_SB(0, 1), cB + hstep, voffB); PG8_STAGE(PG8_SA(0, 1), cA + hstep, voffA);
        if (wr == 1) PG8_BAR;
        PG8_WAIT_V(4); PG8_BAR;
        PG8_STAGE(PG8_SB(1, 0), cB + kstep, voffB); PG8_STAGE(PG8_SA(1, 0), cA + kstep, voffA); PG8_STAGE(PG8_SB(1, 1), cB + hstep + kstep, voffB);
        PG8_WAIT_V(6); PG8_BAR;
    }
    for (;;) {
        const bool has_next = S.next(ui + 1, nxt);
        const char* nA = has_next ? (const char*)g.A + (size_t)nxt.pm * tstep + (size_t)nxt.kb * kstep : cA; const char* nB = has_next ? (const char*)g.Bt + (size_t)nxt.pn * tstep + (size_t)nxt.kb * kstep : cB;
        for (int t = 0; t < nt; t += 2) {
            const bool last = (t == nt - 2);
            const char* a1 = cA + (size_t)(t + 1) * kstep;
            const char* a2 = last ? nA : cA + (size_t)(t + 2) * kstep; const char* b2 = last ? nB : cB + (size_t)(t + 2) * kstep;
            const char* a3 = a2 + kstep; const char* b3 = b2 + kstep;
            if (last && has_next) S.a_ready(nxt);
            if constexpr (SP2) {
            PG8_LDB(B0, 0, 0); PG8_LDB(B1, 0, 1); PG8_SCHED; PG8_LDA(At, 0, 0); PG8_STAGE(PG8_SA(1, 1), a1 + hstep, voffA);
            PG8_WAIT_V(8); PG8_WAIT_L(0); PG8_BAR; PG8_MMA(0, 0, At, B0); PG8_MMA(0, 1, At, B1); PG8_BAR; PG8_SCHED;
            PG8_LDA(At, 0, 1); PG8_STAGE(PG8_SB(0, 0), b2, voffB); PG8_STAGE(PG8_SB(0, 1), b2 + hstep, voffB); PG8_STAGE(PG8_SA(0, 0), a2, voffA);
            PG8_WAIT_V(8); PG8_WAIT_L(0); PG8_BAR; PG8_MMA(1, 0, At, B0); PG8_MMA(1, 1, At, B1); PG8_BAR; PG8_SCHED;
            PG8_LDB(B0, 1, 0); PG8_LDB(B1, 1, 1); PG8_SCHED; PG8_LDA(At, 1, 0); PG8_STAGE(PG8_SA(0, 1), a2 + hstep, voffA);
            PG8_WAIT_V(8); PG8_WAIT_L(0); PG8_BAR; PG8_MMA(0, 0, At, B0); PG8_MMA(0, 1, At, B1); PG8_BAR; PG8_SCHED;
            PG8_LDA(At, 1, 1); PG8_STAGE(PG8_SB(1, 0), b3, voffB); PG8_STAGE(PG8_SB(1, 1), b3 + hstep, voffB); PG8_STAGE(PG8_SA(1, 0), a3, voffA);
            PG8_WAIT_V(8); PG8_WAIT_L(0); PG8_BAR; PG8_MMA(1, 0, At, B0); PG8_MMA(1, 1, At, B1); PG8_BAR; PG8_SCHED;
            } else {
            PG8_LDB(B0, 0, 0); PG8_SCHED; PG8_LDA(At, 0, 0); PG8_STAGE(PG8_SA(1, 1), a1 + hstep, voffA);
            PG8_WAIT_L(8); PG8_BAR; PG8_WAIT_L(0); PG8_MMA(0, 0, At, B0); PG8_BAR; PG8_SCHED;
            PG8_LDB(B1, 0, 1); PG8_STAGE(PG8_SB(0, 0), b2, voffB);
            PG8_BAR; PG8_WAIT_L(0); PG8_MMA(0, 1, At, B1); PG8_BAR;
            PG8_LDA(At, 0, 1); PG8_STAGE(PG8_SA(0, 0), a2, voffA);
            PG8_BAR; PG8_WAIT_L(0); PG8_MMA(1, 0, At, B0); PG8_BAR; PG8_SCHED;
            PG8_STAGE(PG8_SB(0, 1), b2 + hstep, voffB);
            PG8_WAIT_V(6); PG8_BAR; PG8_MMA(1, 1, At, B1); PG8_BAR;
            PG8_LDB(B0, 1, 0); PG8_SCHED; PG8_LDA(At, 1, 0); PG8_STAGE(PG8_SA(0, 1), a2 + hstep, voffA);
            PG8_WAIT_L(8); PG8_BAR; PG8_WAIT_L(0); PG8_MMA(0, 0, At, B0); PG8_BAR; PG8_SCHED;
            PG8_LDB(B1, 1, 1); PG8_STAGE(PG8_SB(1, 0), b3, voffB);
            PG8_BAR; PG8_WAIT_L(0); PG8_MMA(0, 1, At, B1); PG8_BAR;
            PG8_LDA(At, 1, 1); PG8_STAGE(PG8_SA(1, 0), a3, voffA);
            PG8_BAR; PG8_WAIT_L(0); PG8_MMA(1, 0, At, B0); PG8_BAR; PG8_SCHED;
            PG8_STAGE(PG8_SB(1, 1), b3 + hstep, voffB);
            PG8_WAIT_V(6); PG8_BAR; PG8_MMA(1, 1, At, B1); PG8_BAR;
            }
        }
        if constexpr (ALIGN_EPI) { if (wr == 0) PG8_BAR; }
        if constexpr (!Epi::AFTER_DRAIN) { E(acc, cur, wr, wc, fr, fq); S.done(cur); }
        if (!has_next) break;
#pragma unroll
        for (int a = 0; a < 2; ++a)
#pragma unroll
            for (int b = 0; b < 2; ++b)
#pragma unroll
                for (int m = 0; m < 4; ++m)
#pragma unroll
                    for (int n = 0; n < 2; ++n) acc[a][b][m][n] = (f32x4){0.f, 0.f, 0.f, 0.f};
        cur = nxt; cA = nA; cB = nB; ++ui; nt = cur.kn;
        if constexpr (ALIGN_EPI) { if (wr == 1) PG8_BAR; }
    }
    PG8_WAIT_V(0);
    if constexpr (!ALIGN_EPI) { if (wr == 0) PG8_BAR; }
    PG8_BAR;
    if constexpr (Epi::AFTER_DRAIN) { E.fused(acc, cur, wr, wc, fr, fq, lds, wid, lane); S.done(cur); }
#undef PG8_SA
#undef PG8_SB
#undef PG8_STAGE
#undef PG8_LDA
#undef PG8_LDB
#undef PG8_MMA
#undef PG8_WAIT_V
#undef PG8_WAIT_L
#undef PG8_BAR
#undef PG8_SCHED
}
}

constexpr size_t MiB = 1u << 20;
constexpr size_t WS_CTL = 0, CTL_ZERO_BYTES = 4 * MiB;
constexpr size_t WS_SSQ1 = 64 * 1024, WS_SSQ2 = 256 * 1024, WS_SSQ3 = 448 * 1024, WS_SSQO = 640 * 1024;
constexpr size_t WS_SSQ0 = 4 * MiB;
constexpr size_t WS_FBUF = 4 * MiB + 256 * 1024;
constexpr size_t WS_HMETA = 6 * MiB;
constexpr size_t WS_WIN0 = 8 * MiB, WS_WOUT0 = 90 * MiB, WS_WGU0 = 122 * MiB, WS_WD0 = 294 * MiB, WS_WIN1 = 380 * MiB, WS_WOUT1 = 572 * MiB, WS_WGU1 = 636 * MiB, WS_WD1 = 808 * MiB;
constexpr size_t WS_WAT = 894 * MiB, WS_WXT = WS_WAT + 512 * 1024;
constexpr size_t WS_XB = 896 * MiB, WS_Z = 1026 * MiB, WS_END = 1806 * MiB;
constexpr size_t WS_Y0 = WS_Z + 400 * MiB;
constexpr size_t WS_Y1 = 8 * MiB;
static_assert(WS_SSQ1 + (size_t)MP * 8 <= WS_SSQ2 && WS_SSQ2 + (size_t)MP * 8 <= WS_SSQ3 && WS_SSQ3 + (size_t)MP * 8 <= WS_SSQO && WS_SSQO + (size_t)MP * 16 * 8 <= CTL_ZERO_BYTES && WS_SSQ0 + (size_t)MP * 8 <= WS_FBUF && WS_FBUF + (size_t)MP * 16 * 4 <= WS_HMETA && WS_HMETA + (size_t)64 * DM * 8 <= WS_WIN0, "ctl map");
static_assert(WS_WIN0 + (size_t)41 * 256 * DM * 2 <= WS_WOUT0 && WS_WGU0 + (size_t)2 * DFF * DM * 2 <= WS_WD0 && WS_WD0 + (size_t)DM * DFF * 2 <= WS_WIN1 && WS_WIN1 + (size_t)RET_IN * DM * 2 <= WS_WOUT1, "weight map");
static_assert(WS_WOUT1 + (size_t)DM * RET_VW * 2 <= WS_WGU1 && WS_WGU1 + (size_t)2 * DFF * DM * 2 <= WS_WD1 && WS_WD1 + (size_t)DM * DFF * 2 <= WS_WAT, "weight map 2");
static_assert(WS_XB + (size_t)MP * DM * 2 <= WS_Z && WS_Z + (size_t)MP * RET_IN * 2 <= WS_END && WS_Z + (size_t)MP * AB_Z * 2 <= WS_Y0 && WS_Z + (size_t)MP * DFF * 2 <= WS_Y0 && WS_Y0 + (size_t)MP * DM * 2 <= WS_END && WS_Y1 + (size_t)MP * RET_VW * 2 <= WS_WD0, "activation map");
constexpr int CW_TMO = 0, CW_Q2 = 64, CW_TK3 = 256, CW_TK5 = 320, CW_QC = 384, CW_ACT = 512, CW_TL1 = 640, CW_TL4 = 704, CW_TL6 = 768, CW_TL10 = 832, CW_BAR = 4096;
constexpr int RING_BYTES = 131072;
constexpr int LDS_BYTES = 147456;
constexpr int MISC_OFF = LDS_BYTES - 256;
constexpr int NWAVES = 8, NTHREADS = 512;
constexpr int NPHASES = 12;

#define GAS __attribute__((address_space(1)))
#define LAS __attribute__((address_space(3)))
typedef unsigned short bf16;
typedef unsigned v4u __attribute__((ext_vector_type(4)));
typedef unsigned v2u __attribute__((ext_vector_type(2)));
typedef float f32x4 __attribute__((ext_vector_type(4)));
typedef float v2f __attribute__((ext_vector_type(2)));
typedef short bf16x8 __attribute__((ext_vector_type(8)));
typedef short bf16x4 __attribute__((ext_vector_type(4)));
typedef GAS unsigned gu32;
#define RLX_AGENT __ATOMIC_RELAXED, __HIP_MEMORY_SCOPE_AGENT
#define LDS_WAIT() asm volatile("s_waitcnt lgkmcnt(0)" ::: "memory")
#define VM_WAIT() asm volatile("s_waitcnt vmcnt(0)" ::: "memory")
__device__ __forceinline__ unsigned f2bf(float f) { unsigned u = __builtin_bit_cast(unsigned, f); return (u + 0x7fffu + ((u >> 16) & 1u)) >> 16; }
__device__ __forceinline__ unsigned pk2(float lo, float hi) { return pg8::cvt_pk_bf16(lo, hi); }
__device__ __forceinline__ float bflo(unsigned w) { return __builtin_bit_cast(float, w << 16); }
__device__ __forceinline__ float bfhi(unsigned w) { return __builtin_bit_cast(float, w & 0xffff0000u); }
__device__ __forceinline__ float bf2f(unsigned short h) { return __builtin_bit_cast(float, (unsigned)h << 16); }
__device__ __forceinline__ void unpack8(const v4u w, float (&f)[8]) { f[0] = bflo(w.x); f[1] = bfhi(w.x); f[2] = bflo(w.y); f[3] = bfhi(w.y); f[4] = bflo(w.z); f[5] = bfhi(w.z); f[6] = bflo(w.w); f[7] = bfhi(w.w); }
__device__ __forceinline__ v4u pack8f(const float (&f)[8]) { v4u w; w.x = pk2(f[0], f[1]); w.y = pk2(f[2], f[3]); w.z = pk2(f[4], f[5]); w.w = pk2(f[6], f[7]); return w; }
__device__ __forceinline__ int row_of(int b, int t) { return t < NMETA ? MMETA + NMETA * b + t : b * SEQ + (t - NMETA); }
__device__ __forceinline__ f32x4 mfma16(bf16x8 a, bf16x8 b, f32x4 c) { return __builtin_amdgcn_mfma_f32_16x16x32_bf16(a, b, c, 0, 0, 0); }

#define XB_TMO      128
#define XB_XCNT(j)  (256  + 64 * (j))
#define XB_XSUB(j)  (1280 + 64 * (j))
#define XB_XGEN(j)  (2304 + 64 * (j))
#define XB_TOP      3328
#define XB_TOPGEN   3392
#define XCD_BAR_WORDS 3456
#define XB_SPIN_CAP (1u << 22)

__device__ __forceinline__ unsigned xb_ld(unsigned* p)              { return __hip_atomic_load(p, __ATOMIC_RELAXED, __HIP_MEMORY_SCOPE_AGENT); }
__device__ __forceinline__ unsigned xb_add(unsigned* p, unsigned v) { return __hip_atomic_fetch_add(p, v, __ATOMIC_RELAXED, __HIP_MEMORY_SCOPE_AGENT); }
__device__ __forceinline__ unsigned xb_xcc_id() { return (unsigned)__builtin_amdgcn_s_getreg((3 << 11) | 20) & 0xFu; }
#define XB_SPIN(cond, bar) do { unsigned _sp = 0; while (cond) { __builtin_amdgcn_s_sleep(1); \
    if ((++_sp & 255u) == 0u) { if (xb_ld(&(bar)[XB_TMO])) break; if (_sp > XB_SPIN_CAP) { atomicAdd(&(bar)[XB_TMO], 1u); break; } } } } while (0)

struct XcdBarrier {
    unsigned* bar; unsigned x; int wave;
    volatile LAS unsigned* st;
};
__device__ __forceinline__ XcdBarrier xcd_barrier_post(unsigned* bar, volatile LAS unsigned* st, int wave) {
    XcdBarrier b; b.bar = bar; b.x = xb_xcc_id(); b.st = st; b.wave = wave;
    if (threadIdx.x == 0) (void)xb_add(&bar[XB_XCNT(b.x)], 1u);
    return b;
}
__device__ __forceinline__ void xcd_barrier_complete(unsigned* bar, unsigned x, unsigned& nloc, unsigned& nx) {
    const unsigned G = gridDim.x * gridDim.y * gridDim.z;
    unsigned sum, cnt, mine, sp = 0u;
    for (;;) {
        sum = 0u; cnt = 0u; mine = 0u;
#pragma unroll
        for (unsigned j = 0; j < 16; ++j) { const unsigned c = xb_ld(&bar[XB_XCNT(j)]); sum += c; cnt += (c > 0u) ? 1u : 0u; mine = (j == x) ? c : mine; }
        if (sum == G) break;
        __builtin_amdgcn_s_sleep(1);
        if ((++sp & 255u) == 0u) { if (xb_ld(&bar[XB_TMO])) break; if (sp > XB_SPIN_CAP) { atomicAdd(&bar[XB_TMO], 1u); break; } }
    }
    nloc = mine > 0u ? mine : 1u; nx = cnt > 0u ? cnt : 1u;
}
__device__ __forceinline__ void xcd_barrier(const XcdBarrier& b) {
    asm volatile("s_waitcnt vmcnt(0)" ::: "memory");
    __syncthreads();
    if (b.wave == 0 && hw_lane() == 0) {
        unsigned* bar = b.bar;
        __builtin_amdgcn_s_waitcnt(0);
        unsigned nloc = b.st[0], nx = b.st[1];
        if (nloc == 0u) { xcd_barrier_complete(bar, b.x, nloc, nx); b.st[0] = nloc; b.st[1] = nx; }
        const unsigned old = xb_add(&bar[XB_XSUB(b.x)], 1u);
        const unsigned gen = old / nloc;
        if (old + 1u == (gen + 1u) * nloc) {
            __builtin_amdgcn_fence(__ATOMIC_RELEASE, "agent");
            asm volatile("s_waitcnt vmcnt(0)" ::: "memory");
            const unsigned og = xb_add(&bar[XB_TOP], 1u);
            const unsigned tg = og / nx;
            if (og + 1u == (tg + 1u) * nx) xb_add(&bar[XB_TOPGEN], 1u);
            else XB_SPIN(xb_ld(&bar[XB_TOPGEN]) == tg, bar);
            __builtin_amdgcn_fence(__ATOMIC_ACQUIRE, "agent");
            xb_add(&bar[XB_XGEN(b.x)], 1u);
            asm volatile("s_waitcnt vmcnt(0)" ::: "memory");
        } else {
            XB_SPIN(xb_ld(&bar[XB_XGEN(b.x)]) == gen, bar);
            __builtin_amdgcn_fence(__ATOMIC_ACQUIRE, "agent");
            asm volatile("s_waitcnt vmcnt(0)" ::: "memory");
        }
    }
    __syncthreads();
}

struct Args { const float* in[23]; float* out; unsigned char* ws; int ph_lo, ph_hi; };
__device__ __forceinline__ float* h_row(float* out, unsigned char* ws, int r) { return r < MTOK ? out + (size_t)r * DM : (float*)(ws + WS_HMETA) + (size_t)(r - MTOK) * DM; }
struct Frame {
    LAS unsigned char* lds;
    volatile LAS unsigned* MISC;
    unsigned char* ws;
    int tid, lane, wave, G;
};
__device__ __forceinline__ float wave_sum(float v) {
    return sum_x32(sum_x16(row16_sum(v)));
}

template <int MODE, int KCH, bool GAIN = false>
__device__ __forceinline__ void p0_tr(const float* W, int K, int N, bf16* WT, LAS unsigned* tile, int item, int lane, const float* gk = nullptr) {
    const int nkc = K / KCH, nb = item / nkc, kc = item - nb * nkc, k0 = kc * KCH, n0 = nb * 64;
    const int kq = lane >> 4, nq = lane & 15; const int n = n0 + 4 * nq; const bool ok = n < N;
    const float* src = W + (size_t)(k0 + 2 * kq) * N + (ok ? n : 0);
    const int nr = lane >> 3, kch = lane & 7;
    f32x4 va[8][2]; v2f gv[8];
#define P0_LOADH(sub, h) do { _Pragma("unroll") for (int i = 4 * (h); i < 4 * (h) + 4; ++i) { const float* p_ = src + (size_t)(64 * (sub) + 8 * i) * N; va[i][0] = __builtin_nontemporal_load((const GAS f32x4*)p_); va[i][1] = __builtin_nontemporal_load((const GAS f32x4*)(p_ + N)); \
            if (GAIN) gv[i] = *(const GAS v2f*)(gk + k0 + 64 * (sub) + 8 * i + 2 * kq); } } while (0)
#define P0_WRH(h) do { _Pragma("unroll") for (int i = 4 * (h); i < 4 * (h) + 4; ++i) { \
            _Pragma("unroll") for (int c = 0; c < 4; ++c) tile[(4 * nq + c) * 33 + 4 * i + kq] = GAIN ? pk2(va[i][0][c] * gv[i].x, va[i][1][c] * gv[i].y) : pk2(va[i][0][c], va[i][1][c]); } } while (0)
#define P0_OUT(sub) do { const int kb = k0 + 64 * (sub); \
        LDS_WAIT(); asm volatile("" ::: "memory"); \
        _Pragma("unroll") for (int st = 0; st < 8; ++st) { const int row = 8 * st + nr; const LAS unsigned* tp = tile + row * 33 + 4 * kch; \
            v4u o; o.x = tp[0]; o.y = tp[1]; o.z = tp[2]; o.w = tp[3]; \
            const int ng = n0 + row; const int drow = MODE == 0 ? ng : (MODE == 1 ? 256 * (ng >> 7) + (ng & 127) : 256 * (ng >> 7) + 128 + (ng & 127)); \
            if (ng < N) __builtin_nontemporal_store(o, (GAS v4u*)(WT + (size_t)drow * K + kb + 8 * kch)); } \
        LDS_WAIT(); asm volatile("" ::: "memory"); } while (0)
    P0_LOADH(0, 0); P0_LOADH(0, 1);
#pragma unroll 1
    for (int sub = 0; sub < KCH / 64; ++sub) { const bool more = sub + 1 < KCH / 64;
        P0_WRH(0); if (more) P0_LOADH(sub + 1, 0);
        P0_WRH(1); if (more) P0_LOADH(sub + 1, 1);
        P0_OUT(sub); }
#undef P0_LOADH
#undef P0_WRH
#undef P0_OUT
}
__device__ __forceinline__ void p0_row(Frame& F, const float* x, const float* meta, int r) {
    bf16* xrow = (bf16*)(F.ws + WS_XB) + (size_t)r * DM;
    const float* src = r < MTOK ? x + (size_t)r * DM : meta + (size_t)((r - MTOK) & 15) * DM;
    const bool pad = r >= MTOK + NB * NMETA;
    float s = 0.f;
    f32x4 v[16];
#pragma unroll
    for (int j = 0; j < 16; ++j) { const int e = (F.lane + 64 * j) * 4; v[j] = pad ? (f32x4){0.f, 0.f, 0.f, 0.f} : *(const GAS f32x4*)(src + e); }
#pragma unroll
    for (int j = 0; j < 16; ++j) { const int e = (F.lane + 64 * j) * 4;
        s += (v[j].x * v[j].x + v[j].y * v[j].y) + (v[j].z * v[j].z + v[j].w * v[j].w);
        if (r >= MTOK && !pad) { u64* hm = (u64*)(F.ws + WS_HMETA) + (size_t)(r - MTOK) * DM + e; hm[0] = fx_from(v[j].x); hm[1] = fx_from(v[j].y); hm[2] = fx_from(v[j].z); hm[3] = fx_from(v[j].w); }
        v2u w; w.x = pk2(v[j].x, v[j].y); w.y = pk2(v[j].z, v[j].w); *(GAS v2u*)(xrow + e) = w; }
    s = wave_sum(s);
    if (F.lane == 0) ((u64*)(F.ws + WS_SSQ0))[r] = fx_from_pos(s);
}
#ifndef CONV_IN_P2
#define CONV_IN_P2 1
#endif
constexpr int P0_KC = 256;
constexpr int CV_G = 172 * (DM / P0_KC), CV_D = 64 * (DFF / P0_KC), CV_IN1 = 384 * (DM / P0_KC), CV_O1 = 64 * (RET_VW / P0_KC);
constexpr int CV_FINE = 2 * (2 * CV_G + CV_D) + CV_IN1 + CV_O1;
constexpr int TL1_LO = 0, TL1_N = 4224;
constexpr int TL4_LO = 2 * CV_G, TL4_N = 1176;
constexpr int TL6_LO = 2 * CV_G + CV_D + CV_IN1 + CV_O1, TL6_N = 4480;
constexpr int TL10_LO = CV_FINE - CV_D, TL10_N = CV_D;
static_assert(TL6_LO == 2 * CV_G + CV_D + CV_IN1 + CV_O1 && TL1_LO + TL1_N <= TL4_LO && TL4_LO + TL4_N <= TL6_LO && TL6_LO + TL6_N <= TL10_LO && TL10_LO + TL10_N == CV_FINE, "tail ranges");
constexpr int CV_P2 = CONV_IN_P2 ? CV_FINE - TL1_N - TL4_N - TL6_N - TL10_N : 0;
constexpr int CV_PER = 32, N_CONV = (CV_P2 + CV_PER - 1) / CV_PER;
__host__ __device__ constexpr int p2_conv_index(int d) {
    return d < TL4_LO - (TL1_LO + TL1_N) ? TL1_LO + TL1_N + d
         : d < (TL4_LO - (TL1_LO + TL1_N)) + (TL6_LO - (TL4_LO + TL4_N)) ? TL4_LO + TL4_N + (d - (TL4_LO - (TL1_LO + TL1_N)))
         : TL6_LO + TL6_N + (d - (TL4_LO - (TL1_LO + TL1_N)) - (TL6_LO - (TL4_LO + TL4_N))); }
static_assert(p2_conv_index(0) == (TL1_LO + TL1_N < TL4_LO ? TL1_LO + TL1_N : TL4_LO + TL4_N) && p2_conv_index(CV_FINE - TL1_N - TL4_N - TL6_N - TL10_N - 1) == (TL6_LO + TL6_N < TL10_LO ? TL10_LO - 1 : TL6_LO - 1), "P2 conversion index map");
struct ConvPtrs { const float *wg, *wu, *wd, *win1, *wo1, *fnorm, *cnorm; };
__device__ __forceinline__ void conv_fine_b2(unsigned char* ws, LAS unsigned* tile, const ConvPtrs P, int it, int lane) {
    int r = it;
    if (r < CV_G) { p0_tr<1, P0_KC, true>(P.wg, DM, DFF, (bf16*)(ws + WS_WGU0), tile, r, lane, P.fnorm); return; } r -= CV_G;
    if (r < CV_G) { p0_tr<2, P0_KC, true>(P.wu, DM, DFF, (bf16*)(ws + WS_WGU0), tile, r, lane, P.fnorm); return; } r -= CV_G;
    if (r < CV_D) { p0_tr<0, P0_KC>(P.wd, DFF, DM, (bf16*)(ws + WS_WD0), tile, r, lane); return; } r -= CV_D;
    if (r < CV_IN1) { p0_tr<0, P0_KC, true>(P.win1, DM, RET_IN, (bf16*)(ws + WS_WIN1), tile, r, lane, P.cnorm); return; } r -= CV_IN1;
    if (r < CV_O1) { p0_tr<0, P0_KC>(P.wo1, RET_VW, DM, (bf16*)(ws + WS_WOUT1), tile, r, lane); return; } r -= CV_O1;
    if (r < CV_G) { p0_tr<1, P0_KC, true>(P.wg + (size_t)DM * DFF, DM, DFF, (bf16*)(ws + WS_WGU1), tile, r, lane, P.fnorm + DM); return; } r -= CV_G;
    if (r < CV_G) { p0_tr<2, P0_KC, true>(P.wu + (size_t)DM * DFF, DM, DFF, (bf16*)(ws + WS_WGU1), tile, r, lane, P.fnorm + DM); return; } r -= CV_G;
    p0_tr<0, P0_KC>(P.wd + (size_t)DFF * DM, DFF, DM, (bf16*)(ws + WS_WD1), tile, r, lane);
}
__device__ __forceinline__ void conv_item(unsigned char* ws, LAS unsigned char* ldsb, ConvPtrs P, int ci, int wave, int lane) {
    LAS unsigned* tile = (LAS unsigned*)(ldsb + wave * 8448);
    for (int k = wave; k < CV_PER; k += NWAVES) { const int d = __builtin_amdgcn_readfirstlane(ci * CV_PER + k); if (d < CV_P2) conv_fine_b2(ws, tile, P, p2_conv_index(d), lane); }
}
__device__ __forceinline__ void tail_conv(Frame& F, const Args& A, int qword, int lo, int n) {
#if CONV_IN_P2
    gu32* q = (gu32*)(F.ws + WS_CTL) + qword;
    const ConvPtrs CP{A.in[20], A.in[21], A.in[22], A.in[16], A.in[18], A.in[19], A.in[15]};
    LAS unsigned* tile = (LAS unsigned*)(F.lds + F.wave * 8448);
    for (;;) {
        if (F.tid == 0) F.MISC[0] = __hip_atomic_fetch_add(q, 1u, RLX_AGENT);
        __syncthreads();
        const int bt = (int)F.MISC[0];
        __syncthreads();
        if (bt * NWAVES >= n) break;
        const int k = __builtin_amdgcn_readfirstlane(bt * NWAVES + F.wave);
        if (k < n) conv_fine_b2(F.ws, tile, CP, lo + k, F.lane);
    }
#endif
}
__device__ __forceinline__ void p0_prologue(Frame& F, const Args& A) {
    const int gw = __builtin_amdgcn_readfirstlane(blockIdx.x * NWAVES + F.wave), NGW = F.G * NWAVES;
    unsigned char* ws = F.ws;
    constexpr int KC = P0_KC; LAS unsigned* tile = (LAS unsigned*)(F.lds + F.wave * 8448);
    constexpr int I_IN0 = 161 * (DM / KC), I_SQ = 64 * (DM / KC), I_BD = 16 * 2;
    constexpr int NITEMS = I_IN0 + I_SQ + 2 * I_BD;
    for (int it = gw; it < NITEMS; it += NGW) {
        int r = it;
        if (r < I_IN0) { p0_tr<0, KC, true>(A.in[3], DM, AB_IN, (bf16*)(ws + WS_WIN0), tile, r, F.lane, A.in[2]); continue; } r -= I_IN0;
        if (r < I_SQ) { p0_tr<0, KC>(A.in[14], DM, DM, (bf16*)(ws + WS_WOUT0), tile, r, F.lane); continue; } r -= I_SQ;
        if (r < I_BD) { const int blk = r >> 1; p0_tr<0, 128>(A.in[7] + (size_t)blk * 16384, 128, 128, (bf16*)(ws + WS_WAT) + (size_t)blk * 16384, tile, r & 1, F.lane); continue; } r -= I_BD;
        { const int blk = r >> 1; p0_tr<0, 128>(A.in[9] + (size_t)blk * 16384, 128, 128, (bf16*)(ws + WS_WXT) + (size_t)blk * 16384, tile, r & 1, F.lane); }
    }
#if !CONV_IN_P2
    { const ConvPtrs CP{A.in[20], A.in[21], A.in[22], A.in[16], A.in[18], A.in[19], A.in[15]};
      for (int it = gw; it < CV_FINE; it += NGW) conv_fine_b2(ws, tile, CP, it, F.lane); }
#endif
    for (int m = gw; m < MP; m += NGW) p0_row(F, A.in[0], A.in[1], m);
}

__device__ __forceinline__ float sigmoidf_fast(float x) { return __builtin_amdgcn_rcpf(1.0f + __expf(-x)); }
__device__ __forceinline__ float gelu_tanh(float g) { const float z = 0.7978845608028654f * (g + 0.044715f * g * g * g); const float e = __expf(2.0f * z); return 0.5f * g * (2.0f - 2.0f * __builtin_amdgcn_rcpf(e + 1.0f)); }

constexpr int LRU_XA = 0, LRU_STRIDE = 272, LRU_XF = 17408, LRU_XF_STRIDE = 132  , LRU_GT = 51200, LRU_YT = 68608;
__device__ __forceinline__ void lru_item(Frame& F, const Args& A, int b, int n) {
#define LRU_BAR() do { asm volatile("s_waitcnt lgkmcnt(0)" ::: "memory"); __builtin_amdgcn_s_barrier(); asm volatile("" ::: "memory"); } while (0)
    const bf16* z0 = (const bf16*)(F.ws + WS_Z); bf16* y0 = (bf16*)(F.ws + WS_Y0);
    const int tid = F.tid, lane = F.lane, w = F.wave, fr = lane & 15, fq = lane >> 4;
    LAS unsigned char* lds = F.lds;
    LAS float* XF = (LAS float*)(lds + LRU_XF);
    const int c8 = (tid & 15) * 8, r4 = tid >> 4;
    const int ch0 = n * 128 + c8;
    float cw[4][8], cb[8];
#pragma unroll
    for (int e = 0; e < 8; ++e) { cb[e] = A.in[6][ch0 + e];
#pragma unroll
        for (int j = 0; j < 4; ++j) cw[j][e] = A.in[5][j * LRU_W + ch0 + e]; }
    const int dch = n * 128 + 16 * w + fr;
    const float ba = A.in[8][dch], bx = A.in[10][dch];
    const float cneg = -8.0f * log1pf(expf(-A.in[11][dch]));
    bf16x8 bwa[4], bwx[4];
    { const bf16* wat = (const bf16*)(F.ws + WS_WAT) + ((size_t)n * 128 + 16 * w + fr) * 128 + 8 * fq; const bf16* wxt = (const bf16*)(F.ws + WS_WXT) + ((size_t)n * 128 + 16 * w + fr) * 128 + 8 * fq;
#pragma unroll
      for (int ks = 0; ks < 4; ++ks) { bwa[ks] = *(const bf16x8*)(wat + 32 * ks); bwx[ks] = *(const bf16x8*)(wxt + 32 * ks); } }
    float hc = 0.f;
    v4u xr[2][4], gv[2];
#define LRU_LOAD(tau) do { _Pragma("unroll") for (int q = 0; q < 2; ++q) { const int t = 64 * (tau) + r4 + 32 * q - 48; \
            gv[q] = (v4u){0u, 0u, 0u, 0u}; if (t >= 0) gv[q] = *(const GAS v4u*)(z0 + (size_t)row_of(b, t) * AB_Z + LRU_W + ch0); \
            _Pragma("unroll") for (int j = 0; j < 4; ++j) { const int tj = t - 3 + j; xr[q][j] = (v4u){0u, 0u, 0u, 0u}; if (tj >= 0) xr[q][j] = *(const GAS v4u*)(z0 + (size_t)row_of(b, tj) * AB_Z + ch0); } } } while (0)
    LRU_LOAD(0);
    for (int tau = 0; tau < 65; ++tau) {
#pragma unroll
        for (int q = 0; q < 2; ++q) {
            const int rr = r4 + 32 * q;
            float xc[8];
#pragma unroll
            for (int e = 0; e < 8; ++e) xc[e] = cb[e];
#pragma unroll
            for (int j = 0; j < 4; ++j) { float xf[8]; unpack8(xr[q][j], xf);
#pragma unroll
                for (int e = 0; e < 8; ++e) xc[e] += cw[j][e] * xf[e]; }
            *(LAS v4u*)(lds + LRU_XA + rr * LRU_STRIDE + c8 * 2) = pack8f(xc);
            *(LAS f32x4*)(XF + rr * LRU_XF_STRIDE + c8) = (f32x4){xc[0], xc[1], xc[2], xc[3]};
            *(LAS f32x4*)(XF + rr * LRU_XF_STRIDE + c8 + 4) = (f32x4){xc[4], xc[5], xc[6], xc[7]};
            *(LAS v4u*)(lds + LRU_GT + rr * LRU_STRIDE + c8 * 2) = gv[q];
        }
        if (tau < 64) LRU_LOAD(tau + 1);
        LRU_BAR();
        f32x4 accr[4], acci[4];
#pragma unroll
        for (int m = 0; m < 4; ++m) { accr[m] = (f32x4){0.f, 0.f, 0.f, 0.f}; acci[m] = (f32x4){0.f, 0.f, 0.f, 0.f}; }
#pragma unroll
        for (int m = 0; m < 4; ++m)
#pragma unroll
            for (int ks = 0; ks < 4; ++ks) { const bf16x8 a = *(const LAS bf16x8*)(lds + LRU_XA + (16 * m + fr) * LRU_STRIDE + (32 * ks + 8 * fq) * 2);
                accr[m] = mfma16(a, bwa[ks], accr[m]); acci[m] = mfma16(a, bwx[ks], acci[m]); }
        const int d = 16 * w + fr;
#pragma unroll
        for (int m = 0; m < 4; ++m) {
            float av[4], bv[4];
#pragma unroll
            for (int g = 0; g < 4; ++g) { const int rr = 16 * m + 4 * fq + g;
                const float rg = sigmoidf_fast(accr[m][g] + ba), ig = sigmoidf_fast(acci[m][g] + bx);
                const float la = cneg * rg; av[g] = __expf(la); const float mult = __builtin_amdgcn_sqrtf(fmaxf(1.0f - __expf(2.0f * la), 0.f));
                bv[g] = mult * (ig * XF[rr * LRU_XF_STRIDE + d]);
                if (tau == 0 && rr < 48) bv[g] = 0.f; }
            float P = av[0] * av[1], H = bv[0] * av[1] + bv[1]; P *= av[2]; H = H * av[2] + bv[2]; P *= av[3]; H = H * av[3] + bv[3];
            { const float P1 = __shfl_up(P, 16), H1 = __shfl_up(H, 16); if (fq >= 1) { H = P * H1 + H; P = P1 * P; } }
            { const float P2 = __shfl_up(P, 32), H2 = __shfl_up(H, 32); if (fq >= 2) { H = P * H2 + H; P = P2 * P; } }
            float Pe = __shfl_up(P, 16), He = __shfl_up(H, 16); if (fq == 0) { Pe = 1.f; He = 0.f; }
            float h = Pe * hc + He;
            float hv[4];
#pragma unroll
            for (int g = 0; g < 4; ++g) { h = av[g] * h + bv[g]; hv[g] = h; }
            hc = __shfl(h, 48 + fr);
#pragma unroll
            for (int g = 0; g < 4; ++g) { const int rr = 16 * m + 4 * fq + g;
                const float gt = bf2f(*(const LAS unsigned short*)(lds + LRU_GT + rr * LRU_STRIDE + d * 2));
                *(LAS unsigned short*)(lds + LRU_YT + rr * LRU_STRIDE + d * 2) = (unsigned short)(pk2(hv[g] * gelu_tanh(gt), 0.f) & 0xffffu); }
        }
        LRU_BAR();
#pragma unroll
        for (int q = 0; q < 2; ++q) { const int rr = r4 + 32 * q, t = 64 * tau + rr - 48;
            if (t >= 0) *(GAS v4u*)(y0 + (size_t)row_of(b, t) * DM + ch0) = *(const LAS v4u*)(lds + LRU_YT + rr * LRU_STRIDE + c8 * 2); }
    }
#undef LRU_LOAD
#undef LRU_BAR
    __syncthreads();
}

constexpr int AT_STRIDE = 288, AT_TILE = 64 * AT_STRIDE, AT_KT = 0, AT_VN = 2 * AT_TILE, AT_RSK = 4 * AT_TILE, AT_CUM = AT_RSK + 512, AT_SCAN = AT_CUM + 4352 * 4;
static_assert(AT_SCAN + 64 <= RING_BYTES, "attention LDS map");
__device__ __forceinline__ float log_sigmoid(float x) { return fminf(x, 0.f) - log1pf(__expf(-fabsf(x))); }
__device__ __forceinline__ void attn_item(Frame& F, const Args& A, int b, int h, int j) {
    const bf16* z0 = (const bf16*)(F.ws + WS_Z); bf16* y0 = (bf16*)(F.ws + WS_Y0); const float* fbuf = (const float*)(F.ws + WS_FBUF);
    const int tid = F.tid, lane = F.lane, w = F.wave, fr = lane & 15, fq = lane >> 4;
    LAS unsigned char* lds = F.lds;
    LAS float* CUM = (LAS float*)(lds + AT_CUM); LAS float* SCAN = (LAS float*)(lds + AT_SCAN); LAS float* RSK = (LAS float*)(lds + AT_RSK);
    constexpr float LOG2E = 1.4426950408889634f;
    const int nT = NMETA + 256 * j;
    { const float bf_h = A.in[4][h];
      float loc[9]; float run = 0.f;
#pragma unroll
      for (int e = 0; e < 9; ++e) { const int t = 9 * tid + e; float v = 0.f; if (t < nT) v = log_sigmoid(fbuf[(size_t)row_of(b, t) * 16 + h] + bf_h); run += v; loc[e] = run; }
      float inc = run;
#pragma unroll
      for (int o = 1; o < 64; o <<= 1) { const float t = __shfl_up(inc, o); if (lane >= o) inc += t; }
      if (lane == 63) SCAN[w] = inc;
      __syncthreads();
      float off = inc - run;
      for (int k = 0; k < w; ++k) off += SCAN[k];
#pragma unroll
      for (int e = 0; e < 9; ++e) { const int t = 9 * tid + e; if (t < nT) CUM[t + 240] = (off + loc[e]) * LOG2E; }
      if (tid < 240) CUM[tid] = 0.f; }
    bf16x8 qf[2][4];
    const int ubase = 256 * j + 32 * w;
#pragma unroll
    for (int m = 0; m < 2; ++m) {
        const int u = ubase + 16 * m + fr; const int t = u - 240; const int r = row_of(b, t < 0 ? 0 : t);
        const bf16* qp = z0 + (size_t)r * AB_Z + 4096 + 128 * h + 8 * fq;
        float qv[4][8]; float s = 0.f;
#pragma unroll
        for (int ks = 0; ks < 4; ++ks) { const v4u raw = *(const GAS v4u*)(qp + 32 * ks); unpack8(raw, qv[ks]);
#pragma unroll
            for (int e = 0; e < 8; ++e) s += qv[ks][e] * qv[ks][e]; }
        s = sum_x32(sum_x16(s));
        const float rs = __builtin_amdgcn_rsqf(s * (1.0f / 128.0f) + RMS_EPS) * (0.08838834764831845f * LOG2E);
#pragma unroll
        for (int ks = 0; ks < 4; ++ks) { float o[8];
#pragma unroll
            for (int e = 0; e < 8; ++e) o[e] = qv[ks][e] * rs * (A.in[12][32 * ks + 8 * fq + e] * A.in[13][32 * ks + 8 * fq + e]);
            const v4u pk = pack8f(o); qf[m][ks] = __builtin_bit_cast(bf16x8, pk); }
    }
    f32x4 O[2][8]; float mrow[2], lrow[2];
#pragma unroll
    for (int m = 0; m < 2; ++m) {
#pragma unroll
        for (int dt = 0; dt < 8; ++dt) O[m][dt] = (f32x4){0.f, 0.f, 0.f, 0.f};
        mrow[m] = -1e30f; lrow[m] = 0.f; }
    const int imax = 4 * j + 3;
    const int skey = tid >> 3, sdc = (tid & 7) * 16;
    const unsigned vbase = (unsigned)(size_t)lds + AT_VN + (4u * fq + ((unsigned)(lane & 15) >> 2)) * AT_STRIDE + 8u * (unsigned)(lane & 3);
    v4u kreg[2], vreg[2];
#define AT_LOAD(i_) do { const int t_ = 64 * (i_) + skey - 240; const int r_ = row_of(b, t_ < 0 ? 0 : t_); const bf16* kp_ = z0 + (size_t)r_ * AB_Z + 6144 + 128 * h + sdc; const bf16* vp_ = z0 + (size_t)r_ * AB_Z + 8192 + 128 * h + sdc; \
        kreg[0] = *(const GAS v4u*)(kp_); kreg[1] = *(const GAS v4u*)(kp_ + 8); vreg[0] = *(const GAS v4u*)(vp_); vreg[1] = *(const GAS v4u*)(vp_ + 8); } while (0)
    const unsigned klo_ = (unsigned)(skey * AB_Z + 6144 + 128 * h + sdc) * 2u;
#define AT_LOADN(i_) do { const unsigned char* zt_ = (const unsigned char*)(z0 + (size_t)(b * SEQ + 64 * (i_) - 256) * AB_Z); \
        kreg[0] = *(const GAS v4u*)(zt_ + klo_); kreg[1] = *(const GAS v4u*)(zt_ + klo_ + 16); vreg[0] = *(const GAS v4u*)(zt_ + klo_ + 4096); vreg[1] = *(const GAS v4u*)(zt_ + klo_ + 4112); } while (0)
#define AT_STAGE(buf_) do { float a8_[8], b8_[8]; unpack8(kreg[0], a8_); unpack8(kreg[1], b8_); float s_ = 0.f; \
        _Pragma("unroll") for (int e = 0; e < 8; ++e) s_ += a8_[e] * a8_[e] + b8_[e] * b8_[e]; \
        s_ = oct_sum(s_); \
        if ((tid & 7) == 0) RSK[(buf_) * 64 + skey] = __builtin_amdgcn_rsqf(s_ * (1.0f / 128.0f) + RMS_EPS); \
        *(LAS v4u*)(lds + AT_KT + (buf_) * AT_TILE + skey * AT_STRIDE + sdc * 2) = kreg[0]; *(LAS v4u*)(lds + AT_KT + (buf_) * AT_TILE + skey * AT_STRIDE + sdc * 2 + 16) = kreg[1]; \
        *(LAS v4u*)(lds + AT_VN + (buf_) * AT_TILE + skey * AT_STRIDE + sdc * 2) = vreg[0]; *(LAS v4u*)(lds + AT_VN + (buf_) * AT_TILE + skey * AT_STRIDE + sdc * 2 + 16) = vreg[1]; } while (0)
    AT_LOAD(3); AT_STAGE(1);
    if (imax > 3) AT_LOAD(4);
    __syncthreads();
    float bq[2];
#pragma unroll
    for (int m = 0; m < 2; ++m) bq[m] = CUM[ubase + 16 * m + fr];
#ifdef PROBE_ATT_A
    unsigned long long atm_t0 = 0, atm_acc = 0;
#define ATM(n) do { if ((n) == PROBE_ATT_A) atm_t0 = __builtin_amdgcn_s_memrealtime(); if ((n) == PROBE_ATT_B) atm_acc += __builtin_amdgcn_s_memrealtime() - atm_t0; } while (0)
#else
#define ATM(n) do { } while (0)
#endif
    for (int i = 3; i <= imax; ++i) {
        const int buf = i & 1;
        ATM(0);
        if (i < imax) { AT_STAGE(buf ^ 1); if (i + 1 < imax) AT_LOADN(i + 2); }
        ATM(1);
        if (64 * i <= ubase + 31) {
            f32x4 S[2][4];
#pragma unroll
            for (int m = 0; m < 2; ++m)
#pragma unroll
                for (int nt = 0; nt < 4; ++nt) S[m][nt] = (f32x4){0.f, 0.f, 0.f, 0.f};
#pragma unroll
            for (int nt = 0; nt < 4; ++nt)
#pragma unroll
                for (int ks = 0; ks < 4; ++ks) { const bf16x8 kf = *(const LAS bf16x8*)(lds + AT_KT + buf * AT_TILE + (16 * nt + fr) * AT_STRIDE + (32 * ks + 8 * fq) * 2);
                    S[0][nt] = mfma16(kf, qf[0][ks], S[0][nt]); S[1][nt] = mfma16(kf, qf[1][ks], S[1][nt]); }
            ATM(2);
            const bool need_mask = (i == 3) || (64 * i + 63 > ubase);
            bf16x8 pb[2][2];
#pragma unroll
            for (int m = 0; m < 2; ++m) {
                const int uq = ubase + 16 * m + fr;
                float mx = -__builtin_inff();
#pragma unroll
                for (int nt = 0; nt < 4; ++nt) { const f32x4 bkv = *(const LAS f32x4*)(CUM + 64 * i + 16 * nt + 4 * fq), rkv = *(const LAS f32x4*)(RSK + buf * 64 + 16 * nt + 4 * fq);
#pragma unroll
                    for (int g = 0; g < 4; ++g) S[m][nt][g] = S[m][nt][g] * rkv[g] + (bq[m] - bkv[g]); }
                if (need_mask) {
#pragma unroll
                    for (int nt = 0; nt < 4; ++nt)
#pragma unroll
                        for (int g = 0; g < 4; ++g) { const int uk = 64 * i + 16 * nt + 4 * fq + g; if (uk > uq || uk < 240) S[m][nt][g] = -__builtin_inff(); }
                    asm volatile("" ::: "memory"); }
#pragma unroll
                for (int nt = 0; nt < 4; ++nt)
#pragma unroll
                    for (int g = 0; g < 4; ++g) mx = fmaxf(mx, S[m][nt][g]);
                mx = max_x32(max_x16(mx));
                const float mn = fmaxf(mrow[m], mx);
                const float alpha = __builtin_amdgcn_exp2f(mrow[m] - mn); mrow[m] = mn;
                float ps = 0.f;
#pragma unroll
                for (int nt = 0; nt < 4; ++nt)
#pragma unroll
                    for (int g = 0; g < 4; ++g) { const float p = __builtin_amdgcn_exp2f(S[m][nt][g] - mn); ps += p; S[m][nt][g] = p; }
                lrow[m] = lrow[m] * alpha + ps;
                if (!__all(alpha == 1.0f)) {
#pragma unroll
                    for (int dt = 0; dt < 8; ++dt) O[m][dt] *= alpha; }
#pragma unroll
                for (int k2 = 0; k2 < 2; ++k2) { v4u pw; pw.x = pk2(S[m][2 * k2][0], S[m][2 * k2][1]); pw.y = pk2(S[m][2 * k2][2], S[m][2 * k2][3]); pw.z = pk2(S[m][2 * k2 + 1][0], S[m][2 * k2 + 1][1]); pw.w = pk2(S[m][2 * k2 + 1][2], S[m][2 * k2 + 1][3]);
                    pb[m][k2] = __builtin_bit_cast(bf16x8, pw); }
            }
            ATM(3);
            const unsigned vb = vbase + (unsigned)(buf * AT_TILE);
            { v2u vp[16]; asm volatile("ds_read_b64_tr_b16 %0, %16 offset:0 \n\tds_read_b64_tr_b16 %1, %16 offset:4608 \n\tds_read_b64_tr_b16 %2, %16 offset:9216 \n\tds_read_b64_tr_b16 %3, %16 offset:13824 \n\tds_read_b64_tr_b16 %4, %16 offset:32 \n\tds_read_b64_tr_b16 %5, %16 offset:4640 \n\tds_read_b64_tr_b16 %6, %16 offset:9248 \n\tds_read_b64_tr_b16 %7, %16 offset:13856 \n\tds_read_b64_tr_b16 %8, %16 offset:64 \n\tds_read_b64_tr_b16 %9, %16 offset:4672 \n\tds_read_b64_tr_b16 %10, %16 offset:9280 \n\tds_read_b64_tr_b16 %11, %16 offset:13888 \n\tds_read_b64_tr_b16 %12, %16 offset:96 \n\tds_read_b64_tr_b16 %13, %16 offset:4704 \n\tds_read_b64_tr_b16 %14, %16 offset:9312 \n\tds_read_b64_tr_b16 %15, %16 offset:13920 \n\ts_waitcnt lgkmcnt(0)" : "=&v"(vp[0]), "=&v"(vp[1]), "=&v"(vp[2]), "=&v"(vp[3]), "=&v"(vp[4]), "=&v"(vp[5]), "=&v"(vp[6]), "=&v"(vp[7]), "=&v"(vp[8]), "=&v"(vp[9]), "=&v"(vp[10]), "=&v"(vp[11]), "=&v"(vp[12]), "=&v"(vp[13]), "=&v"(vp[14]), "=&v"(vp[15]) : "v"(vb) : "memory");
              { v4u aw; aw.x = vp[0].x; aw.y = vp[0].y; aw.z = vp[1].x; aw.w = vp[1].y; const bf16x8 vfr = __builtin_bit_cast(bf16x8, aw); O[0][0] = mfma16(vfr, pb[0][0], O[0][0]); O[1][0] = mfma16(vfr, pb[1][0], O[1][0]); }
              { v4u aw; aw.x = vp[2].x; aw.y = vp[2].y; aw.z = vp[3].x; aw.w = vp[3].y; const bf16x8 vfr = __builtin_bit_cast(bf16x8, aw); O[0][0] = mfma16(vfr, pb[0][1], O[0][0]); O[1][0] = mfma16(vfr, pb[1][1], O[1][0]); }
              { v4u aw; aw.x = vp[4].x; aw.y = vp[4].y; aw.z = vp[5].x; aw.w = vp[5].y; const bf16x8 vfr = __builtin_bit_cast(bf16x8, aw); O[0][1] = mfma16(vfr, pb[0][0], O[0][1]); O[1][1] = mfma16(vfr, pb[1][0], O[1][1]); }
              { v4u aw; aw.x = vp[6].x; aw.y = vp[6].y; aw.z = vp[7].x; aw.w = vp[7].y; const bf16x8 vfr = __builtin_bit_cast(bf16x8, aw); O[0][1] = mfma16(vfr, pb[0][1], O[0][1]); O[1][1] = mfma16(vfr, pb[1][1], O[1][1]); }
              { v4u aw; aw.x = vp[8].x; aw.y = vp[8].y; aw.z = vp[9].x; aw.w = vp[9].y; const bf16x8 vfr = __builtin_bit_cast(bf16x8, aw); O[0][2] = mfma16(vfr, pb[0][0], O[0][2]); O[1][2] = mfma16(vfr, pb[1][0], O[1][2]); }
              { v4u aw; aw.x = vp[10].x; aw.y = vp[10].y; aw.z = vp[11].x; aw.w = vp[11].y; const bf16x8 vfr = __builtin_bit_cast(bf16x8, aw); O[0][2] = mfma16(vfr, pb[0][1], O[0][2]); O[1][2] = mfma16(vfr, pb[1][1], O[1][2]); }
              { v4u aw; aw.x = vp[12].x; aw.y = vp[12].y; aw.z = vp[13].x; aw.w = vp[13].y; const bf16x8 vfr = __builtin_bit_cast(bf16x8, aw); O[0][3] = mfma16(vfr, pb[0][0], O[0][3]); O[1][3] = mfma16(vfr, pb[1][0], O[1][3]); }
              { v4u aw; aw.x = vp[14].x; aw.y = vp[14].y; aw.z = vp[15].x; aw.w = vp[15].y; const bf16x8 vfr = __builtin_bit_cast(bf16x8, aw); O[0][3] = mfma16(vfr, pb[0][1], O[0][3]); O[1][3] = mfma16(vfr, pb[1][1], O[1][3]); }
            }
            { v2u vp[16]; asm volatile("ds_read_b64_tr_b16 %0, %16 offset:128 \n\tds_read_b64_tr_b16 %1, %16 offset:4736 \n\tds_read_b64_tr_b16 %2, %16 offset:9344 \n\tds_read_b64_tr_b16 %3, %16 offset:13952 \n\tds_read_b64_tr_b16 %4, %16 offset:160 \n\tds_read_b64_tr_b16 %5, %16 offset:4768 \n\tds_read_b64_tr_b16 %6, %16 offset:9376 \n\tds_read_b64_tr_b16 %7, %16 offset:13984 \n\tds_read_b64_tr_b16 %8, %16 offset:192 \n\tds_read_b64_tr_b16 %9, %16 offset:4800 \n\tds_read_b64_tr_b16 %10, %16 offset:9408 \n\tds_read_b64_tr_b16 %11, %16 offset:14016 \n\tds_read_b64_tr_b16 %12, %16 offset:224 \n\tds_read_b64_tr_b16 %13, %16 offset:4832 \n\tds_read_b64_tr_b16 %14, %16 offset:9440 \n\tds_read_b64_tr_b16 %15, %16 offset:14048 \n\ts_waitcnt lgkmcnt(0)" : "=&v"(vp[0]), "=&v"(vp[1]), "=&v"(vp[2]), "=&v"(vp[3]), "=&v"(vp[4]), "=&v"(vp[5]), "=&v"(vp[6]), "=&v"(vp[7]), "=&v"(vp[8]), "=&v"(vp[9]), "=&v"(vp[10]), "=&v"(vp[11]), "=&v"(vp[12]), "=&v"(vp[13]), "=&v"(vp[14]), "=&v"(vp[15]) : "v"(vb) : "memory");
              { v4u aw; aw.x = vp[0].x; aw.y = vp[0].y; aw.z = vp[1].x; aw.w = vp[1].y; const bf16x8 vfr = __builtin_bit_cast(bf16x8, aw); O[0][4] = mfma16(vfr, pb[0][0], O[0][4]); O[1][4] = mfma16(vfr, pb[1][0], O[1][4]); }
              { v4u aw; aw.x = vp[2].x; aw.y = vp[2].y; aw.z = vp[3].x; aw.w = vp[3].y; const bf16x8 vfr = __builtin_bit_cast(bf16x8, aw); O[0][4] = mfma16(vfr, pb[0][1], O[0][4]); O[1][4] = mfma16(vfr, pb[1][1], O[1][4]); }
              { v4u aw; aw.x = vp[4].x; aw.y = vp[4].y; aw.z = vp[5].x; aw.w = vp[5].y; const bf16x8 vfr = __builtin_bit_cast(bf16x8, aw); O[0][5] = mfma16(vfr, pb[0][0], O[0][5]); O[1][5] = mfma16(vfr, pb[1][0], O[1][5]); }
              { v4u aw; aw.x = vp[6].x; aw.y = vp[6].y; aw.z = vp[7].x; aw.w = vp[7].y; const bf16x8 vfr = __builtin_bit_cast(bf16x8, aw); O[0][5] = mfma16(vfr, pb[0][1], O[0][5]); O[1][5] = mfma16(vfr, pb[1][1], O[1][5]); }
              { v4u aw; aw.x = vp[8].x; aw.y = vp[8].y; aw.z = vp[9].x; aw.w = vp[9].y; const bf16x8 vfr = __builtin_bit_cast(bf16x8, aw); O[0][6] = mfma16(vfr, pb[0][0], O[0][6]); O[1][6] = mfma16(vfr, pb[1][0], O[1][6]); }
              { v4u aw; aw.x = vp[10].x; aw.y = vp[10].y; aw.z = vp[11].x; aw.w = vp[11].y; const bf16x8 vfr = __builtin_bit_cast(bf16x8, aw); O[0][6] = mfma16(vfr, pb[0][1], O[0][6]); O[1][6] = mfma16(vfr, pb[1][1], O[1][6]); }
              { v4u aw; aw.x = vp[12].x; aw.y = vp[12].y; aw.z = vp[13].x; aw.w = vp[13].y; const bf16x8 vfr = __builtin_bit_cast(bf16x8, aw); O[0][7] = mfma16(vfr, pb[0][0], O[0][7]); O[1][7] = mfma16(vfr, pb[1][0], O[1][7]); }
              { v4u aw; aw.x = vp[14].x; aw.y = vp[14].y; aw.z = vp[15].x; aw.w = vp[15].y; const bf16x8 vfr = __builtin_bit_cast(bf16x8, aw); O[0][7] = mfma16(vfr, pb[0][1], O[0][7]); O[1][7] = mfma16(vfr, pb[1][1], O[1][7]); }
            }
        }
        ATM(4);
        asm volatile("s_waitcnt lgkmcnt(0)" ::: "memory"); __builtin_amdgcn_s_barrier(); asm volatile("" ::: "memory");
        ATM(5);
    }
#ifdef PROBE_ATT_A
    if (w == 0 && lane == 0 && blockIdx.x == 0) { const unsigned long long a_ = (((unsigned long long)F.MISC[23] << 32) | F.MISC[22]) + atm_acc; F.MISC[22] = (unsigned)a_; F.MISC[23] = (unsigned)(a_ >> 32); }
#endif
#undef ATM
#undef AT_LOAD
#undef AT_LOADN
#undef AT_STAGE
#pragma unroll
    for (int m = 0; m < 2; ++m) {
        float l = sum_x32(sum_x16(lrow[m]));
        const int t = ubase + 16 * m + fr - 240;
        if (t >= 0) { const float il = __builtin_amdgcn_rcpf(l); bf16* op = y0 + (size_t)row_of(b, t) * DM + LRU_W + 128 * h + 4 * fq;
#pragma unroll
            for (int dt = 0; dt < 8; ++dt) { v2u o; o.x = pk2(O[m][dt][0] * il, O[m][dt][1] * il); o.y = pk2(O[m][dt][2] * il, O[m][dt][3] * il); *(GAS v2u*)(op + 16 * dt) = o; } }
    }
}

__device__ __forceinline__ int p2_fetch(Frame& F, gu32* qctr) {
    if ((F.wave == 0 && hw_lane() == 0)) F.MISC[0] = __hip_atomic_fetch_add(qctr, 1u, RLX_AGENT);
    __syncthreads();
    const int item = (int)F.MISC[0];
    __syncthreads();
    return item;
}
#ifndef CONV_CAP
#define CONV_CAP 96
#endif
__device__ __forceinline__ int p2_next(Frame& F, gu32* qa, gu32* qc, gu32* act, int nconv, int qa_end, int pending) {
    if ((F.wave == 0 && hw_lane() == 0)) {
        int code = -1;
        bool done_att = F.MISC[3] != 0u;
        if (!done_att) {
            if (pending >= 0) { if (pending < qa_end) code = pending; else done_att = true; }
            else {
                if ((int)__hip_atomic_load(qc, RLX_AGENT) < nconv && (int)__hip_atomic_load(act, RLX_AGENT) < CONV_CAP) {
                    const int a = (int)__hip_atomic_fetch_add(act, 1u, RLX_AGENT);
                    if (a < CONV_CAP) { const int c = (int)__hip_atomic_fetch_add(qc, 1u, RLX_AGENT); if (c < nconv) code = -3 - c; }
                    if (code == -1) (void)__hip_atomic_fetch_add(act, 0xFFFFFFFFu, RLX_AGENT); }
                if (code == -1) { const int t = (int)__hip_atomic_fetch_add(qa, 1u, RLX_AGENT); if (t < qa_end) code = t; else done_att = true; } } }
        if (code == -1) { const int c = (int)__hip_atomic_fetch_add(qc, 1u, RLX_AGENT); if (c < nconv) { code = -3 - c; (void)__hip_atomic_fetch_add(act, 1u, RLX_AGENT); } else code = -2; }
        F.MISC[3] = done_att ? 1u : 0u; F.MISC[0] = (unsigned)code; }
    __syncthreads();
    const int code = (int)F.MISC[0];
    __syncthreads();
    return code;
}
__device__ __forceinline__ void p2_mixer0(Frame& F, const Args& A, int rep) {
    gu32* ctl = (gu32*)(F.ws + WS_CTL);
    gu32* qa = ctl + CW_Q2 + 64 * rep; gu32* qc = ctl + CW_QC + 64 * rep; gu32* act = ctl + CW_ACT + 64 * rep;
    constexpr int N_LRU = NB * 16, N_ATT = NB * FOX_H * 17;
    const int nconv = (rep == 0) ? N_CONV : 0;
    if ((F.wave == 0 && hw_lane() == 0)) F.MISC[3] = 0u;
    int item = p2_fetch(F, qa);
#ifdef PROBE_LRU
    const unsigned long long lru_t0 = __builtin_amdgcn_s_memrealtime(); const bool lru_first = (item == 0);
#endif
    while (item < N_LRU) { lru_item(F, A, item >> 4, item & 15); item = p2_fetch(F, qa); }
#ifdef PROBE_LRU
    if (lru_first && F.wave == 0 && hw_lane() == 0) __hip_atomic_store(ctl + 1000, (unsigned)(__builtin_amdgcn_s_memrealtime() - lru_t0), __ATOMIC_RELAXED, __HIP_MEMORY_SCOPE_AGENT);
#endif
    int code = p2_next(F, qa, qc, act, nconv, N_LRU + N_ATT, item);
    while (code != -2) {
        Frame G = F; { const int ln = hw_lane(); G.lane = ln; G.tid = F.wave * 64 + ln; G.wave = F.wave; }
        if (code >= 0) { const int a = code - N_LRU; const int j = 16 - a / 64, bh = a % 64; attn_item(G, A, bh >> 4, bh & 15, j); }
        else { const ConvPtrs CP{A.in[20], A.in[21], A.in[22], A.in[16], A.in[18], A.in[19], A.in[15]}; conv_item(G.ws, G.lds, CP, -3 - code, G.wave, G.lane);
            __syncthreads(); if ((F.wave == 0 && hw_lane() == 0)) (void)__hip_atomic_fetch_add(act, 0xFFFFFFFFu, RLX_AGENT); }
        code = p2_next(F, qa, qc, act, nconv, N_LRU + N_ATT, -1);
    }
}

constexpr int RT_SQ = 528, RT_SV = 272, RT_SS_STRIDE = 144;
constexpr int RT_QS = 0, RT_KN = 33792, RT_VN = 67584, RT_VS = 84992, RT_SS = 102400, RT_OB = 111616, RT_OB_STRIDE = 272;
static_assert(RT_KN == 64 * RT_SQ && RT_VN == RT_KN + 64 * RT_SQ && RT_VS == RT_VN + 64 * RT_SV && RT_SS == RT_VS + 64 * RT_SV && RT_OB == RT_SS + 64 * RT_SS_STRIDE && RT_OB + 64 * RT_OB_STRIDE <= MISC_OFF, "retention LDS map");
__device__ __forceinline__ int ret_row(int b, int c, int idx) { return c == 0 ? (idx < 48 ? -1 : MMETA + NMETA * b + (idx - 48)) : b * SEQ + 64 * (c - 1) + idx; }
__device__ __forceinline__ void ret_item(Frame& F, const Args& A, int b, int h, int es, bool accum) {
    const bf16* z1 = (const bf16*)(F.ws + WS_Z); bf16* ob = (bf16*)(F.ws + WS_Y1); u64* ssqo = (u64*)(F.ws + WS_SSQO);
    const int tid = F.tid, lane = F.lane, w = F.wave, fr = lane & 15, fq = lane >> 4;
    LAS unsigned char* lds = F.lds;
    const float lg = log1pf(-exp2f(-5.0f - (float)h)) * 1.4426950408889634f;
    const float cdec = __builtin_amdgcn_exp2f(lg * 64.0f);
    f32x4 Sacc[16];
#pragma unroll
    for (int dt = 0; dt < 16; ++dt) Sacc[dt] = (f32x4){0.f, 0.f, 0.f, 0.f};
    const int qrow = tid >> 5, qd = (tid & 31) * 8;
    const int vrow = tid >> 4, ve = (tid & 15) * 8;
    const float kd0 = __builtin_amdgcn_exp2f(lg * (float)(63 - vrow)), kd1 = __builtin_amdgcn_exp2f(lg * (float)(31 - vrow));
    const unsigned lbase = (unsigned)(size_t)lds;
    const unsigned trq = (unsigned)((lane & 15) >> 2), trp = (unsigned)(lane & 3);
    const unsigned kbase = lbase + RT_KN + (8u * fq + trq) * RT_SQ + 8u * trp;
    const unsigned vbase = lbase + RT_VN + (8u * fq + trq) * RT_SV + 32u * w + 8u * trp;
    const unsigned vsbase = vbase + (RT_VS - RT_VN);
    v4u qreg[4], kreg[4], vreg[2];
    const size_t qcol = (size_t)h * RET_QK + qd, kcol = 4096 + (size_t)h * RET_QK + qd, vcol = 8192 + (size_t)h * RET_V + 128 * es + ve;
#define RT_PREFETCH(c) do { \
        _Pragma("unroll") for (int k = 0; k < 4; ++k) { const int r = ret_row(b, (c), qrow + 16 * k); \
            if (r >= 0) { qreg[k] = *(const GAS v4u*)(z1 + (size_t)r * RET_IN + qcol); kreg[k] = *(const GAS v4u*)(z1 + (size_t)r * RET_IN + kcol); } \
            else { qreg[k] = (v4u){0u, 0u, 0u, 0u}; kreg[k] = (v4u){0u, 0u, 0u, 0u}; } } \
        _Pragma("unroll") for (int k = 0; k < 2; ++k) { const int r = ret_row(b, (c), vrow + 32 * k); \
            if (r >= 0) vreg[k] = *(const GAS v4u*)(z1 + (size_t)r * RET_IN + vcol); else vreg[k] = (v4u){0u, 0u, 0u, 0u}; } } while (0)
    RT_PREFETCH(0);
    const unsigned qo_ = (unsigned)(qrow * RET_IN + (int)qcol) * 2u, ko_ = (unsigned)(qrow * RET_IN + (int)kcol) * 2u, vo_ = (unsigned)(vrow * RET_IN + (int)vcol) * 2u;
#define RT_PREFETCHN(c) do { const unsigned char* zc_ = (const unsigned char*)(z1 + (size_t)(b * SEQ + 64 * ((c) - 1)) * RET_IN); \
        _Pragma("unroll") for (int k = 0; k < 4; ++k) { const unsigned char* zk_ = zc_ + (size_t)(16 * k) * RET_IN * 2; qreg[k] = *(const GAS v4u*)(zk_ + qo_); kreg[k] = *(const GAS v4u*)(zk_ + ko_); } \
        _Pragma("unroll") for (int k = 0; k < 2; ++k) { const unsigned char* zk_ = zc_ + (size_t)(32 * k) * RET_IN * 2; vreg[k] = *(const GAS v4u*)(zk_ + vo_); } } while (0)
#define RT_BAR() do { asm volatile("s_waitcnt lgkmcnt(0)" ::: "memory"); __builtin_amdgcn_s_barrier(); asm volatile("" ::: "memory"); } while (0)
#define RT_FLUSH(cc) do { const int row_ = tid >> 3, seg_ = tid & 7; const LAS unsigned char* sp_ = lds + RT_OB + row_ * RT_OB_STRIDE + seg_ * 32; \
        const v4u o0_ = *(const LAS v4u*)(sp_), o1_ = *(const LAS v4u*)(sp_ + 16); \
        bf16* dp_ = ob + (size_t)(b * SEQ + 64 * ((cc) - 1) + row_) * RET_VW + h * RET_V + 128 * es + 16 * seg_; \
        *(GAS v4u*)(dp_) = o0_; *(GAS v4u*)(dp_ + 8) = o1_; } while (0)
#ifdef PROBE_ATT_A
    unsigned long long rtm_t0 = 0, rtm_acc = 0;
#define RTM(n) do { if ((n) + 100 == PROBE_ATT_A) rtm_t0 = __builtin_amdgcn_s_memrealtime(); if ((n) + 100 == PROBE_ATT_B) rtm_acc += __builtin_amdgcn_s_memrealtime() - rtm_t0; } while (0)
#else
#define RTM(n) do { } while (0)
#endif
    for (int c = 0; c < 65; ++c) {
        RTM(0);
        RT_BAR();
        RTM(1);
#pragma unroll
        for (int k = 0; k < 4; ++k) { const int m = qrow + 16 * k;
            *(LAS v4u*)(lds + RT_QS + m * RT_SQ + qd * 2) = qreg[k];
            *(LAS v4u*)(lds + RT_KN + m * RT_SQ + qd * 2) = kreg[k]; }
#pragma unroll
        for (int k = 0; k < 2; ++k) { const int m = vrow + 32 * k; float vf8[8]; unpack8(vreg[k], vf8); const float kd = k == 0 ? kd0 : kd1;
            *(LAS v4u*)(lds + RT_VN + m * RT_SV + ve * 2) = vreg[k];
#pragma unroll
            for (int e = 0; e < 8; ++e) vf8[e] *= kd;
            *(LAS v4u*)(lds + RT_VS + m * RT_SV + ve * 2) = pack8f(vf8); }
        RTM(15);
        RT_BAR();
        if (c < 64) RT_PREFETCHN(c + 1);
        if (c >= 2) RT_FLUSH(c - 1);
        RTM(2);
        { const int it = w >> 1, mt0 = 2 * (w & 1);
          f32x4 sacc[2] = {(f32x4){0.f, 0.f, 0.f, 0.f}, (f32x4){0.f, 0.f, 0.f, 0.f}};
#pragma unroll
          for (int ks = 0; ks < 8; ++ks) { const bf16x8 a = *(const LAS bf16x8*)(lds + RT_QS + (16 * it + fr) * RT_SQ + (32 * ks + 8 * fq) * 2);
#pragma unroll
              for (int q = 0; q < 2; ++q) { const bf16x8 kb = *(const LAS bf16x8*)(lds + RT_KN + (16 * (mt0 + q) + fr) * RT_SQ + (32 * ks + 8 * fq) * 2); sacc[q] = mfma16(a, kb, sacc[q]); } }
#pragma unroll
          for (int q = 0; q < 2; ++q)
#pragma unroll
              for (int g = 0; g < 4; ++g) { const int i = 16 * it + 4 * fq + g, m = 16 * (mt0 + q) + fr; const int dd = i > m ? i - m : m - i;
                  const float sv = sacc[q][g] * __builtin_amdgcn_exp2f(lg * (float)dd);
                  *(LAS unsigned short*)(lds + RT_SS + i * RT_SS_STRIDE + m * 2) = (unsigned short)(pk2(sv, 0.f) & 0xffffu); } }
        RTM(3);
        RT_BAR();
        RTM(4);
        f32x4 acc[4];
#pragma unroll
        for (int mi = 0; mi < 4; ++mi) acc[mi] = (f32x4){0.f, 0.f, 0.f, 0.f};
        const unsigned qbase = lbase + RT_QS + (unsigned)fr * RT_SQ + 8u * (unsigned)fq;
        { v4u bw; bw.x = pk2(Sacc[0][0], Sacc[0][1]); bw.y = pk2(Sacc[0][2], Sacc[0][3]); bw.z = pk2(Sacc[1][0], Sacc[1][1]); bw.w = pk2(Sacc[1][2], Sacc[1][3]);
          const bf16x8 bfrag = __builtin_bit_cast(bf16x8, bw); v2u qq[8];
          asm volatile("ds_read_b64 %0, %8 offset:0 \n\tds_read_b64 %1, %8 offset:32 \n\tds_read_b64 %2, %8 offset:8448 \n\tds_read_b64 %3, %8 offset:8480 \n\tds_read_b64 %4, %8 offset:16896 \n\tds_read_b64 %5, %8 offset:16928 \n\tds_read_b64 %6, %8 offset:25344 \n\tds_read_b64 %7, %8 offset:25376 \n\ts_waitcnt lgkmcnt(0)" : "=&v"(qq[0]), "=&v"(qq[1]), "=&v"(qq[2]), "=&v"(qq[3]), "=&v"(qq[4]), "=&v"(qq[5]), "=&v"(qq[6]), "=&v"(qq[7]) : "v"(qbase) : "memory");
          { v4u aw; aw.x = qq[0].x; aw.y = qq[0].y; aw.z = qq[1].x; aw.w = qq[1].y; acc[0] = mfma16(__builtin_bit_cast(bf16x8, aw), bfrag, acc[0]); }
          { v4u aw; aw.x = qq[2].x; aw.y = qq[2].y; aw.z = qq[3].x; aw.w = qq[3].y; acc[1] = mfma16(__builtin_bit_cast(bf16x8, aw), bfrag, acc[1]); }
          { v4u aw; aw.x = qq[4].x; aw.y = qq[4].y; aw.z = qq[5].x; aw.w = qq[5].y; acc[2] = mfma16(__builtin_bit_cast(bf16x8, aw), bfrag, acc[2]); }
          { v4u aw; aw.x = qq[6].x; aw.y = qq[6].y; aw.z = qq[7].x; aw.w = qq[7].y; acc[3] = mfma16(__builtin_bit_cast(bf16x8, aw), bfrag, acc[3]); }
        }
        { v4u bw; bw.x = pk2(Sacc[2][0], Sacc[2][1]); bw.y = pk2(Sacc[2][2], Sacc[2][3]); bw.z = pk2(Sacc[3][0], Sacc[3][1]); bw.w = pk2(Sacc[3][2], Sacc[3][3]);
          const bf16x8 bfrag = __builtin_bit_cast(bf16x8, bw); v2u qq[8];
          asm volatile("ds_read_b64 %0, %8 offset:64 \n\tds_read_b64 %1, %8 offset:96 \n\tds_read_b64 %2, %8 offset:8512 \n\tds_read_b64 %3, %8 offset:8544 \n\tds_read_b64 %4, %8 offset:16960 \n\tds_read_b64 %5, %8 offset:16992 \n\tds_read_b64 %6, %8 offset:25408 \n\tds_read_b64 %7, %8 offset:25440 \n\ts_waitcnt lgkmcnt(0)" : "=&v"(qq[0]), "=&v"(qq[1]), "=&v"(qq[2]), "=&v"(qq[3]), "=&v"(qq[4]), "=&v"(qq[5]), "=&v"(qq[6]), "=&v"(qq[7]) : "v"(qbase) : "memory");
          { v4u aw; aw.x = qq[0].x; aw.y = qq[0].y; aw.z = qq[1].x; aw.w = qq[1].y; acc[0] = mfma16(__builtin_bit_cast(bf16x8, aw), bfrag, acc[0]); }
          { v4u aw; aw.x = qq[2].x; aw.y = qq[2].y; aw.z = qq[3].x; aw.w = qq[3].y; acc[1] = mfma16(__builtin_bit_cast(bf16x8, aw), bfrag, acc[1]); }
          { v4u aw; aw.x = qq[4].x; aw.y = qq[4].y; aw.z = qq[5].x; aw.w = qq[5].y; acc[2] = mfma16(__builtin_bit_cast(bf16x8, aw), bfrag, acc[2]); }
          { v4u aw; aw.x = qq[6].x; aw.y = qq[6].y; aw.z = qq[7].x; aw.w = qq[7].y; acc[3] = mfma16(__builtin_bit_cast(bf16x8, aw), bfrag, acc[3]); }
        }
        { v4u bw; bw.x = pk2(Sacc[4][0], Sacc[4][1]); bw.y = pk2(Sacc[4][2], Sacc[4][3]); bw.z = pk2(Sacc[5][0], Sacc[5][1]); bw.w = pk2(Sacc[5][2], Sacc[5][3]);
          const bf16x8 bfrag = __builtin_bit_cast(bf16x8, bw); v2u qq[8];
          asm volatile("ds_read_b64 %0, %8 offset:128 \n\tds_read_b64 %1, %8 offset:160 \n\tds_read_b64 %2, %8 offset:8576 \n\tds_read_b64 %3, %8 offset:8608 \n\tds_read_b64 %4, %8 offset:17024 \n\tds_read_b64 %5, %8 offset:17056 \n\tds_read_b64 %6, %8 offset:25472 \n\tds_read_b64 %7, %8 offset:25504 \n\ts_waitcnt lgkmcnt(0)" : "=&v"(qq[0]), "=&v"(qq[1]), "=&v"(qq[2]), "=&v"(qq[3]), "=&v"(qq[4]), "=&v"(qq[5]), "=&v"(qq[6]), "=&v"(qq[7]) : "v"(qbase) : "memory");
          { v4u aw; aw.x = qq[0].x; aw.y = qq[0].y; aw.z = qq[1].x; aw.w = qq[1].y; acc[0] = mfma16(__builtin_bit_cast(bf16x8, aw), bfrag, acc[0]); }
          { v4u aw; aw.x = qq[2].x; aw.y = qq[2].y; aw.z = qq[3].x; aw.w = qq[3].y; acc[1] = mfma16(__builtin_bit_cast(bf16x8, aw), bfrag, acc[1]); }
          { v4u aw; aw.x = qq[4].x; aw.y = qq[4].y; aw.z = qq[5].x; aw.w = qq[5].y; acc[2] = mfma16(__builtin_bit_cast(bf16x8, aw), bfrag, acc[2]); }
          { v4u aw; aw.x = qq[6].x; aw.y = qq[6].y; aw.z = qq[7].x; aw.w = qq[7].y; acc[3] = mfma16(__builtin_bit_cast(bf16x8, aw), bfrag, acc[3]); }
        }
        { v4u bw; bw.x = pk2(Sacc[6][0], Sacc[6][1]); bw.y = pk2(Sacc[6][2], Sacc[6][3]); bw.z = pk2(Sacc[7][0], Sacc[7][1]); bw.w = pk2(Sacc[7][2], Sacc[7][3]);
          const bf16x8 bfrag = __builtin_bit_cast(bf16x8, bw); v2u qq[8];
          asm volatile("ds_read_b64 %0, %8 offset:192 \n\tds_read_b64 %1, %8 offset:224 \n\tds_read_b64 %2, %8 offset:8640 \n\tds_read_b64 %3, %8 offset:8672 \n\tds_read_b64 %4, %8 offset:17088 \n\tds_read_b64 %5, %8 offset:17120 \n\tds_read_b64 %6, %8 offset:25536 \n\tds_read_b64 %7, %8 offset:25568 \n\ts_waitcnt lgkmcnt(0)" : "=&v"(qq[0]), "=&v"(qq[1]), "=&v"(qq[2]), "=&v"(qq[3]), "=&v"(qq[4]), "=&v"(qq[5]), "=&v"(qq[6]), "=&v"(qq[7]) : "v"(qbase) : "memory");
          { v4u aw; aw.x = qq[0].x; aw.y = qq[0].y; aw.z = qq[1].x; aw.w = qq[1].y; acc[0] = mfma16(__builtin_bit_cast(bf16x8, aw), bfrag, acc[0]); }
          { v4u aw; aw.x = qq[2].x; aw.y = qq[2].y; aw.z = qq[3].x; aw.w = qq[3].y; acc[1] = mfma16(__builtin_bit_cast(bf16x8, aw), bfrag, acc[1]); }
          { v4u aw; aw.x = qq[4].x; aw.y = qq[4].y; aw.z = qq[5].x; aw.w = qq[5].y; acc[2] = mfma16(__builtin_bit_cast(bf16x8, aw), bfrag, acc[2]); }
          { v4u aw; aw.x = qq[6].x; aw.y = qq[6].y; aw.z = qq[7].x; aw.w = qq[7].y; acc[3] = mfma16(__builtin_bit_cast(bf16x8, aw), bfrag, acc[3]); }
        }
        { v4u bw; bw.x = pk2(Sacc[8][0], Sacc[8][1]); bw.y = pk2(Sacc[8][2], Sacc[8][3]); bw.z = pk2(Sacc[9][0], Sacc[9][1]); bw.w = pk2(Sacc[9][2], Sacc[9][3]);
          const bf16x8 bfrag = __builtin_bit_cast(bf16x8, bw); v2u qq[8];
          asm volatile("ds_read_b64 %0, %8 offset:256 \n\tds_read_b64 %1, %8 offset:288 \n\tds_read_b64 %2, %8 offset:8704 \n\tds_read_b64 %3, %8 offset:8736 \n\tds_read_b64 %4, %8 offset:17152 \n\tds_read_b64 %5, %8 offset:17184 \n\tds_read_b64 %6, %8 offset:25600 \n\tds_read_b64 %7, %8 offset:25632 \n\ts_waitcnt lgkmcnt(0)" : "=&v"(qq[0]), "=&v"(qq[1]), "=&v"(qq[2]), "=&v"(qq[3]), "=&v"(qq[4]), "=&v"(qq[5]), "=&v"(qq[6]), "=&v"(qq[7]) : "v"(qbase) : "memory");
          { v4u aw; aw.x = qq[0].x; aw.y = qq[0].y; aw.z = qq[1].x; aw.w = qq[1].y; acc[0] = mfma16(__builtin_bit_cast(bf16x8, aw), bfrag, acc[0]); }
          { v4u aw; aw.x = qq[2].x; aw.y = qq[2].y; aw.z = qq[3].x; aw.w = qq[3].y; acc[1] = mfma16(__builtin_bit_cast(bf16x8, aw), bfrag, acc[1]); }
          { v4u aw; aw.x = qq[4].x; aw.y = qq[4].y; aw.z = qq[5].x; aw.w = qq[5].y; acc[2] = mfma16(__builtin_bit_cast(bf16x8, aw), bfrag, acc[2]); }
          { v4u aw; aw.x = qq[6].x; aw.y = qq[6].y; aw.z = qq[7].x; aw.w = qq[7].y; acc[3] = mfma16(__builtin_bit_cast(bf16x8, aw), bfrag, acc[3]); }
        }
        { v4u bw; bw.x = pk2(Sacc[10][0], Sacc[10][1]); bw.y = pk2(Sacc[10][2], Sacc[10][3]); bw.z = pk2(Sacc[11][0], Sacc[11][1]); bw.w = pk2(Sacc[11][2], Sacc[11][3]);
          const bf16x8 bfrag = __builtin_bit_cast(bf16x8, bw); v2u qq[8];
          asm volatile("ds_read_b64 %0, %8 offset:320 \n\tds_read_b64 %1, %8 offset:352 \n\tds_read_b64 %2, %8 offset:8768 \n\tds_read_b64 %3, %8 offset:8800 \n\tds_read_b64 %4, %8 offset:17216 \n\tds_read_b64 %5, %8 offset:17248 \n\tds_read_b64 %6, %8 offset:25664 \n\tds_read_b64 %7, %8 offset:25696 \n\ts_waitcnt lgkmcnt(0)" : "=&v"(qq[0]), "=&v"(qq[1]), "=&v"(qq[2]), "=&v"(qq[3]), "=&v"(qq[4]), "=&v"(qq[5]), "=&v"(qq[6]), "=&v"(qq[7]) : "v"(qbase) : "memory");
          { v4u aw; aw.x = qq[0].x; aw.y = qq[0].y; aw.z = qq[1].x; aw.w = qq[1].y; acc[0] = mfma16(__builtin_bit_cast(bf16x8, aw), bfrag, acc[0]); }
          { v4u aw; aw.x = qq[2].x; aw.y = qq[2].y; aw.z = qq[3].x; aw.w = qq[3].y; acc[1] = mfma16(__builtin_bit_cast(bf16x8, aw), bfrag, acc[1]); }
          { v4u aw; aw.x = qq[4].x; aw.y = qq[4].y; aw.z = qq[5].x; aw.w = qq[5].y; acc[2] = mfma16(__builtin_bit_cast(bf16x8, aw), bfrag, acc[2]); }
          { v4u aw; aw.x = qq[6].x; aw.y = qq[6].y; aw.z = qq[7].x; aw.w = qq[7].y; acc[3] = mfma16(__builtin_bit_cast(bf16x8, aw), bfrag, acc[3]); }
        }
        { v4u bw; bw.x = pk2(Sacc[12][0], Sacc[12][1]); bw.y = pk2(Sacc[12][2], Sacc[12][3]); bw.z = pk2(Sacc[13][0], Sacc[13][1]); bw.w = pk2(Sacc[13][2], Sacc[13][3]);
          const bf16x8 bfrag = __builtin_bit_cast(bf16x8, bw); v2u qq[8];
          asm volatile("ds_read_b64 %0, %8 offset:384 \n\tds_read_b64 %1, %8 offset:416 \n\tds_read_b64 %2, %8 offset:8832 \n\tds_read_b64 %3, %8 offset:8864 \n\tds_read_b64 %4, %8 offset:17280 \n\tds_read_b64 %5, %8 offset:17312 \n\tds_read_b64 %6, %8 offset:25728 \n\tds_read_b64 %7, %8 offset:25760 \n\ts_waitcnt lgkmcnt(0)" : "=&v"(qq[0]), "=&v"(qq[1]), "=&v"(qq[2]), "=&v"(qq[3]), "=&v"(qq[4]), "=&v"(qq[5]), "=&v"(qq[6]), "=&v"(qq[7]) : "v"(qbase) : "memory");
          { v4u aw; aw.x = qq[0].x; aw.y = qq[0].y; aw.z = qq[1].x; aw.w = qq[1].y; acc[0] = mfma16(__builtin_bit_cast(bf16x8, aw), bfrag, acc[0]); }
          { v4u aw; aw.x = qq[2].x; aw.y = qq[2].y; aw.z = qq[3].x; aw.w = qq[3].y; acc[1] = mfma16(__builtin_bit_cast(bf16x8, aw), bfrag, acc[1]); }
          { v4u aw; aw.x = qq[4].x; aw.y = qq[4].y; aw.z = qq[5].x; aw.w = qq[5].y; acc[2] = mfma16(__builtin_bit_cast(bf16x8, aw), bfrag, acc[2]); }
          { v4u aw; aw.x = qq[6].x; aw.y = qq[6].y; aw.z = qq[7].x; aw.w = qq[7].y; acc[3] = mfma16(__builtin_bit_cast(bf16x8, aw), bfrag, acc[3]); }
        }
        { v4u bw; bw.x = pk2(Sacc[14][0], Sacc[14][1]); bw.y = pk2(Sacc[14][2], Sacc[14][3]); bw.z = pk2(Sacc[15][0], Sacc[15][1]); bw.w = pk2(Sacc[15][2], Sacc[15][3]);
          const bf16x8 bfrag = __builtin_bit_cast(bf16x8, bw); v2u qq[8];
          asm volatile("ds_read_b64 %0, %8 offset:448 \n\tds_read_b64 %1, %8 offset:480 \n\tds_read_b64 %2, %8 offset:8896 \n\tds_read_b64 %3, %8 offset:8928 \n\tds_read_b64 %4, %8 offset:17344 \n\tds_read_b64 %5, %8 offset:17376 \n\tds_read_b64 %6, %8 offset:25792 \n\tds_read_b64 %7, %8 offset:25824 \n\ts_waitcnt lgkmcnt(0)" : "=&v"(qq[0]), "=&v"(qq[1]), "=&v"(qq[2]), "=&v"(qq[3]), "=&v"(qq[4]), "=&v"(qq[5]), "=&v"(qq[6]), "=&v"(qq[7]) : "v"(qbase) : "memory");
          { v4u aw; aw.x = qq[0].x; aw.y = qq[0].y; aw.z = qq[1].x; aw.w = qq[1].y; acc[0] = mfma16(__builtin_bit_cast(bf16x8, aw), bfrag, acc[0]); }
          { v4u aw; aw.x = qq[2].x; aw.y = qq[2].y; aw.z = qq[3].x; aw.w = qq[3].y; acc[1] = mfma16(__builtin_bit_cast(bf16x8, aw), bfrag, acc[1]); }
          { v4u aw; aw.x = qq[4].x; aw.y = qq[4].y; aw.z = qq[5].x; aw.w = qq[5].y; acc[2] = mfma16(__builtin_bit_cast(bf16x8, aw), bfrag, acc[2]); }
          { v4u aw; aw.x = qq[6].x; aw.y = qq[6].y; aw.z = qq[7].x; aw.w = qq[7].y; acc[3] = mfma16(__builtin_bit_cast(bf16x8, aw), bfrag, acc[3]); }
        }
#pragma unroll
        for (int mi = 0; mi < 4; ++mi)
#pragma unroll
            for (int g = 0; g < 4; ++g) acc[mi][g] *= __builtin_amdgcn_exp2f(lg * (float)(16 * mi + 4 * fq + g + 1));
        RTM(45);
        v2u vp[8];
        asm volatile("ds_read_b64_tr_b16 %0, %4 offset:0 \n\tds_read_b64_tr_b16 %1, %4 offset:1088 \n\tds_read_b64_tr_b16 %2, %4 offset:8704 \n\tds_read_b64_tr_b16 %3, %4 offset:9792 \n\ts_waitcnt lgkmcnt(0)" : "=&v"(vp[0]), "=&v"(vp[1]), "=&v"(vp[2]), "=&v"(vp[3]) : "v"(vbase) : "memory");
        asm volatile("ds_read_b64_tr_b16 %0, %4 offset:0 \n\tds_read_b64_tr_b16 %1, %4 offset:1088 \n\tds_read_b64_tr_b16 %2, %4 offset:8704 \n\tds_read_b64_tr_b16 %3, %4 offset:9792 \n\ts_waitcnt lgkmcnt(0)" : "=&v"(vp[4]), "=&v"(vp[5]), "=&v"(vp[6]), "=&v"(vp[7]) : "v"(vsbase) : "memory");
        bf16x8 vf[2], vs[2];
        { v4u t0; t0.x = vp[0].x; t0.y = vp[0].y; t0.z = vp[1].x; t0.w = vp[1].y; vf[0] = __builtin_bit_cast(bf16x8, t0); v4u t1; t1.x = vp[4].x; t1.y = vp[4].y; t1.z = vp[5].x; t1.w = vp[5].y; vs[0] = __builtin_bit_cast(bf16x8, t1); }
        { v4u t0; t0.x = vp[2].x; t0.y = vp[2].y; t0.z = vp[3].x; t0.w = vp[3].y; vf[1] = __builtin_bit_cast(bf16x8, t0); v4u t1; t1.x = vp[6].x; t1.y = vp[6].y; t1.z = vp[7].x; t1.w = vp[7].y; vs[1] = __builtin_bit_cast(bf16x8, t1); }
#pragma unroll
        for (int mi = 0; mi < 4; ++mi)
#pragma unroll
            for (int k2 = 0; k2 < 2; ++k2) { const bf16x8 a = *(const LAS bf16x8*)(lds + RT_SS + (16 * mi + fr) * RT_SS_STRIDE + (32 * k2 + 8 * fq) * 2); acc[mi] = mfma16(a, vf[k2], acc[mi]); }
        RTM(5);
        if (c > 0) {
            float sel = 0.f;
#pragma unroll
            for (int mi = 0; mi < 4; ++mi)
#pragma unroll
                for (int g = 0; g < 4; ++g) { const float v = acc[mi][g];
                    *(LAS unsigned short*)(lds + RT_OB + (16 * mi + 4 * fq + g) * RT_OB_STRIDE + (16 * w + fr) * 2) = (unsigned short)(pk2(v, 0.f) & 0xffffu);
                    const float sq = row16_sum(v * v);
                    sel = (fr == 4 * mi + g) ? sq : sel; }
            if (accum) { const int rj = b * SEQ + 64 * (c - 1) + 16 * (fr >> 2) + 4 * fq + (fr & 3); atomicAdd(ssqo + (size_t)rj * 16 + h, fx_from_pos(sel)); }
        }
        RTM(6);
#pragma unroll
        for (int dt = 0; dt < 16; ++dt) Sacc[dt] *= cdec;
        { v2u kp[16]; asm volatile("ds_read_b64_tr_b16 %0, %16 offset:0 \n\tds_read_b64_tr_b16 %1, %16 offset:2112 \n\tds_read_b64_tr_b16 %2, %16 offset:16896 \n\tds_read_b64_tr_b16 %3, %16 offset:19008 \n\tds_read_b64_tr_b16 %4, %16 offset:32 \n\tds_read_b64_tr_b16 %5, %16 offset:2144 \n\tds_read_b64_tr_b16 %6, %16 offset:16928 \n\tds_read_b64_tr_b16 %7, %16 offset:19040 \n\tds_read_b64_tr_b16 %8, %16 offset:64 \n\tds_read_b64_tr_b16 %9, %16 offset:2176 \n\tds_read_b64_tr_b16 %10, %16 offset:16960 \n\tds_read_b64_tr_b16 %11, %16 offset:19072 \n\tds_read_b64_tr_b16 %12, %16 offset:96 \n\tds_read_b64_tr_b16 %13, %16 offset:2208 \n\tds_read_b64_tr_b16 %14, %16 offset:16992 \n\tds_read_b64_tr_b16 %15, %16 offset:19104 \n\ts_waitcnt lgkmcnt(0)" : "=&v"(kp[0]), "=&v"(kp[1]), "=&v"(kp[2]), "=&v"(kp[3]), "=&v"(kp[4]), "=&v"(kp[5]), "=&v"(kp[6]), "=&v"(kp[7]), "=&v"(kp[8]), "=&v"(kp[9]), "=&v"(kp[10]), "=&v"(kp[11]), "=&v"(kp[12]), "=&v"(kp[13]), "=&v"(kp[14]), "=&v"(kp[15]) : "v"(kbase) : "memory");
          { v4u aw; aw.x = kp[0].x; aw.y = kp[0].y; aw.z = kp[1].x; aw.w = kp[1].y; Sacc[0] = mfma16(__builtin_bit_cast(bf16x8, aw), vs[0], Sacc[0]); }
          { v4u aw; aw.x = kp[2].x; aw.y = kp[2].y; aw.z = kp[3].x; aw.w = kp[3].y; Sacc[0] = mfma16(__builtin_bit_cast(bf16x8, aw), vs[1], Sacc[0]); }
          { v4u aw; aw.x = kp[4].x; aw.y = kp[4].y; aw.z = kp[5].x; aw.w = kp[5].y; Sacc[1] = mfma16(__builtin_bit_cast(bf16x8, aw), vs[0], Sacc[1]); }
          { v4u aw; aw.x = kp[6].x; aw.y = kp[6].y; aw.z = kp[7].x; aw.w = kp[7].y; Sacc[1] = mfma16(__builtin_bit_cast(bf16x8, aw), vs[1], Sacc[1]); }
          { v4u aw; aw.x = kp[8].x; aw.y = kp[8].y; aw.z = kp[9].x; aw.w = kp[9].y; Sacc[2] = mfma16(__builtin_bit_cast(bf16x8, aw), vs[0], Sacc[2]); }
          { v4u aw; aw.x = kp[10].x; aw.y = kp[10].y; aw.z = kp[11].x; aw.w = kp[11].y; Sacc[2] = mfma16(__builtin_bit_cast(bf16x8, aw), vs[1], Sacc[2]); }
          { v4u aw; aw.x = kp[12].x; aw.y = kp[12].y; aw.z = kp[13].x; aw.w = kp[13].y; Sacc[3] = mfma16(__builtin_bit_cast(bf16x8, aw), vs[0], Sacc[3]); }
          { v4u aw; aw.x = kp[14].x; aw.y = kp[14].y; aw.z = kp[15].x; aw.w = kp[15].y; Sacc[3] = mfma16(__builtin_bit_cast(bf16x8, aw), vs[1], Sacc[3]); }
        }
        { v2u kp[16]; asm volatile("ds_read_b64_tr_b16 %0, %16 offset:128 \n\tds_read_b64_tr_b16 %1, %16 offset:2240 \n\tds_read_b64_tr_b16 %2, %16 offset:17024 \n\tds_read_b64_tr_b16 %3, %16 offset:19136 \n\tds_read_b64_tr_b16 %4, %16 offset:160 \n\tds_read_b64_tr_b16 %5, %16 offset:2272 \n\tds_read_b64_tr_b16 %6, %16 offset:17056 \n\tds_read_b64_tr_b16 %7, %16 offset:19168 \n\tds_read_b64_tr_b16 %8, %16 offset:192 \n\tds_read_b64_tr_b16 %9, %16 offset:2304 \n\tds_read_b64_tr_b16 %10, %16 offset:17088 \n\tds_read_b64_tr_b16 %11, %16 offset:19200 \n\tds_read_b64_tr_b16 %12, %16 offset:224 \n\tds_read_b64_tr_b16 %13, %16 offset:2336 \n\tds_read_b64_tr_b16 %14, %16 offset:17120 \n\tds_read_b64_tr_b16 %15, %16 offset:19232 \n\ts_waitcnt lgkmcnt(0)" : "=&v"(kp[0]), "=&v"(kp[1]), "=&v"(kp[2]), "=&v"(kp[3]), "=&v"(kp[4]), "=&v"(kp[5]), "=&v"(kp[6]), "=&v"(kp[7]), "=&v"(kp[8]), "=&v"(kp[9]), "=&v"(kp[10]), "=&v"(kp[11]), "=&v"(kp[12]), "=&v"(kp[13]), "=&v"(kp[14]), "=&v"(kp[15]) : "v"(kbase) : "memory");
          { v4u aw; aw.x = kp[0].x; aw.y = kp[0].y; aw.z = kp[1].x; aw.w = kp[1].y; Sacc[4] = mfma16(__builtin_bit_cast(bf16x8, aw), vs[0], Sacc[4]); }
          { v4u aw; aw.x = kp[2].x; aw.y = kp[2].y; aw.z = kp[3].x; aw.w = kp[3].y; Sacc[4] = mfma16(__builtin_bit_cast(bf16x8, aw), vs[1], Sacc[4]); }
          { v4u aw; aw.x = kp[4].x; aw.y = kp[4].y; aw.z = kp[5].x; aw.w = kp[5].y; Sacc[5] = mfma16(__builtin_bit_cast(bf16x8, aw), vs[0], Sacc[5]); }
          { v4u aw; aw.x = kp[6].x; aw.y = kp[6].y; aw.z = kp[7].x; aw.w = kp[7].y; Sacc[5] = mfma16(__builtin_bit_cast(bf16x8, aw), vs[1], Sacc[5]); }
          { v4u aw; aw.x = kp[8].x; aw.y = kp[8].y; aw.z = kp[9].x; aw.w = kp[9].y; Sacc[6] = mfma16(__builtin_bit_cast(bf16x8, aw), vs[0], Sacc[6]); }
          { v4u aw; aw.x = kp[10].x; aw.y = kp[10].y; aw.z = kp[11].x; aw.w = kp[11].y; Sacc[6] = mfma16(__builtin_bit_cast(bf16x8, aw), vs[1], Sacc[6]); }
          { v4u aw; aw.x = kp[12].x; aw.y = kp[12].y; aw.z = kp[13].x; aw.w = kp[13].y; Sacc[7] = mfma16(__builtin_bit_cast(bf16x8, aw), vs[0], Sacc[7]); }
          { v4u aw; aw.x = kp[14].x; aw.y = kp[14].y; aw.z = kp[15].x; aw.w = kp[15].y; Sacc[7] = mfma16(__builtin_bit_cast(bf16x8, aw), vs[1], Sacc[7]); }
        }
        { v2u kp[16]; asm volatile("ds_read_b64_tr_b16 %0, %16 offset:256 \n\tds_read_b64_tr_b16 %1, %16 offset:2368 \n\tds_read_b64_tr_b16 %2, %16 offset:17152 \n\tds_read_b64_tr_b16 %3, %16 offset:19264 \n\tds_read_b64_tr_b16 %4, %16 offset:288 \n\tds_read_b64_tr_b16 %5, %16 offset:2400 \n\tds_read_b64_tr_b16 %6, %16 offset:17184 \n\tds_read_b64_tr_b16 %7, %16 offset:19296 \n\tds_read_b64_tr_b16 %8, %16 offset:320 \n\tds_read_b64_tr_b16 %9, %16 offset:2432 \n\tds_read_b64_tr_b16 %10, %16 offset:17216 \n\tds_read_b64_tr_b16 %11, %16 offset:19328 \n\tds_read_b64_tr_b16 %12, %16 offset:352 \n\tds_read_b64_tr_b16 %13, %16 offset:2464 \n\tds_read_b64_tr_b16 %14, %16 offset:17248 \n\tds_read_b64_tr_b16 %15, %16 offset:19360 \n\ts_waitcnt lgkmcnt(0)" : "=&v"(kp[0]), "=&v"(kp[1]), "=&v"(kp[2]), "=&v"(kp[3]), "=&v"(kp[4]), "=&v"(kp[5]), "=&v"(kp[6]), "=&v"(kp[7]), "=&v"(kp[8]), "=&v"(kp[9]), "=&v"(kp[10]), "=&v"(kp[11]), "=&v"(kp[12]), "=&v"(kp[13]), "=&v"(kp[14]), "=&v"(kp[15]) : "v"(kbase) : "memory");
          { v4u aw; aw.x = kp[0].x; aw.y = kp[0].y; aw.z = kp[1].x; aw.w = kp[1].y; Sacc[8] = mfma16(__builtin_bit_cast(bf16x8, aw), vs[0], Sacc[8]); }
          { v4u aw; aw.x = kp[2].x; aw.y = kp[2].y; aw.z = kp[3].x; aw.w = kp[3].y; Sacc[8] = mfma16(__builtin_bit_cast(bf16x8, aw), vs[1], Sacc[8]); }
          { v4u aw; aw.x = kp[4].x; aw.y = kp[4].y; aw.z = kp[5].x; aw.w = kp[5].y; Sacc[9] = mfma16(__builtin_bit_cast(bf16x8, aw), vs[0], Sacc[9]); }
          { v4u aw; aw.x = kp[6].x; aw.y = kp[6].y; aw.z = kp[7].x; aw.w = kp[7].y; Sacc[9] = mfma16(__builtin_bit_cast(bf16x8, aw), vs[1], Sacc[9]); }
          { v4u aw; aw.x = kp[8].x; aw.y = kp[8].y; aw.z = kp[9].x; aw.w = kp[9].y; Sacc[10] = mfma16(__builtin_bit_cast(bf16x8, aw), vs[0], Sacc[10]); }
          { v4u aw; aw.x = kp[10].x; aw.y = kp[10].y; aw.z = kp[11].x; aw.w = kp[11].y; Sacc[10] = mfma16(__builtin_bit_cast(bf16x8, aw), vs[1], Sacc[10]); }
          { v4u aw; aw.x = kp[12].x; aw.y = kp[12].y; aw.z = kp[13].x; aw.w = kp[13].y; Sacc[11] = mfma16(__builtin_bit_cast(bf16x8, aw), vs[0], Sacc[11]); }
          { v4u aw; aw.x = kp[14].x; aw.y = kp[14].y; aw.z = kp[15].x; aw.w = kp[15].y; Sacc[11] = mfma16(__builtin_bit_cast(bf16x8, aw), vs[1], Sacc[11]); }
        }
        { v2u kp[16]; asm volatile("ds_read_b64_tr_b16 %0, %16 offset:384 \n\tds_read_b64_tr_b16 %1, %16 offset:2496 \n\tds_read_b64_tr_b16 %2, %16 offset:17280 \n\tds_read_b64_tr_b16 %3, %16 offset:19392 \n\tds_read_b64_tr_b16 %4, %16 offset:416 \n\tds_read_b64_tr_b16 %5, %16 offset:2528 \n\tds_read_b64_tr_b16 %6, %16 offset:17312 \n\tds_read_b64_tr_b16 %7, %16 offset:19424 \n\tds_read_b64_tr_b16 %8, %16 offset:448 \n\tds_read_b64_tr_b16 %9, %16 offset:2560 \n\tds_read_b64_tr_b16 %10, %16 offset:17344 \n\tds_read_b64_tr_b16 %11, %16 offset:19456 \n\tds_read_b64_tr_b16 %12, %16 offset:480 \n\tds_read_b64_tr_b16 %13, %16 offset:2592 \n\tds_read_b64_tr_b16 %14, %16 offset:17376 \n\tds_read_b64_tr_b16 %15, %16 offset:19488 \n\ts_waitcnt lgkmcnt(0)" : "=&v"(kp[0]), "=&v"(kp[1]), "=&v"(kp[2]), "=&v"(kp[3]), "=&v"(kp[4]), "=&v"(kp[5]), "=&v"(kp[6]), "=&v"(kp[7]), "=&v"(kp[8]), "=&v"(kp[9]), "=&v"(kp[10]), "=&v"(kp[11]), "=&v"(kp[12]), "=&v"(kp[13]), "=&v"(kp[14]), "=&v"(kp[15]) : "v"(kbase) : "memory");
          { v4u aw; aw.x = kp[0].x; aw.y = kp[0].y; aw.z = kp[1].x; aw.w = kp[1].y; Sacc[12] = mfma16(__builtin_bit_cast(bf16x8, aw), vs[0], Sacc[12]); }
          { v4u aw; aw.x = kp[2].x; aw.y = kp[2].y; aw.z = kp[3].x; aw.w = kp[3].y; Sacc[12] = mfma16(__builtin_bit_cast(bf16x8, aw), vs[1], Sacc[12]); }
          { v4u aw; aw.x = kp[4].x; aw.y = kp[4].y; aw.z = kp[5].x; aw.w = kp[5].y; Sacc[13] = mfma16(__builtin_bit_cast(bf16x8, aw), vs[0], Sacc[13]); }
          { v4u aw; aw.x = kp[6].x; aw.y = kp[6].y; aw.z = kp[7].x; aw.w = kp[7].y; Sacc[13] = mfma16(__builtin_bit_cast(bf16x8, aw), vs[1], Sacc[13]); }
          { v4u aw; aw.x = kp[8].x; aw.y = kp[8].y; aw.z = kp[9].x; aw.w = kp[9].y; Sacc[14] = mfma16(__builtin_bit_cast(bf16x8, aw), vs[0], Sacc[14]); }
          { v4u aw; aw.x = kp[10].x; aw.y = kp[10].y; aw.z = kp[11].x; aw.w = kp[11].y; Sacc[14] = mfma16(__builtin_bit_cast(bf16x8, aw), vs[1], Sacc[14]); }
          { v4u aw; aw.x = kp[12].x; aw.y = kp[12].y; aw.z = kp[13].x; aw.w = kp[13].y; Sacc[15] = mfma16(__builtin_bit_cast(bf16x8, aw), vs[0], Sacc[15]); }
          { v4u aw; aw.x = kp[14].x; aw.y = kp[14].y; aw.z = kp[15].x; aw.w = kp[15].y; Sacc[15] = mfma16(__builtin_bit_cast(bf16x8, aw), vs[1], Sacc[15]); }
        }
        RTM(7);
    }
#undef RT_BAR
#undef RT_PREFETCH
#undef RT_PREFETCHN
#ifdef PROBE_ATT_A
    if (w == 0 && lane == 0 && blockIdx.x == 0) { const unsigned long long a_ = (((unsigned long long)F.MISC[23] << 32) | F.MISC[22]) + rtm_acc; F.MISC[22] = (unsigned)a_; F.MISC[23] = (unsigned)(a_ >> 32); }
#endif
#undef RTM
    __syncthreads();
    RT_FLUSH(64);
#undef RT_FLUSH
    __syncthreads();
}
__device__ __forceinline__ void p7_retention(Frame& F, const Args& A, bool accum) {
    for (int item = blockIdx.x; item < NB * RET_H * 4; item += F.G) ret_item(F, A, item >> 6, (item >> 2) & 15, item & 3, accum);
}
__device__ __forceinline__ void p8_gate(Frame& F, const Args& A, bool probe = false) {
    const bf16* z1 = (const bf16*)(F.ws + WS_Z); bf16* ob = (bf16*)(F.ws + WS_Y1); const u64* ssqo = (const u64*)(F.ws + WS_SSQO); const float* gain = A.in[17];
    const int gt = blockIdx.x * NTHREADS + F.tid, nthr = F.G * NTHREADS;
    const int c = (gt & 1023) * 8, hd = c >> 9, rstep = nthr >> 10, r0 = (gt >> 10) < rstep ? (gt >> 10) : MTOK;
    const f32x4 g0 = *(const GAS f32x4*)(gain + c), g1 = *(const GAS f32x4*)(gain + c + 4);
    for (int r = r0; r < MTOK; r += 4 * rstep) {
        v4u gw[4], ow[4]; float ss[4];
#pragma unroll
        for (int k = 0; k < 4; ++k) { const int rr = r + k * rstep; if (rr < MTOK) { gw[k] = *(const GAS v4u*)(z1 + (size_t)rr * RET_IN + 16384 + c); ow[k] = *(const GAS v4u*)(ob + (size_t)rr * RET_VW + c); ss[k] = fx_to_pos(ssqo[(size_t)rr * 16 + hd]); } }
#pragma unroll
        for (int k = 0; k < 4; ++k) { const int rr = r + k * rstep; if (rr < MTOK) {
            const float rs = __builtin_amdgcn_rsqf(ss[k] * (1.0f / 512.0f) + RMS_EPS);
            float gf[8], of[8], y[8]; unpack8(gw[k], gf); unpack8(ow[k], of);
#pragma unroll
            for (int e = 0; e < 8; ++e) { const float gn = e < 4 ? g0[e] : g1[e - 4]; y[e] = gf[e] * sigmoidf_fast(gf[e]) * (of[e] * rs * gn); }
            bf16* dst = probe ? (bf16*)(F.ws + WS_XB) + (size_t)(rr & (MTOK / 2 - 1)) * RET_VW + c : ob + (size_t)rr * RET_VW + c;
            *(GAS v4u*)dst = pack8f(y); } }
    }
}


__device__ __forceinline__ void meta_fixup(Frame& F, const u64* Hmeta, bf16* XB, u64* ssq) {
    __syncthreads();
    if (F.MISC[4] != 0u) {
        __builtin_amdgcn_fence(__ATOMIC_ACQUIRE, "agent"); asm volatile("s_waitcnt vmcnt(0)" ::: "memory");
        for (int row = F.wave; row < NB * NMETA; row += NWAVES) { const u64* hrow = Hmeta + (size_t)row * DM; bf16* xrow = XB + (size_t)(MTOK + row) * DM; float s = 0.f;
#pragma unroll 4
            for (int j = 0; j < 16; ++j) { const int e = (F.lane + 64 * j) * 4; const f32x4 v = {fx_to(hrow[e]), fx_to(hrow[e + 1]), fx_to(hrow[e + 2]), fx_to(hrow[e + 3])};
                s += (v.x * v.x + v.y * v.y) + (v.z * v.z + v.w * v.w); v2u w; w.x = pk2(v.x, v.y); w.y = pk2(v.z, v.w); *(GAS v2u*)(xrow + e) = w; }
            s = wave_sum(s);
            if (F.lane == 0) ssq[MTOK + row] = fx_from_pos(s); }
        __syncthreads();
        if (F.tid == 0) F.MISC[4] = 0u;
    }
    __syncthreads();
}


__device__ __forceinline__ void phase_stagger(int us) {
    if (us <= 0) return;
    const unsigned long long t0 = __builtin_amdgcn_s_memrealtime(), ticks = (unsigned long long)(((blockIdx.x >> 3) & 3) * us * 100);
    while (__builtin_amdgcn_s_memrealtime() - t0 < ticks) __builtin_amdgcn_s_sleep(16);
}

__global__ void __launch_bounds__(NTHREADS, 2) hybrid_fwd(Args args) {
    extern __shared__ __attribute__((aligned(16))) unsigned char lds_raw[];
    Frame F;
    F.lds = (LAS unsigned char*)lds_raw;
    F.MISC = (volatile LAS unsigned*)(F.lds + MISC_OFF);
    F.tid = threadIdx.x; F.lane = F.tid & 63; F.wave = __builtin_amdgcn_readfirstlane(F.tid >> 6);
    F.G = gridDim.x; F.ws = args.ws;
    if (F.tid < 64) F.MISC[F.tid] = 0u;
    __syncthreads();
    unsigned* ctl = (unsigned*)(F.ws + WS_CTL);
#if !MK_PER_PHASE
    const XcdBarrier bar = xcd_barrier_post(ctl + CW_BAR, F.MISC + 8, F.wave);
#define GRID_BAR() xcd_barrier(bar)
#else
#define GRID_BAR() do { } while (0)
#endif
    const int lo = args.ph_lo, hi = args.ph_hi;
#ifndef PHASE_MASK
#define PHASE_MASK 0xFFF
#endif
#define IN(k) ((((PHASE_MASK) >> (k)) & 1) && lo <= (k) && (k) < hi)
#define BOTH(k) (IN(k) && IN((k) + 1))
#ifndef STAGGER_US
#define STAGGER_US 0
#endif
#ifndef REPEAT_MASK
#define REPEAT_MASK 0
#endif
#define RETID() do { const int ln_ = hw_lane(); F.lane = ln_; F.tid = F.wave * 64 + ln_; } while (0)
#define REPS(k) (1 + (((REPEAT_MASK) >> (k)) & 1))
    unsigned char* ws = F.ws;
    bf16* XB = (bf16*)(ws + WS_XB); u64* Hmeta = (u64*)(ws + WS_HMETA); bf16* Z = (bf16*)(ws + WS_Z); bf16* Y0 = (bf16*)(ws + WS_Y0); bf16* Y1 = (bf16*)(ws + WS_Y1);
    u64* SSQ0 = (u64*)(ws + WS_SSQ0); u64* SSQ1 = (u64*)(ws + WS_SSQ1); u64* SSQ2 = (u64*)(ws + WS_SSQ2); u64* SSQ3 = (u64*)(ws + WS_SSQ3);
    const int c = (int)blockIdx.x;
#ifdef PROBE_TSUM_MASK
    if (F.tid == 0) { const unsigned long long t_ = __builtin_amdgcn_s_memrealtime(); F.MISC[20] = (unsigned)t_; F.MISC[21] = (unsigned)(t_ >> 32); F.MISC[22] = 0u; F.MISC[23] = 0u; }
#define PT(k) do { if (F.wave == 0 && hw_lane() == 0) { const unsigned long long now_ = __builtin_amdgcn_s_memrealtime(), prev_ = ((unsigned long long)F.MISC[21] << 32) | F.MISC[20]; \
        if (((PROBE_TSUM_MASK) >> (k)) & 1) { const unsigned long long a_ = (((unsigned long long)F.MISC[23] << 32) | F.MISC[22]) + (now_ - prev_); F.MISC[22] = (unsigned)a_; F.MISC[23] = (unsigned)(a_ >> 32); } \
        F.MISC[20] = (unsigned)now_; F.MISC[21] = (unsigned)(now_ >> 32); } } while (0)
#else
#define PT(k) do { } while (0)
#endif

    if (IN(0)) { RETID(); p0_prologue(F, args); if (REPS(0) > 1) p0_prologue(F, args); if (BOTH(0)) GRID_BAR(); PT(0); }
#ifdef PROBE_EXTRA_BARRIERS
    for (int k = 0; k < PROBE_EXTRA_BARRIERS; ++k) GRID_BAR();
#endif
    if (IN(1)) { RETID();
        pg8::Gemm g{XB, (const bf16*)(ws + WS_WIN0), MP, 41 * 256, DM}; pg8::StaticOrder S; S.init(MP, 41 * 256, DM, F.G, c);
        pg8::EpiIn0 E{Z, (float*)(ws + WS_FBUF), SSQ0};
        pg8::gemm_phase<pg8::EpiIn0, pg8::StaticOrder, true, true>(F.lds, g, S, E, F.wave); if (REPS(1) > 1) { pg8::gemm_phase<pg8::EpiIn0, pg8::StaticOrder, true, true>(F.lds, g, S, E, F.wave); }
        tail_conv(F, args, CW_TL1, TL1_LO, TL1_N);
        if (BOTH(1)) GRID_BAR(); PT(1);
    }
    if (IN(2)) { RETID(); p2_mixer0(F, args, 0); if (REPS(2) > 1) { GRID_BAR(); p2_mixer0(F, args, 1); } if (BOTH(2)) GRID_BAR(); PT(2); }
    if (IN(3)) { RETID();
        pg8::Gemm g{Y0, (const bf16*)(ws + WS_WOUT0), MP, DM, DM}; pg8::SplitMetaOrder S; S.init2(DM, DM, F.G, c, ctl + CW_TK3, F.MISC + 4);
        pg8::EpiResX E{args.in[0], Hmeta, XB, SSQ1, DM / 64};
        phase_stagger(STAGGER_US);
        pg8::gemm_phase<pg8::EpiResX, pg8::SplitMetaOrder, true, true>(F.lds, g, S, E, F.wave);
        meta_fixup(F, Hmeta, XB, SSQ1);
        if (REPS(3) > 1) { pg8::EpiNone EN; pg8::StaticOrder S2; S2.init(MP, DM, DM, F.G, c); pg8::gemm_phase<pg8::EpiNone, pg8::StaticOrder, true, true>(F.lds, g, S2, EN, F.wave); }
        if (BOTH(3)) GRID_BAR(); PT(3);
    }
    if (IN(4)) { RETID();
        pg8::Gemm g{XB, (const bf16*)(ws + WS_WGU0), MP, 2 * DFF, DM}; pg8::StaticOrder S; S.init(MP, 2 * DFF, DM, F.G, c);
        pg8::EpiGU E{Z, SSQ1};
#ifdef PROBE_CLOCK
        const unsigned long long ck_t0 = __builtin_amdgcn_s_memtime(), ck_r0 = __builtin_amdgcn_s_memrealtime();
#endif
        pg8::gemm_phase<pg8::EpiGU, pg8::StaticOrder, true, true>(F.lds, g, S, E, F.wave);
#ifdef PROBE_CLOCK
        { const unsigned long long ck_t1 = __builtin_amdgcn_s_memtime(), ck_r1 = __builtin_amdgcn_s_memrealtime();
          if (F.tid == 0) F.MISC[16] = (unsigned)(((ck_t1 - ck_t0) * 100ull) / (ck_r1 - ck_r0 + 1ull)); }
#endif
#ifndef PROBE_P4_MODE
#define PROBE_P4_MODE 1
#endif
        if (REPS(4) > 1) {
            if (PROBE_P4_MODE == 1) { pg8::gemm_phase<pg8::EpiGU, pg8::StaticOrder, true, true>(F.lds, g, S, E, F.wave); }
            else if (PROBE_P4_MODE == 2) { pg8::EpiNone EN; pg8::gemm_phase<pg8::EpiNone, pg8::StaticOrder, true, true>(F.lds, g, S, EN, F.wave); }
            else { pg8::EpiNone EN; pg8::HotOrder HS; HS.init(MP, 2 * DFF, DM, F.G, c); pg8::gemm_phase<pg8::EpiNone, pg8::HotOrder, true, true>(F.lds, g, HS, EN, F.wave); }
        }
        tail_conv(F, args, CW_TL4, TL4_LO, TL4_N);
        if (BOTH(4)) GRID_BAR(); PT(4);
    }
    if (IN(5)) { RETID();
        pg8::Gemm g{Z, (const bf16*)(ws + WS_WD0), MP, DM, DFF}; pg8::SplitMetaOrder S; S.init2(DM, DFF, F.G, c, ctl + CW_TK5, F.MISC + 4);
        pg8::EpiRes E{nullptr, Hmeta, XB, SSQ2, DFF / 64};
        phase_stagger(STAGGER_US);
        pg8::gemm_phase<pg8::EpiRes, pg8::SplitMetaOrder, true, true>(F.lds, g, S, E, F.wave);
        meta_fixup(F, Hmeta, XB, SSQ2);
        if (REPS(5) > 1) { pg8::StaticOrder S2; S2.init(MTOK, DM, DFF, F.G, c); pg8::EpiNone EN; pg8::gemm_phase<pg8::EpiNone, pg8::StaticOrder, true, true>(F.lds, g, S2, EN, F.wave); }
        if (BOTH(5)) GRID_BAR(); PT(5);
    }
    if (IN(6)) { RETID();
        pg8::Gemm g{XB, (const bf16*)(ws + WS_WIN1), MP, RET_IN, DM}; pg8::StaticOrder S; S.init(MP, RET_IN, DM, F.G, c);
        pg8::EpiIn1 E{Z, SSQ2};
        pg8::gemm_phase<pg8::EpiIn1, pg8::StaticOrder, true, true>(F.lds, g, S, E, F.wave); if (REPS(6) > 1) { pg8::gemm_phase<pg8::EpiIn1, pg8::StaticOrder, true, true>(F.lds, g, S, E, F.wave); }
        tail_conv(F, args, CW_TL6, TL6_LO, TL6_N);
        if (BOTH(6)) GRID_BAR(); PT(6);
    }
    if (IN(7)) { RETID(); p7_retention(F, args, true); if (REPS(7) > 1) p7_retention(F, args, false); if (BOTH(7)) GRID_BAR(); PT(7); }
    if (IN(8)) { RETID(); p8_gate(F, args); if (REPS(8) > 1) p8_gate(F, args, true); if (BOTH(8)) GRID_BAR(); PT(8); }
    if (IN(9)) { RETID();
        pg8::Gemm g{Y1, (const bf16*)(ws + WS_WOUT1), MTOK, DM, RET_VW}; pg8::StaticOrder S; S.init(MTOK, DM, RET_VW, F.G, c);
        pg8::EpiRes E{nullptr, Hmeta, XB, SSQ3, RET_VW / 64};
        phase_stagger(STAGGER_US);
        pg8::gemm_phase<pg8::EpiRes, pg8::StaticOrder, true, true>(F.lds, g, S, E, F.wave);
        if (REPS(9) > 1) { pg8::EpiNone EN; pg8::gemm_phase<pg8::EpiNone, pg8::StaticOrder, true, true>(F.lds, g, S, EN, F.wave); }
        if (BOTH(9)) GRID_BAR(); PT(9);
    }
    if (IN(10)) { RETID();
        pg8::Gemm g{XB, (const bf16*)(ws + WS_WGU1), MTOK, 2 * DFF, DM}; pg8::StaticOrder S; S.init(MTOK, 2 * DFF, DM, F.G, c);
        pg8::EpiGU E{Z, SSQ3};
        pg8::gemm_phase<pg8::EpiGU, pg8::StaticOrder, true, true>(F.lds, g, S, E, F.wave); if (REPS(10) > 1) { pg8::gemm_phase<pg8::EpiGU, pg8::StaticOrder, true, true>(F.lds, g, S, E, F.wave); }
        tail_conv(F, args, CW_TL10, TL10_LO, TL10_N);
        if (BOTH(10)) GRID_BAR(); PT(10);
    }
    if (IN(11)) { RETID();
        pg8::Gemm g{Z, (const bf16*)(ws + WS_WD1), MTOK, DM, DFF}; pg8::StaticOrder S; S.init(MTOK, DM, DFF, F.G, c);
        pg8::EpiFinal E{XB, args.out};
        phase_stagger(STAGGER_US);
        pg8::gemm_phase<pg8::EpiFinal, pg8::StaticOrder, true, true>(F.lds, g, S, E, F.wave);
        if (REPS(11) > 1) { pg8::EpiNone EN; pg8::gemm_phase<pg8::EpiNone, pg8::StaticOrder, true, true>(F.lds, g, S, EN, F.wave); }
        PT(11);
    }
#ifdef PROBE_CLOCK
    if (blockIdx.x == 0 && F.tid == 0) { const unsigned long long r0 = __builtin_amdgcn_s_memrealtime(), ticks = (unsigned long long)F.MISC[16] * 100ull;
        while (__builtin_amdgcn_s_memrealtime() - r0 < ticks) __builtin_amdgcn_s_sleep(32); }
#endif
#ifdef PROBE_TSUM_MASK
#ifdef PROBE_LRU
    if (blockIdx.x == 0 && F.wave == 0 && hw_lane() == 0) { const unsigned long long a_ = (((unsigned long long)F.MISC[23] << 32) | F.MISC[22]) + __hip_atomic_load(ctl + 1000, __ATOMIC_RELAXED, __HIP_MEMORY_SCOPE_AGENT); F.MISC[22] = (unsigned)a_; F.MISC[23] = (unsigned)(a_ >> 32); }
#endif
    if (blockIdx.x == 0 && F.wave == 0 && hw_lane() == 0) { const unsigned long long r0 = __builtin_amdgcn_s_memrealtime(), ticks = ((((unsigned long long)F.MISC[23] << 32) | F.MISC[22])) * (unsigned long long)(PROBE_TSUM_MULT);
        while (__builtin_amdgcn_s_memrealtime() - r0 < ticks) __builtin_amdgcn_s_sleep(32); }
#endif
#undef IN
#undef BOTH
}

extern "C" void kernel_launch(void* const* d_in, const int* in_sizes, int n_in, void* d_out, int out_size, void* d_ws, size_t ws_size, hipStream_t stream) {
    static int grid = 0;
    if (grid == 0) {
        if (n_in != 23 || in_sizes[0] != MTOK * DM || out_size != MTOK * DM || ws_size < WS_END) { fprintf(stderr, "kernel_launch: unexpected shapes (n_in %d, in0 %d, out %d, ws %zu < %zu); nothing launched\n", n_in, n_in > 0 ? in_sizes[0] : -1, out_size, ws_size, (size_t)WS_END); grid = -1; return; }
        int dev = 0, cus = 0, per_cu = 0;
        if (hipGetDevice(&dev) != hipSuccess || hipDeviceGetAttribute(&cus, hipDeviceAttributeMultiprocessorCount, dev) != hipSuccess) { fprintf(stderr, "kernel_launch: device query failed\n"); grid = -1; return; }
        if (hipFuncSetAttribute((const void*)hybrid_fwd, hipFuncAttributeMaxDynamicSharedMemorySize, LDS_BYTES) != hipSuccess) { fprintf(stderr, "kernel_launch: hipFuncSetAttribute failed\n"); grid = -1; return; }
        if (hipOccupancyMaxActiveBlocksPerMultiprocessor(&per_cu, (const void*)hybrid_fwd, NTHREADS, LDS_BYTES) != hipSuccess || per_cu < 1) { fprintf(stderr, "kernel_launch: occupancy query reports %d workgroups per CU\n", per_cu); }
        (void)hipGetLastError();
        grid = cus;
    }
    if (grid < 0) return;
    if (hipMemsetAsync((char*)d_ws + WS_CTL, 0, CTL_ZERO_BYTES, stream) != hipSuccess) { fprintf(stderr, "kernel_launch: memset failed\n"); return; }
    Args a{};
    for (int i = 0; i < 23; ++i) a.in[i] = (const float*)d_in[i];
    a.out = (float*)d_out; a.ws = (unsigned char*)d_ws;
#if MK_PER_PHASE
    for (int p = 0; p < NPHASES; ++p) { a.ph_lo = p; a.ph_hi = p + 1; hipLaunchKernelGGL(hybrid_fwd, dim3(grid), dim3(NTHREADS), LDS_BYTES, stream, a); }
#else
    a.ph_lo = 0; a.ph_hi = NPHASES;
    hipLaunchKernelGGL(hybrid_fwd, dim3(grid), dim3(NTHREADS), LDS_BYTES, stream, a);
#endif
    const hipError_t le = hipPeekAtLastError();
    if (le != hipSuccess) fprintf(stderr, "kernel_launch: launch failed: %s\n", hipGetErrorName(le));
}
```
